# Optimizing an MI355X kernel written in HIP

```python
import math
import jax, jax.numpy as jnp
from jax import lax
import numpy as np

D_MODEL = 1024
BATCH = 8
SEQ = 2048
DEPTH = 1
DEC_BATCH = 16
DEC_SEQ = 2048
PAST_LEN = 128

HEAD_DIM = 64
DIFF_HEADS = 4
WIN_HEADS = 8
WIN_KV_HEADS = 2
WIN_GROUP = WIN_HEADS // WIN_KV_HEADS
WINDOW = 128
BLOCK = 128
N_BUCKETS = 32
MAX_DISTANCE = 128
N_BIAS_HEADS = DIFF_HEADS + WIN_HEADS
D_FF = 2816
CONV_WIDTH = 3
EPS = 1e-6
NEG_INF = -1e30

DIFF_QK_W = DIFF_HEADS * 2 * HEAD_DIM
DIFF_V_W = DIFF_HEADS * 2 * HEAD_DIM
WIN_Q_W = WIN_HEADS * HEAD_DIM
WIN_KV_W = WIN_KV_HEADS * HEAD_DIM
D_IN = 2 * DIFF_QK_W + DIFF_V_W + WIN_Q_W + 2 * WIN_KV_W
D_MIX = DIFF_V_W + WIN_Q_W
SPLIT_POINTS = (DIFF_QK_W, 2 * DIFF_QK_W, 2 * DIFF_QK_W + DIFF_V_W,
                2 * DIFF_QK_W + DIFF_V_W + WIN_Q_W,
                2 * DIFF_QK_W + DIFF_V_W + WIN_Q_W + WIN_KV_W)

kernel_name = 'hymba_diff_window_encoder'


def rms_norm(x, g):
    xf = x.astype(jnp.float32)
    y = xf * lax.rsqrt(jnp.mean(xf * xf, axis=-1, keepdims=True) + EPS)
    return (y * g.astype(jnp.float32)).astype(x.dtype)


def rel_bucket(rel):
    nb = N_BUCKETS // 2
    max_exact = nb // 2
    ret = jnp.where(rel > 0, nb, 0)
    n = jnp.abs(rel)
    nf = jnp.maximum(n, 1).astype(jnp.float32)
    large = max_exact + (jnp.log(nf / max_exact) / math.log(MAX_DISTANCE / max_exact)
                         * (nb - max_exact)).astype(jnp.int32)
    large = jnp.minimum(large, nb - 1)
    return ret + jnp.where(n < max_exact, n, large)


def diff_attention(q, k, v, bias_table, lam):
    B, S = q.shape[0], q.shape[1]
    nb = S // BLOCK
    scale = HEAD_DIM ** -0.5
    table = bias_table[:, :DIFF_HEADS]
    kpos = jnp.arange(S)
    qb = q.reshape(B, nb, BLOCK, DIFF_HEADS, 2, HEAD_DIM).transpose(1, 0, 2, 3, 4, 5)
    lam32 = lam.astype(jnp.float32)

    def one_block(args):
        n, qblk = args
        qpos = n * BLOCK + jnp.arange(BLOCK)
        bias = table[rel_bucket(kpos[None, :] - qpos[:, None])]
        s = jnp.einsum('bqhmd,bkhmd->bhmqk', qblk, k).astype(jnp.float32) * scale
        s = s + bias.transpose(2, 0, 1)[None, :, None].astype(jnp.float32)
        p = jax.nn.softmax(s, axis=-1)
        a = p[:, :, 0] - lam32 * p[:, :, 1]
        return jnp.einsum('bhqk,bkhe->bqhe', a.astype(v.dtype), v)

    out = lax.map(one_block, (jnp.arange(nb), qb))
    return out.transpose(1, 0, 2, 3, 4).reshape(B, S, DIFF_HEADS, 2 * HEAD_DIM)


def window_attention(q, k, v, bias_table, sink):
    B, S = q.shape[0], q.shape[1]
    nb = S // BLOCK
    scale = HEAD_DIM ** -0.5
    qb = q.reshape(B, nb, BLOCK, WIN_KV_HEADS, WIN_GROUP, HEAD_DIM)

    def band(t):
        tp = jnp.pad(t, ((0, 0), (BLOCK, BLOCK), (0, 0), (0, 0)))
        tp = tp.reshape(B, nb + 2, BLOCK, WIN_KV_HEADS, HEAD_DIM)
        return jnp.concatenate([tp[:, :-2], tp[:, 1:-1], tp[:, 2:]], axis=2)

    kb, vb = band(k), band(v)
    qi = jnp.arange(BLOCK)
    kj = jnp.arange(3 * BLOCK) - BLOCK
    rel = kj[None, :] - qi[:, None]
    bias = bias_table[rel_bucket(rel)][..., DIFF_HEADS:]
    bias = bias.transpose(2, 0, 1).reshape(WIN_KV_HEADS, WIN_GROUP, BLOCK, 3 * BLOCK)
    kpos = jnp.arange(nb)[:, None] * BLOCK + kj[None, :]
    valid = ((jnp.abs(rel) <= WINDOW)[None]
             & (kpos >= 0)[:, None, :] & (kpos < S)[:, None, :])
    s = jnp.einsum('bnqhgd,bnkhd->bnhgqk', qb, kb).astype(jnp.float32) * scale
    s = s + bias[None, None].astype(jnp.float32)
    s = jnp.where(valid[None, :, None, None], s, NEG_INF)
    sink_col = jnp.broadcast_to(
        sink.astype(jnp.float32).reshape(1, 1, WIN_KV_HEADS, WIN_GROUP, 1, 1),
        s.shape[:-1] + (1,))
    p = jax.nn.softmax(jnp.concatenate([s, sink_col], axis=-1), axis=-1)[..., :-1]
    out = jnp.einsum('bnhgqk,bnkhd->bnqhgd', p.astype(v.dtype), vb)
    return out.reshape(B, S, WIN_HEADS * HEAD_DIM)


def dwconv_centered(u, w, b):
    S = u.shape[1]
    pad = CONV_WIDTH // 2
    up = jnp.pad(u, ((0, 0), (pad, pad), (0, 0)))
    return sum(up[:, i:i + S] * w[i] for i in range(CONV_WIDTH)) + b


def encoder_layer(x, layer_idx, norm_attn_g, w_in, diff_q_norm_g, diff_k_norm_g,
                  diff_lambda_q1, diff_lambda_k1, diff_lambda_q2, diff_lambda_k2,
                  diff_subln_g, win_q_norm_g, win_k_norm_g, win_sink, rel_bias,
                  w_out, norm_ffn_g, w_gate, w_up, conv_w, conv_b, w_down):
    B, S = x.shape[0], x.shape[1]
    h = rms_norm(x, norm_attn_g)
    proj = h @ w_in
    dq, dk, dv, wq, wk, wv = jnp.split(proj, SPLIT_POINTS, axis=-1)

    dq = rms_norm(dq.reshape(B, S, DIFF_HEADS, 2, HEAD_DIM), diff_q_norm_g)
    dk = rms_norm(dk.reshape(B, S, DIFF_HEADS, 2, HEAD_DIM), diff_k_norm_g)
    dv = dv.reshape(B, S, DIFF_HEADS, 2 * HEAD_DIM)
    lam_init = 0.8 - 0.6 * math.exp(-0.3 * layer_idx)
    lam = (jnp.exp(jnp.sum(diff_lambda_q1.astype(jnp.float32) * diff_lambda_k1.astype(jnp.float32)))
           - jnp.exp(jnp.sum(diff_lambda_q2.astype(jnp.float32) * diff_lambda_k2.astype(jnp.float32)))
           + lam_init)
    o_a = diff_attention(dq, dk, dv, rel_bias, lam)
    o_a = (rms_norm(o_a, diff_subln_g) * (1.0 - lam_init)).reshape(B, S, DIFF_V_W)

    wq = rms_norm(wq.reshape(B, S, WIN_HEADS, HEAD_DIM), win_q_norm_g)
    wk = rms_norm(wk.reshape(B, S, WIN_KV_HEADS, HEAD_DIM), win_k_norm_g)
    wv = wv.reshape(B, S, WIN_KV_HEADS, HEAD_DIM)
    o_b = window_attention(wq, wk, wv, rel_bias, win_sink)

    x = x + jnp.concatenate([o_a, o_b], axis=-1) @ w_out

    h = rms_norm(x, norm_ffn_g)
    u = dwconv_centered(h @ w_gate, conv_w, conv_b)
    x = x + (jax.nn.silu(u) * (h @ w_up)) @ w_down
    return x


def setup_inputs(seed: int = 0) -> dict:
    key = jax.random.key(seed)
    ks = jax.random.split(key, 22)
    f32 = jnp.float32

    def nrm(k, shape, scale):
        return jax.random.normal(k, shape, f32) * scale

    def gain(k, shape):
        return 1.0 + 0.05 * jax.random.normal(k, shape, f32)

    return {
        'x_prompt': nrm(ks[0], (BATCH, SEQ, D_MODEL), 1.0),
        'x_sample': nrm(ks[1], (DEC_BATCH, DEC_SEQ, D_MODEL), 1.0),
        'norm_attn_g': gain(ks[2], (DEPTH, D_MODEL)),
        'w_in': nrm(ks[3], (DEPTH, D_MODEL, D_IN), D_MODEL ** -0.5),
        'diff_q_norm_g': gain(ks[4], (DEPTH, HEAD_DIM)),
        'diff_k_norm_g': gain(ks[5], (DEPTH, HEAD_DIM)),
        'diff_lambda_q1': nrm(ks[6], (DEPTH, HEAD_DIM), 0.1),
        'diff_lambda_k1': nrm(ks[7], (DEPTH, HEAD_DIM), 0.1),
        'diff_lambda_q2': nrm(ks[8], (DEPTH, HEAD_DIM), 0.1),
        'diff_lambda_k2': nrm(ks[9], (DEPTH, HEAD_DIM), 0.1),
        'diff_subln_g': gain(ks[10], (DEPTH, 2 * HEAD_DIM)),
        'win_q_norm_g': gain(ks[11], (DEPTH, HEAD_DIM)),
        'win_k_norm_g': gain(ks[12], (DEPTH, HEAD_DIM)),
        'win_sink': nrm(ks[13], (DEPTH, WIN_HEADS), 0.5),
        'rel_bias': nrm(ks[14], (N_BUCKETS, N_BIAS_HEADS), 0.5),
        'w_out': nrm(ks[15], (DEPTH, D_MIX, D_MODEL), D_MIX ** -0.5),
        'norm_ffn_g': gain(ks[16], (DEPTH, D_MODEL)),
        'w_gate': nrm(ks[17], (DEPTH, D_MODEL, D_FF), D_MODEL ** -0.5),
        'w_up': nrm(ks[18], (DEPTH, D_MODEL, D_FF), D_MODEL ** -0.5),
        'conv_w': nrm(ks[19], (DEPTH, CONV_WIDTH, D_FF), CONV_WIDTH ** -0.5),
        'conv_b': nrm(ks[20], (DEPTH, D_FF), 0.02),
        'w_down': nrm(ks[21], (DEPTH, D_FF, D_MODEL), D_FF ** -0.5),
    }


def reference(x_prompt, x_sample, norm_attn_g, w_in, diff_q_norm_g, diff_k_norm_g,
              diff_lambda_q1, diff_lambda_k1, diff_lambda_q2, diff_lambda_k2,
              diff_subln_g, win_q_norm_g, win_k_norm_g, win_sink, rel_bias,
              w_out, norm_ffn_g, w_gate, w_up, conv_w, conv_b, w_down):
    def run(x):
        for l in range(DEPTH):
            x = encoder_layer(
                x, l, norm_attn_g[l], w_in[l], diff_q_norm_g[l], diff_k_norm_g[l],
                diff_lambda_q1[l], diff_lambda_k1[l], diff_lambda_q2[l], diff_lambda_k2[l],
                diff_subln_g[l], win_q_norm_g[l], win_k_norm_g[l], win_sink[l], rel_bias,
                w_out[l], norm_ffn_g[l], w_gate[l], w_up[l], conv_w[l], conv_b[l], w_down[l])
        return x

    y_prompt = run(x_prompt)
    y_sample = run(x_sample)
    return (y_prompt, y_sample)
```

```cpp
#include <hip/hip_runtime.h>
#include <hip/hip_bf16.h>
#include <cstdio>
#include <cstdint>

#ifndef MK_N_LAUNCHES
#define MK_N_LAUNCHES 1
#endif

#define LAS __attribute__((address_space(3)))
#define GAS __attribute__((address_space(1)))
typedef unsigned short bf16_t;
typedef short bf16x8 __attribute__((ext_vector_type(8)));
typedef short s16x4 __attribute__((ext_vector_type(4)));
typedef float f32x2 __attribute__((ext_vector_type(2)));
typedef float f32x4 __attribute__((ext_vector_type(4)));
typedef float f32x16 __attribute__((ext_vector_type(16)));
typedef unsigned u32x2 __attribute__((ext_vector_type(2)));
typedef unsigned u32x4 __attribute__((ext_vector_type(4)));
typedef __bf16 bf16x2_t __attribute__((ext_vector_type(2)));

constexpr int DM = 1024, SEQ = 2048, NSEQ = 24, NTOK = NSEQ * SEQ, TOK_P = 8 * SEQ;
constexpr int DIN = 2304, DFF = 2816;
constexpr int C_DQ = 0, C_DK = 512, C_DV = 1024, C_WQ = 1536, C_WK = 2048, C_WV = 2176;
constexpr int NBH = 12;
constexpr float EPS = 1e-6f, LOG2E = 1.4426950408889634f, QSCALE = 0.125f * LOG2E;
constexpr float LAM_INIT = 0.2f;
constexpr int NWAVES = 8;

__device__ __forceinline__ unsigned cvtpk(float lo, float hi) { f32x2 v = {lo, hi}; bf16x2_t b = __builtin_convertvector(v, bf16x2_t); return __builtin_bit_cast(unsigned, b); }
__device__ __forceinline__ u32x4 pack8(f32x4 a, f32x4 b) { u32x4 w; w.x = cvtpk(a[0], a[1]); w.y = cvtpk(a[2], a[3]); w.z = cvtpk(b[0], b[1]); w.w = cvtpk(b[2], b[3]); return w; }
__device__ __forceinline__ float dot4(f32x4 a) { return (a[0] * a[0] + a[1] * a[1]) + (a[2] * a[2] + a[3] * a[3]); }

namespace pg8 {
constexpr int BM = 256, BK = 64, HALF = 128, HTB = HALF * BK * 2, STAGE_BYTES = 8 * HTB, NXCD = 8, WGM = 8;
__host__ __device__ __forceinline__ int lds_byte(int r, int c) { const int st = (r >> 4) * 2 + (c >> 5), rr = r & 15, cc = c & 31, ob = rr * 64 + cc * 2; return st * 1024 + (ob ^ (((ob >> 9) & 1) << 5)); }
__host__ __device__ __forceinline__ void stage_rc(int b, int& R, int& C) { const int st = b / 1024, sb = b % 1024, swz = sb ^ (((sb >> 9) & 1) << 5); R = (st >> 1) * 16 + swz / 64; C = (st & 1) * 32 + (swz % 64) / 2; }
__host__ __device__ __forceinline__ int perm32(int rho) { const int n = rho >> 4, i = rho & 15; return 8 * (i >> 2) + 4 * n + (i & 3); }

struct Unit { int pm, pn; };
struct Gemm { const bf16_t* A; const bf16_t* Bt; int K; int arows; };

struct StaticOrder {
    int nM, nN, nwg, G, c, rev;
    __device__ void init(int nM_, int nN_, int G_, int c_, int rev_ = 0) { nM = nM_; nN = nN_; nwg = nM * nN; G = G_; c = c_; rev = rev_; }
    __device__ bool next(int i, Unit& u) const {
        const int nr = (nwg - c + G - 1) / G; if (i >= nr) return false;
        const long L = (long)(rev ? nr - 1 - i : i) * G + c;
        int wgid = (int)L; { const int q = nwg / NXCD, r = nwg % NXCD, xcd = wgid % NXCD, off = wgid / NXCD; wgid = (xcd < r ? xcd * (q + 1) : r * (q + 1) + (xcd - r) * q) + off; }
        const int nig = WGM * nN, gid = wgid / nig, fm = gid * WGM, gsz = (nM - fm) < WGM ? (nM - fm) : WGM;
        u.pm = fm + ((wgid % nig) % gsz); u.pn = (wgid % nig) / gsz; return true;
    }
};


struct EpiProj {
    static constexpr bool PERM = true;
    bf16_t* P; const LAS float* gl;
    __device__ __forceinline__ void pre(const Unit&, int, int) const {}
    __device__ __forceinline__ void operator()(const f32x4 (&acc)[2][2][4][2], const Unit& u, int wr, int wc, int fr, int fq, int lane) const {
        const int gidx = u.pn * 4 + wc;
        int gsel = -1; float sc = 1.f;
        if (gidx < 8) { gsel = 0; sc = QSCALE; } else if (gidx < 16) { gsel = 1; } else if (gidx < 24) { } else if (gidx < 32) { gsel = 2; sc = QSCALE; } else if (gidx < 34) { gsel = 3; }
        const bool nrm = gsel >= 0; const LAS float* gain = gl + (nrm ? gsel : 0) * 64;
        f32x4 gv[2][2];
#pragma unroll
        for (int bj = 0; bj < 2; ++bj)
#pragma unroll
            for (int n = 0; n < 2; ++n) gv[bj][n] = nrm ? *(const LAS f32x4*)(gain + 32 * bj + 8 * fq + 4 * n) * sc : (f32x4){1.f, 1.f, 1.f, 1.f};
        bf16_t* base = P + (size_t)(u.pm * BM + wr * 64 + fr) * DIN + gidx * 64 + 8 * fq;
#pragma unroll
        for (int ai = 0; ai < 2; ++ai)
#pragma unroll
            for (int m = 0; m < 4; ++m) {
                f32x4 v00 = acc[ai][0][m][0], v01 = acc[ai][0][m][1], v10 = acc[ai][1][m][0], v11 = acc[ai][1][m][1];
                float rn = 1.f;
                if (nrm) { float ss = (dot4(v00) + dot4(v01)) + (dot4(v10) + dot4(v11)); ss += __shfl_xor(ss, 16); ss += __shfl_xor(ss, 32); rn = __builtin_amdgcn_rsqf(ss * (1.0f / 64.0f) + EPS); }
                v00 = v00 * rn * gv[0][0]; v01 = v01 * rn * gv[0][1]; v10 = v10 * rn * gv[1][0]; v11 = v11 * rn * gv[1][1];
                bf16_t* rowp = base + (size_t)(ai * HALF + m * 16) * DIN;
                const u32x4 pa = pack8(v00, v01), pb = pack8(v10, v11);
                u32x4 px; px.x = (unsigned)__builtin_amdgcn_mov_dpp((int)pb.x, 0x128, 0xf, 0xf, true); px.y = (unsigned)__builtin_amdgcn_mov_dpp((int)pb.y, 0x128, 0xf, 0xf, true);
                px.z = (unsigned)__builtin_amdgcn_mov_dpp((int)pb.z, 0x128, 0xf, 0xf, true); px.w = (unsigned)__builtin_amdgcn_mov_dpp((int)pb.w, 0x128, 0xf, 0xf, true);
                const bool hi8 = (fr & 8) != 0;
                bf16_t* r1p = base + (size_t)(ai * HALF + m * 16 - (hi8 ? 8 : 0)) * DIN + (hi8 ? 32 : 0);
                bf16_t* r2p = base + (size_t)(ai * HALF + m * 16 + (hi8 ? 0 : 8)) * DIN + (hi8 ? 0 : 32);
                *(u32x4*)(r1p) = hi8 ? px : pa; *(u32x4*)(r2p) = hi8 ? pa : px;
            }
    }
};

struct EpiOut {
    static constexpr bool PERM = true;
    const bf16_t* __restrict__ xb; const float* __restrict__ rms; bf16_t* __restrict__ x1b; float* __restrict__ ssq; LAS float* xl;
    __device__ __forceinline__ void pre(const Unit&, int, int) const {}
    __device__ __forceinline__ void operator()(const f32x4 (&acc)[2][2][4][2], const Unit& u, int wr, int wc, int fr, int fq, int lane) const {
        asm volatile("" : "+v"(fr), "+v"(fq));
        const int rowbase = u.pm * BM;
        const int col0 = u.pn * BM + wc * 64 + 8 * fq;
        const bool hi8 = (fr & 8) != 0;
#pragma unroll
        for (int ai = 0; ai < 2; ++ai) {
            u32x4 xv[4][2]; float rr[4];
#pragma unroll
            for (int m = 0; m < 4; ++m) { const size_t row = (size_t)(rowbase + ai * HALF + wr * 64 + m * 16 + fr);
                rr[m] = rms[row];
#pragma unroll
                for (int bj = 0; bj < 2; ++bj) xv[m][bj] = *(const u32x4*)(xb + row * DM + col0 + bj * 32); }
#pragma unroll
            for (int m = 0; m < 4; ++m) {
                const int rl = ai * HALF + wr * 64 + m * 16 + fr; float s = 0.f; u32x4 pk[2];
#pragma unroll
                for (int bj = 0; bj < 2; ++bj) { const u32x4 w = xv[m][bj];
                    f32x4 x0, x1;
                    x0[0] = __uint_as_float(w.x << 16); x0[1] = __uint_as_float(w.x & 0xffff0000u); x0[2] = __uint_as_float(w.y << 16); x0[3] = __uint_as_float(w.y & 0xffff0000u);
                    x1[0] = __uint_as_float(w.z << 16); x1[1] = __uint_as_float(w.z & 0xffff0000u); x1[2] = __uint_as_float(w.w << 16); x1[3] = __uint_as_float(w.w & 0xffff0000u);
                    const f32x4 o0 = x0 * rr[m] + acc[ai][bj][m][0], o1 = x1 * rr[m] + acc[ai][bj][m][1];
                    pk[bj] = pack8(o0, o1);
                    s += dot4(o0) + dot4(o1); }
                u32x4 px; px.x = (unsigned)__builtin_amdgcn_mov_dpp((int)pk[1].x, 0x128, 0xf, 0xf, true); px.y = (unsigned)__builtin_amdgcn_mov_dpp((int)pk[1].y, 0x128, 0xf, 0xf, true);
                px.z = (unsigned)__builtin_amdgcn_mov_dpp((int)pk[1].z, 0x128, 0xf, 0xf, true); px.w = (unsigned)__builtin_amdgcn_mov_dpp((int)pk[1].w, 0x128, 0xf, 0xf, true);
                bf16_t* r1p = x1b + (size_t)(rowbase + rl - (hi8 ? 8 : 0)) * DM + col0 + (hi8 ? 32 : 0);
                bf16_t* r2p = x1b + (size_t)(rowbase + rl + (hi8 ? 0 : 8)) * DM + col0 + (hi8 ? 0 : 32);
                *(u32x4*)(r1p) = hi8 ? px : pk[0]; *(u32x4*)(r2p) = hi8 ? pk[0] : px;
                s += __shfl_xor(s, 16); s += __shfl_xor(s, 32);
                if (fq == 0) xl[rl * 4 + wc] = s;
            }
        }
        asm volatile("s_waitcnt lgkmcnt(0)" ::: "memory"); __builtin_amdgcn_s_barrier(); asm volatile("" ::: "memory");
        const int t = (wr * 4 + wc) * 64 + lane;
        if (t < 256) { const f32x4 q = *(const LAS f32x4*)(xl + t * 4); ssq[(size_t)(rowbase + t) * 4 + u.pn] = (q[0] + q[1]) + (q[2] + q[3]); }
    }
};

__device__ __forceinline__ float dpp8(float x) { return __builtin_bit_cast(float, __builtin_amdgcn_mov_dpp(__builtin_bit_cast(int, x), 0x128, 0xf, 0xf, true)); }
struct EpiDown {
    static constexpr bool PERM = true;
    const bf16_t* __restrict__ x1b; float* __restrict__ out;
    __device__ __forceinline__ void pre(const Unit&, int, int) const {}
    __device__ __forceinline__ void operator()(const f32x4 (&acc)[2][2][4][2], const Unit& u, int wr, int wc, int fr, int fq, int lane) const {
        const int col0 = u.pn * BM + wc * 32 + 8 * fq; const bool hi8 = (fr & 8) != 0;
        u32x4 w[2][4][2];
#pragma unroll
        for (int ai = 0; ai < 2; ++ai)
#pragma unroll
            for (int m = 0; m < 4; ++m) { const size_t off = (size_t)(u.pm * BM + ai * HALF + wr * 64 + m * 16 + fr) * DM + col0;
#pragma unroll
                for (int bj = 0; bj < 2; ++bj) w[ai][m][bj] = *(const u32x4*)(x1b + off + bj * HALF); }
#pragma unroll
        for (int ai = 0; ai < 2; ++ai)
#pragma unroll
            for (int m = 0; m < 4; ++m) { const size_t off = (size_t)(u.pm * BM + ai * HALF + wr * 64 + m * 16 + fr) * DM + col0;
#pragma unroll
                for (int bj = 0; bj < 2; ++bj) { const u32x4 ww = w[ai][m][bj];
                    f32x4 r0, r1;
                    r0[0] = __uint_as_float(ww.x << 16); r0[1] = __uint_as_float(ww.x & 0xffff0000u); r0[2] = __uint_as_float(ww.y << 16); r0[3] = __uint_as_float(ww.y & 0xffff0000u);
                    r1[0] = __uint_as_float(ww.z << 16); r1[1] = __uint_as_float(ww.z & 0xffff0000u); r1[2] = __uint_as_float(ww.w << 16); r1[3] = __uint_as_float(ww.w & 0xffff0000u);
                    const f32x4 q0 = r0 + acc[ai][bj][m][0], q1 = r1 + acc[ai][bj][m][1];
                    f32x4 qx; qx[0] = dpp8(q1[0]); qx[1] = dpp8(q1[1]); qx[2] = dpp8(q1[2]); qx[3] = dpp8(q1[3]);
                    const long d1 = hi8 ? (long)(4 - 8 * DM) : 0, d2 = hi8 ? 0 : (long)(4 + 8 * DM);
                    *(f32x4*)(out + off + bj * HALF + d1) = hi8 ? qx : q0; *(f32x4*)(out + off + bj * HALF + d2) = hi8 ? q0 : qx; } }
    }
};

template <int CTRL> __device__ __forceinline__ float dppz(float x) { return __builtin_bit_cast(float, __builtin_amdgcn_update_dpp(0, __builtin_bit_cast(int, x), CTRL, 0xf, 0xf, true)); }
struct EpiFfn {
    static constexpr bool PERM = true;
    bf16_t* act; const float* ssq; const float* cw; const float* cb; LAS float* xl;
    __device__ __forceinline__ void pre(const Unit& u, int wid, int lane_) const {
        int lane = lane_; asm volatile("" : "+v"(lane));
        const int tok0 = 254 * u.pm - 1;
        if (wid >= 4) { int tok = tok0 + 64 * (wid - 4) + lane; tok = tok < 0 ? 0 : (tok > NTOK - 1 ? NTOK - 1 : tok);
            __builtin_amdgcn_global_load_lds((const unsigned*)(ssq + (size_t)tok * 4), (LAS unsigned*)((LAS char*)xl + 4096 + (wid - 4) * 1024), 16, 0, 0); }
        if (wid < 2) { const float* src = (wid == 0 ? (lane < 32 ? cw : cw + DFF) : (lane < 32 ? cw + 2 * DFF : cb)) + u.pn * 128 + (lane & 31) * 4;
            __builtin_amdgcn_global_load_lds((const unsigned*)src, (LAS unsigned*)((LAS char*)xl + 20480 + wid * 1024), 16, 0, 0); }
    }
    template <int AI, int M, bool MASK>
    __device__ __forceinline__ void conv_rows(const f32x4 (&acc)[2][2][4][2], const f32x4 (&w0)[2], const f32x4 (&w1)[2], const f32x4 (&w2)[2], const f32x4 (&bb)[2],
                                              int tok, int rl, int G, int xc, int fr, int ch0) const {
        const bool pcut = MASK && (tok & (SEQ - 1)) == 0, ncut = MASK && (tok & (SEQ - 1)) == SEQ - 1;
        f32x4 r0, r1;
#pragma unroll
        for (int n = 0; n < 2; ++n) { f32x4 res;
            f32x4 ex = (f32x4){0.f, 0.f, 0.f, 0.f};
            if (M == 0) { if (G > 0) ex = *(const LAS f32x4*)(xl + (2 * (G - 1) + 1) * 128 + xc + 4 * n); ex = fr == 0 ? ex : (f32x4){0.f, 0.f, 0.f, 0.f}; }
            if (M == 3) { if (G < 3) ex = *(const LAS f32x4*)(xl + (2 * (G + 1)) * 128 + xc + 4 * n); ex = fr == 15 ? ex : (f32x4){0.f, 0.f, 0.f, 0.f}; }
#pragma unroll
            for (int i = 0; i < 4; ++i) {
                const float own = acc[AI][0][M][n][i];
                float pr = dppz<0x111>(own);
                pr += (M > 0) ? dppz<0x10F>(acc[AI][0][M > 0 ? M - 1 : 0][n][i]) : ex[i];
                float nx = dppz<0x101>(own);
                nx += (M < 3) ? dppz<0x11F>(acc[AI][0][M < 3 ? M + 1 : 3][n][i]) : ex[i];
                if (MASK) { pr = pcut ? 0.f : pr; nx = ncut ? 0.f : nx; }
                const float uc = fmaf(w0[n][i], pr, fmaf(w1[n][i], own, fmaf(w2[n][i], nx, bb[n][i])));
                const float sg = uc * __builtin_amdgcn_rcpf(1.0f + __builtin_amdgcn_exp2f(-LOG2E * uc));
                res[i] = sg * acc[AI][1][M][n][i];
            }
            if (n == 0) r0 = res; else r1 = res; }
        if (rl != 0 && rl != 255 && tok < NTOK) *(u32x4*)(act + (size_t)tok * DFF + ch0) = pack8(r0, r1);
    }
    __device__ __forceinline__ void operator()(f32x4 (&acc)[2][2][4][2], const Unit& u, int wr, int wc, int fr, int fq, int lane) const {
        const int ch0 = u.pn * 128 + wc * 32 + 8 * fq;
        const int tok0 = 254 * u.pm - 1;
#pragma unroll
        for (int ai = 0; ai < 2; ++ai)
#pragma unroll
            for (int m = 0; m < 4; ++m) { const f32x4 qs = *(const LAS f32x4*)(xl + 1024 + (ai * HALF + wr * 64 + m * 16 + fr) * 4);
                const float s = (qs[0] + qs[1]) + (qs[2] + qs[3]); const float rs = __builtin_amdgcn_rsqf(s * (1.0f / DM) + EPS);
#pragma unroll
                for (int bj = 0; bj < 2; ++bj)
#pragma unroll
                    for (int n = 0; n < 2; ++n) acc[ai][bj][m][n] = acc[ai][bj][m][n] * rs; }
        const int xc = wc * 32 + 8 * fq;
#pragma unroll
        for (int ai = 0; ai < 2; ++ai) { const int G = 2 * ai + wr;
            if (fr == 0) { *(LAS f32x4*)(xl + (2 * G) * 128 + xc) = acc[ai][0][0][0]; *(LAS f32x4*)(xl + (2 * G) * 128 + xc + 4) = acc[ai][0][0][1]; }
            if (fr == 15) { *(LAS f32x4*)(xl + (2 * G + 1) * 128 + xc) = acc[ai][0][3][0]; *(LAS f32x4*)(xl + (2 * G + 1) * 128 + xc + 4) = acc[ai][0][3][1]; } }
        asm volatile("s_waitcnt lgkmcnt(0)" ::: "memory"); __builtin_amdgcn_s_barrier(); asm volatile("" ::: "memory"); __builtin_amdgcn_sched_barrier(0);
        f32x4 w0[2], w1[2], w2[2], bb[2];
#pragma unroll
        for (int n = 0; n < 2; ++n) { const LAS float* wl = xl + 5120 + xc + 4 * n; w0[n] = *(const LAS f32x4*)(wl); w1[n] = *(const LAS f32x4*)(wl + 128); w2[n] = *(const LAS f32x4*)(wl + 256); bb[n] = *(const LAS f32x4*)(wl + 384); }
#define FFN_ROWS(AI, M) do { const int tb_ = tok0 + AI * HALF + wr * 64 + M * 16; const int G_ = 2 * AI + wr; \
        conv_rows<AI, M, true>(acc, w0, w1, w2, bb, tb_ + fr, AI * HALF + wr * 64 + M * 16 + fr, G_, xc, fr, ch0); \
        if ((M) & 1) __builtin_amdgcn_sched_barrier(0); } while (0)
        FFN_ROWS(0, 0); FFN_ROWS(0, 1); FFN_ROWS(0, 2); FFN_ROWS(0, 3); FFN_ROWS(1, 0); FFN_ROWS(1, 1); FFN_ROWS(1, 2); FFN_ROWS(1, 3);
#undef FFN_ROWS
    }
};

template <class Epi, class Sched, bool ALIGN_EPI = true, bool SP2 = true>
__device__ __forceinline__ void gemm_phase(LAS unsigned char* lds, const Gemm g, const Sched& S, const Epi& E) {
    const int tid = threadIdx.x, wid = __builtin_amdgcn_readfirstlane(tid >> 6), lane = tid & 63, wr = wid >> 2, wc = wid & 3, fr = lane & 15, fq = lane >> 4;
    const int K = g.K, nt = K / BK;
    unsigned voffA[2], voffB[2];
#pragma unroll
    for (int i = 0; i < 2; ++i) { int R, C; stage_rc(tid * 16 + i * 8192, R, C); const int Rb = Epi::PERM ? ((R & ~31) + perm32(R & 31)) : R;
        voffA[i] = (unsigned)(R * K + C) * 2u; voffB[i] = (unsigned)(Rb * K + C) * 2u; }
    const size_t kstep = (size_t)(BK * 2);
    const size_t hstep = (size_t)HALF * K * 2;
    const size_t tstepB = 2 * hstep;
    const size_t tstepA = (size_t)g.arows * K * 2;
    const unsigned ldsw = (unsigned)wid * 1024u;
    const int aoff = lds_byte(wr * 64 + fr, fq * 8), boff = lds_byte(wc * 32 + fr, fq * 8);
#define PG8_SA(b, h) (((b) * 2 + (h)) * HTB)
#define PG8_SB(b, h) ((4 + (b) * 2 + (h)) * HTB)
#define PG8_STAGE(bufoff, gbase, voff) do { _Pragma("unroll") for (int _i = 0; _i < 2; ++_i) \
        __builtin_amdgcn_global_load_lds((const unsigned*)((const char*)(gbase) + (voff)[_i]), (LAS unsigned*)(lds + (bufoff) + ldsw + _i * 8192), 16, 0, 0); } while (0)
#define PG8_LDA(dst, b, h) do { _Pragma("unroll") for (int m = 0; m < 4; ++m) _Pragma("unroll") for (int k = 0; k < 2; ++k) dst[m][k] = *(const LAS bf16x8*)(lds + PG8_SA(b, h) + aoff + m * 2048 + k * 1024); } while (0)
#define PG8_LDB(dst, b, h) do { _Pragma("unroll") for (int n = 0; n < 2; ++n) _Pragma("unroll") for (int k = 0; k < 2; ++k) dst[n][k] = *(const LAS bf16x8*)(lds + PG8_SB(b, h) + boff + n * 2048 + k * 1024); } while (0)
#define PG8_MMA(ai, bj, At, Bt) do { __builtin_amdgcn_s_setprio(1); _Pragma("unroll") for (int m = 0; m < 4; ++m) _Pragma("unroll") for (int n = 0; n < 2; ++n) _Pragma("unroll") for (int k = 0; k < 2; ++k) \
        acc[ai][bj][m][n] = __builtin_amdgcn_mfma_f32_16x16x32_bf16(Bt[n][k], At[m][k], acc[ai][bj][m][n], 0, 0, 0); __builtin_amdgcn_s_setprio(0); } while (0)
#define PG8_WAIT_V(n) asm volatile("s_waitcnt vmcnt(" #n ")" ::: "memory")
#define PG8_WAIT_L(n) asm volatile("s_waitcnt lgkmcnt(" #n ")" ::: "memory")
#define PG8_BAR __builtin_amdgcn_s_barrier()
#define PG8_SCHED __builtin_amdgcn_sched_barrier(0)
    Unit cur, nxt; int ui = 0;
    if (!S.next(0, cur)) return;
    f32x4 acc[2][2][4][2];
#pragma unroll
    for (int a = 0; a < 2; ++a)
#pragma unroll
        for (int b = 0; b < 2; ++b)
#pragma unroll
            for (int m = 0; m < 4; ++m)
#pragma unroll
                for (int n = 0; n < 2; ++n) acc[a][b][m][n] = (f32x4){0.f, 0.f, 0.f, 0.f};
    bf16x8 At[4][2], B0[2][2], B1[2][2];
    const char* cA = (const char*)g.A + (size_t)cur.pm * tstepA; const char* cB = (const char*)g.Bt + (size_t)cur.pn * tstepB;
    if constexpr (SP2) {
        PG8_STAGE(PG8_SB(0, 0), cB, voffB); PG8_STAGE(PG8_SB(0, 1), cB + hstep, voffB); PG8_STAGE(PG8_SA(0, 0), cA, voffA); PG8_STAGE(PG8_SA(0, 1), cA + hstep, voffA);
        if (wr == 1) PG8_BAR;
        PG8_WAIT_V(2); PG8_BAR;
        PG8_STAGE(PG8_SB(1, 0), cB + kstep, voffB); PG8_STAGE(PG8_SA(1, 0), cA + kstep, voffA); PG8_STAGE(PG8_SB(1, 1), cB + hstep + kstep, voffB);
        PG8_WAIT_V(6); PG8_BAR;
    } else {
        PG8_STAGE(PG8_SB(0, 0), cB, voffB); PG8_STAGE(PG8_SA(0, 0), cA, voffA); PG8_STAGE(PG8_SB(0, 1), cB + hstep, voffB); PG8_STAGE(PG8_SA(0, 1), cA + hstep, voffA);
        if (wr == 1) PG8_BAR;
        PG8_WAIT_V(4); PG8_BAR;
        PG8_STAGE(PG8_SB(1, 0), cB + kstep, voffB); PG8_STAGE(PG8_SA(1, 0), cA + kstep, voffA); PG8_STAGE(PG8_SB(1, 1), cB + hstep + kstep, voffB);
        PG8_WAIT_V(6); PG8_BAR;
    }
    for (;;) {
        const bool has_next = S.next(ui + 1, nxt);
        const char* nA = has_next ? (const char*)g.A + (size_t)nxt.pm * tstepA : cA; const char* nB = has_next ? (const char*)g.Bt + (size_t)nxt.pn * tstepB : cB;
        for (int t = 0; t < nt; t += 2) {
            const bool last = (t == nt - 2);
            const char* a1 = cA + (size_t)(t + 1) * kstep;
            const char* a2 = last ? nA : cA + (size_t)(t + 2) * kstep; const char* b2 = last ? nB : cB + (size_t)(t + 2) * kstep;
            const char* a3 = a2 + kstep; const char* b3 = b2 + kstep;
            if (last) E.pre(cur, wid, lane);
            if constexpr (SP2) {
            PG8_LDB(B0, 0, 0); PG8_LDB(B1, 0, 1); PG8_SCHED; PG8_LDA(At, 0, 0); PG8_STAGE(PG8_SA(1, 1), a1 + hstep, voffA);
            PG8_WAIT_V(8); PG8_WAIT_L(0); PG8_BAR; PG8_MMA(0, 0, At, B0); PG8_MMA(0, 1, At, B1); PG8_BAR; PG8_SCHED;
            PG8_LDA(At, 0, 1); PG8_STAGE(PG8_SB(0, 0), b2, voffB); PG8_STAGE(PG8_SB(0, 1), b2 + hstep, voffB); PG8_STAGE(PG8_SA(0, 0), a2, voffA);
            PG8_WAIT_V(8); PG8_WAIT_L(0); PG8_BAR; PG8_MMA(1, 0, At, B0); PG8_MMA(1, 1, At, B1); PG8_BAR; PG8_SCHED;
            PG8_LDB(B0, 1, 0); PG8_LDB(B1, 1, 1); PG8_SCHED; PG8_LDA(At, 1, 0); PG8_STAGE(PG8_SA(0, 1), a2 + hstep, voffA);
            PG8_WAIT_V(8); PG8_WAIT_L(0); PG8_BAR; PG8_MMA(0, 0, At, B0); PG8_MMA(0, 1, At, B1); PG8_BAR; PG8_SCHED;
            PG8_LDA(At, 1, 1); PG8_STAGE(PG8_SB(1, 0), b3, voffB); PG8_STAGE(PG8_SB(1, 1), b3 + hstep, voffB); PG8_STAGE(PG8_SA(1, 0), a3, voffA);
            PG8_WAIT_V(8); PG8_WAIT_L(0); PG8_BAR; PG8_MMA(1, 0, At, B0); PG8_MMA(1, 1, At, B1); PG8_BAR; PG8_SCHED;
            } else {
            PG8_LDB(B0, 0, 0); PG8_SCHED; PG8_LDA(At, 0, 0); PG8_STAGE(PG8_SA(1, 1), a1 + hstep, voffA);
            PG8_WAIT_L(8); PG8_BAR; PG8_WAIT_L(0); PG8_MMA(0, 0, At, B0); PG8_BAR; PG8_SCHED;
            PG8_LDB(B1, 0, 1); PG8_STAGE(PG8_SB(0, 0), b2, voffB);
            PG8_BAR; PG8_WAIT_L(0); PG8_MMA(0, 1, At, B1); PG8_BAR;
            PG8_LDA(At, 0, 1); PG8_STAGE(PG8_SA(0, 0), a2, voffA);
            PG8_BAR; PG8_WAIT_L(0); PG8_MMA(1, 0, At, B0); PG8_BAR; PG8_SCHED;
            PG8_STAGE(PG8_SB(0, 1), b2 + hstep, voffB);
            PG8_WAIT_V(6); PG8_BAR; PG8_MMA(1, 1, At, B1); PG8_BAR;
            PG8_LDB(B0, 1, 0); PG8_SCHED; PG8_LDA(At, 1, 0); PG8_STAGE(PG8_SA(0, 1), a2 + hstep, voffA);
            PG8_WAIT_L(8); PG8_BAR; PG8_WAIT_L(0); PG8_MMA(0, 0, At, B0); PG8_BAR; PG8_SCHED;
            PG8_LDB(B1, 1, 1); PG8_STAGE(PG8_SB(1, 0), b3, voffB);
            PG8_BAR; PG8_WAIT_L(0); PG8_MMA(0, 1, At, B1); PG8_BAR;
            PG8_LDA(At, 1, 1); PG8_STAGE(PG8_SA(1, 0), a3, voffA);
            PG8_BAR; PG8_WAIT_L(0); PG8_MMA(1, 0, At, B0); PG8_BAR; PG8_SCHED;
            PG8_STAGE(PG8_SB(1, 1), b3 + hstep, voffB);
            PG8_WAIT_V(6); PG8_BAR; PG8_MMA(1, 1, At, B1); PG8_BAR;
            }
        }
        if constexpr (ALIGN_EPI) { if (wr == 0) PG8_BAR; }
        E(acc, cur, wr, wc, fr, fq, lane);
        if (!has_next) break;
#pragma unroll
        for (int a = 0; a < 2; ++a)
#pragma unroll
            for (int b = 0; b < 2; ++b)
#pragma unroll
                for (int m = 0; m < 4; ++m)
#pragma unroll
                    for (int n = 0; n < 2; ++n) acc[a][b][m][n] = (f32x4){0.f, 0.f, 0.f, 0.f};
        cur = nxt; cA = nA; cB = nB; ++ui;
        if constexpr (ALIGN_EPI) { if (wr == 1) PG8_BAR; }
    }
    PG8_WAIT_V(0);
    if constexpr (!ALIGN_EPI) { if (wr == 0) PG8_BAR; }
    PG8_BAR;
#undef PG8_SA
#undef PG8_SB
#undef PG8_STAGE
#undef PG8_LDA
#undef PG8_LDB
#undef PG8_MMA
#undef PG8_WAIT_V
#undef PG8_WAIT_L
#undef PG8_BAR
#undef PG8_SCHED
}
}

namespace att {
constexpr int PITCH = DIN;
#define SBAR() __builtin_amdgcn_sched_barrier(0)
#define KSW(row, colB) ((row) * 128 + ((colB) ^ ((((row) >> 1) & 7) << 4)))
__device__ __forceinline__ int crow(int r, int hi) { return (r & 3) + 8 * (r >> 2) + 4 * hi; }
__device__ __forceinline__ int rel_bucket(int rel) {
    const int n = rel < 0 ? -rel : rel; int v;
    if (n < 8) v = n; else { v = 2 + (31 - __clz(n * n)); v = v > 15 ? 15 : v; }
    return (rel > 0 ? 16 : 0) + v;
}
constexpr float THR = 5.0f;

__device__ __forceinline__ void partialSM(f32x16& p0, f32x16& p1, float off, float& m_reg, float& alpha) {
    float pmax = p0[0];
#pragma unroll
    for (int r = 1; r < 16; ++r) pmax = fmaxf(pmax, p0[r]);
#pragma unroll
    for (int r = 0; r < 16; ++r) pmax = fmaxf(pmax, p1[r]);
    { auto rr = __builtin_amdgcn_permlane32_swap(__float_as_uint(pmax), __float_as_uint(pmax), false, false);
      pmax = fmaxf(__uint_as_float(rr[0]), __uint_as_float(rr[1])); }
    pmax += off;
    if (__builtin_expect(__all(pmax - m_reg <= THR), 1)) { alpha = 1.f; }
    else { const float mn = fmaxf(m_reg, pmax); alpha = __builtin_amdgcn_exp2f(m_reg - mn); m_reg = mn; }
    const float sub = off - m_reg;
#pragma unroll
    for (int r = 0; r < 16; ++r) { p0[r] += sub; p1[r] += sub; }
#pragma unroll
    for (int r = 0; r < 16; ++r) p0[r] = __builtin_amdgcn_exp2f(p0[r]);
}
__device__ __forceinline__ void finishSM(f32x16& p0, f32x16& p1, float alpha, float& l_reg, bf16x8& pa0, bf16x8& pa1, bf16x8& pa2, bf16x8& pa3) {
#pragma unroll
    for (int r = 0; r < 16; ++r) p1[r] = __builtin_amdgcn_exp2f(p1[r]);
    float ps = 0;
#pragma unroll
    for (int r = 0; r < 16; ++r) ps += p0[r];
#pragma unroll
    for (int r = 0; r < 16; ++r) ps += p1[r];
    { auto rr = __builtin_amdgcn_permlane32_swap(__float_as_uint(ps), __float_as_uint(ps), false, false);
      ps = __uint_as_float(rr[0]) + __uint_as_float(rr[1]); }
    l_reg = l_reg * alpha + ps;
#define PK4(P, BASE, OUT) do { unsigned a0 = cvtpk(P[BASE + 0], P[BASE + 1]), a1 = cvtpk(P[BASE + 2], P[BASE + 3]);   \
    unsigned b0 = cvtpk(P[BASE + 4], P[BASE + 5]), b1 = cvtpk(P[BASE + 6], P[BASE + 7]);                              \
    auto r0 = __builtin_amdgcn_permlane32_swap(a0, b0, false, false); auto r1 = __builtin_amdgcn_permlane32_swap(a1, b1, false, false); \
    u32x4 w = {r0[0], r1[0], r0[1], r1[1]}; OUT = __builtin_bit_cast(bf16x8, w); } while (0)
    PK4(p0, 0, pa0); PK4(p0, 8, pa1); PK4(p1, 0, pa2); PK4(p1, 8, pa3);
#undef PK4
}
__device__ __forceinline__ void qkt64(f32x16& p0, f32x16& p1, const LAS char* Ks, const bf16x8* qr, int r32, int hi) {
#pragma unroll
    for (int d0 = 0; d0 < 4; ++d0) { const int cb = (d0 * 16 + hi * 8) * 2;
        const bf16x8 b0 = *(const LAS bf16x8*)(Ks + KSW(r32, cb));
        const bf16x8 b1 = *(const LAS bf16x8*)(Ks + KSW(r32, cb) + 4096);
        p0 = __builtin_amdgcn_mfma_f32_32x32x16_bf16(b0, qr[d0], p0, 0, 0, 0); p1 = __builtin_amdgcn_mfma_f32_32x32x16_bf16(b1, qr[d0], p1, 0, 0, 0); }
}
template <int NCB> __device__ __forceinline__ int v_st(int k, int c) { const int kk = (k & ~0xC) | ((k & 4) << 1) | ((k & 8) >> 1); return ((kk >> 3) * NCB + (c >> 5)) * 512 + ((kk & 7) * 32 + (c & 31)) * 2; }
__device__ __forceinline__ int v_rd_base(int lane) { return ((lane & 3) << 3) | (((lane >> 2) & 3) << 6) | (((lane >> 4) & 1) << 5) | (((lane >> 5) & 1) << 8); }
template <int NCB> constexpr int v_rd_off(int d0, int ks, int half) { return d0 * 512 + ks * (NCB * 1024) + half * (NCB * 512); }
template <int OFF> __device__ __forceinline__ s16x4 tr_read(int vb) { s16x4 r; asm volatile("ds_read_b64_tr_b16 %0, %1 offset:%2" : "=&v"(r) : "v"(vb), "i"(OFF) : "memory"); return r; }
template <int NCB, int D0> __device__ __forceinline__ void pv_one(f32x16& od, int vb, bf16x8 pa0, bf16x8 pa1, bf16x8 pa2, bf16x8 pa3) {
    const s16x4 l0 = tr_read<v_rd_off<NCB>(D0, 0, 0)>(vb), h0 = tr_read<v_rd_off<NCB>(D0, 0, 1)>(vb), l1 = tr_read<v_rd_off<NCB>(D0, 1, 0)>(vb), h1 = tr_read<v_rd_off<NCB>(D0, 1, 1)>(vb);
    const s16x4 l2 = tr_read<v_rd_off<NCB>(D0, 2, 0)>(vb), h2 = tr_read<v_rd_off<NCB>(D0, 2, 1)>(vb), l3 = tr_read<v_rd_off<NCB>(D0, 3, 0)>(vb), h3 = tr_read<v_rd_off<NCB>(D0, 3, 1)>(vb);
    asm volatile("s_waitcnt lgkmcnt(0)" ::: "memory"); SBAR();
#define PK(L, H) (bf16x8){L[0], L[1], L[2], L[3], H[0], H[1], H[2], H[3]}
    od = __builtin_amdgcn_mfma_f32_32x32x16_bf16(pa0, PK(l0, h0), od, 0, 0, 0);
    od = __builtin_amdgcn_mfma_f32_32x32x16_bf16(pa1, PK(l1, h1), od, 0, 0, 0);
    od = __builtin_amdgcn_mfma_f32_32x32x16_bf16(pa2, PK(l2, h2), od, 0, 0, 0);
    od = __builtin_amdgcn_mfma_f32_32x32x16_bf16(pa3, PK(l3, h3), od, 0, 0, 0);
#undef PK
}

constexpr int D_V = 0, D_K = 49152, D_WS = 81920, D_TB = 83968, D_ST = 86016, D_END = D_ST + 65536;
constexpr int NT = SEQ / 64;

typedef short v4i16_t __attribute__((ext_vector_type(4)));
__device__ __forceinline__ s16x4 vtr(const LAS char* p) { return __builtin_bit_cast(s16x4, __builtin_amdgcn_ds_read_tr16_b64_v4i16((LAS v4i16_t*)p)); }
#define PIN(x) asm volatile("" : "+v"(x))
#define MX3(a, b, c) __builtin_fmaxf(__builtin_fmaxf((a), (b)), (c))
#define EX(v) __builtin_amdgcn_exp2f(v)
#define MFMA32(a, b, c) __builtin_amdgcn_mfma_f32_32x32x16_bf16((a), (b), (c), 0, 0, 0)
constexpr float THRL = 6.0f;
__device__ __forceinline__ float rowmax32(const f32x16& C0, const f32x16& C1) {
    float a = MX3(C0[0], C0[1], C1[0]), b = MX3(C0[2], C0[3], C1[1]); a = MX3(a, C1[2], C1[3]);
#pragma unroll
    for (int r = 4; r < 16; r += 4) { a = MX3(a, C0[r], C0[r + 1]); b = MX3(b, C0[r + 2], C0[r + 3]); a = MX3(a, C1[r], C1[r + 1]); b = MX3(b, C1[r + 2], C1[r + 3]); }
    float rm = __builtin_fmaxf(a, b);
    auto rr = __builtin_amdgcn_permlane32_swap(__float_as_uint(rm), __float_as_uint(rm), false, false);
    return __builtin_fmaxf(__uint_as_float(rr[0]), __uint_as_float(rr[1]));
}
__device__ __forceinline__ void diff_pass(f32x16 (&o)[4], float& l_out, const bf16_t* Qw, const bf16_t* __restrict__ Kh, const bf16_t* __restrict__ Vh,
                                          LAS char* lds, int qa, float cL, float cR) {
    const int tid = threadIdx.x, wid = __builtin_amdgcn_readfirstlane(tid >> 6), lane = tid & 63, r32 = lane & 31, hi = lane >> 5;
    LAS char* V_lds = lds + D_V; LAS char* K_lds = lds + D_K;
    LAS float* wsf = (LAS float*)(lds + D_WS) + wid * 64 + 32;
    const LAS float* tb = (const LAS float*)(lds + D_TB);
#pragma unroll
    for (int d = 0; d < 4; ++d) o[d] = f32x16{};
    bf16x8 qr[4];
    asm volatile("global_load_dwordx4 %0, %4, off\n\tglobal_load_dwordx4 %1, %4, off offset:32\n\tglobal_load_dwordx4 %2, %4, off offset:64\n\tglobal_load_dwordx4 %3, %4, off offset:96"
                 : "=&v"(qr[0]), "=&v"(qr[1]), "=&v"(qr[2]), "=&v"(qr[3]) : "v"(Qw) : "memory");
    const bf16_t* ksrc; const bf16_t* vsrc0;
    { const int row = wid * 8 + (lane >> 3), pos = lane & 7;
      ksrc = Kh + (long)row * PITCH + ((pos ^ ((row >> 1) & 7)) * 8);
      vsrc0 = Vh + (long)row * PITCH + ((pos ^ (((row >> 1) & 1) << 2)) * 8); }
    const LAS char* kq[4];
    { const int sw = (r32 >> 1) & 7;
#pragma unroll
      for (int d0 = 0; d0 < 4; ++d0) kq[d0] = K_lds + r32 * 128 + (((2 * d0 + hi) ^ sw) << 4); }
    const LAS char* vpe; const LAS char* vpo;
    { const int q = (lane & 15) >> 2, p = lane & 3, g = (lane >> 4) & 1, sw = (q >> 1) & 1;
      vpe = V_lds + (4 * hi + q) * 128 + sw * 64 + g * 32 + p * 8; vpo = V_lds + (4 * hi + q) * 128 + (sw ^ 1) * 64 + g * 32 + p * 8; }
#define DMA_K(j, ko) __builtin_amdgcn_global_load_lds((const unsigned*)(ksrc + (long)(j) * 64 * PITCH), (LAS unsigned*)(K_lds + (ko) + wid * 1024), 16, 0, 0)
#define DMA_V(j, vo) do { __builtin_amdgcn_global_load_lds((const unsigned*)(vsrc0 + (long)(j) * 64 * PITCH), (LAS unsigned*)(V_lds + (vo) + wid * 1024), 16, 0, 0); \
    __builtin_amdgcn_global_load_lds((const unsigned*)(vsrc0 + 64 + (long)(j) * 64 * PITCH), (LAS unsigned*)(V_lds + (vo) + 8192 + wid * 1024), 16, 0, 0); } while (0)
#define WAIT_BAR(N) do { asm volatile("s_waitcnt vmcnt(" #N ") lgkmcnt(0)" ::: "memory"); __builtin_amdgcn_s_barrier(); asm volatile("" ::: "memory"); } while (0)
    float mhat, l_reg = 0.f; bool resc = false;
    f32x16 pA0, pA1, pB0, pB1;
    bf16x8 kf[4]; s16x4 vlo[6], vhi[6]; u32x4 pw0, pw1, pw2, pw3;
#define KRD(i, KS) do { kf[(i) & 3] = *(const LAS bf16x8*)(kq[(i) >> 1] + (KS) + ((i) & 1) * 4096); } while (0)
    asm volatile("s_waitcnt lgkmcnt(0)" ::: "memory"); __builtin_amdgcn_s_barrier(); asm volatile("" ::: "memory");
    DMA_K(0, 0); DMA_K(1, 8192); DMA_V(0, 0); DMA_K(2, 16384); DMA_K(3, 24576); DMA_V(1, 16384);
    asm volatile("s_waitcnt vmcnt(7) lgkmcnt(0)" : "+v"(qr[0]), "+v"(qr[1]), "+v"(qr[2]), "+v"(qr[3]) :: "memory");
    __builtin_amdgcn_s_barrier(); asm volatile("" ::: "memory");
    {
        float off0 = 0.f; const int d_ = -qa;
        if (d_ <= -154) { pA0 = f32x16{}; pA1 = f32x16{}; off0 = cL; }
        else { const LAS float* t_ = tb + (d_ + 256 + 4 * hi - r32);
#pragma unroll
            for (int r = 0; r < 16; ++r) { pA0[r] = t_[(r & 3) + 8 * (r >> 2)]; pA1[r] = t_[32 + (r & 3) + 8 * (r >> 2)]; } }
#pragma unroll
        for (int d0 = 0; d0 < 4; ++d0) { const bf16x8 k0_ = *(const LAS bf16x8*)(kq[d0]), k1_ = *(const LAS bf16x8*)(kq[d0] + 4096);
            pA0 = MFMA32(k0_, qr[d0], pA0); pA1 = MFMA32(k1_, qr[d0], pA1); }
        const float rm = rowmax32(pA0, pA1);
        mhat = rm + off0;
#pragma unroll
        for (int r = 0; r < 16; ++r) { pA0[r] = EX(pA0[r] - rm); pA1[r] = EX(pA1[r] - rm); }
    }
    WAIT_BAR(3);
    KRD(0, 8192); KRD(1, 8192); KRD(2, 8192); KRD(3, 8192);
#define PKW(P, B) cvtpk(P[B], P[(B) + 1])
#define PAF(k) __builtin_bit_cast(bf16x8, pw##k)
#define VFR(i) (bf16x8){vlo[(i) % 6][0], vlo[(i) % 6][1], vlo[(i) % 6][2], vlo[(i) % 6][3], vhi[(i) % 6][0], vhi[(i) % 6][1], vhi[(i) % 6][2], vhi[(i) % 6][3]}
#define VRD(i, VS) do { const LAS char* vq_ = ((((i) & 3) & 1) ? vpo : vpe) + (VS) + (((i) & 3) >> 1) * 8192 + ((i) >> 2) * 2048; vlo[(i) % 6] = vtr(vq_); vhi[(i) % 6] = vtr(vq_ + 1024); } while (0)
#define GAPA(g, CC, QI, KB, A0, A1, A2, A3, W0, W1, PW) do { CC = MFMA32(kf[(g) & 3], qr[QI], CC); if ((g) + 4 < 8) KRD((g) + 4, KB); sacc += A0; sacc += A1; sacc += A2; sacc += A3; PIN(sacc); W0; W1; PIN(PW); SBAR(); } while (0)
#define GAPB(i, X, B, VB, KN, PRE) do { o[(i) & 3] = MFMA32(PAF_SEL(i), VFR(i), o[(i) & 3]); X[B] = EX(X[B]); X[(B) + 1] = EX(X[(B) + 1]); PIN(X); if ((i) + 5 < 16) VRD((i) + 5, VB); \
    if ((PRE) && (i) >= 8 && (i) < 12) KRD((i) - 8, KN); SBAR(); } while (0)
#define PAF_SEL(i) (((i) >> 2) == 0 ? PAF(0) : ((i) >> 2) == 1 ? PAF(1) : ((i) >> 2) == 2 ? PAF(2) : PAF(3))
#define STEP(C0, C1, P0, P1, t, KB, VB, KN, PRE) do { SBAR(); \
    { const int d_ = (t) * 64 - qa; \
      if (d_ > -154 && d_ < 122) { const LAS float* t_ = tb + (d_ + 256 + 4 * hi - r32); \
        _Pragma("unroll") for (int r = 0; r < 16; ++r) { C0[r] = t_[(r & 3) + 8 * (r >> 2)] - mhat; C1[r] = t_[32 + (r & 3) + 8 * (r >> 2)] - mhat; } } \
      else { const float cs_ = (d_ < 0 ? cL : cR) - mhat; _Pragma("unroll") for (int r = 0; r < 16; ++r) { C0[r] = cs_; C1[r] = cs_; } } } \
    PIN(C0); PIN(C1); SBAR(); \
    float sacc = (P0[0] + P0[1]); \
    GAPA(0, C0, 0, KB, P0[2],  P0[3],  P0[4],  P0[5],  pw0[0] = PKW(P0, 0),  pw0[1] = PKW(P0, 2),  pw0); \
    GAPA(1, C1, 0, KB, P0[6],  P0[7],  P0[8],  P0[9],  pw0[2] = PKW(P0, 4),  pw0[3] = PKW(P0, 6),  pw0); \
    GAPA(2, C0, 1, KB, P0[10], P0[11], P0[12], P0[13], pw1[0] = PKW(P0, 8),  pw1[1] = PKW(P0, 10), pw1); \
    GAPA(3, C1, 1, KB, P0[14], P0[15], P1[0],  P1[1],  pw1[2] = PKW(P0, 12), pw1[3] = PKW(P0, 14), pw1); \
    GAPA(4, C0, 2, KB, P1[2],  P1[3],  P1[4],  P1[5],  pw2[0] = PKW(P1, 0),  pw2[1] = PKW(P1, 2),  pw2); \
    GAPA(5, C1, 2, KB, P1[6],  P1[7],  P1[8],  P1[9],  pw2[2] = PKW(P1, 4),  pw2[3] = PKW(P1, 6),  pw2); \
    GAPA(6, C0, 3, KB, P1[10], P1[11], P1[12], P1[13], pw3[0] = PKW(P1, 8),  pw3[1] = PKW(P1, 10), pw3); \
    GAPA(7, C1, 3, KB, P1[14], P1[15], 0.f,    0.f,    pw3[2] = PKW(P1, 12), pw3[3] = PKW(P1, 14), pw3); \
    l_reg += sacc; \
    VRD(0, VB); VRD(1, VB); VRD(2, VB); VRD(3, VB); VRD(4, VB); \
    { const float rm = rowmax32(C0, C1); resc = false; \
      if (__builtin_expect(__any(rm > THRL), 0)) { const float dl = __builtin_fmaxf(rm, 0.f); mhat += dl; \
        _Pragma("unroll") for (int r = 0; r < 16; ++r) { C0[r] -= dl; C1[r] -= dl; } \
        const float f = EX(-dl); l_reg *= f; if (hi == 0) wsf[r32] = f; resc = true; } } \
    SBAR(); \
    GAPB(0, C0, 0, VB, KN, PRE);  GAPB(1, C0, 2, VB, KN, PRE);  GAPB(2, C0, 4, VB, KN, PRE);   GAPB(3, C0, 6, VB, KN, PRE); \
    GAPB(4, C0, 8, VB, KN, PRE);  GAPB(5, C0, 10, VB, KN, PRE); GAPB(6, C0, 12, VB, KN, PRE);  GAPB(7, C0, 14, VB, KN, PRE); \
    GAPB(8, C1, 0, VB, KN, PRE);  GAPB(9, C1, 2, VB, KN, PRE);  GAPB(10, C1, 4, VB, KN, PRE);  GAPB(11, C1, 6, VB, KN, PRE); \
    GAPB(12, C1, 8, VB, KN, PRE); GAPB(13, C1, 10, VB, KN, PRE); GAPB(14, C1, 12, VB, KN, PRE); GAPB(15, C1, 14, VB, KN, PRE); \
    } while (0)
#define RESC() do { if (resc) { asm volatile("s_waitcnt lgkmcnt(0)" ::: "memory"); \
    _Pragma("unroll") for (int d = 0; d < 4; ++d) _Pragma("unroll") for (int r = 0; r < 16; ++r) o[d][r] *= wsf[crow(r, hi)]; } } while (0)
    int ks_cur = 8192, ks_n1 = 16384, ks_n3 = 0;
    int vs_prev = 0, vs_next = 32768;
#define ROT() do { ks_cur = (ks_cur + 8192) & 24576; ks_n1 = (ks_n1 + 8192) & 24576; ks_n3 = (ks_n3 + 8192) & 24576; vs_prev = vs_prev == 32768 ? 0 : vs_prev + 16384; vs_next = vs_next == 32768 ? 0 : vs_next + 16384; } while (0)
#define STEPX(C0, C1, P0, P1, t, PRE) STEP(C0, C1, P0, P1, t, ks_cur, vs_prev, ks_n1, PRE)
#pragma unroll 1
    for (int t = 1; t + 4 < NT; t += 2) {
        DMA_K(t + 3, ks_n3); DMA_V(t + 1, vs_next);
        STEPX(pB0, pB1, pA0, pA1, t, true);
        WAIT_BAR(3); RESC(); ROT();
        DMA_K(t + 4, ks_n3); DMA_V(t + 2, vs_next);
        STEPX(pA0, pA1, pB0, pB1, t + 1, true);
        WAIT_BAR(3); RESC(); ROT();
    }
    DMA_V(NT - 2, vs_next);
    STEPX(pB0, pB1, pA0, pA1, NT - 3, true);
    WAIT_BAR(2); RESC(); ROT();
    DMA_V(NT - 1, vs_next);
    STEPX(pA0, pA1, pB0, pB1, NT - 2, true);
    WAIT_BAR(2); RESC(); ROT();
    STEPX(pB0, pB1, pA0, pA1, NT - 1, false);
    WAIT_BAR(0); RESC(); ROT();
    { float sacc = 0.f;
#pragma unroll
      for (int r = 0; r < 16; ++r) sacc += pB0[r];
#pragma unroll
      for (int r = 0; r < 16; ++r) sacc += pB1[r];
      l_reg += sacc;
      pw0 = (u32x4){PKW(pB0, 0), PKW(pB0, 2), PKW(pB0, 4), PKW(pB0, 6)}; pw1 = (u32x4){PKW(pB0, 8), PKW(pB0, 10), PKW(pB0, 12), PKW(pB0, 14)};
      pw2 = (u32x4){PKW(pB1, 0), PKW(pB1, 2), PKW(pB1, 4), PKW(pB1, 6)}; pw3 = (u32x4){PKW(pB1, 8), PKW(pB1, 10), PKW(pB1, 12), PKW(pB1, 14)};
      SBAR();
#define DRAIN(i) do { VRD(i, vs_prev); o[(i) & 3] = MFMA32(PAF_SEL(i), VFR(i), o[(i) & 3]); } while (0)
      DRAIN(0); DRAIN(1); DRAIN(2); DRAIN(3); DRAIN(4); DRAIN(5); DRAIN(6); DRAIN(7); DRAIN(8); DRAIN(9); DRAIN(10); DRAIN(11); DRAIN(12); DRAIN(13); DRAIN(14); DRAIN(15);
#undef DRAIN
    }
    { auto rr = __builtin_amdgcn_permlane32_swap(__float_as_uint(l_reg), __float_as_uint(l_reg), false, false); l_out = __uint_as_float(rr[0]) + __uint_as_float(rr[1]); }
#undef DMA_K
#undef DMA_V
#undef WAIT_BAR
#undef ROT
#undef KRD
#undef PKW
#undef PAF
#undef VFR
#undef VRD
#undef GAPA
#undef GAPB
#undef PAF_SEL
#undef STEP
#undef STEPX
#undef RESC
}

__device__ __forceinline__ void diff_unit(int b, int h, int qb, const bf16_t* P, bf16_t* O, LAS char* lds, float lam, const float* relb) {
    const int tid = threadIdx.x, wid = __builtin_amdgcn_readfirstlane(tid >> 6), lane = tid & 63, r32 = lane & 31, hi = lane >> 5;
    const long rowbase = (long)b * SEQ; const int q0 = qb * 256, qa = q0 + wid * 32;
    LAS float* tb = (LAS float*)(lds + D_TB);
    LAS float* li_l = (LAS float*)(lds + D_WS) + wid * 64;
    tb[tid] = relb[rel_bucket(tid - 256) * NBH + h] * LOG2E;
    const float cL = relb[15 * NBH + h] * LOG2E, cR = relb[31 * NBH + h] * LOG2E;
    const bf16_t* Qrow = P + (rowbase + qa + r32) * PITCH + C_DQ + h * 128 + hi * 8;
    const bf16_t* Kh = P + rowbase * PITCH + C_DK + h * 128;
    const bf16_t* Vh = P + rowbase * PITCH + C_DV + h * 128;
    LAS u32x4* stash = (LAS u32x4*)(lds + D_ST + wid * 8192);
    f32x16 o[4]; float l_reg;
#pragma unroll 1
    for (int pass = 0; pass < 2; ++pass) {
        const int mo = pass == 0 ? 64 : 0;
        diff_pass(o, l_reg, Qrow + mo, Kh + mo, Vh, lds, qa, cL, cR);
        int ln = lane; asm volatile("" : "+v"(ln));
        const int r32e = ln & 31, hie = ln >> 5;
        if (hie == 0) li_l[r32e] = l_reg; asm volatile("s_waitcnt lgkmcnt(0)" ::: "memory");
        if (pass == 0) {
            float rli[16];
#pragma unroll
            for (int r = 0; r < 16; ++r) rli[r] = -lam * __builtin_amdgcn_rcpf(li_l[crow(r, hie)]);
#pragma unroll
            for (int d0 = 0; d0 < 4; ++d0) {
                u32x4 w0, w1;
                w0.x = cvtpk(o[d0][0] * rli[0], o[d0][1] * rli[1]); w0.y = cvtpk(o[d0][2] * rli[2], o[d0][3] * rli[3]); w0.z = cvtpk(o[d0][4] * rli[4], o[d0][5] * rli[5]); w0.w = cvtpk(o[d0][6] * rli[6], o[d0][7] * rli[7]);
                w1.x = cvtpk(o[d0][8] * rli[8], o[d0][9] * rli[9]); w1.y = cvtpk(o[d0][10] * rli[10], o[d0][11] * rli[11]); w1.z = cvtpk(o[d0][12] * rli[12], o[d0][13] * rli[13]); w1.w = cvtpk(o[d0][14] * rli[14], o[d0][15] * rli[15]);
                stash[(2 * d0) * 64 + ln] = w0; stash[(2 * d0 + 1) * 64 + ln] = w1;
            }
        } else {
            float rli[16], ssq[16];
#pragma unroll
            for (int r = 0; r < 16; ++r) { rli[r] = __builtin_amdgcn_rcpf(li_l[crow(r, hie)]); ssq[r] = 0.f; }
#pragma unroll
            for (int d0 = 0; d0 < 4; ++d0) {
                const u32x4 w0 = stash[(2 * d0) * 64 + ln], w1 = stash[(2 * d0 + 1) * 64 + ln];
                const unsigned ww[8] = {w0.x, w0.y, w0.z, w0.w, w1.x, w1.y, w1.z, w1.w};
#pragma unroll
                for (int r = 0; r < 16; ++r) { const float c = __uint_as_float((r & 1) ? (ww[r >> 1] & 0xffff0000u) : (ww[r >> 1] << 16));
                    const float x = fmaf(o[d0][r], rli[r], c); o[d0][r] = x; ssq[r] = fmaf(x, x, ssq[r]); }
            }
            asm volatile("s_waitcnt lgkmcnt(0)" ::: "memory");
#pragma unroll
            for (int r = 0; r < 16; ++r) { float s = ssq[r];
                s += __shfl_xor(s, 1); s += __shfl_xor(s, 2); s += __shfl_xor(s, 4); s += __shfl_xor(s, 8); s += __shfl_xor(s, 16);
                ssq[r] = __builtin_amdgcn_rsqf(s * (1.0f / 128.0f) + EPS); }
            LAS bf16_t* stg = (LAS bf16_t*)(lds + D_ST + wid * 8192);
#pragma unroll
            for (int r = 0; r < 16; ++r) { const int orow = crow(r, hie);
#pragma unroll
                for (int d0 = 0; d0 < 4; ++d0) stg[orow * 128 + d0 * 32 + r32e] = (bf16_t)(cvtpk(o[d0][r] * ssq[r], 0.f) & 0xffffu); }
            asm volatile("s_waitcnt lgkmcnt(0)" ::: "memory");
            bf16_t* Ow = O + (rowbase + qa + (ln >> 4)) * DM + h * 128 + (ln & 15) * 8;
            const LAS bf16_t* sl = stg + (ln >> 4) * 128 + (ln & 15) * 8;
#pragma unroll
            for (int i = 0; i < 8; ++i) { const u32x4 v = *(const LAS u32x4*)(sl + i * 512); *(u32x4*)(Ow + (long)i * 4 * DM) = v; }
        }
    }
    asm volatile("s_waitcnt lgkmcnt(0)" ::: "memory"); __syncthreads();
}

constexpr int W_K = 0, W_V = 49152, W_TB = 98304, W_WS = 106496, W_OST = 108544, W_END = W_OST + 32768;
__device__ __forceinline__ void win_unit(int b, int kvh, int qb, const bf16_t* P, bf16_t* O, LAS char* lds, const float* relb, const float* sink) {
    const int tid = threadIdx.x, wid = __builtin_amdgcn_readfirstlane(tid >> 6), lane = tid & 63, r32 = lane & 31, hi = lane >> 5;
    const long rowbase = (long)b * SEQ; const int q0 = qb * 128, kbase = q0 - 128;
    LAS float* tbw = (LAS float*)(lds + W_TB);
#pragma unroll
    for (int e = 0; e < 4; ++e) { const int idx = tid + e * 512, g = idx >> 9, rel = (idx & 511) - 256;
        tbw[idx] = (rel >= -128 && rel <= 128) ? (relb[rel_bucket(rel) * NBH + 4 + 4 * kvh + g] - sink[4 * kvh + g]) * LOG2E : -1e30f; }
    { int tl = tid; asm volatile("" : "+v"(tl));
      const int kr = tl >> 3, kc = (tl & 7) * 8, kst = KSW(kr, kc * 2), vst = v_st<2>(kr, kc);
      const bf16_t* Kh = P + rowbase * PITCH + C_WK + kvh * 64; const bf16_t* Vh = P + rowbase * PITCH + C_WV + kvh * 64;
      bf16x8 kreg[6], vreg[6];
#pragma unroll
      for (int t = 0; t < 6; ++t) { const int k0 = kbase + 64 * t; if (k0 >= 0 && k0 < SEQ) { kreg[t] = *(const bf16x8*)(&Kh[(long)(k0 + kr) * PITCH + kc]); vreg[t] = *(const bf16x8*)(&Vh[(long)(k0 + kr) * PITCH + kc]); } }
#pragma unroll
      for (int t = 0; t < 6; ++t) { const int k0 = kbase + 64 * t; if (k0 >= 0 && k0 < SEQ) { *(LAS bf16x8*)(lds + W_K + t * 8192 + kst) = kreg[t]; *(LAS bf16x8*)(lds + W_V + t * 8192 + vst) = vreg[t]; } }
    }
    __syncthreads();
    const int g = wid >> 1, hq = 4 * kvh + g;
    LAS float* li_l = (LAS float*)(lds + W_WS) + wid * 64;
    const LAS float* tbg = tbw + g * 512;
    const int vbw = (int)(uintptr_t)(lds + W_V) + v_rd_base(lane);
#pragma unroll 1
    for (int jb = 0; jb < 2; ++jb) {
        const int ql = 64 * (wid & 1) + 32 * jb;
        const bf16_t* Qw = P + (rowbase + q0 + ql + r32) * PITCH + C_WQ + hq * 64 + hi * 8;
        bf16x8 qr[4];
#pragma unroll
        for (int d0 = 0; d0 < 4; ++d0) qr[d0] = *(const bf16x8*)(Qw + d0 * 16);
        float l_reg = 0.f;
        f32x16 o[2]; o[0] = f32x16{}; o[1] = f32x16{};
        const int t_lo = ql >> 6;
#pragma unroll 1
        for (int t = t_lo; t < t_lo + 5; ++t) {
            const int k0 = kbase + 64 * t; if (k0 < 0 || k0 >= SEQ) continue;
            const int d_ = 64 * t - 128 - ql;
            const LAS float* t_ = tbg + (d_ + 256 + 4 * hi - r32);
            f32x16 p0, p1;
#pragma unroll
            for (int r = 0; r < 16; ++r) { p0[r] = t_[(r & 3) + 8 * (r >> 2)]; p1[r] = t_[32 + (r & 3) + 8 * (r >> 2)]; }
            qkt64(p0, p1, lds + W_K + t * 8192, qr, r32, hi);
#pragma unroll
            for (int r = 0; r < 16; ++r) { p0[r] = __builtin_amdgcn_exp2f(p0[r]); p1[r] = __builtin_amdgcn_exp2f(p1[r]); }
            bf16x8 pa0, pa1, pa2, pa3;
            {
                float ps = 0;
#pragma unroll
                for (int r = 0; r < 16; ++r) ps += p0[r];
#pragma unroll
                for (int r = 0; r < 16; ++r) ps += p1[r];
                l_reg += ps;
#define PK4(Pv, BASE, OUT) do { unsigned a0 = cvtpk(Pv[BASE + 0], Pv[BASE + 1]), a1 = cvtpk(Pv[BASE + 2], Pv[BASE + 3]);   \
    unsigned b0 = cvtpk(Pv[BASE + 4], Pv[BASE + 5]), b1 = cvtpk(Pv[BASE + 6], Pv[BASE + 7]);                              \
    auto r0 = __builtin_amdgcn_permlane32_swap(a0, b0, false, false); auto r1 = __builtin_amdgcn_permlane32_swap(a1, b1, false, false); \
    u32x4 w = {r0[0], r1[0], r0[1], r1[1]}; OUT = __builtin_bit_cast(bf16x8, w); } while (0)
                PK4(p0, 0, pa0); PK4(p0, 8, pa1); PK4(p1, 0, pa2); PK4(p1, 8, pa3);
#undef PK4
            }
            const int vb = vbw + t * 8192;
            pv_one<2, 0>(o[0], vb, pa0, pa1, pa2, pa3); pv_one<2, 1>(o[1], vb, pa0, pa1, pa2, pa3);
        }
        { auto rr = __builtin_amdgcn_permlane32_swap(__float_as_uint(l_reg), __float_as_uint(l_reg), false, false); l_reg = 1.0f + __uint_as_float(rr[0]) + __uint_as_float(rr[1]); }
        int ln = lane; asm volatile("" : "+v"(ln));
        const int r32e = ln & 31, hie = ln >> 5;
        if (hie == 0) li_l[r32e] = l_reg; asm volatile("s_waitcnt lgkmcnt(0)" ::: "memory");
        float rli[16];
#pragma unroll
        for (int r = 0; r < 16; ++r) rli[r] = __builtin_amdgcn_rcpf(li_l[crow(r, hie)]);
        LAS bf16_t* stg = (LAS bf16_t*)(lds + W_OST + wid * 4096);
#pragma unroll
        for (int r = 0; r < 16; ++r) { const int orow = crow(r, hie);
#pragma unroll
            for (int d0 = 0; d0 < 2; ++d0) stg[orow * 64 + d0 * 32 + r32e] = (bf16_t)(cvtpk(o[d0][r] * rli[r], 0.f) & 0xffffu); }
        asm volatile("s_waitcnt lgkmcnt(0)" ::: "memory");
        bf16_t* Ow = O + (rowbase + q0 + ql + (ln >> 3)) * DM + 512 + hq * 64 + (ln & 7) * 8;
        const LAS bf16_t* sl = stg + (ln >> 3) * 64 + (ln & 7) * 8;
#pragma unroll
        for (int i = 0; i < 4; ++i) { const u32x4 v = *(const LAS u32x4*)(sl + i * 512); *(u32x4*)(Ow + (long)i * 8 * DM) = v; }
        asm volatile("s_waitcnt lgkmcnt(0)" ::: "memory");
    }
    asm volatile("s_waitcnt lgkmcnt(0)" ::: "memory"); __syncthreads();
}
#undef SBAR
#undef KSW
}

constexpr size_t MiB = 1u << 20;
constexpr size_t WS_CTL = 0, CTL_ZERO_BYTES = 64 * 1024;
constexpr size_t WS_W1 = 1 * MiB;
constexpr size_t WS_W2 = WS_W1 + (size_t)DIN * DM * 2;
constexpr size_t WS_W3 = WS_W2 + (size_t)DM * DM * 2;
constexpr size_t WS_W4 = WS_W3 + (size_t)2 * DFF * DM * 2;
constexpr size_t WS_SSQ = 24 * MiB;
constexpr size_t WS_XB = 28 * MiB;
constexpr size_t WS_RSTD1 = 27 * MiB;
constexpr size_t WS_OB = 340 * MiB;
constexpr size_t WS_PROJ = 124 * MiB;
constexpr size_t WS_X1B = 125 * MiB;
constexpr size_t WS_ACT = 222 * MiB;
constexpr size_t WS_END = WS_ACT + (size_t)NTOK * DFF * 2;
static_assert(WS_W4 + (size_t)DM * DFF * 2 <= WS_SSQ && WS_SSQ + (size_t)NTOK * 64 <= WS_XB && WS_XB + (size_t)NTOK * DM * 2 <= WS_PROJ, "d_ws map");
static_assert(WS_X1B + (size_t)(NTOK + 256) * DM * 2 <= WS_ACT && WS_PROJ + (size_t)NTOK * DIN * 2 <= WS_OB && WS_OB + (size_t)NTOK * DM * 2 <= WS_END && WS_SSQ + (size_t)NTOK * 16 <= WS_RSTD1 && WS_RSTD1 + (size_t)NTOK * 4 <= WS_XB, "d_ws map");
constexpr int CW_BAR = 1024;

constexpr int RING_BYTES = 131072, EPX_OFF = RING_BYTES, LDS_BYTES = 163840, MISC_OFF = LDS_BYTES - 512;
static_assert(att::D_END <= MISC_OFF && att::W_END <= MISC_OFF && EPX_OFF + 22528 <= MISC_OFF, "LDS map");

typedef GAS unsigned gu32;
#define RLX_AGENT __ATOMIC_RELAXED, __HIP_MEMORY_SCOPE_AGENT
#define LDS_WAIT() asm volatile("s_waitcnt lgkmcnt(0)" ::: "memory")

#define XB_TMO      128
#define XB_XCNT(j)  (256  + 64 * (j))
#define XB_XSUB(j)  (1280 + 64 * (j))
#define XB_XGEN(j)  (2304 + 64 * (j))
#define XB_TOP      3328
#define XB_TOPGEN   3392
#define XCD_BAR_WORDS 3456
#define XB_SPIN_CAP (1u << 22)
__device__ __forceinline__ unsigned xb_ld(unsigned* p)              { return __hip_atomic_load(p, __ATOMIC_RELAXED, __HIP_MEMORY_SCOPE_AGENT); }
__device__ __forceinline__ unsigned xb_add(unsigned* p, unsigned v) { return __hip_atomic_fetch_add(p, v, __ATOMIC_RELAXED, __HIP_MEMORY_SCOPE_AGENT); }
__device__ __forceinline__ unsigned xb_xcc_id() { return (unsigned)__builtin_amdgcn_s_getreg((3 << 11) | 20) & 0xFu; }
#define XB_SPIN(cond, bar) do { unsigned _sp = 0; while (cond) { __builtin_amdgcn_s_sleep(1); \
    if ((++_sp & 255u) == 0u) { if (xb_ld(&(bar)[XB_TMO])) break; if (_sp > XB_SPIN_CAP) { atomicAdd(&(bar)[XB_TMO], 1u); break; } } } } while (0)
struct XcdBarrier { unsigned* bar; unsigned x; volatile LAS unsigned* st; };
__device__ __forceinline__ XcdBarrier xcd_barrier_post(unsigned* bar, volatile LAS unsigned* st) {
    XcdBarrier b; b.bar = bar; b.x = xb_xcc_id(); b.st = st;
    if (threadIdx.x == 0) (void)xb_add(&bar[XB_XCNT(b.x)], 1u);
    return b;
}
__device__ __forceinline__ void xcd_barrier_complete(unsigned* bar, unsigned x, unsigned& nloc, unsigned& nx) {
    const unsigned G = gridDim.x * gridDim.y * gridDim.z;
    unsigned sum, cnt, mine, sp = 0u;
    for (;;) {
        sum = 0u; cnt = 0u; mine = 0u;
#pragma unroll
        for (unsigned j = 0; j < 16; ++j) { const unsigned c = xb_ld(&bar[XB_XCNT(j)]); sum += c; cnt += (c > 0u) ? 1u : 0u; mine = (j == x) ? c : mine; }
        if (sum == G) break;
        __builtin_amdgcn_s_sleep(1);
        if ((++sp & 255u) == 0u) { if (xb_ld(&bar[XB_TMO])) break; if (sp > XB_SPIN_CAP) { atomicAdd(&bar[XB_TMO], 1u); break; } }
    }
    nloc = mine > 0u ? mine : 1u; nx = cnt > 0u ? cnt : 1u;
}
__device__ __forceinline__ void xcd_barrier(const XcdBarrier& b) {
    asm volatile("s_waitcnt vmcnt(0)" ::: "memory");
    __syncthreads();
    if (threadIdx.x == 0) {
        unsigned* bar = b.bar;
        __builtin_amdgcn_s_waitcnt(0);
        unsigned nloc = b.st[0], nx = b.st[1];
        if (nloc == 0u) { xcd_barrier_complete(bar, b.x, nloc, nx); b.st[0] = nloc; b.st[1] = nx; }
        const unsigned old = xb_add(&bar[XB_XSUB(b.x)], 1u);
        const unsigned gen = old / nloc;
        if (old + 1u == (gen + 1u) * nloc) {
            __builtin_amdgcn_fence(__ATOMIC_RELEASE, "agent");
            asm volatile("s_waitcnt vmcnt(0)" ::: "memory");
            const unsigned og = xb_add(&bar[XB_TOP], 1u);
            const unsigned tg = og / nx;
            if (og + 1u == (tg + 1u) * nx) xb_add(&bar[XB_TOPGEN], 1u);
            else XB_SPIN(xb_ld(&bar[XB_TOPGEN]) == tg, bar);
            __builtin_amdgcn_fence(__ATOMIC_ACQUIRE, "agent");
            xb_add(&bar[XB_XGEN(b.x)], 1u);
            asm volatile("s_waitcnt vmcnt(0)" ::: "memory");
        } else {
            XB_SPIN(xb_ld(&bar[XB_XGEN(b.x)]) == gen, bar);
            __builtin_amdgcn_fence(__ATOMIC_ACQUIRE, "agent");
            asm volatile("s_waitcnt vmcnt(0)" ::: "memory");
        }
    }
    __syncthreads();
}

__device__ __forceinline__ float wave_sum(float v) {
#pragma unroll
    for (int o = 1; o < 64; o <<= 1) v += __shfl_xor(v, o);
    return v;
}
__device__ __forceinline__ unsigned f2bf(float f) { unsigned u = __builtin_bit_cast(unsigned, f); return (u + 0x7fffu + ((u >> 16) & 1u)) >> 16; }
__device__ __forceinline__ unsigned pk2(float lo, float hi) { return f2bf(lo) | (f2bf(hi) << 16); }
__device__ __forceinline__ void transpose_item(const float* W, int ld, int cbase, int K, int k0, bf16_t* WT, int nrow0, const float* fold, int foldmask, float fscale, int foldlim, LAS float* scr, int lane) {
    float wv[32];
#pragma unroll
    for (int i = 0; i < 32; ++i) wv[i] = W[(size_t)(k0 + 2 * i + (lane >> 5)) * ld + cbase + (lane & 31)];
#pragma unroll
    for (int i = 0; i < 32; ++i) { const int kk = 2 * i + (lane >> 5), k = k0 + kk;
        float f = 1.f; if (fold != nullptr && k < foldlim) f = fold[k & foldmask] * fscale;
        scr[kk * 33 + (lane & 31)] = wv[i] * f; }
    LDS_WAIT(); asm volatile("" ::: "memory");
    const int c = lane & 7;
#pragma unroll
    for (int j = 0; j < 4; ++j) { const int n = (lane >> 3) + 8 * j; const LAS float* s = scr + (8 * c) * 33 + n;
        u32x4 o; o.x = pk2(s[0 * 33], s[1 * 33]); o.y = pk2(s[2 * 33], s[3 * 33]); o.z = pk2(s[4 * 33], s[5 * 33]); o.w = pk2(s[6 * 33], s[7 * 33]);
        *(u32x4*)(WT + (size_t)(nrow0 + n) * K + k0 + 8 * c) = o; }
    LDS_WAIT(); asm volatile("" ::: "memory");
}

struct Args { const float* in[22]; float* out; unsigned char* ws; int ph_lo, ph_hi, li, pad; };

__global__ void __launch_bounds__(NWAVES * 64, 2) hymba_fwd(Args args) {
    extern __shared__ __attribute__((aligned(16))) unsigned char lds_raw[];
    LAS unsigned char* lds = (LAS unsigned char*)lds_raw;
    volatile LAS unsigned* MISC = (volatile LAS unsigned*)(lds + MISC_OFF);
    const int tid = threadIdx.x, lane = tid & 63, wave = __builtin_amdgcn_readfirstlane(tid >> 6);
    const int G = gridDim.x; const int bx = blockIdx.x; const int vcu = (G % 8 == 0) ? (bx % 8) * (G / 8) + bx / 8 : bx;
    unsigned char* ws = args.ws;
    unsigned* ctl = (unsigned*)(ws + WS_CTL);
    const float* xp = args.in[0]; const float* xs = args.in[1];
    bf16_t* W1 = (bf16_t*)(ws + WS_W1); bf16_t* W2 = (bf16_t*)(ws + WS_W2); bf16_t* W3 = (bf16_t*)(ws + WS_W3); bf16_t* W4 = (bf16_t*)(ws + WS_W4);
    float* SSQ = (float*)(ws + WS_SSQ); bf16_t* XB = (bf16_t*)(ws + WS_XB); bf16_t* PROJ = (bf16_t*)(ws + WS_PROJ); bf16_t* X1B = (bf16_t*)(ws + WS_X1B); bf16_t* ACT = (bf16_t*)(ws + WS_ACT);
    bf16_t* OB = (bf16_t*)(ws + WS_OB); float* RMS1 = (float*)(ws + WS_RSTD1);
    for (int u = tid; u < 128; u += NWAVES * 64) ((LAS unsigned*)(lds + MISC_OFF))[u] = 0u;
    __syncthreads();
    XcdBarrier bar; bar.bar = ctl + CW_BAR + args.li * XCD_BAR_WORDS; bar.x = 0; bar.st = nullptr;
    if (MK_N_LAUNCHES != 6) bar = xcd_barrier_post(ctl + CW_BAR + args.li * XCD_BAR_WORDS, MISC + 8);
    const int lo = args.ph_lo, hi_ph = args.ph_hi;
#ifndef ONLY_PHASE
#define ONLY_PHASE -1
#endif
#define IN(k) ((ONLY_PHASE < 0 || ONLY_PHASE == (k)) && lo <= (k) && (k) < hi_ph)
#define BOTH(k) (IN(k) && IN((k) + 1))
#define GRID_BAR() do { if (MK_N_LAUNCHES != 6) xcd_barrier(bar); } while (0)

    if (IN(0)) {
        LAS float* scr = (LAS float*)(lds + wave * 16384);
        const int gw = vcu * NWAVES + wave, NGW = G * NWAVES;
        constexpr int I1 = (DM / 64) * (DIN / 32), I2 = (DM / 64) * (DM / 32), I3 = (DM / 64) * (2 * DFF / 32), I4 = (DFF / 64) * (DM / 32);
        for (int it = gw; it < I1 + I2 + I3 + I4; it += NGW) {
            int r = it;
            if (r < I1) { const int nblk = DIN / 32, kb = r / nblk, nb = r % nblk, n0 = 32 * nb, pn = n0 >> 8, p = n0 & 255, bj = p >> 7, wc = (p & 127) >> 5;
                transpose_item(args.in[3], DIN, 256 * pn + 64 * wc + 32 * bj, DM, 64 * kb, W1, n0, args.in[2], DM - 1, 1.f, DM, scr, lane); continue; } r -= I1;
            if (r < I2) { const int nblk = DM / 32, kb = r / nblk, nb = r % nblk;
                const int n0 = 32 * nb, pn = n0 >> 8, p = n0 & 255, bj = p >> 7, wc = (p & 127) >> 5;
                transpose_item(args.in[15], DM, 256 * pn + 64 * wc + 32 * bj, DM, 64 * kb, W2, n0, args.in[10], 127, 1.0f - LAM_INIT, 512, scr, lane); continue; } r -= I2;
            if (r < I3) { const int nblk = 2 * DFF / 32, kb = r / nblk, nb = r % nblk, n0 = 32 * nb, pn = n0 >> 8, p = n0 & 255, bj = p >> 7, e0 = p & 127;
                transpose_item(bj ? args.in[18] : args.in[17], DFF, 128 * pn + e0, DM, 64 * kb, W3, n0, args.in[16], DM - 1, 1.f, DM, scr, lane); continue; } r -= I3;
            { const int nblk = DM / 32, kb = r / nblk, nb = r % nblk;
                transpose_item(args.in[21], DM, 32 * nb, DFF, 64 * kb, W4, 32 * nb, nullptr, 0, 1.f, 0, scr, lane); }
        }
        for (int m = gw; m < NTOK; m += 4 * NGW) {
            f32x4 v[4][4]; float ss[4]; int mr[4];
#pragma unroll
            for (int q = 0; q < 4; ++q) { int mm = m + q * NGW; mr[q] = mm; if (mm >= NTOK) mm = m;
                const float* xr = mm < TOK_P ? xp + (size_t)mm * DM : xs + (size_t)(mm - TOK_P) * DM;
#pragma unroll
                for (int j = 0; j < 4; ++j) v[q][j] = __builtin_nontemporal_load((const f32x4*)xr + 64 * j + lane); }
#pragma unroll
            for (int q = 0; q < 4; ++q) { ss[q] = 0.f;
#pragma unroll
                for (int j = 0; j < 4; ++j) ss[q] += dot4(v[q][j]); }
#pragma unroll
            for (int o = 1; o < 64; o <<= 1) {
#pragma unroll
                for (int q = 0; q < 4; ++q) ss[q] += __shfl_xor(ss[q], o); }
#pragma unroll
            for (int q = 0; q < 4; ++q) if (mr[q] < NTOK) { const float ms = ss[q] * (1.f / DM) + EPS; const float r = __builtin_amdgcn_rsqf(ms);
                if (lane == 0) RMS1[mr[q]] = ms * r;
                u32x2* o8 = (u32x2*)(XB + (size_t)mr[q] * DM) + lane;
#pragma unroll
                for (int j = 0; j < 4; ++j) { u32x2 w; w.x = cvtpk(v[q][j][0] * r, v[q][j][1] * r); w.y = cvtpk(v[q][j][2] * r, v[q][j][3] * r); o8[64 * j] = w; } }
        }
        if (BOTH(0)) GRID_BAR();
    }

    if (IN(1)) {
        pg8::Gemm g{XB, W1, DM, 256}; pg8::StaticOrder S; S.init(NTOK / 256, DIN / 256, G, bx);
        { LAS float* gl = (LAS float*)(lds + EPX_OFF);
          if (tid < 256) { const int v = tid >> 6, d = tid & 63; gl[tid] = (v == 0 ? args.in[4] : v == 1 ? args.in[5] : v == 2 ? args.in[11] : args.in[12])[d]; }
          LDS_WAIT(); __syncthreads(); }
        pg8::EpiProj E{PROJ, (const LAS float*)(lds + EPX_OFF)};
        pg8::gemm_phase<pg8::EpiProj, pg8::StaticOrder>(lds, g, S, E);
        if (BOTH(1)) GRID_BAR();
    }

    if (IN(2)) {
        if (wave == 0) {
            const float a = args.in[6][lane] * args.in[7][lane], b2 = args.in[8][lane] * args.in[9][lane];
            const float sa = wave_sum(a), sb = wave_sum(b2);
            if (lane == 0) ((LAS float*)(lds + MISC_OFF))[16] = __expf(sa) - __expf(sb) + LAM_INIT;
        }
        LDS_WAIT(); __syncthreads();
        const float lam = ((const LAS float*)(lds + MISC_OFF))[16];
        const int per = (768 + G - 1) / G;
#ifndef NO_DIFF
        for (int i = 0; i < per; ++i) { const int u = vcu * per + i; if (u < 768) { const int bh = u >> 3, qb = u & 7;
            att::diff_unit(bh >> 2, bh & 3, qb, PROJ, OB, (LAS char*)lds, lam, args.in[14]); } }
#endif
#ifndef NO_WIN
        for (int i = 0; i < per; ++i) { const int u = vcu * per + i; if (u < 768) { const int bk = u >> 4, qb = u & 15;
            att::win_unit(bk >> 1, bk & 1, qb, PROJ, OB, (LAS char*)lds, args.in[14], args.in[13]); } }
#endif
        if (BOTH(2)) GRID_BAR();
    }

    if (IN(3)) {
        pg8::Gemm g{OB, W2, DM, 256}; pg8::StaticOrder S; S.init(NTOK / 256, DM / 256, G, bx);
        pg8::EpiOut E{XB, RMS1, X1B, SSQ, (LAS float*)(lds + EPX_OFF)};
        pg8::gemm_phase<pg8::EpiOut, pg8::StaticOrder>(lds, g, S, E);
        if (BOTH(3)) GRID_BAR();
    }

    if (IN(4)) {
        pg8::Gemm g{X1B - DM, W3, DM, 254}; pg8::StaticOrder S; S.init(194, 2 * DFF / 256, G, bx);
        pg8::EpiFfn E{ACT, SSQ, args.in[19], args.in[20], (LAS float*)(lds + EPX_OFF)};
        pg8::gemm_phase<pg8::EpiFfn, pg8::StaticOrder>(lds, g, S, E);
        if (BOTH(4)) GRID_BAR();
    }

    if (IN(5)) {
        pg8::Gemm g{ACT, W4, DFF, 256}; pg8::StaticOrder S; S.init(NTOK / 256, DM / 256, G, bx, 1);
        pg8::EpiDown E{X1B, args.out};
        pg8::gemm_phase<pg8::EpiDown, pg8::StaticOrder>(lds, g, S, E);
    }
#undef IN
#undef BOTH
#undef GRID_BAR
}

extern "C" void kernel_launch(void* const* d_in, const int* in_sizes, int n_in, void* d_out, int out_size, void* d_ws, size_t ws_size, hipStream_t stream) {
    static int grid = 0;
    if (grid == 0) {
        if (n_in != 22 || in_sizes[0] != TOK_P * DM || in_sizes[1] != (NTOK - TOK_P) * DM || out_size != NTOK * DM || ws_size < WS_END) {
            fprintf(stderr, "kernel_launch: shape mismatch (n_in %d, in0 %d, in1 %d, out %d, ws %zu; need ws >= %zu)\n", n_in, n_in > 0 ? in_sizes[0] : -1, n_in > 1 ? in_sizes[1] : -1, out_size, ws_size, (size_t)WS_END); grid = -1; return; }
        int dev = 0, cus = 0;
        if (hipGetDevice(&dev) != hipSuccess || hipDeviceGetAttribute(&cus, hipDeviceAttributeMultiprocessorCount, dev) != hipSuccess) { fprintf(stderr, "kernel_launch: device query failed\n"); grid = -1; return; }
        if (hipFuncSetAttribute((const void*)hymba_fwd, hipFuncAttributeMaxDynamicSharedMemorySize, LDS_BYTES) != hipSuccess) { fprintf(stderr, "kernel_launch: hipFuncSetAttribute failed\n"); grid = -1; return; }
        int per_cu = 0;
        if (hipOccupancyMaxActiveBlocksPerMultiprocessor(&per_cu, (const void*)hymba_fwd, NWAVES * 64, LDS_BYTES) != hipSuccess || per_cu < 1)
            fprintf(stderr, "kernel_launch: note: occupancy query reports %d workgroups per CU\n", per_cu);
        (void)hipGetLastError();
        grid = cus;
    }
    if (grid < 0) return;
    (void)hipMemsetAsync((char*)d_ws + WS_CTL, 0, CTL_ZERO_BYTES, stream);
    Args a{};
    for (int i = 0; i < 22; ++i) a.in[i] = (const float*)d_in[i];
    a.out = (float*)d_out; a.ws = (unsigned char*)d_ws;
#ifndef PROBE_DUP
#define PROBE_DUP -1
#endif
    constexpr int NL = (PROBE_DUP >= 0) ? 3 : MK_N_LAUNCHES;
    for (int li = 0; li < NL; ++li) {
        if (PROBE_DUP >= 0) {
            a.ph_lo = li == 0 ? 0 : (li == 1 ? PROBE_DUP : PROBE_DUP + 1); a.ph_hi = li == 2 ? 6 : PROBE_DUP + 1; a.li = li;
        } else { a.ph_lo = (NL == 6) ? li : 0; a.ph_hi = (NL == 6) ? li + 1 : 6; a.li = (NL == 6) ? 0 : li; }
        hipLaunchKernelGGL(hymba_fwd, dim3(grid), dim3(NWAVES * 64), LDS_BYTES, stream, a);
        const hipError_t le = hipPeekAtLastError();
        if (le != hipSuccess) { fprintf(stderr, "kernel_launch: launch %d failed: %s\n", li, hipGetErrorName(le)); break; }
    }
}
```

```cpp
#include <hip/hip_runtime.h>
#include <hip/hip_bf16.h>
#include <cstdio>
#include <cstdint>

#ifndef MK_N_LAUNCHES
#define MK_N_LAUNCHES 1
#endif

#define LAS __attribute__((address_space(3)))
#define GAS __attribute__((address_space(1)))
typedef unsigned short bf16_t;
typedef short bf16x8 __attribute__((ext_vector_type(8)));
typedef short s16x4 __attribute__((ext_vector_type(4)));
typedef float f32x2 __attribute__((ext_vector_type(2)));
typedef float f32x4 __attribute__((ext_vector_type(4)));
typedef float f32x16 __attribute__((ext_vector_type(16)));
typedef unsigned u32x2 __attribute__((ext_vector_type(2)));
typedef unsigned u32x4 __attribute__((ext_vector_type(4)));
typedef __bf16 bf16x2_t __attribute__((ext_vector_type(2)));

constexpr int DM = 1024, SEQ = 2048, NSEQ = 24, NTOK = NSEQ * SEQ, TOK_P = 8 * SEQ;
constexpr int DIN = 2304, DFF = 2816;
constexpr int C_DQ = 0, C_DK = 512, C_DV = 1024, C_WQ = 1536, C_WK = 2048, C_WV = 2176;
constexpr int NBH = 12;
constexpr float EPS = 1e-6f, LOG2E = 1.4426950408889634f, QSCALE = 0.125f * LOG2E;
constexpr float LAM_INIT = 0.2f;
constexpr int NWAVES = 8;

__device__ __forceinline__ unsigned cvtpk(float lo, float hi) { f32x2 v = {lo, hi}; bf16x2_t b = __builtin_convertvector(v, bf16x2_t); return __builtin_bit_cast(unsigned, b); }
__device__ __forceinline__ u32x4 pack8(f32x4 a, f32x4 b) { u32x4 w; w.x = cvtpk(a[0], a[1]); w.y = cvtpk(a[2], a[3]); w.z = cvtpk(b[0], b[1]); w.w = cvtpk(b[2], b[3]); return w; }
__device__ __forceinline__ float dot4(f32x4 a) { return (a[0] * a[0] + a[1] * a[1]) + (a[2] * a[2] + a[3] * a[3]); }

namespace pg8 {
constexpr int BM = 256, BK = 64, HALF = 128, HTB = HALF * BK * 2, STAGE_BYTES = 8 * HTB, NXCD = 8, WGM = 8;
__host__ __device__ __forceinline__ int lds_byte(int r, int c) { const int st = (r >> 4) * 2 + (c >> 5), rr = r & 15, cc = c & 31, ob = rr * 64 + cc * 2; return st * 1024 + (ob ^ (((ob >> 9) & 1) << 5)); }
__host__ __device__ __forceinline__ void stage_rc(int b, int& R, int& C) { const int st = b / 1024, sb = b % 1024, swz = sb ^ (((sb >> 9) & 1) << 5); R = (st >> 1) * 16 + swz / 64; C = (st & 1) * 32 + (swz % 64) / 2; }
__host__ __device__ __forceinline__ int perm32(int rho) { const int n = rho >> 4, i = rho & 15; return 8 * (i >> 2) + 4 * n + (i & 3); }

typedef int v4i32_t __attribute__((ext_vector_type(4)));
struct Unit { int pm, pn; };
struct Gemm { const bf16_t* A; const bf16_t* Bt; int K; int arows; };

struct StaticOrder {
    int nM, nN, nwg, G, c, rev;
    __device__ void init(int nM_, int nN_, int G_, int c_, int rev_ = 0) { nM = nM_; nN = nN_; nwg = nM * nN; G = G_; c = c_; rev = rev_; }
    __device__ bool next(int i, Unit& u) const {
        const int nr = (nwg - c + G - 1) / G; if (i >= nr) return false;
        const long L = (long)(rev ? nr - 1 - i : i) * G + c;
        int wgid = (int)L; { const int q = nwg / NXCD, r = nwg % NXCD, xcd = wgid % NXCD, off = wgid / NXCD; wgid = (xcd < r ? xcd * (q + 1) : r * (q + 1) + (xcd - r) * q) + off; }
        const int nig = WGM * nN, gid = wgid / nig, fm = gid * WGM, gsz = (nM - fm) < WGM ? (nM - fm) : WGM;
        u.pm = fm + ((wgid % nig) % gsz); u.pn = (wgid % nig) / gsz; return true;
    }
};


struct EpiProj {
    static constexpr bool PERM = true;
    bf16_t* P; const LAS float* gl;
    __device__ __forceinline__ void pre(const Unit&, int, int) const {}
    __device__ __forceinline__ void operator()(const f32x4 (&acc)[2][2][4][2], const Unit& u, int wr, int wc, int fr, int fq, int lane) const {
        const int gidx = u.pn * 4 + wc;
        int gsel = -1; float sc = 1.f;
        if (gidx < 8) { gsel = 0; sc = QSCALE; } else if (gidx < 16) { gsel = 1; } else if (gidx < 24) { } else if (gidx < 32) { gsel = 2; sc = QSCALE; } else if (gidx < 34) { gsel = 3; }
        const bool nrm = gsel >= 0; const LAS float* gain = gl + (nrm ? gsel : 0) * 64;
        f32x4 gv[2][2];
#pragma unroll
        for (int bj = 0; bj < 2; ++bj)
#pragma unroll
            for (int n = 0; n < 2; ++n) gv[bj][n] = nrm ? *(const LAS f32x4*)(gain + 32 * bj + 8 * fq + 4 * n) * sc : (f32x4){1.f, 1.f, 1.f, 1.f};
        bf16_t* base = P + (size_t)(u.pm * BM + wr * 64 + fr) * DIN + gidx * 64 + 8 * fq;
#pragma unroll
        for (int ai = 0; ai < 2; ++ai)
#pragma unroll
            for (int m = 0; m < 4; ++m) {
                f32x4 v00 = acc[ai][0][m][0], v01 = acc[ai][0][m][1], v10 = acc[ai][1][m][0], v11 = acc[ai][1][m][1];
                float rn = 1.f;
                if (nrm) { float ss = (dot4(v00) + dot4(v01)) + (dot4(v10) + dot4(v11)); ss += __shfl_xor(ss, 16); ss += __shfl_xor(ss, 32); rn = __builtin_amdgcn_rsqf(ss * (1.0f / 64.0f) + EPS); }
                v00 = v00 * rn * gv[0][0]; v01 = v01 * rn * gv[0][1]; v10 = v10 * rn * gv[1][0]; v11 = v11 * rn * gv[1][1];
                bf16_t* rowp = base + (size_t)(ai * HALF + m * 16) * DIN;
                const u32x4 pa = pack8(v00, v01), pb = pack8(v10, v11);
                u32x4 px; px.x = (unsigned)__builtin_amdgcn_mov_dpp((int)pb.x, 0x128, 0xf, 0xf, true); px.y = (unsigned)__builtin_amdgcn_mov_dpp((int)pb.y, 0x128, 0xf, 0xf, true);
                px.z = (unsigned)__builtin_amdgcn_mov_dpp((int)pb.z, 0x128, 0xf, 0xf, true); px.w = (unsigned)__builtin_amdgcn_mov_dpp((int)pb.w, 0x128, 0xf, 0xf, true);
                const bool hi8 = (fr & 8) != 0;
                bf16_t* r1p = base + (size_t)(ai * HALF + m * 16 - (hi8 ? 8 : 0)) * DIN + (hi8 ? 32 : 0);
                bf16_t* r2p = base + (size_t)(ai * HALF + m * 16 + (hi8 ? 0 : 8)) * DIN + (hi8 ? 0 : 32);
                *(u32x4*)(r1p) = hi8 ? px : pa; *(u32x4*)(r2p) = hi8 ? pa : px;
            }
    }
};

struct EpiOut {
    static constexpr bool PERM = true;
    const bf16_t* __restrict__ xb; const float* __restrict__ rms; bf16_t* __restrict__ x1b; float* __restrict__ ssq; LAS float* xl;
    __device__ __forceinline__ void pre(const Unit&, int, int) const {}
    __device__ __forceinline__ void operator()(const f32x4 (&acc)[2][2][4][2], const Unit& u, int wr, int wc, int fr, int fq, int lane) const {
        asm volatile("" : "+v"(fr), "+v"(fq));
        const int rowbase = u.pm * BM;
        const int col0 = u.pn * BM + wc * 64 + 8 * fq;
        const bool hi8 = (fr & 8) != 0;
#pragma unroll
        for (int ai = 0; ai < 2; ++ai) {
            u32x4 xv[4][2]; float rr[4];
#pragma unroll
            for (int m = 0; m < 4; ++m) { const size_t row = (size_t)(rowbase + ai * HALF + wr * 64 + m * 16 + fr);
                rr[m] = rms[row];
#pragma unroll
                for (int bj = 0; bj < 2; ++bj) xv[m][bj] = *(const u32x4*)(xb + row * DM + col0 + bj * 32); }
#pragma unroll
            for (int m = 0; m < 4; ++m) {
                const int rl = ai * HALF + wr * 64 + m * 16 + fr; float s = 0.f; u32x4 pk[2];
#pragma unroll
                for (int bj = 0; bj < 2; ++bj) { const u32x4 w = xv[m][bj];
                    f32x4 x0, x1;
                    x0[0] = __uint_as_float(w.x << 16); x0[1] = __uint_as_float(w.x & 0xffff0000u); x0[2] = __uint_as_float(w.y << 16); x0[3] = __uint_as_float(w.y & 0xffff0000u);
                    x1[0] = __uint_as_float(w.z << 16); x1[1] = __uint_as_float(w.z & 0xffff0000u); x1[2] = __uint_as_float(w.w << 16); x1[3] = __uint_as_float(w.w & 0xffff0000u);
                    const f32x4 o0 = x0 * rr[m] + acc[ai][bj][m][0], o1 = x1 * rr[m] + acc[ai][bj][m][1];
                    pk[bj] = pack8(o0, o1);
                    s += dot4(o0) + dot4(o1); }
                u32x4 px; px.x = (unsigned)__builtin_amdgcn_mov_dpp((int)pk[1].x, 0x128, 0xf, 0xf, true); px.y = (unsigned)__builtin_amdgcn_mov_dpp((int)pk[1].y, 0x128, 0xf, 0xf, true);
                px.z = (unsigned)__builtin_amdgcn_mov_dpp((int)pk[1].z, 0x128, 0xf, 0xf, true); px.w = (unsigned)__builtin_amdgcn_mov_dpp((int)pk[1].w, 0x128, 0xf, 0xf, true);
                bf16_t* r1p = x1b + (size_t)(rowbase + rl - (hi8 ? 8 : 0)) * DM + col0 + (hi8 ? 32 : 0);
                bf16_t* r2p = x1b + (size_t)(rowbase + rl + (hi8 ? 0 : 8)) * DM + col0 + (hi8 ? 0 : 32);
                *(u32x4*)(r1p) = hi8 ? px : pk[0]; *(u32x4*)(r2p) = hi8 ? pk[0] : px;
                s += __shfl_xor(s, 16); s += __shfl_xor(s, 32);
                if (fq == 0) xl[rl * 4 + wc] = s;
            }
        }
        asm volatile("s_waitcnt lgkmcnt(0)" ::: "memory"); __builtin_amdgcn_s_barrier(); asm volatile("" ::: "memory");
        const int t = (wr * 4 + wc) * 64 + lane;
        if (t < 256) { const f32x4 q = *(const LAS f32x4*)(xl + t * 4); ssq[(size_t)(rowbase + t) * 4 + u.pn] = (q[0] + q[1]) + (q[2] + q[3]); }
    }
};

__device__ __forceinline__ float dpp8(float x) { return __builtin_bit_cast(float, __builtin_amdgcn_mov_dpp(__builtin_bit_cast(int, x), 0x128, 0xf, 0xf, true)); }
struct EpiDown {
    static constexpr bool PERM = true;
    const bf16_t* __restrict__ x1b; float* __restrict__ out;
    __device__ __forceinline__ void pre(const Unit&, int, int) const {}
    __device__ __forceinline__ void operator()(const f32x4 (&acc)[2][2][4][2], const Unit& u, int wr, int wc, int fr, int fq, int lane) const {
        const int col0 = u.pn * BM + wc * 32 + 8 * fq; const bool hi8 = (fr & 8) != 0;
        u32x4 w[2][4][2];
#pragma unroll
        for (int ai = 0; ai < 2; ++ai)
#pragma unroll
            for (int m = 0; m < 4; ++m) { const size_t off = (size_t)(u.pm * BM + ai * HALF + wr * 64 + m * 16 + fr) * DM + col0;
#pragma unroll
                for (int bj = 0; bj < 2; ++bj) w[ai][m][bj] = *(const u32x4*)(x1b + off + bj * HALF); }
#pragma unroll
        for (int ai = 0; ai < 2; ++ai)
#pragma unroll
            for (int m = 0; m < 4; ++m) { const size_t off = (size_t)(u.pm * BM + ai * HALF + wr * 64 + m * 16 + fr) * DM + col0;
#pragma unroll
                for (int bj = 0; bj < 2; ++bj) { const u32x4 ww = w[ai][m][bj];
                    f32x4 r0, r1;
                    r0[0] = __uint_as_float(ww.x << 16); r0[1] = __uint_as_float(ww.x & 0xffff0000u); r0[2] = __uint_as_float(ww.y << 16); r0[3] = __uint_as_float(ww.y & 0xffff0000u);
                    r1[0] = __uint_as_float(ww.z << 16); r1[1] = __uint_as_float(ww.z & 0xffff0000u); r1[2] = __uint_as_float(ww.w << 16); r1[3] = __uint_as_float(ww.w & 0xffff0000u);
                    const f32x4 q0 = r0 + acc[ai][bj][m][0], q1 = r1 + acc[ai][bj][m][1];
                    f32x4 qx; qx[0] = dpp8(q1[0]); qx[1] = dpp8(q1[1]); qx[2] = dpp8(q1[2]); qx[3] = dpp8(q1[3]);
                    const long d1 = hi8 ? (long)(4 - 8 * DM) : 0, d2 = hi8 ? 0 : (long)(4 + 8 * DM);
                    *(f32x4*)(out + off + bj * HALF + d1) = hi8 ? qx : q0; *(f32x4*)(out + off + bj * HALF + d2) = hi8 ? q0 : qx; } }
    }
};

template <int CTRL> __device__ __forceinline__ float dppz(float x) { return __builtin_bit_cast(float, __builtin_amdgcn_update_dpp(0, __builtin_bit_cast(int, x), CTRL, 0xf, 0xf, true)); }
struct EpiFfn {
    static constexpr bool PERM = true;
    bf16_t* act; const float* fa; const float* swm; const float* cw; const float* cb; LAS float* xl;
    __device__ __forceinline__ void pre(const Unit& u, int wid, int lane_) const {
        int lane = lane_; asm volatile("" : "+v"(lane));
        const int tok0 = 254 * u.pm - 1;
        if (wid >= 4) { int tok = tok0 + 64 * (wid - 4) + lane; tok = tok < 0 ? 0 : (tok > NTOK - 1 ? NTOK - 1 : tok);
            __builtin_amdgcn_global_load_lds((const unsigned*)(fa + tok), (LAS unsigned*)((LAS char*)xl + 4096 + (wid - 4) * 256), 4, 0, 0); }
        if (wid == 2) __builtin_amdgcn_global_load_lds((const unsigned*)(swm + u.pn * 256 + lane * 4), (LAS unsigned*)((LAS char*)xl + 5120), 16, 0, 0);
        if (wid < 2) { const float* src = (wid == 0 ? (lane < 32 ? cw : cw + DFF) : (lane < 32 ? cw + 2 * DFF : cb)) + u.pn * 128 + (lane & 31) * 4;
            __builtin_amdgcn_global_load_lds((const unsigned*)src, (LAS unsigned*)((LAS char*)xl + 20480 + wid * 1024), 16, 0, 0); }
    }
    template <int AI, int M, bool MASK>
    __device__ __forceinline__ void conv_rows(const f32x4 (&acc)[2][2][4][2], const f32x4 (&w0)[2], const f32x4 (&w1)[2], const f32x4 (&w2)[2], const f32x4 (&bb)[2],
                                              int tok, int rl, int G, int xc, int fr, int ch0) const {
        const bool pcut = MASK && (tok & (SEQ - 1)) == 0, ncut = MASK && (tok & (SEQ - 1)) == SEQ - 1;
        f32x4 r0, r1;
#pragma unroll
        for (int n = 0; n < 2; ++n) { f32x4 res;
            f32x4 ex = (f32x4){0.f, 0.f, 0.f, 0.f};
            if (M == 0) { if (G > 0) ex = *(const LAS f32x4*)(xl + (2 * (G - 1) + 1) * 128 + xc + 4 * n); ex = fr == 0 ? ex : (f32x4){0.f, 0.f, 0.f, 0.f}; }
            if (M == 3) { if (G < 3) ex = *(const LAS f32x4*)(xl + (2 * (G + 1)) * 128 + xc + 4 * n); ex = fr == 15 ? ex : (f32x4){0.f, 0.f, 0.f, 0.f}; }
#pragma unroll
            for (int i = 0; i < 4; ++i) {
                const float own = acc[AI][0][M][n][i];
                float pr = dppz<0x111>(own);
                pr += (M > 0) ? dppz<0x10F>(acc[AI][0][M > 0 ? M - 1 : 0][n][i]) : ex[i];
                float nx = dppz<0x101>(own);
                nx += (M < 3) ? dppz<0x11F>(acc[AI][0][M < 3 ? M + 1 : 3][n][i]) : ex[i];
                if (MASK) { pr = pcut ? 0.f : pr; nx = ncut ? 0.f : nx; }
                const float uc = fmaf(w0[n][i], pr, fmaf(w1[n][i], own, fmaf(w2[n][i], nx, bb[n][i])));
                const float sg = uc * __builtin_amdgcn_rcpf(1.0f + __builtin_amdgcn_exp2f(-LOG2E * uc));
                res[i] = sg * acc[AI][1][M][n][i];
            }
            if (n == 0) r0 = res; else r1 = res; }
        if (rl != 0 && rl != 255 && tok < NTOK) *(u32x4*)(act + (size_t)tok * DFF + ch0) = pack8(r0, r1);
    }
    __device__ __forceinline__ void operator()(f32x4 (&acc)[2][2][4][2], const Unit& u, int wr, int wc, int fr, int fq, int lane) const {
        const int ch0 = u.pn * 128 + wc * 32 + 8 * fq;
        const int tok0 = 254 * u.pm - 1;
        int fql = fq; asm volatile("" : "+v"(fql));
        const int xc = wc * 32 + 8 * fql;
        f32x4 su[2];
#pragma unroll
        for (int n = 0; n < 2; ++n) su[n] = *(const LAS f32x4*)(xl + 1280 + 128 + xc + 4 * n) * (1.0f / 127.0f);
#pragma unroll
        for (int ai = 0; ai < 2; ++ai)
#pragma unroll
            for (int m = 0; m < 4; ++m) { const float rs = xl[1024 + ai * HALF + wr * 64 + m * 16 + fr];
#pragma unroll
                for (int n = 0; n < 2; ++n) { const f32x4 rsu = su[n] * rs;
                    acc[ai][0][m][n] = __builtin_convertvector(__builtin_bit_cast(v4i32_t, acc[ai][0][m][n]), f32x4) * rs;
                    acc[ai][1][m][n] = __builtin_convertvector(__builtin_bit_cast(v4i32_t, acc[ai][1][m][n]), f32x4) * rsu; } }
#pragma unroll
        for (int ai = 0; ai < 2; ++ai) { const int G = 2 * ai + wr;
            if (fr == 0) { *(LAS f32x4*)(xl + (2 * G) * 128 + xc) = acc[ai][0][0][0]; *(LAS f32x4*)(xl + (2 * G) * 128 + xc + 4) = acc[ai][0][0][1]; }
            if (fr == 15) { *(LAS f32x4*)(xl + (2 * G + 1) * 128 + xc) = acc[ai][0][3][0]; *(LAS f32x4*)(xl + (2 * G + 1) * 128 + xc + 4) = acc[ai][0][3][1]; } }
        asm volatile("s_waitcnt lgkmcnt(0)" ::: "memory"); __builtin_amdgcn_s_barrier(); asm volatile("" ::: "memory"); __builtin_amdgcn_sched_barrier(0);
        f32x4 w0[2], w1[2], w2[2], bb[2];
#pragma unroll
        for (int n = 0; n < 2; ++n) { const LAS float* wl = xl + 5120 + xc + 4 * n; const f32x4 sgc = *(const LAS f32x4*)(xl + 1280 + xc + 4 * n) * (1.0f / 127.0f);
            w0[n] = *(const LAS f32x4*)(wl) * sgc; w1[n] = *(const LAS f32x4*)(wl + 128) * sgc; w2[n] = *(const LAS f32x4*)(wl + 256) * sgc; bb[n] = *(const LAS f32x4*)(wl + 384); }
#define FFN_ROWS(AI, M) do { const int tb_ = tok0 + AI * HALF + wr * 64 + M * 16; const int G_ = 2 * AI + wr; \
        conv_rows<AI, M, true>(acc, w0, w1, w2, bb, tb_ + fr, AI * HALF + wr * 64 + M * 16 + fr, G_, xc, fr, ch0); \
        if ((M) & 1) __builtin_amdgcn_sched_barrier(0); } while (0)
        FFN_ROWS(0, 0); FFN_ROWS(0, 1); FFN_ROWS(0, 2); FFN_ROWS(0, 3); FFN_ROWS(1, 0); FFN_ROWS(1, 1); FFN_ROWS(1, 2); FFN_ROWS(1, 3);
#undef FFN_ROWS
    }
};

template <class Epi, class Sched, bool ALIGN_EPI = true, bool SP2 = true, bool I8 = false>
__device__ __forceinline__ void gemm_phase(LAS unsigned char* lds, const Gemm g, const Sched& S, const Epi& E) {
    const int tid = threadIdx.x, wid = __builtin_amdgcn_readfirstlane(tid >> 6), lane = tid & 63, wr = wid >> 2, wc = wid & 3, fr = lane & 15, fq = lane >> 4;
    const int K = g.K, nt = K / BK;
    unsigned voffA[2], voffB[2];
#pragma unroll
    for (int i = 0; i < 2; ++i) { int R, C; stage_rc(tid * 16 + i * 8192, R, C); const int Rb = Epi::PERM ? ((R & ~31) + perm32(R & 31)) : R;
        voffA[i] = (unsigned)(R * K + C) * 2u; voffB[i] = (unsigned)(Rb * K + C) * 2u; }
    const size_t kstep = (size_t)(BK * 2);
    const size_t hstep = (size_t)HALF * K * 2;
    const size_t tstepB = 2 * hstep;
    const size_t tstepA = (size_t)g.arows * K * 2;
    const unsigned ldsw = (unsigned)wid * 1024u;
    const int aoff = lds_byte(wr * 64 + fr, fq * 8), boff = lds_byte(wc * 32 + fr, fq * 8);
#define PG8_SA(b, h) (((b) * 2 + (h)) * HTB)
#define PG8_SB(b, h) ((4 + (b) * 2 + (h)) * HTB)
#define PG8_STAGE(bufoff, gbase, voff) do { _Pragma("unroll") for (int _i = 0; _i < 2; ++_i) \
        __builtin_amdgcn_global_load_lds((const unsigned*)((const char*)(gbase) + (voff)[_i]), (LAS unsigned*)(lds + (bufoff) + ldsw + _i * 8192), 16, 0, 0); } while (0)
#define PG8_LDA(dst, b, h) do { _Pragma("unroll") for (int m = 0; m < 4; ++m) _Pragma("unroll") for (int k = 0; k < 2; ++k) dst[m][k] = *(const LAS bf16x8*)(lds + PG8_SA(b, h) + aoff + m * 2048 + k * 1024); } while (0)
#define PG8_LDB(dst, b, h) do { _Pragma("unroll") for (int n = 0; n < 2; ++n) _Pragma("unroll") for (int k = 0; k < 2; ++k) dst[n][k] = *(const LAS bf16x8*)(lds + PG8_SB(b, h) + boff + n * 2048 + k * 1024); } while (0)
#define PG8_MMA(ai, bj, At, Bt) do { __builtin_amdgcn_s_setprio(1); _Pragma("unroll") for (int m = 0; m < 4; ++m) _Pragma("unroll") for (int n = 0; n < 2; ++n) _Pragma("unroll") for (int k = 0; k < 2; ++k) \
        { if constexpr (I8) acc[ai][bj][m][n] = __builtin_bit_cast(f32x4, __builtin_amdgcn_mfma_i32_16x16x64_i8(__builtin_bit_cast(v4i32_t, Bt[n][k]), __builtin_bit_cast(v4i32_t, At[m][k]), __builtin_bit_cast(v4i32_t, acc[ai][bj][m][n]), 0, 0, 0)); \
          else acc[ai][bj][m][n] = __builtin_amdgcn_mfma_f32_16x16x32_bf16(Bt[n][k], At[m][k], acc[ai][bj][m][n], 0, 0, 0); } __builtin_amdgcn_s_setprio(0); } while (0)
#define PG8_WAIT_V(n) asm volatile("s_waitcnt vmcnt(" #n ")" ::: "memory")
#define PG8_WAIT_L(n) asm volatile("s_waitcnt lgkmcnt(" #n ")" ::: "memory")
#define PG8_BAR __builtin_amdgcn_s_barrier()
#define PG8_SCHED __builtin_amdgcn_sched_barrier(0)
    Unit cur, nxt; int ui = 0;
    if (!S.next(0, cur)) return;
    f32x4 acc[2][2][4][2];
#pragma unroll
    for (int a = 0; a < 2; ++a)
#pragma unroll
        for (int b = 0; b < 2; ++b)
#pragma unroll
            for (int m = 0; m < 4; ++m)
#pragma unroll
                for (int n = 0; n < 2; ++n) acc[a][b][m][n] = (f32x4){0.f, 0.f, 0.f, 0.f};
    bf16x8 At[4][2], B0[2][2], B1[2][2];
    const char* cA = (const char*)g.A + (size_t)cur.pm * tstepA; const char* cB = (const char*)g.Bt + (size_t)cur.pn * tstepB;
    if constexpr (SP2) {
        PG8_STAGE(PG8_SB(0, 0), cB, voffB); PG8_STAGE(PG8_SB(0, 1), cB + hstep, voffB); PG8_STAGE(PG8_SA(0, 0), cA, voffA); PG8_STAGE(PG8_SA(0, 1), cA + hstep, voffA);
        if (wr == 1) PG8_BAR;
        PG8_WAIT_V(2); PG8_BAR;
        PG8_STAGE(PG8_SB(1, 0), cB + kstep, voffB); PG8_STAGE(PG8_SA(1, 0), cA + kstep, voffA); PG8_STAGE(PG8_SB(1, 1), cB + hstep + kstep, voffB);
        PG8_WAIT_V(6); PG8_BAR;
    } else {
        PG8_STAGE(PG8_SB(0, 0), cB, voffB); PG8_STAGE(PG8_SA(0, 0), cA, voffA); PG8_STAGE(PG8_SB(0, 1), cB + hstep, voffB); PG8_STAGE(PG8_SA(0, 1), cA + hstep, voffA);
        if (wr == 1) PG8_BAR;
        PG8_WAIT_V(4); PG8_BAR;
        PG8_STAGE(PG8_SB(1, 0), cB + kstep, voffB); PG8_STAGE(PG8_SA(1, 0), cA + kstep, voffA); PG8_STAGE(PG8_SB(1, 1), cB + hstep + kstep, voffB);
        PG8_WAIT_V(6); PG8_BAR;
    }
    for (;;) {
        const bool has_next = S.next(ui + 1, nxt);
        const char* nA = has_next ? (const char*)g.A + (size_t)nxt.pm * tstepA : cA; const char* nB = has_next ? (const char*)g.Bt + (size_t)nxt.pn * tstepB : cB;
        for (int t = 0; t < nt; t += 2) {
            const bool last = (t == nt - 2);
            const char* a1 = cA + (size_t)(t + 1) * kstep;
            const char* a2 = last ? nA : cA + (size_t)(t + 2) * kstep; const char* b2 = last ? nB : cB + (size_t)(t + 2) * kstep;
            const char* a3 = a2 + kstep; const char* b3 = b2 + kstep;
            if (last) E.pre(cur, wid, lane);
            if constexpr (SP2) {
            PG8_LDB(B0, 0, 0); PG8_LDB(B1, 0, 1); PG8_SCHED; PG8_LDA(At, 0, 0); PG8_STAGE(PG8_SA(1, 1), a1 + hstep, voffA);
            PG8_WAIT_V(8); PG8_WAIT_L(0); PG8_BAR; PG8_MMA(0, 0, At, B0); PG8_MMA(0, 1, At, B1); PG8_BAR; PG8_SCHED;
            PG8_LDA(At, 0, 1); PG8_STAGE(PG8_SB(0, 0), b2, voffB); PG8_STAGE(PG8_SB(0, 1), b2 + hstep, voffB); PG8_STAGE(PG8_SA(0, 0), a2, voffA);
            PG8_WAIT_V(8); PG8_WAIT_L(0); PG8_BAR; PG8_MMA(1, 0, At, B0); PG8_MMA(1, 1, At, B1); PG8_BAR; PG8_SCHED;
            PG8_LDB(B0, 1, 0); PG8_LDB(B1, 1, 1); PG8_SCHED; PG8_LDA(At, 1, 0); PG8_STAGE(PG8_SA(0, 1), a2 + hstep, voffA);
            PG8_WAIT_V(8); PG8_WAIT_L(0); PG8_BAR; PG8_MMA(0, 0, At, B0); PG8_MMA(0, 1, At, B1); PG8_BAR; PG8_SCHED;
            PG8_LDA(At, 1, 1); PG8_STAGE(PG8_SB(1, 0), b3, voffB); PG8_STAGE(PG8_SB(1, 1), b3 + hstep, voffB); PG8_STAGE(PG8_SA(1, 0), a3, voffA);
            PG8_WAIT_V(8); PG8_WAIT_L(0); PG8_BAR; PG8_MMA(1, 0, At, B0); PG8_MMA(1, 1, At, B1); PG8_BAR; PG8_SCHED;
            } else {
            PG8_LDB(B0, 0, 0); PG8_SCHED; PG8_LDA(At, 0, 0); PG8_STAGE(PG8_SA(1, 1), a1 + hstep, voffA);
            PG8_WAIT_L(8); PG8_BAR; PG8_WAIT_L(0); PG8_MMA(0, 0, At, B0); PG8_BAR; PG8_SCHED;
            PG8_LDB(B1, 0, 1); PG8_STAGE(PG8_SB(0, 0), b2, voffB);
            PG8_BAR; PG8_WAIT_L(0); PG8_MMA(0, 1, At, B1); PG8_BAR;
            PG8_LDA(At, 0, 1); PG8_STAGE(PG8_SA(0, 0), a2, voffA);
            PG8_BAR; PG8_WAIT_L(0); PG8_MMA(1, 0, At, B0); PG8_BAR; PG8_SCHED;
            PG8_STAGE(PG8_SB(0, 1), b2 + hstep, voffB);
            PG8_WAIT_V(6); PG8_BAR; PG8_MMA(1, 1, At, B1); PG8_BAR;
            PG8_LDB(B0, 1, 0); PG8_SCHED; PG8_LDA(At, 1, 0); PG8_STAGE(PG8_SA(0, 1), a2 + hstep, voffA);
            PG8_WAIT_L(8); PG8_BAR; PG8_WAIT_L(0); PG8_MMA(0, 0, At, B0); PG8_BAR; PG8_SCHED;
            PG8_LDB(B1, 1, 1); PG8_STAGE(PG8_SB(1, 0), b3, voffB);
            PG8_BAR; PG8_WAIT_L(0); PG8_MMA(0, 1, At, B1); PG8_BAR;
            PG8_LDA(At, 1, 1); PG8_STAGE(PG8_SA(1, 0), a3, voffA);
            PG8_BAR; PG8_WAIT_L(0); PG8_MMA(1, 0, At, B0); PG8_BAR; PG8_SCHED;
            PG8_STAGE(PG8_SB(1, 1), b3 + hstep, voffB);
            PG8_WAIT_V(6); PG8_BAR; PG8_MMA(1, 1, At, B1); PG8_BAR;
            }
        }
        if constexpr (ALIGN_EPI) { if (wr == 0) PG8_BAR; }
        E(acc, cur, wr, wc, fr, fq, lane);
        if (!has_next) break;
#pragma unroll
        for (int a = 0; a < 2; ++a)
#pragma unroll
            for (int b = 0; b < 2; ++b)
#pragma unroll
                for (int m = 0; m < 4; ++m)
#pragma unroll
                    for (int n = 0; n < 2; ++n) acc[a][b][m][n] = (f32x4){0.f, 0.f, 0.f, 0.f};
        cur = nxt; cA = nA; cB = nB; ++ui;
        if constexpr (ALIGN_EPI) { if (wr == 1) PG8_BAR; }
    }
    PG8_WAIT_V(0);
    if constexpr (!ALIGN_EPI) { if (wr == 0) PG8_BAR; }
    PG8_BAR;
#undef PG8_SA
#undef PG8_SB
#undef PG8_STAGE
#undef PG8_LDA
#undef PG8_LDB
#undef PG8_MMA
#undef PG8_WAIT_V
#undef PG8_WAIT_L
#undef PG8_BAR
#undef PG8_SCHED
}
}

namespace att {
constexpr int PITCH = DIN;
#define SBAR() __builtin_amdgcn_sched_barrier(0)
#define KSW(row, colB) ((row) * 128 + ((colB) ^ ((((row) >> 1) & 7) << 4)))
__device__ __forceinline__ int crow(int r, int hi) { return (r & 3) + 8 * (r >> 2) + 4 * hi; }
__device__ __forceinline__ int rel_bucket(int rel) {
    const int n = rel < 0 ? -rel : rel; int v;
    if (n < 8) v = n; else { v = 2 + (31 - __clz(n * n)); v = v > 15 ? 15 : v; }
    return (rel > 0 ? 16 : 0) + v;
}
constexpr float THR = 5.0f;

__device__ __forceinline__ void partialSM(f32x16& p0, f32x16& p1, float off, float& m_reg, float& alpha) {
    float pmax = p0[0];
#pragma unroll
    for (int r = 1; r < 16; ++r) pmax = fmaxf(pmax, p0[r]);
#pragma unroll
    for (int r = 0; r < 16; ++r) pmax = fmaxf(pmax, p1[r]);
    { auto rr = __builtin_amdgcn_permlane32_swap(__float_as_uint(pmax), __float_as_uint(pmax), false, false);
      pmax = fmaxf(__uint_as_float(rr[0]), __uint_as_float(rr[1])); }
    pmax += off;
    if (__builtin_expect(__all(pmax - m_reg <= THR), 1)) { alpha = 1.f; }
    else { const float mn = fmaxf(m_reg, pmax); alpha = __builtin_amdgcn_exp2f(m_reg - mn); m_reg = mn; }
    const float sub = off - m_reg;
#pragma unroll
    for (int r = 0; r < 16; ++r) { p0[r] += sub; p1[r] += sub; }
#pragma unroll
    for (int r = 0; r < 16; ++r) p0[r] = __builtin_amdgcn_exp2f(p0[r]);
}
__device__ __forceinline__ void finishSM(f32x16& p0, f32x16& p1, float alpha, float& l_reg, bf16x8& pa0, bf16x8& pa1, bf16x8& pa2, bf16x8& pa3) {
#pragma unroll
    for (int r = 0; r < 16; ++r) p1[r] = __builtin_amdgcn_exp2f(p1[r]);
    float ps = 0;
#pragma unroll
    for (int r = 0; r < 16; ++r) ps += p0[r];
#pragma unroll
    for (int r = 0; r < 16; ++r) ps += p1[r];
    { auto rr = __builtin_amdgcn_permlane32_swap(__float_as_uint(ps), __float_as_uint(ps), false, false);
      ps = __uint_as_float(rr[0]) + __uint_as_float(rr[1]); }
    l_reg = l_reg * alpha + ps;
#define PK4(P, BASE, OUT) do { unsigned a0 = cvtpk(P[BASE + 0], P[BASE + 1]), a1 = cvtpk(P[BASE + 2], P[BASE + 3]);   \
    unsigned b0 = cvtpk(P[BASE + 4], P[BASE + 5]), b1 = cvtpk(P[BASE + 6], P[BASE + 7]);                              \
    auto r0 = __builtin_amdgcn_permlane32_swap(a0, b0, false, false); auto r1 = __builtin_amdgcn_permlane32_swap(a1, b1, false, false); \
    u32x4 w = {r0[0], r1[0], r0[1], r1[1]}; OUT = __builtin_bit_cast(bf16x8, w); } while (0)
    PK4(p0, 0, pa0); PK4(p0, 8, pa1); PK4(p1, 0, pa2); PK4(p1, 8, pa3);
#undef PK4
}
__device__ __forceinline__ void qkt64(f32x16& p0, f32x16& p1, const LAS char* Ks, const bf16x8* qr, int r32, int hi) {
#pragma unroll
    for (int d0 = 0; d0 < 4; ++d0) { const int cb = (d0 * 16 + hi * 8) * 2;
        const bf16x8 b0 = *(const LAS bf16x8*)(Ks + KSW(r32, cb));
        const bf16x8 b1 = *(const LAS bf16x8*)(Ks + KSW(r32, cb) + 4096);
        p0 = __builtin_amdgcn_mfma_f32_32x32x16_bf16(b0, qr[d0], p0, 0, 0, 0); p1 = __builtin_amdgcn_mfma_f32_32x32x16_bf16(b1, qr[d0], p1, 0, 0, 0); }
}
template <int NCB> __device__ __forceinline__ int v_st(int k, int c) { const int kk = (k & ~0xC) | ((k & 4) << 1) | ((k & 8) >> 1); return ((kk >> 3) * NCB + (c >> 5)) * 512 + ((kk & 7) * 32 + (c & 31)) * 2; }
__device__ __forceinline__ int v_rd_base(int lane) { return ((lane & 3) << 3) | (((lane >> 2) & 3) << 6) | (((lane >> 4) & 1) << 5) | (((lane >> 5) & 1) << 8); }
template <int NCB> constexpr int v_rd_off(int d0, int ks, int half) { return d0 * 512 + ks * (NCB * 1024) + half * (NCB * 512); }
template <int OFF> __device__ __forceinline__ s16x4 tr_read(int vb) { s16x4 r; asm volatile("ds_read_b64_tr_b16 %0, %1 offset:%2" : "=&v"(r) : "v"(vb), "i"(OFF) : "memory"); return r; }
template <int NCB, int D0> __device__ __forceinline__ void pv_one(f32x16& od, int vb, bf16x8 pa0, bf16x8 pa1, bf16x8 pa2, bf16x8 pa3) {
    const s16x4 l0 = tr_read<v_rd_off<NCB>(D0, 0, 0)>(vb), h0 = tr_read<v_rd_off<NCB>(D0, 0, 1)>(vb), l1 = tr_read<v_rd_off<NCB>(D0, 1, 0)>(vb), h1 = tr_read<v_rd_off<NCB>(D0, 1, 1)>(vb);
    const s16x4 l2 = tr_read<v_rd_off<NCB>(D0, 2, 0)>(vb), h2 = tr_read<v_rd_off<NCB>(D0, 2, 1)>(vb), l3 = tr_read<v_rd_off<NCB>(D0, 3, 0)>(vb), h3 = tr_read<v_rd_off<NCB>(D0, 3, 1)>(vb);
    asm volatile("s_waitcnt lgkmcnt(0)" ::: "memory"); SBAR();
#define PK(L, H) (bf16x8){L[0], L[1], L[2], L[3], H[0], H[1], H[2], H[3]}
    od = __builtin_amdgcn_mfma_f32_32x32x16_bf16(pa0, PK(l0, h0), od, 0, 0, 0);
    od = __builtin_amdgcn_mfma_f32_32x32x16_bf16(pa1, PK(l1, h1), od, 0, 0, 0);
    od = __builtin_amdgcn_mfma_f32_32x32x16_bf16(pa2, PK(l2, h2), od, 0, 0, 0);
    od = __builtin_amdgcn_mfma_f32_32x32x16_bf16(pa3, PK(l3, h3), od, 0, 0, 0);
#undef PK
}

constexpr int D_V = 0, D_K = 49152, D_WS = 81920, D_TB = 83968, D_ST = 86016, D_END = D_ST + 65536;
constexpr int NT = SEQ / 64;

typedef short v4i16_t __attribute__((ext_vector_type(4)));
__device__ __forceinline__ s16x4 vtr(const LAS char* p) { return __builtin_bit_cast(s16x4, __builtin_amdgcn_ds_read_tr16_b64_v4i16((LAS v4i16_t*)p)); }
#define PIN(x) asm volatile("" : "+v"(x))
#define MX3(a, b, c) __builtin_fmaxf(__builtin_fmaxf((a), (b)), (c))
#define EX(v) __builtin_amdgcn_exp2f(v)
#define MFMA32(a, b, c) __builtin_amdgcn_mfma_f32_32x32x16_bf16((a), (b), (c), 0, 0, 0)
constexpr float THRL = 6.0f;
__device__ __forceinline__ float rowmax32(const f32x16& C0, const f32x16& C1) {
    float a = MX3(C0[0], C0[1], C1[0]), b = MX3(C0[2], C0[3], C1[1]); a = MX3(a, C1[2], C1[3]);
#pragma unroll
    for (int r = 4; r < 16; r += 4) { a = MX3(a, C0[r], C0[r + 1]); b = MX3(b, C0[r + 2], C0[r + 3]); a = MX3(a, C1[r], C1[r + 1]); b = MX3(b, C1[r + 2], C1[r + 3]); }
    float rm = __builtin_fmaxf(a, b);
    auto rr = __builtin_amdgcn_permlane32_swap(__float_as_uint(rm), __float_as_uint(rm), false, false);
    return __builtin_fmaxf(__uint_as_float(rr[0]), __uint_as_float(rr[1]));
}
__device__ __forceinline__ void diff_pass(f32x16 (&o)[4], float& l_out, const bf16_t* Qw, const bf16_t* __restrict__ Kh, const bf16_t* __restrict__ Vh,
                                          LAS char* lds, int qa, float cL, float cR) {
    const int tid = threadIdx.x, wid = __builtin_amdgcn_readfirstlane(tid >> 6), lane = tid & 63, r32 = lane & 31, hi = lane >> 5;
    LAS char* V_lds = lds + D_V; LAS char* K_lds = lds + D_K;
    LAS float* wsf = (LAS float*)(lds + D_WS) + wid * 64 + 32;
    const LAS float* tb = (const LAS float*)(lds + D_TB);
#pragma unroll
    for (int d = 0; d < 4; ++d) o[d] = f32x16{};
    bf16x8 qr[4];
#pragma unroll
    for (int d0 = 0; d0 < 4; ++d0) qr[d0] = *(const bf16x8*)(Qw + d0 * 16);
#pragma unroll
    for (int d0 = 0; d0 < 4; ++d0) PIN(qr[d0]);
    const bf16_t* ksrc; const bf16_t* vsrc0;
    { const int row = wid * 8 + (lane >> 3), pos = lane & 7;
      ksrc = Kh + (long)row * PITCH + ((pos ^ ((row >> 1) & 7)) * 8);
      vsrc0 = Vh + (long)row * PITCH + ((pos ^ (((row >> 1) & 1) << 2)) * 8); }
    const LAS char* kq[4];
    { const int sw = (r32 >> 1) & 7;
#pragma unroll
      for (int d0 = 0; d0 < 4; ++d0) kq[d0] = K_lds + r32 * 128 + (((2 * d0 + hi) ^ sw) << 4); }
    const LAS char* vpe; const LAS char* vpo;
    { const int q = (lane & 15) >> 2, p = lane & 3, g = (lane >> 4) & 1, sw = (q >> 1) & 1;
      vpe = V_lds + (4 * hi + q) * 128 + sw * 64 + g * 32 + p * 8; vpo = V_lds + (4 * hi + q) * 128 + (sw ^ 1) * 64 + g * 32 + p * 8; }
#define DMA_K(j, ko) __builtin_amdgcn_global_load_lds((const unsigned*)(ksrc + (long)(j) * 64 * PITCH), (LAS unsigned*)(K_lds + (ko) + wid * 1024), 16, 0, 0)
#define DMA_V(j, vo) do { __builtin_amdgcn_global_load_lds((const unsigned*)(vsrc0 + (long)(j) * 64 * PITCH), (LAS unsigned*)(V_lds + (vo) + wid * 1024), 16, 0, 0); \
    __builtin_amdgcn_global_load_lds((const unsigned*)(vsrc0 + 64 + (long)(j) * 64 * PITCH), (LAS unsigned*)(V_lds + (vo) + 8192 + wid * 1024), 16, 0, 0); } while (0)
#define WAIT_BAR(N) do { asm volatile("s_waitcnt vmcnt(" #N ") lgkmcnt(0)" ::: "memory"); __builtin_amdgcn_s_barrier(); asm volatile("" ::: "memory"); } while (0)
    float mhat, l_reg = 0.f; bool resc = false;
    f32x16 pA0, pA1, pB0, pB1;
    bf16x8 kf[4]; s16x4 vlo[6], vhi[6]; u32x4 pw0, pw1, pw2, pw3;
#define KRD(i, KS) do { kf[(i) & 3] = *(const LAS bf16x8*)(kq[(i) >> 1] + (KS) + ((i) & 1) * 4096); } while (0)
    WAIT_BAR(0);
    DMA_K(0, 0); DMA_K(1, 8192); DMA_V(0, 0); DMA_K(2, 16384); DMA_K(3, 24576); DMA_V(1, 16384);
    WAIT_BAR(7);
    {
        float off0 = 0.f; const int d_ = -qa;
        if (d_ <= -154) { pA0 = f32x16{}; pA1 = f32x16{}; off0 = cL; }
        else { const LAS float* t_ = tb + (d_ + 256 + 4 * hi - r32);
#pragma unroll
            for (int r = 0; r < 16; ++r) { pA0[r] = t_[(r & 3) + 8 * (r >> 2)]; pA1[r] = t_[32 + (r & 3) + 8 * (r >> 2)]; } }
#pragma unroll
        for (int d0 = 0; d0 < 4; ++d0) { const bf16x8 k0_ = *(const LAS bf16x8*)(kq[d0]), k1_ = *(const LAS bf16x8*)(kq[d0] + 4096);
            pA0 = MFMA32(k0_, qr[d0], pA0); pA1 = MFMA32(k1_, qr[d0], pA1); }
        const float rm = rowmax32(pA0, pA1);
        mhat = rm + off0;
#pragma unroll
        for (int r = 0; r < 16; ++r) { pA0[r] = EX(pA0[r] - rm); pA1[r] = EX(pA1[r] - rm); }
    }
    WAIT_BAR(3);
    KRD(0, 8192); KRD(1, 8192); KRD(2, 8192); KRD(3, 8192);
#define PKW(P, B) cvtpk(P[B], P[(B) + 1])
#define PAF(k) __builtin_bit_cast(bf16x8, pw##k)
#define VFR(i) (bf16x8){vlo[(i) % 6][0], vlo[(i) % 6][1], vlo[(i) % 6][2], vlo[(i) % 6][3], vhi[(i) % 6][0], vhi[(i) % 6][1], vhi[(i) % 6][2], vhi[(i) % 6][3]}
#define VRD(i, VS) do { const LAS char* vq_ = ((((i) & 3) & 1) ? vpo : vpe) + (VS) + (((i) & 3) >> 1) * 8192 + ((i) >> 2) * 2048; vlo[(i) % 6] = vtr(vq_); vhi[(i) % 6] = vtr(vq_ + 1024); } while (0)
#define GAPA(g, CC, QI, KB, A0, A1, A2, A3, W0, W1, PW) do { CC = MFMA32(kf[(g) & 3], qr[QI], CC); if ((g) + 4 < 8) KRD((g) + 4, KB); sacc += A0; sacc += A1; sacc += A2; sacc += A3; PIN(sacc); W0; W1; PIN(PW); SBAR(); } while (0)
#define GAPB(i, X, B, VB, KN, PRE) do { o[(i) & 3] = MFMA32(PAF_SEL(i), VFR(i), o[(i) & 3]); X[B] = EX(X[B]); X[(B) + 1] = EX(X[(B) + 1]); PIN(X); if ((i) + 5 < 16) VRD((i) + 5, VB); \
    if ((PRE) && (i) >= 8 && (i) < 12) KRD((i) - 8, KN); SBAR(); } while (0)
#define PAF_SEL(i) (((i) >> 2) == 0 ? PAF(0) : ((i) >> 2) == 1 ? PAF(1) : ((i) >> 2) == 2 ? PAF(2) : PAF(3))
#define STEP(C0, C1, P0, P1, t, KB, VB, KN, PRE) do { SBAR(); \
    { const int d_ = (t) * 64 - qa; \
      if (d_ > -154 && d_ < 122) { const LAS float* t_ = tb + (d_ + 256 + 4 * hi - r32); \
        _Pragma("unroll") for (int r = 0; r < 16; ++r) { C0[r] = t_[(r & 3) + 8 * (r >> 2)] - mhat; C1[r] = t_[32 + (r & 3) + 8 * (r >> 2)] - mhat; } } \
      else { const float cs_ = (d_ < 0 ? cL : cR) - mhat; _Pragma("unroll") for (int r = 0; r < 16; ++r) { C0[r] = cs_; C1[r] = cs_; } } } \
    PIN(C0); PIN(C1); SBAR(); \
    float sacc = (P0[0] + P0[1]); \
    GAPA(0, C0, 0, KB, P0[2],  P0[3],  P0[4],  P0[5],  pw0[0] = PKW(P0, 0),  pw0[1] = PKW(P0, 2),  pw0); \
    GAPA(1, C1, 0, KB, P0[6],  P0[7],  P0[8],  P0[9],  pw0[2] = PKW(P0, 4),  pw0[3] = PKW(P0, 6),  pw0); \
    GAPA(2, C0, 1, KB, P0[10], P0[11], P0[12], P0[13], pw1[0] = PKW(P0, 8),  pw1[1] = PKW(P0, 10), pw1); \
    GAPA(3, C1, 1, KB, P0[14], P0[15], P1[0],  P1[1],  pw1[2] = PKW(P0, 12), pw1[3] = PKW(P0, 14), pw1); \
    GAPA(4, C0, 2, KB, P1[2],  P1[3],  P1[4],  P1[5],  pw2[0] = PKW(P1, 0),  pw2[1] = PKW(P1, 2),  pw2); \
    GAPA(5, C1, 2, KB, P1[6],  P1[7],  P1[8],  P1[9],  pw2[2] = PKW(P1, 4),  pw2[3] = PKW(P1, 6),  pw2); \
    GAPA(6, C0, 3, KB, P1[10], P1[11], P1[12], P1[13], pw3[0] = PKW(P1, 8),  pw3[1] = PKW(P1, 10), pw3); \
    GAPA(7, C1, 3, KB, P1[14], P1[15], 0.f,    0.f,    pw3[2] = PKW(P1, 12), pw3[3] = PKW(P1, 14), pw3); \
    l_reg += sacc; \
    VRD(0, VB); VRD(1, VB); VRD(2, VB); VRD(3, VB); VRD(4, VB); \
    { const float rm = rowmax32(C0, C1); resc = false; \
      if (__builtin_expect(__any(rm > THRL), 0)) { const float dl = __builtin_fmaxf(rm, 0.f); mhat += dl; \
        _Pragma("unroll") for (int r = 0; r < 16; ++r) { C0[r] -= dl; C1[r] -= dl; } \
        const float f = EX(-dl); l_reg *= f; if (hi == 0) wsf[r32] = f; resc = true; } } \
    SBAR(); \
    GAPB(0, C0, 0, VB, KN, PRE);  GAPB(1, C0, 2, VB, KN, PRE);  GAPB(2, C0, 4, VB, KN, PRE);   GAPB(3, C0, 6, VB, KN, PRE); \
    GAPB(4, C0, 8, VB, KN, PRE);  GAPB(5, C0, 10, VB, KN, PRE); GAPB(6, C0, 12, VB, KN, PRE);  GAPB(7, C0, 14, VB, KN, PRE); \
    GAPB(8, C1, 0, VB, KN, PRE);  GAPB(9, C1, 2, VB, KN, PRE);  GAPB(10, C1, 4, VB, KN, PRE);  GAPB(11, C1, 6, VB, KN, PRE); \
    GAPB(12, C1, 8, VB, KN, PRE); GAPB(13, C1, 10, VB, KN, PRE); GAPB(14, C1, 12, VB, KN, PRE); GAPB(15, C1, 14, VB, KN, PRE); \
    } while (0)
#define RESC() do { if (resc) { asm volatile("s_waitcnt lgkmcnt(0)" ::: "memory"); \
    _Pragma("unroll") for (int d = 0; d < 4; ++d) _Pragma("unroll") for (int r = 0; r < 16; ++r) o[d][r] *= wsf[crow(r, hi)]; } } while (0)
    int ks_cur = 8192, ks_n1 = 16384, ks_n3 = 0;
    int vs_prev = 0, vs_next = 32768;
#define ROT() do { ks_cur = (ks_cur + 8192) & 24576; ks_n1 = (ks_n1 + 8192) & 24576; ks_n3 = (ks_n3 + 8192) & 24576; vs_prev = vs_prev == 32768 ? 0 : vs_prev + 16384; vs_next = vs_next == 32768 ? 0 : vs_next + 16384; } while (0)
#define STEPX(C0, C1, P0, P1, t, PRE) STEP(C0, C1, P0, P1, t, ks_cur, vs_prev, ks_n1, PRE)
#pragma unroll 1
    for (int t = 1; t + 4 < NT; t += 2) {
        DMA_K(t + 3, ks_n3); DMA_V(t + 1, vs_next);
        STEPX(pB0, pB1, pA0, pA1, t, true);
        WAIT_BAR(3); RESC(); ROT();
        DMA_K(t + 4, ks_n3); DMA_V(t + 2, vs_next);
        STEPX(pA0, pA1, pB0, pB1, t + 1, true);
        WAIT_BAR(3); RESC(); ROT();
    }
    DMA_V(NT - 2, vs_next);
    STEPX(pB0, pB1, pA0, pA1, NT - 3, true);
    WAIT_BAR(2); RESC(); ROT();
    DMA_V(NT - 1, vs_next);
    STEPX(pA0, pA1, pB0, pB1, NT - 2, true);
    WAIT_BAR(2); RESC(); ROT();
    STEPX(pB0, pB1, pA0, pA1, NT - 1, false);
    WAIT_BAR(0); RESC(); ROT();
    { float sacc = 0.f;
#pragma unroll
      for (int r = 0; r < 16; ++r) sacc += pB0[r];
#pragma unroll
      for (int r = 0; r < 16; ++r) sacc += pB1[r];
      l_reg += sacc;
      pw0 = (u32x4){PKW(pB0, 0), PKW(pB0, 2), PKW(pB0, 4), PKW(pB0, 6)}; pw1 = (u32x4){PKW(pB0, 8), PKW(pB0, 10), PKW(pB0, 12), PKW(pB0, 14)};
      pw2 = (u32x4){PKW(pB1, 0), PKW(pB1, 2), PKW(pB1, 4), PKW(pB1, 6)}; pw3 = (u32x4){PKW(pB1, 8), PKW(pB1, 10), PKW(pB1, 12), PKW(pB1, 14)};
      SBAR();
#define DRAIN(i) do { VRD(i, vs_prev); o[(i) & 3] = MFMA32(PAF_SEL(i), VFR(i), o[(i) & 3]); } while (0)
      DRAIN(0); DRAIN(1); DRAIN(2); DRAIN(3); DRAIN(4); DRAIN(5); DRAIN(6); DRAIN(7); DRAIN(8); DRAIN(9); DRAIN(10); DRAIN(11); DRAIN(12); DRAIN(13); DRAIN(14); DRAIN(15);
#undef DRAIN
    }
    { auto rr = __builtin_amdgcn_permlane32_swap(__float_as_uint(l_reg), __float_as_uint(l_reg), false, false); l_out = __uint_as_float(rr[0]) + __uint_as_float(rr[1]); }
#undef DMA_K
#undef DMA_V
#undef WAIT_BAR
#undef ROT
#undef KRD
#undef PKW
#undef PAF
#undef VFR
#undef VRD
#undef GAPA
#undef GAPB
#undef PAF_SEL
#undef STEP
#undef STEPX
#undef RESC
}

__device__ __forceinline__ void diff_unit(int b, int h, int qb, const bf16_t* P, bf16_t* O, LAS char* lds, float lam, const float* relb) {
    const int tid = threadIdx.x, wid = __builtin_amdgcn_readfirstlane(tid >> 6), lane = tid & 63, r32 = lane & 31, hi = lane >> 5;
    const long rowbase = (long)b * SEQ; const int q0 = qb * 256, qa = q0 + wid * 32;
    LAS float* tb = (LAS float*)(lds + D_TB);
    LAS float* li_l = (LAS float*)(lds + D_WS) + wid * 64;
    tb[tid] = relb[rel_bucket(tid - 256) * NBH + h] * LOG2E;
    const float cL = relb[15 * NBH + h] * LOG2E, cR = relb[31 * NBH + h] * LOG2E;
    const bf16_t* Qrow = P + (rowbase + qa + r32) * PITCH + C_DQ + h * 128 + hi * 8;
    const bf16_t* Kh = P + rowbase * PITCH + C_DK + h * 128;
    const bf16_t* Vh = P + rowbase * PITCH + C_DV + h * 128;
    LAS u32x4* stash = (LAS u32x4*)(lds + D_ST + wid * 8192);
    f32x16 o[4]; float l_reg;
#pragma unroll 1
    for (int pass = 0; pass < 2; ++pass) {
        const int mo = pass == 0 ? 64 : 0;
        diff_pass(o, l_reg, Qrow + mo, Kh + mo, Vh, lds, qa, cL, cR);
        int ln = lane; asm volatile("" : "+v"(ln));
        const int r32e = ln & 31, hie = ln >> 5;
        if (hie == 0) li_l[r32e] = l_reg; asm volatile("s_waitcnt lgkmcnt(0)" ::: "memory");
        if (pass == 0) {
            float rli[16];
#pragma unroll
            for (int r = 0; r < 16; ++r) rli[r] = -lam * __builtin_amdgcn_rcpf(li_l[crow(r, hie)]);
#pragma unroll
            for (int d0 = 0; d0 < 4; ++d0) {
                u32x4 w0, w1;
                w0.x = cvtpk(o[d0][0] * rli[0], o[d0][1] * rli[1]); w0.y = cvtpk(o[d0][2] * rli[2], o[d0][3] * rli[3]); w0.z = cvtpk(o[d0][4] * rli[4], o[d0][5] * rli[5]); w0.w = cvtpk(o[d0][6] * rli[6], o[d0][7] * rli[7]);
                w1.x = cvtpk(o[d0][8] * rli[8], o[d0][9] * rli[9]); w1.y = cvtpk(o[d0][10] * rli[10], o[d0][11] * rli[11]); w1.z = cvtpk(o[d0][12] * rli[12], o[d0][13] * rli[13]); w1.w = cvtpk(o[d0][14] * rli[14], o[d0][15] * rli[15]);
                stash[(2 * d0) * 64 + ln] = w0; stash[(2 * d0 + 1) * 64 + ln] = w1;
            }
        } else {
            float rli[16], ssq[16];
#pragma unroll
            for (int r = 0; r < 16; ++r) { rli[r] = __builtin_amdgcn_rcpf(li_l[crow(r, hie)]); ssq[r] = 0.f; }
#pragma unroll
            for (int d0 = 0; d0 < 4; ++d0) {
                const u32x4 w0 = stash[(2 * d0) * 64 + ln], w1 = stash[(2 * d0 + 1) * 64 + ln];
                const unsigned ww[8] = {w0.x, w0.y, w0.z, w0.w, w1.x, w1.y, w1.z, w1.w};
#pragma unroll
                for (int r = 0; r < 16; ++r) { const float c = __uint_as_float((r & 1) ? (ww[r >> 1] & 0xffff0000u) : (ww[r >> 1] << 16));
                    const float x = fmaf(o[d0][r], rli[r], c); o[d0][r] = x; ssq[r] = fmaf(x, x, ssq[r]); }
            }
            asm volatile("s_waitcnt lgkmcnt(0)" ::: "memory");
#pragma unroll
            for (int r = 0; r < 16; ++r) { float s = ssq[r];
                s += __shfl_xor(s, 1); s += __shfl_xor(s, 2); s += __shfl_xor(s, 4); s += __shfl_xor(s, 8); s += __shfl_xor(s, 16);
                ssq[r] = __builtin_amdgcn_rsqf(s * (1.0f / 128.0f) + EPS); }
            LAS bf16_t* stg = (LAS bf16_t*)(lds + D_ST + wid * 8192);
#pragma unroll
            for (int r = 0; r < 16; ++r) { const int orow = crow(r, hie);
#pragma unroll
                for (int d0 = 0; d0 < 4; ++d0) stg[orow * 128 + d0 * 32 + r32e] = (bf16_t)(cvtpk(o[d0][r] * ssq[r], 0.f) & 0xffffu); }
            asm volatile("s_waitcnt lgkmcnt(0)" ::: "memory");
            bf16_t* Ow = O + (rowbase + qa + (ln >> 4)) * DM + h * 128 + (ln & 15) * 8;
            const LAS bf16_t* sl = stg + (ln >> 4) * 128 + (ln & 15) * 8;
#pragma unroll
            for (int i = 0; i < 8; ++i) { const u32x4 v = *(const LAS u32x4*)(sl + i * 512); *(u32x4*)(Ow + (long)i * 4 * DM) = v; }
        }
    }
    asm volatile("s_waitcnt lgkmcnt(0)" ::: "memory"); __syncthreads();
}

constexpr int W_K = 0, W_V = 49152, W_TB = 98304, W_WS = 106496, W_OST = 108544, W_END = W_OST + 32768;
__device__ __forceinline__ void win_unit(int b, int kvh, int qb, const bf16_t* P, bf16_t* O, LAS char* lds, const float* relb, const float* sink) {
    const int tid = threadIdx.x, wid = __builtin_amdgcn_readfirstlane(tid >> 6), lane = tid & 63, r32 = lane & 31, hi = lane >> 5;
    const long rowbase = (long)b * SEQ; const int q0 = qb * 128, kbase = q0 - 128;
    LAS float* tbw = (LAS float*)(lds + W_TB);
#pragma unroll
    for (int e = 0; e < 4; ++e) { const int idx = tid + e * 512, g = idx >> 9, rel = (idx & 511) - 256;
        tbw[idx] = (rel >= -128 && rel <= 128) ? (relb[rel_bucket(rel) * NBH + 4 + 4 * kvh + g] - sink[4 * kvh + g]) * LOG2E : -1e30f; }
    { int tl = tid; asm volatile("" : "+v"(tl));
      const int kr = tl >> 3, kc = (tl & 7) * 8, kst = KSW(kr, kc * 2), vst = v_st<2>(kr, kc);
      const bf16_t* Kh = P + rowbase * PITCH + C_WK + kvh * 64; const bf16_t* Vh = P + rowbase * PITCH + C_WV + kvh * 64;
      bf16x8 kreg[6], vreg[6];
#pragma unroll
      for (int t = 0; t < 6; ++t) { const int k0 = kbase + 64 * t; if (k0 >= 0 && k0 < SEQ) { kreg[t] = *(const bf16x8*)(&Kh[(long)(k0 + kr) * PITCH + kc]); vreg[t] = *(const bf16x8*)(&Vh[(long)(k0 + kr) * PITCH + kc]); } }
#pragma unroll
      for (int t = 0; t < 6; ++t) { const int k0 = kbase + 64 * t; if (k0 >= 0 && k0 < SEQ) { *(LAS bf16x8*)(lds + W_K + t * 8192 + kst) = kreg[t]; *(LAS bf16x8*)(lds + W_V + t * 8192 + vst) = vreg[t]; } }
    }
    __syncthreads();
    const int g = wid >> 1, hq = 4 * kvh + g;
    LAS float* li_l = (LAS float*)(lds + W_WS) + wid * 64;
    const LAS float* tbg = tbw + g * 512;
    const int vbw = (int)(uintptr_t)(lds + W_V) + v_rd_base(lane);
#pragma unroll 1
    for (int jb = 0; jb < 2; ++jb) {
        const int ql = 64 * (wid & 1) + 32 * jb;
        const bf16_t* Qw = P + (rowbase + q0 + ql + r32) * PITCH + C_WQ + hq * 64 + hi * 8;
        bf16x8 qr[4];
#pragma unroll
        for (int d0 = 0; d0 < 4; ++d0) qr[d0] = *(const bf16x8*)(Qw + d0 * 16);
        float l_reg = 0.f;
        f32x16 o[2]; o[0] = f32x16{}; o[1] = f32x16{};
        const int t_lo = ql >> 6;
#pragma unroll 1
        for (int t = t_lo; t < t_lo + 5; ++t) {
            const int k0 = kbase + 64 * t; if (k0 < 0 || k0 >= SEQ) continue;
            const int d_ = 64 * t - 128 - ql;
            const LAS float* t_ = tbg + (d_ + 256 + 4 * hi - r32);
            f32x16 p0, p1;
#pragma unroll
            for (int r = 0; r < 16; ++r) { p0[r] = t_[(r & 3) + 8 * (r >> 2)]; p1[r] = t_[32 + (r & 3) + 8 * (r >> 2)]; }
            qkt64(p0, p1, lds + W_K + t * 8192, qr, r32, hi);
#pragma unroll
            for (int r = 0; r < 16; ++r) { p0[r] = __builtin_amdgcn_exp2f(p0[r]); p1[r] = __builtin_amdgcn_exp2f(p1[r]); }
            bf16x8 pa0, pa1, pa2, pa3;
            {
                float ps = 0;
#pragma unroll
                for (int r = 0; r < 16; ++r) ps += p0[r];
#pragma unroll
                for (int r = 0; r < 16; ++r) ps += p1[r];
                l_reg += ps;
#define PK4(Pv, BASE, OUT) do { unsigned a0 = cvtpk(Pv[BASE + 0], Pv[BASE + 1]), a1 = cvtpk(Pv[BASE + 2], Pv[BASE + 3]);   \
    unsigned b0 = cvtpk(Pv[BASE + 4], Pv[BASE + 5]), b1 = cvtpk(Pv[BASE + 6], Pv[BASE + 7]);                              \
    auto r0 = __builtin_amdgcn_permlane32_swap(a0, b0, false, false); auto r1 = __builtin_amdgcn_permlane32_swap(a1, b1, false, false); \
    u32x4 w = {r0[0], r1[0], r0[1], r1[1]}; OUT = __builtin_bit_cast(bf16x8, w); } while (0)
                PK4(p0, 0, pa0); PK4(p0, 8, pa1); PK4(p1, 0, pa2); PK4(p1, 8, pa3);
#undef PK4
            }
            const int vb = vbw + t * 8192;
            pv_one<2, 0>(o[0], vb, pa0, pa1, pa2, pa3); pv_one<2, 1>(o[1], vb, pa0, pa1, pa2, pa3);
        }
        { auto rr = __builtin_amdgcn_permlane32_swap(__float_as_uint(l_reg), __float_as_uint(l_reg), false, false); l_reg = 1.0f + __uint_as_float(rr[0]) + __uint_as_float(rr[1]); }
        int ln = lane; asm volatile("" : "+v"(ln));
        const int r32e = ln & 31, hie = ln >> 5;
        if (hie == 0) li_l[r32e] = l_reg; asm volatile("s_waitcnt lgkmcnt(0)" ::: "memory");
        float rli[16];
#pragma unroll
        for (int r = 0; r < 16; ++r) rli[r] = __builtin_amdgcn_rcpf(li_l[crow(r, hie)]);
        LAS bf16_t* stg = (LAS bf16_t*)(lds + W_OST + wid * 4096);
#pragma unroll
        for (int r = 0; r < 16; ++r) { const int orow = crow(r, hie);
#pragma unroll
            for (int d0 = 0; d0 < 2; ++d0) stg[orow * 64 + d0 * 32 + r32e] = (bf16_t)(cvtpk(o[d0][r] * rli[r], 0.f) & 0xffffu); }
        asm volatile("s_waitcnt lgkmcnt(0)" ::: "memory");
        bf16_t* Ow = O + (rowbase + q0 + ql + (ln >> 3)) * DM + 512 + hq * 64 + (ln & 7) * 8;
        const LAS bf16_t* sl = stg + (ln >> 3) * 64 + (ln & 7) * 8;
#pragma unroll
        for (int i = 0; i < 4; ++i) { const u32x4 v = *(const LAS u32x4*)(sl + i * 512); *(u32x4*)(Ow + (long)i * 8 * DM) = v; }
        asm volatile("s_waitcnt lgkmcnt(0)" ::: "memory");
    }
    asm volatile("s_waitcnt lgkmcnt(0)" ::: "memory"); __syncthreads();
}
#undef SBAR
#undef KSW
}

constexpr size_t MiB = 1u << 20;
constexpr size_t WS_CTL = 0, CTL_ZERO_BYTES = 64 * 1024;
constexpr size_t WS_W1 = 1 * MiB;
constexpr size_t WS_W2 = WS_W1 + (size_t)DIN * DM * 2;
constexpr size_t WS_W3 = WS_W2 + (size_t)DM * DM * 2;
constexpr size_t WS_W4 = WS_W3 + (size_t)2 * DFF * DM * 2;
constexpr size_t WS_SSQ = 24 * MiB;
constexpr size_t WS_XB = 28 * MiB;
constexpr size_t WS_RSTD1 = 27 * MiB;
constexpr size_t WS_FA = 25 * MiB;
constexpr size_t WS_X1Q = WS_XB;
constexpr int CW_WMAX = 8192;
constexpr size_t WS_OB = 340 * MiB;
constexpr size_t WS_PROJ = 124 * MiB;
constexpr size_t WS_X1B = 125 * MiB;
constexpr size_t WS_ACT = 222 * MiB;
constexpr size_t WS_END = WS_ACT + (size_t)NTOK * DFF * 2;
static_assert(CW_WMAX * 4 + 2 * DFF * 4 <= CTL_ZERO_BYTES && WS_SSQ + (size_t)NTOK * 16 <= WS_FA && WS_FA + (size_t)NTOK * 4 <= WS_RSTD1, "d_ws map");
static_assert(WS_W4 + (size_t)DM * DFF * 2 <= WS_SSQ && WS_SSQ + (size_t)NTOK * 64 <= WS_XB && WS_XB + (size_t)NTOK * DM * 2 <= WS_PROJ, "d_ws map");
static_assert(WS_X1B + (size_t)(NTOK + 256) * DM * 2 <= WS_ACT && WS_PROJ + (size_t)NTOK * DIN * 2 <= WS_OB && WS_OB + (size_t)NTOK * DM * 2 <= WS_END && WS_SSQ + (size_t)NTOK * 16 <= WS_RSTD1 && WS_RSTD1 + (size_t)NTOK * 4 <= WS_XB, "d_ws map");
constexpr int CW_BAR = 1024;

constexpr int RING_BYTES = 131072, EPX_OFF = RING_BYTES, LDS_BYTES = 163840, MISC_OFF = LDS_BYTES - 512;
static_assert(att::D_END <= MISC_OFF && att::W_END <= MISC_OFF && EPX_OFF + 22528 <= MISC_OFF, "LDS map");

typedef GAS unsigned gu32;
#define RLX_AGENT __ATOMIC_RELAXED, __HIP_MEMORY_SCOPE_AGENT
#define LDS_WAIT() asm volatile("s_waitcnt lgkmcnt(0)" ::: "memory")

#define XB_TMO      128
#define XB_XCNT(j)  (256  + 64 * (j))
#define XB_XSUB(j)  (1280 + 64 * (j))
#define XB_XGEN(j)  (2304 + 64 * (j))
#define XB_TOP      3328
#define XB_TOPGEN   3392
#define XCD_BAR_WORDS 3456
#define XB_SPIN_CAP (1u << 22)
__device__ __forceinline__ unsigned xb_ld(unsigned* p)              { return __hip_atomic_load(p, __ATOMIC_RELAXED, __HIP_MEMORY_SCOPE_AGENT); }
__device__ __forceinline__ unsigned xb_add(unsigned* p, unsigned v) { return __hip_atomic_fetch_add(p, v, __ATOMIC_RELAXED, __HIP_MEMORY_SCOPE_AGENT); }
__device__ __forceinline__ unsigned xb_xcc_id() { return (unsigned)__builtin_amdgcn_s_getreg((3 << 11) | 20) & 0xFu; }
#define XB_SPIN(cond, bar) do { unsigned _sp = 0; while (cond) { __builtin_amdgcn_s_sleep(1); \
    if ((++_sp & 255u) == 0u) { if (xb_ld(&(bar)[XB_TMO])) break; if (_sp > XB_SPIN_CAP) { atomicAdd(&(bar)[XB_TMO], 1u); break; } } } } while (0)
struct XcdBarrier { unsigned* bar; unsigned x; volatile LAS unsigned* st; };
__device__ __forceinline__ XcdBarrier xcd_barrier_post(unsigned* bar, volatile LAS unsigned* st) {
    XcdBarrier b; b.bar = bar; b.x = xb_xcc_id(); b.st = st;
    if (threadIdx.x == 0) (void)xb_add(&bar[XB_XCNT(b.x)], 1u);
    return b;
}
__device__ __forceinline__ void xcd_barrier_complete(unsigned* bar, unsigned x, unsigned& nloc, unsigned& nx) {
    const unsigned G = gridDim.x * gridDim.y * gridDim.z;
    unsigned sum, cnt, mine, sp = 0u;
    for (;;) {
        sum = 0u; cnt = 0u; mine = 0u;
#pragma unroll
        for (unsigned j = 0; j < 16; ++j) { const unsigned c = xb_ld(&bar[XB_XCNT(j)]); sum += c; cnt += (c > 0u) ? 1u : 0u; mine = (j == x) ? c : mine; }
        if (sum == G) break;
        __builtin_amdgcn_s_sleep(1);
        if ((++sp & 255u) == 0u) { if (xb_ld(&bar[XB_TMO])) break; if (sp > XB_SPIN_CAP) { atomicAdd(&bar[XB_TMO], 1u); break; } }
    }
    nloc = mine > 0u ? mine : 1u; nx = cnt > 0u ? cnt : 1u;
}
__device__ __forceinline__ void xcd_barrier(const XcdBarrier& b) {
    asm volatile("s_waitcnt vmcnt(0)" ::: "memory");
    __syncthreads();
    if (threadIdx.x == 0) {
        unsigned* bar = b.bar;
        __builtin_amdgcn_s_waitcnt(0);
        unsigned nloc = b.st[0], nx = b.st[1];
        if (nloc == 0u) { xcd_barrier_complete(bar, b.x, nloc, nx); b.st[0] = nloc; b.st[1] = nx; }
        const unsigned old = xb_add(&bar[XB_XSUB(b.x)], 1u);
        const unsigned gen = old / nloc;
        if (old + 1u == (gen + 1u) * nloc) {
            __builtin_amdgcn_fence(__ATOMIC_RELEASE, "agent");
            asm volatile("s_waitcnt vmcnt(0)" ::: "memory");
            const unsigned og = xb_add(&bar[XB_TOP], 1u);
            const unsigned tg = og / nx;
            if (og + 1u == (tg + 1u) * nx) xb_add(&bar[XB_TOPGEN], 1u);
            else XB_SPIN(xb_ld(&bar[XB_TOPGEN]) == tg, bar);
            __builtin_amdgcn_fence(__ATOMIC_ACQUIRE, "agent");
            xb_add(&bar[XB_XGEN(b.x)], 1u);
            asm volatile("s_waitcnt vmcnt(0)" ::: "memory");
        } else {
            XB_SPIN(xb_ld(&bar[XB_XGEN(b.x)]) == gen, bar);
            __builtin_amdgcn_fence(__ATOMIC_ACQUIRE, "agent");
            asm volatile("s_waitcnt vmcnt(0)" ::: "memory");
        }
    }
    __syncthreads();
}

__device__ __forceinline__ float wave_sum(float v) {
#pragma unroll
    for (int o = 1; o < 64; o <<= 1) v += __shfl_xor(v, o);
    return v;
}
__device__ __forceinline__ unsigned f2bf(float f) { unsigned u = __builtin_bit_cast(unsigned, f); return (u + 0x7fffu + ((u >> 16) & 1u)) >> 16; }
__device__ __forceinline__ unsigned pk2(float lo, float hi) { return f2bf(lo) | (f2bf(hi) << 16); }
__device__ __forceinline__ void transpose_item(const float* W, int ld, int cbase, int K, int k0, bf16_t* WT, int nrow0, const float* fold, int foldmask, float fscale, int foldlim, LAS float* scr, int lane) {
    float wv[32];
#pragma unroll
    for (int i = 0; i < 32; ++i) wv[i] = W[(size_t)(k0 + 2 * i + (lane >> 5)) * ld + cbase + (lane & 31)];
#pragma unroll
    for (int i = 0; i < 32; ++i) { const int kk = 2 * i + (lane >> 5), k = k0 + kk;
        float f = 1.f; if (fold != nullptr && k < foldlim) f = fold[k & foldmask] * fscale;
        scr[kk * 33 + (lane & 31)] = wv[i] * f; }
    LDS_WAIT(); asm volatile("" ::: "memory");
    const int c = lane & 7;
#pragma unroll
    for (int j = 0; j < 4; ++j) { const int n = (lane >> 3) + 8 * j; const LAS float* s = scr + (8 * c) * 33 + n;
        u32x4 o; o.x = pk2(s[0 * 33], s[1 * 33]); o.y = pk2(s[2 * 33], s[3 * 33]); o.z = pk2(s[4 * 33], s[5 * 33]); o.w = pk2(s[6 * 33], s[7 * 33]);
        *(u32x4*)(WT + (size_t)(nrow0 + n) * K + k0 + 8 * c) = o; }
    LDS_WAIT(); asm volatile("" ::: "memory");
}

__device__ __forceinline__ void absmax_item(const float* W, int ld, int cbase, int k0, unsigned* wmax, const float* fold, int lane) {
    float wv[32];
#pragma unroll
    for (int i = 0; i < 32; ++i) wv[i] = W[(size_t)(k0 + 2 * i + (lane >> 5)) * ld + cbase + (lane & 31)];
    float m = 0.f;
#pragma unroll
    for (int i = 0; i < 32; ++i) m = __builtin_fmaxf(m, __builtin_fabsf(wv[i] * fold[k0 + 2 * i + (lane >> 5)]));
    m = __builtin_fmaxf(m, __shfl_xor(m, 32));
    if (lane < 32) (void)__hip_atomic_fetch_max(wmax + lane, __float_as_uint(m), __ATOMIC_RELAXED, __HIP_MEMORY_SCOPE_AGENT);
}
__device__ __forceinline__ unsigned q4(float a, float b, float c, float d) {
    const unsigned ua = __float_as_uint(a + 12582912.0f), ub = __float_as_uint(b + 12582912.0f), uc = __float_as_uint(c + 12582912.0f), ud = __float_as_uint(d + 12582912.0f);
    return (ua & 0xffu) | ((ub & 0xffu) << 8) | ((uc & 0xffu) << 16) | (ud << 24);
}
__device__ __forceinline__ void quant_item(const float* W, int ld, int cbase, int K, int k0, signed char* WQ, int nrow0, const float* fold, const unsigned* wmax, LAS float* scr, int lane) {
    float wv[32];
#pragma unroll
    for (int i = 0; i < 32; ++i) wv[i] = W[(size_t)(k0 + 2 * i + (lane >> 5)) * ld + cbase + (lane & 31)];
    const float am = __uint_as_float(wmax[lane & 31]); const float inv = am > 0.f ? 127.0f / am : 0.f;
#pragma unroll
    for (int i = 0; i < 32; ++i) { const int kk = 2 * i + (lane >> 5); scr[kk * 33 + (lane & 31)] = wv[i] * fold[k0 + kk] * inv; }
    LDS_WAIT(); asm volatile("" ::: "memory");
    const int n = lane >> 1, c = lane & 1; const LAS float* sp = scr + (32 * c) * 33 + n;
    u32x4 o0, o1;
    o0.x = q4(sp[0 * 33], sp[1 * 33], sp[2 * 33], sp[3 * 33]);     o0.y = q4(sp[4 * 33], sp[5 * 33], sp[6 * 33], sp[7 * 33]);
    o0.z = q4(sp[8 * 33], sp[9 * 33], sp[10 * 33], sp[11 * 33]);   o0.w = q4(sp[12 * 33], sp[13 * 33], sp[14 * 33], sp[15 * 33]);
    o1.x = q4(sp[16 * 33], sp[17 * 33], sp[18 * 33], sp[19 * 33]); o1.y = q4(sp[20 * 33], sp[21 * 33], sp[22 * 33], sp[23 * 33]);
    o1.z = q4(sp[24 * 33], sp[25 * 33], sp[26 * 33], sp[27 * 33]); o1.w = q4(sp[28 * 33], sp[29 * 33], sp[30 * 33], sp[31 * 33]);
    u32x4* dst = (u32x4*)(WQ + (size_t)(nrow0 + n) * K + k0 + 32 * c);
    dst[0] = o0; dst[1] = o1;
    LDS_WAIT(); asm volatile("" ::: "memory");
}

struct Args { const float* in[22]; float* out; unsigned char* ws; int ph_lo, ph_hi, li, pad; };

__global__ void __launch_bounds__(NWAVES * 64, 2) hymba_fwd(Args args) {
    extern __shared__ __attribute__((aligned(16))) unsigned char lds_raw[];
    LAS unsigned char* lds = (LAS unsigned char*)lds_raw;
    volatile LAS unsigned* MISC = (volatile LAS unsigned*)(lds + MISC_OFF);
    const int tid = threadIdx.x, lane = tid & 63, wave = __builtin_amdgcn_readfirstlane(tid >> 6);
    const int G = gridDim.x; const int bx = blockIdx.x; const int vcu = (G % 8 == 0) ? (bx % 8) * (G / 8) + bx / 8 : bx;
    unsigned char* ws = args.ws;
    unsigned* ctl = (unsigned*)(ws + WS_CTL);
    const float* xp = args.in[0]; const float* xs = args.in[1];
    bf16_t* W1 = (bf16_t*)(ws + WS_W1); bf16_t* W2 = (bf16_t*)(ws + WS_W2); bf16_t* W3 = (bf16_t*)(ws + WS_W3); bf16_t* W4 = (bf16_t*)(ws + WS_W4);
    float* SSQ = (float*)(ws + WS_SSQ); bf16_t* XB = (bf16_t*)(ws + WS_XB); bf16_t* PROJ = (bf16_t*)(ws + WS_PROJ); bf16_t* X1B = (bf16_t*)(ws + WS_X1B); bf16_t* ACT = (bf16_t*)(ws + WS_ACT);
    bf16_t* OB = (bf16_t*)(ws + WS_OB); float* RMS1 = (float*)(ws + WS_RSTD1);
    for (int u = tid; u < 128; u += NWAVES * 64) ((LAS unsigned*)(lds + MISC_OFF))[u] = 0u;
    __syncthreads();
    XcdBarrier bar; bar.bar = ctl + CW_BAR + args.li * XCD_BAR_WORDS; bar.x = 0; bar.st = nullptr;
    if (MK_N_LAUNCHES != 6) bar = xcd_barrier_post(ctl + CW_BAR + args.li * XCD_BAR_WORDS, MISC + 8);
    const int lo = args.ph_lo, hi_ph = args.ph_hi;
#ifndef ONLY_PHASE
#define ONLY_PHASE -1
#endif
#define IN(k) ((ONLY_PHASE < 0 || ONLY_PHASE == (k)) && lo <= (k) && (k) < hi_ph)
#define BOTH(k) (IN(k) && IN((k) + 1))
#define GRID_BAR() do { if (MK_N_LAUNCHES != 6) xcd_barrier(bar); } while (0)

    if (IN(0)) {
        LAS float* scr = (LAS float*)(lds + wave * 16384);
        const int gw = vcu * NWAVES + wave, NGW = G * NWAVES;
        constexpr int I1 = (DM / 64) * (DIN / 32), I2 = (DM / 64) * (DM / 32), I3 = (DM / 64) * (2 * DFF / 32), I4 = (DFF / 64) * (DM / 32);
        for (int it = gw; it < I1 + I2 + I3 + I4; it += NGW) {
            int r = it;
            if (r < I1) { const int nblk = DIN / 32, kb = r / nblk, nb = r % nblk, n0 = 32 * nb, pn = n0 >> 8, p = n0 & 255, bj = p >> 7, wc = (p & 127) >> 5;
                transpose_item(args.in[3], DIN, 256 * pn + 64 * wc + 32 * bj, DM, 64 * kb, W1, n0, args.in[2], DM - 1, 1.f, DM, scr, lane); continue; } r -= I1;
            if (r < I2) { const int nblk = DM / 32, kb = r / nblk, nb = r % nblk;
                const int n0 = 32 * nb, pn = n0 >> 8, p = n0 & 255, bj = p >> 7, wc = (p & 127) >> 5;
                transpose_item(args.in[15], DM, 256 * pn + 64 * wc + 32 * bj, DM, 64 * kb, W2, n0, args.in[10], 127, 1.0f - LAM_INIT, 512, scr, lane); continue; } r -= I2;
            if (r < I3) { const int nblk = 2 * DFF / 32, kb = r / nblk, nb = r % nblk, n0 = 32 * nb, pn = n0 >> 8, p = n0 & 255, bj = p >> 7, e0 = p & 127;
                absmax_item(bj ? args.in[18] : args.in[17], DFF, 128 * pn + e0, 64 * kb, ctl + CW_WMAX + n0, args.in[16], lane); continue; } r -= I3;
            { const int nblk = DM / 32, kb = r / nblk, nb = r % nblk;
                transpose_item(args.in[21], DM, 32 * nb, DFF, 64 * kb, W4, 32 * nb, nullptr, 0, 1.f, 0, scr, lane); }
        }
        for (int m = gw; m < NTOK; m += 4 * NGW) {
            f32x4 v[4][4]; float ss[4]; int mr[4];
#pragma unroll
            for (int q = 0; q < 4; ++q) { int mm = m + q * NGW; mr[q] = mm; if (mm >= NTOK) mm = m;
                const float* xr = mm < TOK_P ? xp + (size_t)mm * DM : xs + (size_t)(mm - TOK_P) * DM;
#pragma unroll
                for (int j = 0; j < 4; ++j) v[q][j] = __builtin_nontemporal_load((const f32x4*)xr + 64 * j + lane); }
#pragma unroll
            for (int q = 0; q < 4; ++q) { ss[q] = 0.f;
#pragma unroll
                for (int j = 0; j < 4; ++j) ss[q] += dot4(v[q][j]); }
#pragma unroll
            for (int o = 1; o < 64; o <<= 1) {
#pragma unroll
                for (int q = 0; q < 4; ++q) ss[q] += __shfl_xor(ss[q], o); }
#pragma unroll
            for (int q = 0; q < 4; ++q) if (mr[q] < NTOK) { const float ms = ss[q] * (1.f / DM) + EPS; const float r = __builtin_amdgcn_rsqf(ms);
                if (lane == 0) RMS1[mr[q]] = ms * r;
                u32x2* o8 = (u32x2*)(XB + (size_t)mr[q] * DM) + lane;
#pragma unroll
                for (int j = 0; j < 4; ++j) { u32x2 w; w.x = cvtpk(v[q][j][0] * r, v[q][j][1] * r); w.y = cvtpk(v[q][j][2] * r, v[q][j][3] * r); o8[64 * j] = w; } }
        }
        if (BOTH(0)) GRID_BAR();
    }

    if (IN(1)) {
        pg8::Gemm g{XB, W1, DM, 256}; pg8::StaticOrder S; S.init(NTOK / 256, DIN / 256, G, bx);
        { LAS float* gl = (LAS float*)(lds + EPX_OFF);
          if (tid < 256) { const int v = tid >> 6, d = tid & 63; gl[tid] = (v == 0 ? args.in[4] : v == 1 ? args.in[5] : v == 2 ? args.in[11] : args.in[12])[d]; }
          LDS_WAIT(); __syncthreads(); }
        pg8::EpiProj E{PROJ, (const LAS float*)(lds + EPX_OFF)};
        pg8::gemm_phase<pg8::EpiProj, pg8::StaticOrder>(lds, g, S, E);
        if (BOTH(1)) GRID_BAR();
    }

    if (IN(2)) {
        if (wave == 0) {
            const float a = args.in[6][lane] * args.in[7][lane], b2 = args.in[8][lane] * args.in[9][lane];
            const float sa = wave_sum(a), sb = wave_sum(b2);
            if (lane == 0) ((LAS float*)(lds + MISC_OFF))[16] = __expf(sa) - __expf(sb) + LAM_INIT;
        }
        LDS_WAIT(); __syncthreads();
        const float lam = ((const LAS float*)(lds + MISC_OFF))[16];
        const int per = (768 + G - 1) / G;
#ifndef NO_DIFF
        for (int i = 0; i < per; ++i) { const int u = vcu * per + i; if (u < 768) { const int bh = u >> 3, qb = u & 7;
            att::diff_unit(bh >> 2, bh & 3, qb, PROJ, OB, (LAS char*)lds, lam, args.in[14]); } }
#endif
#ifndef NO_WIN
        for (int i = 0; i < per; ++i) { const int u = vcu * per + i; if (u < 768) { const int bk = u >> 4, qb = u & 15;
            att::win_unit(bk >> 1, bk & 1, qb, PROJ, OB, (LAS char*)lds, args.in[14], args.in[13]); } }
#endif
        if (BOTH(2)) GRID_BAR();
    }

    if (IN(3)) {
        pg8::Gemm g{OB, W2, DM, 256}; pg8::StaticOrder S; S.init(NTOK / 256, DM / 256, G, bx);
        pg8::EpiOut E{XB, RMS1, X1B, SSQ, (LAS float*)(lds + EPX_OFF)};
        pg8::gemm_phase<pg8::EpiOut, pg8::StaticOrder>(lds, g, S, E);
        if (BOTH(3)) GRID_BAR();
    }

    if (IN(4)) {
        signed char* W3Q = (signed char*)(ws + WS_W3); signed char* X1Q = (signed char*)(ws + WS_X1Q); float* FA = (float*)(ws + WS_FA);
        {
            LAS float* scr = (LAS float*)(lds + wave * 16384);
            const int gw = vcu * NWAVES + wave, NGW = G * NWAVES;
            constexpr int I3 = (DM / 64) * (2 * DFF / 32);
            for (int r = gw; r < I3; r += NGW) { const int nblk = 2 * DFF / 32, kb = r / nblk, nb = r % nblk, n0 = 32 * nb, pn = n0 >> 8, p = n0 & 255, bj = p >> 7, e0 = p & 127;
                quant_item(bj ? args.in[18] : args.in[17], DFF, 128 * pn + e0, DM, 64 * kb, W3Q, n0, args.in[16], ctl + CW_WMAX + n0, scr, lane); }
            for (int m = gw; m < NTOK; m += 4 * NGW) {
                u32x4 va[4], vb[4]; int mr[4];
#pragma unroll
                for (int q = 0; q < 4; ++q) { int mm = m + q * NGW; mr[q] = mm; if (mm >= NTOK) mm = m;
                    const u32x4* xr = (const u32x4*)(X1B + (size_t)mm * DM) + 2 * lane; va[q] = xr[0]; vb[q] = xr[1]; }
#pragma unroll
                for (int q = 0; q < 4; ++q) {
                    const unsigned w[8] = {va[q].x, va[q].y, va[q].z, va[q].w, vb[q].x, vb[q].y, vb[q].z, vb[q].w};
                    float f[16]; float am = 0.f;
#pragma unroll
                    for (int j = 0; j < 8; ++j) { f[2 * j] = __uint_as_float(w[j] << 16); f[2 * j + 1] = __uint_as_float(w[j] & 0xffff0000u); am = __builtin_fmaxf(am, __builtin_fmaxf(__builtin_fabsf(f[2 * j]), __builtin_fabsf(f[2 * j + 1]))); }
#pragma unroll
                    for (int o = 1; o < 64; o <<= 1) am = __builtin_fmaxf(am, __shfl_xor(am, o));
                    if (mr[q] < NTOK) { const float inv = am > 0.f ? 127.0f / am : 0.f;
                        u32x4 o; o.x = q4(f[0] * inv, f[1] * inv, f[2] * inv, f[3] * inv); o.y = q4(f[4] * inv, f[5] * inv, f[6] * inv, f[7] * inv);
                        o.z = q4(f[8] * inv, f[9] * inv, f[10] * inv, f[11] * inv); o.w = q4(f[12] * inv, f[13] * inv, f[14] * inv, f[15] * inv);
                        ((u32x4*)(X1Q + (size_t)mr[q] * DM))[lane] = o;
                        if (lane == 0) { const f32x4 qs = *(const f32x4*)(SSQ + (size_t)mr[q] * 4); const float ssum = (qs[0] + qs[1]) + (qs[2] + qs[3]);
                            FA[mr[q]] = __builtin_amdgcn_rsqf(ssum * (1.0f / DM) + EPS) * am * (1.0f / 127.0f); } }
                }
            }
        }
        GRID_BAR();
        pg8::Gemm g{(const bf16_t*)(X1Q - DM), (const bf16_t*)W3Q, DM / 2, 254}; pg8::StaticOrder S; S.init(194, 2 * DFF / 256, G, bx);
        pg8::EpiFfn E{ACT, FA, (const float*)(ctl + CW_WMAX), args.in[19], args.in[20], (LAS float*)(lds + EPX_OFF)};
        pg8::gemm_phase<pg8::EpiFfn, pg8::StaticOrder, true, true, true>(lds, g, S, E);
        if (BOTH(4)) GRID_BAR();
    }

    if (IN(5)) {
        pg8::Gemm g{ACT, W4, DFF, 256}; pg8::StaticOrder S; S.init(NTOK / 256, DM / 256, G, bx, 1);
        pg8::EpiDown E{X1B, args.out};
        pg8::gemm_phase<pg8::EpiDown, pg8::StaticOrder>(lds, g, S, E);
    }
#undef IN
#undef BOTH
#undef GRID_BAR
}

extern "C" void kernel_launch(void* const* d_in, const int* in_sizes, int n_in, void* d_out, int out_size, void* d_ws, size_t ws_size, hipStream_t stream) {
    static int grid = 0;
    if (grid == 0) {
        if (n_in != 22 || in_sizes[0] != TOK_P * DM || in_sizes[1] != (NTOK - TOK_P) * DM || out_size != NTOK * DM || ws_size < WS_END) {
            fprintf(stderr, "kernel_launch: shape mismatch (n_in %d, in0 %d, in1 %d, out %d, ws %zu; need ws >= %zu)\n", n_in, n_in > 0 ? in_sizes[0] : -1, n_in > 1 ? in_sizes[1] : -1, out_size, ws_size, (size_t)WS_END); grid = -1; return; }
        int dev = 0, cus = 0;
        if (hipGetDevice(&dev) != hipSuccess || hipDeviceGetAttribute(&cus, hipDeviceAttributeMultiprocessorCount, dev) != hipSuccess) { fprintf(stderr, "kernel_launch: device query failed\n"); grid = -1; return; }
        if (hipFuncSetAttribute((const void*)hymba_fwd, hipFuncAttributeMaxDynamicSharedMemorySize, LDS_BYTES) != hipSuccess) { fprintf(stderr, "kernel_launch: hipFuncSetAttribute failed\n"); grid = -1; return; }
        int per_cu = 0;
        if (hipOccupancyMaxActiveBlocksPerMultiprocessor(&per_cu, (const void*)hymba_fwd, NWAVES * 64, LDS_BYTES) != hipSuccess || per_cu < 1)
            fprintf(stderr, "kernel_launch: note: occupancy query reports %d workgroups per CU\n", per_cu);
        (void)hipGetLastError();
        grid = cus;
    }
    if (grid < 0) return;
    (void)hipMemsetAsync((char*)d_ws + WS_CTL, 0, CTL_ZERO_BYTES, stream);
    Args a{};
    for (int i = 0; i < 22; ++i) a.in[i] = (const float*)d_in[i];
    a.out = (float*)d_out; a.ws = (unsigned char*)d_ws;
#ifndef PROBE_DUP
#define PROBE_DUP -1
#endif
    constexpr int NL = (PROBE_DUP >= 0) ? 3 : MK_N_LAUNCHES;
    for (int li = 0; li < NL; ++li) {
        if (PROBE_DUP >= 0) {
            a.ph_lo = li == 0 ? 0 : (li == 1 ? PROBE_DUP : PROBE_DUP + 1); a.ph_hi = li == 2 ? 6 : PROBE_DUP + 1; a.li = li;
        } else { a.ph_lo = (NL == 6) ? li : 0; a.ph_hi = (NL == 6) ? li + 1 : 6; a.li = (NL == 6) ? 0 : li; }
        hipLaunchKernelGGL(hymba_fwd, dim3(grid), dim3(NWAVES * 64), LDS_BYTES, stream, a);
        const hipError_t le = hipPeekAtLastError();
        if (le != hipSuccess) { fprintf(stderr, "kernel_launch: launch %d failed: %s\n", li, hipGetErrorName(le)); break; }
    }
}
```

```cpp
#include <hip/hip_runtime.h>
#include <hip/hip_bf16.h>
#include <cstdio>
#include <cstdint>

#ifndef MK_N_LAUNCHES
#define MK_N_LAUNCHES 1
#endif

#define LAS __attribute__((address_space(3)))
#define GAS __attribute__((address_space(1)))
typedef unsigned short bf16_t;
typedef short bf16x8 __attribute__((ext_vector_type(8)));
typedef short s16x4 __attribute__((ext_vector_type(4)));
typedef float f32x2 __attribute__((ext_vector_type(2)));
typedef float f32x4 __attribute__((ext_vector_type(4)));
typedef float f32x16 __attribute__((ext_vector_type(16)));
typedef unsigned u32x2 __attribute__((ext_vector_type(2)));
typedef unsigned u32x4 __attribute__((ext_vector_type(4)));
typedef __bf16 bf16x2_t __attribute__((ext_vector_type(2)));

constexpr int DM = 1024, SEQ = 2048, NSEQ = 24, NTOK = NSEQ * SEQ, TOK_P = 8 * SEQ;
constexpr int DIN = 2304, DFF = 2816;
constexpr int C_DQ = 0, C_DK = 512, C_DV = 1024, C_WQ = 1536, C_WK = 2048, C_WV = 2176;
constexpr int NBH = 12;
constexpr float EPS = 1e-6f, LOG2E = 1.4426950408889634f, QSCALE = 0.125f * LOG2E;
constexpr float LAM_INIT = 0.2f;
constexpr int NWAVES = 8;

__device__ __forceinline__ unsigned cvtpk(float lo, float hi) { f32x2 v = {lo, hi}; bf16x2_t b = __builtin_convertvector(v, bf16x2_t); return __builtin_bit_cast(unsigned, b); }
__device__ __forceinline__ u32x4 pack8(f32x4 a, f32x4 b) { u32x4 w; w.x = cvtpk(a[0], a[1]); w.y = cvtpk(a[2], a[3]); w.z = cvtpk(b[0], b[1]); w.w = cvtpk(b[2], b[3]); return w; }
__device__ __forceinline__ float dot4(f32x4 a) { return (a[0] * a[0] + a[1] * a[1]) + (a[2] * a[2] + a[3] * a[3]); }

namespace pg8 {
constexpr int BM = 256, BK = 64, HALF = 128, HTB = HALF * BK * 2, STAGE_BYTES = 8 * HTB, NXCD = 8, WGM = 8;
__host__ __device__ __forceinline__ int lds_byte(int r, int c) { const int st = (r >> 4) * 2 + (c >> 5), rr = r & 15, cc = c & 31, ob = rr * 64 + cc * 2; return st * 1024 + (ob ^ (((ob >> 9) & 1) << 5)); }
__host__ __device__ __forceinline__ void stage_rc(int b, int& R, int& C) { const int st = b / 1024, sb = b % 1024, swz = sb ^ (((sb >> 9) & 1) << 5); R = (st >> 1) * 16 + swz / 64; C = (st & 1) * 32 + (swz % 64) / 2; }
__host__ __device__ __forceinline__ int perm32(int rho) { const int n = rho >> 4, i = rho & 15; return 8 * (i >> 2) + 4 * n + (i & 3); }

typedef int v4i32_t __attribute__((ext_vector_type(4)));
struct Unit { int pm, pn; };
struct Gemm { const bf16_t* A; const bf16_t* Bt; int K; int arows; };

struct StaticOrder {
    int nM, nN, nwg, G, c, rev;
    __device__ void init(int nM_, int nN_, int G_, int c_, int rev_ = 0) { nM = nM_; nN = nN_; nwg = nM * nN; G = G_; c = c_; rev = rev_; }
    __device__ bool next(int i, Unit& u) const {
        const int nr = (nwg - c + G - 1) / G; if (i >= nr) return false;
        const long L = (long)(rev ? nr - 1 - i : i) * G + c;
        int wgid = (int)L; { const int q = nwg / NXCD, r = nwg % NXCD, xcd = wgid % NXCD, off = wgid / NXCD; wgid = (xcd < r ? xcd * (q + 1) : r * (q + 1) + (xcd - r) * q) + off; }
        const int nig = WGM * nN, gid = wgid / nig, fm = gid * WGM, gsz = (nM - fm) < WGM ? (nM - fm) : WGM;
        u.pm = fm + ((wgid % nig) % gsz); u.pn = (wgid % nig) / gsz; return true;
    }
};


struct EpiProj {
    static constexpr bool PERM = true;
    bf16_t* P; const LAS float* gl; const float* fx; const float* swm;
    __device__ __forceinline__ void pre(const Unit& u, int wid, int lane_) const {
        int lane = lane_; asm volatile("" : "+v"(lane));
        if (wid >= 4) __builtin_amdgcn_global_load_lds((const unsigned*)(fx + u.pm * BM + 64 * (wid - 4) + lane), (LAS unsigned*)((LAS char*)gl + 1024 + (wid - 4) * 256), 4, 0, 0);
        if (wid == 2) __builtin_amdgcn_global_load_lds((const unsigned*)(swm + u.pn * 256 + lane * 4), (LAS unsigned*)((LAS char*)gl + 2048), 16, 0, 0);
    }
    __device__ __forceinline__ void operator()(const f32x4 (&acc)[2][2][4][2], const Unit& u, int wr, int wc, int fr, int fq, int lane) const {
        int fql = fq; asm volatile("" : "+v"(fql));
        f32x4 csw[2][2];
#pragma unroll
        for (int bj = 0; bj < 2; ++bj)
#pragma unroll
            for (int n = 0; n < 2; ++n) csw[bj][n] = *(const LAS f32x4*)(gl + 512 + 128 * bj + 32 * wc + 8 * fql + 4 * n) * (1.0f / 127.0f);
        const int gidx = u.pn * 4 + wc;
        int gsel = -1; float sc = 1.f;
        if (gidx < 8) { gsel = 0; sc = QSCALE; } else if (gidx < 16) { gsel = 1; } else if (gidx < 24) { } else if (gidx < 32) { gsel = 2; sc = QSCALE; } else if (gidx < 34) { gsel = 3; }
        const bool nrm = gsel >= 0; const LAS float* gain = gl + (nrm ? gsel : 0) * 64;
        f32x4 gv[2][2];
#pragma unroll
        for (int bj = 0; bj < 2; ++bj)
#pragma unroll
            for (int n = 0; n < 2; ++n) gv[bj][n] = nrm ? *(const LAS f32x4*)(gain + 32 * bj + 8 * fq + 4 * n) * sc : (f32x4){1.f, 1.f, 1.f, 1.f};
        bf16_t* base = P + (size_t)(u.pm * BM + wr * 64 + fr) * DIN + gidx * 64 + 8 * fq;
#pragma unroll
        for (int ai = 0; ai < 2; ++ai)
#pragma unroll
            for (int m = 0; m < 4; ++m) {
                const float fxr = gl[256 + ai * HALF + wr * 64 + m * 16 + fr];
                f32x4 v00 = __builtin_convertvector(__builtin_bit_cast(v4i32_t, acc[ai][0][m][0]), f32x4) * (csw[0][0] * fxr), v01 = __builtin_convertvector(__builtin_bit_cast(v4i32_t, acc[ai][0][m][1]), f32x4) * (csw[0][1] * fxr);
                f32x4 v10 = __builtin_convertvector(__builtin_bit_cast(v4i32_t, acc[ai][1][m][0]), f32x4) * (csw[1][0] * fxr), v11 = __builtin_convertvector(__builtin_bit_cast(v4i32_t, acc[ai][1][m][1]), f32x4) * (csw[1][1] * fxr);
                float rn = 1.f;
                if (nrm) { float ss = (dot4(v00) + dot4(v01)) + (dot4(v10) + dot4(v11)); ss += __shfl_xor(ss, 16); ss += __shfl_xor(ss, 32); rn = __builtin_amdgcn_rsqf(ss * (1.0f / 64.0f) + EPS); }
                v00 = v00 * rn * gv[0][0]; v01 = v01 * rn * gv[0][1]; v10 = v10 * rn * gv[1][0]; v11 = v11 * rn * gv[1][1];
                bf16_t* rowp = base + (size_t)(ai * HALF + m * 16) * DIN;
                const u32x4 pa = pack8(v00, v01), pb = pack8(v10, v11);
                u32x4 px; px.x = (unsigned)__builtin_amdgcn_mov_dpp((int)pb.x, 0x128, 0xf, 0xf, true); px.y = (unsigned)__builtin_amdgcn_mov_dpp((int)pb.y, 0x128, 0xf, 0xf, true);
                px.z = (unsigned)__builtin_amdgcn_mov_dpp((int)pb.z, 0x128, 0xf, 0xf, true); px.w = (unsigned)__builtin_amdgcn_mov_dpp((int)pb.w, 0x128, 0xf, 0xf, true);
                const bool hi8 = (fr & 8) != 0;
                bf16_t* r1p = base + (size_t)(ai * HALF + m * 16 - (hi8 ? 8 : 0)) * DIN + (hi8 ? 32 : 0);
                bf16_t* r2p = base + (size_t)(ai * HALF + m * 16 + (hi8 ? 0 : 8)) * DIN + (hi8 ? 0 : 32);
                *(u32x4*)(r1p) = hi8 ? px : pa; *(u32x4*)(r2p) = hi8 ? pa : px;
            }
    }
};

struct EpiOut {
    static constexpr bool PERM = true;
    const bf16_t* __restrict__ xb; const float* __restrict__ rms; bf16_t* __restrict__ x1b; float* __restrict__ ssq; LAS float* xl;
    __device__ __forceinline__ void pre(const Unit&, int, int) const {}
    __device__ __forceinline__ void operator()(const f32x4 (&acc)[2][2][4][2], const Unit& u, int wr, int wc, int fr, int fq, int lane) const {
        asm volatile("" : "+v"(fr), "+v"(fq));
        const int rowbase = u.pm * BM;
        const int col0 = u.pn * BM + wc * 64 + 8 * fq;
        const bool hi8 = (fr & 8) != 0;
#pragma unroll
        for (int ai = 0; ai < 2; ++ai) {
            u32x4 xv[4][2]; float rr[4];
#pragma unroll
            for (int m = 0; m < 4; ++m) { const size_t row = (size_t)(rowbase + ai * HALF + wr * 64 + m * 16 + fr);
                rr[m] = rms[row];
#pragma unroll
                for (int bj = 0; bj < 2; ++bj) xv[m][bj] = *(const u32x4*)(xb + row * DM + col0 + bj * 32); }
#pragma unroll
            for (int m = 0; m < 4; ++m) {
                const int rl = ai * HALF + wr * 64 + m * 16 + fr; float s = 0.f; u32x4 pk[2];
#pragma unroll
                for (int bj = 0; bj < 2; ++bj) { const u32x4 w = xv[m][bj];
                    f32x4 x0, x1;
                    x0[0] = __uint_as_float(w.x << 16); x0[1] = __uint_as_float(w.x & 0xffff0000u); x0[2] = __uint_as_float(w.y << 16); x0[3] = __uint_as_float(w.y & 0xffff0000u);
                    x1[0] = __uint_as_float(w.z << 16); x1[1] = __uint_as_float(w.z & 0xffff0000u); x1[2] = __uint_as_float(w.w << 16); x1[3] = __uint_as_float(w.w & 0xffff0000u);
                    const f32x4 o0 = x0 * rr[m] + acc[ai][bj][m][0], o1 = x1 * rr[m] + acc[ai][bj][m][1];
                    pk[bj] = pack8(o0, o1);
                    s += dot4(o0) + dot4(o1); }
                u32x4 px; px.x = (unsigned)__builtin_amdgcn_mov_dpp((int)pk[1].x, 0x128, 0xf, 0xf, true); px.y = (unsigned)__builtin_amdgcn_mov_dpp((int)pk[1].y, 0x128, 0xf, 0xf, true);
                px.z = (unsigned)__builtin_amdgcn_mov_dpp((int)pk[1].z, 0x128, 0xf, 0xf, true); px.w = (unsigned)__builtin_amdgcn_mov_dpp((int)pk[1].w, 0x128, 0xf, 0xf, true);
                bf16_t* r1p = x1b + (size_t)(rowbase + rl - (hi8 ? 8 : 0)) * DM + col0 + (hi8 ? 32 : 0);
                bf16_t* r2p = x1b + (size_t)(rowbase + rl + (hi8 ? 0 : 8)) * DM + col0 + (hi8 ? 0 : 32);
                *(u32x4*)(r1p) = hi8 ? px : pk[0]; *(u32x4*)(r2p) = hi8 ? pk[0] : px;
                s += __shfl_xor(s, 16); s += __shfl_xor(s, 32);
                if (fq == 0) xl[rl * 4 + wc] = s;
            }
        }
        asm volatile("s_waitcnt lgkmcnt(0)" ::: "memory"); __builtin_amdgcn_s_barrier(); asm volatile("" ::: "memory");
        const int t = (wr * 4 + wc) * 64 + lane;
        if (t < 256) { const f32x4 q = *(const LAS f32x4*)(xl + t * 4); ssq[(size_t)(rowbase + t) * 4 + u.pn] = (q[0] + q[1]) + (q[2] + q[3]); }
    }
};

__device__ __forceinline__ float dpp8(float x) { return __builtin_bit_cast(float, __builtin_amdgcn_mov_dpp(__builtin_bit_cast(int, x), 0x128, 0xf, 0xf, true)); }
struct EpiDown {
    static constexpr bool PERM = true;
    const bf16_t* __restrict__ x1b; float* __restrict__ out;
    __device__ __forceinline__ void pre(const Unit&, int, int) const {}
    __device__ __forceinline__ void operator()(const f32x4 (&acc)[2][2][4][2], const Unit& u, int wr, int wc, int fr, int fq, int lane) const {
        const int col0 = u.pn * BM + wc * 32 + 8 * fq; const bool hi8 = (fr & 8) != 0;
        u32x4 w[2][4][2];
#pragma unroll
        for (int ai = 0; ai < 2; ++ai)
#pragma unroll
            for (int m = 0; m < 4; ++m) { const size_t off = (size_t)(u.pm * BM + ai * HALF + wr * 64 + m * 16 + fr) * DM + col0;
#pragma unroll
                for (int bj = 0; bj < 2; ++bj) w[ai][m][bj] = *(const u32x4*)(x1b + off + bj * HALF); }
#pragma unroll
        for (int ai = 0; ai < 2; ++ai)
#pragma unroll
            for (int m = 0; m < 4; ++m) { const size_t off = (size_t)(u.pm * BM + ai * HALF + wr * 64 + m * 16 + fr) * DM + col0;
#pragma unroll
                for (int bj = 0; bj < 2; ++bj) { const u32x4 ww = w[ai][m][bj];
                    f32x4 r0, r1;
                    r0[0] = __uint_as_float(ww.x << 16); r0[1] = __uint_as_float(ww.x & 0xffff0000u); r0[2] = __uint_as_float(ww.y << 16); r0[3] = __uint_as_float(ww.y & 0xffff0000u);
                    r1[0] = __uint_as_float(ww.z << 16); r1[1] = __uint_as_float(ww.z & 0xffff0000u); r1[2] = __uint_as_float(ww.w << 16); r1[3] = __uint_as_float(ww.w & 0xffff0000u);
                    const f32x4 q0 = r0 + acc[ai][bj][m][0], q1 = r1 + acc[ai][bj][m][1];
                    f32x4 qx; qx[0] = dpp8(q1[0]); qx[1] = dpp8(q1[1]); qx[2] = dpp8(q1[2]); qx[3] = dpp8(q1[3]);
                    const long d1 = hi8 ? (long)(4 - 8 * DM) : 0, d2 = hi8 ? 0 : (long)(4 + 8 * DM);
                    *(f32x4*)(out + off + bj * HALF + d1) = hi8 ? qx : q0; *(f32x4*)(out + off + bj * HALF + d2) = hi8 ? q0 : qx; } }
    }
};

template <int CTRL> __device__ __forceinline__ float dppz(float x) { return __builtin_bit_cast(float, __builtin_amdgcn_update_dpp(0, __builtin_bit_cast(int, x), CTRL, 0xf, 0xf, true)); }
struct EpiFfn {
    static constexpr bool PERM = true;
    bf16_t* act; const float* fa; const float* swm; const float* cw; const float* cb; LAS float* xl;
    __device__ __forceinline__ void pre(const Unit& u, int wid, int lane_) const {
        int lane = lane_; asm volatile("" : "+v"(lane));
        const int tok0 = 254 * u.pm - 1;
        if (wid >= 4) { int tok = tok0 + 64 * (wid - 4) + lane; tok = tok < 0 ? 0 : (tok > NTOK - 1 ? NTOK - 1 : tok);
            __builtin_amdgcn_global_load_lds((const unsigned*)(fa + tok), (LAS unsigned*)((LAS char*)xl + 4096 + (wid - 4) * 256), 4, 0, 0); }
        if (wid == 2) __builtin_amdgcn_global_load_lds((const unsigned*)(swm + u.pn * 256 + lane * 4), (LAS unsigned*)((LAS char*)xl + 5120), 16, 0, 0);
        if (wid < 2) { const float* src = (wid == 0 ? (lane < 32 ? cw : cw + DFF) : (lane < 32 ? cw + 2 * DFF : cb)) + u.pn * 128 + (lane & 31) * 4;
            __builtin_amdgcn_global_load_lds((const unsigned*)src, (LAS unsigned*)((LAS char*)xl + 20480 + wid * 1024), 16, 0, 0); }
    }
    template <int AI, int M, bool MASK>
    __device__ __forceinline__ void conv_rows(const f32x4 (&acc)[2][2][4][2], const f32x4 (&w0)[2], const f32x4 (&w1)[2], const f32x4 (&w2)[2], const f32x4 (&bb)[2],
                                              int tok, int rl, int G, int xc, int fr, int ch0) const {
        const bool pcut = MASK && (tok & (SEQ - 1)) == 0, ncut = MASK && (tok & (SEQ - 1)) == SEQ - 1;
        f32x4 r0, r1;
#pragma unroll
        for (int n = 0; n < 2; ++n) { f32x4 res;
            f32x4 ex = (f32x4){0.f, 0.f, 0.f, 0.f};
            if (M == 0) { if (G > 0) ex = *(const LAS f32x4*)(xl + (2 * (G - 1) + 1) * 128 + xc + 4 * n); ex = fr == 0 ? ex : (f32x4){0.f, 0.f, 0.f, 0.f}; }
            if (M == 3) { if (G < 3) ex = *(const LAS f32x4*)(xl + (2 * (G + 1)) * 128 + xc + 4 * n); ex = fr == 15 ? ex : (f32x4){0.f, 0.f, 0.f, 0.f}; }
#pragma unroll
            for (int i = 0; i < 4; ++i) {
                const float own = acc[AI][0][M][n][i];
                float pr = dppz<0x111>(own);
                pr += (M > 0) ? dppz<0x10F>(acc[AI][0][M > 0 ? M - 1 : 0][n][i]) : ex[i];
                float nx = dppz<0x101>(own);
                nx += (M < 3) ? dppz<0x11F>(acc[AI][0][M < 3 ? M + 1 : 3][n][i]) : ex[i];
                if (MASK) { pr = pcut ? 0.f : pr; nx = ncut ? 0.f : nx; }
                const float uc = fmaf(w0[n][i], pr, fmaf(w1[n][i], own, fmaf(w2[n][i], nx, bb[n][i])));
                const float sg = uc * __builtin_amdgcn_rcpf(1.0f + __builtin_amdgcn_exp2f(-LOG2E * uc));
                res[i] = sg * acc[AI][1][M][n][i];
            }
            if (n == 0) r0 = res; else r1 = res; }
        if (rl != 0 && rl != 255 && tok < NTOK) *(u32x4*)(act + (size_t)tok * DFF + ch0) = pack8(r0, r1);
    }
    __device__ __forceinline__ void operator()(f32x4 (&acc)[2][2][4][2], const Unit& u, int wr, int wc, int fr, int fq, int lane) const {
        const int ch0 = u.pn * 128 + wc * 32 + 8 * fq;
        const int tok0 = 254 * u.pm - 1;
        int fql = fq; asm volatile("" : "+v"(fql));
        const int xc = wc * 32 + 8 * fql;
        f32x4 su[2];
#pragma unroll
        for (int n = 0; n < 2; ++n) su[n] = *(const LAS f32x4*)(xl + 1280 + 128 + xc + 4 * n) * (1.0f / 127.0f);
#pragma unroll
        for (int ai = 0; ai < 2; ++ai)
#pragma unroll
            for (int m = 0; m < 4; ++m) { const float rs = xl[1024 + ai * HALF + wr * 64 + m * 16 + fr];
#pragma unroll
                for (int n = 0; n < 2; ++n) { const f32x4 rsu = su[n] * rs;
                    acc[ai][0][m][n] = __builtin_convertvector(__builtin_bit_cast(v4i32_t, acc[ai][0][m][n]), f32x4) * rs;
                    acc[ai][1][m][n] = __builtin_convertvector(__builtin_bit_cast(v4i32_t, acc[ai][1][m][n]), f32x4) * rsu; } }
#pragma unroll
        for (int ai = 0; ai < 2; ++ai) { const int G = 2 * ai + wr;
            if (fr == 0) { *(LAS f32x4*)(xl + (2 * G) * 128 + xc) = acc[ai][0][0][0]; *(LAS f32x4*)(xl + (2 * G) * 128 + xc + 4) = acc[ai][0][0][1]; }
            if (fr == 15) { *(LAS f32x4*)(xl + (2 * G + 1) * 128 + xc) = acc[ai][0][3][0]; *(LAS f32x4*)(xl + (2 * G + 1) * 128 + xc + 4) = acc[ai][0][3][1]; } }
        asm volatile("s_waitcnt lgkmcnt(0)" ::: "memory"); __builtin_amdgcn_s_barrier(); asm volatile("" ::: "memory"); __builtin_amdgcn_sched_barrier(0);
        f32x4 w0[2], w1[2], w2[2], bb[2];
#pragma unroll
        for (int n = 0; n < 2; ++n) { const LAS float* wl = xl + 5120 + xc + 4 * n; const f32x4 sgc = *(const LAS f32x4*)(xl + 1280 + xc + 4 * n) * (1.0f / 127.0f);
            w0[n] = *(const LAS f32x4*)(wl) * sgc; w1[n] = *(const LAS f32x4*)(wl + 128) * sgc; w2[n] = *(const LAS f32x4*)(wl + 256) * sgc; bb[n] = *(const LAS f32x4*)(wl + 384); }
#define FFN_ROWS(AI, M) do { const int tb_ = tok0 + AI * HALF + wr * 64 + M * 16; const int G_ = 2 * AI + wr; \
        conv_rows<AI, M, true>(acc, w0, w1, w2, bb, tb_ + fr, AI * HALF + wr * 64 + M * 16 + fr, G_, xc, fr, ch0); \
        if ((M) & 1) __builtin_amdgcn_sched_barrier(0); } while (0)
        FFN_ROWS(0, 0); FFN_ROWS(0, 1); FFN_ROWS(0, 2); FFN_ROWS(0, 3); FFN_ROWS(1, 0); FFN_ROWS(1, 1); FFN_ROWS(1, 2); FFN_ROWS(1, 3);
#undef FFN_ROWS
    }
};

template <class Epi, class Sched, bool ALIGN_EPI = true, bool SP2 = true, bool I8 = false>
__device__ __forceinline__ void gemm_phase(LAS unsigned char* lds, const Gemm g, const Sched& S, const Epi& E) {
    const int tid = threadIdx.x, wid = __builtin_amdgcn_readfirstlane(tid >> 6), lane = tid & 63, wr = wid >> 2, wc = wid & 3, fr = lane & 15, fq = lane >> 4;
    const int K = g.K, nt = K / BK;
    unsigned voffA[2], voffB[2];
#pragma unroll
    for (int i = 0; i < 2; ++i) { int R, C; stage_rc(tid * 16 + i * 8192, R, C); const int Rb = Epi::PERM ? ((R & ~31) + perm32(R & 31)) : R;
        voffA[i] = (unsigned)(R * K + C) * 2u; voffB[i] = (unsigned)(Rb * K + C) * 2u; }
    const size_t kstep = (size_t)(BK * 2);
    const size_t hstep = (size_t)HALF * K * 2;
    const size_t tstepB = 2 * hstep;
    const size_t tstepA = (size_t)g.arows * K * 2;
    const unsigned ldsw = (unsigned)wid * 1024u;
    const int aoff = lds_byte(wr * 64 + fr, fq * 8), boff = lds_byte(wc * 32 + fr, fq * 8);
#define PG8_SA(b, h) (((b) * 2 + (h)) * HTB)
#define PG8_SB(b, h) ((4 + (b) * 2 + (h)) * HTB)
#define PG8_STAGE(bufoff, gbase, voff) do { _Pragma("unroll") for (int _i = 0; _i < 2; ++_i) \
        __builtin_amdgcn_global_load_lds((const unsigned*)((const char*)(gbase) + (voff)[_i]), (LAS unsigned*)(lds + (bufoff) + ldsw + _i * 8192), 16, 0, 0); } while (0)
#define PG8_LDA(dst, b, h) do { _Pragma("unroll") for (int m = 0; m < 4; ++m) _Pragma("unroll") for (int k = 0; k < 2; ++k) dst[m][k] = *(const LAS bf16x8*)(lds + PG8_SA(b, h) + aoff + m * 2048 + k * 1024); } while (0)
#define PG8_LDB(dst, b, h) do { _Pragma("unroll") for (int n = 0; n < 2; ++n) _Pragma("unroll") for (int k = 0; k < 2; ++k) dst[n][k] = *(const LAS bf16x8*)(lds + PG8_SB(b, h) + boff + n * 2048 + k * 1024); } while (0)
#define PG8_MMA(ai, bj, At, Bt) do { __builtin_amdgcn_s_setprio(1); _Pragma("unroll") for (int m = 0; m < 4; ++m) _Pragma("unroll") for (int n = 0; n < 2; ++n) _Pragma("unroll") for (int k = 0; k < 2; ++k) \
        { if constexpr (I8) acc[ai][bj][m][n] = __builtin_bit_cast(f32x4, __builtin_amdgcn_mfma_i32_16x16x64_i8(__builtin_bit_cast(v4i32_t, Bt[n][k]), __builtin_bit_cast(v4i32_t, At[m][k]), __builtin_bit_cast(v4i32_t, acc[ai][bj][m][n]), 0, 0, 0)); \
          else acc[ai][bj][m][n] = __builtin_amdgcn_mfma_f32_16x16x32_bf16(Bt[n][k], At[m][k], acc[ai][bj][m][n], 0, 0, 0); } __builtin_amdgcn_s_setprio(0); } while (0)
#define PG8_WAIT_V(n) asm volatile("s_waitcnt vmcnt(" #n ")" ::: "memory")
#define PG8_WAIT_L(n) asm volatile("s_waitcnt lgkmcnt(" #n ")" ::: "memory")
#define PG8_BAR __builtin_amdgcn_s_barrier()
#define PG8_SCHED __builtin_amdgcn_sched_barrier(0)
    Unit cur, nxt; int ui = 0;
    if (!S.next(0, cur)) return;
    f32x4 acc[2][2][4][2];
#pragma unroll
    for (int a = 0; a < 2; ++a)
#pragma unroll
        for (int b = 0; b < 2; ++b)
#pragma unroll
            for (int m = 0; m < 4; ++m)
#pragma unroll
                for (int n = 0; n < 2; ++n) acc[a][b][m][n] = (f32x4){0.f, 0.f, 0.f, 0.f};
    bf16x8 At[4][2], B0[2][2], B1[2][2];
    const char* cA = (const char*)g.A + (size_t)cur.pm * tstepA; const char* cB = (const char*)g.Bt + (size_t)cur.pn * tstepB;
    if constexpr (SP2) {
        PG8_STAGE(PG8_SB(0, 0), cB, voffB); PG8_STAGE(PG8_SB(0, 1), cB + hstep, voffB); PG8_STAGE(PG8_SA(0, 0), cA, voffA); PG8_STAGE(PG8_SA(0, 1), cA + hstep, voffA);
        if (wr == 1) PG8_BAR;
        PG8_WAIT_V(2); PG8_BAR;
        PG8_STAGE(PG8_SB(1, 0), cB + kstep, voffB); PG8_STAGE(PG8_SA(1, 0), cA + kstep, voffA); PG8_STAGE(PG8_SB(1, 1), cB + hstep + kstep, voffB);
        PG8_WAIT_V(6); PG8_BAR;
    } else {
        PG8_STAGE(PG8_SB(0, 0), cB, voffB); PG8_STAGE(PG8_SA(0, 0), cA, voffA); PG8_STAGE(PG8_SB(0, 1), cB + hstep, voffB); PG8_STAGE(PG8_SA(0, 1), cA + hstep, voffA);
        if (wr == 1) PG8_BAR;
        PG8_WAIT_V(4); PG8_BAR;
        PG8_STAGE(PG8_SB(1, 0), cB + kstep, voffB); PG8_STAGE(PG8_SA(1, 0), cA + kstep, voffA); PG8_STAGE(PG8_SB(1, 1), cB + hstep + kstep, voffB);
        PG8_WAIT_V(6); PG8_BAR;
    }
    for (;;) {
        const bool has_next = S.next(ui + 1, nxt);
        const char* nA = has_next ? (const char*)g.A + (size_t)nxt.pm * tstepA : cA; const char* nB = has_next ? (const char*)g.Bt + (size_t)nxt.pn * tstepB : cB;
        for (int t = 0; t < nt; t += 2) {
            const bool last = (t == nt - 2);
            const char* a1 = cA + (size_t)(t + 1) * kstep;
            const char* a2 = last ? nA : cA + (size_t)(t + 2) * kstep; const char* b2 = last ? nB : cB + (size_t)(t + 2) * kstep;
            const char* a3 = a2 + kstep; const char* b3 = b2 + kstep;
            if (last) E.pre(cur, wid, lane);
            if constexpr (SP2) {
            PG8_LDB(B0, 0, 0); PG8_LDB(B1, 0, 1); PG8_SCHED; PG8_LDA(At, 0, 0); PG8_STAGE(PG8_SA(1, 1), a1 + hstep, voffA);
            PG8_WAIT_V(8); PG8_WAIT_L(0); PG8_BAR; PG8_MMA(0, 0, At, B0); PG8_MMA(0, 1, At, B1); PG8_BAR; PG8_SCHED;
            PG8_LDA(At, 0, 1); PG8_STAGE(PG8_SB(0, 0), b2, voffB); PG8_STAGE(PG8_SB(0, 1), b2 + hstep, voffB); PG8_STAGE(PG8_SA(0, 0), a2, voffA);
            PG8_WAIT_V(8); PG8_WAIT_L(0); PG8_BAR; PG8_MMA(1, 0, At, B0); PG8_MMA(1, 1, At, B1); PG8_BAR; PG8_SCHED;
            PG8_LDB(B0, 1, 0); PG8_LDB(B1, 1, 1); PG8_SCHED; PG8_LDA(At, 1, 0); PG8_STAGE(PG8_SA(0, 1), a2 + hstep, voffA);
            PG8_WAIT_V(8); PG8_WAIT_L(0); PG8_BAR; PG8_MMA(0, 0, At, B0); PG8_MMA(0, 1, At, B1); PG8_BAR; PG8_SCHED;
            PG8_LDA(At, 1, 1); PG8_STAGE(PG8_SB(1, 0), b3, voffB); PG8_STAGE(PG8_SB(1, 1), b3 + hstep, voffB); PG8_STAGE(PG8_SA(1, 0), a3, voffA);
            PG8_WAIT_V(8); PG8_WAIT_L(0); PG8_BAR; PG8_MMA(1, 0, At, B0); PG8_MMA(1, 1, At, B1); PG8_BAR; PG8_SCHED;
            } else {
            PG8_LDB(B0, 0, 0); PG8_SCHED; PG8_LDA(At, 0, 0); PG8_STAGE(PG8_SA(1, 1), a1 + hstep, voffA);
            PG8_WAIT_L(8); PG8_BAR; PG8_WAIT_L(0); PG8_MMA(0, 0, At, B0); PG8_BAR; PG8_SCHED;
            PG8_LDB(B1, 0, 1); PG8_STAGE(PG8_SB(0, 0), b2, voffB);
            PG8_BAR; PG8_WAIT_L(0); PG8_MMA(0, 1, At, B1); PG8_BAR;
            PG8_LDA(At, 0, 1); PG8_STAGE(PG8_SA(0, 0), a2, voffA);
            PG8_BAR; PG8_WAIT_L(0); PG8_MMA(1, 0, At, B0); PG8_BAR; PG8_SCHED;
            PG8_STAGE(PG8_SB(0, 1), b2 + hstep, voffB);
            PG8_WAIT_V(6); PG8_BAR; PG8_MMA(1, 1, At, B1); PG8_BAR;
            PG8_LDB(B0, 1, 0); PG8_SCHED; PG8_LDA(At, 1, 0); PG8_STAGE(PG8_SA(0, 1), a2 + hstep, voffA);
            PG8_WAIT_L(8); PG8_BAR; PG8_WAIT_L(0); PG8_MMA(0, 0, At, B0); PG8_BAR; PG8_SCHED;
            PG8_LDB(B1, 1, 1); PG8_STAGE(PG8_SB(1, 0), b3, voffB);
            PG8_BAR; PG8_WAIT_L(0); PG8_MMA(0, 1, At, B1); PG8_BAR;
            PG8_LDA(At, 1, 1); PG8_STAGE(PG8_SA(1, 0), a3, voffA);
            PG8_BAR; PG8_WAIT_L(0); PG8_MMA(1, 0, At, B0); PG8_BAR; PG8_SCHED;
            PG8_STAGE(PG8_SB(1, 1), b3 + hstep, voffB);
            PG8_WAIT_V(6); PG8_BAR; PG8_MMA(1, 1, At, B1); PG8_BAR;
            }
        }
        if constexpr (ALIGN_EPI) { if (wr == 0) PG8_BAR; }
        E(acc, cur, wr, wc, fr, fq, lane);
        if (!has_next) break;
#pragma unroll
        for (int a = 0; a < 2; ++a)
#pragma unroll
            for (int b = 0; b < 2; ++b)
#pragma unroll
                for (int m = 0; m < 4; ++m)
#pragma unroll
                    for (int n = 0; n < 2; ++n) acc[a][b][m][n] = (f32x4){0.f, 0.f, 0.f, 0.f};
        cur = nxt; cA = nA; cB = nB; ++ui;
        if constexpr (ALIGN_EPI) { if (wr == 1) PG8_BAR; }
    }
    PG8_WAIT_V(0);
    if constexpr (!ALIGN_EPI) { if (wr == 0) PG8_BAR; }
    PG8_BAR;
#undef PG8_SA
#undef PG8_SB
#undef PG8_STAGE
#undef PG8_LDA
#undef PG8_LDB
#undef PG8_MMA
#undef PG8_WAIT_V
#undef PG8_WAIT_L
#undef PG8_BAR
#undef PG8_SCHED
}
}

namespace att {
constexpr int PITCH = DIN;
#define SBAR() __builtin_amdgcn_sched_barrier(0)
#define KSW(row, colB) ((row) * 128 + ((colB) ^ ((((row) >> 1) & 7) << 4)))
__device__ __forceinline__ int crow(int r, int hi) { return (r & 3) + 8 * (r >> 2) + 4 * hi; }
__device__ __forceinline__ int rel_bucket(int rel) {
    const int n = rel < 0 ? -rel : rel; int v;
    if (n < 8) v = n; else { v = 2 + (31 - __clz(n * n)); v = v > 15 ? 15 : v; }
    return (rel > 0 ? 16 : 0) + v;
}
constexpr float THR = 5.0f;

__device__ __forceinline__ void partialSM(f32x16& p0, f32x16& p1, float off, float& m_reg, float& alpha) {
    float pmax = p0[0];
#pragma unroll
    for (int r = 1; r < 16; ++r) pmax = fmaxf(pmax, p0[r]);
#pragma unroll
    for (int r = 0; r < 16; ++r) pmax = fmaxf(pmax, p1[r]);
    { auto rr = __builtin_amdgcn_permlane32_swap(__float_as_uint(pmax), __float_as_uint(pmax), false, false);
      pmax = fmaxf(__uint_as_float(rr[0]), __uint_as_float(rr[1])); }
    pmax += off;
    if (__builtin_expect(__all(pmax - m_reg <= THR), 1)) { alpha = 1.f; }
    else { const float mn = fmaxf(m_reg, pmax); alpha = __builtin_amdgcn_exp2f(m_reg - mn); m_reg = mn; }
    const float sub = off - m_reg;
#pragma unroll
    for (int r = 0; r < 16; ++r) { p0[r] += sub; p1[r] += sub; }
#pragma unroll
    for (int r = 0; r < 16; ++r) p0[r] = __builtin_amdgcn_exp2f(p0[r]);
}
__device__ __forceinline__ void finishSM(f32x16& p0, f32x16& p1, float alpha, float& l_reg, bf16x8& pa0, bf16x8& pa1, bf16x8& pa2, bf16x8& pa3) {
#pragma unroll
    for (int r = 0; r < 16; ++r) p1[r] = __builtin_amdgcn_exp2f(p1[r]);
    float ps = 0;
#pragma unroll
    for (int r = 0; r < 16; ++r) ps += p0[r];
#pragma unroll
    for (int r = 0; r < 16; ++r) ps += p1[r];
    { auto rr = __builtin_amdgcn_permlane32_swap(__float_as_uint(ps), __float_as_uint(ps), false, false);
      ps = __uint_as_float(rr[0]) + __uint_as_float(rr[1]); }
    l_reg = l_reg * alpha + ps;
#define PK4(P, BASE, OUT) do { unsigned a0 = cvtpk(P[BASE + 0], P[BASE + 1]), a1 = cvtpk(P[BASE + 2], P[BASE + 3]);   \
    unsigned b0 = cvtpk(P[BASE + 4], P[BASE + 5]), b1 = cvtpk(P[BASE + 6], P[BASE + 7]);                              \
    auto r0 = __builtin_amdgcn_permlane32_swap(a0, b0, false, false); auto r1 = __builtin_amdgcn_permlane32_swap(a1, b1, false, false); \
    u32x4 w = {r0[0], r1[0], r0[1], r1[1]}; OUT = __builtin_bit_cast(bf16x8, w); } while (0)
    PK4(p0, 0, pa0); PK4(p0, 8, pa1); PK4(p1, 0, pa2); PK4(p1, 8, pa3);
#undef PK4
}
__device__ __forceinline__ void qkt64(f32x16& p0, f32x16& p1, const LAS char* Ks, const bf16x8* qr, int r32, int hi) {
#pragma unroll
    for (int d0 = 0; d0 < 4; ++d0) { const int cb = (d0 * 16 + hi * 8) * 2;
        const bf16x8 b0 = *(const LAS bf16x8*)(Ks + KSW(r32, cb));
        const bf16x8 b1 = *(const LAS bf16x8*)(Ks + KSW(r32, cb) + 4096);
        p0 = __builtin_amdgcn_mfma_f32_32x32x16_bf16(b0, qr[d0], p0, 0, 0, 0); p1 = __builtin_amdgcn_mfma_f32_32x32x16_bf16(b1, qr[d0], p1, 0, 0, 0); }
}
template <int NCB> __device__ __forceinline__ int v_st(int k, int c) { const int kk = (k & ~0xC) | ((k & 4) << 1) | ((k & 8) >> 1); return ((kk >> 3) * NCB + (c >> 5)) * 512 + ((kk & 7) * 32 + (c & 31)) * 2; }
__device__ __forceinline__ int v_rd_base(int lane) { return ((lane & 3) << 3) | (((lane >> 2) & 3) << 6) | (((lane >> 4) & 1) << 5) | (((lane >> 5) & 1) << 8); }
template <int NCB> constexpr int v_rd_off(int d0, int ks, int half) { return d0 * 512 + ks * (NCB * 1024) + half * (NCB * 512); }
template <int OFF> __device__ __forceinline__ s16x4 tr_read(int vb) { s16x4 r; asm volatile("ds_read_b64_tr_b16 %0, %1 offset:%2" : "=&v"(r) : "v"(vb), "i"(OFF) : "memory"); return r; }
template <int NCB, int D0> __device__ __forceinline__ void pv_one(f32x16& od, int vb, bf16x8 pa0, bf16x8 pa1, bf16x8 pa2, bf16x8 pa3) {
    const s16x4 l0 = tr_read<v_rd_off<NCB>(D0, 0, 0)>(vb), h0 = tr_read<v_rd_off<NCB>(D0, 0, 1)>(vb), l1 = tr_read<v_rd_off<NCB>(D0, 1, 0)>(vb), h1 = tr_read<v_rd_off<NCB>(D0, 1, 1)>(vb);
    const s16x4 l2 = tr_read<v_rd_off<NCB>(D0, 2, 0)>(vb), h2 = tr_read<v_rd_off<NCB>(D0, 2, 1)>(vb), l3 = tr_read<v_rd_off<NCB>(D0, 3, 0)>(vb), h3 = tr_read<v_rd_off<NCB>(D0, 3, 1)>(vb);
    asm volatile("s_waitcnt lgkmcnt(0)" ::: "memory"); SBAR();
#define PK(L, H) (bf16x8){L[0], L[1], L[2], L[3], H[0], H[1], H[2], H[3]}
    od = __builtin_amdgcn_mfma_f32_32x32x16_bf16(pa0, PK(l0, h0), od, 0, 0, 0);
    od = __builtin_amdgcn_mfma_f32_32x32x16_bf16(pa1, PK(l1, h1), od, 0, 0, 0);
    od = __builtin_amdgcn_mfma_f32_32x32x16_bf16(pa2, PK(l2, h2), od, 0, 0, 0);
    od = __builtin_amdgcn_mfma_f32_32x32x16_bf16(pa3, PK(l3, h3), od, 0, 0, 0);
#undef PK
}

constexpr int D_V = 0, D_K = 49152, D_WS = 81920, D_TB = 83968, D_ST = 86016, D_END = D_ST + 65536;
constexpr int NT = SEQ / 64;

typedef short v4i16_t __attribute__((ext_vector_type(4)));
__device__ __forceinline__ s16x4 vtr(const LAS char* p) { return __builtin_bit_cast(s16x4, __builtin_amdgcn_ds_read_tr16_b64_v4i16((LAS v4i16_t*)p)); }
#define PIN(x) asm volatile("" : "+v"(x))
#define MX3(a, b, c) __builtin_fmaxf(__builtin_fmaxf((a), (b)), (c))
#define EX(v) __builtin_amdgcn_exp2f(v)
#define MFMA32(a, b, c) __builtin_amdgcn_mfma_f32_32x32x16_bf16((a), (b), (c), 0, 0, 0)
constexpr float THRL = 6.0f;
__device__ __forceinline__ float rowmax32(const f32x16& C0, const f32x16& C1) {
    float a = MX3(C0[0], C0[1], C1[0]), b = MX3(C0[2], C0[3], C1[1]); a = MX3(a, C1[2], C1[3]);
#pragma unroll
    for (int r = 4; r < 16; r += 4) { a = MX3(a, C0[r], C0[r + 1]); b = MX3(b, C0[r + 2], C0[r + 3]); a = MX3(a, C1[r], C1[r + 1]); b = MX3(b, C1[r + 2], C1[r + 3]); }
    float rm = __builtin_fmaxf(a, b);
    auto rr = __builtin_amdgcn_permlane32_swap(__float_as_uint(rm), __float_as_uint(rm), false, false);
    return __builtin_fmaxf(__uint_as_float(rr[0]), __uint_as_float(rr[1]));
}
__device__ __forceinline__ void diff_pass(f32x16 (&o)[4], float& l_out, const bf16_t* Qw, const bf16_t* __restrict__ Kh, const bf16_t* __restrict__ Vh,
                                          LAS char* lds, int qa, float cL, float cR) {
    const int tid = threadIdx.x, wid = __builtin_amdgcn_readfirstlane(tid >> 6), lane = tid & 63, r32 = lane & 31, hi = lane >> 5;
    LAS char* V_lds = lds + D_V; LAS char* K_lds = lds + D_K;
    LAS float* wsf = (LAS float*)(lds + D_WS) + wid * 64 + 32;
    const LAS float* tb = (const LAS float*)(lds + D_TB);
#pragma unroll
    for (int d = 0; d < 4; ++d) o[d] = f32x16{};
    bf16x8 qr[4];
#pragma unroll
    for (int d0 = 0; d0 < 4; ++d0) qr[d0] = *(const bf16x8*)(Qw + d0 * 16);
#pragma unroll
    for (int d0 = 0; d0 < 4; ++d0) PIN(qr[d0]);
    const bf16_t* ksrc; const bf16_t* vsrc0;
    { const int row = wid * 8 + (lane >> 3), pos = lane & 7;
      ksrc = Kh + (long)row * PITCH + ((pos ^ ((row >> 1) & 7)) * 8);
      vsrc0 = Vh + (long)row * PITCH + ((pos ^ (((row >> 1) & 1) << 2)) * 8); }
    const LAS char* kq[4];
    { const int sw = (r32 >> 1) & 7;
#pragma unroll
      for (int d0 = 0; d0 < 4; ++d0) kq[d0] = K_lds + r32 * 128 + (((2 * d0 + hi) ^ sw) << 4); }
    const LAS char* vpe; const LAS char* vpo;
    { const int q = (lane & 15) >> 2, p = lane & 3, g = (lane >> 4) & 1, sw = (q >> 1) & 1;
      vpe = V_lds + (4 * hi + q) * 128 + sw * 64 + g * 32 + p * 8; vpo = V_lds + (4 * hi + q) * 128 + (sw ^ 1) * 64 + g * 32 + p * 8; }
#define DMA_K(j, ko) __builtin_amdgcn_global_load_lds((const unsigned*)(ksrc + (long)(j) * 64 * PITCH), (LAS unsigned*)(K_lds + (ko) + wid * 1024), 16, 0, 0)
#define DMA_V(j, vo) do { __builtin_amdgcn_global_load_lds((const unsigned*)(vsrc0 + (long)(j) * 64 * PITCH), (LAS unsigned*)(V_lds + (vo) + wid * 1024), 16, 0, 0); \
    __builtin_amdgcn_global_load_lds((const unsigned*)(vsrc0 + 64 + (long)(j) * 64 * PITCH), (LAS unsigned*)(V_lds + (vo) + 8192 + wid * 1024), 16, 0, 0); } while (0)
#define WAIT_BAR(N) do { asm volatile("s_waitcnt vmcnt(" #N ") lgkmcnt(0)" ::: "memory"); __builtin_amdgcn_s_barrier(); asm volatile("" ::: "memory"); } while (0)
    float mhat, l_reg = 0.f; bool resc = false;
    f32x16 pA0, pA1, pB0, pB1;
    bf16x8 kf[4]; s16x4 vlo[6], vhi[6]; u32x4 pw0, pw1, pw2, pw3;
#define KRD(i, KS) do { kf[(i) & 3] = *(const LAS bf16x8*)(kq[(i) >> 1] + (KS) + ((i) & 1) * 4096); } while (0)
    WAIT_BAR(0);
    DMA_K(0, 0); DMA_K(1, 8192); DMA_V(0, 0); DMA_K(2, 16384); DMA_K(3, 24576); DMA_V(1, 16384);
    WAIT_BAR(7);
    {
        float off0 = 0.f; const int d_ = -qa;
        if (d_ <= -154) { pA0 = f32x16{}; pA1 = f32x16{}; off0 = cL; }
        else { const LAS float* t_ = tb + (d_ + 256 + 4 * hi - r32);
#pragma unroll
            for (int r = 0; r < 16; ++r) { pA0[r] = t_[(r & 3) + 8 * (r >> 2)]; pA1[r] = t_[32 + (r & 3) + 8 * (r >> 2)]; } }
#pragma unroll
        for (int d0 = 0; d0 < 4; ++d0) { const bf16x8 k0_ = *(const LAS bf16x8*)(kq[d0]), k1_ = *(const LAS bf16x8*)(kq[d0] + 4096);
            pA0 = MFMA32(k0_, qr[d0], pA0); pA1 = MFMA32(k1_, qr[d0], pA1); }
        const float rm = rowmax32(pA0, pA1);
        mhat = rm + off0;
#pragma unroll
        for (int r = 0; r < 16; ++r) { pA0[r] = EX(pA0[r] - rm); pA1[r] = EX(pA1[r] - rm); }
    }
    WAIT_BAR(3);
    KRD(0, 8192); KRD(1, 8192); KRD(2, 8192); KRD(3, 8192);
#define PKW(P, B) cvtpk(P[B], P[(B) + 1])
#define PAF(k) __builtin_bit_cast(bf16x8, pw##k)
#define VFR(i) (bf16x8){vlo[(i) % 6][0], vlo[(i) % 6][1], vlo[(i) % 6][2], vlo[(i) % 6][3], vhi[(i) % 6][0], vhi[(i) % 6][1], vhi[(i) % 6][2], vhi[(i) % 6][3]}
#define VRD(i, VS) do { const LAS char* vq_ = ((((i) & 3) & 1) ? vpo : vpe) + (VS) + (((i) & 3) >> 1) * 8192 + ((i) >> 2) * 2048; vlo[(i) % 6] = vtr(vq_); vhi[(i) % 6] = vtr(vq_ + 1024); } while (0)
#define GAPA(g, CC, QI, KB, A0, A1, A2, A3, W0, W1, PW) do { CC = MFMA32(kf[(g) & 3], qr[QI], CC); if ((g) + 4 < 8) KRD((g) + 4, KB); sacc += A0; sacc += A1; sacc += A2; sacc += A3; PIN(sacc); W0; W1; PIN(PW); SBAR(); } while (0)
#define GAPB(i, X, B, VB, KN, PRE) do { o[(i) & 3] = MFMA32(PAF_SEL(i), VFR(i), o[(i) & 3]); X[B] = EX(X[B]); X[(B) + 1] = EX(X[(B) + 1]); PIN(X); if ((i) + 5 < 16) VRD((i) + 5, VB); \
    if ((PRE) && (i) >= 8 && (i) < 12) KRD((i) - 8, KN); SBAR(); } while (0)
#define PAF_SEL(i) (((i) >> 2) == 0 ? PAF(0) : ((i) >> 2) == 1 ? PAF(1) : ((i) >> 2) == 2 ? PAF(2) : PAF(3))
#define STEP(C0, C1, P0, P1, t, KB, VB, KN, PRE) do { SBAR(); \
    { const int d_ = (t) * 64 - qa; \
      if (d_ > -154 && d_ < 122) { const LAS float* t_ = tb + (d_ + 256 + 4 * hi - r32); \
        _Pragma("unroll") for (int r = 0; r < 16; ++r) { C0[r] = t_[(r & 3) + 8 * (r >> 2)] - mhat; C1[r] = t_[32 + (r & 3) + 8 * (r >> 2)] - mhat; } } \
      else { const float cs_ = (d_ < 0 ? cL : cR) - mhat; _Pragma("unroll") for (int r = 0; r < 16; ++r) { C0[r] = cs_; C1[r] = cs_; } } } \
    PIN(C0); PIN(C1); SBAR(); \
    float sacc = (P0[0] + P0[1]); \
    GAPA(0, C0, 0, KB, P0[2],  P0[3],  P0[4],  P0[5],  pw0[0] = PKW(P0, 0),  pw0[1] = PKW(P0, 2),  pw0); \
    GAPA(1, C1, 0, KB, P0[6],  P0[7],  P0[8],  P0[9],  pw0[2] = PKW(P0, 4),  pw0[3] = PKW(P0, 6),  pw0); \
    GAPA(2, C0, 1, KB, P0[10], P0[11], P0[12], P0[13], pw1[0] = PKW(P0, 8),  pw1[1] = PKW(P0, 10), pw1); \
    GAPA(3, C1, 1, KB, P0[14], P0[15], P1[0],  P1[1],  pw1[2] = PKW(P0, 12), pw1[3] = PKW(P0, 14), pw1); \
    GAPA(4, C0, 2, KB, P1[2],  P1[3],  P1[4],  P1[5],  pw2[0] = PKW(P1, 0),  pw2[1] = PKW(P1, 2),  pw2); \
    GAPA(5, C1, 2, KB, P1[6],  P1[7],  P1[8],  P1[9],  pw2[2] = PKW(P1, 4),  pw2[3] = PKW(P1, 6),  pw2); \
    GAPA(6, C0, 3, KB, P1[10], P1[11], P1[12], P1[13], pw3[0] = PKW(P1, 8),  pw3[1] = PKW(P1, 10), pw3); \
    GAPA(7, C1, 3, KB, P1[14], P1[15], 0.f,    0.f,    pw3[2] = PKW(P1, 12), pw3[3] = PKW(P1, 14), pw3); \
    l_reg += sacc; \
    VRD(0, VB); VRD(1, VB); VRD(2, VB); VRD(3, VB); VRD(4, VB); \
    { const float rm = rowmax32(C0, C1); resc = false; \
      if (__builtin_expect(__any(rm > THRL), 0)) { const float dl = __builtin_fmaxf(rm, 0.f); mhat += dl; \
        _Pragma("unroll") for (int r = 0; r < 16; ++r) { C0[r] -= dl; C1[r] -= dl; } \
        const float f = EX(-dl); l_reg *= f; if (hi == 0) wsf[r32] = f; resc = true; } } \
    SBAR(); \
    GAPB(0, C0, 0, VB, KN, PRE);  GAPB(1, C0, 2, VB, KN, PRE);  GAPB(2, C0, 4, VB, KN, PRE);   GAPB(3, C0, 6, VB, KN, PRE); \
    GAPB(4, C0, 8, VB, KN, PRE);  GAPB(5, C0, 10, VB, KN, PRE); GAPB(6, C0, 12, VB, KN, PRE);  GAPB(7, C0, 14, VB, KN, PRE); \
    GAPB(8, C1, 0, VB, KN, PRE);  GAPB(9, C1, 2, VB, KN, PRE);  GAPB(10, C1, 4, VB, KN, PRE);  GAPB(11, C1, 6, VB, KN, PRE); \
    GAPB(12, C1, 8, VB, KN, PRE); GAPB(13, C1, 10, VB, KN, PRE); GAPB(14, C1, 12, VB, KN, PRE); GAPB(15, C1, 14, VB, KN, PRE); \
    } while (0)
#define RESC() do { if (resc) { asm volatile("s_waitcnt lgkmcnt(0)" ::: "memory"); \
    _Pragma("unroll") for (int d = 0; d < 4; ++d) _Pragma("unroll") for (int r = 0; r < 16; ++r) o[d][r] *= wsf[crow(r, hi)]; } } while (0)
    int ks_cur = 8192, ks_n1 = 16384, ks_n3 = 0;
    int vs_prev = 0, vs_next = 32768;
#define ROT() do { ks_cur = (ks_cur + 8192) & 24576; ks_n1 = (ks_n1 + 8192) & 24576; ks_n3 = (ks_n3 + 8192) & 24576; vs_prev = vs_prev == 32768 ? 0 : vs_prev + 16384; vs_next = vs_next == 32768 ? 0 : vs_next + 16384; } while (0)
#define STEPX(C0, C1, P0, P1, t, PRE) STEP(C0, C1, P0, P1, t, ks_cur, vs_prev, ks_n1, PRE)
#pragma unroll 1
    for (int t = 1; t + 4 < NT; t += 2) {
        DMA_K(t + 3, ks_n3); DMA_V(t + 1, vs_next);
        STEPX(pB0, pB1, pA0, pA1, t, true);
        WAIT_BAR(3); RESC(); ROT();
        DMA_K(t + 4, ks_n3); DMA_V(t + 2, vs_next);
        STEPX(pA0, pA1, pB0, pB1, t + 1, true);
        WAIT_BAR(3); RESC(); ROT();
    }
    DMA_V(NT - 2, vs_next);
    STEPX(pB0, pB1, pA0, pA1, NT - 3, true);
    WAIT_BAR(2); RESC(); ROT();
    DMA_V(NT - 1, vs_next);
    STEPX(pA0, pA1, pB0, pB1, NT - 2, true);
    WAIT_BAR(2); RESC(); ROT();
    STEPX(pB0, pB1, pA0, pA1, NT - 1, false);
    WAIT_BAR(0); RESC(); ROT();
    { float sacc = 0.f;
#pragma unroll
      for (int r = 0; r < 16; ++r) sacc += pB0[r];
#pragma unroll
      for (int r = 0; r < 16; ++r) sacc += pB1[r];
      l_reg += sacc;
      pw0 = (u32x4){PKW(pB0, 0), PKW(pB0, 2), PKW(pB0, 4), PKW(pB0, 6)}; pw1 = (u32x4){PKW(pB0, 8), PKW(pB0, 10), PKW(pB0, 12), PKW(pB0, 14)};
      pw2 = (u32x4){PKW(pB1, 0), PKW(pB1, 2), PKW(pB1, 4), PKW(pB1, 6)}; pw3 = (u32x4){PKW(pB1, 8), PKW(pB1, 10), PKW(pB1, 12), PKW(pB1, 14)};
      SBAR();
#define DRAIN(i) do { VRD(i, vs_prev); o[(i) & 3] = MFMA32(PAF_SEL(i), VFR(i), o[(i) & 3]); } while (0)
      DRAIN(0); DRAIN(1); DRAIN(2); DRAIN(3); DRAIN(4); DRAIN(5); DRAIN(6); DRAIN(7); DRAIN(8); DRAIN(9); DRAIN(10); DRAIN(11); DRAIN(12); DRAIN(13); DRAIN(14); DRAIN(15);
#undef DRAIN
    }
    { auto rr = __builtin_amdgcn_permlane32_swap(__float_as_uint(l_reg), __float_as_uint(l_reg), false, false); l_out = __uint_as_float(rr[0]) + __uint_as_float(rr[1]); }
#undef DMA_K
#undef DMA_V
#undef WAIT_BAR
#undef ROT
#undef KRD
#undef PKW
#undef PAF
#undef VFR
#undef VRD
#undef GAPA
#undef GAPB
#undef PAF_SEL
#undef STEP
#undef STEPX
#undef RESC
}

__device__ __forceinline__ void diff_unit(int b, int h, int qb, const bf16_t* P, bf16_t* O, LAS char* lds, float lam, const float* relb) {
    const int tid = threadIdx.x, wid = __builtin_amdgcn_readfirstlane(tid >> 6), lane = tid & 63, r32 = lane & 31, hi = lane >> 5;
    const long rowbase = (long)b * SEQ; const int q0 = qb * 256, qa = q0 + wid * 32;
    LAS float* tb = (LAS float*)(lds + D_TB);
    LAS float* li_l = (LAS float*)(lds + D_WS) + wid * 64;
    tb[tid] = relb[rel_bucket(tid - 256) * NBH + h] * LOG2E;
    const float cL = relb[15 * NBH + h] * LOG2E, cR = relb[31 * NBH + h] * LOG2E;
    const bf16_t* Qrow = P + (rowbase + qa + r32) * PITCH + C_DQ + h * 128 + hi * 8;
    const bf16_t* Kh = P + rowbase * PITCH + C_DK + h * 128;
    const bf16_t* Vh = P + rowbase * PITCH + C_DV + h * 128;
    LAS u32x4* stash = (LAS u32x4*)(lds + D_ST + wid * 8192);
    f32x16 o[4]; float l_reg;
#pragma unroll 1
    for (int pass = 0; pass < 2; ++pass) {
        const int mo = pass == 0 ? 64 : 0;
        diff_pass(o, l_reg, Qrow + mo, Kh + mo, Vh, lds, qa, cL, cR);
        int ln = lane; asm volatile("" : "+v"(ln));
        const int r32e = ln & 31, hie = ln >> 5;
        if (hie == 0) li_l[r32e] = l_reg; asm volatile("s_waitcnt lgkmcnt(0)" ::: "memory");
        if (pass == 0) {
            float rli[16];
#pragma unroll
            for (int r = 0; r < 16; ++r) rli[r] = -lam * __builtin_amdgcn_rcpf(li_l[crow(r, hie)]);
#pragma unroll
            for (int d0 = 0; d0 < 4; ++d0) {
                u32x4 w0, w1;
                w0.x = cvtpk(o[d0][0] * rli[0], o[d0][1] * rli[1]); w0.y = cvtpk(o[d0][2] * rli[2], o[d0][3] * rli[3]); w0.z = cvtpk(o[d0][4] * rli[4], o[d0][5] * rli[5]); w0.w = cvtpk(o[d0][6] * rli[6], o[d0][7] * rli[7]);
                w1.x = cvtpk(o[d0][8] * rli[8], o[d0][9] * rli[9]); w1.y = cvtpk(o[d0][10] * rli[10], o[d0][11] * rli[11]); w1.z = cvtpk(o[d0][12] * rli[12], o[d0][13] * rli[13]); w1.w = cvtpk(o[d0][14] * rli[14], o[d0][15] * rli[15]);
                stash[(2 * d0) * 64 + ln] = w0; stash[(2 * d0 + 1) * 64 + ln] = w1;
            }
        } else {
            float rli[16], ssq[16];
#pragma unroll
            for (int r = 0; r < 16; ++r) { rli[r] = __builtin_amdgcn_rcpf(li_l[crow(r, hie)]); ssq[r] = 0.f; }
#pragma unroll
            for (int d0 = 0; d0 < 4; ++d0) {
                const u32x4 w0 = stash[(2 * d0) * 64 + ln], w1 = stash[(2 * d0 + 1) * 64 + ln];
                const unsigned ww[8] = {w0.x, w0.y, w0.z, w0.w, w1.x, w1.y, w1.z, w1.w};
#pragma unroll
                for (int r = 0; r < 16; ++r) { const float c = __uint_as_float((r & 1) ? (ww[r >> 1] & 0xffff0000u) : (ww[r >> 1] << 16));
                    const float x = fmaf(o[d0][r], rli[r], c); o[d0][r] = x; ssq[r] = fmaf(x, x, ssq[r]); }
            }
            asm volatile("s_waitcnt lgkmcnt(0)" ::: "memory");
#pragma unroll
            for (int r = 0; r < 16; ++r) { float s = ssq[r];
                s += __shfl_xor(s, 1); s += __shfl_xor(s, 2); s += __shfl_xor(s, 4); s += __shfl_xor(s, 8); s += __shfl_xor(s, 16);
                ssq[r] = __builtin_amdgcn_rsqf(s * (1.0f / 128.0f) + EPS); }
            LAS bf16_t* stg = (LAS bf16_t*)(lds + D_ST + wid * 8192);
#pragma unroll
            for (int r = 0; r < 16; ++r) { const int orow = crow(r, hie);
#pragma unroll
                for (int d0 = 0; d0 < 4; ++d0) stg[orow * 128 + d0 * 32 + r32e] = (bf16_t)(cvtpk(o[d0][r] * ssq[r], 0.f) & 0xffffu); }
            asm volatile("s_waitcnt lgkmcnt(0)" ::: "memory");
            bf16_t* Ow = O + (rowbase + qa + (ln >> 4)) * DM + h * 128 + (ln & 15) * 8;
            const LAS bf16_t* sl = stg + (ln >> 4) * 128 + (ln & 15) * 8;
#pragma unroll
            for (int i = 0; i < 8; ++i) { const u32x4 v = *(const LAS u32x4*)(sl + i * 512); *(u32x4*)(Ow + (long)i * 4 * DM) = v; }
        }
    }
    asm volatile("s_waitcnt lgkmcnt(0)" ::: "memory"); __syncthreads();
}

constexpr int W_K = 0, W_V = 49152, W_TB = 98304, W_WS = 106496, W_OST = 108544, W_END = W_OST + 32768;
__device__ __forceinline__ void win_unit(int b, int kvh, int qb, const bf16_t* P, bf16_t* O, LAS char* lds, const float* relb, const float* sink) {
    const int tid = threadIdx.x, wid = __builtin_amdgcn_readfirstlane(tid >> 6), lane = tid & 63, r32 = lane & 31, hi = lane >> 5;
    const long rowbase = (long)b * SEQ; const int q0 = qb * 128, kbase = q0 - 128;
    LAS float* tbw = (LAS float*)(lds + W_TB);
#pragma unroll
    for (int e = 0; e < 4; ++e) { const int idx = tid + e * 512, g = idx >> 9, rel = (idx & 511) - 256;
        tbw[idx] = (rel >= -128 && rel <= 128) ? (relb[rel_bucket(rel) * NBH + 4 + 4 * kvh + g] - sink[4 * kvh + g]) * LOG2E : -1e30f; }
    { int tl = tid; asm volatile("" : "+v"(tl));
      const int kr = tl >> 3, kc = (tl & 7) * 8, kst = KSW(kr, kc * 2), vst = v_st<2>(kr, kc);
      const bf16_t* Kh = P + rowbase * PITCH + C_WK + kvh * 64; const bf16_t* Vh = P + rowbase * PITCH + C_WV + kvh * 64;
      bf16x8 kreg[6], vreg[6];
#pragma unroll
      for (int t = 0; t < 6; ++t) { const int k0 = kbase + 64 * t; if (k0 >= 0 && k0 < SEQ) { kreg[t] = *(const bf16x8*)(&Kh[(long)(k0 + kr) * PITCH + kc]); vreg[t] = *(const bf16x8*)(&Vh[(long)(k0 + kr) * PITCH + kc]); } }
#pragma unroll
      for (int t = 0; t < 6; ++t) { const int k0 = kbase + 64 * t; if (k0 >= 0 && k0 < SEQ) { *(LAS bf16x8*)(lds + W_K + t * 8192 + kst) = kreg[t]; *(LAS bf16x8*)(lds + W_V + t * 8192 + vst) = vreg[t]; } }
    }
    __syncthreads();
    const int g = wid >> 1, hq = 4 * kvh + g;
    LAS float* li_l = (LAS float*)(lds + W_WS) + wid * 64;
    const LAS float* tbg = tbw + g * 512;
    const int vbw = (int)(uintptr_t)(lds + W_V) + v_rd_base(lane);
#pragma unroll 1
    for (int jb = 0; jb < 2; ++jb) {
        const int ql = 64 * (wid & 1) + 32 * jb;
        const bf16_t* Qw = P + (rowbase + q0 + ql + r32) * PITCH + C_WQ + hq * 64 + hi * 8;
        bf16x8 qr[4];
#pragma unroll
        for (int d0 = 0; d0 < 4; ++d0) qr[d0] = *(const bf16x8*)(Qw + d0 * 16);
        float l_reg = 0.f;
        f32x16 o[2]; o[0] = f32x16{}; o[1] = f32x16{};
        const int t_lo = ql >> 6;
#pragma unroll 1
        for (int t = t_lo; t < t_lo + 5; ++t) {
            const int k0 = kbase + 64 * t; if (k0 < 0 || k0 >= SEQ) continue;
            const int d_ = 64 * t - 128 - ql;
            const LAS float* t_ = tbg + (d_ + 256 + 4 * hi - r32);
            f32x16 p0, p1;
#pragma unroll
            for (int r = 0; r < 16; ++r) { p0[r] = t_[(r & 3) + 8 * (r >> 2)]; p1[r] = t_[32 + (r & 3) + 8 * (r >> 2)]; }
            qkt64(p0, p1, lds + W_K + t * 8192, qr, r32, hi);
#pragma unroll
            for (int r = 0; r < 16; ++r) { p0[r] = __builtin_amdgcn_exp2f(p0[r]); p1[r] = __builtin_amdgcn_exp2f(p1[r]); }
            bf16x8 pa0, pa1, pa2, pa3;
            {
                float ps = 0;
#pragma unroll
                for (int r = 0; r < 16; ++r) ps += p0[r];
#pragma unroll
                for (int r = 0; r < 16; ++r) ps += p1[r];
                l_reg += ps;
#define PK4(Pv, BASE, OUT) do { unsigned a0 = cvtpk(Pv[BASE + 0], Pv[BASE + 1]), a1 = cvtpk(Pv[BASE + 2], Pv[BASE + 3]);   \
    unsigned b0 = cvtpk(Pv[BASE + 4], Pv[BASE + 5]), b1 = cvtpk(Pv[BASE + 6], Pv[BASE + 7]);                              \
    auto r0 = __builtin_amdgcn_permlane32_swap(a0, b0, false, false); auto r1 = __builtin_amdgcn_permlane32_swap(a1, b1, false, false); \
    u32x4 w = {r0[0], r1[0], r0[1], r1[1]}; OUT = __builtin_bit_cast(bf16x8, w); } while (0)
                PK4(p0, 0, pa0); PK4(p0, 8, pa1); PK4(p1, 0, pa2); PK4(p1, 8, pa3);
#undef PK4
            }
            const int vb = vbw + t * 8192;
            pv_one<2, 0>(o[0], vb, pa0, pa1, pa2, pa3); pv_one<2, 1>(o[1], vb, pa0, pa1, pa2, pa3);
        }
        { auto rr = __builtin_amdgcn_permlane32_swap(__float_as_uint(l_reg), __float_as_uint(l_reg), false, false); l_reg = 1.0f + __uint_as_float(rr[0]) + __uint_as_float(rr[1]); }
        int ln = lane; asm volatile("" : "+v"(ln));
        const int r32e = ln & 31, hie = ln >> 5;
        if (hie == 0) li_l[r32e] = l_reg; asm volatile("s_waitcnt lgkmcnt(0)" ::: "memory");
        float rli[16];
#pragma unroll
        for (int r = 0; r < 16; ++r) rli[r] = __builtin_amdgcn_rcpf(li_l[crow(r, hie)]);
        LAS bf16_t* stg = (LAS bf16_t*)(lds + W_OST + wid * 4096);
#pragma unroll
        for (int r = 0; r < 16; ++r) { const int orow = crow(r, hie);
#pragma unroll
            for (int d0 = 0; d0 < 2; ++d0) stg[orow * 64 + d0 * 32 + r32e] = (bf16_t)(cvtpk(o[d0][r] * rli[r], 0.f) & 0xffffu); }
        asm volatile("s_waitcnt lgkmcnt(0)" ::: "memory");
        bf16_t* Ow = O + (rowbase + q0 + ql + (ln >> 3)) * DM + 512 + hq * 64 + (ln & 7) * 8;
        const LAS bf16_t* sl = stg + (ln >> 3) * 64 + (ln & 7) * 8;
#pragma unroll
        for (int i = 0; i < 4; ++i) { const u32x4 v = *(const LAS u32x4*)(sl + i * 512); *(u32x4*)(Ow + (long)i * 8 * DM) = v; }
        asm volatile("s_waitcnt lgkmcnt(0)" ::: "memory");
    }
    asm volatile("s_waitcnt lgkmcnt(0)" ::: "memory"); __syncthreads();
}
#undef SBAR
#undef KSW
}

constexpr size_t MiB = 1u << 20;
constexpr size_t WS_CTL = 0, CTL_ZERO_BYTES = 64 * 1024;
constexpr size_t WS_W1 = 1 * MiB;
constexpr size_t WS_W2 = WS_W1 + (size_t)DIN * DM * 2;
constexpr size_t WS_W3 = WS_W2 + (size_t)DM * DM * 2;
constexpr size_t WS_W4 = WS_W3 + (size_t)2 * DFF * DM * 2;
constexpr size_t WS_SSQ = 24 * MiB;
constexpr size_t WS_XB = 28 * MiB;
constexpr size_t WS_RSTD1 = 27 * MiB;
constexpr size_t WS_FA = 25 * MiB;
constexpr size_t WS_X1Q = WS_XB;
constexpr size_t WS_XQ = 436 * MiB;
constexpr size_t WS_FX = 26 * MiB;
constexpr int CW_WMAX1 = 13824, CW_W1CNT = 16200;
constexpr int CW_WMAX = 8192;
constexpr size_t WS_OB = 340 * MiB;
constexpr size_t WS_PROJ = 124 * MiB;
constexpr size_t WS_X1B = 125 * MiB;
constexpr size_t WS_ACT = 222 * MiB;
constexpr size_t WS_END = WS_ACT + (size_t)NTOK * DFF * 2;
static_assert(WS_OB + (size_t)NTOK * DM * 2 <= WS_XQ && WS_XQ + (size_t)NTOK * DM <= WS_END && WS_PROJ + (size_t)NTOK * DIN * 2 <= WS_XQ, "d_ws map");
static_assert(CW_WMAX + 2 * DFF <= CW_WMAX1 && CW_WMAX1 + DIN <= CW_W1CNT && CW_W1CNT * 4 < CTL_ZERO_BYTES && WS_FA + (size_t)NTOK * 4 <= WS_FX && WS_FX + (size_t)NTOK * 4 <= WS_RSTD1 && WS_SSQ + (size_t)NTOK * 16 <= WS_FA && WS_FA + (size_t)NTOK * 4 <= WS_RSTD1, "d_ws map");
static_assert(WS_W4 + (size_t)DM * DFF * 2 <= WS_SSQ && WS_SSQ + (size_t)NTOK * 64 <= WS_XB && WS_XB + (size_t)NTOK * DM * 2 <= WS_PROJ, "d_ws map");
static_assert(WS_X1B + (size_t)(NTOK + 256) * DM * 2 <= WS_ACT && WS_PROJ + (size_t)NTOK * DIN * 2 <= WS_OB && WS_OB + (size_t)NTOK * DM * 2 <= WS_END && WS_SSQ + (size_t)NTOK * 16 <= WS_RSTD1 && WS_RSTD1 + (size_t)NTOK * 4 <= WS_XB, "d_ws map");
constexpr int CW_BAR = 1024;

constexpr int RING_BYTES = 131072, EPX_OFF = RING_BYTES, LDS_BYTES = 163840, MISC_OFF = LDS_BYTES - 512;
static_assert(att::D_END <= MISC_OFF && att::W_END <= MISC_OFF && EPX_OFF + 22528 <= MISC_OFF, "LDS map");

typedef GAS unsigned gu32;
#define RLX_AGENT __ATOMIC_RELAXED, __HIP_MEMORY_SCOPE_AGENT
#define LDS_WAIT() asm volatile("s_waitcnt lgkmcnt(0)" ::: "memory")

#define XB_TMO      128
#define XB_XCNT(j)  (256  + 64 * (j))
#define XB_XSUB(j)  (1280 + 64 * (j))
#define XB_XGEN(j)  (2304 + 64 * (j))
#define XB_TOP      3328
#define XB_TOPGEN   3392
#define XCD_BAR_WORDS 3456
#define XB_SPIN_CAP (1u << 22)
__device__ __forceinline__ unsigned xb_ld(unsigned* p)              { return __hip_atomic_load(p, __ATOMIC_RELAXED, __HIP_MEMORY_SCOPE_AGENT); }
__device__ __forceinline__ unsigned xb_add(unsigned* p, unsigned v) { return __hip_atomic_fetch_add(p, v, __ATOMIC_RELAXED, __HIP_MEMORY_SCOPE_AGENT); }
__device__ __forceinline__ unsigned xb_xcc_id() { return (unsigned)__builtin_amdgcn_s_getreg((3 << 11) | 20) & 0xFu; }
#define XB_SPIN(cond, bar) do { unsigned _sp = 0; while (cond) { __builtin_amdgcn_s_sleep(1); \
    if ((++_sp & 255u) == 0u) { if (xb_ld(&(bar)[XB_TMO])) break; if (_sp > XB_SPIN_CAP) { atomicAdd(&(bar)[XB_TMO], 1u); break; } } } } while (0)
struct XcdBarrier { unsigned* bar; unsigned x; volatile LAS unsigned* st; };
__device__ __forceinline__ XcdBarrier xcd_barrier_post(unsigned* bar, volatile LAS unsigned* st) {
    XcdBarrier b; b.bar = bar; b.x = xb_xcc_id(); b.st = st;
    if (threadIdx.x == 0) (void)xb_add(&bar[XB_XCNT(b.x)], 1u);
    return b;
}
__device__ __forceinline__ void xcd_barrier_complete(unsigned* bar, unsigned x, unsigned& nloc, unsigned& nx) {
    const unsigned G = gridDim.x * gridDim.y * gridDim.z;
    unsigned sum, cnt, mine, sp = 0u;
    for (;;) {
        sum = 0u; cnt = 0u; mine = 0u;
#pragma unroll
        for (unsigned j = 0; j < 16; ++j) { const unsigned c = xb_ld(&bar[XB_XCNT(j)]); sum += c; cnt += (c > 0u) ? 1u : 0u; mine = (j == x) ? c : mine; }
        if (sum == G) break;
        __builtin_amdgcn_s_sleep(1);
        if ((++sp & 255u) == 0u) { if (xb_ld(&bar[XB_TMO])) break; if (sp > XB_SPIN_CAP) { atomicAdd(&bar[XB_TMO], 1u); break; } }
    }
    nloc = mine > 0u ? mine : 1u; nx = cnt > 0u ? cnt : 1u;
}
__device__ __forceinline__ void xcd_barrier(const XcdBarrier& b) {
    asm volatile("s_waitcnt vmcnt(0)" ::: "memory");
    __syncthreads();
    if (threadIdx.x == 0) {
        unsigned* bar = b.bar;
        __builtin_amdgcn_s_waitcnt(0);
        unsigned nloc = b.st[0], nx = b.st[1];
        if (nloc == 0u) { xcd_barrier_complete(bar, b.x, nloc, nx); b.st[0] = nloc; b.st[1] = nx; }
        const unsigned old = xb_add(&bar[XB_XSUB(b.x)], 1u);
        const unsigned gen = old / nloc;
        if (old + 1u == (gen + 1u) * nloc) {
            __builtin_amdgcn_fence(__ATOMIC_RELEASE, "agent");
            asm volatile("s_waitcnt vmcnt(0)" ::: "memory");
            const unsigned og = xb_add(&bar[XB_TOP], 1u);
            const unsigned tg = og / nx;
            if (og + 1u == (tg + 1u) * nx) xb_add(&bar[XB_TOPGEN], 1u);
            else XB_SPIN(xb_ld(&bar[XB_TOPGEN]) == tg, bar);
            __builtin_amdgcn_fence(__ATOMIC_ACQUIRE, "agent");
            xb_add(&bar[XB_XGEN(b.x)], 1u);
            asm volatile("s_waitcnt vmcnt(0)" ::: "memory");
        } else {
            XB_SPIN(xb_ld(&bar[XB_XGEN(b.x)]) == gen, bar);
            __builtin_amdgcn_fence(__ATOMIC_ACQUIRE, "agent");
            asm volatile("s_waitcnt vmcnt(0)" ::: "memory");
        }
    }
    __syncthreads();
}

__device__ __forceinline__ float wave_sum(float v) {
#pragma unroll
    for (int o = 1; o < 64; o <<= 1) v += __shfl_xor(v, o);
    return v;
}
__device__ __forceinline__ unsigned f2bf(float f) { unsigned u = __builtin_bit_cast(unsigned, f); return (u + 0x7fffu + ((u >> 16) & 1u)) >> 16; }
__device__ __forceinline__ unsigned pk2(float lo, float hi) { return f2bf(lo) | (f2bf(hi) << 16); }
__device__ __forceinline__ void transpose_item(const float* W, int ld, int cbase, int K, int k0, bf16_t* WT, int nrow0, const float* fold, int foldmask, float fscale, int foldlim, LAS float* scr, int lane) {
    float wv[32];
#pragma unroll
    for (int i = 0; i < 32; ++i) wv[i] = W[(size_t)(k0 + 2 * i + (lane >> 5)) * ld + cbase + (lane & 31)];
#pragma unroll
    for (int i = 0; i < 32; ++i) { const int kk = 2 * i + (lane >> 5), k = k0 + kk;
        float f = 1.f; if (fold != nullptr && k < foldlim) f = fold[k & foldmask] * fscale;
        scr[kk * 33 + (lane & 31)] = wv[i] * f; }
    LDS_WAIT(); asm volatile("" ::: "memory");
    const int c = lane & 7;
#pragma unroll
    for (int j = 0; j < 4; ++j) { const int n = (lane >> 3) + 8 * j; const LAS float* s = scr + (8 * c) * 33 + n;
        u32x4 o; o.x = pk2(s[0 * 33], s[1 * 33]); o.y = pk2(s[2 * 33], s[3 * 33]); o.z = pk2(s[4 * 33], s[5 * 33]); o.w = pk2(s[6 * 33], s[7 * 33]);
        *(u32x4*)(WT + (size_t)(nrow0 + n) * K + k0 + 8 * c) = o; }
    LDS_WAIT(); asm volatile("" ::: "memory");
}

__device__ __forceinline__ void absmax_item(const float* W, int ld, int cbase, int k0, unsigned* wmax, const float* fold, int lane) {
    float wv[32];
#pragma unroll
    for (int i = 0; i < 32; ++i) wv[i] = W[(size_t)(k0 + 2 * i + (lane >> 5)) * ld + cbase + (lane & 31)];
    float m = 0.f;
#pragma unroll
    for (int i = 0; i < 32; ++i) m = __builtin_fmaxf(m, __builtin_fabsf(wv[i] * fold[k0 + 2 * i + (lane >> 5)]));
    m = __builtin_fmaxf(m, __shfl_xor(m, 32));
    if (lane < 32) (void)__hip_atomic_fetch_max(wmax + lane, __float_as_uint(m), __ATOMIC_RELAXED, __HIP_MEMORY_SCOPE_AGENT);
}
__device__ __forceinline__ unsigned q4(float a, float b, float c, float d) {
    const unsigned ua = __float_as_uint(a + 12582912.0f), ub = __float_as_uint(b + 12582912.0f), uc = __float_as_uint(c + 12582912.0f), ud = __float_as_uint(d + 12582912.0f);
    return (ua & 0xffu) | ((ub & 0xffu) << 8) | ((uc & 0xffu) << 16) | (ud << 24);
}
__device__ __forceinline__ void quant_item(const float* W, int ld, int cbase, int K, int k0, signed char* WQ, int nrow0, const float* fold, const unsigned* wmax, LAS float* scr, int lane) {
    float wv[32];
#pragma unroll
    for (int i = 0; i < 32; ++i) wv[i] = W[(size_t)(k0 + 2 * i + (lane >> 5)) * ld + cbase + (lane & 31)];
    const float am = __uint_as_float(__hip_atomic_load(wmax + (lane & 31), __ATOMIC_RELAXED, __HIP_MEMORY_SCOPE_AGENT)); const float inv = am > 0.f ? 127.0f / am : 0.f;
#pragma unroll
    for (int i = 0; i < 32; ++i) { const int kk = 2 * i + (lane >> 5); scr[kk * 33 + (lane & 31)] = wv[i] * fold[k0 + kk] * inv; }
    LDS_WAIT(); asm volatile("" ::: "memory");
    const int n = lane >> 1, c = lane & 1; const LAS float* sp = scr + (32 * c) * 33 + n;
    u32x4 o0, o1;
    o0.x = q4(sp[0 * 33], sp[1 * 33], sp[2 * 33], sp[3 * 33]);     o0.y = q4(sp[4 * 33], sp[5 * 33], sp[6 * 33], sp[7 * 33]);
    o0.z = q4(sp[8 * 33], sp[9 * 33], sp[10 * 33], sp[11 * 33]);   o0.w = q4(sp[12 * 33], sp[13 * 33], sp[14 * 33], sp[15 * 33]);
    o1.x = q4(sp[16 * 33], sp[17 * 33], sp[18 * 33], sp[19 * 33]); o1.y = q4(sp[20 * 33], sp[21 * 33], sp[22 * 33], sp[23 * 33]);
    o1.z = q4(sp[24 * 33], sp[25 * 33], sp[26 * 33], sp[27 * 33]); o1.w = q4(sp[28 * 33], sp[29 * 33], sp[30 * 33], sp[31 * 33]);
    u32x4* dst = (u32x4*)(WQ + (size_t)(nrow0 + n) * K + k0 + 32 * c);
    dst[0] = o0; dst[1] = o1;
    LDS_WAIT(); asm volatile("" ::: "memory");
}

struct Args { const float* in[22]; float* out; unsigned char* ws; int ph_lo, ph_hi, li, pad; };

__global__ void __launch_bounds__(NWAVES * 64, 2) hymba_fwd(Args args) {
    extern __shared__ __attribute__((aligned(16))) unsigned char lds_raw[];
    LAS unsigned char* lds = (LAS unsigned char*)lds_raw;
    volatile LAS unsigned* MISC = (volatile LAS unsigned*)(lds + MISC_OFF);
    const int tid = threadIdx.x, lane = tid & 63, wave = __builtin_amdgcn_readfirstlane(tid >> 6);
    const int G = gridDim.x; const int bx = blockIdx.x; const int vcu = (G % 8 == 0) ? (bx % 8) * (G / 8) + bx / 8 : bx;
    unsigned char* ws = args.ws;
    unsigned* ctl = (unsigned*)(ws + WS_CTL);
    const float* xp = args.in[0]; const float* xs = args.in[1];
    bf16_t* W1 = (bf16_t*)(ws + WS_W1); bf16_t* W2 = (bf16_t*)(ws + WS_W2); bf16_t* W3 = (bf16_t*)(ws + WS_W3); bf16_t* W4 = (bf16_t*)(ws + WS_W4);
    float* SSQ = (float*)(ws + WS_SSQ); bf16_t* XB = (bf16_t*)(ws + WS_XB); bf16_t* PROJ = (bf16_t*)(ws + WS_PROJ); bf16_t* X1B = (bf16_t*)(ws + WS_X1B); bf16_t* ACT = (bf16_t*)(ws + WS_ACT);
    bf16_t* OB = (bf16_t*)(ws + WS_OB); float* RMS1 = (float*)(ws + WS_RSTD1);
    signed char* XQ = (signed char*)(ws + WS_XQ); float* FX = (float*)(ws + WS_FX); signed char* W1Q = (signed char*)(ws + WS_W1);
    for (int u = tid; u < 128; u += NWAVES * 64) ((LAS unsigned*)(lds + MISC_OFF))[u] = 0u;
    __syncthreads();
    XcdBarrier bar; bar.bar = ctl + CW_BAR + args.li * XCD_BAR_WORDS; bar.x = 0; bar.st = nullptr;
    if (MK_N_LAUNCHES != 6) bar = xcd_barrier_post(ctl + CW_BAR + args.li * XCD_BAR_WORDS, MISC + 8);
    const int lo = args.ph_lo, hi_ph = args.ph_hi;
#ifndef ONLY_PHASE
#define ONLY_PHASE -1
#endif
#define IN(k) ((ONLY_PHASE < 0 || ONLY_PHASE == (k)) && lo <= (k) && (k) < hi_ph)
#define BOTH(k) (IN(k) && IN((k) + 1))
#define GRID_BAR() do { if (MK_N_LAUNCHES != 6) xcd_barrier(bar); } while (0)

    if (IN(0)) {
        LAS float* scr = (LAS float*)(lds + wave * 16384);
        const int gw = vcu * NWAVES + wave, NGW = G * NWAVES;
        constexpr int I1 = (DM / 64) * (DIN / 32), I2 = (DM / 64) * (DM / 32), I3 = (DM / 64) * (2 * DFF / 32), I4 = (DFF / 64) * (DM / 32);
        for (int it = gw; it < I1 + I2 + I3 + I4; it += NGW) {
            int r = it;
            if (r < I1) { const int nblk = DIN / 32, kb = r / nblk, nb = r % nblk, n0 = 32 * nb, pn = n0 >> 8, p = n0 & 255, bj = p >> 7, wc = (p & 127) >> 5;
                absmax_item(args.in[3], DIN, 256 * pn + 64 * wc + 32 * bj, 64 * kb, ctl + CW_WMAX1 + n0, args.in[2], lane);
                __builtin_amdgcn_fence(__ATOMIC_RELEASE, "agent"); if (lane == 0) (void)__hip_atomic_fetch_add(ctl + CW_W1CNT, 1u, __ATOMIC_RELAXED, __HIP_MEMORY_SCOPE_AGENT); continue; } r -= I1;
            if (r < I2) { const int nblk = DM / 32, kb = r / nblk, nb = r % nblk;
                const int n0 = 32 * nb, pn = n0 >> 8, p = n0 & 255, bj = p >> 7, wc = (p & 127) >> 5;
                transpose_item(args.in[15], DM, 256 * pn + 64 * wc + 32 * bj, DM, 64 * kb, W2, n0, args.in[10], 127, 1.0f - LAM_INIT, 512, scr, lane); continue; } r -= I2;
            if (r < I3) { const int nblk = 2 * DFF / 32, kb = r / nblk, nb = r % nblk, n0 = 32 * nb, pn = n0 >> 8, p = n0 & 255, bj = p >> 7, e0 = p & 127;
                absmax_item(bj ? args.in[18] : args.in[17], DFF, 128 * pn + e0, 64 * kb, ctl + CW_WMAX + n0, args.in[16], lane); continue; } r -= I3;
            { const int nblk = DM / 32, kb = r / nblk, nb = r % nblk;
                transpose_item(args.in[21], DM, 32 * nb, DFF, 64 * kb, W4, 32 * nb, nullptr, 0, 1.f, 0, scr, lane); }
        }
        for (int m = gw; m < NTOK; m += 4 * NGW) {
            f32x4 v[4][4]; float ss[4]; int mr[4];
#pragma unroll
            for (int q = 0; q < 4; ++q) { int mm = m + q * NGW; mr[q] = mm; if (mm >= NTOK) mm = m;
                const float* xr = mm < TOK_P ? xp + (size_t)mm * DM : xs + (size_t)(mm - TOK_P) * DM;
#pragma unroll
                for (int j = 0; j < 4; ++j) v[q][j] = __builtin_nontemporal_load((const f32x4*)xr + 64 * j + lane); }
#pragma unroll
            for (int q = 0; q < 4; ++q) { ss[q] = 0.f;
#pragma unroll
                for (int j = 0; j < 4; ++j) ss[q] += dot4(v[q][j]); }
#pragma unroll
            for (int o = 1; o < 64; o <<= 1) {
#pragma unroll
                for (int q = 0; q < 4; ++q) ss[q] += __shfl_xor(ss[q], o); }
            float am[4];
#pragma unroll
            for (int q = 0; q < 4; ++q) { float a = 0.f;
#pragma unroll
                for (int j = 0; j < 4; ++j) a = __builtin_fmaxf(__builtin_fmaxf(a, __builtin_fmaxf(__builtin_fabsf(v[q][j][0]), __builtin_fabsf(v[q][j][1]))), __builtin_fmaxf(__builtin_fabsf(v[q][j][2]), __builtin_fabsf(v[q][j][3])));
                am[q] = a; }
#pragma unroll
            for (int o = 1; o < 64; o <<= 1) {
#pragma unroll
                for (int q = 0; q < 4; ++q) am[q] = __builtin_fmaxf(am[q], __shfl_xor(am[q], o)); }
#pragma unroll
            for (int q = 0; q < 4; ++q) if (mr[q] < NTOK) { const float ms = ss[q] * (1.f / DM) + EPS; const float r = __builtin_amdgcn_rsqf(ms);
                { const float inv = am[q] > 0.f ? 127.0f / am[q] : 0.f;
                  unsigned* oq = (unsigned*)(XQ + (size_t)mr[q] * DM) + lane;
#pragma unroll
                  for (int j = 0; j < 4; ++j) oq[64 * j] = q4(v[q][j][0] * inv, v[q][j][1] * inv, v[q][j][2] * inv, v[q][j][3] * inv);
                  if (lane == 0) FX[mr[q]] = am[q] * r * (1.0f / 127.0f); }
                if (lane == 0) RMS1[mr[q]] = ms * r;
                u32x2* o8 = (u32x2*)(XB + (size_t)mr[q] * DM) + lane;
#pragma unroll
                for (int j = 0; j < 4; ++j) { u32x2 w; w.x = cvtpk(v[q][j][0] * r, v[q][j][1] * r); w.y = cvtpk(v[q][j][2] * r, v[q][j][3] * r); o8[64 * j] = w; } }
        }
        { unsigned sp = 0; while (__builtin_amdgcn_readfirstlane(__hip_atomic_load(ctl + CW_W1CNT, __ATOMIC_RELAXED, __HIP_MEMORY_SCOPE_AGENT)) < (unsigned)I1) { __builtin_amdgcn_s_sleep(2); if (++sp > (1u << 22)) break; }
          __builtin_amdgcn_fence(__ATOMIC_ACQUIRE, "agent"); }
        for (int r = gw; r < I1; r += NGW) { const int nblk = DIN / 32, kb = r / nblk, nb = r % nblk, n0 = 32 * nb, pn = n0 >> 8, p = n0 & 255, bj = p >> 7, wc = (p & 127) >> 5;
            quant_item(args.in[3], DIN, 256 * pn + 64 * wc + 32 * bj, DM, 64 * kb, W1Q, n0, args.in[2], ctl + CW_WMAX1 + n0, scr, lane); }
        if (BOTH(0)) GRID_BAR();
    }

    if (IN(1)) {
        pg8::Gemm g{(const bf16_t*)XQ, (const bf16_t*)W1Q, DM / 2, 256}; pg8::StaticOrder S; S.init(NTOK / 256, DIN / 256, G, bx);
        { LAS float* gl = (LAS float*)(lds + EPX_OFF);
          if (tid < 256) { const int v = tid >> 6, d = tid & 63; gl[tid] = (v == 0 ? args.in[4] : v == 1 ? args.in[5] : v == 2 ? args.in[11] : args.in[12])[d]; }
          LDS_WAIT(); __syncthreads(); }
        pg8::EpiProj E{PROJ, (const LAS float*)(lds + EPX_OFF), FX, (const float*)(ctl + CW_WMAX1)};
        pg8::gemm_phase<pg8::EpiProj, pg8::StaticOrder, true, true, true>(lds, g, S, E);
        if (BOTH(1)) GRID_BAR();
    }

    if (IN(2)) {
        if (wave == 0) {
            const float a = args.in[6][lane] * args.in[7][lane], b2 = args.in[8][lane] * args.in[9][lane];
            const float sa = wave_sum(a), sb = wave_sum(b2);
            if (lane == 0) ((LAS float*)(lds + MISC_OFF))[16] = __expf(sa) - __expf(sb) + LAM_INIT;
        }
        LDS_WAIT(); __syncthreads();
        const float lam = ((const LAS float*)(lds + MISC_OFF))[16];
        const int per = (768 + G - 1) / G;
#ifndef NO_DIFF
        for (int i = 0; i < per; ++i) { const int u = vcu * per + i; if (u < 768) { const int bh = u >> 3, qb = u & 7;
            att::diff_unit(bh >> 2, bh & 3, qb, PROJ, OB, (LAS char*)lds, lam, args.in[14]); } }
#endif
#ifndef NO_WIN
        for (int i = 0; i < per; ++i) { const int u = vcu * per + i; if (u < 768) { const int bk = u >> 4, qb = u & 15;
            att::win_unit(bk >> 1, bk & 1, qb, PROJ, OB, (LAS char*)lds, args.in[14], args.in[13]); } }
#endif
        if (BOTH(2)) GRID_BAR();
    }

    if (IN(3)) {
        pg8::Gemm g{OB, W2, DM, 256}; pg8::StaticOrder S; S.init(NTOK / 256, DM / 256, G, bx);
        pg8::EpiOut E{XB, RMS1, X1B, SSQ, (LAS float*)(lds + EPX_OFF)};
        pg8::gemm_phase<pg8::EpiOut, pg8::StaticOrder>(lds, g, S, E);
        if (BOTH(3)) GRID_BAR();
    }

    if (IN(4)) {
        signed char* W3Q = (signed char*)(ws + WS_W3); signed char* X1Q = (signed char*)(ws + WS_X1Q); float* FA = (float*)(ws + WS_FA);
        {
            LAS float* scr = (LAS float*)(lds + wave * 16384);
            const int gw = vcu * NWAVES + wave, NGW = G * NWAVES;
            constexpr int I3 = (DM / 64) * (2 * DFF / 32);
            for (int r = gw; r < I3; r += NGW) { const int nblk = 2 * DFF / 32, kb = r / nblk, nb = r % nblk, n0 = 32 * nb, pn = n0 >> 8, p = n0 & 255, bj = p >> 7, e0 = p & 127;
                quant_item(bj ? args.in[18] : args.in[17], DFF, 128 * pn + e0, DM, 64 * kb, W3Q, n0, args.in[16], ctl + CW_WMAX + n0, scr, lane); }
            for (int m = gw; m < NTOK; m += 4 * NGW) {
                u32x4 va[4], vb[4]; int mr[4];
#pragma unroll
                for (int q = 0; q < 4; ++q) { int mm = m + q * NGW; mr[q] = mm; if (mm >= NTOK) mm = m;
                    const u32x4* xr = (const u32x4*)(X1B + (size_t)mm * DM) + 2 * lane; va[q] = xr[0]; vb[q] = xr[1]; }
#pragma unroll
                for (int q = 0; q < 4; ++q) {
                    const unsigned w[8] = {va[q].x, va[q].y, va[q].z, va[q].w, vb[q].x, vb[q].y, vb[q].z, vb[q].w};
                    float f[16]; float am = 0.f;
#pragma unroll
                    for (int j = 0; j < 8; ++j) { f[2 * j] = __uint_as_float(w[j] << 16); f[2 * j + 1] = __uint_as_float(w[j] & 0xffff0000u); am = __builtin_fmaxf(am, __builtin_fmaxf(__builtin_fabsf(f[2 * j]), __builtin_fabsf(f[2 * j + 1]))); }
#pragma unroll
                    for (int o = 1; o < 64; o <<= 1) am = __builtin_fmaxf(am, __shfl_xor(am, o));
                    if (mr[q] < NTOK) { const float inv = am > 0.f ? 127.0f / am : 0.f;
                        u32x4 o; o.x = q4(f[0] * inv, f[1] * inv, f[2] * inv, f[3] * inv); o.y = q4(f[4] * inv, f[5] * inv, f[6] * inv, f[7] * inv);
                        o.z = q4(f[8] * inv, f[9] * inv, f[10] * inv, f[11] * inv); o.w = q4(f[12] * inv, f[13] * inv, f[14] * inv, f[15] * inv);
                        ((u32x4*)(X1Q + (size_t)mr[q] * DM))[lane] = o;
                        if (lane == 0) { const f32x4 qs = *(const f32x4*)(SSQ + (size_t)mr[q] * 4); const float ssum = (qs[0] + qs[1]) + (qs[2] + qs[3]);
                            FA[mr[q]] = __builtin_amdgcn_rsqf(ssum * (1.0f / DM) + EPS) * am * (1.0f / 127.0f); } }
                }
            }
        }
        GRID_BAR();
        pg8::Gemm g{(const bf16_t*)(X1Q - DM), (const bf16_t*)W3Q, DM / 2, 254}; pg8::StaticOrder S; S.init(194, 2 * DFF / 256, G, bx);
        pg8::EpiFfn E{ACT, FA, (const float*)(ctl + CW_WMAX), args.in[19], args.in[20], (LAS float*)(lds + EPX_OFF)};
        pg8::gemm_phase<pg8::EpiFfn, pg8::StaticOrder, true, true, true>(lds, g, S, E);
        if (BOTH(4)) GRID_BAR();
    }

    if (IN(5)) {
        pg8::Gemm g{ACT, W4, DFF, 256}; pg8::StaticOrder S; S.init(NTOK / 256, DM / 256, G, bx, 1);
        pg8::EpiDown E{X1B, args.out};
        pg8::gemm_phase<pg8::EpiDown, pg8::StaticOrder>(lds, g, S, E);
    }
#undef IN
#undef BOTH
#undef GRID_BAR
}

extern "C" void kernel_launch(void* const* d_in, const int* in_sizes, int n_in, void* d_out, int out_size, void* d_ws, size_t ws_size, hipStream_t stream) {
    static int grid = 0;
    if (grid == 0) {
        if (n_in != 22 || in_sizes[0] != TOK_P * DM || in_sizes[1] != (NTOK - TOK_P) * DM || out_size != NTOK * DM || ws_size < WS_END) {
            fprintf(stderr, "kernel_launch: shape mismatch (n_in %d, in0 %d, in1 %d, out %d, ws %zu; need ws >= %zu)\n", n_in, n_in > 0 ? in_sizes[0] : -1, n_in > 1 ? in_sizes[1] : -1, out_size, ws_size, (size_t)WS_END); grid = -1; return; }
        int dev = 0, cus = 0;
        if (hipGetDevice(&dev) != hipSuccess || hipDeviceGetAttribute(&cus, hipDeviceAttributeMultiprocessorCount, dev) != hipSuccess) { fprintf(stderr, "kernel_launch: device query failed\n"); grid = -1; return; }
        if (hipFuncSetAttribute((const void*)hymba_fwd, hipFuncAttributeMaxDynamicSharedMemorySize, LDS_BYTES) != hipSuccess) { fprintf(stderr, "kernel_launch: hipFuncSetAttribute failed\n"); grid = -1; return; }
        int per_cu = 0;
        if (hipOccupancyMaxActiveBlocksPerMultiprocessor(&per_cu, (const void*)hymba_fwd, NWAVES * 64, LDS_BYTES) != hipSuccess || per_cu < 1)
            fprintf(stderr, "kernel_launch: note: occupancy query reports %d workgroups per CU\n", per_cu);
        (void)hipGetLastError();
        grid = cus;
    }
    if (grid < 0) return;
    (void)hipMemsetAsync((char*)d_ws + WS_CTL, 0, CTL_ZERO_BYTES, stream);
    Args a{};
    for (int i = 0; i < 22; ++i) a.in[i] = (const float*)d_in[i];
    a.out = (float*)d_out; a.ws = (unsigned char*)d_ws;
#ifndef PROBE_DUP
#define PROBE_DUP -1
#endif
    constexpr int NL = (PROBE_DUP >= 0) ? 3 : MK_N_LAUNCHES;
    for (int li = 0; li < NL; ++li) {
        if (PROBE_DUP >= 0) {
            a.ph_lo = li == 0 ? 0 : (li == 1 ? PROBE_DUP : PROBE_DUP + 1); a.ph_hi = li == 2 ? 6 : PROBE_DUP + 1; a.li = li;
        } else { a.ph_lo = (NL == 6) ? li : 0; a.ph_hi = (NL == 6) ? li + 1 : 6; a.li = (NL == 6) ? 0 : li; }
        hipLaunchKernelGGL(hymba_fwd, dim3(grid), dim3(NWAVES * 64), LDS_BYTES, stream, a);
        const hipError_t le = hipPeekAtLastError();
        if (le != hipSuccess) { fprintf(stderr, "kernel_launch: launch %d failed: %s\n", li, hipGetErrorName(le)); break; }
    }
}
```

```cpp
#include <hip/hip_runtime.h>
#include <hip/hip_bf16.h>
#include <cstdio>
#include <cstdint>

#ifndef MK_N_LAUNCHES
#define MK_N_LAUNCHES 1
#endif

#define LAS __attribute__((address_space(3)))
#define GAS __attribute__((address_space(1)))
typedef unsigned short bf16_t;
typedef short bf16x8 __attribute__((ext_vector_type(8)));
typedef short s16x4 __attribute__((ext_vector_type(4)));
typedef float f32x2 __attribute__((ext_vector_type(2)));
typedef float f32x4 __attribute__((ext_vector_type(4)));
typedef float f32x16 __attribute__((ext_vector_type(16)));
typedef unsigned u32x2 __attribute__((ext_vector_type(2)));
typedef unsigned u32x4 __attribute__((ext_vector_type(4)));
typedef __bf16 bf16x2_t __attribute__((ext_vector_type(2)));

constexpr int DM = 1024, SEQ = 2048, NSEQ = 24, NTOK = NSEQ * SEQ, TOK_P = 8 * SEQ;
constexpr int DIN = 2304, DFF = 2816;
constexpr int C_DQ = 0, C_DK = 512, C_DV = 1024, C_WQ = 1536, C_WK = 2048, C_WV = 2176;
constexpr int NBH = 12;
constexpr float EPS = 1e-6f, LOG2E = 1.4426950408889634f, QSCALE = 0.125f * LOG2E;
constexpr float LAM_INIT = 0.2f;
constexpr int NWAVES = 8;

__device__ __forceinline__ unsigned cvtpk(float lo, float hi) { f32x2 v = {lo, hi}; bf16x2_t b = __builtin_convertvector(v, bf16x2_t); return __builtin_bit_cast(unsigned, b); }
__device__ __forceinline__ u32x4 pack8(f32x4 a, f32x4 b) { u32x4 w; w.x = cvtpk(a[0], a[1]); w.y = cvtpk(a[2], a[3]); w.z = cvtpk(b[0], b[1]); w.w = cvtpk(b[2], b[3]); return w; }
__device__ __forceinline__ float dot4(f32x4 a) { return (a[0] * a[0] + a[1] * a[1]) + (a[2] * a[2] + a[3] * a[3]); }

__device__ __forceinline__ unsigned q4(float a, float b, float c, float d) {
    const unsigned ua = __float_as_uint(a + 12582912.0f), ub = __float_as_uint(b + 12582912.0f), uc = __float_as_uint(c + 12582912.0f), ud = __float_as_uint(d + 12582912.0f);
    return (ua & 0xffu) | ((ub & 0xffu) << 8) | ((uc & 0xffu) << 16) | (ud << 24);
}
namespace pg8 {
constexpr int BM = 256, BK = 64, HALF = 128, HTB = HALF * BK * 2, STAGE_BYTES = 8 * HTB, NXCD = 8, WGM = 8;
__host__ __device__ __forceinline__ int lds_byte(int r, int c) { const int st = (r >> 4) * 2 + (c >> 5), rr = r & 15, cc = c & 31, ob = rr * 64 + cc * 2; return st * 1024 + (ob ^ (((ob >> 9) & 1) << 5)); }
__host__ __device__ __forceinline__ void stage_rc(int b, int& R, int& C) { const int st = b / 1024, sb = b % 1024, swz = sb ^ (((sb >> 9) & 1) << 5); R = (st >> 1) * 16 + swz / 64; C = (st & 1) * 32 + (swz % 64) / 2; }
__host__ __device__ __forceinline__ int perm32(int rho) { const int n = rho >> 4, i = rho & 15; return 8 * (i >> 2) + 4 * n + (i & 3); }

typedef int v4i32_t __attribute__((ext_vector_type(4)));
struct Unit { int pm, pn; };
struct Gemm { const bf16_t* A; const bf16_t* Bt; int K; int arows; };

struct StaticOrder {
    int nM, nN, nwg, G, c, rev;
    __device__ void init(int nM_, int nN_, int G_, int c_, int rev_ = 0) { nM = nM_; nN = nN_; nwg = nM * nN; G = G_; c = c_; rev = rev_; }
    __device__ bool next(int i, Unit& u) const {
        const int nr = (nwg - c + G - 1) / G; if (i >= nr) return false;
        const long L = (long)(rev ? nr - 1 - i : i) * G + c;
        int wgid = (int)L; { const int q = nwg / NXCD, r = nwg % NXCD, xcd = wgid % NXCD, off = wgid / NXCD; wgid = (xcd < r ? xcd * (q + 1) : r * (q + 1) + (xcd - r) * q) + off; }
        const int nig = WGM * nN, gid = wgid / nig, fm = gid * WGM, gsz = (nM - fm) < WGM ? (nM - fm) : WGM;
        u.pm = fm + ((wgid % nig) % gsz); u.pn = (wgid % nig) / gsz; return true;
    }
};


struct EpiProj {
    static constexpr bool PERM = true;
    bf16_t* P; const LAS float* gl; const float* fx; const float* swm;
    __device__ __forceinline__ void pre(const Unit& u, int wid, int lane_) const {
        int lane = lane_; asm volatile("" : "+v"(lane));
        if (wid >= 4) __builtin_amdgcn_global_load_lds((const unsigned*)(fx + u.pm * BM + 64 * (wid - 4) + lane), (LAS unsigned*)((LAS char*)gl + 1024 + (wid - 4) * 256), 4, 0, 0);
        if (wid == 2) __builtin_amdgcn_global_load_lds((const unsigned*)(swm + u.pn * 256 + lane * 4), (LAS unsigned*)((LAS char*)gl + 2048), 16, 0, 0);
    }
    __device__ __forceinline__ void operator()(const f32x4 (&acc)[2][2][4][2], const Unit& u, int wr, int wc, int fr, int fq, int lane) const {
        int fql = fq; asm volatile("" : "+v"(fql));
        f32x4 csw[2][2];
#pragma unroll
        for (int bj = 0; bj < 2; ++bj)
#pragma unroll
            for (int n = 0; n < 2; ++n) csw[bj][n] = *(const LAS f32x4*)(gl + 512 + 128 * bj + 32 * wc + 8 * fql + 4 * n) * (1.0f / 127.0f);
        const int gidx = u.pn * 4 + wc;
        int gsel = -1; float sc = 1.f;
        if (gidx < 8) { gsel = 0; sc = QSCALE; } else if (gidx < 16) { gsel = 1; } else if (gidx < 24) { } else if (gidx < 32) { gsel = 2; sc = QSCALE; } else if (gidx < 34) { gsel = 3; }
        const bool nrm = gsel >= 0; const LAS float* gain = gl + (nrm ? gsel : 0) * 64;
        f32x4 gv[2][2];
#pragma unroll
        for (int bj = 0; bj < 2; ++bj)
#pragma unroll
            for (int n = 0; n < 2; ++n) gv[bj][n] = nrm ? *(const LAS f32x4*)(gain + 32 * bj + 8 * fq + 4 * n) * sc : (f32x4){1.f, 1.f, 1.f, 1.f};
        bf16_t* base = P + (size_t)(u.pm * BM + wr * 64 + fr) * DIN + gidx * 64 + 8 * fq;
#pragma unroll
        for (int ai = 0; ai < 2; ++ai)
#pragma unroll
            for (int m = 0; m < 4; ++m) {
                const float fxr = gl[256 + ai * HALF + wr * 64 + m * 16 + fr];
                f32x4 v00 = __builtin_convertvector(__builtin_bit_cast(v4i32_t, acc[ai][0][m][0]), f32x4) * (csw[0][0] * fxr), v01 = __builtin_convertvector(__builtin_bit_cast(v4i32_t, acc[ai][0][m][1]), f32x4) * (csw[0][1] * fxr);
                f32x4 v10 = __builtin_convertvector(__builtin_bit_cast(v4i32_t, acc[ai][1][m][0]), f32x4) * (csw[1][0] * fxr), v11 = __builtin_convertvector(__builtin_bit_cast(v4i32_t, acc[ai][1][m][1]), f32x4) * (csw[1][1] * fxr);
                float rn = 1.f;
                if (nrm) { float ss = (dot4(v00) + dot4(v01)) + (dot4(v10) + dot4(v11)); ss += __shfl_xor(ss, 16); ss += __shfl_xor(ss, 32); rn = __builtin_amdgcn_rsqf(ss * (1.0f / 64.0f) + EPS); }
                v00 = v00 * rn * gv[0][0]; v01 = v01 * rn * gv[0][1]; v10 = v10 * rn * gv[1][0]; v11 = v11 * rn * gv[1][1];
                bf16_t* rowp = base + (size_t)(ai * HALF + m * 16) * DIN;
                const u32x4 pa = pack8(v00, v01), pb = pack8(v10, v11);
                u32x4 px; px.x = (unsigned)__builtin_amdgcn_mov_dpp((int)pb.x, 0x128, 0xf, 0xf, true); px.y = (unsigned)__builtin_amdgcn_mov_dpp((int)pb.y, 0x128, 0xf, 0xf, true);
                px.z = (unsigned)__builtin_amdgcn_mov_dpp((int)pb.z, 0x128, 0xf, 0xf, true); px.w = (unsigned)__builtin_amdgcn_mov_dpp((int)pb.w, 0x128, 0xf, 0xf, true);
                const bool hi8 = (fr & 8) != 0;
                bf16_t* r1p = base + (size_t)(ai * HALF + m * 16 - (hi8 ? 8 : 0)) * DIN + (hi8 ? 32 : 0);
                bf16_t* r2p = base + (size_t)(ai * HALF + m * 16 + (hi8 ? 0 : 8)) * DIN + (hi8 ? 0 : 32);
                *(u32x4*)(r1p) = hi8 ? px : pa; *(u32x4*)(r2p) = hi8 ? pa : px;
            }
    }
};

struct EpiOut {
    static constexpr bool PERM = true;
    const float* __restrict__ xp; const float* __restrict__ xsm; bf16_t* __restrict__ x1b; LAS float* xl;
    signed char* x1q; float* fa; float* xs; unsigned* cnt;
    __device__ __forceinline__ void pre(const Unit&, int, int) const {}
    __device__ __forceinline__ void operator()(f32x4 (&acc)[2][2][4][2], const Unit& u, int wr, int wc, int fr, int fq, int lane) const {
        asm volatile("" : "+v"(fr), "+v"(fq));
        const int rowbase = u.pm * BM;
        const int col0 = u.pn * BM + wc * 64 + 8 * fq;
        const bool hi8 = (fr & 8) != 0;
        const float* xrow0 = rowbase < TOK_P ? xp + (size_t)rowbase * DM : xsm + (size_t)(rowbase - TOK_P) * DM;
#pragma unroll
        for (int ai = 0; ai < 2; ++ai) {
            f32x4 xv[4][2][2];
#pragma unroll
            for (int m = 0; m < 4; ++m) { const float* xr = xrow0 + (size_t)(ai * HALF + wr * 64 + m * 16 + fr) * DM + col0;
#pragma unroll
                for (int bj = 0; bj < 2; ++bj) { xv[m][bj][0] = *(const f32x4*)(xr + bj * 32); xv[m][bj][1] = *(const f32x4*)(xr + bj * 32 + 4); } }
#pragma unroll
            for (int m = 0; m < 4; ++m) {
                const int rl = ai * HALF + wr * 64 + m * 16 + fr; float s = 0.f, am = 0.f; u32x4 pk[2];
#pragma unroll
                for (int bj = 0; bj < 2; ++bj) {
                    const f32x4 o0 = xv[m][bj][0] + acc[ai][bj][m][0], o1 = xv[m][bj][1] + acc[ai][bj][m][1];
                    pk[bj] = pack8(o0, o1);
                    f32x4 b0, b1;
                    b0[0] = __uint_as_float(pk[bj].x << 16); b0[1] = __uint_as_float(pk[bj].x & 0xffff0000u); b0[2] = __uint_as_float(pk[bj].y << 16); b0[3] = __uint_as_float(pk[bj].y & 0xffff0000u);
                    b1[0] = __uint_as_float(pk[bj].z << 16); b1[1] = __uint_as_float(pk[bj].z & 0xffff0000u); b1[2] = __uint_as_float(pk[bj].w << 16); b1[3] = __uint_as_float(pk[bj].w & 0xffff0000u);
                    acc[ai][bj][m][0] = b0; acc[ai][bj][m][1] = b1;
#pragma unroll
                    for (int i = 0; i < 4; ++i) am = __builtin_fmaxf(am, __builtin_fmaxf(__builtin_fabsf(b0[i]), __builtin_fabsf(b1[i])));
                    s += dot4(o0) + dot4(o1); }
                u32x4 px; px.x = (unsigned)__builtin_amdgcn_mov_dpp((int)pk[1].x, 0x128, 0xf, 0xf, true); px.y = (unsigned)__builtin_amdgcn_mov_dpp((int)pk[1].y, 0x128, 0xf, 0xf, true);
                px.z = (unsigned)__builtin_amdgcn_mov_dpp((int)pk[1].z, 0x128, 0xf, 0xf, true); px.w = (unsigned)__builtin_amdgcn_mov_dpp((int)pk[1].w, 0x128, 0xf, 0xf, true);
                bf16_t* r1p = x1b + (size_t)(rowbase + rl - (hi8 ? 8 : 0)) * DM + col0 + (hi8 ? 32 : 0);
                bf16_t* r2p = x1b + (size_t)(rowbase + rl + (hi8 ? 0 : 8)) * DM + col0 + (hi8 ? 0 : 32);
                *(u32x4*)(r1p) = hi8 ? px : pk[0]; *(u32x4*)(r2p) = hi8 ? pk[0] : px;
                s += __shfl_xor(s, 16); s += __shfl_xor(s, 32);
                am = __builtin_fmaxf(am, __shfl_xor(am, 16)); am = __builtin_fmaxf(am, __shfl_xor(am, 32));
                if (fq == 0) { xl[rl * 8 + wc] = s; xl[rl * 8 + 4 + wc] = am; }
            }
        }
        asm volatile("s_waitcnt lgkmcnt(0)" ::: "memory"); __builtin_amdgcn_s_barrier(); asm volatile("" ::: "memory");
        const int t = (wr * 4 + wc) * 64 + lane;
        if (t < 256) {
            const f32x4 q = *(const LAS f32x4*)(xl + t * 8), a4 = *(const LAS f32x4*)(xl + t * 8 + 4);
            float* sl = xs + ((size_t)(rowbase + t) * 4 + u.pn) * 2;
            __hip_atomic_store(sl, (q[0] + q[1]) + (q[2] + q[3]), __ATOMIC_RELAXED, __HIP_MEMORY_SCOPE_AGENT);
            __hip_atomic_store(sl + 1, __builtin_fmaxf(__builtin_fmaxf(a4[0], a4[1]), __builtin_fmaxf(a4[2], a4[3])), __ATOMIC_RELAXED, __HIP_MEMORY_SCOPE_AGENT);
            asm volatile("s_waitcnt vmcnt(0)" ::: "memory");
            if (lane == 0) (void)__hip_atomic_fetch_add(cnt + u.pm, 1u, __ATOMIC_RELAXED, __HIP_MEMORY_SCOPE_AGENT);
        }
        if (t < 64) {
            unsigned sp = 0; while (__builtin_amdgcn_readfirstlane(__hip_atomic_load(cnt + u.pm, __ATOMIC_RELAXED, __HIP_MEMORY_SCOPE_AGENT)) < 16u) { __builtin_amdgcn_s_sleep(1); if (++sp > (1u << 22)) break; }
        }
        asm volatile("s_waitcnt lgkmcnt(0)" ::: "memory"); __builtin_amdgcn_s_barrier(); asm volatile("" ::: "memory");
        if (t < 256) {
            const float* sl = xs + (size_t)(rowbase + t) * 8; float ss = 0.f, am = 0.f;
#pragma unroll
            for (int j = 0; j < 4; ++j) { ss += __hip_atomic_load(sl + 2 * j, __ATOMIC_RELAXED, __HIP_MEMORY_SCOPE_AGENT); am = __builtin_fmaxf(am, __hip_atomic_load(sl + 2 * j + 1, __ATOMIC_RELAXED, __HIP_MEMORY_SCOPE_AGENT)); }
            xl[2048 + t] = am > 0.f ? 127.0f / am : 0.f;
            if (u.pn == 0) fa[rowbase + t] = __builtin_amdgcn_rsqf(ss * (1.0f / DM) + EPS) * am * (1.0f / 127.0f);
        }
        asm volatile("s_waitcnt lgkmcnt(0)" ::: "memory"); __builtin_amdgcn_s_barrier(); asm volatile("" ::: "memory");
#pragma unroll
        for (int ai = 0; ai < 2; ++ai)
#pragma unroll
            for (int m = 0; m < 4; ++m) { const int rl = ai * HALF + wr * 64 + m * 16 + fr; const float inv = xl[2048 + rl];
                signed char* qp = x1q + (size_t)(rowbase + rl) * DM + col0;
#pragma unroll
                for (int bj = 0; bj < 2; ++bj) { const f32x4 b0 = acc[ai][bj][m][0] * inv, b1 = acc[ai][bj][m][1] * inv;
                    u32x2 o; o.x = q4(b0[0], b0[1], b0[2], b0[3]); o.y = q4(b1[0], b1[1], b1[2], b1[3]);
                    *(u32x2*)(qp + 32 * bj) = o; } }
    }
};

__device__ __forceinline__ float dpp8(float x) { return __builtin_bit_cast(float, __builtin_amdgcn_mov_dpp(__builtin_bit_cast(int, x), 0x128, 0xf, 0xf, true)); }
struct EpiDown {
    static constexpr bool PERM = true;
    const bf16_t* __restrict__ x1b; float* __restrict__ out;
    __device__ __forceinline__ void pre(const Unit&, int, int) const {}
    __device__ __forceinline__ void operator()(const f32x4 (&acc)[2][2][4][2], const Unit& u, int wr, int wc, int fr, int fq, int lane) const {
        const int col0 = u.pn * BM + wc * 32 + 8 * fq; const bool hi8 = (fr & 8) != 0;
        u32x4 w[2][4][2];
#pragma unroll
        for (int ai = 0; ai < 2; ++ai)
#pragma unroll
            for (int m = 0; m < 4; ++m) { const size_t off = (size_t)(u.pm * BM + ai * HALF + wr * 64 + m * 16 + fr) * DM + col0;
#pragma unroll
                for (int bj = 0; bj < 2; ++bj) w[ai][m][bj] = *(const u32x4*)(x1b + off + bj * HALF); }
#pragma unroll
        for (int ai = 0; ai < 2; ++ai)
#pragma unroll
            for (int m = 0; m < 4; ++m) { const size_t off = (size_t)(u.pm * BM + ai * HALF + wr * 64 + m * 16 + fr) * DM + col0;
#pragma unroll
                for (int bj = 0; bj < 2; ++bj) { const u32x4 ww = w[ai][m][bj];
                    f32x4 r0, r1;
                    r0[0] = __uint_as_float(ww.x << 16); r0[1] = __uint_as_float(ww.x & 0xffff0000u); r0[2] = __uint_as_float(ww.y << 16); r0[3] = __uint_as_float(ww.y & 0xffff0000u);
                    r1[0] = __uint_as_float(ww.z << 16); r1[1] = __uint_as_float(ww.z & 0xffff0000u); r1[2] = __uint_as_float(ww.w << 16); r1[3] = __uint_as_float(ww.w & 0xffff0000u);
                    const f32x4 q0 = r0 + acc[ai][bj][m][0], q1 = r1 + acc[ai][bj][m][1];
                    f32x4 qx; qx[0] = dpp8(q1[0]); qx[1] = dpp8(q1[1]); qx[2] = dpp8(q1[2]); qx[3] = dpp8(q1[3]);
                    const long d1 = hi8 ? (long)(4 - 8 * DM) : 0, d2 = hi8 ? 0 : (long)(4 + 8 * DM);
                    *(f32x4*)(out + off + bj * HALF + d1) = hi8 ? qx : q0; *(f32x4*)(out + off + bj * HALF + d2) = hi8 ? q0 : qx; } }
    }
};

template <int CTRL> __device__ __forceinline__ float dppz(float x) { return __builtin_bit_cast(float, __builtin_amdgcn_update_dpp(0, __builtin_bit_cast(int, x), CTRL, 0xf, 0xf, true)); }
struct EpiFfn {
    static constexpr bool PERM = true;
    bf16_t* act; const float* fa; const float* swm; const float* cw; const float* cb; LAS float* xl;
    __device__ __forceinline__ void pre(const Unit& u, int wid, int lane_) const {
        int lane = lane_; asm volatile("" : "+v"(lane));
        const int tok0 = 254 * u.pm - 1;
        if (wid >= 4) { int tok = tok0 + 64 * (wid - 4) + lane; tok = tok < 0 ? 0 : (tok > NTOK - 1 ? NTOK - 1 : tok);
            __builtin_amdgcn_global_load_lds((const unsigned*)(fa + tok), (LAS unsigned*)((LAS char*)xl + 4096 + (wid - 4) * 256), 4, 0, 0); }
        if (wid == 2) __builtin_amdgcn_global_load_lds((const unsigned*)(swm + u.pn * 256 + lane * 4), (LAS unsigned*)((LAS char*)xl + 5120), 16, 0, 0);
        if (wid < 2) { const float* src = (wid == 0 ? (lane < 32 ? cw : cw + DFF) : (lane < 32 ? cw + 2 * DFF : cb)) + u.pn * 128 + (lane & 31) * 4;
            __builtin_amdgcn_global_load_lds((const unsigned*)src, (LAS unsigned*)((LAS char*)xl + 20480 + wid * 1024), 16, 0, 0); }
    }
    template <int AI, int M, bool MASK>
    __device__ __forceinline__ void conv_rows(const f32x4 (&acc)[2][2][4][2], const f32x4 (&w0)[2], const f32x4 (&w1)[2], const f32x4 (&w2)[2], const f32x4 (&bb)[2],
                                              int tok, int rl, int G, int xc, int fr, int ch0) const {
        const bool pcut = MASK && (tok & (SEQ - 1)) == 0, ncut = MASK && (tok & (SEQ - 1)) == SEQ - 1;
        f32x4 r0, r1;
#pragma unroll
        for (int n = 0; n < 2; ++n) { f32x4 res;
            f32x4 ex = (f32x4){0.f, 0.f, 0.f, 0.f};
            if (M == 0) { if (G > 0) ex = *(const LAS f32x4*)(xl + (2 * (G - 1) + 1) * 128 + xc + 4 * n); ex = fr == 0 ? ex : (f32x4){0.f, 0.f, 0.f, 0.f}; }
            if (M == 3) { if (G < 3) ex = *(const LAS f32x4*)(xl + (2 * (G + 1)) * 128 + xc + 4 * n); ex = fr == 15 ? ex : (f32x4){0.f, 0.f, 0.f, 0.f}; }
#pragma unroll
            for (int i = 0; i < 4; ++i) {
                const float own = acc[AI][0][M][n][i];
                float pr = dppz<0x111>(own);
                pr += (M > 0) ? dppz<0x10F>(acc[AI][0][M > 0 ? M - 1 : 0][n][i]) : ex[i];
                float nx = dppz<0x101>(own);
                nx += (M < 3) ? dppz<0x11F>(acc[AI][0][M < 3 ? M + 1 : 3][n][i]) : ex[i];
                if (MASK) { pr = pcut ? 0.f : pr; nx = ncut ? 0.f : nx; }
                const float uc = fmaf(w0[n][i], pr, fmaf(w1[n][i], own, fmaf(w2[n][i], nx, bb[n][i])));
                const float sg = uc * __builtin_amdgcn_rcpf(1.0f + __builtin_amdgcn_exp2f(-LOG2E * uc));
                res[i] = sg * acc[AI][1][M][n][i];
            }
            if (n == 0) r0 = res; else r1 = res; }
        if (rl != 0 && rl != 255 && tok < NTOK) *(u32x4*)(act + (size_t)tok * DFF + ch0) = pack8(r0, r1);
    }
    __device__ __forceinline__ void operator()(f32x4 (&acc)[2][2][4][2], const Unit& u, int wr, int wc, int fr, int fq, int lane) const {
        const int ch0 = u.pn * 128 + wc * 32 + 8 * fq;
        const int tok0 = 254 * u.pm - 1;
        int fql = fq; asm volatile("" : "+v"(fql));
        const int xc = wc * 32 + 8 * fql;
        f32x4 su[2];
#pragma unroll
        for (int n = 0; n < 2; ++n) su[n] = *(const LAS f32x4*)(xl + 1280 + 128 + xc + 4 * n) * (1.0f / 127.0f);
#pragma unroll
        for (int ai = 0; ai < 2; ++ai)
#pragma unroll
            for (int m = 0; m < 4; ++m) { const float rs = xl[1024 + ai * HALF + wr * 64 + m * 16 + fr];
#pragma unroll
                for (int n = 0; n < 2; ++n) { const f32x4 rsu = su[n] * rs;
                    acc[ai][0][m][n] = __builtin_convertvector(__builtin_bit_cast(v4i32_t, acc[ai][0][m][n]), f32x4) * rs;
                    acc[ai][1][m][n] = __builtin_convertvector(__builtin_bit_cast(v4i32_t, acc[ai][1][m][n]), f32x4) * rsu; } }
#pragma unroll
        for (int ai = 0; ai < 2; ++ai) { const int G = 2 * ai + wr;
            if (fr == 0) { *(LAS f32x4*)(xl + (2 * G) * 128 + xc) = acc[ai][0][0][0]; *(LAS f32x4*)(xl + (2 * G) * 128 + xc + 4) = acc[ai][0][0][1]; }
            if (fr == 15) { *(LAS f32x4*)(xl + (2 * G + 1) * 128 + xc) = acc[ai][0][3][0]; *(LAS f32x4*)(xl + (2 * G + 1) * 128 + xc + 4) = acc[ai][0][3][1]; } }
        asm volatile("s_waitcnt lgkmcnt(0)" ::: "memory"); __builtin_amdgcn_s_barrier(); asm volatile("" ::: "memory"); __builtin_amdgcn_sched_barrier(0);
        f32x4 w0[2], w1[2], w2[2], bb[2];
#pragma unroll
        for (int n = 0; n < 2; ++n) { const LAS float* wl = xl + 5120 + xc + 4 * n; const f32x4 sgc = *(const LAS f32x4*)(xl + 1280 + xc + 4 * n) * (1.0f / 127.0f);
            w0[n] = *(const LAS f32x4*)(wl) * sgc; w1[n] = *(const LAS f32x4*)(wl + 128) * sgc; w2[n] = *(const LAS f32x4*)(wl + 256) * sgc; bb[n] = *(const LAS f32x4*)(wl + 384); }
#define FFN_ROWS(AI, M) do { const int tb_ = tok0 + AI * HALF + wr * 64 + M * 16; const int G_ = 2 * AI + wr; \
        conv_rows<AI, M, true>(acc, w0, w1, w2, bb, tb_ + fr, AI * HALF + wr * 64 + M * 16 + fr, G_, xc, fr, ch0); \
        if ((M) & 1) __builtin_amdgcn_sched_barrier(0); } while (0)
        FFN_ROWS(0, 0); FFN_ROWS(0, 1); FFN_ROWS(0, 2); FFN_ROWS(0, 3); FFN_ROWS(1, 0); FFN_ROWS(1, 1); FFN_ROWS(1, 2); FFN_ROWS(1, 3);
#undef FFN_ROWS
    }
};

template <class Epi, class Sched, bool ALIGN_EPI = true, bool SP2 = true, bool I8 = false>
__device__ __forceinline__ void gemm_phase(LAS unsigned char* lds, const Gemm g, const Sched& S, const Epi& E) {
    const int tid = threadIdx.x, wid = __builtin_amdgcn_readfirstlane(tid >> 6), lane = tid & 63, wr = wid >> 2, wc = wid & 3, fr = lane & 15, fq = lane >> 4;
    const int K = g.K, nt = K / BK;
    unsigned voffA[2], voffB[2];
#pragma unroll
    for (int i = 0; i < 2; ++i) { int R, C; stage_rc(tid * 16 + i * 8192, R, C); const int Rb = Epi::PERM ? ((R & ~31) + perm32(R & 31)) : R;
        voffA[i] = (unsigned)(R * K + C) * 2u; voffB[i] = (unsigned)(Rb * K + C) * 2u; }
    const size_t kstep = (size_t)(BK * 2);
    const size_t hstep = (size_t)HALF * K * 2;
    const size_t tstepB = 2 * hstep;
    const size_t tstepA = (size_t)g.arows * K * 2;
    const unsigned ldsw = (unsigned)wid * 1024u;
    const int aoff = lds_byte(wr * 64 + fr, fq * 8), boff = lds_byte(wc * 32 + fr, fq * 8);
#define PG8_SA(b, h) (((b) * 2 + (h)) * HTB)
#define PG8_SB(b, h) ((4 + (b) * 2 + (h)) * HTB)
#define PG8_STAGE(bufoff, gbase, voff) do { _Pragma("unroll") for (int _i = 0; _i < 2; ++_i) \
        __builtin_amdgcn_global_load_lds((const unsigned*)((const char*)(gbase) + (voff)[_i]), (LAS unsigned*)(lds + (bufoff) + ldsw + _i * 8192), 16, 0, 0); } while (0)
#define PG8_LDA(dst, b, h) do { _Pragma("unroll") for (int m = 0; m < 4; ++m) _Pragma("unroll") for (int k = 0; k < 2; ++k) dst[m][k] = *(const LAS bf16x8*)(lds + PG8_SA(b, h) + aoff + m * 2048 + k * 1024); } while (0)
#define PG8_LDB(dst, b, h) do { _Pragma("unroll") for (int n = 0; n < 2; ++n) _Pragma("unroll") for (int k = 0; k < 2; ++k) dst[n][k] = *(const LAS bf16x8*)(lds + PG8_SB(b, h) + boff + n * 2048 + k * 1024); } while (0)
#define PG8_MMA(ai, bj, At, Bt) do { __builtin_amdgcn_s_setprio(1); _Pragma("unroll") for (int m = 0; m < 4; ++m) _Pragma("unroll") for (int n = 0; n < 2; ++n) _Pragma("unroll") for (int k = 0; k < 2; ++k) \
        { if constexpr (I8) acc[ai][bj][m][n] = __builtin_bit_cast(f32x4, __builtin_amdgcn_mfma_i32_16x16x64_i8(__builtin_bit_cast(v4i32_t, Bt[n][k]), __builtin_bit_cast(v4i32_t, At[m][k]), __builtin_bit_cast(v4i32_t, acc[ai][bj][m][n]), 0, 0, 0)); \
          else acc[ai][bj][m][n] = __builtin_amdgcn_mfma_f32_16x16x32_bf16(Bt[n][k], At[m][k], acc[ai][bj][m][n], 0, 0, 0); } __builtin_amdgcn_s_setprio(0); } while (0)
#define PG8_WAIT_V(n) asm volatile("s_waitcnt vmcnt(" #n ")" ::: "memory")
#define PG8_WAIT_L(n) asm volatile("s_waitcnt lgkmcnt(" #n ")" ::: "memory")
#define PG8_BAR __builtin_amdgcn_s_barrier()
#define PG8_SCHED __builtin_amdgcn_sched_barrier(0)
    Unit cur, nxt; int ui = 0;
    if (!S.next(0, cur)) return;
    f32x4 acc[2][2][4][2];
#pragma unroll
    for (int a = 0; a < 2; ++a)
#pragma unroll
        for (int b = 0; b < 2; ++b)
#pragma unroll
            for (int m = 0; m < 4; ++m)
#pragma unroll
                for (int n = 0; n < 2; ++n) acc[a][b][m][n] = (f32x4){0.f, 0.f, 0.f, 0.f};
    bf16x8 At[4][2], B0[2][2], B1[2][2];
    const char* cA = (const char*)g.A + (size_t)cur.pm * tstepA; const char* cB = (const char*)g.Bt + (size_t)cur.pn * tstepB;
    if constexpr (SP2) {
        PG8_STAGE(PG8_SB(0, 0), cB, voffB); PG8_STAGE(PG8_SB(0, 1), cB + hstep, voffB); PG8_STAGE(PG8_SA(0, 0), cA, voffA); PG8_STAGE(PG8_SA(0, 1), cA + hstep, voffA);
        if (wr == 1) PG8_BAR;
        PG8_WAIT_V(2); PG8_BAR;
        PG8_STAGE(PG8_SB(1, 0), cB + kstep, voffB); PG8_STAGE(PG8_SA(1, 0), cA + kstep, voffA); PG8_STAGE(PG8_SB(1, 1), cB + hstep + kstep, voffB);
        PG8_WAIT_V(6); PG8_BAR;
    } else {
        PG8_STAGE(PG8_SB(0, 0), cB, voffB); PG8_STAGE(PG8_SA(0, 0), cA, voffA); PG8_STAGE(PG8_SB(0, 1), cB + hstep, voffB); PG8_STAGE(PG8_SA(0, 1), cA + hstep, voffA);
        if (wr == 1) PG8_BAR;
        PG8_WAIT_V(4); PG8_BAR;
        PG8_STAGE(PG8_SB(1, 0), cB + kstep, voffB); PG8_STAGE(PG8_SA(1, 0), cA + kstep, voffA); PG8_STAGE(PG8_SB(1, 1), cB + hstep + kstep, voffB);
        PG8_WAIT_V(6); PG8_BAR;
    }
    for (;;) {
        const bool has_next = S.next(ui + 1, nxt);
        const char* nA = has_next ? (const char*)g.A + (size_t)nxt.pm * tstepA : cA; const char* nB = has_next ? (const char*)g.Bt + (size_t)nxt.pn * tstepB : cB;
        for (int t = 0; t < nt; t += 2) {
            const bool last = (t == nt - 2);
            const char* a1 = cA + (size_t)(t + 1) * kstep;
            const char* a2 = last ? nA : cA + (size_t)(t + 2) * kstep; const char* b2 = last ? nB : cB + (size_t)(t + 2) * kstep;
            const char* a3 = a2 + kstep; const char* b3 = b2 + kstep;
            if (last) E.pre(cur, wid, lane);
            if constexpr (SP2) {
            PG8_LDB(B0, 0, 0); PG8_LDB(B1, 0, 1); PG8_SCHED; PG8_LDA(At, 0, 0); PG8_STAGE(PG8_SA(1, 1), a1 + hstep, voffA);
            PG8_WAIT_V(8); PG8_WAIT_L(0); PG8_BAR; PG8_MMA(0, 0, At, B0); PG8_MMA(0, 1, At, B1); PG8_BAR; PG8_SCHED;
            PG8_LDA(At, 0, 1); PG8_STAGE(PG8_SB(0, 0), b2, voffB); PG8_STAGE(PG8_SB(0, 1), b2 + hstep, voffB); PG8_STAGE(PG8_SA(0, 0), a2, voffA);
            PG8_WAIT_V(8); PG8_WAIT_L(0); PG8_BAR; PG8_MMA(1, 0, At, B0); PG8_MMA(1, 1, At, B1); PG8_BAR; PG8_SCHED;
            PG8_LDB(B0, 1, 0); PG8_LDB(B1, 1, 1); PG8_SCHED; PG8_LDA(At, 1, 0); PG8_STAGE(PG8_SA(0, 1), a2 + hstep, voffA);
            PG8_WAIT_V(8); PG8_WAIT_L(0); PG8_BAR; PG8_MMA(0, 0, At, B0); PG8_MMA(0, 1, At, B1); PG8_BAR; PG8_SCHED;
            PG8_LDA(At, 1, 1); PG8_STAGE(PG8_SB(1, 0), b3, voffB); PG8_STAGE(PG8_SB(1, 1), b3 + hstep, voffB); PG8_STAGE(PG8_SA(1, 0), a3, voffA);
            PG8_WAIT_V(8); PG8_WAIT_L(0); PG8_BAR; PG8_MMA(1, 0, At, B0); PG8_MMA(1, 1, At, B1); PG8_BAR; PG8_SCHED;
            } else {
            PG8_LDB(B0, 0, 0); PG8_SCHED; PG8_LDA(At, 0, 0); PG8_STAGE(PG8_SA(1, 1), a1 + hstep, voffA);
            PG8_WAIT_L(8); PG8_BAR; PG8_WAIT_L(0); PG8_MMA(0, 0, At, B0); PG8_BAR; PG8_SCHED;
            PG8_LDB(B1, 0, 1); PG8_STAGE(PG8_SB(0, 0), b2, voffB);
            PG8_BAR; PG8_WAIT_L(0); PG8_MMA(0, 1, At, B1); PG8_BAR;
            PG8_LDA(At, 0, 1); PG8_STAGE(PG8_SA(0, 0), a2, voffA);
            PG8_BAR; PG8_WAIT_L(0); PG8_MMA(1, 0, At, B0); PG8_BAR; PG8_SCHED;
            PG8_STAGE(PG8_SB(0, 1), b2 + hstep, voffB);
            PG8_WAIT_V(6); PG8_BAR; PG8_MMA(1, 1, At, B1); PG8_BAR;
            PG8_LDB(B0, 1, 0); PG8_SCHED; PG8_LDA(At, 1, 0); PG8_STAGE(PG8_SA(0, 1), a2 + hstep, voffA);
            PG8_WAIT_L(8); PG8_BAR; PG8_WAIT_L(0); PG8_MMA(0, 0, At, B0); PG8_BAR; PG8_SCHED;
            PG8_LDB(B1, 1, 1); PG8_STAGE(PG8_SB(1, 0), b3, voffB);
            PG8_BAR; PG8_WAIT_L(0); PG8_MMA(0, 1, At, B1); PG8_BAR;
            PG8_LDA(At, 1, 1); PG8_STAGE(PG8_SA(1, 0), a3, voffA);
            PG8_BAR; PG8_WAIT_L(0); PG8_MMA(1, 0, At, B0); PG8_BAR; PG8_SCHED;
            PG8_STAGE(PG8_SB(1, 1), b3 + hstep, voffB);
            PG8_WAIT_V(6); PG8_BAR; PG8_MMA(1, 1, At, B1); PG8_BAR;
            }
        }
        if constexpr (ALIGN_EPI) { if (wr == 0) PG8_BAR; }
        E(acc, cur, wr, wc, fr, fq, lane);
        if (!has_next) break;
#pragma unroll
        for (int a = 0; a < 2; ++a)
#pragma unroll
            for (int b = 0; b < 2; ++b)
#pragma unroll
                for (int m = 0; m < 4; ++m)
#pragma unroll
                    for (int n = 0; n < 2; ++n) acc[a][b][m][n] = (f32x4){0.f, 0.f, 0.f, 0.f};
        cur = nxt; cA = nA; cB = nB; ++ui;
        if constexpr (ALIGN_EPI) { if (wr == 1) PG8_BAR; }
    }
    PG8_WAIT_V(0);
    if constexpr (!ALIGN_EPI) { if (wr == 0) PG8_BAR; }
    PG8_BAR;
#undef PG8_SA
#undef PG8_SB
#undef PG8_STAGE
#undef PG8_LDA
#undef PG8_LDB
#undef PG8_MMA
#undef PG8_WAIT_V
#undef PG8_WAIT_L
#undef PG8_BAR
#undef PG8_SCHED
}
}

namespace att {
constexpr int PITCH = DIN;
#define SBAR() __builtin_amdgcn_sched_barrier(0)
#define KSW(row, colB) ((row) * 128 + ((colB) ^ ((((row) >> 1) & 7) << 4)))
__device__ __forceinline__ int crow(int r, int hi) { return (r & 3) + 8 * (r >> 2) + 4 * hi; }
__device__ __forceinline__ int rel_bucket(int rel) {
    const int n = rel < 0 ? -rel : rel; int v;
    if (n < 8) v = n; else { v = 2 + (31 - __clz(n * n)); v = v > 15 ? 15 : v; }
    return (rel > 0 ? 16 : 0) + v;
}
constexpr float THR = 5.0f;

__device__ __forceinline__ void partialSM(f32x16& p0, f32x16& p1, float off, float& m_reg, float& alpha) {
    float pmax = p0[0];
#pragma unroll
    for (int r = 1; r < 16; ++r) pmax = fmaxf(pmax, p0[r]);
#pragma unroll
    for (int r = 0; r < 16; ++r) pmax = fmaxf(pmax, p1[r]);
    { auto rr = __builtin_amdgcn_permlane32_swap(__float_as_uint(pmax), __float_as_uint(pmax), false, false);
      pmax = fmaxf(__uint_as_float(rr[0]), __uint_as_float(rr[1])); }
    pmax += off;
    if (__builtin_expect(__all(pmax - m_reg <= THR), 1)) { alpha = 1.f; }
    else { const float mn = fmaxf(m_reg, pmax); alpha = __builtin_amdgcn_exp2f(m_reg - mn); m_reg = mn; }
    const float sub = off - m_reg;
#pragma unroll
    for (int r = 0; r < 16; ++r) { p0[r] += sub; p1[r] += sub; }
#pragma unroll
    for (int r = 0; r < 16; ++r) p0[r] = __builtin_amdgcn_exp2f(p0[r]);
}
__device__ __forceinline__ void finishSM(f32x16& p0, f32x16& p1, float alpha, float& l_reg, bf16x8& pa0, bf16x8& pa1, bf16x8& pa2, bf16x8& pa3) {
#pragma unroll
    for (int r = 0; r < 16; ++r) p1[r] = __builtin_amdgcn_exp2f(p1[r]);
    float ps = 0;
#pragma unroll
    for (int r = 0; r < 16; ++r) ps += p0[r];
#pragma unroll
    for (int r = 0; r < 16; ++r) ps += p1[r];
    { auto rr = __builtin_amdgcn_permlane32_swap(__float_as_uint(ps), __float_as_uint(ps), false, false);
      ps = __uint_as_float(rr[0]) + __uint_as_float(rr[1]); }
    l_reg = l_reg * alpha + ps;
#define PK4(P, BASE, OUT) do { unsigned a0 = cvtpk(P[BASE + 0], P[BASE + 1]), a1 = cvtpk(P[BASE + 2], P[BASE + 3]);   \
    unsigned b0 = cvtpk(P[BASE + 4], P[BASE + 5]), b1 = cvtpk(P[BASE + 6], P[BASE + 7]);                              \
    auto r0 = __builtin_amdgcn_permlane32_swap(a0, b0, false, false); auto r1 = __builtin_amdgcn_permlane32_swap(a1, b1, false, false); \
    u32x4 w = {r0[0], r1[0], r0[1], r1[1]}; OUT = __builtin_bit_cast(bf16x8, w); } while (0)
    PK4(p0, 0, pa0); PK4(p0, 8, pa1); PK4(p1, 0, pa2); PK4(p1, 8, pa3);
#undef PK4
}
__device__ __forceinline__ void qkt64(f32x16& p0, f32x16& p1, const LAS char* Ks, const bf16x8* qr, int r32, int hi) {
#pragma unroll
    for (int d0 = 0; d0 < 4; ++d0) { const int cb = (d0 * 16 + hi * 8) * 2;
        const bf16x8 b0 = *(const LAS bf16x8*)(Ks + KSW(r32, cb));
        const bf16x8 b1 = *(const LAS bf16x8*)(Ks + KSW(r32, cb) + 4096);
        p0 = __builtin_amdgcn_mfma_f32_32x32x16_bf16(b0, qr[d0], p0, 0, 0, 0); p1 = __builtin_amdgcn_mfma_f32_32x32x16_bf16(b1, qr[d0], p1, 0, 0, 0); }
}
template <int NCB> __device__ __forceinline__ int v_st(int k, int c) { const int kk = (k & ~0xC) | ((k & 4) << 1) | ((k & 8) >> 1); return ((kk >> 3) * NCB + (c >> 5)) * 512 + ((kk & 7) * 32 + (c & 31)) * 2; }
__device__ __forceinline__ int v_rd_base(int lane) { return ((lane & 3) << 3) | (((lane >> 2) & 3) << 6) | (((lane >> 4) & 1) << 5) | (((lane >> 5) & 1) << 8); }
template <int NCB> constexpr int v_rd_off(int d0, int ks, int half) { return d0 * 512 + ks * (NCB * 1024) + half * (NCB * 512); }
template <int OFF> __device__ __forceinline__ s16x4 tr_read(int vb) { s16x4 r; asm volatile("ds_read_b64_tr_b16 %0, %1 offset:%2" : "=&v"(r) : "v"(vb), "i"(OFF) : "memory"); return r; }
template <int NCB, int D0> __device__ __forceinline__ void pv_one(f32x16& od, int vb, bf16x8 pa0, bf16x8 pa1, bf16x8 pa2, bf16x8 pa3) {
    const s16x4 l0 = tr_read<v_rd_off<NCB>(D0, 0, 0)>(vb), h0 = tr_read<v_rd_off<NCB>(D0, 0, 1)>(vb), l1 = tr_read<v_rd_off<NCB>(D0, 1, 0)>(vb), h1 = tr_read<v_rd_off<NCB>(D0, 1, 1)>(vb);
    const s16x4 l2 = tr_read<v_rd_off<NCB>(D0, 2, 0)>(vb), h2 = tr_read<v_rd_off<NCB>(D0, 2, 1)>(vb), l3 = tr_read<v_rd_off<NCB>(D0, 3, 0)>(vb), h3 = tr_read<v_rd_off<NCB>(D0, 3, 1)>(vb);
    asm volatile("s_waitcnt lgkmcnt(0)" ::: "memory"); SBAR();
#define PK(L, H) (bf16x8){L[0], L[1], L[2], L[3], H[0], H[1], H[2], H[3]}
    od = __builtin_amdgcn_mfma_f32_32x32x16_bf16(pa0, PK(l0, h0), od, 0, 0, 0);
    od = __builtin_amdgcn_mfma_f32_32x32x16_bf16(pa1, PK(l1, h1), od, 0, 0, 0);
    od = __builtin_amdgcn_mfma_f32_32x32x16_bf16(pa2, PK(l2, h2), od, 0, 0, 0);
    od = __builtin_amdgcn_mfma_f32_32x32x16_bf16(pa3, PK(l3, h3), od, 0, 0, 0);
#undef PK
}

constexpr int D_V = 0, D_K = 49152, D_WS = 81920, D_TB = 83968, D_ST = 86016, D_END = D_ST + 65536;
constexpr int NT = SEQ / 64;

typedef short v4i16_t __attribute__((ext_vector_type(4)));
__device__ __forceinline__ s16x4 vtr(const LAS char* p) { return __builtin_bit_cast(s16x4, __builtin_amdgcn_ds_read_tr16_b64_v4i16((LAS v4i16_t*)p)); }
#define PIN(x) asm volatile("" : "+v"(x))
#define MX3(a, b, c) __builtin_fmaxf(__builtin_fmaxf((a), (b)), (c))
#define EX(v) __builtin_amdgcn_exp2f(v)
#define MFMA32(a, b, c) __builtin_amdgcn_mfma_f32_32x32x16_bf16((a), (b), (c), 0, 0, 0)
constexpr float THRL = 6.0f;
__device__ __forceinline__ float rowmax32(const f32x16& C0, const f32x16& C1) {
    float a = MX3(C0[0], C0[1], C1[0]), b = MX3(C0[2], C0[3], C1[1]); a = MX3(a, C1[2], C1[3]);
#pragma unroll
    for (int r = 4; r < 16; r += 4) { a = MX3(a, C0[r], C0[r + 1]); b = MX3(b, C0[r + 2], C0[r + 3]); a = MX3(a, C1[r], C1[r + 1]); b = MX3(b, C1[r + 2], C1[r + 3]); }
    float rm = __builtin_fmaxf(a, b);
    auto rr = __builtin_amdgcn_permlane32_swap(__float_as_uint(rm), __float_as_uint(rm), false, false);
    return __builtin_fmaxf(__uint_as_float(rr[0]), __uint_as_float(rr[1]));
}
__device__ __forceinline__ void diff_pass(f32x16 (&o)[4], float& l_out, const bf16_t* Qw, const bf16_t* __restrict__ Kh, const bf16_t* __restrict__ Vh,
                                          LAS char* lds, int qa, float cL, float cR) {
    const int tid = threadIdx.x, wid = __builtin_amdgcn_readfirstlane(tid >> 6), lane = tid & 63, r32 = lane & 31, hi = lane >> 5;
    LAS char* V_lds = lds + D_V; LAS char* K_lds = lds + D_K;
    LAS float* wsf = (LAS float*)(lds + D_WS) + wid * 64 + 32;
    const LAS float* tb = (const LAS float*)(lds + D_TB);
#pragma unroll
    for (int d = 0; d < 4; ++d) o[d] = f32x16{};
    bf16x8 qr[4];
#pragma unroll
    for (int d0 = 0; d0 < 4; ++d0) qr[d0] = *(const bf16x8*)(Qw + d0 * 16);
#pragma unroll
    for (int d0 = 0; d0 < 4; ++d0) PIN(qr[d0]);
    const bf16_t* ksrc; const bf16_t* vsrc0;
    { const int row = wid * 8 + (lane >> 3), pos = lane & 7;
      ksrc = Kh + (long)row * PITCH + ((pos ^ ((row >> 1) & 7)) * 8);
      vsrc0 = Vh + (long)row * PITCH + ((pos ^ (((row >> 1) & 1) << 2)) * 8); }
    const LAS char* kq[4];
    { const int sw = (r32 >> 1) & 7;
#pragma unroll
      for (int d0 = 0; d0 < 4; ++d0) kq[d0] = K_lds + r32 * 128 + (((2 * d0 + hi) ^ sw) << 4); }
    const LAS char* vpe; const LAS char* vpo;
    { const int q = (lane & 15) >> 2, p = lane & 3, g = (lane >> 4) & 1, sw = (q >> 1) & 1;
      vpe = V_lds + (4 * hi + q) * 128 + sw * 64 + g * 32 + p * 8; vpo = V_lds + (4 * hi + q) * 128 + (sw ^ 1) * 64 + g * 32 + p * 8; }
#define DMA_K(j, ko) __builtin_amdgcn_global_load_lds((const unsigned*)(ksrc + (long)(j) * 64 * PITCH), (LAS unsigned*)(K_lds + (ko) + wid * 1024), 16, 0, 0)
#define DMA_V(j, vo) do { __builtin_amdgcn_global_load_lds((const unsigned*)(vsrc0 + (long)(j) * 64 * PITCH), (LAS unsigned*)(V_lds + (vo) + wid * 1024), 16, 0, 0); \
    __builtin_amdgcn_global_load_lds((const unsigned*)(vsrc0 + 64 + (long)(j) * 64 * PITCH), (LAS unsigned*)(V_lds + (vo) + 8192 + wid * 1024), 16, 0, 0); } while (0)
#define WAIT_BAR(N) do { asm volatile("s_waitcnt vmcnt(" #N ") lgkmcnt(0)" ::: "memory"); __builtin_amdgcn_s_barrier(); asm volatile("" ::: "memory"); } while (0)
    float mhat, l_reg = 0.f; bool resc = false;
    f32x16 pA0, pA1, pB0, pB1;
    bf16x8 kf[4]; s16x4 vlo[6], vhi[6]; u32x4 pw0, pw1, pw2, pw3;
#define KRD(i, KS) do { kf[(i) & 3] = *(const LAS bf16x8*)(kq[(i) >> 1] + (KS) + ((i) & 1) * 4096); } while (0)
    WAIT_BAR(0);
    DMA_K(0, 0); DMA_K(1, 8192); DMA_V(0, 0); DMA_K(2, 16384); DMA_K(3, 24576); DMA_V(1, 16384);
    WAIT_BAR(7);
    {
        float off0 = 0.f; const int d_ = -qa;
        if (d_ <= -154) { pA0 = f32x16{}; pA1 = f32x16{}; off0 = cL; }
        else { const LAS float* t_ = tb + (d_ + 256 + 4 * hi - r32);
#pragma unroll
            for (int r = 0; r < 16; ++r) { pA0[r] = t_[(r & 3) + 8 * (r >> 2)]; pA1[r] = t_[32 + (r & 3) + 8 * (r >> 2)]; } }
#pragma unroll
        for (int d0 = 0; d0 < 4; ++d0) { const bf16x8 k0_ = *(const LAS bf16x8*)(kq[d0]), k1_ = *(const LAS bf16x8*)(kq[d0] + 4096);
            pA0 = MFMA32(k0_, qr[d0], pA0); pA1 = MFMA32(k1_, qr[d0], pA1); }
        const float rm = rowmax32(pA0, pA1);
        mhat = rm + off0;
#pragma unroll
        for (int r = 0; r < 16; ++r) { pA0[r] = EX(pA0[r] - rm); pA1[r] = EX(pA1[r] - rm); }
    }
    WAIT_BAR(3);
    KRD(0, 8192); KRD(1, 8192); KRD(2, 8192); KRD(3, 8192);
#define PKW(P, B) cvtpk(P[B], P[(B) + 1])
#define PAF(k) __builtin_bit_cast(bf16x8, pw##k)
#define VFR(i) (bf16x8){vlo[(i) % 6][0], vlo[(i) % 6][1], vlo[(i) % 6][2], vlo[(i) % 6][3], vhi[(i) % 6][0], vhi[(i) % 6][1], vhi[(i) % 6][2], vhi[(i) % 6][3]}
#define VRD(i, VS) do { const LAS char* vq_ = ((((i) & 3) & 1) ? vpo : vpe) + (VS) + (((i) & 3) >> 1) * 8192 + ((i) >> 2) * 2048; vlo[(i) % 6] = vtr(vq_); vhi[(i) % 6] = vtr(vq_ + 1024); } while (0)
#define GAPA(g, CC, QI, KB, A0, A1, A2, A3, W0, W1, PW) do { CC = MFMA32(kf[(g) & 3], qr[QI], CC); if ((g) + 4 < 8) KRD((g) + 4, KB); sacc += A0; sacc += A1; sacc += A2; sacc += A3; PIN(sacc); W0; W1; PIN(PW); SBAR(); } while (0)
#define GAPB(i, X, B, VB, KN, PRE) do { o[(i) & 3] = MFMA32(PAF_SEL(i), VFR(i), o[(i) & 3]); X[B] = EX(X[B]); X[(B) + 1] = EX(X[(B) + 1]); PIN(X); if ((i) + 5 < 16) VRD((i) + 5, VB); \
    if ((PRE) && (i) >= 8 && (i) < 12) KRD((i) - 8, KN); SBAR(); } while (0)
#define PAF_SEL(i) (((i) >> 2) == 0 ? PAF(0) : ((i) >> 2) == 1 ? PAF(1) : ((i) >> 2) == 2 ? PAF(2) : PAF(3))
#define STEP(C0, C1, P0, P1, t, KB, VB, KN, PRE) do { SBAR(); \
    { const int d_ = (t) * 64 - qa; \
      if (d_ > -154 && d_ < 122) { const LAS float* t_ = tb + (d_ + 256 + 4 * hi - r32); \
        _Pragma("unroll") for (int r = 0; r < 16; ++r) { C0[r] = t_[(r & 3) + 8 * (r >> 2)] - mhat; C1[r] = t_[32 + (r & 3) + 8 * (r >> 2)] - mhat; } } \
      else { const float cs_ = (d_ < 0 ? cL : cR) - mhat; _Pragma("unroll") for (int r = 0; r < 16; ++r) { C0[r] = cs_; C1[r] = cs_; } } } \
    PIN(C0); PIN(C1); SBAR(); \
    float sacc = (P0[0] + P0[1]); \
    GAPA(0, C0, 0, KB, P0[2],  P0[3],  P0[4],  P0[5],  pw0[0] = PKW(P0, 0),  pw0[1] = PKW(P0, 2),  pw0); \
    GAPA(1, C1, 0, KB, P0[6],  P0[7],  P0[8],  P0[9],  pw0[2] = PKW(P0, 4),  pw0[3] = PKW(P0, 6),  pw0); \
    GAPA(2, C0, 1, KB, P0[10], P0[11], P0[12], P0[13], pw1[0] = PKW(P0, 8),  pw1[1] = PKW(P0, 10), pw1); \
    GAPA(3, C1, 1, KB, P0[14], P0[15], P1[0],  P1[1],  pw1[2] = PKW(P0, 12), pw1[3] = PKW(P0, 14), pw1); \
    GAPA(4, C0, 2, KB, P1[2],  P1[3],  P1[4],  P1[5],  pw2[0] = PKW(P1, 0),  pw2[1] = PKW(P1, 2),  pw2); \
    GAPA(5, C1, 2, KB, P1[6],  P1[7],  P1[8],  P1[9],  pw2[2] = PKW(P1, 4),  pw2[3] = PKW(P1, 6),  pw2); \
    GAPA(6, C0, 3, KB, P1[10], P1[11], P1[12], P1[13], pw3[0] = PKW(P1, 8),  pw3[1] = PKW(P1, 10), pw3); \
    GAPA(7, C1, 3, KB, P1[14], P1[15], 0.f,    0.f,    pw3[2] = PKW(P1, 12), pw3[3] = PKW(P1, 14), pw3); \
    l_reg += sacc; \
    VRD(0, VB); VRD(1, VB); VRD(2, VB); VRD(3, VB); VRD(4, VB); \
    { const float rm = rowmax32(C0, C1); resc = false; \
      if (__builtin_expect(__any(rm > THRL), 0)) { const float dl = __builtin_fmaxf(rm, 0.f); mhat += dl; \
        _Pragma("unroll") for (int r = 0; r < 16; ++r) { C0[r] -= dl; C1[r] -= dl; } \
        const float f = EX(-dl); l_reg *= f; if (hi == 0) wsf[r32] = f; resc = true; } } \
    SBAR(); \
    GAPB(0, C0, 0, VB, KN, PRE);  GAPB(1, C0, 2, VB, KN, PRE);  GAPB(2, C0, 4, VB, KN, PRE);   GAPB(3, C0, 6, VB, KN, PRE); \
    GAPB(4, C0, 8, VB, KN, PRE);  GAPB(5, C0, 10, VB, KN, PRE); GAPB(6, C0, 12, VB, KN, PRE);  GAPB(7, C0, 14, VB, KN, PRE); \
    GAPB(8, C1, 0, VB, KN, PRE);  GAPB(9, C1, 2, VB, KN, PRE);  GAPB(10, C1, 4, VB, KN, PRE);  GAPB(11, C1, 6, VB, KN, PRE); \
    GAPB(12, C1, 8, VB, KN, PRE); GAPB(13, C1, 10, VB, KN, PRE); GAPB(14, C1, 12, VB, KN, PRE); GAPB(15, C1, 14, VB, KN, PRE); \
    } while (0)
#define RESC() do { if (resc) { asm volatile("s_waitcnt lgkmcnt(0)" ::: "memory"); \
    _Pragma("unroll") for (int d = 0; d < 4; ++d) _Pragma("unroll") for (int r = 0; r < 16; ++r) o[d][r] *= wsf[crow(r, hi)]; } } while (0)
    int ks_cur = 8192, ks_n1 = 16384, ks_n3 = 0;
    int vs_prev = 0, vs_next = 32768;
#define ROT() do { ks_cur = (ks_cur + 8192) & 24576; ks_n1 = (ks_n1 + 8192) & 24576; ks_n3 = (ks_n3 + 8192) & 24576; vs_prev = vs_prev == 32768 ? 0 : vs_prev + 16384; vs_next = vs_next == 32768 ? 0 : vs_next + 16384; } while (0)
#define STEPX(C0, C1, P0, P1, t, PRE) STEP(C0, C1, P0, P1, t, ks_cur, vs_prev, ks_n1, PRE)
#pragma unroll 1
    for (int t = 1; t + 4 < NT; t += 2) {
        DMA_K(t + 3, ks_n3); DMA_V(t + 1, vs_next);
        STEPX(pB0, pB1, pA0, pA1, t, true);
        WAIT_BAR(3); RESC(); ROT();
        DMA_K(t + 4, ks_n3); DMA_V(t + 2, vs_next);
        STEPX(pA0, pA1, pB0, pB1, t + 1, true);
        WAIT_BAR(3); RESC(); ROT();
    }
    DMA_V(NT - 2, vs_next);
    STEPX(pB0, pB1, pA0, pA1, NT - 3, true);
    WAIT_BAR(2); RESC(); ROT();
    DMA_V(NT - 1, vs_next);
    STEPX(pA0, pA1, pB0, pB1, NT - 2, true);
    WAIT_BAR(2); RESC(); ROT();
    STEPX(pB0, pB1, pA0, pA1, NT - 1, false);
    WAIT_BAR(0); RESC(); ROT();
    { float sacc = 0.f;
#pragma unroll
      for (int r = 0; r < 16; ++r) sacc += pB0[r];
#pragma unroll
      for (int r = 0; r < 16; ++r) sacc += pB1[r];
      l_reg += sacc;
      pw0 = (u32x4){PKW(pB0, 0), PKW(pB0, 2), PKW(pB0, 4), PKW(pB0, 6)}; pw1 = (u32x4){PKW(pB0, 8), PKW(pB0, 10), PKW(pB0, 12), PKW(pB0, 14)};
      pw2 = (u32x4){PKW(pB1, 0), PKW(pB1, 2), PKW(pB1, 4), PKW(pB1, 6)}; pw3 = (u32x4){PKW(pB1, 8), PKW(pB1, 10), PKW(pB1, 12), PKW(pB1, 14)};
      SBAR();
#define DRAIN(i) do { VRD(i, vs_prev); o[(i) & 3] = MFMA32(PAF_SEL(i), VFR(i), o[(i) & 3]); } while (0)
      DRAIN(0); DRAIN(1); DRAIN(2); DRAIN(3); DRAIN(4); DRAIN(5); DRAIN(6); DRAIN(7); DRAIN(8); DRAIN(9); DRAIN(10); DRAIN(11); DRAIN(12); DRAIN(13); DRAIN(14); DRAIN(15);
#undef DRAIN
    }
    { auto rr = __builtin_amdgcn_permlane32_swap(__float_as_uint(l_reg), __float_as_uint(l_reg), false, false); l_out = __uint_as_float(rr[0]) + __uint_as_float(rr[1]); }
#undef DMA_K
#undef DMA_V
#undef WAIT_BAR
#undef ROT
#undef KRD
#undef PKW
#undef PAF
#undef VFR
#undef VRD
#undef GAPA
#undef GAPB
#undef PAF_SEL
#undef STEP
#undef STEPX
#undef RESC
}

__device__ __forceinline__ void diff_unit(int b, int h, int qb, const bf16_t* P, bf16_t* O, LAS char* lds, float lam, const float* relb) {
    const int tid = threadIdx.x, wid = __builtin_amdgcn_readfirstlane(tid >> 6), lane = tid & 63, r32 = lane & 31, hi = lane >> 5;
    const long rowbase = (long)b * SEQ; const int q0 = qb * 256, qa = q0 + wid * 32;
    LAS float* tb = (LAS float*)(lds + D_TB);
    LAS float* li_l = (LAS float*)(lds + D_WS) + wid * 64;
    tb[tid] = relb[rel_bucket(tid - 256) * NBH + h] * LOG2E;
    const float cL = relb[15 * NBH + h] * LOG2E, cR = relb[31 * NBH + h] * LOG2E;
    const bf16_t* Qrow = P + (rowbase + qa + r32) * PITCH + C_DQ + h * 128 + hi * 8;
    const bf16_t* Kh = P + rowbase * PITCH + C_DK + h * 128;
    const bf16_t* Vh = P + rowbase * PITCH + C_DV + h * 128;
    LAS u32x4* stash = (LAS u32x4*)(lds + D_ST + wid * 8192);
    f32x16 o[4]; float l_reg;
#pragma unroll 1
    for (int pass = 0; pass < 2; ++pass) {
        const int mo = pass == 0 ? 64 : 0;
        diff_pass(o, l_reg, Qrow + mo, Kh + mo, Vh, lds, qa, cL, cR);
        int ln = lane; asm volatile("" : "+v"(ln));
        const int r32e = ln & 31, hie = ln >> 5;
        if (hie == 0) li_l[r32e] = l_reg; asm volatile("s_waitcnt lgkmcnt(0)" ::: "memory");
        if (pass == 0) {
            float rli[16];
#pragma unroll
            for (int r = 0; r < 16; ++r) rli[r] = -lam * __builtin_amdgcn_rcpf(li_l[crow(r, hie)]);
#pragma unroll
            for (int d0 = 0; d0 < 4; ++d0) {
                u32x4 w0, w1;
                w0.x = cvtpk(o[d0][0] * rli[0], o[d0][1] * rli[1]); w0.y = cvtpk(o[d0][2] * rli[2], o[d0][3] * rli[3]); w0.z = cvtpk(o[d0][4] * rli[4], o[d0][5] * rli[5]); w0.w = cvtpk(o[d0][6] * rli[6], o[d0][7] * rli[7]);
                w1.x = cvtpk(o[d0][8] * rli[8], o[d0][9] * rli[9]); w1.y = cvtpk(o[d0][10] * rli[10], o[d0][11] * rli[11]); w1.z = cvtpk(o[d0][12] * rli[12], o[d0][13] * rli[13]); w1.w = cvtpk(o[d0][14] * rli[14], o[d0][15] * rli[15]);
                stash[(2 * d0) * 64 + ln] = w0; stash[(2 * d0 + 1) * 64 + ln] = w1;
            }
        } else {
            float rli[16], ssq[16];
#pragma unroll
            for (int r = 0; r < 16; ++r) { rli[r] = __builtin_amdgcn_rcpf(li_l[crow(r, hie)]); ssq[r] = 0.f; }
#pragma unroll
            for (int d0 = 0; d0 < 4; ++d0) {
                const u32x4 w0 = stash[(2 * d0) * 64 + ln], w1 = stash[(2 * d0 + 1) * 64 + ln];
                const unsigned ww[8] = {w0.x, w0.y, w0.z, w0.w, w1.x, w1.y, w1.z, w1.w};
#pragma unroll
                for (int r = 0; r < 16; ++r) { const float c = __uint_as_float((r & 1) ? (ww[r >> 1] & 0xffff0000u) : (ww[r >> 1] << 16));
                    const float x = fmaf(o[d0][r], rli[r], c); o[d0][r] = x; ssq[r] = fmaf(x, x, ssq[r]); }
            }
            asm volatile("s_waitcnt lgkmcnt(0)" ::: "memory");
#pragma unroll
            for (int r = 0; r < 16; ++r) { float s = ssq[r];
                s += __shfl_xor(s, 1); s += __shfl_xor(s, 2); s += __shfl_xor(s, 4); s += __shfl_xor(s, 8); s += __shfl_xor(s, 16);
                ssq[r] = __builtin_amdgcn_rsqf(s * (1.0f / 128.0f) + EPS); }
            LAS bf16_t* stg = (LAS bf16_t*)(lds + D_ST + wid * 8192);
#pragma unroll
            for (int r = 0; r < 16; ++r) { const int orow = crow(r, hie);
#pragma unroll
                for (int d0 = 0; d0 < 4; ++d0) stg[orow * 128 + d0 * 32 + r32e] = (bf16_t)(cvtpk(o[d0][r] * ssq[r], 0.f) & 0xffffu); }
            asm volatile("s_waitcnt lgkmcnt(0)" ::: "memory");
            bf16_t* Ow = O + (rowbase + qa + (ln >> 4)) * DM + h * 128 + (ln & 15) * 8;
            const LAS bf16_t* sl = stg + (ln >> 4) * 128 + (ln & 15) * 8;
#pragma unroll
            for (int i = 0; i < 8; ++i) { const u32x4 v = *(const LAS u32x4*)(sl + i * 512); *(u32x4*)(Ow + (long)i * 4 * DM) = v; }
        }
    }
    asm volatile("s_waitcnt lgkmcnt(0)" ::: "memory"); __syncthreads();
}

constexpr int W_K = 0, W_V = 49152, W_TB = 98304, W_WS = 106496, W_OST = 108544, W_END = W_OST + 32768;
__device__ __forceinline__ void win_unit(int b, int kvh, int qb, const bf16_t* P, bf16_t* O, LAS char* lds, const float* relb, const float* sink) {
    const int tid = threadIdx.x, wid = __builtin_amdgcn_readfirstlane(tid >> 6), lane = tid & 63, r32 = lane & 31, hi = lane >> 5;
    const long rowbase = (long)b * SEQ; const int q0 = qb * 128, kbase = q0 - 128;
    LAS float* tbw = (LAS float*)(lds + W_TB);
#pragma unroll
    for (int e = 0; e < 4; ++e) { const int idx = tid + e * 512, g = idx >> 9, rel = (idx & 511) - 256;
        tbw[idx] = (rel >= -128 && rel <= 128) ? (relb[rel_bucket(rel) * NBH + 4 + 4 * kvh + g] - sink[4 * kvh + g]) * LOG2E : -1e30f; }
    { int tl = tid; asm volatile("" : "+v"(tl));
      const int kr = tl >> 3, kc = (tl & 7) * 8, kst = KSW(kr, kc * 2), vst = v_st<2>(kr, kc);
      const bf16_t* Kh = P + rowbase * PITCH + C_WK + kvh * 64; const bf16_t* Vh = P + rowbase * PITCH + C_WV + kvh * 64;
      bf16x8 kreg[6], vreg[6];
#pragma unroll
      for (int t = 0; t < 6; ++t) { const int k0 = kbase + 64 * t; if (k0 >= 0 && k0 < SEQ) { kreg[t] = *(const bf16x8*)(&Kh[(long)(k0 + kr) * PITCH + kc]); vreg[t] = *(const bf16x8*)(&Vh[(long)(k0 + kr) * PITCH + kc]); } }
#pragma unroll
      for (int t = 0; t < 6; ++t) { const int k0 = kbase + 64 * t; if (k0 >= 0 && k0 < SEQ) { *(LAS bf16x8*)(lds + W_K + t * 8192 + kst) = kreg[t]; *(LAS bf16x8*)(lds + W_V + t * 8192 + vst) = vreg[t]; } }
    }
    __syncthreads();
    const int g = wid >> 1, hq = 4 * kvh + g;
    LAS float* li_l = (LAS float*)(lds + W_WS) + wid * 64;
    const LAS float* tbg = tbw + g * 512;
    const int vbw = (int)(uintptr_t)(lds + W_V) + v_rd_base(lane);
#pragma unroll 1
    for (int jb = 0; jb < 2; ++jb) {
        const int ql = 64 * (wid & 1) + 32 * jb;
        const bf16_t* Qw = P + (rowbase + q0 + ql + r32) * PITCH + C_WQ + hq * 64 + hi * 8;
        bf16x8 qr[4];
#pragma unroll
        for (int d0 = 0; d0 < 4; ++d0) qr[d0] = *(const bf16x8*)(Qw + d0 * 16);
        float l_reg = 0.f;
        f32x16 o[2]; o[0] = f32x16{}; o[1] = f32x16{};
        const int t_lo = ql >> 6;
#pragma unroll 1
        for (int t = t_lo; t < t_lo + 5; ++t) {
            const int k0 = kbase + 64 * t; if (k0 < 0 || k0 >= SEQ) continue;
            const int d_ = 64 * t - 128 - ql;
            const LAS float* t_ = tbg + (d_ + 256 + 4 * hi - r32);
            f32x16 p0, p1;
#pragma unroll
            for (int r = 0; r < 16; ++r) { p0[r] = t_[(r & 3) + 8 * (r >> 2)]; p1[r] = t_[32 + (r & 3) + 8 * (r >> 2)]; }
            qkt64(p0, p1, lds + W_K + t * 8192, qr, r32, hi);
#pragma unroll
            for (int r = 0; r < 16; ++r) { p0[r] = __builtin_amdgcn_exp2f(p0[r]); p1[r] = __builtin_amdgcn_exp2f(p1[r]); }
            bf16x8 pa0, pa1, pa2, pa3;
            {
                float ps = 0;
#pragma unroll
                for (int r = 0; r < 16; ++r) ps += p0[r];
#pragma unroll
                for (int r = 0; r < 16; ++r) ps += p1[r];
                l_reg += ps;
#define PK4(Pv, BASE, OUT) do { unsigned a0 = cvtpk(Pv[BASE + 0], Pv[BASE + 1]), a1 = cvtpk(Pv[BASE + 2], Pv[BASE + 3]);   \
    unsigned b0 = cvtpk(Pv[BASE + 4], Pv[BASE + 5]), b1 = cvtpk(Pv[BASE + 6], Pv[BASE + 7]);                              \
    auto r0 = __builtin_amdgcn_permlane32_swap(a0, b0, false, false); auto r1 = __builtin_amdgcn_permlane32_swap(a1, b1, false, false); \
    u32x4 w = {r0[0], r1[0], r0[1], r1[1]}; OUT = __builtin_bit_cast(bf16x8, w); } while (0)
                PK4(p0, 0, pa0); PK4(p0, 8, pa1); PK4(p1, 0, pa2); PK4(p1, 8, pa3);
#undef PK4
            }
            const int vb = vbw + t * 8192;
            pv_one<2, 0>(o[0], vb, pa0, pa1, pa2, pa3); pv_one<2, 1>(o[1], vb, pa0, pa1, pa2, pa3);
        }
        { auto rr = __builtin_amdgcn_permlane32_swap(__float_as_uint(l_reg), __float_as_uint(l_reg), false, false); l_reg = 1.0f + __uint_as_float(rr[0]) + __uint_as_float(rr[1]); }
        int ln = lane; asm volatile("" : "+v"(ln));
        const int r32e = ln & 31, hie = ln >> 5;
        if (hie == 0) li_l[r32e] = l_reg; asm volatile("s_waitcnt lgkmcnt(0)" ::: "memory");
        float rli[16];
#pragma unroll
        for (int r = 0; r < 16; ++r) rli[r] = __builtin_amdgcn_rcpf(li_l[crow(r, hie)]);
        LAS bf16_t* stg = (LAS bf16_t*)(lds + W_OST + wid * 4096);
#pragma unroll
        for (int r = 0; r < 16; ++r) { const int orow = crow(r, hie);
#pragma unroll
            for (int d0 = 0; d0 < 2; ++d0) stg[orow * 64 + d0 * 32 + r32e] = (bf16_t)(cvtpk(o[d0][r] * rli[r], 0.f) & 0xffffu); }
        asm volatile("s_waitcnt lgkmcnt(0)" ::: "memory");
        bf16_t* Ow = O + (rowbase + q0 + ql + (ln >> 3)) * DM + 512 + hq * 64 + (ln & 7) * 8;
        const LAS bf16_t* sl = stg + (ln >> 3) * 64 + (ln & 7) * 8;
#pragma unroll
        for (int i = 0; i < 4; ++i) { const u32x4 v = *(const LAS u32x4*)(sl + i * 512); *(u32x4*)(Ow + (long)i * 8 * DM) = v; }
        asm volatile("s_waitcnt lgkmcnt(0)" ::: "memory");
    }
    asm volatile("s_waitcnt lgkmcnt(0)" ::: "memory"); __syncthreads();
}
#undef SBAR
#undef KSW
}

constexpr size_t MiB = 1u << 20;
constexpr size_t WS_CTL = 0, CTL_ZERO_BYTES = 64 * 1024;
constexpr size_t WS_W1 = 1 * MiB;
constexpr size_t WS_W2 = WS_W1 + (size_t)DIN * DM * 2;
constexpr size_t WS_W3 = WS_W2 + (size_t)DM * DM * 2;
constexpr size_t WS_W4 = WS_W3 + (size_t)2 * DFF * DM * 2;
constexpr size_t WS_XS = 24 * MiB;
constexpr int CW_P3CNT = 4480;
constexpr size_t WS_FA = 26 * MiB;
constexpr size_t WS_FX = 26 * MiB + 512 * 1024;
constexpr int CW_WMAX1 = 13824, CW_W1CNT = 16200;
constexpr int CW_WMAX = 8192;
constexpr size_t WS_PROJ = 28 * MiB;
constexpr size_t WS_OB = 244 * MiB;
constexpr size_t WS_XQ = 340 * MiB;
constexpr size_t WS_X1Q = 340 * MiB;
constexpr size_t WS_X1B = 388 * MiB;
constexpr size_t WS_ACT = 28 * MiB;
constexpr size_t WS_END = WS_X1B + (size_t)NTOK * DM * 2;
static_assert(WS_W4 + (size_t)DM * DFF * 2 <= WS_XS && WS_XS + (size_t)NTOK * 32 <= WS_FA && WS_FA + (size_t)NTOK * 4 <= WS_FX && WS_FX + (size_t)NTOK * 4 <= WS_PROJ, "d_ws map");
static_assert(WS_PROJ + (size_t)NTOK * DIN * 2 <= WS_OB && WS_OB + (size_t)NTOK * DM * 2 <= WS_XQ && WS_XQ + (size_t)NTOK * DM <= WS_X1B && WS_ACT + (size_t)NTOK * DFF * 2 <= WS_X1Q - 4096, "d_ws map");
static_assert(CW_WMAX + 2 * DFF <= CW_WMAX1 && CW_WMAX1 + DIN <= CW_W1CNT && CW_W1CNT * 4 < CTL_ZERO_BYTES && 1024 + 3456 <= CW_P3CNT && CW_P3CNT + 192 <= CW_WMAX, "d_ws map");
constexpr int CW_BAR = 1024, XCD_BAR_WORDS_C = 3456;

constexpr int RING_BYTES = 131072, EPX_OFF = RING_BYTES, LDS_BYTES = 163840, MISC_OFF = LDS_BYTES - 512;
static_assert(att::D_END <= MISC_OFF && att::W_END <= MISC_OFF && EPX_OFF + 22528 <= MISC_OFF, "LDS map");

typedef GAS unsigned gu32;
#define RLX_AGENT __ATOMIC_RELAXED, __HIP_MEMORY_SCOPE_AGENT
#define LDS_WAIT() asm volatile("s_waitcnt lgkmcnt(0)" ::: "memory")

#define XB_TMO      128
#define XB_XCNT(j)  (256  + 64 * (j))
#define XB_XSUB(j)  (1280 + 64 * (j))
#define XB_XGEN(j)  (2304 + 64 * (j))
#define XB_TOP      3328
#define XB_TOPGEN   3392
#define XCD_BAR_WORDS 3456
#define XB_SPIN_CAP (1u << 22)
__device__ __forceinline__ unsigned xb_ld(unsigned* p)              { return __hip_atomic_load(p, __ATOMIC_RELAXED, __HIP_MEMORY_SCOPE_AGENT); }
__device__ __forceinline__ unsigned xb_add(unsigned* p, unsigned v) { return __hip_atomic_fetch_add(p, v, __ATOMIC_RELAXED, __HIP_MEMORY_SCOPE_AGENT); }
__device__ __forceinline__ unsigned xb_xcc_id() { return (unsigned)__builtin_amdgcn_s_getreg((3 << 11) | 20) & 0xFu; }
#define XB_SPIN(cond, bar) do { unsigned _sp = 0; while (cond) { __builtin_amdgcn_s_sleep(1); \
    if ((++_sp & 255u) == 0u) { if (xb_ld(&(bar)[XB_TMO])) break; if (_sp > XB_SPIN_CAP) { atomicAdd(&(bar)[XB_TMO], 1u); break; } } } } while (0)
struct XcdBarrier { unsigned* bar; unsigned x; volatile LAS unsigned* st; };
__device__ __forceinline__ XcdBarrier xcd_barrier_post(unsigned* bar, volatile LAS unsigned* st) {
    XcdBarrier b; b.bar = bar; b.x = xb_xcc_id(); b.st = st;
    if (threadIdx.x == 0) (void)xb_add(&bar[XB_XCNT(b.x)], 1u);
    return b;
}
__device__ __forceinline__ void xcd_barrier_complete(unsigned* bar, unsigned x, unsigned& nloc, unsigned& nx) {
    const unsigned G = gridDim.x * gridDim.y * gridDim.z;
    unsigned sum, cnt, mine, sp = 0u;
    for (;;) {
        sum = 0u; cnt = 0u; mine = 0u;
#pragma unroll
        for (unsigned j = 0; j < 16; ++j) { const unsigned c = xb_ld(&bar[XB_XCNT(j)]); sum += c; cnt += (c > 0u) ? 1u : 0u; mine = (j == x) ? c : mine; }
        if (sum == G) break;
        __builtin_amdgcn_s_sleep(1);
        if ((++sp & 255u) == 0u) { if (xb_ld(&bar[XB_TMO])) break; if (sp > XB_SPIN_CAP) { atomicAdd(&bar[XB_TMO], 1u); break; } }
    }
    nloc = mine > 0u ? mine : 1u; nx = cnt > 0u ? cnt : 1u;
}
__device__ __forceinline__ void xcd_barrier(const XcdBarrier& b) {
    asm volatile("s_waitcnt vmcnt(0)" ::: "memory");
    __syncthreads();
    if (threadIdx.x == 0) {
        unsigned* bar = b.bar;
        __builtin_amdgcn_s_waitcnt(0);
        unsigned nloc = b.st[0], nx = b.st[1];
        if (nloc == 0u) { xcd_barrier_complete(bar, b.x, nloc, nx); b.st[0] = nloc; b.st[1] = nx; }
        const unsigned old = xb_add(&bar[XB_XSUB(b.x)], 1u);
        const unsigned gen = old / nloc;
        if (old + 1u == (gen + 1u) * nloc) {
            __builtin_amdgcn_fence(__ATOMIC_RELEASE, "agent");
            asm volatile("s_waitcnt vmcnt(0)" ::: "memory");
            const unsigned og = xb_add(&bar[XB_TOP], 1u);
            const unsigned tg = og / nx;
            if (og + 1u == (tg + 1u) * nx) xb_add(&bar[XB_TOPGEN], 1u);
            else XB_SPIN(xb_ld(&bar[XB_TOPGEN]) == tg, bar);
            __builtin_amdgcn_fence(__ATOMIC_ACQUIRE, "agent");
            xb_add(&bar[XB_XGEN(b.x)], 1u);
            asm volatile("s_waitcnt vmcnt(0)" ::: "memory");
        } else {
            XB_SPIN(xb_ld(&bar[XB_XGEN(b.x)]) == gen, bar);
            __builtin_amdgcn_fence(__ATOMIC_ACQUIRE, "agent");
            asm volatile("s_waitcnt vmcnt(0)" ::: "memory");
        }
    }
    __syncthreads();
}

__device__ __forceinline__ float wave_sum(float v) {
#pragma unroll
    for (int o = 1; o < 64; o <<= 1) v += __shfl_xor(v, o);
    return v;
}
__device__ __forceinline__ unsigned f2bf(float f) { unsigned u = __builtin_bit_cast(unsigned, f); return (u + 0x7fffu + ((u >> 16) & 1u)) >> 16; }
__device__ __forceinline__ unsigned pk2(float lo, float hi) { return f2bf(lo) | (f2bf(hi) << 16); }
__device__ __forceinline__ void transpose_item(const float* W, int ld, int cbase, int K, int k0, bf16_t* WT, int nrow0, const float* fold, int foldmask, float fscale, int foldlim, LAS float* scr, int lane) {
    float wv[32];
#pragma unroll
    for (int i = 0; i < 32; ++i) wv[i] = W[(size_t)(k0 + 2 * i + (lane >> 5)) * ld + cbase + (lane & 31)];
#pragma unroll
    for (int i = 0; i < 32; ++i) { const int kk = 2 * i + (lane >> 5), k = k0 + kk;
        float f = 1.f; if (fold != nullptr && k < foldlim) f = fold[k & foldmask] * fscale;
        scr[kk * 33 + (lane & 31)] = wv[i] * f; }
    LDS_WAIT(); asm volatile("" ::: "memory");
    const int c = lane & 7;
#pragma unroll
    for (int j = 0; j < 4; ++j) { const int n = (lane >> 3) + 8 * j; const LAS float* s = scr + (8 * c) * 33 + n;
        u32x4 o; o.x = pk2(s[0 * 33], s[1 * 33]); o.y = pk2(s[2 * 33], s[3 * 33]); o.z = pk2(s[4 * 33], s[5 * 33]); o.w = pk2(s[6 * 33], s[7 * 33]);
        *(u32x4*)(WT + (size_t)(nrow0 + n) * K + k0 + 8 * c) = o; }
    LDS_WAIT(); asm volatile("" ::: "memory");
}

__device__ __forceinline__ void absmax_item(const float* W, int ld, int cbase, int k0, unsigned* wmax, const float* fold, int lane) {
    float wv[32];
#pragma unroll
    for (int i = 0; i < 32; ++i) wv[i] = W[(size_t)(k0 + 2 * i + (lane >> 5)) * ld + cbase + (lane & 31)];
    float m = 0.f;
#pragma unroll
    for (int i = 0; i < 32; ++i) m = __builtin_fmaxf(m, __builtin_fabsf(wv[i] * fold[k0 + 2 * i + (lane >> 5)]));
    m = __builtin_fmaxf(m, __shfl_xor(m, 32));
    if (lane < 32) (void)__hip_atomic_fetch_max(wmax + lane, __float_as_uint(m), __ATOMIC_RELAXED, __HIP_MEMORY_SCOPE_AGENT);
}
__device__ __forceinline__ void quant_item(const float* W, int ld, int cbase, int K, int k0, signed char* WQ, int nrow0, const float* fold, const unsigned* wmax, LAS float* scr, int lane) {
    float wv[32];
#pragma unroll
    for (int i = 0; i < 32; ++i) wv[i] = W[(size_t)(k0 + 2 * i + (lane >> 5)) * ld + cbase + (lane & 31)];
    const float am = __uint_as_float(__hip_atomic_load(wmax + (lane & 31), __ATOMIC_RELAXED, __HIP_MEMORY_SCOPE_AGENT)); const float inv = am > 0.f ? 127.0f / am : 0.f;
#pragma unroll
    for (int i = 0; i < 32; ++i) { const int kk = 2 * i + (lane >> 5); scr[kk * 33 + (lane & 31)] = wv[i] * fold[k0 + kk] * inv; }
    LDS_WAIT(); asm volatile("" ::: "memory");
    const int n = lane >> 1, c = lane & 1; const LAS float* sp = scr + (32 * c) * 33 + n;
    u32x4 o0, o1;
    o0.x = q4(sp[0 * 33], sp[1 * 33], sp[2 * 33], sp[3 * 33]);     o0.y = q4(sp[4 * 33], sp[5 * 33], sp[6 * 33], sp[7 * 33]);
    o0.z = q4(sp[8 * 33], sp[9 * 33], sp[10 * 33], sp[11 * 33]);   o0.w = q4(sp[12 * 33], sp[13 * 33], sp[14 * 33], sp[15 * 33]);
    o1.x = q4(sp[16 * 33], sp[17 * 33], sp[18 * 33], sp[19 * 33]); o1.y = q4(sp[20 * 33], sp[21 * 33], sp[22 * 33], sp[23 * 33]);
    o1.z = q4(sp[24 * 33], sp[25 * 33], sp[26 * 33], sp[27 * 33]); o1.w = q4(sp[28 * 33], sp[29 * 33], sp[30 * 33], sp[31 * 33]);
    u32x4* dst = (u32x4*)(WQ + (size_t)(nrow0 + n) * K + k0 + 32 * c);
    dst[0] = o0; dst[1] = o1;
    LDS_WAIT(); asm volatile("" ::: "memory");
}

struct Args { const float* in[22]; float* out; unsigned char* ws; int ph_lo, ph_hi, li, pad; };

__global__ void __launch_bounds__(NWAVES * 64, 2) hymba_fwd(Args args) {
    extern __shared__ __attribute__((aligned(16))) unsigned char lds_raw[];
    LAS unsigned char* lds = (LAS unsigned char*)lds_raw;
    volatile LAS unsigned* MISC = (volatile LAS unsigned*)(lds + MISC_OFF);
    const int tid = threadIdx.x, lane = tid & 63, wave = __builtin_amdgcn_readfirstlane(tid >> 6);
    const int G = gridDim.x; const int bx = blockIdx.x; const int vcu = (G % 8 == 0) ? (bx % 8) * (G / 8) + bx / 8 : bx;
    unsigned char* ws = args.ws;
    unsigned* ctl = (unsigned*)(ws + WS_CTL);
    const float* xp = args.in[0]; const float* xs = args.in[1];
    bf16_t* W1 = (bf16_t*)(ws + WS_W1); bf16_t* W2 = (bf16_t*)(ws + WS_W2); bf16_t* W3 = (bf16_t*)(ws + WS_W3); bf16_t* W4 = (bf16_t*)(ws + WS_W4);
    bf16_t* PROJ = (bf16_t*)(ws + WS_PROJ); bf16_t* X1B = (bf16_t*)(ws + WS_X1B); bf16_t* ACT = (bf16_t*)(ws + WS_ACT);
    bf16_t* OB = (bf16_t*)(ws + WS_OB);
    signed char* XQ = (signed char*)(ws + WS_XQ); float* FX = (float*)(ws + WS_FX); signed char* W1Q = (signed char*)(ws + WS_W1);
    for (int u = tid; u < 128; u += NWAVES * 64) ((LAS unsigned*)(lds + MISC_OFF))[u] = 0u;
    __syncthreads();
    XcdBarrier bar; bar.bar = ctl + CW_BAR + args.li * XCD_BAR_WORDS; bar.x = 0; bar.st = nullptr;
    if (MK_N_LAUNCHES != 6) bar = xcd_barrier_post(ctl + CW_BAR + args.li * XCD_BAR_WORDS, MISC + 8);
    const int lo = args.ph_lo, hi_ph = args.ph_hi;
#ifndef ONLY_PHASE
#define ONLY_PHASE -1
#endif
#define IN(k) ((ONLY_PHASE < 0 || ONLY_PHASE == (k)) && lo <= (k) && (k) < hi_ph)
#define BOTH(k) (IN(k) && IN((k) + 1))
#define GRID_BAR() do { if (MK_N_LAUNCHES != 6) xcd_barrier(bar); } while (0)

    if (IN(0)) {
        LAS float* scr = (LAS float*)(lds + wave * 16384);
        const int gw = vcu * NWAVES + wave, NGW = G * NWAVES;
        constexpr int I1 = (DM / 64) * (DIN / 32), I2 = (DM / 64) * (DM / 32), I3 = (DM / 64) * (2 * DFF / 32), I4 = (DFF / 64) * (DM / 32);
        for (int it = gw; it < I1 + I2 + I3 + I4; it += NGW) {
            int r = it;
            if (r < I1) { const int nblk = DIN / 32, kb = r / nblk, nb = r % nblk, n0 = 32 * nb, pn = n0 >> 8, p = n0 & 255, bj = p >> 7, wc = (p & 127) >> 5;
                absmax_item(args.in[3], DIN, 256 * pn + 64 * wc + 32 * bj, 64 * kb, ctl + CW_WMAX1 + n0, args.in[2], lane);
                asm volatile("s_waitcnt vmcnt(0)" ::: "memory"); if (lane == 0) (void)__hip_atomic_fetch_add(ctl + CW_W1CNT, 1u, __ATOMIC_RELAXED, __HIP_MEMORY_SCOPE_AGENT); continue; } r -= I1;
            if (r < I2) { const int nblk = DM / 32, kb = r / nblk, nb = r % nblk;
                const int n0 = 32 * nb, pn = n0 >> 8, p = n0 & 255, bj = p >> 7, wc = (p & 127) >> 5;
                transpose_item(args.in[15], DM, 256 * pn + 64 * wc + 32 * bj, DM, 64 * kb, W2, n0, args.in[10], 127, 1.0f - LAM_INIT, 512, scr, lane); continue; } r -= I2;
            if (r < I3) { const int nblk = 2 * DFF / 32, kb = r / nblk, nb = r % nblk, n0 = 32 * nb, pn = n0 >> 8, p = n0 & 255, bj = p >> 7, e0 = p & 127;
                absmax_item(bj ? args.in[18] : args.in[17], DFF, 128 * pn + e0, 64 * kb, ctl + CW_WMAX + n0, args.in[16], lane); continue; } r -= I3;
            { const int nblk = DM / 32, kb = r / nblk, nb = r % nblk;
                transpose_item(args.in[21], DM, 32 * nb, DFF, 64 * kb, W4, 32 * nb, nullptr, 0, 1.f, 0, scr, lane); }
        }
        for (int m = gw; m < NTOK; m += 4 * NGW) {
            f32x4 v[4][4]; float ss[4]; int mr[4];
#pragma unroll
            for (int q = 0; q < 4; ++q) { int mm = m + q * NGW; mr[q] = mm; if (mm >= NTOK) mm = m;
                const float* xr = mm < TOK_P ? xp + (size_t)mm * DM : xs + (size_t)(mm - TOK_P) * DM;
#pragma unroll
                for (int j = 0; j < 4; ++j) v[q][j] = __builtin_nontemporal_load((const f32x4*)xr + 64 * j + lane); }
#pragma unroll
            for (int q = 0; q < 4; ++q) { ss[q] = 0.f;
#pragma unroll
                for (int j = 0; j < 4; ++j) ss[q] += dot4(v[q][j]); }
#pragma unroll
            for (int o = 1; o < 64; o <<= 1) {
#pragma unroll
                for (int q = 0; q < 4; ++q) ss[q] += __shfl_xor(ss[q], o); }
            float am[4];
#pragma unroll
            for (int q = 0; q < 4; ++q) { float a = 0.f;
#pragma unroll
                for (int j = 0; j < 4; ++j) a = __builtin_fmaxf(__builtin_fmaxf(a, __builtin_fmaxf(__builtin_fabsf(v[q][j][0]), __builtin_fabsf(v[q][j][1]))), __builtin_fmaxf(__builtin_fabsf(v[q][j][2]), __builtin_fabsf(v[q][j][3])));
                am[q] = a; }
#pragma unroll
            for (int o = 1; o < 64; o <<= 1) {
#pragma unroll
                for (int q = 0; q < 4; ++q) am[q] = __builtin_fmaxf(am[q], __shfl_xor(am[q], o)); }
#pragma unroll
            for (int q = 0; q < 4; ++q) if (mr[q] < NTOK) { const float ms = ss[q] * (1.f / DM) + EPS; const float r = __builtin_amdgcn_rsqf(ms);
                { const float inv = am[q] > 0.f ? 127.0f / am[q] : 0.f;
                  unsigned* oq = (unsigned*)(XQ + (size_t)mr[q] * DM) + lane;
#pragma unroll
                  for (int j = 0; j < 4; ++j) oq[64 * j] = q4(v[q][j][0] * inv, v[q][j][1] * inv, v[q][j][2] * inv, v[q][j][3] * inv);
                  if (lane == 0) FX[mr[q]] = am[q] * r * (1.0f / 127.0f); }
            }
        }
        { unsigned sp = 0; while (__builtin_amdgcn_readfirstlane(__hip_atomic_load(ctl + CW_W1CNT, __ATOMIC_RELAXED, __HIP_MEMORY_SCOPE_AGENT)) < (unsigned)I1) { __builtin_amdgcn_s_sleep(2); if (++sp > (1u << 22)) break; }
          __builtin_amdgcn_fence(__ATOMIC_ACQUIRE, "agent"); }
        for (int r = gw; r < I1; r += NGW) { const int nblk = DIN / 32, kb = r / nblk, nb = r % nblk, n0 = 32 * nb, pn = n0 >> 8, p = n0 & 255, bj = p >> 7, wc = (p & 127) >> 5;
            quant_item(args.in[3], DIN, 256 * pn + 64 * wc + 32 * bj, DM, 64 * kb, W1Q, n0, args.in[2], ctl + CW_WMAX1 + n0, scr, lane); }
        if (BOTH(0)) GRID_BAR();
    }

    if (IN(1)) {
        pg8::Gemm g{(const bf16_t*)XQ, (const bf16_t*)W1Q, DM / 2, 256}; pg8::StaticOrder S; S.init(NTOK / 256, DIN / 256, G, bx);
        { LAS float* gl = (LAS float*)(lds + EPX_OFF);
          if (tid < 256) { const int v = tid >> 6, d = tid & 63; gl[tid] = (v == 0 ? args.in[4] : v == 1 ? args.in[5] : v == 2 ? args.in[11] : args.in[12])[d]; }
          LDS_WAIT(); __syncthreads(); }
        pg8::EpiProj E{PROJ, (const LAS float*)(lds + EPX_OFF), FX, (const float*)(ctl + CW_WMAX1)};
        pg8::gemm_phase<pg8::EpiProj, pg8::StaticOrder, true, true, true>(lds, g, S, E);
        if (BOTH(1)) GRID_BAR();
    }

    if (IN(2)) {
        if (wave == 0) {
            const float a = args.in[6][lane] * args.in[7][lane], b2 = args.in[8][lane] * args.in[9][lane];
            const float sa = wave_sum(a), sb = wave_sum(b2);
            if (lane == 0) ((LAS float*)(lds + MISC_OFF))[16] = __expf(sa) - __expf(sb) + LAM_INIT;
        }
        LDS_WAIT(); __syncthreads();
        const float lam = ((const LAS float*)(lds + MISC_OFF))[16];
        const int per = (768 + G - 1) / G;
#ifndef NO_DIFF
        for (int i = 0; i < per; ++i) { const int u = vcu * per + i; if (u < 768) { const int bh = u >> 3, qb = u & 7;
            att::diff_unit(bh >> 2, bh & 3, qb, PROJ, OB, (LAS char*)lds, lam, args.in[14]); } }
#endif
#ifndef NO_WIN
        for (int i = 0; i < per; ++i) { const int u = vcu * per + i; if (u < 768) { const int bk = u >> 4, qb = u & 15;
            att::win_unit(bk >> 1, bk & 1, qb, PROJ, OB, (LAS char*)lds, args.in[14], args.in[13]); } }
#endif
        if (BOTH(2)) GRID_BAR();
    }

    if (IN(3)) {
        pg8::Gemm g{OB, W2, DM, 256}; pg8::StaticOrder S; S.init(NTOK / 256, DM / 256, G, bx);
        {
            LAS float* scr = (LAS float*)(lds + wave * 16384);
            const int gw = vcu * NWAVES + wave, NGW = G * NWAVES;
            constexpr int I3 = (DM / 64) * (2 * DFF / 32);
            for (int r = gw; r < I3; r += NGW) { const int nblk = 2 * DFF / 32, kb = r / nblk, nb = r % nblk, n0 = 32 * nb, pn = n0 >> 8, p = n0 & 255, bj = p >> 7, e0 = p & 127;
                quant_item(bj ? args.in[18] : args.in[17], DFF, 128 * pn + e0, DM, 64 * kb, (signed char*)(ws + WS_W3), n0, args.in[16], ctl + CW_WMAX + n0, scr, lane); }
            __syncthreads();
        }
        pg8::EpiOut E{xp, xs, X1B, (LAS float*)(lds + EPX_OFF), (signed char*)(ws + WS_X1Q), (float*)(ws + WS_FA), (float*)(ws + WS_XS), ctl + CW_P3CNT};
        pg8::gemm_phase<pg8::EpiOut, pg8::StaticOrder>(lds, g, S, E);
        if (BOTH(3)) GRID_BAR();
    }

    if (IN(4)) {
        signed char* W3Q = (signed char*)(ws + WS_W3); signed char* X1Q = (signed char*)(ws + WS_X1Q); float* FA = (float*)(ws + WS_FA);
        pg8::Gemm g{(const bf16_t*)(X1Q - DM), (const bf16_t*)W3Q, DM / 2, 254}; pg8::StaticOrder S; S.init(194, 2 * DFF / 256, G, bx);
        pg8::EpiFfn E{ACT, FA, (const float*)(ctl + CW_WMAX), args.in[19], args.in[20], (LAS float*)(lds + EPX_OFF)};
        pg8::gemm_phase<pg8::EpiFfn, pg8::StaticOrder, true, true, true>(lds, g, S, E);
        if (BOTH(4)) GRID_BAR();
    }

    if (IN(5)) {
        pg8::Gemm g{ACT, W4, DFF, 256}; pg8::StaticOrder S; S.init(NTOK / 256, DM / 256, G, bx, 1);
        pg8::EpiDown E{X1B, args.out};
        pg8::gemm_phase<pg8::EpiDown, pg8::StaticOrder>(lds, g, S, E);
    }
#undef IN
#undef BOTH
#undef GRID_BAR
}

extern "C" void kernel_launch(void* const* d_in, const int* in_sizes, int n_in, void* d_out, int out_size, void* d_ws, size_t ws_size, hipStream_t stream) {
    static int grid = 0;
    if (grid == 0) {
        if (n_in != 22 || in_sizes[0] != TOK_P * DM || in_sizes[1] != (NTOK - TOK_P) * DM || out_size != NTOK * DM || ws_size < WS_END) {
            fprintf(stderr, "kernel_launch: shape mismatch (n_in %d, in0 %d, in1 %d, out %d, ws %zu; need ws >= %zu)\n", n_in, n_in > 0 ? in_sizes[0] : -1, n_in > 1 ? in_sizes[1] : -1, out_size, ws_size, (size_t)WS_END); grid = -1; return; }
        int dev = 0, cus = 0;
        if (hipGetDevice(&dev) != hipSuccess || hipDeviceGetAttribute(&cus, hipDeviceAttributeMultiprocessorCount, dev) != hipSuccess) { fprintf(stderr, "kernel_launch: device query failed\n"); grid = -1; return; }
        if (hipFuncSetAttribute((const void*)hymba_fwd, hipFuncAttributeMaxDynamicSharedMemorySize, LDS_BYTES) != hipSuccess) { fprintf(stderr, "kernel_launch: hipFuncSetAttribute failed\n"); grid = -1; return; }
        int per_cu = 0;
        if (hipOccupancyMaxActiveBlocksPerMultiprocessor(&per_cu, (const void*)hymba_fwd, NWAVES * 64, LDS_BYTES) != hipSuccess || per_cu < 1)
            fprintf(stderr, "kernel_launch: note: occupancy query reports %d workgroups per CU\n", per_cu);
        (void)hipGetLastError();
        grid = cus;
    }
    if (grid < 0) return;
    (void)hipMemsetAsync((char*)d_ws + WS_CTL, 0, CTL_ZERO_BYTES, stream);
    Args a{};
    for (int i = 0; i < 22; ++i) a.in[i] = (const float*)d_in[i];
    a.out = (float*)d_out; a.ws = (unsigned char*)d_ws;
#ifndef PROBE_DUP
#define PROBE_DUP -1
#endif
    constexpr int NL = (PROBE_DUP >= 0) ? 3 : MK_N_LAUNCHES;
    for (int li = 0; li < NL; ++li) {
        if (PROBE_DUP >= 0) {
            a.ph_lo = li == 0 ? 0 : (li == 1 ? PROBE_DUP : PROBE_DUP + 1); a.ph_hi = li == 2 ? 6 : PROBE_DUP + 1; a.li = li;
        } else { a.ph_lo = (NL == 6) ? li : 0; a.ph_hi = (NL == 6) ? li + 1 : 6; a.li = (NL == 6) ? 0 : li; }
        hipLaunchKernelGGL(hymba_fwd, dim3(grid), dim3(NWAVES * 64), LDS_BYTES, stream, a);
        const hipError_t le = hipPeekAtLastError();
        if (le != hipSuccess) { fprintf(stderr, "kernel_launch: launch %d failed: %s\n", li, hipGetErrorName(le)); break; }
    }
}
```

```cpp
#include <hip/hip_runtime.h>
#include <hip/hip_bf16.h>
#include <cstdio>
#include <cstdint>

#ifndef MK_N_LAUNCHES
#define MK_N_LAUNCHES 1
#endif

#define LAS __attribute__((address_space(3)))
#define GAS __attribute__((address_space(1)))
typedef unsigned short bf16_t;
typedef short bf16x8 __attribute__((ext_vector_type(8)));
typedef short s16x4 __attribute__((ext_vector_type(4)));
typedef float f32x2 __attribute__((ext_vector_type(2)));
typedef float f32x4 __attribute__((ext_vector_type(4)));
typedef float f32x16 __attribute__((ext_vector_type(16)));
typedef unsigned u32x2 __attribute__((ext_vector_type(2)));
typedef unsigned u32x4 __attribute__((ext_vector_type(4)));
typedef __bf16 bf16x2_t __attribute__((ext_vector_type(2)));

constexpr int DM = 1024, SEQ = 2048, NSEQ = 24, NTOK = NSEQ * SEQ, TOK_P = 8 * SEQ;
constexpr int DIN = 2304, DFF = 2816;
constexpr int C_DQ = 0, C_DK = 512, C_DV = 1024, C_WQ = 1536, C_WK = 2048, C_WV = 2176;
constexpr int NBH = 12;
constexpr float EPS = 1e-6f, LOG2E = 1.4426950408889634f, QSCALE = 0.125f * LOG2E;
constexpr float LAM_INIT = 0.2f;
constexpr int NWAVES = 8;

__device__ __forceinline__ unsigned cvtpk(float lo, float hi) { f32x2 v = {lo, hi}; bf16x2_t b = __builtin_convertvector(v, bf16x2_t); return __builtin_bit_cast(unsigned, b); }
__device__ __forceinline__ u32x4 pack8(f32x4 a, f32x4 b) { u32x4 w; w.x = cvtpk(a[0], a[1]); w.y = cvtpk(a[2], a[3]); w.z = cvtpk(b[0], b[1]); w.w = cvtpk(b[2], b[3]); return w; }
__device__ __forceinline__ float dot4(f32x4 a) { return (a[0] * a[0] + a[1] * a[1]) + (a[2] * a[2] + a[3] * a[3]); }

__device__ __forceinline__ unsigned q4(float a, float b, float c, float d) {
    const unsigned ua = __float_as_uint(a + 12582912.0f), ub = __float_as_uint(b + 12582912.0f), uc = __float_as_uint(c + 12582912.0f), ud = __float_as_uint(d + 12582912.0f);
    return (ua & 0xffu) | ((ub & 0xffu) << 8) | ((uc & 0xffu) << 16) | (ud << 24);
}
namespace pg8 {
constexpr int BM = 256, BK = 64, HALF = 128, HTB = HALF * BK * 2, STAGE_BYTES = 8 * HTB, NXCD = 8, WGM = 8;
__host__ __device__ __forceinline__ int lds_byte(int r, int c) { const int st = (r >> 4) * 2 + (c >> 5), rr = r & 15, cc = c & 31, ob = rr * 64 + cc * 2; return st * 1024 + (ob ^ (((ob >> 9) & 1) << 5)); }
__host__ __device__ __forceinline__ void stage_rc(int b, int& R, int& C) { const int st = b / 1024, sb = b % 1024, swz = sb ^ (((sb >> 9) & 1) << 5); R = (st >> 1) * 16 + swz / 64; C = (st & 1) * 32 + (swz % 64) / 2; }
__host__ __device__ __forceinline__ int perm32(int rho) { const int n = rho >> 4, i = rho & 15; return 8 * (i >> 2) + 4 * n + (i & 3); }

typedef int v4i32_t __attribute__((ext_vector_type(4)));
struct Unit { int pm, pn; };
struct Gemm { const bf16_t* A; const bf16_t* Bt; int K; int arows; };

struct StaticOrder {
    int nM, nN, nwg, G, c, rev;
    __device__ void init(int nM_, int nN_, int G_, int c_, int rev_ = 0) { nM = nM_; nN = nN_; nwg = nM * nN; G = G_; c = c_; rev = rev_; }
    __device__ bool next(int i, Unit& u) const {
        const int nr = (nwg - c + G - 1) / G; if (i >= nr) return false;
        const long L = (long)(rev ? nr - 1 - i : i) * G + c;
        int wgid = (int)L; { const int q = nwg / NXCD, r = nwg % NXCD, xcd = wgid % NXCD, off = wgid / NXCD; wgid = (xcd < r ? xcd * (q + 1) : r * (q + 1) + (xcd - r) * q) + off; }
        const int nig = WGM * nN, gid = wgid / nig, fm = gid * WGM, gsz = (nM - fm) < WGM ? (nM - fm) : WGM;
        u.pm = fm + ((wgid % nig) % gsz); u.pn = (wgid % nig) / gsz; return true;
    }
};


struct EpiProj {
    static constexpr bool PERM = true;
    bf16_t* P; const LAS float* gl; const float* fx; const float* swm;
    __device__ __forceinline__ void pre(const Unit& u, int wid, int lane_) const {
        int lane = lane_; asm volatile("" : "+v"(lane));
        if (wid >= 4) __builtin_amdgcn_global_load_lds((const unsigned*)(fx + u.pm * BM + 64 * (wid - 4) + lane), (LAS unsigned*)((LAS char*)gl + 1024 + (wid - 4) * 256), 4, 0, 0);
        if (wid == 2) __builtin_amdgcn_global_load_lds((const unsigned*)(swm + u.pn * 256 + lane * 4), (LAS unsigned*)((LAS char*)gl + 2048), 16, 0, 0);
    }
    __device__ __forceinline__ void operator()(const f32x4 (&acc)[2][2][4][2], const Unit& u, int wr, int wc, int fr, int fq, int lane) const {
        int fql = fq; asm volatile("" : "+v"(fql));
        f32x4 csw[2][2];
#pragma unroll
        for (int bj = 0; bj < 2; ++bj)
#pragma unroll
            for (int n = 0; n < 2; ++n) csw[bj][n] = *(const LAS f32x4*)(gl + 512 + 128 * bj + 32 * wc + 8 * fql + 4 * n) * (1.0f / 127.0f);
        const int gidx = u.pn * 4 + wc;
        int gsel = -1; float sc = 1.f;
        if (gidx < 8) { gsel = 0; sc = QSCALE; } else if (gidx < 16) { gsel = 1; } else if (gidx < 24) { } else if (gidx < 32) { gsel = 2; sc = QSCALE; } else if (gidx < 34) { gsel = 3; }
        const bool nrm = gsel >= 0; const LAS float* gain = gl + (nrm ? gsel : 0) * 64;
        f32x4 gv[2][2];
#pragma unroll
        for (int bj = 0; bj < 2; ++bj)
#pragma unroll
            for (int n = 0; n < 2; ++n) gv[bj][n] = nrm ? *(const LAS f32x4*)(gain + 32 * bj + 8 * fq + 4 * n) * sc : (f32x4){1.f, 1.f, 1.f, 1.f};
        bf16_t* base = P + (size_t)(u.pm * BM + wr * 64 + fr) * DIN + gidx * 64 + 8 * fq;
#pragma unroll
        for (int ai = 0; ai < 2; ++ai)
#pragma unroll
            for (int m = 0; m < 4; ++m) {
                const float fxr = gl[256 + ai * HALF + wr * 64 + m * 16 + fr];
                f32x4 v00 = __builtin_convertvector(__builtin_bit_cast(v4i32_t, acc[ai][0][m][0]), f32x4) * (csw[0][0] * fxr), v01 = __builtin_convertvector(__builtin_bit_cast(v4i32_t, acc[ai][0][m][1]), f32x4) * (csw[0][1] * fxr);
                f32x4 v10 = __builtin_convertvector(__builtin_bit_cast(v4i32_t, acc[ai][1][m][0]), f32x4) * (csw[1][0] * fxr), v11 = __builtin_convertvector(__builtin_bit_cast(v4i32_t, acc[ai][1][m][1]), f32x4) * (csw[1][1] * fxr);
                float rn = 1.f;
                if (nrm) { float ss = (dot4(v00) + dot4(v01)) + (dot4(v10) + dot4(v11)); ss += __shfl_xor(ss, 16); ss += __shfl_xor(ss, 32); rn = __builtin_amdgcn_rsqf(ss * (1.0f / 64.0f) + EPS); }
                v00 = v00 * rn * gv[0][0]; v01 = v01 * rn * gv[0][1]; v10 = v10 * rn * gv[1][0]; v11 = v11 * rn * gv[1][1];
                bf16_t* rowp = base + (size_t)(ai * HALF + m * 16) * DIN;
                const u32x4 pa = pack8(v00, v01), pb = pack8(v10, v11);
                u32x4 px; px.x = (unsigned)__builtin_amdgcn_mov_dpp((int)pb.x, 0x128, 0xf, 0xf, true); px.y = (unsigned)__builtin_amdgcn_mov_dpp((int)pb.y, 0x128, 0xf, 0xf, true);
                px.z = (unsigned)__builtin_amdgcn_mov_dpp((int)pb.z, 0x128, 0xf, 0xf, true); px.w = (unsigned)__builtin_amdgcn_mov_dpp((int)pb.w, 0x128, 0xf, 0xf, true);
                const bool hi8 = (fr & 8) != 0;
                bf16_t* r1p = base + (size_t)(ai * HALF + m * 16 - (hi8 ? 8 : 0)) * DIN + (hi8 ? 32 : 0);
                bf16_t* r2p = base + (size_t)(ai * HALF + m * 16 + (hi8 ? 0 : 8)) * DIN + (hi8 ? 0 : 32);
                *(u32x4*)(r1p) = hi8 ? px : pa; *(u32x4*)(r2p) = hi8 ? pa : px;
            }
    }
};

struct EpiOut {
    static constexpr bool PERM = true;
    const float* __restrict__ xp; const float* __restrict__ xsm; bf16_t* __restrict__ x1b; LAS float* xl;
    signed char* x1q; float* fa; float* xs; unsigned* cnt;
    __device__ __forceinline__ void pre(const Unit&, int, int) const {}
    __device__ __forceinline__ void operator()(f32x4 (&acc)[2][2][4][2], const Unit& u, int wr, int wc, int fr, int fq, int lane) const {
        asm volatile("" : "+v"(fr), "+v"(fq));
        const int rowbase = u.pm * BM;
        const int col0 = u.pn * BM + wc * 64 + 8 * fq;
        const bool hi8 = (fr & 8) != 0;
        const float* xrow0 = rowbase < TOK_P ? xp + (size_t)rowbase * DM : xsm + (size_t)(rowbase - TOK_P) * DM;
#pragma unroll
        for (int ai = 0; ai < 2; ++ai) {
            f32x4 xv[4][2][2];
#pragma unroll
            for (int m = 0; m < 4; ++m) { const float* xr = xrow0 + (size_t)(ai * HALF + wr * 64 + m * 16 + fr) * DM + col0;
#pragma unroll
                for (int bj = 0; bj < 2; ++bj) { xv[m][bj][0] = *(const f32x4*)(xr + bj * 32); xv[m][bj][1] = *(const f32x4*)(xr + bj * 32 + 4); } }
#pragma unroll
            for (int m = 0; m < 4; ++m) {
                const int rl = ai * HALF + wr * 64 + m * 16 + fr; float s = 0.f, am = 0.f; u32x4 pk[2];
#pragma unroll
                for (int bj = 0; bj < 2; ++bj) {
                    const f32x4 o0 = xv[m][bj][0] + acc[ai][bj][m][0], o1 = xv[m][bj][1] + acc[ai][bj][m][1];
                    pk[bj] = pack8(o0, o1);
                    f32x4 b0, b1;
                    b0[0] = __uint_as_float(pk[bj].x << 16); b0[1] = __uint_as_float(pk[bj].x & 0xffff0000u); b0[2] = __uint_as_float(pk[bj].y << 16); b0[3] = __uint_as_float(pk[bj].y & 0xffff0000u);
                    b1[0] = __uint_as_float(pk[bj].z << 16); b1[1] = __uint_as_float(pk[bj].z & 0xffff0000u); b1[2] = __uint_as_float(pk[bj].w << 16); b1[3] = __uint_as_float(pk[bj].w & 0xffff0000u);
                    acc[ai][bj][m][0] = b0; acc[ai][bj][m][1] = b1;
#pragma unroll
                    for (int i = 0; i < 4; ++i) am = __builtin_fmaxf(am, __builtin_fmaxf(__builtin_fabsf(b0[i]), __builtin_fabsf(b1[i])));
                    s += dot4(o0) + dot4(o1); }
                s += __shfl_xor(s, 16); s += __shfl_xor(s, 32);
                am = __builtin_fmaxf(am, __shfl_xor(am, 16)); am = __builtin_fmaxf(am, __shfl_xor(am, 32));
                if (fq == 0) { xl[rl * 8 + wc] = s; xl[rl * 8 + 4 + wc] = am; }
            }
        }
        asm volatile("s_waitcnt lgkmcnt(0)" ::: "memory"); __builtin_amdgcn_s_barrier(); asm volatile("" ::: "memory");
        const int t = (wr * 4 + wc) * 64 + lane;
        if (t < 256) {
            const f32x4 q = *(const LAS f32x4*)(xl + t * 8), a4 = *(const LAS f32x4*)(xl + t * 8 + 4);
            float* sl = xs + ((size_t)(rowbase + t) * 4 + u.pn) * 2;
            __hip_atomic_store(sl, (q[0] + q[1]) + (q[2] + q[3]), __ATOMIC_RELAXED, __HIP_MEMORY_SCOPE_AGENT);
            __hip_atomic_store(sl + 1, __builtin_fmaxf(__builtin_fmaxf(a4[0], a4[1]), __builtin_fmaxf(a4[2], a4[3])), __ATOMIC_RELAXED, __HIP_MEMORY_SCOPE_AGENT);
            asm volatile("s_waitcnt vmcnt(0)" ::: "memory");
            if (lane == 0) (void)__hip_atomic_fetch_add(cnt + u.pm, 1u, __ATOMIC_RELAXED, __HIP_MEMORY_SCOPE_AGENT);
        }
#pragma unroll
        for (int ai = 0; ai < 2; ++ai)
#pragma unroll
            for (int m = 0; m < 4; ++m) { const int rl = ai * HALF + wr * 64 + m * 16 + fr;
                const u32x4 pk0 = pack8(acc[ai][0][m][0], acc[ai][0][m][1]), pk1 = pack8(acc[ai][1][m][0], acc[ai][1][m][1]);
                u32x4 px; px.x = (unsigned)__builtin_amdgcn_mov_dpp((int)pk1.x, 0x128, 0xf, 0xf, true); px.y = (unsigned)__builtin_amdgcn_mov_dpp((int)pk1.y, 0x128, 0xf, 0xf, true);
                px.z = (unsigned)__builtin_amdgcn_mov_dpp((int)pk1.z, 0x128, 0xf, 0xf, true); px.w = (unsigned)__builtin_amdgcn_mov_dpp((int)pk1.w, 0x128, 0xf, 0xf, true);
                bf16_t* r1p = x1b + (size_t)(rowbase + rl - (hi8 ? 8 : 0)) * DM + col0 + (hi8 ? 32 : 0);
                bf16_t* r2p = x1b + (size_t)(rowbase + rl + (hi8 ? 0 : 8)) * DM + col0 + (hi8 ? 0 : 32);
                *(u32x4*)(r1p) = hi8 ? px : pk0; *(u32x4*)(r2p) = hi8 ? pk0 : px; }
        if (t < 64) {
            unsigned sp = 0; while (__builtin_amdgcn_readfirstlane(__hip_atomic_load(cnt + u.pm, __ATOMIC_RELAXED, __HIP_MEMORY_SCOPE_AGENT)) < 16u) { __builtin_amdgcn_s_sleep(1); if (++sp > (1u << 22)) break; }
        }
        asm volatile("s_waitcnt lgkmcnt(0)" ::: "memory"); __builtin_amdgcn_s_barrier(); asm volatile("" ::: "memory");
        if (t < 256) {
            const float* sl = xs + (size_t)(rowbase + t) * 8; float ss = 0.f, am = 0.f;
#pragma unroll
            for (int j = 0; j < 4; ++j) { ss += __hip_atomic_load(sl + 2 * j, __ATOMIC_RELAXED, __HIP_MEMORY_SCOPE_AGENT); am = __builtin_fmaxf(am, __hip_atomic_load(sl + 2 * j + 1, __ATOMIC_RELAXED, __HIP_MEMORY_SCOPE_AGENT)); }
            xl[2048 + t] = am > 0.f ? 127.0f / am : 0.f;
            if (u.pn == 0) fa[rowbase + t] = __builtin_amdgcn_rsqf(ss * (1.0f / DM) + EPS) * am * (1.0f / 127.0f);
        }
        asm volatile("s_waitcnt lgkmcnt(0)" ::: "memory"); __builtin_amdgcn_s_barrier(); asm volatile("" ::: "memory");
#pragma unroll
        for (int ai = 0; ai < 2; ++ai)
#pragma unroll
            for (int m = 0; m < 4; ++m) { const int rl = ai * HALF + wr * 64 + m * 16 + fr; const float inv = xl[2048 + rl];
                signed char* qp = x1q + (size_t)(rowbase + rl) * DM + col0;
#pragma unroll
                for (int bj = 0; bj < 2; ++bj) { const f32x4 b0 = acc[ai][bj][m][0] * inv, b1 = acc[ai][bj][m][1] * inv;
                    u32x2 o; o.x = q4(b0[0], b0[1], b0[2], b0[3]); o.y = q4(b1[0], b1[1], b1[2], b1[3]);
                    *(u32x2*)(qp + 32 * bj) = o; } }
    }
};

__device__ __forceinline__ float dpp8(float x) { return __builtin_bit_cast(float, __builtin_amdgcn_mov_dpp(__builtin_bit_cast(int, x), 0x128, 0xf, 0xf, true)); }
struct EpiDown {
    static constexpr bool PERM = true;
    const bf16_t* __restrict__ x1b; float* __restrict__ out;
    __device__ __forceinline__ void pre(const Unit&, int, int) const {}
    __device__ __forceinline__ void operator()(const f32x4 (&acc)[2][2][4][2], const Unit& u, int wr, int wc, int fr, int fq, int lane) const {
        const int col0 = u.pn * BM + wc * 32 + 8 * fq; const bool hi8 = (fr & 8) != 0;
        u32x4 w[2][4][2];
#pragma unroll
        for (int ai = 0; ai < 2; ++ai)
#pragma unroll
            for (int m = 0; m < 4; ++m) { const size_t off = (size_t)(u.pm * BM + ai * HALF + wr * 64 + m * 16 + fr) * DM + col0;
#pragma unroll
                for (int bj = 0; bj < 2; ++bj) w[ai][m][bj] = *(const u32x4*)(x1b + off + bj * HALF); }
#pragma unroll
        for (int ai = 0; ai < 2; ++ai)
#pragma unroll
            for (int m = 0; m < 4; ++m) { const size_t off = (size_t)(u.pm * BM + ai * HALF + wr * 64 + m * 16 + fr) * DM + col0;
#pragma unroll
                for (int bj = 0; bj < 2; ++bj) { const u32x4 ww = w[ai][m][bj];
                    f32x4 r0, r1;
                    r0[0] = __uint_as_float(ww.x << 16); r0[1] = __uint_as_float(ww.x & 0xffff0000u); r0[2] = __uint_as_float(ww.y << 16); r0[3] = __uint_as_float(ww.y & 0xffff0000u);
                    r1[0] = __uint_as_float(ww.z << 16); r1[1] = __uint_as_float(ww.z & 0xffff0000u); r1[2] = __uint_as_float(ww.w << 16); r1[3] = __uint_as_float(ww.w & 0xffff0000u);
                    const f32x4 q0 = r0 + acc[ai][bj][m][0], q1 = r1 + acc[ai][bj][m][1];
                    f32x4 qx; qx[0] = dpp8(q1[0]); qx[1] = dpp8(q1[1]); qx[2] = dpp8(q1[2]); qx[3] = dpp8(q1[3]);
                    const long d1 = hi8 ? (long)(4 - 8 * DM) : 0, d2 = hi8 ? 0 : (long)(4 + 8 * DM);
                    *(f32x4*)(out + off + bj * HALF + d1) = hi8 ? qx : q0; *(f32x4*)(out + off + bj * HALF + d2) = hi8 ? q0 : qx; } }
    }
};

template <int CTRL> __device__ __forceinline__ float dppz(float x) { return __builtin_bit_cast(float, __builtin_amdgcn_update_dpp(0, __builtin_bit_cast(int, x), CTRL, 0xf, 0xf, true)); }
struct EpiFfn {
    static constexpr bool PERM = true;
    bf16_t* act; const float* fa; const float* swm; const float* cw; const float* cb; LAS float* xl;
    __device__ __forceinline__ void pre(const Unit& u, int wid, int lane_) const {
        int lane = lane_; asm volatile("" : "+v"(lane));
        const int tok0 = 254 * u.pm - 1;
        if (wid >= 4) { int tok = tok0 + 64 * (wid - 4) + lane; tok = tok < 0 ? 0 : (tok > NTOK - 1 ? NTOK - 1 : tok);
            __builtin_amdgcn_global_load_lds((const unsigned*)(fa + tok), (LAS unsigned*)((LAS char*)xl + 4096 + (wid - 4) * 256), 4, 0, 0); }
        if (wid == 2) __builtin_amdgcn_global_load_lds((const unsigned*)(swm + u.pn * 256 + lane * 4), (LAS unsigned*)((LAS char*)xl + 5120), 16, 0, 0);
        if (wid < 2) { const float* src = (wid == 0 ? (lane < 32 ? cw : cw + DFF) : (lane < 32 ? cw + 2 * DFF : cb)) + u.pn * 128 + (lane & 31) * 4;
            __builtin_amdgcn_global_load_lds((const unsigned*)src, (LAS unsigned*)((LAS char*)xl + 20480 + wid * 1024), 16, 0, 0); }
    }
    template <int AI, int M, bool MASK>
    __device__ __forceinline__ void conv_rows(const f32x4 (&acc)[2][2][4][2], const f32x4 (&w0)[2], const f32x4 (&w1)[2], const f32x4 (&w2)[2], const f32x4 (&bb)[2],
                                              int tok, int rl, int G, int xc, int fr, int ch0) const {
        const bool pcut = MASK && (tok & (SEQ - 1)) == 0, ncut = MASK && (tok & (SEQ - 1)) == SEQ - 1;
        f32x4 r0, r1;
#pragma unroll
        for (int n = 0; n < 2; ++n) { f32x4 res;
            f32x4 ex = (f32x4){0.f, 0.f, 0.f, 0.f};
            if (M == 0) { if (G > 0) ex = *(const LAS f32x4*)(xl + (2 * (G - 1) + 1) * 128 + xc + 4 * n); ex = fr == 0 ? ex : (f32x4){0.f, 0.f, 0.f, 0.f}; }
            if (M == 3) { if (G < 3) ex = *(const LAS f32x4*)(xl + (2 * (G + 1)) * 128 + xc + 4 * n); ex = fr == 15 ? ex : (f32x4){0.f, 0.f, 0.f, 0.f}; }
#pragma unroll
            for (int i = 0; i < 4; ++i) {
                const float own = acc[AI][0][M][n][i];
                float pr = dppz<0x111>(own);
                pr += (M > 0) ? dppz<0x10F>(acc[AI][0][M > 0 ? M - 1 : 0][n][i]) : ex[i];
                float nx = dppz<0x101>(own);
                nx += (M < 3) ? dppz<0x11F>(acc[AI][0][M < 3 ? M + 1 : 3][n][i]) : ex[i];
                if (MASK) { pr = pcut ? 0.f : pr; nx = ncut ? 0.f : nx; }
                const float uc = fmaf(w0[n][i], pr, fmaf(w1[n][i], own, fmaf(w2[n][i], nx, bb[n][i])));
                const float sg = uc * __builtin_amdgcn_rcpf(1.0f + __builtin_amdgcn_exp2f(-LOG2E * uc));
                res[i] = sg * acc[AI][1][M][n][i];
            }
            if (n == 0) r0 = res; else r1 = res; }
        if (rl != 0 && rl != 255 && tok < NTOK) *(u32x4*)(act + (size_t)tok * DFF + ch0) = pack8(r0, r1);
    }
    __device__ __forceinline__ void operator()(f32x4 (&acc)[2][2][4][2], const Unit& u, int wr, int wc, int fr, int fq, int lane) const {
        const int ch0 = u.pn * 128 + wc * 32 + 8 * fq;
        const int tok0 = 254 * u.pm - 1;
        int fql = fq; asm volatile("" : "+v"(fql));
        const int xc = wc * 32 + 8 * fql;
        f32x4 su[2];
#pragma unroll
        for (int n = 0; n < 2; ++n) su[n] = *(const LAS f32x4*)(xl + 1280 + 128 + xc + 4 * n) * (1.0f / 127.0f);
#pragma unroll
        for (int ai = 0; ai < 2; ++ai)
#pragma unroll
            for (int m = 0; m < 4; ++m) { const float rs = xl[1024 + ai * HALF + wr * 64 + m * 16 + fr];
#pragma unroll
                for (int n = 0; n < 2; ++n) { const f32x4 rsu = su[n] * rs;
                    acc[ai][0][m][n] = __builtin_convertvector(__builtin_bit_cast(v4i32_t, acc[ai][0][m][n]), f32x4) * rs;
                    acc[ai][1][m][n] = __builtin_convertvector(__builtin_bit_cast(v4i32_t, acc[ai][1][m][n]), f32x4) * rsu; } }
#pragma unroll
        for (int ai = 0; ai < 2; ++ai) { const int G = 2 * ai + wr;
            if (fr == 0) { *(LAS f32x4*)(xl + (2 * G) * 128 + xc) = acc[ai][0][0][0]; *(LAS f32x4*)(xl + (2 * G) * 128 + xc + 4) = acc[ai][0][0][1]; }
            if (fr == 15) { *(LAS f32x4*)(xl + (2 * G + 1) * 128 + xc) = acc[ai][0][3][0]; *(LAS f32x4*)(xl + (2 * G + 1) * 128 + xc + 4) = acc[ai][0][3][1]; } }
        asm volatile("s_waitcnt lgkmcnt(0)" ::: "memory"); __builtin_amdgcn_s_barrier(); asm volatile("" ::: "memory"); __builtin_amdgcn_sched_barrier(0);
        f32x4 w0[2], w1[2], w2[2], bb[2];
#pragma unroll
        for (int n = 0; n < 2; ++n) { const LAS float* wl = xl + 5120 + xc + 4 * n; const f32x4 sgc = *(const LAS f32x4*)(xl + 1280 + xc + 4 * n) * (1.0f / 127.0f);
            w0[n] = *(const LAS f32x4*)(wl) * sgc; w1[n] = *(const LAS f32x4*)(wl + 128) * sgc; w2[n] = *(const LAS f32x4*)(wl + 256) * sgc; bb[n] = *(const LAS f32x4*)(wl + 384); }
#define FFN_ROWS(AI, M) do { const int tb_ = tok0 + AI * HALF + wr * 64 + M * 16; const int G_ = 2 * AI + wr; \
        conv_rows<AI, M, true>(acc, w0, w1, w2, bb, tb_ + fr, AI * HALF + wr * 64 + M * 16 + fr, G_, xc, fr, ch0); \
        if ((M) & 1) __builtin_amdgcn_sched_barrier(0); } while (0)
        FFN_ROWS(0, 0); FFN_ROWS(0, 1); FFN_ROWS(0, 2); FFN_ROWS(0, 3); FFN_ROWS(1, 0); FFN_ROWS(1, 1); FFN_ROWS(1, 2); FFN_ROWS(1, 3);
#undef FFN_ROWS
    }
};

template <class Epi, class Sched, bool ALIGN_EPI = true, bool SP2 = true, bool I8 = false>
__device__ __forceinline__ void gemm_phase(LAS unsigned char* lds, const Gemm g, const Sched& S, const Epi& E) {
    const int tid = threadIdx.x, wid = __builtin_amdgcn_readfirstlane(tid >> 6), lane = tid & 63, wr = wid >> 2, wc = wid & 3, fr = lane & 15, fq = lane >> 4;
    const int K = g.K, nt = K / BK;
    unsigned voffA[2], voffB[2];
#pragma unroll
    for (int i = 0; i < 2; ++i) { int R, C; stage_rc(tid * 16 + i * 8192, R, C); const int Rb = Epi::PERM ? ((R & ~31) + perm32(R & 31)) : R;
        voffA[i] = (unsigned)(R * K + C) * 2u; voffB[i] = (unsigned)(Rb * K + C) * 2u; }
    const size_t kstep = (size_t)(BK * 2);
    const size_t hstep = (size_t)HALF * K * 2;
    const size_t tstepB = 2 * hstep;
    const size_t tstepA = (size_t)g.arows * K * 2;
    const unsigned ldsw = (unsigned)wid * 1024u;
    const int aoff = lds_byte(wr * 64 + fr, fq * 8), boff = lds_byte(wc * 32 + fr, fq * 8);
#define PG8_SA(b, h) (((b) * 2 + (h)) * HTB)
#define PG8_SB(b, h) ((4 + (b) * 2 + (h)) * HTB)
#define PG8_STAGE(bufoff, gbase, voff) do { _Pragma("unroll") for (int _i = 0; _i < 2; ++_i) \
        __builtin_amdgcn_global_load_lds((const unsigned*)((const char*)(gbase) + (voff)[_i]), (LAS unsigned*)(lds + (bufoff) + ldsw + _i * 8192), 16, 0, 0); } while (0)
#define PG8_LDA(dst, b, h) do { _Pragma("unroll") for (int m = 0; m < 4; ++m) _Pragma("unroll") for (int k = 0; k < 2; ++k) dst[m][k] = *(const LAS bf16x8*)(lds + PG8_SA(b, h) + aoff + m * 2048 + k * 1024); } while (0)
#define PG8_LDB(dst, b, h) do { _Pragma("unroll") for (int n = 0; n < 2; ++n) _Pragma("unroll") for (int k = 0; k < 2; ++k) dst[n][k] = *(const LAS bf16x8*)(lds + PG8_SB(b, h) + boff + n * 2048 + k * 1024); } while (0)
#define PG8_MMA(ai, bj, At, Bt) do { __builtin_amdgcn_s_setprio(1); _Pragma("unroll") for (int m = 0; m < 4; ++m) _Pragma("unroll") for (int n = 0; n < 2; ++n) _Pragma("unroll") for (int k = 0; k < 2; ++k) \
        { if constexpr (I8) acc[ai][bj][m][n] = __builtin_bit_cast(f32x4, __builtin_amdgcn_mfma_i32_16x16x64_i8(__builtin_bit_cast(v4i32_t, Bt[n][k]), __builtin_bit_cast(v4i32_t, At[m][k]), __builtin_bit_cast(v4i32_t, acc[ai][bj][m][n]), 0, 0, 0)); \
          else acc[ai][bj][m][n] = __builtin_amdgcn_mfma_f32_16x16x32_bf16(Bt[n][k], At[m][k], acc[ai][bj][m][n], 0, 0, 0); } __builtin_amdgcn_s_setprio(0); } while (0)
#define PG8_WAIT_V(n) asm volatile("s_waitcnt vmcnt(" #n ")" ::: "memory")
#define PG8_WAIT_L(n) asm volatile("s_waitcnt lgkmcnt(" #n ")" ::: "memory")
#define PG8_BAR __builtin_amdgcn_s_barrier()
#define PG8_SCHED __builtin_amdgcn_sched_barrier(0)
    Unit cur, nxt; int ui = 0;
    if (!S.next(0, cur)) return;
    f32x4 acc[2][2][4][2];
#pragma unroll
    for (int a = 0; a < 2; ++a)
#pragma unroll
        for (int b = 0; b < 2; ++b)
#pragma unroll
            for (int m = 0; m < 4; ++m)
#pragma unroll
                for (int n = 0; n < 2; ++n) acc[a][b][m][n] = (f32x4){0.f, 0.f, 0.f, 0.f};
    bf16x8 At[4][2], B0[2][2], B1[2][2];
    const char* cA = (const char*)g.A + (size_t)cur.pm * tstepA; const char* cB = (const char*)g.Bt + (size_t)cur.pn * tstepB;
    if constexpr (SP2) {
        PG8_STAGE(PG8_SB(0, 0), cB, voffB); PG8_STAGE(PG8_SB(0, 1), cB + hstep, voffB); PG8_STAGE(PG8_SA(0, 0), cA, voffA); PG8_STAGE(PG8_SA(0, 1), cA + hstep, voffA);
        if (wr == 1) PG8_BAR;
        PG8_WAIT_V(2); PG8_BAR;
        PG8_STAGE(PG8_SB(1, 0), cB + kstep, voffB); PG8_STAGE(PG8_SA(1, 0), cA + kstep, voffA); PG8_STAGE(PG8_SB(1, 1), cB + hstep + kstep, voffB);
        PG8_WAIT_V(6); PG8_BAR;
    } else {
        PG8_STAGE(PG8_SB(0, 0), cB, voffB); PG8_STAGE(PG8_SA(0, 0), cA, voffA); PG8_STAGE(PG8_SB(0, 1), cB + hstep, voffB); PG8_STAGE(PG8_SA(0, 1), cA + hstep, voffA);
        if (wr == 1) PG8_BAR;
        PG8_WAIT_V(4); PG8_BAR;
        PG8_STAGE(PG8_SB(1, 0), cB + kstep, voffB); PG8_STAGE(PG8_SA(1, 0), cA + kstep, voffA); PG8_STAGE(PG8_SB(1, 1), cB + hstep + kstep, voffB);
        PG8_WAIT_V(6); PG8_BAR;
    }
    for (;;) {
        const bool has_next = S.next(ui + 1, nxt);
        const char* nA = has_next ? (const char*)g.A + (size_t)nxt.pm * tstepA : cA; const char* nB = has_next ? (const char*)g.Bt + (size_t)nxt.pn * tstepB : cB;
        for (int t = 0; t < nt; t += 2) {
            const bool last = (t == nt - 2);
            const char* a1 = cA + (size_t)(t + 1) * kstep;
            const char* a2 = last ? nA : cA + (size_t)(t + 2) * kstep; const char* b2 = last ? nB : cB + (size_t)(t + 2) * kstep;
            const char* a3 = a2 + kstep; const char* b3 = b2 + kstep;
            if (last) E.pre(cur, wid, lane);
            if constexpr (SP2) {
            PG8_LDB(B0, 0, 0); PG8_LDB(B1, 0, 1); PG8_SCHED; PG8_LDA(At, 0, 0); PG8_STAGE(PG8_SA(1, 1), a1 + hstep, voffA);
            PG8_WAIT_V(8); PG8_WAIT_L(0); PG8_BAR; PG8_MMA(0, 0, At, B0); PG8_MMA(0, 1, At, B1); PG8_BAR; PG8_SCHED;
            PG8_LDA(At, 0, 1); PG8_STAGE(PG8_SB(0, 0), b2, voffB); PG8_STAGE(PG8_SB(0, 1), b2 + hstep, voffB); PG8_STAGE(PG8_SA(0, 0), a2, voffA);
            PG8_WAIT_V(8); PG8_WAIT_L(0); PG8_BAR; PG8_MMA(1, 0, At, B0); PG8_MMA(1, 1, At, B1); PG8_BAR; PG8_SCHED;
            PG8_LDB(B0, 1, 0); PG8_LDB(B1, 1, 1); PG8_SCHED; PG8_LDA(At, 1, 0); PG8_STAGE(PG8_SA(0, 1), a2 + hstep, voffA);
            PG8_WAIT_V(8); PG8_WAIT_L(0); PG8_BAR; PG8_MMA(0, 0, At, B0); PG8_MMA(0, 1, At, B1); PG8_BAR; PG8_SCHED;
            PG8_LDA(At, 1, 1); PG8_STAGE(PG8_SB(1, 0), b3, voffB); PG8_STAGE(PG8_SB(1, 1), b3 + hstep, voffB); PG8_STAGE(PG8_SA(1, 0), a3, voffA);
            PG8_WAIT_V(8); PG8_WAIT_L(0); PG8_BAR; PG8_MMA(1, 0, At, B0); PG8_MMA(1, 1, At, B1); PG8_BAR; PG8_SCHED;
            } else {
            PG8_LDB(B0, 0, 0); PG8_SCHED; PG8_LDA(At, 0, 0); PG8_STAGE(PG8_SA(1, 1), a1 + hstep, voffA);
            PG8_WAIT_L(8); PG8_BAR; PG8_WAIT_L(0); PG8_MMA(0, 0, At, B0); PG8_BAR; PG8_SCHED;
            PG8_LDB(B1, 0, 1); PG8_STAGE(PG8_SB(0, 0), b2, voffB);
            PG8_BAR; PG8_WAIT_L(0); PG8_MMA(0, 1, At, B1); PG8_BAR;
            PG8_LDA(At, 0, 1); PG8_STAGE(PG8_SA(0, 0), a2, voffA);
            PG8_BAR; PG8_WAIT_L(0); PG8_MMA(1, 0, At, B0); PG8_BAR; PG8_SCHED;
            PG8_STAGE(PG8_SB(0, 1), b2 + hstep, voffB);
            PG8_WAIT_V(6); PG8_BAR; PG8_MMA(1, 1, At, B1); PG8_BAR;
            PG8_LDB(B0, 1, 0); PG8_SCHED; PG8_LDA(At, 1, 0); PG8_STAGE(PG8_SA(0, 1), a2 + hstep, voffA);
            PG8_WAIT_L(8); PG8_BAR; PG8_WAIT_L(0); PG8_MMA(0, 0, At, B0); PG8_BAR; PG8_SCHED;
            PG8_LDB(B1, 1, 1); PG8_STAGE(PG8_SB(1, 0), b3, voffB);
            PG8_BAR; PG8_WAIT_L(0); PG8_MMA(0, 1, At, B1); PG8_BAR;
            PG8_LDA(At, 1, 1); PG8_STAGE(PG8_SA(1, 0), a3, voffA);
            PG8_BAR; PG8_WAIT_L(0); PG8_MMA(1, 0, At, B0); PG8_BAR; PG8_SCHED;
            PG8_STAGE(PG8_SB(1, 1), b3 + hstep, voffB);
            PG8_WAIT_V(6); PG8_BAR; PG8_MMA(1, 1, At, B1); PG8_BAR;
            }
        }
        if constexpr (ALIGN_EPI) { if (wr == 0) PG8_BAR; }
        E(acc, cur, wr, wc, fr, fq, lane);
        if (!has_next) break;
#pragma unroll
        for (int a = 0; a < 2; ++a)
#pragma unroll
            for (int b = 0; b < 2; ++b)
#pragma unroll
                for (int m = 0; m < 4; ++m)
#pragma unroll
                    for (int n = 0; n < 2; ++n) acc[a][b][m][n] = (f32x4){0.f, 0.f, 0.f, 0.f};
        cur = nxt; cA = nA; cB = nB; ++ui;
        if constexpr (ALIGN_EPI) { if (wr == 1) PG8_BAR; }
    }
    PG8_WAIT_V(0);
    if constexpr (!ALIGN_EPI) { if (wr == 0) PG8_BAR; }
    PG8_BAR;
#undef PG8_SA
#undef PG8_SB
#undef PG8_STAGE
#undef PG8_LDA
#undef PG8_LDB
#undef PG8_MMA
#undef PG8_WAIT_V
#undef PG8_WAIT_L
#undef PG8_BAR
#undef PG8_SCHED
}
}

namespace att {
constexpr int PITCH = DIN;
#define SBAR() __builtin_amdgcn_sched_barrier(0)
#define KSW(row, colB) ((row) * 128 + ((colB) ^ ((((row) >> 1) & 7) << 4)))
__device__ __forceinline__ int crow(int r, int hi) { return (r & 3) + 8 * (r >> 2) + 4 * hi; }
__device__ __forceinline__ int rel_bucket(int rel) {
    const int n = rel < 0 ? -rel : rel; int v;
    if (n < 8) v = n; else { v = 2 + (31 - __clz(n * n)); v = v > 15 ? 15 : v; }
    return (rel > 0 ? 16 : 0) + v;
}
constexpr float THR = 5.0f;

__device__ __forceinline__ void partialSM(f32x16& p0, f32x16& p1, float off, float& m_reg, float& alpha) {
    float pmax = p0[0];
#pragma unroll
    for (int r = 1; r < 16; ++r) pmax = fmaxf(pmax, p0[r]);
#pragma unroll
    for (int r = 0; r < 16; ++r) pmax = fmaxf(pmax, p1[r]);
    { auto rr = __builtin_amdgcn_permlane32_swap(__float_as_uint(pmax), __float_as_uint(pmax), false, false);
      pmax = fmaxf(__uint_as_float(rr[0]), __uint_as_float(rr[1])); }
    pmax += off;
    if (__builtin_expect(__all(pmax - m_reg <= THR), 1)) { alpha = 1.f; }
    else { const float mn = fmaxf(m_reg, pmax); alpha = __builtin_amdgcn_exp2f(m_reg - mn); m_reg = mn; }
    const float sub = off - m_reg;
#pragma unroll
    for (int r = 0; r < 16; ++r) { p0[r] += sub; p1[r] += sub; }
#pragma unroll
    for (int r = 0; r < 16; ++r) p0[r] = __builtin_amdgcn_exp2f(p0[r]);
}
__device__ __forceinline__ void finishSM(f32x16& p0, f32x16& p1, float alpha, float& l_reg, bf16x8& pa0, bf16x8& pa1, bf16x8& pa2, bf16x8& pa3) {
#pragma unroll
    for (int r = 0; r < 16; ++r) p1[r] = __builtin_amdgcn_exp2f(p1[r]);
    float ps = 0;
#pragma unroll
    for (int r = 0; r < 16; ++r) ps += p0[r];
#pragma unroll
    for (int r = 0; r < 16; ++r) ps += p1[r];
    { auto rr = __builtin_amdgcn_permlane32_swap(__float_as_uint(ps), __float_as_uint(ps), false, false);
      ps = __uint_as_float(rr[0]) + __uint_as_float(rr[1]); }
    l_reg = l_reg * alpha + ps;
#define PK4(P, BASE, OUT) do { unsigned a0 = cvtpk(P[BASE + 0], P[BASE + 1]), a1 = cvtpk(P[BASE + 2], P[BASE + 3]);   \
    unsigned b0 = cvtpk(P[BASE + 4], P[BASE + 5]), b1 = cvtpk(P[BASE + 6], P[BASE + 7]);                              \
    auto r0 = __builtin_amdgcn_permlane32_swap(a0, b0, false, false); auto r1 = __builtin_amdgcn_permlane32_swap(a1, b1, false, false); \
    u32x4 w = {r0[0], r1[0], r0[1], r1[1]}; OUT = __builtin_bit_cast(bf16x8, w); } while (0)
    PK4(p0, 0, pa0); PK4(p0, 8, pa1); PK4(p1, 0, pa2); PK4(p1, 8, pa3);
#undef PK4
}
__device__ __forceinline__ void qkt64(f32x16& p0, f32x16& p1, const LAS char* Ks, const bf16x8* qr, int r32, int hi) {
#pragma unroll
    for (int d0 = 0; d0 < 4; ++d0) { const int cb = (d0 * 16 + hi * 8) * 2;
        const bf16x8 b0 = *(const LAS bf16x8*)(Ks + KSW(r32, cb));
        const bf16x8 b1 = *(const LAS bf16x8*)(Ks + KSW(r32, cb) + 4096);
        p0 = __builtin_amdgcn_mfma_f32_32x32x16_bf16(b0, qr[d0], p0, 0, 0, 0); p1 = __builtin_amdgcn_mfma_f32_32x32x16_bf16(b1, qr[d0], p1, 0, 0, 0); }
}
template <int NCB> __device__ __forceinline__ int v_st(int k, int c) { const int kk = (k & ~0xC) | ((k & 4) << 1) | ((k & 8) >> 1); return ((kk >> 3) * NCB + (c >> 5)) * 512 + ((kk & 7) * 32 + (c & 31)) * 2; }
__device__ __forceinline__ int v_rd_base(int lane) { return ((lane & 3) << 3) | (((lane >> 2) & 3) << 6) | (((lane >> 4) & 1) << 5) | (((lane >> 5) & 1) << 8); }
template <int NCB> constexpr int v_rd_off(int d0, int ks, int half) { return d0 * 512 + ks * (NCB * 1024) + half * (NCB * 512); }
template <int OFF> __device__ __forceinline__ s16x4 tr_read(int vb) { s16x4 r; asm volatile("ds_read_b64_tr_b16 %0, %1 offset:%2" : "=&v"(r) : "v"(vb), "i"(OFF) : "memory"); return r; }
template <int NCB, int D0> __device__ __forceinline__ void pv_one(f32x16& od, int vb, bf16x8 pa0, bf16x8 pa1, bf16x8 pa2, bf16x8 pa3) {
    const s16x4 l0 = tr_read<v_rd_off<NCB>(D0, 0, 0)>(vb), h0 = tr_read<v_rd_off<NCB>(D0, 0, 1)>(vb), l1 = tr_read<v_rd_off<NCB>(D0, 1, 0)>(vb), h1 = tr_read<v_rd_off<NCB>(D0, 1, 1)>(vb);
    const s16x4 l2 = tr_read<v_rd_off<NCB>(D0, 2, 0)>(vb), h2 = tr_read<v_rd_off<NCB>(D0, 2, 1)>(vb), l3 = tr_read<v_rd_off<NCB>(D0, 3, 0)>(vb), h3 = tr_read<v_rd_off<NCB>(D0, 3, 1)>(vb);
    asm volatile("s_waitcnt lgkmcnt(0)" ::: "memory"); SBAR();
#define PK(L, H) (bf16x8){L[0], L[1], L[2], L[3], H[0], H[1], H[2], H[3]}
    od = __builtin_amdgcn_mfma_f32_32x32x16_bf16(pa0, PK(l0, h0), od, 0, 0, 0);
    od = __builtin_amdgcn_mfma_f32_32x32x16_bf16(pa1, PK(l1, h1), od, 0, 0, 0);
    od = __builtin_amdgcn_mfma_f32_32x32x16_bf16(pa2, PK(l2, h2), od, 0, 0, 0);
    od = __builtin_amdgcn_mfma_f32_32x32x16_bf16(pa3, PK(l3, h3), od, 0, 0, 0);
#undef PK
}

constexpr int D_V = 0, D_K = 49152, D_WS = 81920, D_TB = 83968, D_ST = 86016, D_END = D_ST + 65536;
constexpr int NT = SEQ / 64;

typedef short v4i16_t __attribute__((ext_vector_type(4)));
__device__ __forceinline__ s16x4 vtr(const LAS char* p) { return __builtin_bit_cast(s16x4, __builtin_amdgcn_ds_read_tr16_b64_v4i16((LAS v4i16_t*)p)); }
#define PIN(x) asm volatile("" : "+v"(x))
#define MX3(a, b, c) __builtin_fmaxf(__builtin_fmaxf((a), (b)), (c))
#define EX(v) __builtin_amdgcn_exp2f(v)
#define MFMA32(a, b, c) __builtin_amdgcn_mfma_f32_32x32x16_bf16((a), (b), (c), 0, 0, 0)
constexpr float THRL = 6.0f;
__device__ __forceinline__ float rowmax32(const f32x16& C0, const f32x16& C1) {
    float a = MX3(C0[0], C0[1], C1[0]), b = MX3(C0[2], C0[3], C1[1]); a = MX3(a, C1[2], C1[3]);
#pragma unroll
    for (int r = 4; r < 16; r += 4) { a = MX3(a, C0[r], C0[r + 1]); b = MX3(b, C0[r + 2], C0[r + 3]); a = MX3(a, C1[r], C1[r + 1]); b = MX3(b, C1[r + 2], C1[r + 3]); }
    float rm = __builtin_fmaxf(a, b);
    auto rr = __builtin_amdgcn_permlane32_swap(__float_as_uint(rm), __float_as_uint(rm), false, false);
    return __builtin_fmaxf(__uint_as_float(rr[0]), __uint_as_float(rr[1]));
}
__device__ __forceinline__ void diff_pass(f32x16 (&o)[4], float& l_out, const bf16_t* Qw, const bf16_t* __restrict__ Kh, const bf16_t* __restrict__ Vh,
                                          LAS char* lds, int qa, float cL, float cR) {
    const int tid = threadIdx.x, wid = __builtin_amdgcn_readfirstlane(tid >> 6), lane = tid & 63, r32 = lane & 31, hi = lane >> 5;
    LAS char* V_lds = lds + D_V; LAS char* K_lds = lds + D_K;
    LAS float* wsf = (LAS float*)(lds + D_WS) + wid * 64 + 32;
    const LAS float* tb = (const LAS float*)(lds + D_TB);
#pragma unroll
    for (int d = 0; d < 4; ++d) o[d] = f32x16{};
    bf16x8 qr[4];
#pragma unroll
    for (int d0 = 0; d0 < 4; ++d0) qr[d0] = *(const bf16x8*)(Qw + d0 * 16);
#pragma unroll
    for (int d0 = 0; d0 < 4; ++d0) PIN(qr[d0]);
    const bf16_t* ksrc; const bf16_t* vsrc0;
    { const int row = wid * 8 + (lane >> 3), pos = lane & 7;
      ksrc = Kh + (long)row * PITCH + ((pos ^ ((row >> 1) & 7)) * 8);
      vsrc0 = Vh + (long)row * PITCH + ((pos ^ (((row >> 1) & 1) << 2)) * 8); }
    const LAS char* kq[4];
    { const int sw = (r32 >> 1) & 7;
#pragma unroll
      for (int d0 = 0; d0 < 4; ++d0) kq[d0] = K_lds + r32 * 128 + (((2 * d0 + hi) ^ sw) << 4); }
    const LAS char* vpe; const LAS char* vpo;
    { const int q = (lane & 15) >> 2, p = lane & 3, g = (lane >> 4) & 1, sw = (q >> 1) & 1;
      vpe = V_lds + (4 * hi + q) * 128 + sw * 64 + g * 32 + p * 8; vpo = V_lds + (4 * hi + q) * 128 + (sw ^ 1) * 64 + g * 32 + p * 8; }
#define DMA_K(j, ko) __builtin_amdgcn_global_load_lds((const unsigned*)(ksrc + (long)(j) * 64 * PITCH), (LAS unsigned*)(K_lds + (ko) + wid * 1024), 16, 0, 0)
#define DMA_V(j, vo) do { __builtin_amdgcn_global_load_lds((const unsigned*)(vsrc0 + (long)(j) * 64 * PITCH), (LAS unsigned*)(V_lds + (vo) + wid * 1024), 16, 0, 0); \
    __builtin_amdgcn_global_load_lds((const unsigned*)(vsrc0 + 64 + (long)(j) * 64 * PITCH), (LAS unsigned*)(V_lds + (vo) + 8192 + wid * 1024), 16, 0, 0); } while (0)
#define WAIT_BAR(N) do { asm volatile("s_waitcnt vmcnt(" #N ") lgkmcnt(0)" ::: "memory"); __builtin_amdgcn_s_barrier(); asm volatile("" ::: "memory"); } while (0)
    float mhat, l_reg = 0.f; bool resc = false;
    f32x16 pA0, pA1, pB0, pB1;
    bf16x8 kf[4]; s16x4 vlo[6], vhi[6]; u32x4 pw0, pw1, pw2, pw3;
#define KRD(i, KS) do { kf[(i) & 3] = *(const LAS bf16x8*)(kq[(i) >> 1] + (KS) + ((i) & 1) * 4096); } while (0)
    WAIT_BAR(0);
    DMA_K(0, 0); DMA_K(1, 8192); DMA_V(0, 0); DMA_K(2, 16384); DMA_K(3, 24576); DMA_V(1, 16384);
    WAIT_BAR(7);
    {
        float off0 = 0.f; const int d_ = -qa;
        if (d_ <= -154) { pA0 = f32x16{}; pA1 = f32x16{}; off0 = cL; }
        else { const LAS float* t_ = tb + (d_ + 256 + 4 * hi - r32);
#pragma unroll
            for (int r = 0; r < 16; ++r) { pA0[r] = t_[(r & 3) + 8 * (r >> 2)]; pA1[r] = t_[32 + (r & 3) + 8 * (r >> 2)]; } }
#pragma unroll
        for (int d0 = 0; d0 < 4; ++d0) { const bf16x8 k0_ = *(const LAS bf16x8*)(kq[d0]), k1_ = *(const LAS bf16x8*)(kq[d0] + 4096);
            pA0 = MFMA32(k0_, qr[d0], pA0); pA1 = MFMA32(k1_, qr[d0], pA1); }
        const float rm = rowmax32(pA0, pA1);
        mhat = rm + off0;
#pragma unroll
        for (int r = 0; r < 16; ++r) { pA0[r] = EX(pA0[r] - rm); pA1[r] = EX(pA1[r] - rm); }
    }
    WAIT_BAR(3);
    KRD(0, 8192); KRD(1, 8192); KRD(2, 8192); KRD(3, 8192);
#define PKW(P, B) cvtpk(P[B], P[(B) + 1])
#define PAF(k) __builtin_bit_cast(bf16x8, pw##k)
#define VFR(i) (bf16x8){vlo[(i) % 6][0], vlo[(i) % 6][1], vlo[(i) % 6][2], vlo[(i) % 6][3], vhi[(i) % 6][0], vhi[(i) % 6][1], vhi[(i) % 6][2], vhi[(i) % 6][3]}
#define VRD(i, VS) do { const LAS char* vq_ = ((((i) & 3) & 1) ? vpo : vpe) + (VS) + (((i) & 3) >> 1) * 8192 + ((i) >> 2) * 2048; vlo[(i) % 6] = vtr(vq_); vhi[(i) % 6] = vtr(vq_ + 1024); } while (0)
#define GAPA(g, CC, QI, KB, A0, A1, A2, A3, W0, W1, PW) do { CC = MFMA32(kf[(g) & 3], qr[QI], CC); if ((g) + 4 < 8) KRD((g) + 4, KB); sacc += A0; sacc += A1; sacc += A2; sacc += A3; PIN(sacc); W0; W1; PIN(PW); SBAR(); } while (0)
#define GAPB(i, X, B, VB, KN, PRE) do { o[(i) & 3] = MFMA32(PAF_SEL(i), VFR(i), o[(i) & 3]); X[B] = EX(X[B]); X[(B) + 1] = EX(X[(B) + 1]); PIN(X); if ((i) + 5 < 16) VRD((i) + 5, VB); \
    if ((PRE) && (i) >= 8 && (i) < 12) KRD((i) - 8, KN); SBAR(); } while (0)
#define PAF_SEL(i) (((i) >> 2) == 0 ? PAF(0) : ((i) >> 2) == 1 ? PAF(1) : ((i) >> 2) == 2 ? PAF(2) : PAF(3))
#define STEP(C0, C1, P0, P1, t, KB, VB, KN, PRE) do { SBAR(); \
    { const int d_ = (t) * 64 - qa; \
      if (d_ > -154 && d_ < 122) { const LAS float* t_ = tb + (d_ + 256 + 4 * hi - r32); \
        _Pragma("unroll") for (int r = 0; r < 16; ++r) { C0[r] = t_[(r & 3) + 8 * (r >> 2)] - mhat; C1[r] = t_[32 + (r & 3) + 8 * (r >> 2)] - mhat; } } \
      else { const float cs_ = (d_ < 0 ? cL : cR) - mhat; _Pragma("unroll") for (int r = 0; r < 16; ++r) { C0[r] = cs_; C1[r] = cs_; } } } \
    PIN(C0); PIN(C1); SBAR(); \
    float sacc = (P0[0] + P0[1]); \
    GAPA(0, C0, 0, KB, P0[2],  P0[3],  P0[4],  P0[5],  pw0[0] = PKW(P0, 0),  pw0[1] = PKW(P0, 2),  pw0); \
    GAPA(1, C1, 0, KB, P0[6],  P0[7],  P0[8],  P0[9],  pw0[2] = PKW(P0, 4),  pw0[3] = PKW(P0, 6),  pw0); \
    GAPA(2, C0, 1, KB, P0[10], P0[11], P0[12], P0[13], pw1[0] = PKW(P0, 8),  pw1[1] = PKW(P0, 10), pw1); \
    GAPA(3, C1, 1, KB, P0[14], P0[15], P1[0],  P1[1],  pw1[2] = PKW(P0, 12), pw1[3] = PKW(P0, 14), pw1); \
    GAPA(4, C0, 2, KB, P1[2],  P1[3],  P1[4],  P1[5],  pw2[0] = PKW(P1, 0),  pw2[1] = PKW(P1, 2),  pw2); \
    GAPA(5, C1, 2, KB, P1[6],  P1[7],  P1[8],  P1[9],  pw2[2] = PKW(P1, 4),  pw2[3] = PKW(P1, 6),  pw2); \
    GAPA(6, C0, 3, KB, P1[10], P1[11], P1[12], P1[13], pw3[0] = PKW(P1, 8),  pw3[1] = PKW(P1, 10), pw3); \
    GAPA(7, C1, 3, KB, P1[14], P1[15], 0.f,    0.f,    pw3[2] = PKW(P1, 12), pw3[3] = PKW(P1, 14), pw3); \
    l_reg += sacc; \
    VRD(0, VB); VRD(1, VB); VRD(2, VB); VRD(3, VB); VRD(4, VB); \
    { const float rm = rowmax32(C0, C1); resc = false; \
      if (__builtin_expect(__any(rm > THRL), 0)) { const float dl = __builtin_fmaxf(rm, 0.f); mhat += dl; \
        _Pragma("unroll") for (int r = 0; r < 16; ++r) { C0[r] -= dl; C1[r] -= dl; } \
        const float f = EX(-dl); l_reg *= f; if (hi == 0) wsf[r32] = f; resc = true; } } \
    SBAR(); \
    GAPB(0, C0, 0, VB, KN, PRE);  GAPB(1, C0, 2, VB, KN, PRE);  GAPB(2, C0, 4, VB, KN, PRE);   GAPB(3, C0, 6, VB, KN, PRE); \
    GAPB(4, C0, 8, VB, KN, PRE);  GAPB(5, C0, 10, VB, KN, PRE); GAPB(6, C0, 12, VB, KN, PRE);  GAPB(7, C0, 14, VB, KN, PRE); \
    GAPB(8, C1, 0, VB, KN, PRE);  GAPB(9, C1, 2, VB, KN, PRE);  GAPB(10, C1, 4, VB, KN, PRE);  GAPB(11, C1, 6, VB, KN, PRE); \
    GAPB(12, C1, 8, VB, KN, PRE); GAPB(13, C1, 10, VB, KN, PRE); GAPB(14, C1, 12, VB, KN, PRE); GAPB(15, C1, 14, VB, KN, PRE); \
    } while (0)
#define RESC() do { if (resc) { asm volatile("s_waitcnt lgkmcnt(0)" ::: "memory"); \
    _Pragma("unroll") for (int d = 0; d < 4; ++d) _Pragma("unroll") for (int r = 0; r < 16; ++r) o[d][r] *= wsf[crow(r, hi)]; } } while (0)
    int ks_cur = 8192, ks_n1 = 16384, ks_n3 = 0;
    int vs_prev = 0, vs_next = 32768;
#define ROT() do { ks_cur = (ks_cur + 8192) & 24576; ks_n1 = (ks_n1 + 8192) & 24576; ks_n3 = (ks_n3 + 8192) & 24576; vs_prev = vs_prev == 32768 ? 0 : vs_prev + 16384; vs_next = vs_next == 32768 ? 0 : vs_next + 16384; } while (0)
#define STEPX(C0, C1, P0, P1, t, PRE) STEP(C0, C1, P0, P1, t, ks_cur, vs_prev, ks_n1, PRE)
#pragma unroll 1
    for (int t = 1; t + 4 < NT; t += 2) {
        DMA_K(t + 3, ks_n3); DMA_V(t + 1, vs_next);
        STEPX(pB0, pB1, pA0, pA1, t, true);
        WAIT_BAR(3); RESC(); ROT();
        DMA_K(t + 4, ks_n3); DMA_V(t + 2, vs_next);
        STEPX(pA0, pA1, pB0, pB1, t + 1, true);
        WAIT_BAR(3); RESC(); ROT();
    }
    DMA_V(NT - 2, vs_next);
    STEPX(pB0, pB1, pA0, pA1, NT - 3, true);
    WAIT_BAR(2); RESC(); ROT();
    DMA_V(NT - 1, vs_next);
    STEPX(pA0, pA1, pB0, pB1, NT - 2, true);
    WAIT_BAR(2); RESC(); ROT();
    STEPX(pB0, pB1, pA0, pA1, NT - 1, false);
    WAIT_BAR(0); RESC(); ROT();
    { float sacc = 0.f;
#pragma unroll
      for (int r = 0; r < 16; ++r) sacc += pB0[r];
#pragma unroll
      for (int r = 0; r < 16; ++r) sacc += pB1[r];
      l_reg += sacc;
      pw0 = (u32x4){PKW(pB0, 0), PKW(pB0, 2), PKW(pB0, 4), PKW(pB0, 6)}; pw1 = (u32x4){PKW(pB0, 8), PKW(pB0, 10), PKW(pB0, 12), PKW(pB0, 14)};
      pw2 = (u32x4){PKW(pB1, 0), PKW(pB1, 2), PKW(pB1, 4), PKW(pB1, 6)}; pw3 = (u32x4){PKW(pB1, 8), PKW(pB1, 10), PKW(pB1, 12), PKW(pB1, 14)};
      SBAR();
#define DRAIN(i) do { VRD(i, vs_prev); o[(i) & 3] = MFMA32(PAF_SEL(i), VFR(i), o[(i) & 3]); } while (0)
      DRAIN(0); DRAIN(1); DRAIN(2); DRAIN(3); DRAIN(4); DRAIN(5); DRAIN(6); DRAIN(7); DRAIN(8); DRAIN(9); DRAIN(10); DRAIN(11); DRAIN(12); DRAIN(13); DRAIN(14); DRAIN(15);
#undef DRAIN
    }
    { auto rr = __builtin_amdgcn_permlane32_swap(__float_as_uint(l_reg), __float_as_uint(l_reg), false, false); l_out = __uint_as_float(rr[0]) + __uint_as_float(rr[1]); }
#undef DMA_K
#undef DMA_V
#undef WAIT_BAR
#undef ROT
#undef KRD
#undef PKW
#undef PAF
#undef VFR
#undef VRD
#undef GAPA
#undef GAPB
#undef PAF_SEL
#undef STEP
#undef STEPX
#undef RESC
}

__device__ __forceinline__ void diff_unit(int b, int h, int qb, const bf16_t* P, bf16_t* O, LAS char* lds, float lam, const float* relb) {
    const int tid = threadIdx.x, wid = __builtin_amdgcn_readfirstlane(tid >> 6), lane = tid & 63, r32 = lane & 31, hi = lane >> 5;
    const long rowbase = (long)b * SEQ; const int q0 = qb * 256, qa = q0 + wid * 32;
    LAS float* tb = (LAS float*)(lds + D_TB);
    LAS float* li_l = (LAS float*)(lds + D_WS) + wid * 64;
    tb[tid] = relb[rel_bucket(tid - 256) * NBH + h] * LOG2E;
    const float cL = relb[15 * NBH + h] * LOG2E, cR = relb[31 * NBH + h] * LOG2E;
    const bf16_t* Qrow = P + (rowbase + qa + r32) * PITCH + C_DQ + h * 128 + hi * 8;
    const bf16_t* Kh = P + rowbase * PITCH + C_DK + h * 128;
    const bf16_t* Vh = P + rowbase * PITCH + C_DV + h * 128;
    LAS u32x4* stash = (LAS u32x4*)(lds + D_ST + wid * 8192);
    f32x16 o[4]; float l_reg;
#pragma unroll 1
    for (int pass = 0; pass < 2; ++pass) {
        const int mo = pass == 0 ? 64 : 0;
        diff_pass(o, l_reg, Qrow + mo, Kh + mo, Vh, lds, qa, cL, cR);
        int ln = lane; asm volatile("" : "+v"(ln));
        const int r32e = ln & 31, hie = ln >> 5;
        if (hie == 0) li_l[r32e] = l_reg; asm volatile("s_waitcnt lgkmcnt(0)" ::: "memory");
        if (pass == 0) {
            float rli[16];
#pragma unroll
            for (int r = 0; r < 16; ++r) rli[r] = -lam * __builtin_amdgcn_rcpf(li_l[crow(r, hie)]);
#pragma unroll
            for (int d0 = 0; d0 < 4; ++d0) {
                u32x4 w0, w1;
                w0.x = cvtpk(o[d0][0] * rli[0], o[d0][1] * rli[1]); w0.y = cvtpk(o[d0][2] * rli[2], o[d0][3] * rli[3]); w0.z = cvtpk(o[d0][4] * rli[4], o[d0][5] * rli[5]); w0.w = cvtpk(o[d0][6] * rli[6], o[d0][7] * rli[7]);
                w1.x = cvtpk(o[d0][8] * rli[8], o[d0][9] * rli[9]); w1.y = cvtpk(o[d0][10] * rli[10], o[d0][11] * rli[11]); w1.z = cvtpk(o[d0][12] * rli[12], o[d0][13] * rli[13]); w1.w = cvtpk(o[d0][14] * rli[14], o[d0][15] * rli[15]);
                stash[(2 * d0) * 64 + ln] = w0; stash[(2 * d0 + 1) * 64 + ln] = w1;
            }
        } else {
            float rli[16], ssq[16];
#pragma unroll
            for (int r = 0; r < 16; ++r) { rli[r] = __builtin_amdgcn_rcpf(li_l[crow(r, hie)]); ssq[r] = 0.f; }
#pragma unroll
            for (int d0 = 0; d0 < 4; ++d0) {
                const u32x4 w0 = stash[(2 * d0) * 64 + ln], w1 = stash[(2 * d0 + 1) * 64 + ln];
                const unsigned ww[8] = {w0.x, w0.y, w0.z, w0.w, w1.x, w1.y, w1.z, w1.w};
#pragma unroll
                for (int r = 0; r < 16; ++r) { const float c = __uint_as_float((r & 1) ? (ww[r >> 1] & 0xffff0000u) : (ww[r >> 1] << 16));
                    const float x = fmaf(o[d0][r], rli[r], c); o[d0][r] = x; ssq[r] = fmaf(x, x, ssq[r]); }
            }
            asm volatile("s_waitcnt lgkmcnt(0)" ::: "memory");
#pragma unroll
            for (int r = 0; r < 16; ++r) { float s = ssq[r];
                s += __shfl_xor(s, 1); s += __shfl_xor(s, 2); s += __shfl_xor(s, 4); s += __shfl_xor(s, 8); s += __shfl_xor(s, 16);
                ssq[r] = __builtin_amdgcn_rsqf(s * (1.0f / 128.0f) + EPS); }
            LAS bf16_t* stg = (LAS bf16_t*)(lds + D_ST + wid * 8192);
#pragma unroll
            for (int r = 0; r < 16; ++r) { const int orow = crow(r, hie);
#pragma unroll
                for (int d0 = 0; d0 < 4; ++d0) stg[orow * 128 + d0 * 32 + r32e] = (bf16_t)(cvtpk(o[d0][r] * ssq[r], 0.f) & 0xffffu); }
            asm volatile("s_waitcnt lgkmcnt(0)" ::: "memory");
            bf16_t* Ow = O + (rowbase + qa + (ln >> 4)) * DM + h * 128 + (ln & 15) * 8;
            const LAS bf16_t* sl = stg + (ln >> 4) * 128 + (ln & 15) * 8;
#pragma unroll
            for (int i = 0; i < 8; ++i) { const u32x4 v = *(const LAS u32x4*)(sl + i * 512); *(u32x4*)(Ow + (long)i * 4 * DM) = v; }
        }
    }
    asm volatile("s_waitcnt lgkmcnt(0)" ::: "memory"); __syncthreads();
}

constexpr int W_K = 0, W_V = 49152, W_TB = 98304, W_WS = 106496, W_OST = 108544, W_END = W_OST + 32768;
__device__ __forceinline__ void win_unit(int b, int kvh, int qb, const bf16_t* P, bf16_t* O, LAS char* lds, const float* relb, const float* sink) {
    const int tid = threadIdx.x, wid = __builtin_amdgcn_readfirstlane(tid >> 6), lane = tid & 63, r32 = lane & 31, hi = lane >> 5;
    const long rowbase = (long)b * SEQ; const int q0 = qb * 128, kbase = q0 - 128;
    LAS float* tbw = (LAS float*)(lds + W_TB);
#pragma unroll
    for (int e = 0; e < 4; ++e) { const int idx = tid + e * 512, g = idx >> 9, rel = (idx & 511) - 256;
        tbw[idx] = (rel >= -128 && rel <= 128) ? (relb[rel_bucket(rel) * NBH + 4 + 4 * kvh + g] - sink[4 * kvh + g]) * LOG2E : -1e30f; }
    { int tl = tid; asm volatile("" : "+v"(tl));
      const int kr = tl >> 3, kc = (tl & 7) * 8, kst = KSW(kr, kc * 2), vst = v_st<2>(kr, kc);
      const bf16_t* Kh = P + rowbase * PITCH + C_WK + kvh * 64; const bf16_t* Vh = P + rowbase * PITCH + C_WV + kvh * 64;
      bf16x8 kreg[6], vreg[6];
#pragma unroll
      for (int t = 0; t < 6; ++t) { const int k0 = kbase + 64 * t; if (k0 >= 0 && k0 < SEQ) { kreg[t] = *(const bf16x8*)(&Kh[(long)(k0 + kr) * PITCH + kc]); vreg[t] = *(const bf16x8*)(&Vh[(long)(k0 + kr) * PITCH + kc]); } }
#pragma unroll
      for (int t = 0; t < 6; ++t) { const int k0 = kbase + 64 * t; if (k0 >= 0 && k0 < SEQ) { *(LAS bf16x8*)(lds + W_K + t * 8192 + kst) = kreg[t]; *(LAS bf16x8*)(lds + W_V + t * 8192 + vst) = vreg[t]; } }
    }
    __syncthreads();
    const int g = wid >> 1, hq = 4 * kvh + g;
    LAS float* li_l = (LAS float*)(lds + W_WS) + wid * 64;
    const LAS float* tbg = tbw + g * 512;
    const int vbw = (int)(uintptr_t)(lds + W_V) + v_rd_base(lane);
#pragma unroll 1
    for (int jb = 0; jb < 2; ++jb) {
        const int ql = 64 * (wid & 1) + 32 * jb;
        const bf16_t* Qw = P + (rowbase + q0 + ql + r32) * PITCH + C_WQ + hq * 64 + hi * 8;
        bf16x8 qr[4];
#pragma unroll
        for (int d0 = 0; d0 < 4; ++d0) qr[d0] = *(const bf16x8*)(Qw + d0 * 16);
        float l_reg = 0.f;
        f32x16 o[2]; o[0] = f32x16{}; o[1] = f32x16{};
        const int t_lo = ql >> 6;
#pragma unroll 1
        for (int t = t_lo; t < t_lo + 5; ++t) {
            const int k0 = kbase + 64 * t; if (k0 < 0 || k0 >= SEQ) continue;
            const int d_ = 64 * t - 128 - ql;
            const LAS float* t_ = tbg + (d_ + 256 + 4 * hi - r32);
            f32x16 p0, p1;
#pragma unroll
            for (int r = 0; r < 16; ++r) { p0[r] = t_[(r & 3) + 8 * (r >> 2)]; p1[r] = t_[32 + (r & 3) + 8 * (r >> 2)]; }
            qkt64(p0, p1, lds + W_K + t * 8192, qr, r32, hi);
#pragma unroll
            for (int r = 0; r < 16; ++r) { p0[r] = __builtin_amdgcn_exp2f(p0[r]); p1[r] = __builtin_amdgcn_exp2f(p1[r]); }
            bf16x8 pa0, pa1, pa2, pa3;
            {
                float ps = 0;
#pragma unroll
                for (int r = 0; r < 16; ++r) ps += p0[r];
#pragma unroll
                for (int r = 0; r < 16; ++r) ps += p1[r];
                l_reg += ps;
#define PK4(Pv, BASE, OUT) do { unsigned a0 = cvtpk(Pv[BASE + 0], Pv[BASE + 1]), a1 = cvtpk(Pv[BASE + 2], Pv[BASE + 3]);   \
    unsigned b0 = cvtpk(Pv[BASE + 4], Pv[BASE + 5]), b1 = cvtpk(Pv[BASE + 6], Pv[BASE + 7]);                              \
    auto r0 = __builtin_amdgcn_permlane32_swap(a0, b0, false, false); auto r1 = __builtin_amdgcn_permlane32_swap(a1, b1, false, false); \
    u32x4 w = {r0[0], r1[0], r0[1], r1[1]}; OUT = __builtin_bit_cast(bf16x8, w); } while (0)
                PK4(p0, 0, pa0); PK4(p0, 8, pa1); PK4(p1, 0, pa2); PK4(p1, 8, pa3);
#undef PK4
            }
            const int vb = vbw + t * 8192;
            pv_one<2, 0>(o[0], vb, pa0, pa1, pa2, pa3); pv_one<2, 1>(o[1], vb, pa0, pa1, pa2, pa3);
        }
        { auto rr = __builtin_amdgcn_permlane32_swap(__float_as_uint(l_reg), __float_as_uint(l_reg), false, false); l_reg = 1.0f + __uint_as_float(rr[0]) + __uint_as_float(rr[1]); }
        int ln = lane; asm volatile("" : "+v"(ln));
        const int r32e = ln & 31, hie = ln >> 5;
        if (hie == 0) li_l[r32e] = l_reg; asm volatile("s_waitcnt lgkmcnt(0)" ::: "memory");
        float rli[16];
#pragma unroll
        for (int r = 0; r < 16; ++r) rli[r] = __builtin_amdgcn_rcpf(li_l[crow(r, hie)]);
        LAS bf16_t* stg = (LAS bf16_t*)(lds + W_OST + wid * 4096);
#pragma unroll
        for (int r = 0; r < 16; ++r) { const int orow = crow(r, hie);
#pragma unroll
            for (int d0 = 0; d0 < 2; ++d0) stg[orow * 64 + d0 * 32 + r32e] = (bf16_t)(cvtpk(o[d0][r] * rli[r], 0.f) & 0xffffu); }
        asm volatile("s_waitcnt lgkmcnt(0)" ::: "memory");
        bf16_t* Ow = O + (rowbase + q0 + ql + (ln >> 3)) * DM + 512 + hq * 64 + (ln & 7) * 8;
        const LAS bf16_t* sl = stg + (ln >> 3) * 64 + (ln & 7) * 8;
#pragma unroll
        for (int i = 0; i < 4; ++i) { const u32x4 v = *(const LAS u32x4*)(sl + i * 512); *(u32x4*)(Ow + (long)i * 8 * DM) = v; }
        asm volatile("s_waitcnt lgkmcnt(0)" ::: "memory");
    }
    asm volatile("s_waitcnt lgkmcnt(0)" ::: "memory"); __syncthreads();
}
#undef SBAR
#undef KSW
}

constexpr size_t MiB = 1u << 20;
constexpr size_t WS_CTL = 0, CTL_ZERO_BYTES = 64 * 1024;
constexpr size_t WS_W1 = 1 * MiB;
constexpr size_t WS_W2 = WS_W1 + (size_t)DIN * DM * 2;
constexpr size_t WS_W3 = WS_W2 + (size_t)DM * DM * 2;
constexpr size_t WS_W4 = WS_W3 + (size_t)2 * DFF * DM * 2;
constexpr size_t WS_XS = 24 * MiB;
constexpr int CW_P3CNT = 4480;
constexpr size_t WS_FA = 26 * MiB;
constexpr size_t WS_FX = 26 * MiB + 512 * 1024;
constexpr int CW_WMAX1 = 13824, CW_W1CNT = 16200;
constexpr int CW_WMAX = 8192;
constexpr size_t WS_PROJ = 28 * MiB;
constexpr size_t WS_OB = 244 * MiB;
constexpr size_t WS_XQ = 340 * MiB;
constexpr size_t WS_X1Q = 340 * MiB;
constexpr size_t WS_X1B = 388 * MiB;
constexpr size_t WS_ACT = 28 * MiB;
constexpr size_t WS_END = WS_X1B + (size_t)NTOK * DM * 2;
static_assert(WS_W4 + (size_t)DM * DFF * 2 <= WS_XS && WS_XS + (size_t)NTOK * 32 <= WS_FA && WS_FA + (size_t)NTOK * 4 <= WS_FX && WS_FX + (size_t)NTOK * 4 <= WS_PROJ, "d_ws map");
static_assert(WS_PROJ + (size_t)NTOK * DIN * 2 <= WS_OB && WS_OB + (size_t)NTOK * DM * 2 <= WS_XQ && WS_XQ + (size_t)NTOK * DM <= WS_X1B && WS_ACT + (size_t)NTOK * DFF * 2 <= WS_X1Q - 4096, "d_ws map");
static_assert(CW_WMAX + 2 * DFF <= CW_WMAX1 && CW_WMAX1 + DIN <= CW_W1CNT && CW_W1CNT * 4 < CTL_ZERO_BYTES && 1024 + 3456 <= CW_P3CNT && CW_P3CNT + 192 <= CW_WMAX, "d_ws map");
constexpr int CW_BAR = 1024, XCD_BAR_WORDS_C = 3456;

constexpr int RING_BYTES = 131072, EPX_OFF = RING_BYTES, LDS_BYTES = 163840, MISC_OFF = LDS_BYTES - 512;
static_assert(att::D_END <= MISC_OFF && att::W_END <= MISC_OFF && EPX_OFF + 22528 <= MISC_OFF, "LDS map");

typedef GAS unsigned gu32;
#define RLX_AGENT __ATOMIC_RELAXED, __HIP_MEMORY_SCOPE_AGENT
#define LDS_WAIT() asm volatile("s_waitcnt lgkmcnt(0)" ::: "memory")

#define XB_TMO      128
#define XB_XCNT(j)  (256  + 64 * (j))
#define XB_XSUB(j)  (1280 + 64 * (j))
#define XB_XGEN(j)  (2304 + 64 * (j))
#define XB_TOP      3328
#define XB_TOPGEN   3392
#define XCD_BAR_WORDS 3456
#define XB_SPIN_CAP (1u << 22)
__device__ __forceinline__ unsigned xb_ld(unsigned* p)              { return __hip_atomic_load(p, __ATOMIC_RELAXED, __HIP_MEMORY_SCOPE_AGENT); }
__device__ __forceinline__ unsigned xb_add(unsigned* p, unsigned v) { return __hip_atomic_fetch_add(p, v, __ATOMIC_RELAXED, __HIP_MEMORY_SCOPE_AGENT); }
__device__ __forceinline__ unsigned xb_xcc_id() { return (unsigned)__builtin_amdgcn_s_getreg((3 << 11) | 20) & 0xFu; }
#define XB_SPIN(cond, bar) do { unsigned _sp = 0; while (cond) { __builtin_amdgcn_s_sleep(1); \
    if ((++_sp & 255u) == 0u) { if (xb_ld(&(bar)[XB_TMO])) break; if (_sp > XB_SPIN_CAP) { atomicAdd(&(bar)[XB_TMO], 1u); break; } } } } while (0)
struct XcdBarrier { unsigned* bar; unsigned x; volatile LAS unsigned* st; };
__device__ __forceinline__ XcdBarrier xcd_barrier_post(unsigned* bar, volatile LAS unsigned* st) {
    XcdBarrier b; b.bar = bar; b.x = xb_xcc_id(); b.st = st;
    if (threadIdx.x == 0) (void)xb_add(&bar[XB_XCNT(b.x)], 1u);
    return b;
}
__device__ __forceinline__ void xcd_barrier_complete(unsigned* bar, unsigned x, unsigned& nloc, unsigned& nx) {
    const unsigned G = gridDim.x * gridDim.y * gridDim.z;
    unsigned sum, cnt, mine, sp = 0u;
    for (;;) {
        sum = 0u; cnt = 0u; mine = 0u;
#pragma unroll
        for (unsigned j = 0; j < 16; ++j) { const unsigned c = xb_ld(&bar[XB_XCNT(j)]); sum += c; cnt += (c > 0u) ? 1u : 0u; mine = (j == x) ? c : mine; }
        if (sum == G) break;
        __builtin_amdgcn_s_sleep(1);
        if ((++sp & 255u) == 0u) { if (xb_ld(&bar[XB_TMO])) break; if (sp > XB_SPIN_CAP) { atomicAdd(&bar[XB_TMO], 1u); break; } }
    }
    nloc = mine > 0u ? mine : 1u; nx = cnt > 0u ? cnt : 1u;
}
__device__ __forceinline__ void xcd_barrier(const XcdBarrier& b) {
    asm volatile("s_waitcnt vmcnt(0)" ::: "memory");
    __syncthreads();
    if (threadIdx.x == 0) {
        unsigned* bar = b.bar;
        __builtin_amdgcn_s_waitcnt(0);
        unsigned nloc = b.st[0], nx = b.st[1];
        if (nloc == 0u) { xcd_barrier_complete(bar, b.x, nloc, nx); b.st[0] = nloc; b.st[1] = nx; }
        const unsigned old = xb_add(&bar[XB_XSUB(b.x)], 1u);
        const unsigned gen = old / nloc;
        if (old + 1u == (gen + 1u) * nloc) {
            __builtin_amdgcn_fence(__ATOMIC_RELEASE, "agent");
            asm volatile("s_waitcnt vmcnt(0)" ::: "memory");
            const unsigned og = xb_add(&bar[XB_TOP], 1u);
            const unsigned tg = og / nx;
            if (og + 1u == (tg + 1u) * nx) xb_add(&bar[XB_TOPGEN], 1u);
            else XB_SPIN(xb_ld(&bar[XB_TOPGEN]) == tg, bar);
            __builtin_amdgcn_fence(__ATOMIC_ACQUIRE, "agent");
            xb_add(&bar[XB_XGEN(b.x)], 1u);
            asm volatile("s_waitcnt vmcnt(0)" ::: "memory");
        } else {
            XB_SPIN(xb_ld(&bar[XB_XGEN(b.x)]) == gen, bar);
            __builtin_amdgcn_fence(__ATOMIC_ACQUIRE, "agent");
            asm volatile("s_waitcnt vmcnt(0)" ::: "memory");
        }
    }
    __syncthreads();
}

__device__ __forceinline__ float wave_sum(float v) {
#pragma unroll
    for (int o = 1; o < 64; o <<= 1) v += __shfl_xor(v, o);
    return v;
}
__device__ __forceinline__ unsigned f2bf(float f) { unsigned u = __builtin_bit_cast(unsigned, f); return (u + 0x7fffu + ((u >> 16) & 1u)) >> 16; }
__device__ __forceinline__ unsigned pk2(float lo, float hi) { return f2bf(lo) | (f2bf(hi) << 16); }
__device__ __forceinline__ void transpose_item(const float* W, int ld, int cbase, int K, int k0, bf16_t* WT, int nrow0, const float* fold, int foldmask, float fscale, int foldlim, LAS float* scr, int lane) {
    float wv[32];
#pragma unroll
    for (int i = 0; i < 32; ++i) wv[i] = W[(size_t)(k0 + 2 * i + (lane >> 5)) * ld + cbase + (lane & 31)];
#pragma unroll
    for (int i = 0; i < 32; ++i) { const int kk = 2 * i + (lane >> 5), k = k0 + kk;
        float f = 1.f; if (fold != nullptr && k < foldlim) f = fold[k & foldmask] * fscale;
        scr[kk * 33 + (lane & 31)] = wv[i] * f; }
    LDS_WAIT(); asm volatile("" ::: "memory");
    const int c = lane & 7;
#pragma unroll
    for (int j = 0; j < 4; ++j) { const int n = (lane >> 3) + 8 * j; const LAS float* s = scr + (8 * c) * 33 + n;
        u32x4 o; o.x = pk2(s[0 * 33], s[1 * 33]); o.y = pk2(s[2 * 33], s[3 * 33]); o.z = pk2(s[4 * 33], s[5 * 33]); o.w = pk2(s[6 * 33], s[7 * 33]);
        *(u32x4*)(WT + (size_t)(nrow0 + n) * K + k0 + 8 * c) = o; }
    LDS_WAIT(); asm volatile("" ::: "memory");
}

__device__ __forceinline__ void absmax_item(const float* W, int ld, int cbase, int k0, unsigned* wmax, const float* fold, int lane) {
    float wv[32];
#pragma unroll
    for (int i = 0; i < 32; ++i) wv[i] = W[(size_t)(k0 + 2 * i + (lane >> 5)) * ld + cbase + (lane & 31)];
    float m = 0.f;
#pragma unroll
    for (int i = 0; i < 32; ++i) m = __builtin_fmaxf(m, __builtin_fabsf(wv[i] * fold[k0 + 2 * i + (lane >> 5)]));
    m = __builtin_fmaxf(m, __shfl_xor(m, 32));
    if (lane < 32) (void)__hip_atomic_fetch_max(wmax + lane, __float_as_uint(m), __ATOMIC_RELAXED, __HIP_MEMORY_SCOPE_AGENT);
}
__device__ __forceinline__ void quant_item(const float* W, int ld, int cbase, int K, int k0, signed char* WQ, int nrow0, const float* fold, const unsigned* wmax, LAS float* scr, int lane) {
    float wv[32];
#pragma unroll
    for (int i = 0; i < 32; ++i) wv[i] = W[(size_t)(k0 + 2 * i + (lane >> 5)) * ld + cbase + (lane & 31)];
    const float am = __uint_as_float(__hip_atomic_load(wmax + (lane & 31), __ATOMIC_RELAXED, __HIP_MEMORY_SCOPE_AGENT)); const float inv = am > 0.f ? 127.0f / am : 0.f;
#pragma unroll
    for (int i = 0; i < 32; ++i) { const int kk = 2 * i + (lane >> 5); scr[kk * 33 + (lane & 31)] = wv[i] * fold[k0 + kk] * inv; }
    LDS_WAIT(); asm volatile("" ::: "memory");
    const int n = lane >> 1, c = lane & 1; const LAS float* sp = scr + (32 * c) * 33 + n;
    u32x4 o0, o1;
    o0.x = q4(sp[0 * 33], sp[1 * 33], sp[2 * 33], sp[3 * 33]);     o0.y = q4(sp[4 * 33], sp[5 * 33], sp[6 * 33], sp[7 * 33]);
    o0.z = q4(sp[8 * 33], sp[9 * 33], sp[10 * 33], sp[11 * 33]);   o0.w = q4(sp[12 * 33], sp[13 * 33], sp[14 * 33], sp[15 * 33]);
    o1.x = q4(sp[16 * 33], sp[17 * 33], sp[18 * 33], sp[19 * 33]); o1.y = q4(sp[20 * 33], sp[21 * 33], sp[22 * 33], sp[23 * 33]);
    o1.z = q4(sp[24 * 33], sp[25 * 33], sp[26 * 33], sp[27 * 33]); o1.w = q4(sp[28 * 33], sp[29 * 33], sp[30 * 33], sp[31 * 33]);
    u32x4* dst = (u32x4*)(WQ + (size_t)(nrow0 + n) * K + k0 + 32 * c);
    dst[0] = o0; dst[1] = o1;
    LDS_WAIT(); asm volatile("" ::: "memory");
}

struct Args { const float* in[22]; float* out; unsigned char* ws; int ph_lo, ph_hi, li, pad; };

__global__ void __launch_bounds__(NWAVES * 64, 2) hymba_fwd(Args args) {
    extern __shared__ __attribute__((aligned(16))) unsigned char lds_raw[];
    LAS unsigned char* lds = (LAS unsigned char*)lds_raw;
    volatile LAS unsigned* MISC = (volatile LAS unsigned*)(lds + MISC_OFF);
    const int tid = threadIdx.x, lane = tid & 63, wave = __builtin_amdgcn_readfirstlane(tid >> 6);
    const int G = gridDim.x; const int bx = blockIdx.x; const int vcu = (G % 8 == 0) ? (bx % 8) * (G / 8) + bx / 8 : bx;
    unsigned char* ws = args.ws;
    unsigned* ctl = (unsigned*)(ws + WS_CTL);
    const float* xp = args.in[0]; const float* xs = args.in[1];
    bf16_t* W1 = (bf16_t*)(ws + WS_W1); bf16_t* W2 = (bf16_t*)(ws + WS_W2); bf16_t* W3 = (bf16_t*)(ws + WS_W3); bf16_t* W4 = (bf16_t*)(ws + WS_W4);
    bf16_t* PROJ = (bf16_t*)(ws + WS_PROJ); bf16_t* X1B = (bf16_t*)(ws + WS_X1B); bf16_t* ACT = (bf16_t*)(ws + WS_ACT);
    bf16_t* OB = (bf16_t*)(ws + WS_OB);
    signed char* XQ = (signed char*)(ws + WS_XQ); float* FX = (float*)(ws + WS_FX); signed char* W1Q = (signed char*)(ws + WS_W1);
    for (int u = tid; u < 128; u += NWAVES * 64) ((LAS unsigned*)(lds + MISC_OFF))[u] = 0u;
    __syncthreads();
    XcdBarrier bar; bar.bar = ctl + CW_BAR + args.li * XCD_BAR_WORDS; bar.x = 0; bar.st = nullptr;
    if (MK_N_LAUNCHES != 6) bar = xcd_barrier_post(ctl + CW_BAR + args.li * XCD_BAR_WORDS, MISC + 8);
    const int lo = args.ph_lo, hi_ph = args.ph_hi;
#ifndef ONLY_PHASE
#define ONLY_PHASE -1
#endif
#define IN(k) ((ONLY_PHASE < 0 || ONLY_PHASE == (k)) && lo <= (k) && (k) < hi_ph)
#define BOTH(k) (IN(k) && IN((k) + 1))
#define GRID_BAR() do { if (MK_N_LAUNCHES != 6) xcd_barrier(bar); } while (0)

    if (IN(0)) {
        LAS float* scr = (LAS float*)(lds + wave * 16384);
        const int gw = vcu * NWAVES + wave, NGW = G * NWAVES;
        constexpr int I1 = (DM / 64) * (DIN / 32), I2 = (DM / 64) * (DM / 32), I3 = (DM / 64) * (2 * DFF / 32), I4 = (DFF / 64) * (DM / 32);
        for (int it = gw; it < I1 + I2 + I3 + I4; it += NGW) {
            int r = it;
            if (r < I1) { const int nblk = DIN / 32, kb = r / nblk, nb = r % nblk, n0 = 32 * nb, pn = n0 >> 8, p = n0 & 255, bj = p >> 7, wc = (p & 127) >> 5;
                absmax_item(args.in[3], DIN, 256 * pn + 64 * wc + 32 * bj, 64 * kb, ctl + CW_WMAX1 + n0, args.in[2], lane);
                asm volatile("s_waitcnt vmcnt(0)" ::: "memory"); if (lane == 0) (void)__hip_atomic_fetch_add(ctl + CW_W1CNT, 1u, __ATOMIC_RELAXED, __HIP_MEMORY_SCOPE_AGENT); continue; } r -= I1;
            if (r < I2) { const int nblk = DM / 32, kb = r / nblk, nb = r % nblk;
                const int n0 = 32 * nb, pn = n0 >> 8, p = n0 & 255, bj = p >> 7, wc = (p & 127) >> 5;
                transpose_item(args.in[15], DM, 256 * pn + 64 * wc + 32 * bj, DM, 64 * kb, W2, n0, args.in[10], 127, 1.0f - LAM_INIT, 512, scr, lane); continue; } r -= I2;
            if (r < I3) { const int nblk = 2 * DFF / 32, kb = r / nblk, nb = r % nblk, n0 = 32 * nb, pn = n0 >> 8, p = n0 & 255, bj = p >> 7, e0 = p & 127;
                absmax_item(bj ? args.in[18] : args.in[17], DFF, 128 * pn + e0, 64 * kb, ctl + CW_WMAX + n0, args.in[16], lane); continue; } r -= I3;
            { const int nblk = DM / 32, kb = r / nblk, nb = r % nblk;
                transpose_item(args.in[21], DM, 32 * nb, DFF, 64 * kb, W4, 32 * nb, nullptr, 0, 1.f, 0, scr, lane); }
        }
        for (int m = gw; m < NTOK; m += 4 * NGW) {
            f32x4 v[4][4]; float ss[4]; int mr[4];
#pragma unroll
            for (int q = 0; q < 4; ++q) { int mm = m + q * NGW; mr[q] = mm; if (mm >= NTOK) mm = m;
                const float* xr = mm < TOK_P ? xp + (size_t)mm * DM : xs + (size_t)(mm - TOK_P) * DM;
#pragma unroll
                for (int j = 0; j < 4; ++j) v[q][j] = __builtin_nontemporal_load((const f32x4*)xr + 64 * j + lane); }
#pragma unroll
            for (int q = 0; q < 4; ++q) { ss[q] = 0.f;
#pragma unroll
                for (int j = 0; j < 4; ++j) ss[q] += dot4(v[q][j]); }
#pragma unroll
            for (int o = 1; o < 64; o <<= 1) {
#pragma unroll
                for (int q = 0; q < 4; ++q) ss[q] += __shfl_xor(ss[q], o); }
            float am[4];
#pragma unroll
            for (int q = 0; q < 4; ++q) { float a = 0.f;
#pragma unroll
                for (int j = 0; j < 4; ++j) a = __builtin_fmaxf(__builtin_fmaxf(a, __builtin_fmaxf(__builtin_fabsf(v[q][j][0]), __builtin_fabsf(v[q][j][1]))), __builtin_fmaxf(__builtin_fabsf(v[q][j][2]), __builtin_fabsf(v[q][j][3])));
                am[q] = a; }
#pragma unroll
            for (int o = 1; o < 64; o <<= 1) {
#pragma unroll
                for (int q = 0; q < 4; ++q) am[q] = __builtin_fmaxf(am[q], __shfl_xor(am[q], o)); }
#pragma unroll
            for (int q = 0; q < 4; ++q) if (mr[q] < NTOK) { const float ms = ss[q] * (1.f / DM) + EPS; const float r = __builtin_amdgcn_rsqf(ms);
                { const float inv = am[q] > 0.f ? 127.0f / am[q] : 0.f;
                  unsigned* oq = (unsigned*)(XQ + (size_t)mr[q] * DM) + lane;
#pragma unroll
                  for (int j = 0; j < 4; ++j) oq[64 * j] = q4(v[q][j][0] * inv, v[q][j][1] * inv, v[q][j][2] * inv, v[q][j][3] * inv);
                  if (lane == 0) FX[mr[q]] = am[q] * r * (1.0f / 127.0f); }
            }
        }
        { unsigned sp = 0; while (__builtin_amdgcn_readfirstlane(__hip_atomic_load(ctl + CW_W1CNT, __ATOMIC_RELAXED, __HIP_MEMORY_SCOPE_AGENT)) < (unsigned)I1) { __builtin_amdgcn_s_sleep(2); if (++sp > (1u << 22)) break; }
          __builtin_amdgcn_fence(__ATOMIC_ACQUIRE, "agent"); }
        for (int r = gw; r < I1; r += NGW) { const int nblk = DIN / 32, kb = r / nblk, nb = r % nblk, n0 = 32 * nb, pn = n0 >> 8, p = n0 & 255, bj = p >> 7, wc = (p & 127) >> 5;
            quant_item(args.in[3], DIN, 256 * pn + 64 * wc + 32 * bj, DM, 64 * kb, W1Q, n0, args.in[2], ctl + CW_WMAX1 + n0, scr, lane); }
        if (BOTH(0)) GRID_BAR();
    }

    if (IN(1)) {
        pg8::Gemm g{(const bf16_t*)XQ, (const bf16_t*)W1Q, DM / 2, 256}; pg8::StaticOrder S; S.init(NTOK / 256, DIN / 256, G, bx);
        { LAS float* gl = (LAS float*)(lds + EPX_OFF);
          if (tid < 256) { const int v = tid >> 6, d = tid & 63; gl[tid] = (v == 0 ? args.in[4] : v == 1 ? args.in[5] : v == 2 ? args.in[11] : args.in[12])[d]; }
          LDS_WAIT(); __syncthreads(); }
        pg8::EpiProj E{PROJ, (const LAS float*)(lds + EPX_OFF), FX, (const float*)(ctl + CW_WMAX1)};
        pg8::gemm_phase<pg8::EpiProj, pg8::StaticOrder, true, true, true>(lds, g, S, E);
        if (BOTH(1)) GRID_BAR();
    }

    if (IN(2)) {
        if (wave == 0) {
            const float a = args.in[6][lane] * args.in[7][lane], b2 = args.in[8][lane] * args.in[9][lane];
            const float sa = wave_sum(a), sb = wave_sum(b2);
            if (lane == 0) ((LAS float*)(lds + MISC_OFF))[16] = __expf(sa) - __expf(sb) + LAM_INIT;
        }
        LDS_WAIT(); __syncthreads();
        const float lam = ((const LAS float*)(lds + MISC_OFF))[16];
        const int per = (768 + G - 1) / G;
#ifndef NO_DIFF
        for (int i = 0; i < per; ++i) { const int u = vcu * per + i; if (u < 768) { const int bh = u >> 3, qb = u & 7;
            att::diff_unit(bh >> 2, bh & 3, qb, PROJ, OB, (LAS char*)lds, lam, args.in[14]); } }
#endif
#ifndef NO_WIN
        for (int i = 0; i < per; ++i) { const int u = vcu * per + i; if (u < 768) { const int bk = u >> 4, qb = u & 15;
            att::win_unit(bk >> 1, bk & 1, qb, PROJ, OB, (LAS char*)lds, args.in[14], args.in[13]); } }
#endif
        if (BOTH(2)) GRID_BAR();
    }

    if (IN(3)) {
        pg8::Gemm g{OB, W2, DM, 256}; pg8::StaticOrder S; S.init(NTOK / 256, DM / 256, G, bx);
        {
            LAS float* scr = (LAS float*)(lds + wave * 16384);
            const int gw = vcu * NWAVES + wave, NGW = G * NWAVES;
            constexpr int I3 = (DM / 64) * (2 * DFF / 32);
            for (int r = gw; r < I3; r += NGW) { const int nblk = 2 * DFF / 32, kb = r / nblk, nb = r % nblk, n0 = 32 * nb, pn = n0 >> 8, p = n0 & 255, bj = p >> 7, e0 = p & 127;
                quant_item(bj ? args.in[18] : args.in[17], DFF, 128 * pn + e0, DM, 64 * kb, (signed char*)(ws + WS_W3), n0, args.in[16], ctl + CW_WMAX + n0, scr, lane); }
            __syncthreads();
        }
        pg8::EpiOut E{xp, xs, X1B, (LAS float*)(lds + EPX_OFF), (signed char*)(ws + WS_X1Q), (float*)(ws + WS_FA), (float*)(ws + WS_XS), ctl + CW_P3CNT};
        pg8::gemm_phase<pg8::EpiOut, pg8::StaticOrder>(lds, g, S, E);
        if (BOTH(3)) GRID_BAR();
    }

    if (IN(4)) {
        signed char* W3Q = (signed char*)(ws + WS_W3); signed char* X1Q = (signed char*)(ws + WS_X1Q); float* FA = (float*)(ws + WS_FA);
        pg8::Gemm g{(const bf16_t*)(X1Q - DM), (const bf16_t*)W3Q, DM / 2, 254}; pg8::StaticOrder S; S.init(194, 2 * DFF / 256, G, bx);
        pg8::EpiFfn E{ACT, FA, (const float*)(ctl + CW_WMAX), args.in[19], args.in[20], (LAS float*)(lds + EPX_OFF)};
        pg8::gemm_phase<pg8::EpiFfn, pg8::StaticOrder, true, true, true>(lds, g, S, E);
        if (BOTH(4)) GRID_BAR();
    }

    if (IN(5)) {
        pg8::Gemm g{ACT, W4, DFF, 256}; pg8::StaticOrder S; S.init(NTOK / 256, DM / 256, G, bx, 1);
        pg8::EpiDown E{X1B, args.out};
        pg8::gemm_phase<pg8::EpiDown, pg8::StaticOrder>(lds, g, S, E);
    }
#undef IN
#undef BOTH
#undef GRID_BAR
}

extern "C" void kernel_launch(void* const* d_in, const int* in_sizes, int n_in, void* d_out, int out_size, void* d_ws, size_t ws_size, hipStream_t stream) {
    static int grid = 0;
    if (grid == 0) {
        if (n_in != 22 || in_sizes[0] != TOK_P * DM || in_sizes[1] != (NTOK - TOK_P) * DM || out_size != NTOK * DM || ws_size < WS_END) {
            fprintf(stderr, "kernel_launch: shape mismatch (n_in %d, in0 %d, in1 %d, out %d, ws %zu; need ws >= %zu)\n", n_in, n_in > 0 ? in_sizes[0] : -1, n_in > 1 ? in_sizes[1] : -1, out_size, ws_size, (size_t)WS_END); grid = -1; return; }
        int dev = 0, cus = 0;
        if (hipGetDevice(&dev) != hipSuccess || hipDeviceGetAttribute(&cus, hipDeviceAttributeMultiprocessorCount, dev) != hipSuccess) { fprintf(stderr, "kernel_launch: device query failed\n"); grid = -1; return; }
        if (hipFuncSetAttribute((const void*)hymba_fwd, hipFuncAttributeMaxDynamicSharedMemorySize, LDS_BYTES) != hipSuccess) { fprintf(stderr, "kernel_launch: hipFuncSetAttribute failed\n"); grid = -1; return; }
        int per_cu = 0;
        if (hipOccupancyMaxActiveBlocksPerMultiprocessor(&per_cu, (const void*)hymba_fwd, NWAVES * 64, LDS_BYTES) != hipSuccess || per_cu < 1)
            fprintf(stderr, "kernel_launch: note: occupancy query reports %d workgroups per CU\n", per_cu);
        (void)hipGetLastError();
        if (cus < 256) { fprintf(stderr, "kernel_launch: %d CUs; this kernel's unit schedule (co-running tile owners in the out-projection epilogue) is built for 256\n", cus); grid = -1; return; }
        grid = 256;
    }
    if (grid < 0) return;
    (void)hipMemsetAsync((char*)d_ws + WS_CTL, 0, CTL_ZERO_BYTES, stream);
    Args a{};
    for (int i = 0; i < 22; ++i) a.in[i] = (const float*)d_in[i];
    a.out = (float*)d_out; a.ws = (unsigned char*)d_ws;
#ifndef PROBE_DUP
#define PROBE_DUP -1
#endif
    constexpr int NL = (PROBE_DUP >= 0) ? 3 : MK_N_LAUNCHES;
    for (int li = 0; li < NL; ++li) {
        if (PROBE_DUP >= 0) {
            a.ph_lo = li == 0 ? 0 : (li == 1 ? PROBE_DUP : PROBE_DUP + 1); a.ph_hi = li == 2 ? 6 : PROBE_DUP + 1; a.li = li;
        } else { a.ph_lo = (NL == 6) ? li : 0; a.ph_hi = (NL == 6) ? li + 1 : 6; a.li = (NL == 6) ? 0 : li; }
        hipLaunchKernelGGL(hymba_fwd, dim3(grid), dim3(NWAVES * 64), LDS_BYTES, stream, a);
        const hipError_t le = hipPeekAtLastError();
        if (le != hipSuccess) { fprintf(stderr, "kernel_launch: launch %d failed: %s\n", li, hipGetErrorName(le)); break; }
    }
}
```

```cpp
#include <hip/hip_runtime.h>
#include <hip/hip_bf16.h>
#include <cstdio>
#include <cstdint>

#ifndef MK_N_LAUNCHES
#define MK_N_LAUNCHES 1
#endif

#define LAS __attribute__((address_space(3)))
#define GAS __attribute__((address_space(1)))
typedef unsigned short bf16_t;
typedef short bf16x8 __attribute__((ext_vector_type(8)));
typedef short s16x4 __attribute__((ext_vector_type(4)));
typedef float f32x2 __attribute__((ext_vector_type(2)));
typedef float f32x4 __attribute__((ext_vector_type(4)));
typedef float f32x16 __attribute__((ext_vector_type(16)));
typedef unsigned u32x2 __attribute__((ext_vector_type(2)));
typedef unsigned u32x4 __attribute__((ext_vector_type(4)));
typedef __bf16 bf16x2_t __attribute__((ext_vector_type(2)));

constexpr int DM = 1024, SEQ = 2048, NSEQ = 24, NTOK = NSEQ * SEQ, TOK_P = 8 * SEQ;
constexpr int DIN = 2304, DFF = 2816;
constexpr int C_DQ = 0, C_DK = 512, C_DV = 1024, C_WQ = 1536, C_WK = 2048, C_WV = 2176;
constexpr int NBH = 12;
constexpr float EPS = 1e-6f, LOG2E = 1.4426950408889634f, QSCALE = 0.125f * LOG2E;
constexpr float LAM_INIT = 0.2f;
constexpr int NWAVES = 8;

__device__ __forceinline__ unsigned cvtpk(float lo, float hi) { f32x2 v = {lo, hi}; bf16x2_t b = __builtin_convertvector(v, bf16x2_t); return __builtin_bit_cast(unsigned, b); }
__device__ __forceinline__ u32x4 pack8(f32x4 a, f32x4 b) { u32x4 w; w.x = cvtpk(a[0], a[1]); w.y = cvtpk(a[2], a[3]); w.z = cvtpk(b[0], b[1]); w.w = cvtpk(b[2], b[3]); return w; }
__device__ __forceinline__ float dot4(f32x4 a) { return (a[0] * a[0] + a[1] * a[1]) + (a[2] * a[2] + a[3] * a[3]); }

__device__ __forceinline__ unsigned q4(float a, float b, float c, float d) {
    const unsigned ua = __float_as_uint(a + 12582912.0f), ub = __float_as_uint(b + 12582912.0f), uc = __float_as_uint(c + 12582912.0f), ud = __float_as_uint(d + 12582912.0f);
    return (ua & 0xffu) | ((ub & 0xffu) << 8) | ((uc & 0xffu) << 16) | (ud << 24);
}
__device__ __forceinline__ unsigned f8x4(float a, float b, float c, float d) {
    int w = 0;
    w = __builtin_amdgcn_cvt_pk_fp8_f32(__builtin_amdgcn_fmed3f(a, -448.f, 448.f), __builtin_amdgcn_fmed3f(b, -448.f, 448.f), w, false);
    w = __builtin_amdgcn_cvt_pk_fp8_f32(__builtin_amdgcn_fmed3f(c, -448.f, 448.f), __builtin_amdgcn_fmed3f(d, -448.f, 448.f), w, true);
    return (unsigned)w;
}
constexpr float ACT8_SCALE = 8.0f, W8_TOP = 224.0f;
namespace pg8 {
constexpr int BM = 256, BK = 64, HALF = 128, HTB = HALF * BK * 2, STAGE_BYTES = 8 * HTB, NXCD = 8, WGM = 8;
__host__ __device__ __forceinline__ int lds_byte(int r, int c) { const int st = (r >> 4) * 2 + (c >> 5), rr = r & 15, cc = c & 31, ob = rr * 64 + cc * 2; return st * 1024 + (ob ^ (((ob >> 9) & 1) << 5)); }
__host__ __device__ __forceinline__ void stage_rc(int b, int& R, int& C) { const int st = b / 1024, sb = b % 1024, swz = sb ^ (((sb >> 9) & 1) << 5); R = (st >> 1) * 16 + swz / 64; C = (st & 1) * 32 + (swz % 64) / 2; }
__host__ __device__ __forceinline__ int perm32(int rho) { const int n = rho >> 4, i = rho & 15; return 8 * (i >> 2) + 4 * n + (i & 3); }

typedef int v4i32_t __attribute__((ext_vector_type(4)));
struct Unit { int pm, pn; };
struct Gemm { const bf16_t* A; const bf16_t* Bt; int K; int arows; };

struct StaticOrder {
    int nM, nN, nwg, G, c, rev;
    __device__ void init(int nM_, int nN_, int G_, int c_, int rev_ = 0) { nM = nM_; nN = nN_; nwg = nM * nN; G = G_; c = c_; rev = rev_; }
    __device__ bool next(int i, Unit& u) const {
        const int nr = (nwg - c + G - 1) / G; if (i >= nr) return false;
        const long L = (long)(rev ? nr - 1 - i : i) * G + c;
        int wgid = (int)L; { const int q = nwg / NXCD, r = nwg % NXCD, xcd = wgid % NXCD, off = wgid / NXCD; wgid = (xcd < r ? xcd * (q + 1) : r * (q + 1) + (xcd - r) * q) + off; }
        const int nig = WGM * nN, gid = wgid / nig, fm = gid * WGM, gsz = (nM - fm) < WGM ? (nM - fm) : WGM;
        u.pm = fm + ((wgid % nig) % gsz); u.pn = (wgid % nig) / gsz; return true;
    }
};


struct EpiProj {
    static constexpr bool PERM = true;
    bf16_t* P; const LAS float* gl; const float* fx; const float* swm;
    __device__ __forceinline__ void pre(const Unit& u, int wid, int lane_) const {
        int lane = lane_; asm volatile("" : "+v"(lane));
        if (wid >= 4) __builtin_amdgcn_global_load_lds((const unsigned*)(fx + u.pm * BM + 64 * (wid - 4) + lane), (LAS unsigned*)((LAS char*)gl + 1024 + (wid - 4) * 256), 4, 0, 0);
        if (wid == 2) __builtin_amdgcn_global_load_lds((const unsigned*)(swm + u.pn * 256 + lane * 4), (LAS unsigned*)((LAS char*)gl + 2048), 16, 0, 0);
    }
    __device__ __forceinline__ void operator()(const f32x4 (&acc)[2][2][4][2], const Unit& u, int wr, int wc, int fr, int fq, int lane) const {
        int fql = fq; asm volatile("" : "+v"(fql));
        f32x4 csw[2][2];
#pragma unroll
        for (int bj = 0; bj < 2; ++bj)
#pragma unroll
            for (int n = 0; n < 2; ++n) csw[bj][n] = *(const LAS f32x4*)(gl + 512 + 128 * bj + 32 * wc + 8 * fql + 4 * n) * (1.0f / 127.0f);
        const int gidx = u.pn * 4 + wc;
        int gsel = -1; float sc = 1.f;
        if (gidx < 8) { gsel = 0; sc = QSCALE; } else if (gidx < 16) { gsel = 1; } else if (gidx < 24) { } else if (gidx < 32) { gsel = 2; sc = QSCALE; } else if (gidx < 34) { gsel = 3; }
        const bool nrm = gsel >= 0; const LAS float* gain = gl + (nrm ? gsel : 0) * 64;
        f32x4 gv[2][2];
#pragma unroll
        for (int bj = 0; bj < 2; ++bj)
#pragma unroll
            for (int n = 0; n < 2; ++n) gv[bj][n] = nrm ? *(const LAS f32x4*)(gain + 32 * bj + 8 * fq + 4 * n) * sc : (f32x4){1.f, 1.f, 1.f, 1.f};
        bf16_t* base = P + (size_t)(u.pm * BM + wr * 64 + fr) * DIN + gidx * 64 + 8 * fq;
#pragma unroll
        for (int ai = 0; ai < 2; ++ai)
#pragma unroll
            for (int m = 0; m < 4; ++m) {
                const float fxr = gl[256 + ai * HALF + wr * 64 + m * 16 + fr];
                f32x4 v00 = __builtin_convertvector(__builtin_bit_cast(v4i32_t, acc[ai][0][m][0]), f32x4) * (csw[0][0] * fxr), v01 = __builtin_convertvector(__builtin_bit_cast(v4i32_t, acc[ai][0][m][1]), f32x4) * (csw[0][1] * fxr);
                f32x4 v10 = __builtin_convertvector(__builtin_bit_cast(v4i32_t, acc[ai][1][m][0]), f32x4) * (csw[1][0] * fxr), v11 = __builtin_convertvector(__builtin_bit_cast(v4i32_t, acc[ai][1][m][1]), f32x4) * (csw[1][1] * fxr);
                float rn = 1.f;
                if (nrm) { float ss = (dot4(v00) + dot4(v01)) + (dot4(v10) + dot4(v11)); ss += __shfl_xor(ss, 16); ss += __shfl_xor(ss, 32); rn = __builtin_amdgcn_rsqf(ss * (1.0f / 64.0f) + EPS); }
                v00 = v00 * rn * gv[0][0]; v01 = v01 * rn * gv[0][1]; v10 = v10 * rn * gv[1][0]; v11 = v11 * rn * gv[1][1];
                bf16_t* rowp = base + (size_t)(ai * HALF + m * 16) * DIN;
                const u32x4 pa = pack8(v00, v01), pb = pack8(v10, v11);
                u32x4 px; px.x = (unsigned)__builtin_amdgcn_mov_dpp((int)pb.x, 0x128, 0xf, 0xf, true); px.y = (unsigned)__builtin_amdgcn_mov_dpp((int)pb.y, 0x128, 0xf, 0xf, true);
                px.z = (unsigned)__builtin_amdgcn_mov_dpp((int)pb.z, 0x128, 0xf, 0xf, true); px.w = (unsigned)__builtin_amdgcn_mov_dpp((int)pb.w, 0x128, 0xf, 0xf, true);
                const bool hi8 = (fr & 8) != 0;
                bf16_t* r1p = base + (size_t)(ai * HALF + m * 16 - (hi8 ? 8 : 0)) * DIN + (hi8 ? 32 : 0);
                bf16_t* r2p = base + (size_t)(ai * HALF + m * 16 + (hi8 ? 0 : 8)) * DIN + (hi8 ? 0 : 32);
                *(u32x4*)(r1p) = hi8 ? px : pa; *(u32x4*)(r2p) = hi8 ? pa : px;
            }
    }
};

struct EpiOut {
    static constexpr bool PERM = true;
    const float* __restrict__ xp; const float* __restrict__ xsm; bf16_t* __restrict__ x1b; LAS float* xl;
    signed char* x1q; float* fa; float* xs; unsigned* cnt;
    __device__ __forceinline__ void pre(const Unit&, int, int) const {}
    __device__ __forceinline__ void operator()(f32x4 (&acc)[2][2][4][2], const Unit& u, int wr, int wc, int fr, int fq, int lane) const {
        asm volatile("" : "+v"(fr), "+v"(fq));
        const int rowbase = u.pm * BM;
        const int col0 = u.pn * BM + wc * 64 + 8 * fq;
        const bool hi8 = (fr & 8) != 0;
        const float* xrow0 = rowbase < TOK_P ? xp + (size_t)rowbase * DM : xsm + (size_t)(rowbase - TOK_P) * DM;
#pragma unroll
        for (int ai = 0; ai < 2; ++ai) {
            f32x4 xv[4][2][2];
#pragma unroll
            for (int m = 0; m < 4; ++m) { const float* xr = xrow0 + (size_t)(ai * HALF + wr * 64 + m * 16 + fr) * DM + col0;
#pragma unroll
                for (int bj = 0; bj < 2; ++bj) { xv[m][bj][0] = *(const f32x4*)(xr + bj * 32); xv[m][bj][1] = *(const f32x4*)(xr + bj * 32 + 4); } }
#pragma unroll
            for (int m = 0; m < 4; ++m) {
                const int rl = ai * HALF + wr * 64 + m * 16 + fr; float s = 0.f, am = 0.f; u32x4 pk[2];
#pragma unroll
                for (int bj = 0; bj < 2; ++bj) {
                    const f32x4 o0 = xv[m][bj][0] + acc[ai][bj][m][0], o1 = xv[m][bj][1] + acc[ai][bj][m][1];
                    pk[bj] = pack8(o0, o1);
                    f32x4 b0, b1;
                    b0[0] = __uint_as_float(pk[bj].x << 16); b0[1] = __uint_as_float(pk[bj].x & 0xffff0000u); b0[2] = __uint_as_float(pk[bj].y << 16); b0[3] = __uint_as_float(pk[bj].y & 0xffff0000u);
                    b1[0] = __uint_as_float(pk[bj].z << 16); b1[1] = __uint_as_float(pk[bj].z & 0xffff0000u); b1[2] = __uint_as_float(pk[bj].w << 16); b1[3] = __uint_as_float(pk[bj].w & 0xffff0000u);
                    acc[ai][bj][m][0] = b0; acc[ai][bj][m][1] = b1;
#pragma unroll
                    for (int i = 0; i < 4; ++i) am = __builtin_fmaxf(am, __builtin_fmaxf(__builtin_fabsf(b0[i]), __builtin_fabsf(b1[i])));
                    s += dot4(o0) + dot4(o1); }
                s += __shfl_xor(s, 16); s += __shfl_xor(s, 32);
                am = __builtin_fmaxf(am, __shfl_xor(am, 16)); am = __builtin_fmaxf(am, __shfl_xor(am, 32));
                if (fq == 0) { xl[rl * 8 + wc] = s; xl[rl * 8 + 4 + wc] = am; }
            }
        }
        asm volatile("s_waitcnt lgkmcnt(0)" ::: "memory"); __builtin_amdgcn_s_barrier(); asm volatile("" ::: "memory");
        const int t = (wr * 4 + wc) * 64 + lane;
        if (t < 256) {
            const f32x4 q = *(const LAS f32x4*)(xl + t * 8), a4 = *(const LAS f32x4*)(xl + t * 8 + 4);
            float* sl = xs + ((size_t)(rowbase + t) * 4 + u.pn) * 2;
            __hip_atomic_store(sl, (q[0] + q[1]) + (q[2] + q[3]), __ATOMIC_RELAXED, __HIP_MEMORY_SCOPE_AGENT);
            __hip_atomic_store(sl + 1, __builtin_fmaxf(__builtin_fmaxf(a4[0], a4[1]), __builtin_fmaxf(a4[2], a4[3])), __ATOMIC_RELAXED, __HIP_MEMORY_SCOPE_AGENT);
            asm volatile("s_waitcnt vmcnt(0)" ::: "memory");
            if (lane == 0) (void)__hip_atomic_fetch_add(cnt + u.pm, 1u, __ATOMIC_RELAXED, __HIP_MEMORY_SCOPE_AGENT);
        }
#pragma unroll
        for (int ai = 0; ai < 2; ++ai)
#pragma unroll
            for (int m = 0; m < 4; ++m) { const int rl = ai * HALF + wr * 64 + m * 16 + fr;
                const u32x4 pk0 = pack8(acc[ai][0][m][0], acc[ai][0][m][1]), pk1 = pack8(acc[ai][1][m][0], acc[ai][1][m][1]);
                u32x4 px; px.x = (unsigned)__builtin_amdgcn_mov_dpp((int)pk1.x, 0x128, 0xf, 0xf, true); px.y = (unsigned)__builtin_amdgcn_mov_dpp((int)pk1.y, 0x128, 0xf, 0xf, true);
                px.z = (unsigned)__builtin_amdgcn_mov_dpp((int)pk1.z, 0x128, 0xf, 0xf, true); px.w = (unsigned)__builtin_amdgcn_mov_dpp((int)pk1.w, 0x128, 0xf, 0xf, true);
                bf16_t* r1p = x1b + (size_t)(rowbase + rl - (hi8 ? 8 : 0)) * DM + col0 + (hi8 ? 32 : 0);
                bf16_t* r2p = x1b + (size_t)(rowbase + rl + (hi8 ? 0 : 8)) * DM + col0 + (hi8 ? 0 : 32);
                *(u32x4*)(r1p) = hi8 ? px : pk0; *(u32x4*)(r2p) = hi8 ? pk0 : px; }
        if (t < 64) {
            unsigned sp = 0; while (__builtin_amdgcn_readfirstlane(__hip_atomic_load(cnt + u.pm, __ATOMIC_RELAXED, __HIP_MEMORY_SCOPE_AGENT)) < 16u) { __builtin_amdgcn_s_sleep(1); if (++sp > (1u << 22)) break; }
        }
        asm volatile("s_waitcnt lgkmcnt(0)" ::: "memory"); __builtin_amdgcn_s_barrier(); asm volatile("" ::: "memory");
        if (t < 256) {
            const float* sl = xs + (size_t)(rowbase + t) * 8; float ss = 0.f, am = 0.f;
#pragma unroll
            for (int j = 0; j < 4; ++j) { ss += __hip_atomic_load(sl + 2 * j, __ATOMIC_RELAXED, __HIP_MEMORY_SCOPE_AGENT); am = __builtin_fmaxf(am, __hip_atomic_load(sl + 2 * j + 1, __ATOMIC_RELAXED, __HIP_MEMORY_SCOPE_AGENT)); }
            xl[2048 + t] = am > 0.f ? 127.0f / am : 0.f;
            if (u.pn == 0) fa[rowbase + t] = __builtin_amdgcn_rsqf(ss * (1.0f / DM) + EPS) * am * (1.0f / 127.0f);
        }
        asm volatile("s_waitcnt lgkmcnt(0)" ::: "memory"); __builtin_amdgcn_s_barrier(); asm volatile("" ::: "memory");
#pragma unroll
        for (int ai = 0; ai < 2; ++ai)
#pragma unroll
            for (int m = 0; m < 4; ++m) { const int rl = ai * HALF + wr * 64 + m * 16 + fr; const float inv = xl[2048 + rl];
                signed char* qp = x1q + (size_t)(rowbase + rl) * DM + col0;
#pragma unroll
                for (int bj = 0; bj < 2; ++bj) { const f32x4 b0 = acc[ai][bj][m][0] * inv, b1 = acc[ai][bj][m][1] * inv;
                    u32x2 o; o.x = q4(b0[0], b0[1], b0[2], b0[3]); o.y = q4(b1[0], b1[1], b1[2], b1[3]);
                    *(u32x2*)(qp + 32 * bj) = o; } }
    }
};

__device__ __forceinline__ float dpp8(float x) { return __builtin_bit_cast(float, __builtin_amdgcn_mov_dpp(__builtin_bit_cast(int, x), 0x128, 0xf, 0xf, true)); }
struct EpiDown {
    static constexpr bool PERM = true;
    const bf16_t* __restrict__ x1b; float* __restrict__ out; const float* __restrict__ wmx;
    __device__ __forceinline__ void pre(const Unit&, int, int) const {}
    __device__ __forceinline__ void operator()(const f32x4 (&acc)[2][2][4][2], const Unit& u, int wr, int wc, int fr, int fq, int lane) const {
        asm volatile("" : "+v"(fr), "+v"(fq));
        const int col0 = u.pn * BM + wc * 32 + 8 * fq; const bool hi8 = (fr & 8) != 0;
        f32x4 cs[2][2];
#pragma unroll
        for (int bj = 0; bj < 2; ++bj)
#pragma unroll
            for (int n = 0; n < 2; ++n) cs[bj][n] = *(const f32x4*)(wmx + col0 + bj * HALF + 4 * n) * (1.0f / (W8_TOP * ACT8_SCALE));
#pragma unroll
        for (int ai = 0; ai < 2; ++ai) {
            u32x4 w[4][2];
#pragma unroll
            for (int m = 0; m < 4; ++m) { const size_t off = (size_t)(u.pm * BM + ai * HALF + wr * 64 + m * 16 + fr) * DM + col0;
#pragma unroll
                for (int bj = 0; bj < 2; ++bj) w[m][bj] = *(const u32x4*)(x1b + off + bj * HALF); }
#pragma unroll
            for (int m = 0; m < 4; ++m) { const size_t off = (size_t)(u.pm * BM + ai * HALF + wr * 64 + m * 16 + fr) * DM + col0;
#pragma unroll
                for (int bj = 0; bj < 2; ++bj) { const u32x4 ww = w[m][bj];
                    f32x4 r0, r1;
                    r0[0] = __uint_as_float(ww.x << 16); r0[1] = __uint_as_float(ww.x & 0xffff0000u); r0[2] = __uint_as_float(ww.y << 16); r0[3] = __uint_as_float(ww.y & 0xffff0000u);
                    r1[0] = __uint_as_float(ww.z << 16); r1[1] = __uint_as_float(ww.z & 0xffff0000u); r1[2] = __uint_as_float(ww.w << 16); r1[3] = __uint_as_float(ww.w & 0xffff0000u);
                    const f32x4 q0 = r0 + acc[ai][bj][m][0] * cs[bj][0], q1 = r1 + acc[ai][bj][m][1] * cs[bj][1];
                    f32x4 qx; qx[0] = dpp8(q1[0]); qx[1] = dpp8(q1[1]); qx[2] = dpp8(q1[2]); qx[3] = dpp8(q1[3]);
                    const long d1 = hi8 ? (long)(4 - 8 * DM) : 0, d2 = hi8 ? 0 : (long)(4 + 8 * DM);
                    *(f32x4*)(out + off + bj * HALF + d1) = hi8 ? qx : q0; *(f32x4*)(out + off + bj * HALF + d2) = hi8 ? q0 : qx; } } }
    }
};

template <int CTRL> __device__ __forceinline__ float dppz(float x) { return __builtin_bit_cast(float, __builtin_amdgcn_update_dpp(0, __builtin_bit_cast(int, x), CTRL, 0xf, 0xf, true)); }
struct EpiFfn {
    static constexpr bool PERM = true;
    unsigned char* act; const float* fa; const float* swm; const float* cw; const float* cb; LAS float* xl;
    __device__ __forceinline__ void pre(const Unit& u, int wid, int lane_) const {
        int lane = lane_; asm volatile("" : "+v"(lane));
        const int tok0 = 254 * u.pm - 1;
        if (wid >= 4) { int tok = tok0 + 64 * (wid - 4) + lane; tok = tok < 0 ? 0 : (tok > NTOK - 1 ? NTOK - 1 : tok);
            __builtin_amdgcn_global_load_lds((const unsigned*)(fa + tok), (LAS unsigned*)((LAS char*)xl + 4096 + (wid - 4) * 256), 4, 0, 0); }
        if (wid == 2) __builtin_amdgcn_global_load_lds((const unsigned*)(swm + u.pn * 256 + lane * 4), (LAS unsigned*)((LAS char*)xl + 5120), 16, 0, 0);
        if (wid < 2) { const float* src = (wid == 0 ? (lane < 32 ? cw : cw + DFF) : (lane < 32 ? cw + 2 * DFF : cb)) + u.pn * 128 + (lane & 31) * 4;
            __builtin_amdgcn_global_load_lds((const unsigned*)src, (LAS unsigned*)((LAS char*)xl + 20480 + wid * 1024), 16, 0, 0); }
    }
    template <int AI, int M, bool MASK>
    __device__ __forceinline__ void conv_rows(const f32x4 (&acc)[2][2][4][2], const f32x4 (&w0)[2], const f32x4 (&w1)[2], const f32x4 (&w2)[2], const f32x4 (&bb)[2],
                                              int tok, int rl, int G, int xc, int fr, int ch0) const {
        const bool pcut = MASK && (tok & (SEQ - 1)) == 0, ncut = MASK && (tok & (SEQ - 1)) == SEQ - 1;
        f32x4 r0, r1;
#pragma unroll
        for (int n = 0; n < 2; ++n) { f32x4 res;
            f32x4 ex = (f32x4){0.f, 0.f, 0.f, 0.f};
            if (M == 0) { if (G > 0) ex = *(const LAS f32x4*)(xl + (2 * (G - 1) + 1) * 128 + xc + 4 * n); ex = fr == 0 ? ex : (f32x4){0.f, 0.f, 0.f, 0.f}; }
            if (M == 3) { if (G < 3) ex = *(const LAS f32x4*)(xl + (2 * (G + 1)) * 128 + xc + 4 * n); ex = fr == 15 ? ex : (f32x4){0.f, 0.f, 0.f, 0.f}; }
#pragma unroll
            for (int i = 0; i < 4; ++i) {
                const float own = acc[AI][0][M][n][i];
                float pr = dppz<0x111>(own);
                pr += (M > 0) ? dppz<0x10F>(acc[AI][0][M > 0 ? M - 1 : 0][n][i]) : ex[i];
                float nx = dppz<0x101>(own);
                nx += (M < 3) ? dppz<0x11F>(acc[AI][0][M < 3 ? M + 1 : 3][n][i]) : ex[i];
                if (MASK) { pr = pcut ? 0.f : pr; nx = ncut ? 0.f : nx; }
                const float uc = fmaf(w0[n][i], pr, fmaf(w1[n][i], own, fmaf(w2[n][i], nx, bb[n][i])));
                const float sg = uc * __builtin_amdgcn_rcpf(1.0f + __builtin_amdgcn_exp2f(-LOG2E * uc));
                res[i] = sg * acc[AI][1][M][n][i] * ACT8_SCALE;
            }
            if (n == 0) r0 = res; else r1 = res; }
        if (rl != 0 && rl != 255 && tok < NTOK) { u32x2 o; o.x = f8x4(r0[0], r0[1], r0[2], r0[3]); o.y = f8x4(r1[0], r1[1], r1[2], r1[3]); *(u32x2*)(act + (size_t)tok * DFF + ch0) = o; }
    }
    __device__ __forceinline__ void operator()(f32x4 (&acc)[2][2][4][2], const Unit& u, int wr, int wc, int fr, int fq, int lane) const {
        const int ch0 = u.pn * 128 + wc * 32 + 8 * fq;
        const int tok0 = 254 * u.pm - 1;
        int fql = fq; asm volatile("" : "+v"(fql));
        const int xc = wc * 32 + 8 * fql;
        f32x4 su[2];
#pragma unroll
        for (int n = 0; n < 2; ++n) su[n] = *(const LAS f32x4*)(xl + 1280 + 128 + xc + 4 * n) * (1.0f / 127.0f);
#pragma unroll
        for (int ai = 0; ai < 2; ++ai)
#pragma unroll
            for (int m = 0; m < 4; ++m) { const float rs = xl[1024 + ai * HALF + wr * 64 + m * 16 + fr];
#pragma unroll
                for (int n = 0; n < 2; ++n) { const f32x4 rsu = su[n] * rs;
                    acc[ai][0][m][n] = __builtin_convertvector(__builtin_bit_cast(v4i32_t, acc[ai][0][m][n]), f32x4) * rs;
                    acc[ai][1][m][n] = __builtin_convertvector(__builtin_bit_cast(v4i32_t, acc[ai][1][m][n]), f32x4) * rsu; } }
#pragma unroll
        for (int ai = 0; ai < 2; ++ai) { const int G = 2 * ai + wr;
            if (fr == 0) { *(LAS f32x4*)(xl + (2 * G) * 128 + xc) = acc[ai][0][0][0]; *(LAS f32x4*)(xl + (2 * G) * 128 + xc + 4) = acc[ai][0][0][1]; }
            if (fr == 15) { *(LAS f32x4*)(xl + (2 * G + 1) * 128 + xc) = acc[ai][0][3][0]; *(LAS f32x4*)(xl + (2 * G + 1) * 128 + xc + 4) = acc[ai][0][3][1]; } }
        asm volatile("s_waitcnt lgkmcnt(0)" ::: "memory"); __builtin_amdgcn_s_barrier(); asm volatile("" ::: "memory"); __builtin_amdgcn_sched_barrier(0);
        f32x4 w0[2], w1[2], w2[2], bb[2];
#pragma unroll
        for (int n = 0; n < 2; ++n) { const LAS float* wl = xl + 5120 + xc + 4 * n; const f32x4 sgc = *(const LAS f32x4*)(xl + 1280 + xc + 4 * n) * (1.0f / 127.0f);
            w0[n] = *(const LAS f32x4*)(wl) * sgc; w1[n] = *(const LAS f32x4*)(wl + 128) * sgc; w2[n] = *(const LAS f32x4*)(wl + 256) * sgc; bb[n] = *(const LAS f32x4*)(wl + 384); }
#define FFN_ROWS(AI, M) do { const int tb_ = tok0 + AI * HALF + wr * 64 + M * 16; const int G_ = 2 * AI + wr; \
        conv_rows<AI, M, true>(acc, w0, w1, w2, bb, tb_ + fr, AI * HALF + wr * 64 + M * 16 + fr, G_, xc, fr, ch0); \
        if ((M) & 1) __builtin_amdgcn_sched_barrier(0); } while (0)
        FFN_ROWS(0, 0); FFN_ROWS(0, 1); FFN_ROWS(0, 2); FFN_ROWS(0, 3); FFN_ROWS(1, 0); FFN_ROWS(1, 1); FFN_ROWS(1, 2); FFN_ROWS(1, 3);
#undef FFN_ROWS
    }
};

typedef int v8i32_t __attribute__((ext_vector_type(8)));
template <class Epi, class Sched, bool ALIGN_EPI = true, bool SP2 = true, int QM = 0>
__device__ __forceinline__ void gemm_phase(LAS unsigned char* lds, const Gemm g, const Sched& S, const Epi& E) {
    const int tid = threadIdx.x, wid = __builtin_amdgcn_readfirstlane(tid >> 6), lane = tid & 63, wr = wid >> 2, wc = wid & 3, fr = lane & 15, fq = lane >> 4;
    const int K = g.K, nt = K / BK;
    unsigned voffA[2], voffB[2];
#pragma unroll
    for (int i = 0; i < 2; ++i) { int R, C; stage_rc(tid * 16 + i * 8192, R, C); const int Rb = Epi::PERM ? ((R & ~31) + perm32(R & 31)) : R;
        voffA[i] = (unsigned)(R * K + C) * 2u; voffB[i] = (unsigned)(Rb * K + C) * 2u; }
    const size_t kstep = (size_t)(BK * 2);
    const size_t hstep = (size_t)HALF * K * 2;
    const size_t tstepB = 2 * hstep;
    const size_t tstepA = (size_t)g.arows * K * 2;
    const unsigned ldsw = (unsigned)wid * 1024u;
    const int aoff = lds_byte(wr * 64 + fr, fq * 8), boff = lds_byte(wc * 32 + fr, fq * 8);
#define PG8_SA(b, h) (((b) * 2 + (h)) * HTB)
#define PG8_SB(b, h) ((4 + (b) * 2 + (h)) * HTB)
#define PG8_STAGE(bufoff, gbase, voff) do { _Pragma("unroll") for (int _i = 0; _i < 2; ++_i) \
        __builtin_amdgcn_global_load_lds((const unsigned*)((const char*)(gbase) + (voff)[_i]), (LAS unsigned*)(lds + (bufoff) + ldsw + _i * 8192), 16, 0, 0); } while (0)
#define PG8_LDA(dst, b, h) do { _Pragma("unroll") for (int m = 0; m < 4; ++m) _Pragma("unroll") for (int k = 0; k < 2; ++k) dst[m][k] = *(const LAS bf16x8*)(lds + PG8_SA(b, h) + aoff + m * 2048 + k * 1024); } while (0)
#define PG8_LDB(dst, b, h) do { _Pragma("unroll") for (int n = 0; n < 2; ++n) _Pragma("unroll") for (int k = 0; k < 2; ++k) dst[n][k] = *(const LAS bf16x8*)(lds + PG8_SB(b, h) + boff + n * 2048 + k * 1024); } while (0)
#define PG8_MMA(ai, bj, At, Bt) do { __builtin_amdgcn_s_setprio(1); \
    if constexpr (QM == 2) { _Pragma("unroll") for (int m = 0; m < 4; ++m) _Pragma("unroll") for (int n = 0; n < 2; ++n) { \
        const v8i32_t b8_ = __builtin_shufflevector(__builtin_bit_cast(v4i32_t, Bt[n][0]), __builtin_bit_cast(v4i32_t, Bt[n][1]), 0, 1, 2, 3, 4, 5, 6, 7), a8_ = __builtin_shufflevector(__builtin_bit_cast(v4i32_t, At[m][0]), __builtin_bit_cast(v4i32_t, At[m][1]), 0, 1, 2, 3, 4, 5, 6, 7); \
        asm volatile("v_mfma_scale_f32_16x16x128_f8f6f4 %0, %1, %2, %0, %3, %3 op_sel_hi:[0,0,0]" : "+v"(acc[ai][bj][m][n]) : "v"(b8_), "v"(a8_), "v"(one8)); } } \
    else _Pragma("unroll") for (int m = 0; m < 4; ++m) _Pragma("unroll") for (int n = 0; n < 2; ++n) _Pragma("unroll") for (int k = 0; k < 2; ++k) \
        { if constexpr (QM == 1) acc[ai][bj][m][n] = __builtin_bit_cast(f32x4, __builtin_amdgcn_mfma_i32_16x16x64_i8(__builtin_bit_cast(v4i32_t, Bt[n][k]), __builtin_bit_cast(v4i32_t, At[m][k]), __builtin_bit_cast(v4i32_t, acc[ai][bj][m][n]), 0, 0, 0)); \
          else acc[ai][bj][m][n] = __builtin_amdgcn_mfma_f32_16x16x32_bf16(Bt[n][k], At[m][k], acc[ai][bj][m][n], 0, 0, 0); } __builtin_amdgcn_s_setprio(0); } while (0)
#define PG8_WAIT_V(n) asm volatile("s_waitcnt vmcnt(" #n ")" ::: "memory")
#define PG8_WAIT_L(n) asm volatile("s_waitcnt lgkmcnt(" #n ")" ::: "memory")
#define PG8_BAR __builtin_amdgcn_s_barrier()
#define PG8_SCHED __builtin_amdgcn_sched_barrier(0)
    Unit cur, nxt; int ui = 0;
    if (!S.next(0, cur)) return;
    const int one8 = 0x7f7f7f7f;
    f32x4 acc[2][2][4][2];
#pragma unroll
    for (int a = 0; a < 2; ++a)
#pragma unroll
        for (int b = 0; b < 2; ++b)
#pragma unroll
            for (int m = 0; m < 4; ++m)
#pragma unroll
                for (int n = 0; n < 2; ++n) acc[a][b][m][n] = (f32x4){0.f, 0.f, 0.f, 0.f};
    bf16x8 At[4][2], B0[2][2], B1[2][2];
    const char* cA = (const char*)g.A + (size_t)cur.pm * tstepA; const char* cB = (const char*)g.Bt + (size_t)cur.pn * tstepB;
    if constexpr (SP2) {
        PG8_STAGE(PG8_SB(0, 0), cB, voffB); PG8_STAGE(PG8_SB(0, 1), cB + hstep, voffB); PG8_STAGE(PG8_SA(0, 0), cA, voffA); PG8_STAGE(PG8_SA(0, 1), cA + hstep, voffA);
        if (wr == 1) PG8_BAR;
        PG8_WAIT_V(2); PG8_BAR;
        PG8_STAGE(PG8_SB(1, 0), cB + kstep, voffB); PG8_STAGE(PG8_SA(1, 0), cA + kstep, voffA); PG8_STAGE(PG8_SB(1, 1), cB + hstep + kstep, voffB);
        PG8_WAIT_V(6); PG8_BAR;
    } else {
        PG8_STAGE(PG8_SB(0, 0), cB, voffB); PG8_STAGE(PG8_SA(0, 0), cA, voffA); PG8_STAGE(PG8_SB(0, 1), cB + hstep, voffB); PG8_STAGE(PG8_SA(0, 1), cA + hstep, voffA);
        if (wr == 1) PG8_BAR;
        PG8_WAIT_V(4); PG8_BAR;
        PG8_STAGE(PG8_SB(1, 0), cB + kstep, voffB); PG8_STAGE(PG8_SA(1, 0), cA + kstep, voffA); PG8_STAGE(PG8_SB(1, 1), cB + hstep + kstep, voffB);
        PG8_WAIT_V(6); PG8_BAR;
    }
    for (;;) {
        const bool has_next = S.next(ui + 1, nxt);
        const char* nA = has_next ? (const char*)g.A + (size_t)nxt.pm * tstepA : cA; const char* nB = has_next ? (const char*)g.Bt + (size_t)nxt.pn * tstepB : cB;
        for (int t = 0; t < nt; t += 2) {
            const bool last = (t == nt - 2);
            const char* a1 = cA + (size_t)(t + 1) * kstep;
            const char* a2 = last ? nA : cA + (size_t)(t + 2) * kstep; const char* b2 = last ? nB : cB + (size_t)(t + 2) * kstep;
            const char* a3 = a2 + kstep; const char* b3 = b2 + kstep;
            if (last) E.pre(cur, wid, lane);
            if constexpr (SP2) {
            PG8_LDB(B0, 0, 0); PG8_LDB(B1, 0, 1); PG8_SCHED; PG8_LDA(At, 0, 0); PG8_STAGE(PG8_SA(1, 1), a1 + hstep, voffA);
            PG8_WAIT_V(8); PG8_WAIT_L(0); PG8_BAR; PG8_MMA(0, 0, At, B0); PG8_MMA(0, 1, At, B1); PG8_BAR; PG8_SCHED;
            PG8_LDA(At, 0, 1); PG8_STAGE(PG8_SB(0, 0), b2, voffB); PG8_STAGE(PG8_SB(0, 1), b2 + hstep, voffB); PG8_STAGE(PG8_SA(0, 0), a2, voffA);
            PG8_WAIT_V(8); PG8_WAIT_L(0); PG8_BAR; PG8_MMA(1, 0, At, B0); PG8_MMA(1, 1, At, B1); PG8_BAR; PG8_SCHED;
            PG8_LDB(B0, 1, 0); PG8_LDB(B1, 1, 1); PG8_SCHED; PG8_LDA(At, 1, 0); PG8_STAGE(PG8_SA(0, 1), a2 + hstep, voffA);
            PG8_WAIT_V(8); PG8_WAIT_L(0); PG8_BAR; PG8_MMA(0, 0, At, B0); PG8_MMA(0, 1, At, B1); PG8_BAR; PG8_SCHED;
            PG8_LDA(At, 1, 1); PG8_STAGE(PG8_SB(1, 0), b3, voffB); PG8_STAGE(PG8_SB(1, 1), b3 + hstep, voffB); PG8_STAGE(PG8_SA(1, 0), a3, voffA);
            PG8_WAIT_V(8); PG8_WAIT_L(0); PG8_BAR; PG8_MMA(1, 0, At, B0); PG8_MMA(1, 1, At, B1); PG8_BAR; PG8_SCHED;
            } else {
            PG8_LDB(B0, 0, 0); PG8_SCHED; PG8_LDA(At, 0, 0); PG8_STAGE(PG8_SA(1, 1), a1 + hstep, voffA);
            PG8_WAIT_L(8); PG8_BAR; PG8_WAIT_L(0); PG8_MMA(0, 0, At, B0); PG8_BAR; PG8_SCHED;
            PG8_LDB(B1, 0, 1); PG8_STAGE(PG8_SB(0, 0), b2, voffB);
            PG8_BAR; PG8_WAIT_L(0); PG8_MMA(0, 1, At, B1); PG8_BAR;
            PG8_LDA(At, 0, 1); PG8_STAGE(PG8_SA(0, 0), a2, voffA);
            PG8_BAR; PG8_WAIT_L(0); PG8_MMA(1, 0, At, B0); PG8_BAR; PG8_SCHED;
            PG8_STAGE(PG8_SB(0, 1), b2 + hstep, voffB);
            PG8_WAIT_V(6); PG8_BAR; PG8_MMA(1, 1, At, B1); PG8_BAR;
            PG8_LDB(B0, 1, 0); PG8_SCHED; PG8_LDA(At, 1, 0); PG8_STAGE(PG8_SA(0, 1), a2 + hstep, voffA);
            PG8_WAIT_L(8); PG8_BAR; PG8_WAIT_L(0); PG8_MMA(0, 0, At, B0); PG8_BAR; PG8_SCHED;
            PG8_LDB(B1, 1, 1); PG8_STAGE(PG8_SB(1, 0), b3, voffB);
            PG8_BAR; PG8_WAIT_L(0); PG8_MMA(0, 1, At, B1); PG8_BAR;
            PG8_LDA(At, 1, 1); PG8_STAGE(PG8_SA(1, 0), a3, voffA);
            PG8_BAR; PG8_WAIT_L(0); PG8_MMA(1, 0, At, B0); PG8_BAR; PG8_SCHED;
            PG8_STAGE(PG8_SB(1, 1), b3 + hstep, voffB);
            PG8_WAIT_V(6); PG8_BAR; PG8_MMA(1, 1, At, B1); PG8_BAR;
            }
        }
        if constexpr (ALIGN_EPI) { if (wr == 0) PG8_BAR; }
        E(acc, cur, wr, wc, fr, fq, lane);
        if (!has_next) break;
#pragma unroll
        for (int a = 0; a < 2; ++a)
#pragma unroll
            for (int b = 0; b < 2; ++b)
#pragma unroll
                for (int m = 0; m < 4; ++m)
#pragma unroll
                    for (int n = 0; n < 2; ++n) acc[a][b][m][n] = (f32x4){0.f, 0.f, 0.f, 0.f};
        cur = nxt; cA = nA; cB = nB; ++ui;
        if constexpr (ALIGN_EPI) { if (wr == 1) PG8_BAR; }
    }
    PG8_WAIT_V(0);
    if constexpr (!ALIGN_EPI) { if (wr == 0) PG8_BAR; }
    PG8_BAR;
#undef PG8_SA
#undef PG8_SB
#undef PG8_STAGE
#undef PG8_LDA
#undef PG8_LDB
#undef PG8_MMA
#undef PG8_WAIT_V
#undef PG8_WAIT_L
#undef PG8_BAR
#undef PG8_SCHED
}
}

namespace att {
constexpr int PITCH = DIN;
#define SBAR() __builtin_amdgcn_sched_barrier(0)
#define KSW(row, colB) ((row) * 128 + ((colB) ^ ((((row) >> 1) & 7) << 4)))
__device__ __forceinline__ int crow(int r, int hi) { return (r & 3) + 8 * (r >> 2) + 4 * hi; }
__device__ __forceinline__ int rel_bucket(int rel) {
    const int n = rel < 0 ? -rel : rel; int v;
    if (n < 8) v = n; else { v = 2 + (31 - __clz(n * n)); v = v > 15 ? 15 : v; }
    return (rel > 0 ? 16 : 0) + v;
}
constexpr float THR = 5.0f;

__device__ __forceinline__ void partialSM(f32x16& p0, f32x16& p1, float off, float& m_reg, float& alpha) {
    float pmax = p0[0];
#pragma unroll
    for (int r = 1; r < 16; ++r) pmax = fmaxf(pmax, p0[r]);
#pragma unroll
    for (int r = 0; r < 16; ++r) pmax = fmaxf(pmax, p1[r]);
    { auto rr = __builtin_amdgcn_permlane32_swap(__float_as_uint(pmax), __float_as_uint(pmax), false, false);
      pmax = fmaxf(__uint_as_float(rr[0]), __uint_as_float(rr[1])); }
    pmax += off;
    if (__builtin_expect(__all(pmax - m_reg <= THR), 1)) { alpha = 1.f; }
    else { const float mn = fmaxf(m_reg, pmax); alpha = __builtin_amdgcn_exp2f(m_reg - mn); m_reg = mn; }
    const float sub = off - m_reg;
#pragma unroll
    for (int r = 0; r < 16; ++r) { p0[r] += sub; p1[r] += sub; }
#pragma unroll
    for (int r = 0; r < 16; ++r) p0[r] = __builtin_amdgcn_exp2f(p0[r]);
}
__device__ __forceinline__ void finishSM(f32x16& p0, f32x16& p1, float alpha, float& l_reg, bf16x8& pa0, bf16x8& pa1, bf16x8& pa2, bf16x8& pa3) {
#pragma unroll
    for (int r = 0; r < 16; ++r) p1[r] = __builtin_amdgcn_exp2f(p1[r]);
    float ps = 0;
#pragma unroll
    for (int r = 0; r < 16; ++r) ps += p0[r];
#pragma unroll
    for (int r = 0; r < 16; ++r) ps += p1[r];
    { auto rr = __builtin_amdgcn_permlane32_swap(__float_as_uint(ps), __float_as_uint(ps), false, false);
      ps = __uint_as_float(rr[0]) + __uint_as_float(rr[1]); }
    l_reg = l_reg * alpha + ps;
#define PK4(P, BASE, OUT) do { unsigned a0 = cvtpk(P[BASE + 0], P[BASE + 1]), a1 = cvtpk(P[BASE + 2], P[BASE + 3]);   \
    unsigned b0 = cvtpk(P[BASE + 4], P[BASE + 5]), b1 = cvtpk(P[BASE + 6], P[BASE + 7]);                              \
    auto r0 = __builtin_amdgcn_permlane32_swap(a0, b0, false, false); auto r1 = __builtin_amdgcn_permlane32_swap(a1, b1, false, false); \
    u32x4 w = {r0[0], r1[0], r0[1], r1[1]}; OUT = __builtin_bit_cast(bf16x8, w); } while (0)
    PK4(p0, 0, pa0); PK4(p0, 8, pa1); PK4(p1, 0, pa2); PK4(p1, 8, pa3);
#undef PK4
}
__device__ __forceinline__ void qkt64(f32x16& p0, f32x16& p1, const LAS char* Ks, const bf16x8* qr, int r32, int hi) {
#pragma unroll
    for (int d0 = 0; d0 < 4; ++d0) { const int cb = (d0 * 16 + hi * 8) * 2;
        const bf16x8 b0 = *(const LAS bf16x8*)(Ks + KSW(r32, cb));
        const bf16x8 b1 = *(const LAS bf16x8*)(Ks + KSW(r32, cb) + 4096);
        p0 = __builtin_amdgcn_mfma_f32_32x32x16_bf16(b0, qr[d0], p0, 0, 0, 0); p1 = __builtin_amdgcn_mfma_f32_32x32x16_bf16(b1, qr[d0], p1, 0, 0, 0); }
}
template <int NCB> __device__ __forceinline__ int v_st(int k, int c) { const int kk = (k & ~0xC) | ((k & 4) << 1) | ((k & 8) >> 1); return ((kk >> 3) * NCB + (c >> 5)) * 512 + ((kk & 7) * 32 + (c & 31)) * 2; }
__device__ __forceinline__ int v_rd_base(int lane) { return ((lane & 3) << 3) | (((lane >> 2) & 3) << 6) | (((lane >> 4) & 1) << 5) | (((lane >> 5) & 1) << 8); }
template <int NCB> constexpr int v_rd_off(int d0, int ks, int half) { return d0 * 512 + ks * (NCB * 1024) + half * (NCB * 512); }
template <int OFF> __device__ __forceinline__ s16x4 tr_read(int vb) { s16x4 r; asm volatile("ds_read_b64_tr_b16 %0, %1 offset:%2" : "=&v"(r) : "v"(vb), "i"(OFF) : "memory"); return r; }
template <int NCB, int D0> __device__ __forceinline__ void pv_one(f32x16& od, int vb, bf16x8 pa0, bf16x8 pa1, bf16x8 pa2, bf16x8 pa3) {
    const s16x4 l0 = tr_read<v_rd_off<NCB>(D0, 0, 0)>(vb), h0 = tr_read<v_rd_off<NCB>(D0, 0, 1)>(vb), l1 = tr_read<v_rd_off<NCB>(D0, 1, 0)>(vb), h1 = tr_read<v_rd_off<NCB>(D0, 1, 1)>(vb);
    const s16x4 l2 = tr_read<v_rd_off<NCB>(D0, 2, 0)>(vb), h2 = tr_read<v_rd_off<NCB>(D0, 2, 1)>(vb), l3 = tr_read<v_rd_off<NCB>(D0, 3, 0)>(vb), h3 = tr_read<v_rd_off<NCB>(D0, 3, 1)>(vb);
    asm volatile("s_waitcnt lgkmcnt(0)" ::: "memory"); SBAR();
#define PK(L, H) (bf16x8){L[0], L[1], L[2], L[3], H[0], H[1], H[2], H[3]}
    od = __builtin_amdgcn_mfma_f32_32x32x16_bf16(pa0, PK(l0, h0), od, 0, 0, 0);
    od = __builtin_amdgcn_mfma_f32_32x32x16_bf16(pa1, PK(l1, h1), od, 0, 0, 0);
    od = __builtin_amdgcn_mfma_f32_32x32x16_bf16(pa2, PK(l2, h2), od, 0, 0, 0);
    od = __builtin_amdgcn_mfma_f32_32x32x16_bf16(pa3, PK(l3, h3), od, 0, 0, 0);
#undef PK
}

constexpr int D_V = 0, D_K = 49152, D_WS = 81920, D_TB = 83968, D_ST = 86016, D_END = D_ST + 65536;
constexpr int NT = SEQ / 64;

typedef short v4i16_t __attribute__((ext_vector_type(4)));
__device__ __forceinline__ s16x4 vtr(const LAS char* p) { return __builtin_bit_cast(s16x4, __builtin_amdgcn_ds_read_tr16_b64_v4i16((LAS v4i16_t*)p)); }
#define PIN(x) asm volatile("" : "+v"(x))
#define MX3(a, b, c) __builtin_fmaxf(__builtin_fmaxf((a), (b)), (c))
#define EX(v) __builtin_amdgcn_exp2f(v)
#define MFMA32(a, b, c) __builtin_amdgcn_mfma_f32_32x32x16_bf16((a), (b), (c), 0, 0, 0)
constexpr float THRL = 6.0f;
__device__ __forceinline__ float rowmax32(const f32x16& C0, const f32x16& C1) {
    float a = MX3(C0[0], C0[1], C1[0]), b = MX3(C0[2], C0[3], C1[1]); a = MX3(a, C1[2], C1[3]);
#pragma unroll
    for (int r = 4; r < 16; r += 4) { a = MX3(a, C0[r], C0[r + 1]); b = MX3(b, C0[r + 2], C0[r + 3]); a = MX3(a, C1[r], C1[r + 1]); b = MX3(b, C1[r + 2], C1[r + 3]); }
    float rm = __builtin_fmaxf(a, b);
    auto rr = __builtin_amdgcn_permlane32_swap(__float_as_uint(rm), __float_as_uint(rm), false, false);
    return __builtin_fmaxf(__uint_as_float(rr[0]), __uint_as_float(rr[1]));
}
__device__ __forceinline__ void diff_pass(f32x16 (&o)[4], float& l_out, const bf16_t* Qw, const bf16_t* __restrict__ Kh, const bf16_t* __restrict__ Vh,
                                          LAS char* lds, int qa, float cL, float cR) {
    const int tid = threadIdx.x, wid = __builtin_amdgcn_readfirstlane(tid >> 6), lane = tid & 63, r32 = lane & 31, hi = lane >> 5;
    LAS char* V_lds = lds + D_V; LAS char* K_lds = lds + D_K;
    LAS float* wsf = (LAS float*)(lds + D_WS) + wid * 64 + 32;
    const LAS float* tb = (const LAS float*)(lds + D_TB);
#pragma unroll
    for (int d = 0; d < 4; ++d) o[d] = f32x16{};
    bf16x8 qr[4];
#pragma unroll
    for (int d0 = 0; d0 < 4; ++d0) qr[d0] = *(const bf16x8*)(Qw + d0 * 16);
#pragma unroll
    for (int d0 = 0; d0 < 4; ++d0) PIN(qr[d0]);
    const bf16_t* ksrc; const bf16_t* vsrc0;
    { const int row = wid * 8 + (lane >> 3), pos = lane & 7;
      ksrc = Kh + (long)row * PITCH + ((pos ^ ((row >> 1) & 7)) * 8);
      vsrc0 = Vh + (long)row * PITCH + ((pos ^ (((row >> 1) & 1) << 2)) * 8); }
    const LAS char* kq[4];
    { const int sw = (r32 >> 1) & 7;
#pragma unroll
      for (int d0 = 0; d0 < 4; ++d0) kq[d0] = K_lds + r32 * 128 + (((2 * d0 + hi) ^ sw) << 4); }
    const LAS char* vpe; const LAS char* vpo;
    { const int q = (lane & 15) >> 2, p = lane & 3, g = (lane >> 4) & 1, sw = (q >> 1) & 1;
      vpe = V_lds + (4 * hi + q) * 128 + sw * 64 + g * 32 + p * 8; vpo = V_lds + (4 * hi + q) * 128 + (sw ^ 1) * 64 + g * 32 + p * 8; }
#define DMA_K(j, ko) __builtin_amdgcn_global_load_lds((const unsigned*)(ksrc + (long)(j) * 64 * PITCH), (LAS unsigned*)(K_lds + (ko) + wid * 1024), 16, 0, 0)
#define DMA_V(j, vo) do { __builtin_amdgcn_global_load_lds((const unsigned*)(vsrc0 + (long)(j) * 64 * PITCH), (LAS unsigned*)(V_lds + (vo) + wid * 1024), 16, 0, 0); \
    __builtin_amdgcn_global_load_lds((const unsigned*)(vsrc0 + 64 + (long)(j) * 64 * PITCH), (LAS unsigned*)(V_lds + (vo) + 8192 + wid * 1024), 16, 0, 0); } while (0)
#define WAIT_BAR(N) do { asm volatile("s_waitcnt vmcnt(" #N ") lgkmcnt(0)" ::: "memory"); __builtin_amdgcn_s_barrier(); asm volatile("" ::: "memory"); } while (0)
    float mhat, l_reg = 0.f; bool resc = false;
    f32x16 pA0, pA1, pB0, pB1;
    bf16x8 kf[4]; s16x4 vlo[6], vhi[6]; u32x4 pw0, pw1, pw2, pw3;
#define KRD(i, KS) do { kf[(i) & 3] = *(const LAS bf16x8*)(kq[(i) >> 1] + (KS) + ((i) & 1) * 4096); } while (0)
    WAIT_BAR(0);
    DMA_K(0, 0); DMA_K(1, 8192); DMA_V(0, 0); DMA_K(2, 16384); DMA_K(3, 24576); DMA_V(1, 16384);
    WAIT_BAR(7);
    {
        float off0 = 0.f; const int d_ = -qa;
        if (d_ <= -154) { pA0 = f32x16{}; pA1 = f32x16{}; off0 = cL; }
        else { const LAS float* t_ = tb + (d_ + 256 + 4 * hi - r32);
#pragma unroll
            for (int r = 0; r < 16; ++r) { pA0[r] = t_[(r & 3) + 8 * (r >> 2)]; pA1[r] = t_[32 + (r & 3) + 8 * (r >> 2)]; } }
#pragma unroll
        for (int d0 = 0; d0 < 4; ++d0) { const bf16x8 k0_ = *(const LAS bf16x8*)(kq[d0]), k1_ = *(const LAS bf16x8*)(kq[d0] + 4096);
            pA0 = MFMA32(k0_, qr[d0], pA0); pA1 = MFMA32(k1_, qr[d0], pA1); }
        const float rm = rowmax32(pA0, pA1);
        mhat = rm + off0;
#pragma unroll
        for (int r = 0; r < 16; ++r) { pA0[r] = EX(pA0[r] - rm); pA1[r] = EX(pA1[r] - rm); }
    }
    WAIT_BAR(3);
    KRD(0, 8192); KRD(1, 8192); KRD(2, 8192); KRD(3, 8192);
#define PKW(P, B) cvtpk(P[B], P[(B) + 1])
#define PAF(k) __builtin_bit_cast(bf16x8, pw##k)
#define VFR(i) (bf16x8){vlo[(i) % 6][0], vlo[(i) % 6][1], vlo[(i) % 6][2], vlo[(i) % 6][3], vhi[(i) % 6][0], vhi[(i) % 6][1], vhi[(i) % 6][2], vhi[(i) % 6][3]}
#define VRD(i, VS) do { const LAS char* vq_ = ((((i) & 3) & 1) ? vpo : vpe) + (VS) + (((i) & 3) >> 1) * 8192 + ((i) >> 2) * 2048; vlo[(i) % 6] = vtr(vq_); vhi[(i) % 6] = vtr(vq_ + 1024); } while (0)
#define GAPA(g, CC, QI, KB, A0, A1, A2, A3, W0, W1, PW) do { CC = MFMA32(kf[(g) & 3], qr[QI], CC); if ((g) + 4 < 8) KRD((g) + 4, KB); sacc += A0; sacc += A1; sacc += A2; sacc += A3; PIN(sacc); W0; W1; PIN(PW); SBAR(); } while (0)
#define GAPB(i, X, B, VB, KN, PRE) do { o[(i) & 3] = MFMA32(PAF_SEL(i), VFR(i), o[(i) & 3]); X[B] = EX(X[B]); X[(B) + 1] = EX(X[(B) + 1]); PIN(X); if ((i) + 5 < 16) VRD((i) + 5, VB); \
    if ((PRE) && (i) >= 8 && (i) < 12) KRD((i) - 8, KN); SBAR(); } while (0)
#define PAF_SEL(i) (((i) >> 2) == 0 ? PAF(0) : ((i) >> 2) == 1 ? PAF(1) : ((i) >> 2) == 2 ? PAF(2) : PAF(3))
#define STEP(C0, C1, P0, P1, t, KB, VB, KN, PRE) do { SBAR(); \
    { const int d_ = (t) * 64 - qa; \
      if (d_ > -154 && d_ < 122) { const LAS float* t_ = tb + (d_ + 256 + 4 * hi - r32); \
        _Pragma("unroll") for (int r = 0; r < 16; ++r) { C0[r] = t_[(r & 3) + 8 * (r >> 2)] - mhat; C1[r] = t_[32 + (r & 3) + 8 * (r >> 2)] - mhat; } } \
      else { const float cs_ = (d_ < 0 ? cL : cR) - mhat; _Pragma("unroll") for (int r = 0; r < 16; ++r) { C0[r] = cs_; C1[r] = cs_; } } } \
    PIN(C0); PIN(C1); SBAR(); \
    float sacc = (P0[0] + P0[1]); \
    GAPA(0, C0, 0, KB, P0[2],  P0[3],  P0[4],  P0[5],  pw0[0] = PKW(P0, 0),  pw0[1] = PKW(P0, 2),  pw0); \
    GAPA(1, C1, 0, KB, P0[6],  P0[7],  P0[8],  P0[9],  pw0[2] = PKW(P0, 4),  pw0[3] = PKW(P0, 6),  pw0); \
    GAPA(2, C0, 1, KB, P0[10], P0[11], P0[12], P0[13], pw1[0] = PKW(P0, 8),  pw1[1] = PKW(P0, 10), pw1); \
    GAPA(3, C1, 1, KB, P0[14], P0[15], P1[0],  P1[1],  pw1[2] = PKW(P0, 12), pw1[3] = PKW(P0, 14), pw1); \
    GAPA(4, C0, 2, KB, P1[2],  P1[3],  P1[4],  P1[5],  pw2[0] = PKW(P1, 0),  pw2[1] = PKW(P1, 2),  pw2); \
    GAPA(5, C1, 2, KB, P1[6],  P1[7],  P1[8],  P1[9],  pw2[2] = PKW(P1, 4),  pw2[3] = PKW(P1, 6),  pw2); \
    GAPA(6, C0, 3, KB, P1[10], P1[11], P1[12], P1[13], pw3[0] = PKW(P1, 8),  pw3[1] = PKW(P1, 10), pw3); \
    GAPA(7, C1, 3, KB, P1[14], P1[15], 0.f,    0.f,    pw3[2] = PKW(P1, 12), pw3[3] = PKW(P1, 14), pw3); \
    l_reg += sacc; \
    VRD(0, VB); VRD(1, VB); VRD(2, VB); VRD(3, VB); VRD(4, VB); \
    { const float rm = rowmax32(C0, C1); resc = false; \
      if (__builtin_expect(__any(rm > THRL), 0)) { const float dl = __builtin_fmaxf(rm, 0.f); mhat += dl; \
        _Pragma("unroll") for (int r = 0; r < 16; ++r) { C0[r] -= dl; C1[r] -= dl; } \
        const float f = EX(-dl); l_reg *= f; if (hi == 0) wsf[r32] = f; resc = true; } } \
    SBAR(); \
    GAPB(0, C0, 0, VB, KN, PRE);  GAPB(1, C0, 2, VB, KN, PRE);  GAPB(2, C0, 4, VB, KN, PRE);   GAPB(3, C0, 6, VB, KN, PRE); \
    GAPB(4, C0, 8, VB, KN, PRE);  GAPB(5, C0, 10, VB, KN, PRE); GAPB(6, C0, 12, VB, KN, PRE);  GAPB(7, C0, 14, VB, KN, PRE); \
    GAPB(8, C1, 0, VB, KN, PRE);  GAPB(9, C1, 2, VB, KN, PRE);  GAPB(10, C1, 4, VB, KN, PRE);  GAPB(11, C1, 6, VB, KN, PRE); \
    GAPB(12, C1, 8, VB, KN, PRE); GAPB(13, C1, 10, VB, KN, PRE); GAPB(14, C1, 12, VB, KN, PRE); GAPB(15, C1, 14, VB, KN, PRE); \
    } while (0)
#define RESC() do { if (resc) { asm volatile("s_waitcnt lgkmcnt(0)" ::: "memory"); \
    _Pragma("unroll") for (int d = 0; d < 4; ++d) _Pragma("unroll") for (int r = 0; r < 16; ++r) o[d][r] *= wsf[crow(r, hi)]; } } while (0)
    int ks_cur = 8192, ks_n1 = 16384, ks_n3 = 0;
    int vs_prev = 0, vs_next = 32768;
#define ROT() do { ks_cur = (ks_cur + 8192) & 24576; ks_n1 = (ks_n1 + 8192) & 24576; ks_n3 = (ks_n3 + 8192) & 24576; vs_prev = vs_prev == 32768 ? 0 : vs_prev + 16384; vs_next = vs_next == 32768 ? 0 : vs_next + 16384; } while (0)
#define STEPX(C0, C1, P0, P1, t, PRE) STEP(C0, C1, P0, P1, t, ks_cur, vs_prev, ks_n1, PRE)
#pragma unroll 1
    for (int t = 1; t + 4 < NT; t += 2) {
        DMA_K(t + 3, ks_n3); DMA_V(t + 1, vs_next);
        STEPX(pB0, pB1, pA0, pA1, t, true);
        WAIT_BAR(3); RESC(); ROT();
        DMA_K(t + 4, ks_n3); DMA_V(t + 2, vs_next);
        STEPX(pA0, pA1, pB0, pB1, t + 1, true);
        WAIT_BAR(3); RESC(); ROT();
    }
    DMA_V(NT - 2, vs_next);
    STEPX(pB0, pB1, pA0, pA1, NT - 3, true);
    WAIT_BAR(2); RESC(); ROT();
    DMA_V(NT - 1, vs_next);
    STEPX(pA0, pA1, pB0, pB1, NT - 2, true);
    WAIT_BAR(2); RESC(); ROT();
    STEPX(pB0, pB1, pA0, pA1, NT - 1, false);
    WAIT_BAR(0); RESC(); ROT();
    { float sacc = 0.f;
#pragma unroll
      for (int r = 0; r < 16; ++r) sacc += pB0[r];
#pragma unroll
      for (int r = 0; r < 16; ++r) sacc += pB1[r];
      l_reg += sacc;
      pw0 = (u32x4){PKW(pB0, 0), PKW(pB0, 2), PKW(pB0, 4), PKW(pB0, 6)}; pw1 = (u32x4){PKW(pB0, 8), PKW(pB0, 10), PKW(pB0, 12), PKW(pB0, 14)};
      pw2 = (u32x4){PKW(pB1, 0), PKW(pB1, 2), PKW(pB1, 4), PKW(pB1, 6)}; pw3 = (u32x4){PKW(pB1, 8), PKW(pB1, 10), PKW(pB1, 12), PKW(pB1, 14)};
      SBAR();
#define DRAIN(i) do { VRD(i, vs_prev); o[(i) & 3] = MFMA32(PAF_SEL(i), VFR(i), o[(i) & 3]); } while (0)
      DRAIN(0); DRAIN(1); DRAIN(2); DRAIN(3); DRAIN(4); DRAIN(5); DRAIN(6); DRAIN(7); DRAIN(8); DRAIN(9); DRAIN(10); DRAIN(11); DRAIN(12); DRAIN(13); DRAIN(14); DRAIN(15);
#undef DRAIN
    }
    { auto rr = __builtin_amdgcn_permlane32_swap(__float_as_uint(l_reg), __float_as_uint(l_reg), false, false); l_out = __uint_as_float(rr[0]) + __uint_as_float(rr[1]); }
#undef DMA_K
#undef DMA_V
#undef WAIT_BAR
#undef ROT
#undef KRD
#undef PKW
#undef PAF
#undef VFR
#undef VRD
#undef GAPA
#undef GAPB
#undef PAF_SEL
#undef STEP
#undef STEPX
#undef RESC
}

__device__ __forceinline__ void diff_unit(int b, int h, int qb, const bf16_t* P, bf16_t* O, LAS char* lds, float lam, const float* relb) {
    const int tid = threadIdx.x, wid = __builtin_amdgcn_readfirstlane(tid >> 6), lane = tid & 63, r32 = lane & 31, hi = lane >> 5;
    const long rowbase = (long)b * SEQ; const int q0 = qb * 256, qa = q0 + wid * 32;
    LAS float* tb = (LAS float*)(lds + D_TB);
    LAS float* li_l = (LAS float*)(lds + D_WS) + wid * 64;
    tb[tid] = relb[rel_bucket(tid - 256) * NBH + h] * LOG2E;
    const float cL = relb[15 * NBH + h] * LOG2E, cR = relb[31 * NBH + h] * LOG2E;
    const bf16_t* Qrow = P + (rowbase + qa + r32) * PITCH + C_DQ + h * 128 + hi * 8;
    const bf16_t* Kh = P + rowbase * PITCH + C_DK + h * 128;
    const bf16_t* Vh = P + rowbase * PITCH + C_DV + h * 128;
    LAS u32x4* stash = (LAS u32x4*)(lds + D_ST + wid * 8192);
    f32x16 o[4]; float l_reg;
#pragma unroll 1
    for (int pass = 0; pass < 2; ++pass) {
        const int mo = pass == 0 ? 64 : 0;
        diff_pass(o, l_reg, Qrow + mo, Kh + mo, Vh, lds, qa, cL, cR);
        int ln = lane; asm volatile("" : "+v"(ln));
        const int r32e = ln & 31, hie = ln >> 5;
        if (hie == 0) li_l[r32e] = l_reg; asm volatile("s_waitcnt lgkmcnt(0)" ::: "memory");
        if (pass == 0) {
            float rli[16];
#pragma unroll
            for (int r = 0; r < 16; ++r) rli[r] = -lam * __builtin_amdgcn_rcpf(li_l[crow(r, hie)]);
#pragma unroll
            for (int d0 = 0; d0 < 4; ++d0) {
                u32x4 w0, w1;
                w0.x = cvtpk(o[d0][0] * rli[0], o[d0][1] * rli[1]); w0.y = cvtpk(o[d0][2] * rli[2], o[d0][3] * rli[3]); w0.z = cvtpk(o[d0][4] * rli[4], o[d0][5] * rli[5]); w0.w = cvtpk(o[d0][6] * rli[6], o[d0][7] * rli[7]);
                w1.x = cvtpk(o[d0][8] * rli[8], o[d0][9] * rli[9]); w1.y = cvtpk(o[d0][10] * rli[10], o[d0][11] * rli[11]); w1.z = cvtpk(o[d0][12] * rli[12], o[d0][13] * rli[13]); w1.w = cvtpk(o[d0][14] * rli[14], o[d0][15] * rli[15]);
                stash[(2 * d0) * 64 + ln] = w0; stash[(2 * d0 + 1) * 64 + ln] = w1;
            }
        } else {
            float rli[16], ssq[16];
#pragma unroll
            for (int r = 0; r < 16; ++r) { rli[r] = __builtin_amdgcn_rcpf(li_l[crow(r, hie)]); ssq[r] = 0.f; }
#pragma unroll
            for (int d0 = 0; d0 < 4; ++d0) {
                const u32x4 w0 = stash[(2 * d0) * 64 + ln], w1 = stash[(2 * d0 + 1) * 64 + ln];
                const unsigned ww[8] = {w0.x, w0.y, w0.z, w0.w, w1.x, w1.y, w1.z, w1.w};
#pragma unroll
                for (int r = 0; r < 16; ++r) { const float c = __uint_as_float((r & 1) ? (ww[r >> 1] & 0xffff0000u) : (ww[r >> 1] << 16));
                    const float x = fmaf(o[d0][r], rli[r], c); o[d0][r] = x; ssq[r] = fmaf(x, x, ssq[r]); }
            }
            asm volatile("s_waitcnt lgkmcnt(0)" ::: "memory");
#pragma unroll
            for (int r = 0; r < 16; ++r) { float s = ssq[r];
                s += __shfl_xor(s, 1); s += __shfl_xor(s, 2); s += __shfl_xor(s, 4); s += __shfl_xor(s, 8); s += __shfl_xor(s, 16);
                ssq[r] = __builtin_amdgcn_rsqf(s * (1.0f / 128.0f) + EPS); }
            LAS bf16_t* stg = (LAS bf16_t*)(lds + D_ST + wid * 8192);
#pragma unroll
            for (int r = 0; r < 16; ++r) { const int orow = crow(r, hie);
#pragma unroll
                for (int d0 = 0; d0 < 4; ++d0) stg[orow * 128 + d0 * 32 + r32e] = (bf16_t)(cvtpk(o[d0][r] * ssq[r], 0.f) & 0xffffu); }
            asm volatile("s_waitcnt lgkmcnt(0)" ::: "memory");
            bf16_t* Ow = O + (rowbase + qa + (ln >> 4)) * DM + h * 128 + (ln & 15) * 8;
            const LAS bf16_t* sl = stg + (ln >> 4) * 128 + (ln & 15) * 8;
#pragma unroll
            for (int i = 0; i < 8; ++i) { const u32x4 v = *(const LAS u32x4*)(sl + i * 512); *(u32x4*)(Ow + (long)i * 4 * DM) = v; }
        }
    }
    asm volatile("s_waitcnt lgkmcnt(0)" ::: "memory"); __syncthreads();
}

constexpr int W_K = 0, W_V = 49152, W_TB = 98304, W_WS = 106496, W_OST = 108544, W_END = W_OST + 32768;
__device__ __forceinline__ void win_unit(int b, int kvh, int qb, const bf16_t* P, bf16_t* O, LAS char* lds, const float* relb, const float* sink) {
    const int tid = threadIdx.x, wid = __builtin_amdgcn_readfirstlane(tid >> 6), lane = tid & 63, r32 = lane & 31, hi = lane >> 5;
    const long rowbase = (long)b * SEQ; const int q0 = qb * 128, kbase = q0 - 128;
    LAS float* tbw = (LAS float*)(lds + W_TB);
#pragma unroll
    for (int e = 0; e < 4; ++e) { const int idx = tid + e * 512, g = idx >> 9, rel = (idx & 511) - 256;
        tbw[idx] = (rel >= -128 && rel <= 128) ? (relb[rel_bucket(rel) * NBH + 4 + 4 * kvh + g] - sink[4 * kvh + g]) * LOG2E : -1e30f; }
    { int tl = tid; asm volatile("" : "+v"(tl));
      const int kr = tl >> 3, kc = (tl & 7) * 8, kst = KSW(kr, kc * 2), vst = v_st<2>(kr, kc);
      const bf16_t* Kh = P + rowbase * PITCH + C_WK + kvh * 64; const bf16_t* Vh = P + rowbase * PITCH + C_WV + kvh * 64;
      bf16x8 kreg[6], vreg[6];
#pragma unroll
      for (int t = 0; t < 6; ++t) { const int k0 = kbase + 64 * t; if (k0 >= 0 && k0 < SEQ) { kreg[t] = *(const bf16x8*)(&Kh[(long)(k0 + kr) * PITCH + kc]); vreg[t] = *(const bf16x8*)(&Vh[(long)(k0 + kr) * PITCH + kc]); } }
#pragma unroll
      for (int t = 0; t < 6; ++t) { const int k0 = kbase + 64 * t; if (k0 >= 0 && k0 < SEQ) { *(LAS bf16x8*)(lds + W_K + t * 8192 + kst) = kreg[t]; *(LAS bf16x8*)(lds + W_V + t * 8192 + vst) = vreg[t]; } }
    }
    __syncthreads();
    const int g = wid >> 1, hq = 4 * kvh + g;
    LAS float* li_l = (LAS float*)(lds + W_WS) + wid * 64;
    const LAS float* tbg = tbw + g * 512;
    const int vbw = (int)(uintptr_t)(lds + W_V) + v_rd_base(lane);
#pragma unroll 1
    for (int jb = 0; jb < 2; ++jb) {
        const int ql = 64 * (wid & 1) + 32 * jb;
        const bf16_t* Qw = P + (rowbase + q0 + ql + r32) * PITCH + C_WQ + hq * 64 + hi * 8;
        bf16x8 qr[4];
#pragma unroll
        for (int d0 = 0; d0 < 4; ++d0) qr[d0] = *(const bf16x8*)(Qw + d0 * 16);
        float l_reg = 0.f;
        f32x16 o[2]; o[0] = f32x16{}; o[1] = f32x16{};
        const int t_lo = ql >> 6;
#pragma unroll 1
        for (int t = t_lo; t < t_lo + 5; ++t) {
            const int k0 = kbase + 64 * t; if (k0 < 0 || k0 >= SEQ) continue;
            const int d_ = 64 * t - 128 - ql;
            const LAS float* t_ = tbg + (d_ + 256 + 4 * hi - r32);
            f32x16 p0, p1;
#pragma unroll
            for (int r = 0; r < 16; ++r) { p0[r] = t_[(r & 3) + 8 * (r >> 2)]; p1[r] = t_[32 + (r & 3) + 8 * (r >> 2)]; }
            qkt64(p0, p1, lds + W_K + t * 8192, qr, r32, hi);
#pragma unroll
            for (int r = 0; r < 16; ++r) { p0[r] = __builtin_amdgcn_exp2f(p0[r]); p1[r] = __builtin_amdgcn_exp2f(p1[r]); }
            bf16x8 pa0, pa1, pa2, pa3;
            {
                float ps = 0;
#pragma unroll
                for (int r = 0; r < 16; ++r) ps += p0[r];
#pragma unroll
                for (int r = 0; r < 16; ++r) ps += p1[r];
                l_reg += ps;
#define PK4(Pv, BASE, OUT) do { unsigned a0 = cvtpk(Pv[BASE + 0], Pv[BASE + 1]), a1 = cvtpk(Pv[BASE + 2], Pv[BASE + 3]);   \
    unsigned b0 = cvtpk(Pv[BASE + 4], Pv[BASE + 5]), b1 = cvtpk(Pv[BASE + 6], Pv[BASE + 7]);                              \
    auto r0 = __builtin_amdgcn_permlane32_swap(a0, b0, false, false); auto r1 = __builtin_amdgcn_permlane32_swap(a1, b1, false, false); \
    u32x4 w = {r0[0], r1[0], r0[1], r1[1]}; OUT = __builtin_bit_cast(bf16x8, w); } while (0)
                PK4(p0, 0, pa0); PK4(p0, 8, pa1); PK4(p1, 0, pa2); PK4(p1, 8, pa3);
#undef PK4
            }
            const int vb = vbw + t * 8192;
            pv_one<2, 0>(o[0], vb, pa0, pa1, pa2, pa3); pv_one<2, 1>(o[1], vb, pa0, pa1, pa2, pa3);
        }
        { auto rr = __builtin_amdgcn_permlane32_swap(__float_as_uint(l_reg), __float_as_uint(l_reg), false, false); l_reg = 1.0f + __uint_as_float(rr[0]) + __uint_as_float(rr[1]); }
        int ln = lane; asm volatile("" : "+v"(ln));
        const int r32e = ln & 31, hie = ln >> 5;
        if (hie == 0) li_l[r32e] = l_reg; asm volatile("s_waitcnt lgkmcnt(0)" ::: "memory");
        float rli[16];
#pragma unroll
        for (int r = 0; r < 16; ++r) rli[r] = __builtin_amdgcn_rcpf(li_l[crow(r, hie)]);
        LAS bf16_t* stg = (LAS bf16_t*)(lds + W_OST + wid * 4096);
#pragma unroll
        for (int r = 0; r < 16; ++r) { const int orow = crow(r, hie);
#pragma unroll
            for (int d0 = 0; d0 < 2; ++d0) stg[orow * 64 + d0 * 32 + r32e] = (bf16_t)(cvtpk(o[d0][r] * rli[r], 0.f) & 0xffffu); }
        asm volatile("s_waitcnt lgkmcnt(0)" ::: "memory");
        bf16_t* Ow = O + (rowbase + q0 + ql + (ln >> 3)) * DM + 512 + hq * 64 + (ln & 7) * 8;
        const LAS bf16_t* sl = stg + (ln >> 3) * 64 + (ln & 7) * 8;
#pragma unroll
        for (int i = 0; i < 4; ++i) { const u32x4 v = *(const LAS u32x4*)(sl + i * 512); *(u32x4*)(Ow + (long)i * 8 * DM) = v; }
        asm volatile("s_waitcnt lgkmcnt(0)" ::: "memory");
    }
    asm volatile("s_waitcnt lgkmcnt(0)" ::: "memory"); __syncthreads();
}
#undef SBAR
#undef KSW
}

constexpr size_t MiB = 1u << 20;
constexpr size_t WS_CTL = 0, CTL_ZERO_BYTES = 64 * 1024;
constexpr size_t WS_W1 = 1 * MiB;
constexpr size_t WS_W2 = WS_W1 + (size_t)DIN * DM * 2;
constexpr size_t WS_W3 = WS_W2 + (size_t)DM * DM * 2;
constexpr size_t WS_W4 = WS_W3 + (size_t)2 * DFF * DM * 2;
constexpr size_t WS_XS = 24 * MiB;
constexpr int CW_WMAX4 = 5120;
constexpr int CW_P3CNT = 4480;
constexpr size_t WS_FA = 26 * MiB;
constexpr size_t WS_FX = 26 * MiB + 512 * 1024;
constexpr int CW_WMAX1 = 13824, CW_W1CNT = 16200;
constexpr int CW_WMAX = 8192;
constexpr size_t WS_PROJ = 28 * MiB;
constexpr size_t WS_OB = 244 * MiB;
constexpr size_t WS_XQ = 340 * MiB;
constexpr size_t WS_X1Q = 340 * MiB;
constexpr size_t WS_X1B = 388 * MiB;
constexpr size_t WS_ACT = 28 * MiB;
constexpr size_t WS_END = WS_X1B + (size_t)NTOK * DM * 2;
static_assert(WS_W4 + (size_t)DM * DFF * 2 <= WS_XS && WS_XS + (size_t)NTOK * 32 <= WS_FA && WS_FA + (size_t)NTOK * 4 <= WS_FX && WS_FX + (size_t)NTOK * 4 <= WS_PROJ, "d_ws map");
static_assert(WS_PROJ + (size_t)NTOK * DIN * 2 <= WS_OB && WS_OB + (size_t)NTOK * DM * 2 <= WS_XQ && WS_XQ + (size_t)NTOK * DM <= WS_X1B && WS_ACT + (size_t)NTOK * DFF * 2 <= WS_X1Q - 4096, "d_ws map");
static_assert(CW_WMAX + 2 * DFF <= CW_WMAX1 && CW_WMAX1 + DIN <= CW_W1CNT && CW_W1CNT * 4 < CTL_ZERO_BYTES && 1024 + 3456 <= CW_P3CNT && CW_P3CNT + 192 <= CW_WMAX4 && CW_WMAX4 + DM <= CW_WMAX, "d_ws map");
constexpr int CW_BAR = 1024, XCD_BAR_WORDS_C = 3456;

constexpr int RING_BYTES = 131072, EPX_OFF = RING_BYTES, LDS_BYTES = 163840, MISC_OFF = LDS_BYTES - 512;
static_assert(att::D_END <= MISC_OFF && att::W_END <= MISC_OFF && EPX_OFF + 22528 <= MISC_OFF, "LDS map");

typedef GAS unsigned gu32;
#define RLX_AGENT __ATOMIC_RELAXED, __HIP_MEMORY_SCOPE_AGENT
#define LDS_WAIT() asm volatile("s_waitcnt lgkmcnt(0)" ::: "memory")

#define XB_TMO      128
#define XB_XCNT(j)  (256  + 64 * (j))
#define XB_XSUB(j)  (1280 + 64 * (j))
#define XB_XGEN(j)  (2304 + 64 * (j))
#define XB_TOP      3328
#define XB_TOPGEN   3392
#define XCD_BAR_WORDS 3456
#define XB_SPIN_CAP (1u << 22)
__device__ __forceinline__ unsigned xb_ld(unsigned* p)              { return __hip_atomic_load(p, __ATOMIC_RELAXED, __HIP_MEMORY_SCOPE_AGENT); }
__device__ __forceinline__ unsigned xb_add(unsigned* p, unsigned v) { return __hip_atomic_fetch_add(p, v, __ATOMIC_RELAXED, __HIP_MEMORY_SCOPE_AGENT); }
__device__ __forceinline__ unsigned xb_xcc_id() { return (unsigned)__builtin_amdgcn_s_getreg((3 << 11) | 20) & 0xFu; }
#define XB_SPIN(cond, bar) do { unsigned _sp = 0; while (cond) { __builtin_amdgcn_s_sleep(1); \
    if ((++_sp & 255u) == 0u) { if (xb_ld(&(bar)[XB_TMO])) break; if (_sp > XB_SPIN_CAP) { atomicAdd(&(bar)[XB_TMO], 1u); break; } } } } while (0)
struct XcdBarrier { unsigned* bar; unsigned x; volatile LAS unsigned* st; };
__device__ __forceinline__ XcdBarrier xcd_barrier_post(unsigned* bar, volatile LAS unsigned* st) {
    XcdBarrier b; b.bar = bar; b.x = xb_xcc_id(); b.st = st;
    if (threadIdx.x == 0) (void)xb_add(&bar[XB_XCNT(b.x)], 1u);
    return b;
}
__device__ __forceinline__ void xcd_barrier_complete(unsigned* bar, unsigned x, unsigned& nloc, unsigned& nx) {
    const unsigned G = gridDim.x * gridDim.y * gridDim.z;
    unsigned sum, cnt, mine, sp = 0u;
    for (;;) {
        sum = 0u; cnt = 0u; mine = 0u;
#pragma unroll
        for (unsigned j = 0; j < 16; ++j) { const unsigned c = xb_ld(&bar[XB_XCNT(j)]); sum += c; cnt += (c > 0u) ? 1u : 0u; mine = (j == x) ? c : mine; }
        if (sum == G) break;
        __builtin_amdgcn_s_sleep(1);
        if ((++sp & 255u) == 0u) { if (xb_ld(&bar[XB_TMO])) break; if (sp > XB_SPIN_CAP) { atomicAdd(&bar[XB_TMO], 1u); break; } }
    }
    nloc = mine > 0u ? mine : 1u; nx = cnt > 0u ? cnt : 1u;
}
__device__ __forceinline__ void xcd_barrier(const XcdBarrier& b) {
    asm volatile("s_waitcnt vmcnt(0)" ::: "memory");
    __syncthreads();
    if (threadIdx.x == 0) {
        unsigned* bar = b.bar;
        __builtin_amdgcn_s_waitcnt(0);
        unsigned nloc = b.st[0], nx = b.st[1];
        if (nloc == 0u) { xcd_barrier_complete(bar, b.x, nloc, nx); b.st[0] = nloc; b.st[1] = nx; }
        const unsigned old = xb_add(&bar[XB_XSUB(b.x)], 1u);
        const unsigned gen = old / nloc;
        if (old + 1u == (gen + 1u) * nloc) {
            __builtin_amdgcn_fence(__ATOMIC_RELEASE, "agent");
            asm volatile("s_waitcnt vmcnt(0)" ::: "memory");
            const unsigned og = xb_add(&bar[XB_TOP], 1u);
            const unsigned tg = og / nx;
            if (og + 1u == (tg + 1u) * nx) xb_add(&bar[XB_TOPGEN], 1u);
            else XB_SPIN(xb_ld(&bar[XB_TOPGEN]) == tg, bar);
            __builtin_amdgcn_fence(__ATOMIC_ACQUIRE, "agent");
            xb_add(&bar[XB_XGEN(b.x)], 1u);
            asm volatile("s_waitcnt vmcnt(0)" ::: "memory");
        } else {
            XB_SPIN(xb_ld(&bar[XB_XGEN(b.x)]) == gen, bar);
            __builtin_amdgcn_fence(__ATOMIC_ACQUIRE, "agent");
            asm volatile("s_waitcnt vmcnt(0)" ::: "memory");
        }
    }
    __syncthreads();
}

__device__ __forceinline__ float wave_sum(float v) {
#pragma unroll
    for (int o = 1; o < 64; o <<= 1) v += __shfl_xor(v, o);
    return v;
}
__device__ __forceinline__ unsigned f2bf(float f) { unsigned u = __builtin_bit_cast(unsigned, f); return (u + 0x7fffu + ((u >> 16) & 1u)) >> 16; }
__device__ __forceinline__ unsigned pk2(float lo, float hi) { return f2bf(lo) | (f2bf(hi) << 16); }
__device__ __forceinline__ void transpose_item(const float* W, int ld, int cbase, int K, int k0, bf16_t* WT, int nrow0, const float* fold, int foldmask, float fscale, int foldlim, LAS float* scr, int lane) {
    float wv[32];
#pragma unroll
    for (int i = 0; i < 32; ++i) wv[i] = W[(size_t)(k0 + 2 * i + (lane >> 5)) * ld + cbase + (lane & 31)];
#pragma unroll
    for (int i = 0; i < 32; ++i) { const int kk = 2 * i + (lane >> 5), k = k0 + kk;
        float f = 1.f; if (fold != nullptr && k < foldlim) f = fold[k & foldmask] * fscale;
        scr[kk * 33 + (lane & 31)] = wv[i] * f; }
    LDS_WAIT(); asm volatile("" ::: "memory");
    const int c = lane & 7;
#pragma unroll
    for (int j = 0; j < 4; ++j) { const int n = (lane >> 3) + 8 * j; const LAS float* s = scr + (8 * c) * 33 + n;
        u32x4 o; o.x = pk2(s[0 * 33], s[1 * 33]); o.y = pk2(s[2 * 33], s[3 * 33]); o.z = pk2(s[4 * 33], s[5 * 33]); o.w = pk2(s[6 * 33], s[7 * 33]);
        *(u32x4*)(WT + (size_t)(nrow0 + n) * K + k0 + 8 * c) = o; }
    LDS_WAIT(); asm volatile("" ::: "memory");
}

__device__ __forceinline__ void absmax_item(const float* W, int ld, int cbase, int k0, unsigned* wmax, const float* fold, int lane) {
    float wv[32];
#pragma unroll
    for (int i = 0; i < 32; ++i) wv[i] = W[(size_t)(k0 + 2 * i + (lane >> 5)) * ld + cbase + (lane & 31)];
    float m = 0.f;
#pragma unroll
    for (int i = 0; i < 32; ++i) m = __builtin_fmaxf(m, __builtin_fabsf(wv[i] * (fold ? fold[k0 + 2 * i + (lane >> 5)] : 1.f)));
    m = __builtin_fmaxf(m, __shfl_xor(m, 32));
    if (lane < 32) (void)__hip_atomic_fetch_max(wmax + lane, __float_as_uint(m), __ATOMIC_RELAXED, __HIP_MEMORY_SCOPE_AGENT);
}
__device__ __forceinline__ void quant_item(const float* W, int ld, int cbase, int K, int k0, signed char* WQ, int nrow0, const float* fold, const unsigned* wmax, LAS float* scr, int lane) {
    float wv[32];
#pragma unroll
    for (int i = 0; i < 32; ++i) wv[i] = W[(size_t)(k0 + 2 * i + (lane >> 5)) * ld + cbase + (lane & 31)];
    const float am = __uint_as_float(__hip_atomic_load(wmax + (lane & 31), __ATOMIC_RELAXED, __HIP_MEMORY_SCOPE_AGENT)); const float inv = am > 0.f ? 127.0f / am : 0.f;
#pragma unroll
    for (int i = 0; i < 32; ++i) { const int kk = 2 * i + (lane >> 5); scr[kk * 33 + (lane & 31)] = wv[i] * fold[k0 + kk] * inv; }
    LDS_WAIT(); asm volatile("" ::: "memory");
    const int n = lane >> 1, c = lane & 1; const LAS float* sp = scr + (32 * c) * 33 + n;
    u32x4 o0, o1;
    o0.x = q4(sp[0 * 33], sp[1 * 33], sp[2 * 33], sp[3 * 33]);     o0.y = q4(sp[4 * 33], sp[5 * 33], sp[6 * 33], sp[7 * 33]);
    o0.z = q4(sp[8 * 33], sp[9 * 33], sp[10 * 33], sp[11 * 33]);   o0.w = q4(sp[12 * 33], sp[13 * 33], sp[14 * 33], sp[15 * 33]);
    o1.x = q4(sp[16 * 33], sp[17 * 33], sp[18 * 33], sp[19 * 33]); o1.y = q4(sp[20 * 33], sp[21 * 33], sp[22 * 33], sp[23 * 33]);
    o1.z = q4(sp[24 * 33], sp[25 * 33], sp[26 * 33], sp[27 * 33]); o1.w = q4(sp[28 * 33], sp[29 * 33], sp[30 * 33], sp[31 * 33]);
    u32x4* dst = (u32x4*)(WQ + (size_t)(nrow0 + n) * K + k0 + 32 * c);
    dst[0] = o0; dst[1] = o1;
    LDS_WAIT(); asm volatile("" ::: "memory");
}

__device__ __forceinline__ void quantf8_item(const float* W, int ld, int cbase, int K, int k0, unsigned char* WQ, int nrow0, const unsigned* wmax, LAS float* scr, int lane) {
    float wv[32];
#pragma unroll
    for (int i = 0; i < 32; ++i) wv[i] = W[(size_t)(k0 + 2 * i + (lane >> 5)) * ld + cbase + (lane & 31)];
    const float am = __uint_as_float(__hip_atomic_load(wmax + (lane & 31), __ATOMIC_RELAXED, __HIP_MEMORY_SCOPE_AGENT)); const float inv = am > 0.f ? W8_TOP / am : 0.f;
#pragma unroll
    for (int i = 0; i < 32; ++i) { const int kk = 2 * i + (lane >> 5); scr[kk * 33 + (lane & 31)] = wv[i] * inv; }
    LDS_WAIT(); asm volatile("" ::: "memory");
    const int n = lane >> 1, c = lane & 1; const LAS float* sp = scr + (32 * c) * 33 + n;
    u32x4 o0, o1;
    o0.x = f8x4(sp[0 * 33], sp[1 * 33], sp[2 * 33], sp[3 * 33]);     o0.y = f8x4(sp[4 * 33], sp[5 * 33], sp[6 * 33], sp[7 * 33]);
    o0.z = f8x4(sp[8 * 33], sp[9 * 33], sp[10 * 33], sp[11 * 33]);   o0.w = f8x4(sp[12 * 33], sp[13 * 33], sp[14 * 33], sp[15 * 33]);
    o1.x = f8x4(sp[16 * 33], sp[17 * 33], sp[18 * 33], sp[19 * 33]); o1.y = f8x4(sp[20 * 33], sp[21 * 33], sp[22 * 33], sp[23 * 33]);
    o1.z = f8x4(sp[24 * 33], sp[25 * 33], sp[26 * 33], sp[27 * 33]); o1.w = f8x4(sp[28 * 33], sp[29 * 33], sp[30 * 33], sp[31 * 33]);
    u32x4* dst = (u32x4*)(WQ + (size_t)(nrow0 + n) * K + k0 + 32 * c);
    dst[0] = o0; dst[1] = o1;
    LDS_WAIT(); asm volatile("" ::: "memory");
}

struct Args { const float* in[22]; float* out; unsigned char* ws; int ph_lo, ph_hi, li, pad; };

__global__ void __launch_bounds__(NWAVES * 64, 2) hymba_fwd(Args args) {
    extern __shared__ __attribute__((aligned(16))) unsigned char lds_raw[];
    LAS unsigned char* lds = (LAS unsigned char*)lds_raw;
    volatile LAS unsigned* MISC = (volatile LAS unsigned*)(lds + MISC_OFF);
    const int tid = threadIdx.x, lane = tid & 63, wave = __builtin_amdgcn_readfirstlane(tid >> 6);
    const int G = gridDim.x; const int bx = blockIdx.x; const int vcu = (G % 8 == 0) ? (bx % 8) * (G / 8) + bx / 8 : bx;
    unsigned char* ws = args.ws;
    unsigned* ctl = (unsigned*)(ws + WS_CTL);
    const float* xp = args.in[0]; const float* xs = args.in[1];
    bf16_t* W1 = (bf16_t*)(ws + WS_W1); bf16_t* W2 = (bf16_t*)(ws + WS_W2); bf16_t* W3 = (bf16_t*)(ws + WS_W3); bf16_t* W4 = (bf16_t*)(ws + WS_W4);
    bf16_t* PROJ = (bf16_t*)(ws + WS_PROJ); bf16_t* X1B = (bf16_t*)(ws + WS_X1B); bf16_t* ACT = (bf16_t*)(ws + WS_ACT);
    bf16_t* OB = (bf16_t*)(ws + WS_OB);
    signed char* XQ = (signed char*)(ws + WS_XQ); float* FX = (float*)(ws + WS_FX); signed char* W1Q = (signed char*)(ws + WS_W1);
    for (int u = tid; u < 128; u += NWAVES * 64) ((LAS unsigned*)(lds + MISC_OFF))[u] = 0u;
    __syncthreads();
    XcdBarrier bar; bar.bar = ctl + CW_BAR + args.li * XCD_BAR_WORDS; bar.x = 0; bar.st = nullptr;
    if (MK_N_LAUNCHES != 6) bar = xcd_barrier_post(ctl + CW_BAR + args.li * XCD_BAR_WORDS, MISC + 8);
    const int lo = args.ph_lo, hi_ph = args.ph_hi;
#ifndef ONLY_PHASE
#define ONLY_PHASE -1
#endif
#define IN(k) ((ONLY_PHASE < 0 || ONLY_PHASE == (k)) && lo <= (k) && (k) < hi_ph)
#define BOTH(k) (IN(k) && IN((k) + 1))
#define GRID_BAR() do { if (MK_N_LAUNCHES != 6) xcd_barrier(bar); } while (0)

    if (IN(0)) {
        LAS float* scr = (LAS float*)(lds + wave * 16384);
        const int gw = vcu * NWAVES + wave, NGW = G * NWAVES;
        constexpr int I1 = (DM / 64) * (DIN / 32), I2 = (DM / 64) * (DM / 32), I3 = (DM / 64) * (2 * DFF / 32), I4 = (DFF / 64) * (DM / 32);
        for (int it = gw; it < I1 + I2 + I3 + I4; it += NGW) {
            int r = it;
            if (r < I1) { const int nblk = DIN / 32, kb = r / nblk, nb = r % nblk, n0 = 32 * nb, pn = n0 >> 8, p = n0 & 255, bj = p >> 7, wc = (p & 127) >> 5;
                absmax_item(args.in[3], DIN, 256 * pn + 64 * wc + 32 * bj, 64 * kb, ctl + CW_WMAX1 + n0, args.in[2], lane);
                asm volatile("s_waitcnt vmcnt(0)" ::: "memory"); if (lane == 0) (void)__hip_atomic_fetch_add(ctl + CW_W1CNT, 1u, __ATOMIC_RELAXED, __HIP_MEMORY_SCOPE_AGENT); continue; } r -= I1;
            if (r < I2) { const int nblk = DM / 32, kb = r / nblk, nb = r % nblk;
                const int n0 = 32 * nb, pn = n0 >> 8, p = n0 & 255, bj = p >> 7, wc = (p & 127) >> 5;
                transpose_item(args.in[15], DM, 256 * pn + 64 * wc + 32 * bj, DM, 64 * kb, W2, n0, args.in[10], 127, 1.0f - LAM_INIT, 512, scr, lane); continue; } r -= I2;
            if (r < I3) { const int nblk = 2 * DFF / 32, kb = r / nblk, nb = r % nblk, n0 = 32 * nb, pn = n0 >> 8, p = n0 & 255, bj = p >> 7, e0 = p & 127;
                absmax_item(bj ? args.in[18] : args.in[17], DFF, 128 * pn + e0, 64 * kb, ctl + CW_WMAX + n0, args.in[16], lane); continue; } r -= I3;
            { const int nblk = DM / 32, kb = r / nblk, nb = r % nblk;
                absmax_item(args.in[21], DM, 32 * nb, 64 * kb, ctl + CW_WMAX4 + 32 * nb, nullptr, lane); }
        }
        for (int m = gw; m < NTOK; m += 4 * NGW) {
            f32x4 v[4][4]; float ss[4]; int mr[4];
#pragma unroll
            for (int q = 0; q < 4; ++q) { int mm = m + q * NGW; mr[q] = mm; if (mm >= NTOK) mm = m;
                const float* xr = mm < TOK_P ? xp + (size_t)mm * DM : xs + (size_t)(mm - TOK_P) * DM;
#pragma unroll
                for (int j = 0; j < 4; ++j) v[q][j] = __builtin_nontemporal_load((const f32x4*)xr + 64 * j + lane); }
#pragma unroll
            for (int q = 0; q < 4; ++q) { ss[q] = 0.f;
#pragma unroll
                for (int j = 0; j < 4; ++j) ss[q] += dot4(v[q][j]); }
#pragma unroll
            for (int o = 1; o < 64; o <<= 1) {
#pragma unroll
                for (int q = 0; q < 4; ++q) ss[q] += __shfl_xor(ss[q], o); }
            float am[4];
#pragma unroll
            for (int q = 0; q < 4; ++q) { float a = 0.f;
#pragma unroll
                for (int j = 0; j < 4; ++j) a = __builtin_fmaxf(__builtin_fmaxf(a, __builtin_fmaxf(__builtin_fabsf(v[q][j][0]), __builtin_fabsf(v[q][j][1]))), __builtin_fmaxf(__builtin_fabsf(v[q][j][2]), __builtin_fabsf(v[q][j][3])));
                am[q] = a; }
#pragma unroll
            for (int o = 1; o < 64; o <<= 1) {
#pragma unroll
                for (int q = 0; q < 4; ++q) am[q] = __builtin_fmaxf(am[q], __shfl_xor(am[q], o)); }
#pragma unroll
            for (int q = 0; q < 4; ++q) if (mr[q] < NTOK) { const float ms = ss[q] * (1.f / DM) + EPS; const float r = __builtin_amdgcn_rsqf(ms);
                { const float inv = am[q] > 0.f ? 127.0f / am[q] : 0.f;
                  unsigned* oq = (unsigned*)(XQ + (size_t)mr[q] * DM) + lane;
#pragma unroll
                  for (int j = 0; j < 4; ++j) oq[64 * j] = q4(v[q][j][0] * inv, v[q][j][1] * inv, v[q][j][2] * inv, v[q][j][3] * inv);
                  if (lane == 0) FX[mr[q]] = am[q] * r * (1.0f / 127.0f); }
            }
        }
        { unsigned sp = 0; while (__builtin_amdgcn_readfirstlane(__hip_atomic_load(ctl + CW_W1CNT, __ATOMIC_RELAXED, __HIP_MEMORY_SCOPE_AGENT)) < (unsigned)I1) { __builtin_amdgcn_s_sleep(2); if (++sp > (1u << 22)) break; }
          __builtin_amdgcn_fence(__ATOMIC_ACQUIRE, "agent"); }
        for (int r = gw; r < I1; r += NGW) { const int nblk = DIN / 32, kb = r / nblk, nb = r % nblk, n0 = 32 * nb, pn = n0 >> 8, p = n0 & 255, bj = p >> 7, wc = (p & 127) >> 5;
            quant_item(args.in[3], DIN, 256 * pn + 64 * wc + 32 * bj, DM, 64 * kb, W1Q, n0, args.in[2], ctl + CW_WMAX1 + n0, scr, lane); }
        if (BOTH(0)) GRID_BAR();
    }

    if (IN(1)) {
        pg8::Gemm g{(const bf16_t*)XQ, (const bf16_t*)W1Q, DM / 2, 256}; pg8::StaticOrder S; S.init(NTOK / 256, DIN / 256, G, bx);
        { LAS float* gl = (LAS float*)(lds + EPX_OFF);
          if (tid < 256) { const int v = tid >> 6, d = tid & 63; gl[tid] = (v == 0 ? args.in[4] : v == 1 ? args.in[5] : v == 2 ? args.in[11] : args.in[12])[d]; }
          LDS_WAIT(); __syncthreads(); }
        pg8::EpiProj E{PROJ, (const LAS float*)(lds + EPX_OFF), FX, (const float*)(ctl + CW_WMAX1)};
        pg8::gemm_phase<pg8::EpiProj, pg8::StaticOrder, true, true, 1>(lds, g, S, E);
        if (BOTH(1)) GRID_BAR();
    }

    if (IN(2)) {
        if (wave == 0) {
            const float a = args.in[6][lane] * args.in[7][lane], b2 = args.in[8][lane] * args.in[9][lane];
            const float sa = wave_sum(a), sb = wave_sum(b2);
            if (lane == 0) ((LAS float*)(lds + MISC_OFF))[16] = __expf(sa) - __expf(sb) + LAM_INIT;
        }
        LDS_WAIT(); __syncthreads();
        const float lam = ((const LAS float*)(lds + MISC_OFF))[16];
        const int per = (768 + G - 1) / G;
#ifndef NO_DIFF
        for (int i = 0; i < per; ++i) { const int u = vcu * per + i; if (u < 768) { const int bh = u >> 3, qb = u & 7;
            att::diff_unit(bh >> 2, bh & 3, qb, PROJ, OB, (LAS char*)lds, lam, args.in[14]); } }
#endif
#ifndef NO_WIN
        for (int i = 0; i < per; ++i) { const int u = vcu * per + i; if (u < 768) { const int bk = u >> 4, qb = u & 15;
            att::win_unit(bk >> 1, bk & 1, qb, PROJ, OB, (LAS char*)lds, args.in[14], args.in[13]); } }
#endif
        if (BOTH(2)) GRID_BAR();
    }

    if (IN(3)) {
        pg8::Gemm g{OB, W2, DM, 256}; pg8::StaticOrder S; S.init(NTOK / 256, DM / 256, G, bx);
        {
            LAS float* scr = (LAS float*)(lds + wave * 16384);
            const int gw = vcu * NWAVES + wave, NGW = G * NWAVES;
            constexpr int I3 = (DM / 64) * (2 * DFF / 32);
            for (int r = gw; r < I3; r += NGW) { const int nblk = 2 * DFF / 32, kb = r / nblk, nb = r % nblk, n0 = 32 * nb, pn = n0 >> 8, p = n0 & 255, bj = p >> 7, e0 = p & 127;
                quant_item(bj ? args.in[18] : args.in[17], DFF, 128 * pn + e0, DM, 64 * kb, (signed char*)(ws + WS_W3), n0, args.in[16], ctl + CW_WMAX + n0, scr, lane); }
            constexpr int I4 = (DFF / 64) * (DM / 32);
            for (int r = gw; r < I4; r += NGW) { const int nblk = DM / 32, kb = r / nblk, nb = r % nblk;
                quantf8_item(args.in[21], DM, 32 * nb, DFF, 64 * kb, (unsigned char*)(ws + WS_W4), 32 * nb, ctl + CW_WMAX4 + 32 * nb, scr, lane); }
            __syncthreads();
        }
        pg8::EpiOut E{xp, xs, X1B, (LAS float*)(lds + EPX_OFF), (signed char*)(ws + WS_X1Q), (float*)(ws + WS_FA), (float*)(ws + WS_XS), ctl + CW_P3CNT};
        pg8::gemm_phase<pg8::EpiOut, pg8::StaticOrder>(lds, g, S, E);
        if (BOTH(3)) GRID_BAR();
    }

    if (IN(4)) {
        signed char* W3Q = (signed char*)(ws + WS_W3); signed char* X1Q = (signed char*)(ws + WS_X1Q); float* FA = (float*)(ws + WS_FA);
        pg8::Gemm g{(const bf16_t*)(X1Q - DM), (const bf16_t*)W3Q, DM / 2, 254}; pg8::StaticOrder S; S.init(194, 2 * DFF / 256, G, bx);
        pg8::EpiFfn E{(unsigned char*)ACT, FA, (const float*)(ctl + CW_WMAX), args.in[19], args.in[20], (LAS float*)(lds + EPX_OFF)};
        pg8::gemm_phase<pg8::EpiFfn, pg8::StaticOrder, true, true, 1>(lds, g, S, E);
        if (BOTH(4)) GRID_BAR();
    }

    if (IN(5)) {
        pg8::Gemm g{ACT, W4, DFF / 2, 256}; pg8::StaticOrder S; S.init(NTOK / 256, DM / 256, G, bx, 1);
        pg8::EpiDown E{X1B, args.out, (const float*)(ctl + CW_WMAX4)};
        pg8::gemm_phase<pg8::EpiDown, pg8::StaticOrder, true, true, 2>(lds, g, S, E);
    }
#undef IN
#undef BOTH
#undef GRID_BAR
}

extern "C" void kernel_launch(void* const* d_in, const int* in_sizes, int n_in, void* d_out, int out_size, void* d_ws, size_t ws_size, hipStream_t stream) {
    static int grid = 0;
    if (grid == 0) {
        if (n_in != 22 || in_sizes[0] != TOK_P * DM || in_sizes[1] != (NTOK - TOK_P) * DM || out_size != NTOK * DM || ws_size < WS_END) {
            fprintf(stderr, "kernel_launch: shape mismatch (n_in %d, in0 %d, in1 %d, out %d, ws %zu; need ws >= %zu)\n", n_in, n_in > 0 ? in_sizes[0] : -1, n_in > 1 ? in_sizes[1] : -1, out_size, ws_size, (size_t)WS_END); grid = -1; return; }
        int dev = 0, cus = 0;
        if (hipGetDevice(&dev) != hipSuccess || hipDeviceGetAttribute(&cus, hipDeviceAttributeMultiprocessorCount, dev) != hipSuccess) { fprintf(stderr, "kernel_launch: device query failed\n"); grid = -1; return; }
        if (hipFuncSetAttribute((const void*)hymba_fwd, hipFuncAttributeMaxDynamicSharedMemorySize, LDS_BYTES) != hipSuccess) { fprintf(stderr, "kernel_launch: hipFuncSetAttribute failed\n"); grid = -1; return; }
        int per_cu = 0;
        if (hipOccupancyMaxActiveBlocksPerMultiprocessor(&per_cu, (const void*)hymba_fwd, NWAVES * 64, LDS_BYTES) != hipSuccess || per_cu < 1)
            fprintf(stderr, "kernel_launch: note: occupancy query reports %d workgroups per CU\n", per_cu);
        (void)hipGetLastError();
        if (cus < 256) { fprintf(stderr, "kernel_launch: %d CUs; this kernel's unit schedule (co-running tile owners in the out-projection epilogue) is built for 256\n", cus); grid = -1; return; }
        grid = 256;
    }
    if (grid < 0) return;
    (void)hipMemsetAsync((char*)d_ws + WS_CTL, 0, CTL_ZERO_BYTES, stream);
    Args a{};
    for (int i = 0; i < 22; ++i) a.in[i] = (const float*)d_in[i];
    a.out = (float*)d_out; a.ws = (unsigned char*)d_ws;
#ifndef PROBE_DUP
#define PROBE_DUP -1
#endif
    constexpr int NL = (PROBE_DUP >= 0) ? 3 : MK_N_LAUNCHES;
    for (int li = 0; li < NL; ++li) {
        if (PROBE_DUP >= 0) {
            a.ph_lo = li == 0 ? 0 : (li == 1 ? PROBE_DUP : PROBE_DUP + 1); a.ph_hi = li == 2 ? 6 : PROBE_DUP + 1; a.li = li;
        } else { a.ph_lo = (NL == 6) ? li : 0; a.ph_hi = (NL == 6) ? li + 1 : 6; a.li = (NL == 6) ? 0 : li; }
        hipLaunchKernelGGL(hymba_fwd, dim3(grid), dim3(NWAVES * 64), LDS_BYTES, stream, a);
        const hipError_t le = hipPeekAtLastError();
        if (le != hipSuccess) { fprintf(stderr, "kernel_launch: launch %d failed: %s\n", li, hipGetErrorName(le)); break; }
    }
}
```

```cpp
#include <hip/hip_runtime.h>
#include <hip/hip_bf16.h>
#include <cstdio>
#include <cstdint>

#ifndef MK_N_LAUNCHES
#define MK_N_LAUNCHES 1
#endif

#define LAS __attribute__((address_space(3)))
#define GAS __attribute__((address_space(1)))
typedef unsigned short bf16_t;
typedef short bf16x8 __attribute__((ext_vector_type(8)));
typedef short s16x4 __attribute__((ext_vector_type(4)));
typedef float f32x2 __attribute__((ext_vector_type(2)));
typedef float f32x4 __attribute__((ext_vector_type(4)));
typedef float f32x16 __attribute__((ext_vector_type(16)));
typedef unsigned u32x2 __attribute__((ext_vector_type(2)));
typedef unsigned u32x4 __attribute__((ext_vector_type(4)));
typedef __bf16 bf16x2_t __attribute__((ext_vector_type(2)));

constexpr int DM = 1024, SEQ = 2048, NSEQ = 24, NTOK = NSEQ * SEQ, TOK_P = 8 * SEQ;
constexpr int DIN = 2304, DFF = 2816;
constexpr int C_DQ = 0, C_DK = 512, C_DV = 1024, C_WQ = 1536, C_WK = 2048, C_WV = 2176;
constexpr int NBH = 12;
constexpr float EPS = 1e-6f, LOG2E = 1.4426950408889634f, QSCALE = 0.125f * LOG2E;
constexpr float LAM_INIT = 0.2f;
constexpr int NWAVES = 8;

__device__ __forceinline__ unsigned cvtpk(float lo, float hi) { f32x2 v = {lo, hi}; bf16x2_t b = __builtin_convertvector(v, bf16x2_t); return __builtin_bit_cast(unsigned, b); }
__device__ __forceinline__ u32x4 pack8(f32x4 a, f32x4 b) { u32x4 w; w.x = cvtpk(a[0], a[1]); w.y = cvtpk(a[2], a[3]); w.z = cvtpk(b[0], b[1]); w.w = cvtpk(b[2], b[3]); return w; }
__device__ __forceinline__ float dot4(f32x4 a) { return (a[0] * a[0] + a[1] * a[1]) + (a[2] * a[2] + a[3] * a[3]); }

__device__ __forceinline__ unsigned q4(float a, float b, float c, float d) {
    const unsigned ua = __float_as_uint(a + 12582912.0f), ub = __float_as_uint(b + 12582912.0f), uc = __float_as_uint(c + 12582912.0f), ud = __float_as_uint(d + 12582912.0f);
    return (ua & 0xffu) | ((ub & 0xffu) << 8) | ((uc & 0xffu) << 16) | (ud << 24);
}
__device__ __forceinline__ unsigned f8x4(float a, float b, float c, float d) {
    int w = 0;
    w = __builtin_amdgcn_cvt_pk_fp8_f32(__builtin_amdgcn_fmed3f(a, -448.f, 448.f), __builtin_amdgcn_fmed3f(b, -448.f, 448.f), w, false);
    w = __builtin_amdgcn_cvt_pk_fp8_f32(__builtin_amdgcn_fmed3f(c, -448.f, 448.f), __builtin_amdgcn_fmed3f(d, -448.f, 448.f), w, true);
    return (unsigned)w;
}
constexpr float ACT8_SCALE = 8.0f, W8_TOP = 224.0f;
namespace pg8 {
constexpr int BM = 256, BK = 64, HALF = 128, HTB = HALF * BK * 2, STAGE_BYTES = 8 * HTB, NXCD = 8, WGM = 8;
__host__ __device__ __forceinline__ int lds_byte(int r, int c) { const int st = (r >> 4) * 2 + (c >> 5), rr = r & 15, cc = c & 31, ob = rr * 64 + cc * 2; return st * 1024 + (ob ^ (((ob >> 9) & 1) << 5)); }
__host__ __device__ __forceinline__ void stage_rc(int b, int& R, int& C) { const int st = b / 1024, sb = b % 1024, swz = sb ^ (((sb >> 9) & 1) << 5); R = (st >> 1) * 16 + swz / 64; C = (st & 1) * 32 + (swz % 64) / 2; }
__host__ __device__ __forceinline__ int perm32(int rho) { const int n = rho >> 4, i = rho & 15; return 8 * (i >> 2) + 4 * n + (i & 3); }

typedef int v4i32_t __attribute__((ext_vector_type(4)));
struct Unit { int pm, pn; };
struct Gemm { const bf16_t* A; const bf16_t* Bt; int K; int arows; };

struct StaticOrder {
    int nM, nN, nwg, G, c, rev;
    __device__ void init(int nM_, int nN_, int G_, int c_, int rev_ = 0) { nM = nM_; nN = nN_; nwg = nM * nN; G = G_; c = c_; rev = rev_; }
    __device__ bool next(int i, Unit& u) const {
        const int nr = (nwg - c + G - 1) / G; if (i >= nr) return false;
        const long L = (long)(rev ? nr - 1 - i : i) * G + c;
        int wgid = (int)L; { const int q = nwg / NXCD, r = nwg % NXCD, xcd = wgid % NXCD, off = wgid / NXCD; wgid = (xcd < r ? xcd * (q + 1) : r * (q + 1) + (xcd - r) * q) + off; }
        const int nig = WGM * nN, gid = wgid / nig, fm = gid * WGM, gsz = (nM - fm) < WGM ? (nM - fm) : WGM;
        u.pm = fm + ((wgid % nig) % gsz); u.pn = (wgid % nig) / gsz; return true;
    }
};


struct EpiProj {
    static constexpr bool PERM = true;
    bf16_t* P; const LAS float* gl; const float* fx; const float* swm;
    __device__ __forceinline__ void pre(const Unit& u, int wid, int lane_) const {
        int lane = lane_; asm volatile("" : "+v"(lane));
        if (wid >= 4) __builtin_amdgcn_global_load_lds((const unsigned*)(fx + u.pm * BM + 64 * (wid - 4) + lane), (LAS unsigned*)((LAS char*)gl + 1024 + (wid - 4) * 256), 4, 0, 0);
        if (wid == 2) __builtin_amdgcn_global_load_lds((const unsigned*)(swm + u.pn * 256 + lane * 4), (LAS unsigned*)((LAS char*)gl + 2048), 16, 0, 0);
    }
    __device__ __forceinline__ void operator()(const f32x4 (&acc)[2][2][4][2], const Unit& u, int wr, int wc, int fr, int fq, int lane) const {
        int fql = fq; asm volatile("" : "+v"(fql));
        f32x4 csw[2][2];
#pragma unroll
        for (int bj = 0; bj < 2; ++bj)
#pragma unroll
            for (int n = 0; n < 2; ++n) csw[bj][n] = *(const LAS f32x4*)(gl + 512 + 128 * bj + 32 * wc + 8 * fql + 4 * n) * (1.0f / 127.0f);
        const int gidx = u.pn * 4 + wc;
        int gsel = -1; float sc = 1.f;
        if (gidx < 8) { gsel = 0; sc = QSCALE; } else if (gidx < 16) { gsel = 1; } else if (gidx < 24) { } else if (gidx < 32) { gsel = 2; sc = QSCALE; } else if (gidx < 34) { gsel = 3; }
        const bool nrm = gsel >= 0; const LAS float* gain = gl + (nrm ? gsel : 0) * 64;
        f32x4 gv[2][2];
#pragma unroll
        for (int bj = 0; bj < 2; ++bj)
#pragma unroll
            for (int n = 0; n < 2; ++n) gv[bj][n] = nrm ? *(const LAS f32x4*)(gain + 32 * bj + 8 * fq + 4 * n) * sc : (f32x4){1.f, 1.f, 1.f, 1.f};
        bf16_t* base = P + (size_t)(u.pm * BM + wr * 64 + fr) * DIN + gidx * 64 + 8 * fq;
#pragma unroll
        for (int ai = 0; ai < 2; ++ai)
#pragma unroll
            for (int m = 0; m < 4; ++m) {
                const float fxr = gl[256 + ai * HALF + wr * 64 + m * 16 + fr];
                f32x4 v00 = __builtin_convertvector(__builtin_bit_cast(v4i32_t, acc[ai][0][m][0]), f32x4) * (csw[0][0] * fxr), v01 = __builtin_convertvector(__builtin_bit_cast(v4i32_t, acc[ai][0][m][1]), f32x4) * (csw[0][1] * fxr);
                f32x4 v10 = __builtin_convertvector(__builtin_bit_cast(v4i32_t, acc[ai][1][m][0]), f32x4) * (csw[1][0] * fxr), v11 = __builtin_convertvector(__builtin_bit_cast(v4i32_t, acc[ai][1][m][1]), f32x4) * (csw[1][1] * fxr);
                float rn = 1.f;
                if (nrm) { float ss = (dot4(v00) + dot4(v01)) + (dot4(v10) + dot4(v11)); ss += __shfl_xor(ss, 16); ss += __shfl_xor(ss, 32); rn = __builtin_amdgcn_rsqf(ss * (1.0f / 64.0f) + EPS); }
                v00 = v00 * rn * gv[0][0]; v01 = v01 * rn * gv[0][1]; v10 = v10 * rn * gv[1][0]; v11 = v11 * rn * gv[1][1];
                bf16_t* rowp = base + (size_t)(ai * HALF + m * 16) * DIN;
                const u32x4 pa = pack8(v00, v01), pb = pack8(v10, v11);
                u32x4 px; px.x = (unsigned)__builtin_amdgcn_mov_dpp((int)pb.x, 0x128, 0xf, 0xf, true); px.y = (unsigned)__builtin_amdgcn_mov_dpp((int)pb.y, 0x128, 0xf, 0xf, true);
                px.z = (unsigned)__builtin_amdgcn_mov_dpp((int)pb.z, 0x128, 0xf, 0xf, true); px.w = (unsigned)__builtin_amdgcn_mov_dpp((int)pb.w, 0x128, 0xf, 0xf, true);
                const bool hi8 = (fr & 8) != 0;
                bf16_t* r1p = base + (size_t)(ai * HALF + m * 16 - (hi8 ? 8 : 0)) * DIN + (hi8 ? 32 : 0);
                bf16_t* r2p = base + (size_t)(ai * HALF + m * 16 + (hi8 ? 0 : 8)) * DIN + (hi8 ? 0 : 32);
                *(u32x4*)(r1p) = hi8 ? px : pa; *(u32x4*)(r2p) = hi8 ? pa : px;
            }
    }
};

struct EpiOut {
    static constexpr bool PERM = true;
    const float* __restrict__ xp; const float* __restrict__ xsm; float* __restrict__ sx1; LAS float* xl;
    signed char* x1q; float* fa; float* xs; unsigned* cnt;
    __device__ __forceinline__ void pre(const Unit&, int, int) const {}
    __device__ __forceinline__ void operator()(f32x4 (&acc)[2][2][4][2], const Unit& u, int wr, int wc, int fr, int fq, int lane) const {
        asm volatile("" : "+v"(fr), "+v"(fq));
        const int rowbase = u.pm * BM;
        const int col0 = u.pn * BM + wc * 64 + 8 * fq;
        const float* xrow0 = rowbase < TOK_P ? xp + (size_t)rowbase * DM : xsm + (size_t)(rowbase - TOK_P) * DM;
#pragma unroll
        for (int ai = 0; ai < 2; ++ai) {
            f32x4 xv[4][2][2];
#pragma unroll
            for (int m = 0; m < 4; ++m) { const float* xr = xrow0 + (size_t)(ai * HALF + wr * 64 + m * 16 + fr) * DM + col0;
#pragma unroll
                for (int bj = 0; bj < 2; ++bj) { xv[m][bj][0] = *(const f32x4*)(xr + bj * 32); xv[m][bj][1] = *(const f32x4*)(xr + bj * 32 + 4); } }
#pragma unroll
            for (int m = 0; m < 4; ++m) {
                const int rl = ai * HALF + wr * 64 + m * 16 + fr; float s = 0.f, am = 0.f;
#pragma unroll
                for (int bj = 0; bj < 2; ++bj) {
                    const f32x4 o0 = xv[m][bj][0] + acc[ai][bj][m][0], o1 = xv[m][bj][1] + acc[ai][bj][m][1];
                    acc[ai][bj][m][0] = o0; acc[ai][bj][m][1] = o1;
#pragma unroll
                    for (int i = 0; i < 4; ++i) am = __builtin_fmaxf(am, __builtin_fmaxf(__builtin_fabsf(o0[i]), __builtin_fabsf(o1[i])));
                    s += dot4(o0) + dot4(o1); }
                s += __shfl_xor(s, 16); s += __shfl_xor(s, 32);
                am = __builtin_fmaxf(am, __shfl_xor(am, 16)); am = __builtin_fmaxf(am, __shfl_xor(am, 32));
                if (fq == 0) { xl[rl * 8 + wc] = s; xl[rl * 8 + 4 + wc] = am; }
            }
        }
        asm volatile("s_waitcnt lgkmcnt(0)" ::: "memory"); __builtin_amdgcn_s_barrier(); asm volatile("" ::: "memory");
        const int t = (wr * 4 + wc) * 64 + lane;
        if (t < 256) {
            const f32x4 q = *(const LAS f32x4*)(xl + t * 8), a4 = *(const LAS f32x4*)(xl + t * 8 + 4);
            float* sl = xs + ((size_t)(rowbase + t) * 4 + u.pn) * 2;
            __hip_atomic_store(sl, (q[0] + q[1]) + (q[2] + q[3]), __ATOMIC_RELAXED, __HIP_MEMORY_SCOPE_AGENT);
            __hip_atomic_store(sl + 1, __builtin_fmaxf(__builtin_fmaxf(a4[0], a4[1]), __builtin_fmaxf(a4[2], a4[3])), __ATOMIC_RELAXED, __HIP_MEMORY_SCOPE_AGENT);
            asm volatile("s_waitcnt vmcnt(0)" ::: "memory");
            if (lane == 0) (void)__hip_atomic_fetch_add(cnt + u.pm, 1u, __ATOMIC_RELAXED, __HIP_MEMORY_SCOPE_AGENT);
        }
        if (t < 64) {
            unsigned sp = 0; while (__builtin_amdgcn_readfirstlane(__hip_atomic_load(cnt + u.pm, __ATOMIC_RELAXED, __HIP_MEMORY_SCOPE_AGENT)) < 16u) { __builtin_amdgcn_s_sleep(1); if (++sp > (1u << 22)) break; }
        }
        asm volatile("s_waitcnt lgkmcnt(0)" ::: "memory"); __builtin_amdgcn_s_barrier(); asm volatile("" ::: "memory");
        if (t < 256) {
            const float* sl = xs + (size_t)(rowbase + t) * 8; float ss = 0.f, am = 0.f;
#pragma unroll
            for (int j = 0; j < 4; ++j) { ss += __hip_atomic_load(sl + 2 * j, __ATOMIC_RELAXED, __HIP_MEMORY_SCOPE_AGENT); am = __builtin_fmaxf(am, __hip_atomic_load(sl + 2 * j + 1, __ATOMIC_RELAXED, __HIP_MEMORY_SCOPE_AGENT)); }
            xl[2048 + t] = am > 0.f ? 127.0f / am : 0.f;
            if (u.pn == 0) { fa[rowbase + t] = __builtin_amdgcn_rsqf(ss * (1.0f / DM) + EPS) * am * (1.0f / 127.0f); sx1[rowbase + t] = am * (1.0f / 127.0f); }
        }
        asm volatile("s_waitcnt lgkmcnt(0)" ::: "memory"); __builtin_amdgcn_s_barrier(); asm volatile("" ::: "memory");
#pragma unroll
        for (int ai = 0; ai < 2; ++ai)
#pragma unroll
            for (int m = 0; m < 4; ++m) { const int rl = ai * HALF + wr * 64 + m * 16 + fr; const float inv = xl[2048 + rl];
                signed char* qp = x1q + (size_t)(rowbase + rl) * DM + col0;
#pragma unroll
                for (int bj = 0; bj < 2; ++bj) { const f32x4 b0 = acc[ai][bj][m][0] * inv, b1 = acc[ai][bj][m][1] * inv;
                    u32x2 o; o.x = q4(b0[0], b0[1], b0[2], b0[3]); o.y = q4(b1[0], b1[1], b1[2], b1[3]);
                    *(u32x2*)(qp + 32 * bj) = o; } }
    }
};

__device__ __forceinline__ float dpp8(float x) { return __builtin_bit_cast(float, __builtin_amdgcn_mov_dpp(__builtin_bit_cast(int, x), 0x128, 0xf, 0xf, true)); }
struct EpiDown {
    static constexpr bool PERM = true;
    const signed char* __restrict__ x1q; const float* __restrict__ sx1; float* __restrict__ out; const float* __restrict__ wmx;
    __device__ __forceinline__ void pre(const Unit&, int, int) const {}
    __device__ __forceinline__ void operator()(const f32x4 (&acc)[2][2][4][2], const Unit& u, int wr, int wc, int fr, int fq, int lane) const {
        asm volatile("" : "+v"(fr), "+v"(fq));
        const int col0 = u.pn * BM + wc * 32 + 8 * fq; const bool hi8 = (fr & 8) != 0;
        f32x4 cs[2][2];
#pragma unroll
        for (int bj = 0; bj < 2; ++bj)
#pragma unroll
            for (int n = 0; n < 2; ++n) cs[bj][n] = *(const f32x4*)(wmx + col0 + bj * HALF + 4 * n) * (1.0f / (W8_TOP * ACT8_SCALE));
#pragma unroll
        for (int ai = 0; ai < 2; ++ai) {
            u32x2 w[4][2]; float sx[4];
#pragma unroll
            for (int m = 0; m < 4; ++m) { const size_t row = (size_t)(u.pm * BM + ai * HALF + wr * 64 + m * 16 + fr); const size_t off = row * DM + col0;
                sx[m] = sx1[row];
#pragma unroll
                for (int bj = 0; bj < 2; ++bj) w[m][bj] = *(const u32x2*)(x1q + off + bj * HALF); }
#pragma unroll
            for (int m = 0; m < 4; ++m) { const size_t off = (size_t)(u.pm * BM + ai * HALF + wr * 64 + m * 16 + fr) * DM + col0;
#pragma unroll
                for (int bj = 0; bj < 2; ++bj) { const int wx = (int)w[m][bj].x, wy = (int)w[m][bj].y;
                    f32x4 r0, r1;
                    r0[0] = (float)((wx << 24) >> 24) * sx[m]; r0[1] = (float)((wx << 16) >> 24) * sx[m]; r0[2] = (float)((wx << 8) >> 24) * sx[m]; r0[3] = (float)(wx >> 24) * sx[m];
                    r1[0] = (float)((wy << 24) >> 24) * sx[m]; r1[1] = (float)((wy << 16) >> 24) * sx[m]; r1[2] = (float)((wy << 8) >> 24) * sx[m]; r1[3] = (float)(wy >> 24) * sx[m];
                    const f32x4 q0 = r0 + acc[ai][bj][m][0] * cs[bj][0], q1 = r1 + acc[ai][bj][m][1] * cs[bj][1];
                    f32x4 qx; qx[0] = dpp8(q1[0]); qx[1] = dpp8(q1[1]); qx[2] = dpp8(q1[2]); qx[3] = dpp8(q1[3]);
                    const long d1 = hi8 ? (long)(4 - 8 * DM) : 0, d2 = hi8 ? 0 : (long)(4 + 8 * DM);
                    *(f32x4*)(out + off + bj * HALF + d1) = hi8 ? qx : q0; *(f32x4*)(out + off + bj * HALF + d2) = hi8 ? q0 : qx; } } }
    }
};

template <int CTRL> __device__ __forceinline__ float dppz(float x) { return __builtin_bit_cast(float, __builtin_amdgcn_update_dpp(0, __builtin_bit_cast(int, x), CTRL, 0xf, 0xf, true)); }
struct EpiFfn {
    static constexpr bool PERM = true;
    unsigned char* act; const float* fa; const float* swm; const float* cw; const float* cb; LAS float* xl;
    __device__ __forceinline__ void pre(const Unit& u, int wid, int lane_) const {
        int lane = lane_; asm volatile("" : "+v"(lane));
        const int tok0 = 254 * u.pm - 1;
        if (wid >= 4) { int tok = tok0 + 64 * (wid - 4) + lane; tok = tok < 0 ? 0 : (tok > NTOK - 1 ? NTOK - 1 : tok);
            __builtin_amdgcn_global_load_lds((const unsigned*)(fa + tok), (LAS unsigned*)((LAS char*)xl + 4096 + (wid - 4) * 256), 4, 0, 0); }
        if (wid == 2) __builtin_amdgcn_global_load_lds((const unsigned*)(swm + u.pn * 256 + lane * 4), (LAS unsigned*)((LAS char*)xl + 5120), 16, 0, 0);
        if (wid < 2) { const float* src = (wid == 0 ? (lane < 32 ? cw : cw + DFF) : (lane < 32 ? cw + 2 * DFF : cb)) + u.pn * 128 + (lane & 31) * 4;
            __builtin_amdgcn_global_load_lds((const unsigned*)src, (LAS unsigned*)((LAS char*)xl + 20480 + wid * 1024), 16, 0, 0); }
    }
    template <int AI, int M, bool MASK>
    __device__ __forceinline__ void conv_rows(const f32x4 (&acc)[2][2][4][2], const f32x4 (&w0)[2], const f32x4 (&w1)[2], const f32x4 (&w2)[2], const f32x4 (&bb)[2],
                                              int tok, int rl, int G, int xc, int fr, int ch0) const {
        const bool pcut = MASK && (tok & (SEQ - 1)) == 0, ncut = MASK && (tok & (SEQ - 1)) == SEQ - 1;
        f32x4 r0, r1;
#pragma unroll
        for (int n = 0; n < 2; ++n) { f32x4 res;
            f32x4 ex = (f32x4){0.f, 0.f, 0.f, 0.f};
            if (M == 0) { if (G > 0) ex = *(const LAS f32x4*)(xl + (2 * (G - 1) + 1) * 128 + xc + 4 * n); ex = fr == 0 ? ex : (f32x4){0.f, 0.f, 0.f, 0.f}; }
            if (M == 3) { if (G < 3) ex = *(const LAS f32x4*)(xl + (2 * (G + 1)) * 128 + xc + 4 * n); ex = fr == 15 ? ex : (f32x4){0.f, 0.f, 0.f, 0.f}; }
#pragma unroll
            for (int i = 0; i < 4; ++i) {
                const float own = acc[AI][0][M][n][i];
                float pr = dppz<0x111>(own);
                pr += (M > 0) ? dppz<0x10F>(acc[AI][0][M > 0 ? M - 1 : 0][n][i]) : ex[i];
                float nx = dppz<0x101>(own);
                nx += (M < 3) ? dppz<0x11F>(acc[AI][0][M < 3 ? M + 1 : 3][n][i]) : ex[i];
                if (MASK) { pr = pcut ? 0.f : pr; nx = ncut ? 0.f : nx; }
                const float uc = fmaf(w0[n][i], pr, fmaf(w1[n][i], own, fmaf(w2[n][i], nx, bb[n][i])));
                const float sg = uc * __builtin_amdgcn_rcpf(1.0f + __builtin_amdgcn_exp2f(-LOG2E * uc));
                res[i] = sg * acc[AI][1][M][n][i] * ACT8_SCALE;
            }
            if (n == 0) r0 = res; else r1 = res; }
        if (rl != 0 && rl != 255 && tok < NTOK) { u32x2 o; o.x = f8x4(r0[0], r0[1], r0[2], r0[3]); o.y = f8x4(r1[0], r1[1], r1[2], r1[3]); *(u32x2*)(act + (size_t)tok * DFF + ch0) = o; }
    }
    __device__ __forceinline__ void operator()(f32x4 (&acc)[2][2][4][2], const Unit& u, int wr, int wc, int fr, int fq, int lane) const {
        const int ch0 = u.pn * 128 + wc * 32 + 8 * fq;
        const int tok0 = 254 * u.pm - 1;
        int fql = fq; asm volatile("" : "+v"(fql));
        const int xc = wc * 32 + 8 * fql;
        f32x4 su[2];
#pragma unroll
        for (int n = 0; n < 2; ++n) su[n] = *(const LAS f32x4*)(xl + 1280 + 128 + xc + 4 * n) * (1.0f / 127.0f);
#pragma unroll
        for (int ai = 0; ai < 2; ++ai)
#pragma unroll
            for (int m = 0; m < 4; ++m) { const float rs = xl[1024 + ai * HALF + wr * 64 + m * 16 + fr];
#pragma unroll
                for (int n = 0; n < 2; ++n) { const f32x4 rsu = su[n] * rs;
                    acc[ai][0][m][n] = __builtin_convertvector(__builtin_bit_cast(v4i32_t, acc[ai][0][m][n]), f32x4) * rs;
                    acc[ai][1][m][n] = __builtin_convertvector(__builtin_bit_cast(v4i32_t, acc[ai][1][m][n]), f32x4) * rsu; } }
#pragma unroll
        for (int ai = 0; ai < 2; ++ai) { const int G = 2 * ai + wr;
            if (fr == 0) { *(LAS f32x4*)(xl + (2 * G) * 128 + xc) = acc[ai][0][0][0]; *(LAS f32x4*)(xl + (2 * G) * 128 + xc + 4) = acc[ai][0][0][1]; }
            if (fr == 15) { *(LAS f32x4*)(xl + (2 * G + 1) * 128 + xc) = acc[ai][0][3][0]; *(LAS f32x4*)(xl + (2 * G + 1) * 128 + xc + 4) = acc[ai][0][3][1]; } }
        asm volatile("s_waitcnt lgkmcnt(0)" ::: "memory"); __builtin_amdgcn_s_barrier(); asm volatile("" ::: "memory"); __builtin_amdgcn_sched_barrier(0);
        f32x4 w0[2], w1[2], w2[2], bb[2];
#pragma unroll
        for (int n = 0; n < 2; ++n) { const LAS float* wl = xl + 5120 + xc + 4 * n; const f32x4 sgc = *(const LAS f32x4*)(xl + 1280 + xc + 4 * n) * (1.0f / 127.0f);
            w0[n] = *(const LAS f32x4*)(wl) * sgc; w1[n] = *(const LAS f32x4*)(wl + 128) * sgc; w2[n] = *(const LAS f32x4*)(wl + 256) * sgc; bb[n] = *(const LAS f32x4*)(wl + 384); }
#define FFN_ROWS(AI, M) do { const int tb_ = tok0 + AI * HALF + wr * 64 + M * 16; const int G_ = 2 * AI + wr; \
        conv_rows<AI, M, true>(acc, w0, w1, w2, bb, tb_ + fr, AI * HALF + wr * 64 + M * 16 + fr, G_, xc, fr, ch0); \
        if ((M) & 1) __builtin_amdgcn_sched_barrier(0); } while (0)
        FFN_ROWS(0, 0); FFN_ROWS(0, 1); FFN_ROWS(0, 2); FFN_ROWS(0, 3); FFN_ROWS(1, 0); FFN_ROWS(1, 1); FFN_ROWS(1, 2); FFN_ROWS(1, 3);
#undef FFN_ROWS
    }
};

typedef int v8i32_t __attribute__((ext_vector_type(8)));
template <class Epi, class Sched, bool ALIGN_EPI = true, bool SP2 = true, int QM = 0>
__device__ __forceinline__ void gemm_phase(LAS unsigned char* lds, const Gemm g, const Sched& S, const Epi& E) {
    const int tid = threadIdx.x, wid = __builtin_amdgcn_readfirstlane(tid >> 6), lane = tid & 63, wr = wid >> 2, wc = wid & 3, fr = lane & 15, fq = lane >> 4;
    const int K = g.K, nt = K / BK;
    unsigned voffA[2], voffB[2];
#pragma unroll
    for (int i = 0; i < 2; ++i) { int R, C; stage_rc(tid * 16 + i * 8192, R, C); const int Rb = Epi::PERM ? ((R & ~31) + perm32(R & 31)) : R;
        voffA[i] = (unsigned)(R * K + C) * 2u; voffB[i] = (unsigned)(Rb * K + C) * 2u; }
    const size_t kstep = (size_t)(BK * 2);
    const size_t hstep = (size_t)HALF * K * 2;
    const size_t tstepB = 2 * hstep;
    const size_t tstepA = (size_t)g.arows * K * 2;
    const unsigned ldsw = (unsigned)wid * 1024u;
    const int aoff = lds_byte(wr * 64 + fr, fq * 8), boff = lds_byte(wc * 32 + fr, fq * 8);
#define PG8_SA(b, h) (((b) * 2 + (h)) * HTB)
#define PG8_SB(b, h) ((4 + (b) * 2 + (h)) * HTB)
#define PG8_STAGE(bufoff, gbase, voff) do { _Pragma("unroll") for (int _i = 0; _i < 2; ++_i) \
        __builtin_amdgcn_global_load_lds((const unsigned*)((const char*)(gbase) + (voff)[_i]), (LAS unsigned*)(lds + (bufoff) + ldsw + _i * 8192), 16, 0, 0); } while (0)
#define PG8_LDA(dst, b, h) do { _Pragma("unroll") for (int m = 0; m < 4; ++m) _Pragma("unroll") for (int k = 0; k < 2; ++k) dst[m][k] = *(const LAS bf16x8*)(lds + PG8_SA(b, h) + aoff + m * 2048 + k * 1024); } while (0)
#define PG8_LDB(dst, b, h) do { _Pragma("unroll") for (int n = 0; n < 2; ++n) _Pragma("unroll") for (int k = 0; k < 2; ++k) dst[n][k] = *(const LAS bf16x8*)(lds + PG8_SB(b, h) + boff + n * 2048 + k * 1024); } while (0)
#define PG8_MMA(ai, bj, At, Bt) do { __builtin_amdgcn_s_setprio(1); \
    if constexpr (QM == 2) { _Pragma("unroll") for (int m = 0; m < 4; ++m) _Pragma("unroll") for (int n = 0; n < 2; ++n) { \
        const v8i32_t b8_ = __builtin_shufflevector(__builtin_bit_cast(v4i32_t, Bt[n][0]), __builtin_bit_cast(v4i32_t, Bt[n][1]), 0, 1, 2, 3, 4, 5, 6, 7), a8_ = __builtin_shufflevector(__builtin_bit_cast(v4i32_t, At[m][0]), __builtin_bit_cast(v4i32_t, At[m][1]), 0, 1, 2, 3, 4, 5, 6, 7); \
        asm volatile("v_mfma_scale_f32_16x16x128_f8f6f4 %0, %1, %2, %0, %3, %3 op_sel_hi:[0,0,0]" : "+v"(acc[ai][bj][m][n]) : "v"(b8_), "v"(a8_), "v"(one8)); } } \
    else _Pragma("unroll") for (int m = 0; m < 4; ++m) _Pragma("unroll") for (int n = 0; n < 2; ++n) _Pragma("unroll") for (int k = 0; k < 2; ++k) \
        { if constexpr (QM == 1) acc[ai][bj][m][n] = __builtin_bit_cast(f32x4, __builtin_amdgcn_mfma_i32_16x16x64_i8(__builtin_bit_cast(v4i32_t, Bt[n][k]), __builtin_bit_cast(v4i32_t, At[m][k]), __builtin_bit_cast(v4i32_t, acc[ai][bj][m][n]), 0, 0, 0)); \
          else acc[ai][bj][m][n] = __builtin_amdgcn_mfma_f32_16x16x32_bf16(Bt[n][k], At[m][k], acc[ai][bj][m][n], 0, 0, 0); } __builtin_amdgcn_s_setprio(0); } while (0)
#define PG8_WAIT_V(n) asm volatile("s_waitcnt vmcnt(" #n ")" ::: "memory")
#define PG8_WAIT_L(n) asm volatile("s_waitcnt lgkmcnt(" #n ")" ::: "memory")
#define PG8_BAR __builtin_amdgcn_s_barrier()
#define PG8_SCHED __builtin_amdgcn_sched_barrier(0)
    Unit cur, nxt; int ui = 0;
    if (!S.next(0, cur)) return;
    const int one8 = 0x7f7f7f7f;
    f32x4 acc[2][2][4][2];
#pragma unroll
    for (int a = 0; a < 2; ++a)
#pragma unroll
        for (int b = 0; b < 2; ++b)
#pragma unroll
            for (int m = 0; m < 4; ++m)
#pragma unroll
                for (int n = 0; n < 2; ++n) acc[a][b][m][n] = (f32x4){0.f, 0.f, 0.f, 0.f};
    bf16x8 At[4][2], B0[2][2], B1[2][2];
    const char* cA = (const char*)g.A + (size_t)cur.pm * tstepA; const char* cB = (const char*)g.Bt + (size_t)cur.pn * tstepB;
    if constexpr (SP2) {
        PG8_STAGE(PG8_SB(0, 0), cB, voffB); PG8_STAGE(PG8_SB(0, 1), cB + hstep, voffB); PG8_STAGE(PG8_SA(0, 0), cA, voffA); PG8_STAGE(PG8_SA(0, 1), cA + hstep, voffA);
        if (wr == 1) PG8_BAR;
        PG8_WAIT_V(2); PG8_BAR;
        PG8_STAGE(PG8_SB(1, 0), cB + kstep, voffB); PG8_STAGE(PG8_SA(1, 0), cA + kstep, voffA); PG8_STAGE(PG8_SB(1, 1), cB + hstep + kstep, voffB);
        PG8_WAIT_V(6); PG8_BAR;
    } else {
        PG8_STAGE(PG8_SB(0, 0), cB, voffB); PG8_STAGE(PG8_SA(0, 0), cA, voffA); PG8_STAGE(PG8_SB(0, 1), cB + hstep, voffB); PG8_STAGE(PG8_SA(0, 1), cA + hstep, voffA);
        if (wr == 1) PG8_BAR;
        PG8_WAIT_V(4); PG8_BAR;
        PG8_STAGE(PG8_SB(1, 0), cB + kstep, voffB); PG8_STAGE(PG8_SA(1, 0), cA + kstep, voffA); PG8_STAGE(PG8_SB(1, 1), cB + hstep + kstep, voffB);
        PG8_WAIT_V(6); PG8_BAR;
    }
    for (;;) {
        const bool has_next = S.next(ui + 1, nxt);
        const char* nA = has_next ? (const char*)g.A + (size_t)nxt.pm * tstepA : cA; const char* nB = has_next ? (const char*)g.Bt + (size_t)nxt.pn * tstepB : cB;
        for (int t = 0; t < nt; t += 2) {
            const bool last = (t == nt - 2);
            const char* a1 = cA + (size_t)(t + 1) * kstep;
            const char* a2 = last ? nA : cA + (size_t)(t + 2) * kstep; const char* b2 = last ? nB : cB + (size_t)(t + 2) * kstep;
            const char* a3 = a2 + kstep; const char* b3 = b2 + kstep;
            if (last) E.pre(cur, wid, lane);
            if constexpr (SP2) {
            PG8_LDB(B0, 0, 0); PG8_LDB(B1, 0, 1); PG8_SCHED; PG8_LDA(At, 0, 0); PG8_STAGE(PG8_SA(1, 1), a1 + hstep, voffA);
            PG8_WAIT_V(8); PG8_WAIT_L(0); PG8_BAR; PG8_MMA(0, 0, At, B0); PG8_MMA(0, 1, At, B1); PG8_BAR; PG8_SCHED;
            PG8_LDA(At, 0, 1); PG8_STAGE(PG8_SB(0, 0), b2, voffB); PG8_STAGE(PG8_SB(0, 1), b2 + hstep, voffB); PG8_STAGE(PG8_SA(0, 0), a2, voffA);
            PG8_WAIT_V(8); PG8_WAIT_L(0); PG8_BAR; PG8_MMA(1, 0, At, B0); PG8_MMA(1, 1, At, B1); PG8_BAR; PG8_SCHED;
            PG8_LDB(B0, 1, 0); PG8_LDB(B1, 1, 1); PG8_SCHED; PG8_LDA(At, 1, 0); PG8_STAGE(PG8_SA(0, 1), a2 + hstep, voffA);
            PG8_WAIT_V(8); PG8_WAIT_L(0); PG8_BAR; PG8_MMA(0, 0, At, B0); PG8_MMA(0, 1, At, B1); PG8_BAR; PG8_SCHED;
            PG8_LDA(At, 1, 1); PG8_STAGE(PG8_SB(1, 0), b3, voffB); PG8_STAGE(PG8_SB(1, 1), b3 + hstep, voffB); PG8_STAGE(PG8_SA(1, 0), a3, voffA);
            PG8_WAIT_V(8); PG8_WAIT_L(0); PG8_BAR; PG8_MMA(1, 0, At, B0); PG8_MMA(1, 1, At, B1); PG8_BAR; PG8_SCHED;
            } else {
            PG8_LDB(B0, 0, 0); PG8_SCHED; PG8_LDA(At, 0, 0); PG8_STAGE(PG8_SA(1, 1), a1 + hstep, voffA);
            PG8_WAIT_L(8); PG8_BAR; PG8_WAIT_L(0); PG8_MMA(0, 0, At, B0); PG8_BAR; PG8_SCHED;
            PG8_LDB(B1, 0, 1); PG8_STAGE(PG8_SB(0, 0), b2, voffB);
            PG8_BAR; PG8_WAIT_L(0); PG8_MMA(0, 1, At, B1); PG8_BAR;
            PG8_LDA(At, 0, 1); PG8_STAGE(PG8_SA(0, 0), a2, voffA);
            PG8_BAR; PG8_WAIT_L(0); PG8_MMA(1, 0, At, B0); PG8_BAR; PG8_SCHED;
            PG8_STAGE(PG8_SB(0, 1), b2 + hstep, voffB);
            PG8_WAIT_V(6); PG8_BAR; PG8_MMA(1, 1, At, B1); PG8_BAR;
            PG8_LDB(B0, 1, 0); PG8_SCHED; PG8_LDA(At, 1, 0); PG8_STAGE(PG8_SA(0, 1), a2 + hstep, voffA);
            PG8_WAIT_L(8); PG8_BAR; PG8_WAIT_L(0); PG8_MMA(0, 0, At, B0); PG8_BAR; PG8_SCHED;
            PG8_LDB(B1, 1, 1); PG8_STAGE(PG8_SB(1, 0), b3, voffB);
            PG8_BAR; PG8_WAIT_L(0); PG8_MMA(0, 1, At, B1); PG8_BAR;
            PG8_LDA(At, 1, 1); PG8_STAGE(PG8_SA(1, 0), a3, voffA);
            PG8_BAR; PG8_WAIT_L(0); PG8_MMA(1, 0, At, B0); PG8_BAR; PG8_SCHED;
            PG8_STAGE(PG8_SB(1, 1), b3 + hstep, voffB);
            PG8_WAIT_V(6); PG8_BAR; PG8_MMA(1, 1, At, B1); PG8_BAR;
            }
        }
        if constexpr (ALIGN_EPI) { if (wr == 0) PG8_BAR; }
        E(acc, cur, wr, wc, fr, fq, lane);
        if (!has_next) break;
#pragma unroll
        for (int a = 0; a < 2; ++a)
#pragma unroll
            for (int b = 0; b < 2; ++b)
#pragma unroll
                for (int m = 0; m < 4; ++m)
#pragma unroll
                    for (int n = 0; n < 2; ++n) acc[a][b][m][n] = (f32x4){0.f, 0.f, 0.f, 0.f};
        cur = nxt; cA = nA; cB = nB; ++ui;
        if constexpr (ALIGN_EPI) { if (wr == 1) PG8_BAR; }
    }
    PG8_WAIT_V(0);
    if constexpr (!ALIGN_EPI) { if (wr == 0) PG8_BAR; }
    PG8_BAR;
#undef PG8_SA
#undef PG8_SB
#undef PG8_STAGE
#undef PG8_LDA
#undef PG8_LDB
#undef PG8_MMA
#undef PG8_WAIT_V
#undef PG8_WAIT_L
#undef PG8_BAR
#undef PG8_SCHED
}
}

namespace att {
constexpr int PITCH = DIN;
#define SBAR() __builtin_amdgcn_sched_barrier(0)
#define KSW(row, colB) ((row) * 128 + ((colB) ^ ((((row) >> 1) & 7) << 4)))
__device__ __forceinline__ int crow(int r, int hi) { return (r & 3) + 8 * (r >> 2) + 4 * hi; }
__device__ __forceinline__ int rel_bucket(int rel) {
    const int n = rel < 0 ? -rel : rel; int v;
    if (n < 8) v = n; else { v = 2 + (31 - __clz(n * n)); v = v > 15 ? 15 : v; }
    return (rel > 0 ? 16 : 0) + v;
}
constexpr float THR = 5.0f;

__device__ __forceinline__ void partialSM(f32x16& p0, f32x16& p1, float off, float& m_reg, float& alpha) {
    float pmax = p0[0];
#pragma unroll
    for (int r = 1; r < 16; ++r) pmax = fmaxf(pmax, p0[r]);
#pragma unroll
    for (int r = 0; r < 16; ++r) pmax = fmaxf(pmax, p1[r]);
    { auto rr = __builtin_amdgcn_permlane32_swap(__float_as_uint(pmax), __float_as_uint(pmax), false, false);
      pmax = fmaxf(__uint_as_float(rr[0]), __uint_as_float(rr[1])); }
    pmax += off;
    if (__builtin_expect(__all(pmax - m_reg <= THR), 1)) { alpha = 1.f; }
    else { const float mn = fmaxf(m_reg, pmax); alpha = __builtin_amdgcn_exp2f(m_reg - mn); m_reg = mn; }
    const float sub = off - m_reg;
#pragma unroll
    for (int r = 0; r < 16; ++r) { p0[r] += sub; p1[r] += sub; }
#pragma unroll
    for (int r = 0; r < 16; ++r) p0[r] = __builtin_amdgcn_exp2f(p0[r]);
}
__device__ __forceinline__ void finishSM(f32x16& p0, f32x16& p1, float alpha, float& l_reg, bf16x8& pa0, bf16x8& pa1, bf16x8& pa2, bf16x8& pa3) {
#pragma unroll
    for (int r = 0; r < 16; ++r) p1[r] = __builtin_amdgcn_exp2f(p1[r]);
    float ps = 0;
#pragma unroll
    for (int r = 0; r < 16; ++r) ps += p0[r];
#pragma unroll
    for (int r = 0; r < 16; ++r) ps += p1[r];
    { auto rr = __builtin_amdgcn_permlane32_swap(__float_as_uint(ps), __float_as_uint(ps), false, false);
      ps = __uint_as_float(rr[0]) + __uint_as_float(rr[1]); }
    l_reg = l_reg * alpha + ps;
#define PK4(P, BASE, OUT) do { unsigned a0 = cvtpk(P[BASE + 0], P[BASE + 1]), a1 = cvtpk(P[BASE + 2], P[BASE + 3]);   \
    unsigned b0 = cvtpk(P[BASE + 4], P[BASE + 5]), b1 = cvtpk(P[BASE + 6], P[BASE + 7]);                              \
    auto r0 = __builtin_amdgcn_permlane32_swap(a0, b0, false, false); auto r1 = __builtin_amdgcn_permlane32_swap(a1, b1, false, false); \
    u32x4 w = {r0[0], r1[0], r0[1], r1[1]}; OUT = __builtin_bit_cast(bf16x8, w); } while (0)
    PK4(p0, 0, pa0); PK4(p0, 8, pa1); PK4(p1, 0, pa2); PK4(p1, 8, pa3);
#undef PK4
}
__device__ __forceinline__ void qkt64(f32x16& p0, f32x16& p1, const LAS char* Ks, const bf16x8* qr, int r32, int hi) {
#pragma unroll
    for (int d0 = 0; d0 < 4; ++d0) { const int cb = (d0 * 16 + hi * 8) * 2;
        const bf16x8 b0 = *(const LAS bf16x8*)(Ks + KSW(r32, cb));
        const bf16x8 b1 = *(const LAS bf16x8*)(Ks + KSW(r32, cb) + 4096);
        p0 = __builtin_amdgcn_mfma_f32_32x32x16_bf16(b0, qr[d0], p0, 0, 0, 0); p1 = __builtin_amdgcn_mfma_f32_32x32x16_bf16(b1, qr[d0], p1, 0, 0, 0); }
}
template <int NCB> __device__ __forceinline__ int v_st(int k, int c) { const int kk = (k & ~0xC) | ((k & 4) << 1) | ((k & 8) >> 1); return ((kk >> 3) * NCB + (c >> 5)) * 512 + ((kk & 7) * 32 + (c & 31)) * 2; }
__device__ __forceinline__ int v_rd_base(int lane) { return ((lane & 3) << 3) | (((lane >> 2) & 3) << 6) | (((lane >> 4) & 1) << 5) | (((lane >> 5) & 1) << 8); }
template <int NCB> constexpr int v_rd_off(int d0, int ks, int half) { return d0 * 512 + ks * (NCB * 1024) + half * (NCB * 512); }
template <int OFF> __device__ __forceinline__ s16x4 tr_read(int vb) { s16x4 r; asm volatile("ds_read_b64_tr_b16 %0, %1 offset:%2" : "=&v"(r) : "v"(vb), "i"(OFF) : "memory"); return r; }
template <int NCB, int D0> __device__ __forceinline__ void pv_one(f32x16& od, int vb, bf16x8 pa0, bf16x8 pa1, bf16x8 pa2, bf16x8 pa3) {
    const s16x4 l0 = tr_read<v_rd_off<NCB>(D0, 0, 0)>(vb), h0 = tr_read<v_rd_off<NCB>(D0, 0, 1)>(vb), l1 = tr_read<v_rd_off<NCB>(D0, 1, 0)>(vb), h1 = tr_read<v_rd_off<NCB>(D0, 1, 1)>(vb);
    const s16x4 l2 = tr_read<v_rd_off<NCB>(D0, 2, 0)>(vb), h2 = tr_read<v_rd_off<NCB>(D0, 2, 1)>(vb), l3 = tr_read<v_rd_off<NCB>(D0, 3, 0)>(vb), h3 = tr_read<v_rd_off<NCB>(D0, 3, 1)>(vb);
    asm volatile("s_waitcnt lgkmcnt(0)" ::: "memory"); SBAR();
#define PK(L, H) (bf16x8){L[0], L[1], L[2], L[3], H[0], H[1], H[2], H[3]}
    od = __builtin_amdgcn_mfma_f32_32x32x16_bf16(pa0, PK(l0, h0), od, 0, 0, 0);
    od = __builtin_amdgcn_mfma_f32_32x32x16_bf16(pa1, PK(l1, h1), od, 0, 0, 0);
    od = __builtin_amdgcn_mfma_f32_32x32x16_bf16(pa2, PK(l2, h2), od, 0, 0, 0);
    od = __builtin_amdgcn_mfma_f32_32x32x16_bf16(pa3, PK(l3, h3), od, 0, 0, 0);
#undef PK
}

constexpr int D_V = 0, D_K = 49152, D_WS = 81920, D_TB = 83968, D_ST = 86016, D_END = D_ST + 65536;
constexpr int NT = SEQ / 64;

typedef short v4i16_t __attribute__((ext_vector_type(4)));
__device__ __forceinline__ s16x4 vtr(const LAS char* p) { return __builtin_bit_cast(s16x4, __builtin_amdgcn_ds_read_tr16_b64_v4i16((LAS v4i16_t*)p)); }
#define PIN(x) asm volatile("" : "+v"(x))
#define MX3(a, b, c) __builtin_fmaxf(__builtin_fmaxf((a), (b)), (c))
#define EX(v) __builtin_amdgcn_exp2f(v)
#define MFMA32(a, b, c) __builtin_amdgcn_mfma_f32_32x32x16_bf16((a), (b), (c), 0, 0, 0)
constexpr float THRL = 6.0f;
__device__ __forceinline__ float rowmax32(const f32x16& C0, const f32x16& C1) {
    float a = MX3(C0[0], C0[1], C1[0]), b = MX3(C0[2], C0[3], C1[1]); a = MX3(a, C1[2], C1[3]);
#pragma unroll
    for (int r = 4; r < 16; r += 4) { a = MX3(a, C0[r], C0[r + 1]); b = MX3(b, C0[r + 2], C0[r + 3]); a = MX3(a, C1[r], C1[r + 1]); b = MX3(b, C1[r + 2], C1[r + 3]); }
    float rm = __builtin_fmaxf(a, b);
    auto rr = __builtin_amdgcn_permlane32_swap(__float_as_uint(rm), __float_as_uint(rm), false, false);
    return __builtin_fmaxf(__uint_as_float(rr[0]), __uint_as_float(rr[1]));
}
__device__ __forceinline__ void diff_pass(f32x16 (&o)[4], float& l_out, const bf16_t* Qw, const bf16_t* __restrict__ Kh, const bf16_t* __restrict__ Vh,
                                          LAS char* lds, int qa, float cL, float cR) {
    const int tid = threadIdx.x, wid = __builtin_amdgcn_readfirstlane(tid >> 6), lane = tid & 63, r32 = lane & 31, hi = lane >> 5;
    LAS char* V_lds = lds + D_V; LAS char* K_lds = lds + D_K;
    LAS float* wsf = (LAS float*)(lds + D_WS) + wid * 64 + 32;
    const LAS float* tb = (const LAS float*)(lds + D_TB);
#pragma unroll
    for (int d = 0; d < 4; ++d) o[d] = f32x16{};
    bf16x8 qr[4];
#pragma unroll
    for (int d0 = 0; d0 < 4; ++d0) qr[d0] = *(const bf16x8*)(Qw + d0 * 16);
#pragma unroll
    for (int d0 = 0; d0 < 4; ++d0) PIN(qr[d0]);
    const bf16_t* ksrc; const bf16_t* vsrc0;
    { const int row = wid * 8 + (lane >> 3), pos = lane & 7;
      ksrc = Kh + (long)row * PITCH + ((pos ^ ((row >> 1) & 7)) * 8);
      vsrc0 = Vh + (long)row * PITCH + ((pos ^ (((row >> 1) & 1) << 2)) * 8); }
    const LAS char* kq[4];
    { const int sw = (r32 >> 1) & 7;
#pragma unroll
      for (int d0 = 0; d0 < 4; ++d0) kq[d0] = K_lds + r32 * 128 + (((2 * d0 + hi) ^ sw) << 4); }
    const LAS char* vpe; const LAS char* vpo;
    { const int q = (lane & 15) >> 2, p = lane & 3, g = (lane >> 4) & 1, sw = (q >> 1) & 1;
      vpe = V_lds + (4 * hi + q) * 128 + sw * 64 + g * 32 + p * 8; vpo = V_lds + (4 * hi + q) * 128 + (sw ^ 1) * 64 + g * 32 + p * 8; }
#define DMA_K(j, ko) __builtin_amdgcn_global_load_lds((const unsigned*)(ksrc + (long)(j) * 64 * PITCH), (LAS unsigned*)(K_lds + (ko) + wid * 1024), 16, 0, 0)
#define DMA_V(j, vo) do { __builtin_amdgcn_global_load_lds((const unsigned*)(vsrc0 + (long)(j) * 64 * PITCH), (LAS unsigned*)(V_lds + (vo) + wid * 1024), 16, 0, 0); \
    __builtin_amdgcn_global_load_lds((const unsigned*)(vsrc0 + 64 + (long)(j) * 64 * PITCH), (LAS unsigned*)(V_lds + (vo) + 8192 + wid * 1024), 16, 0, 0); } while (0)
#define WAIT_BAR(N) do { asm volatile("s_waitcnt vmcnt(" #N ") lgkmcnt(0)" ::: "memory"); __builtin_amdgcn_s_barrier(); asm volatile("" ::: "memory"); } while (0)
    float mhat, l_reg = 0.f; bool resc = false;
    f32x16 pA0, pA1, pB0, pB1;
    bf16x8 kf[4]; s16x4 vlo[6], vhi[6]; u32x4 pw0, pw1, pw2, pw3;
#define KRD(i, KS) do { kf[(i) & 3] = *(const LAS bf16x8*)(kq[(i) >> 1] + (KS) + ((i) & 1) * 4096); } while (0)
    WAIT_BAR(0);
    DMA_K(0, 0); DMA_K(1, 8192); DMA_V(0, 0); DMA_K(2, 16384); DMA_K(3, 24576); DMA_V(1, 16384);
    WAIT_BAR(7);
    {
        float off0 = 0.f; const int d_ = -qa;
        if (d_ <= -154) { pA0 = f32x16{}; pA1 = f32x16{}; off0 = cL; }
        else { const LAS float* t_ = tb + (d_ + 256 + 4 * hi - r32);
#pragma unroll
            for (int r = 0; r < 16; ++r) { pA0[r] = t_[(r & 3) + 8 * (r >> 2)]; pA1[r] = t_[32 + (r & 3) + 8 * (r >> 2)]; } }
#pragma unroll
        for (int d0 = 0; d0 < 4; ++d0) { const bf16x8 k0_ = *(const LAS bf16x8*)(kq[d0]), k1_ = *(const LAS bf16x8*)(kq[d0] + 4096);
            pA0 = MFMA32(k0_, qr[d0], pA0); pA1 = MFMA32(k1_, qr[d0], pA1); }
        const float rm = rowmax32(pA0, pA1);
        mhat = rm + off0;
#pragma unroll
        for (int r = 0; r < 16; ++r) { pA0[r] = EX(pA0[r] - rm); pA1[r] = EX(pA1[r] - rm); }
    }
    WAIT_BAR(3);
    KRD(0, 8192); KRD(1, 8192); KRD(2, 8192); KRD(3, 8192);
#define PKW(P, B) cvtpk(P[B], P[(B) + 1])
#define PAF(k) __builtin_bit_cast(bf16x8, pw##k)
#define VFR(i) (bf16x8){vlo[(i) % 6][0], vlo[(i) % 6][1], vlo[(i) % 6][2], vlo[(i) % 6][3], vhi[(i) % 6][0], vhi[(i) % 6][1], vhi[(i) % 6][2], vhi[(i) % 6][3]}
#define VRD(i, VS) do { const LAS char* vq_ = ((((i) & 3) & 1) ? vpo : vpe) + (VS) + (((i) & 3) >> 1) * 8192 + ((i) >> 2) * 2048; vlo[(i) % 6] = vtr(vq_); vhi[(i) % 6] = vtr(vq_ + 1024); } while (0)
#define GAPA(g, CC, QI, KB, A0, A1, A2, A3, W0, W1, PW) do { CC = MFMA32(kf[(g) & 3], qr[QI], CC); if ((g) + 4 < 8) KRD((g) + 4, KB); sacc += A0; sacc += A1; sacc += A2; sacc += A3; PIN(sacc); W0; W1; PIN(PW); SBAR(); } while (0)
#define GAPB(i, X, B, VB, KN, PRE) do { o[(i) & 3] = MFMA32(PAF_SEL(i), VFR(i), o[(i) & 3]); X[B] = EX(X[B]); X[(B) + 1] = EX(X[(B) + 1]); PIN(X); if ((i) + 5 < 16) VRD((i) + 5, VB); \
    if ((PRE) && (i) >= 8 && (i) < 12) KRD((i) - 8, KN); SBAR(); } while (0)
#define PAF_SEL(i) (((i) >> 2) == 0 ? PAF(0) : ((i) >> 2) == 1 ? PAF(1) : ((i) >> 2) == 2 ? PAF(2) : PAF(3))
#define STEP(C0, C1, P0, P1, t, KB, VB, KN, PRE) do { SBAR(); \
    { const int d_ = (t) * 64 - qa; \
      if (d_ > -154 && d_ < 122) { const LAS float* t_ = tb + (d_ + 256 + 4 * hi - r32); \
        _Pragma("unroll") for (int r = 0; r < 16; ++r) { C0[r] = t_[(r & 3) + 8 * (r >> 2)] - mhat; C1[r] = t_[32 + (r & 3) + 8 * (r >> 2)] - mhat; } } \
      else { const float cs_ = (d_ < 0 ? cL : cR) - mhat; _Pragma("unroll") for (int r = 0; r < 16; ++r) { C0[r] = cs_; C1[r] = cs_; } } } \
    PIN(C0); PIN(C1); SBAR(); \
    float sacc = (P0[0] + P0[1]); \
    GAPA(0, C0, 0, KB, P0[2],  P0[3],  P0[4],  P0[5],  pw0[0] = PKW(P0, 0),  pw0[1] = PKW(P0, 2),  pw0); \
    GAPA(1, C1, 0, KB, P0[6],  P0[7],  P0[8],  P0[9],  pw0[2] = PKW(P0, 4),  pw0[3] = PKW(P0, 6),  pw0); \
    GAPA(2, C0, 1, KB, P0[10], P0[11], P0[12], P0[13], pw1[0] = PKW(P0, 8),  pw1[1] = PKW(P0, 10), pw1); \
    GAPA(3, C1, 1, KB, P0[14], P0[15], P1[0],  P1[1],  pw1[2] = PKW(P0, 12), pw1[3] = PKW(P0, 14), pw1); \
    GAPA(4, C0, 2, KB, P1[2],  P1[3],  P1[4],  P1[5],  pw2[0] = PKW(P1, 0),  pw2[1] = PKW(P1, 2),  pw2); \
    GAPA(5, C1, 2, KB, P1[6],  P1[7],  P1[8],  P1[9],  pw2[2] = PKW(P1, 4),  pw2[3] = PKW(P1, 6),  pw2); \
    GAPA(6, C0, 3, KB, P1[10], P1[11], P1[12], P1[13], pw3[0] = PKW(P1, 8),  pw3[1] = PKW(P1, 10), pw3); \
    GAPA(7, C1, 3, KB, P1[14], P1[15], 0.f,    0.f,    pw3[2] = PKW(P1, 12), pw3[3] = PKW(P1, 14), pw3); \
    l_reg += sacc; \
    VRD(0, VB); VRD(1, VB); VRD(2, VB); VRD(3, VB); VRD(4, VB); \
    { const float rm = rowmax32(C0, C1); resc = false; \
      if (__builtin_expect(__any(rm > THRL), 0)) { const float dl = __builtin_fmaxf(rm, 0.f); mhat += dl; \
        _Pragma("unroll") for (int r = 0; r < 16; ++r) { C0[r] -= dl; C1[r] -= dl; } \
        const float f = EX(-dl); l_reg *= f; if (hi == 0) wsf[r32] = f; resc = true; } } \
    SBAR(); \
    GAPB(0, C0, 0, VB, KN, PRE);  GAPB(1, C0, 2, VB, KN, PRE);  GAPB(2, C0, 4, VB, KN, PRE);   GAPB(3, C0, 6, VB, KN, PRE); \
    GAPB(4, C0, 8, VB, KN, PRE);  GAPB(5, C0, 10, VB, KN, PRE); GAPB(6, C0, 12, VB, KN, PRE);  GAPB(7, C0, 14, VB, KN, PRE); \
    GAPB(8, C1, 0, VB, KN, PRE);  GAPB(9, C1, 2, VB, KN, PRE);  GAPB(10, C1, 4, VB, KN, PRE);  GAPB(11, C1, 6, VB, KN, PRE); \
    GAPB(12, C1, 8, VB, KN, PRE); GAPB(13, C1, 10, VB, KN, PRE); GAPB(14, C1, 12, VB, KN, PRE); GAPB(15, C1, 14, VB, KN, PRE); \
    } while (0)
#define RESC() do { if (resc) { asm volatile("s_waitcnt lgkmcnt(0)" ::: "memory"); \
    _Pragma("unroll") for (int d = 0; d < 4; ++d) _Pragma("unroll") for (int r = 0; r < 16; ++r) o[d][r] *= wsf[crow(r, hi)]; } } while (0)
    int ks_cur = 8192, ks_n1 = 16384, ks_n3 = 0;
    int vs_prev = 0, vs_next = 32768;
#define ROT() do { ks_cur = (ks_cur + 8192) & 24576; ks_n1 = (ks_n1 + 8192) & 24576; ks_n3 = (ks_n3 + 8192) & 24576; vs_prev = vs_prev == 32768 ? 0 : vs_prev + 16384; vs_next = vs_next == 32768 ? 0 : vs_next + 16384; } while (0)
#define STEPX(C0, C1, P0, P1, t, PRE) STEP(C0, C1, P0, P1, t, ks_cur, vs_prev, ks_n1, PRE)
#pragma unroll 1
    for (int t = 1; t + 4 < NT; t += 2) {
        DMA_K(t + 3, ks_n3); DMA_V(t + 1, vs_next);
        STEPX(pB0, pB1, pA0, pA1, t, true);
        WAIT_BAR(3); RESC(); ROT();
        DMA_K(t + 4, ks_n3); DMA_V(t + 2, vs_next);
        STEPX(pA0, pA1, pB0, pB1, t + 1, true);
        WAIT_BAR(3); RESC(); ROT();
    }
    DMA_V(NT - 2, vs_next);
    STEPX(pB0, pB1, pA0, pA1, NT - 3, true);
    WAIT_BAR(2); RESC(); ROT();
    DMA_V(NT - 1, vs_next);
    STEPX(pA0, pA1, pB0, pB1, NT - 2, true);
    WAIT_BAR(2); RESC(); ROT();
    STEPX(pB0, pB1, pA0, pA1, NT - 1, false);
    WAIT_BAR(0); RESC(); ROT();
    { float sacc = 0.f;
#pragma unroll
      for (int r = 0; r < 16; ++r) sacc += pB0[r];
#pragma unroll
      for (int r = 0; r < 16; ++r) sacc += pB1[r];
      l_reg += sacc;
      pw0 = (u32x4){PKW(pB0, 0), PKW(pB0, 2), PKW(pB0, 4), PKW(pB0, 6)}; pw1 = (u32x4){PKW(pB0, 8), PKW(pB0, 10), PKW(pB0, 12), PKW(pB0, 14)};
      pw2 = (u32x4){PKW(pB1, 0), PKW(pB1, 2), PKW(pB1, 4), PKW(pB1, 6)}; pw3 = (u32x4){PKW(pB1, 8), PKW(pB1, 10), PKW(pB1, 12), PKW(pB1, 14)};
      SBAR();
#define DRAIN(i) do { VRD(i, vs_prev); o[(i) & 3] = MFMA32(PAF_SEL(i), VFR(i), o[(i) & 3]); } while (0)
      DRAIN(0); DRAIN(1); DRAIN(2); DRAIN(3); DRAIN(4); DRAIN(5); DRAIN(6); DRAIN(7); DRAIN(8); DRAIN(9); DRAIN(10); DRAIN(11); DRAIN(12); DRAIN(13); DRAIN(14); DRAIN(15);
#undef DRAIN
    }
    { auto rr = __builtin_amdgcn_permlane32_swap(__float_as_uint(l_reg), __float_as_uint(l_reg), false, false); l_out = __uint_as_float(rr[0]) + __uint_as_float(rr[1]); }
#undef DMA_K
#undef DMA_V
#undef WAIT_BAR
#undef ROT
#undef KRD
#undef PKW
#undef PAF
#undef VFR
#undef VRD
#undef GAPA
#undef GAPB
#undef PAF_SEL
#undef STEP
#undef STEPX
#undef RESC
}

__device__ __forceinline__ void diff_unit(int b, int h, int qb, const bf16_t* P, bf16_t* O, LAS char* lds, float lam, const float* relb) {
    const int tid = threadIdx.x, wid = __builtin_amdgcn_readfirstlane(tid >> 6), lane = tid & 63, r32 = lane & 31, hi = lane >> 5;
    const long rowbase = (long)b * SEQ; const int q0 = qb * 256, qa = q0 + wid * 32;
    LAS float* tb = (LAS float*)(lds + D_TB);
    LAS float* li_l = (LAS float*)(lds + D_WS) + wid * 64;
    tb[tid] = relb[rel_bucket(tid - 256) * NBH + h] * LOG2E;
    const float cL = relb[15 * NBH + h] * LOG2E, cR = relb[31 * NBH + h] * LOG2E;
    const bf16_t* Qrow = P + (rowbase + qa + r32) * PITCH + C_DQ + h * 128 + hi * 8;
    const bf16_t* Kh = P + rowbase * PITCH + C_DK + h * 128;
    const bf16_t* Vh = P + rowbase * PITCH + C_DV + h * 128;
    LAS u32x4* stash = (LAS u32x4*)(lds + D_ST + wid * 8192);
    f32x16 o[4]; float l_reg;
#pragma unroll 1
    for (int pass = 0; pass < 2; ++pass) {
        const int mo = pass == 0 ? 64 : 0;
        diff_pass(o, l_reg, Qrow + mo, Kh + mo, Vh, lds, qa, cL, cR);
        int ln = lane; asm volatile("" : "+v"(ln));
        const int r32e = ln & 31, hie = ln >> 5;
        if (hie == 0) li_l[r32e] = l_reg; asm volatile("s_waitcnt lgkmcnt(0)" ::: "memory");
        if (pass == 0) {
            float rli[16];
#pragma unroll
            for (int r = 0; r < 16; ++r) rli[r] = -lam * __builtin_amdgcn_rcpf(li_l[crow(r, hie)]);
#pragma unroll
            for (int d0 = 0; d0 < 4; ++d0) {
                u32x4 w0, w1;
                w0.x = cvtpk(o[d0][0] * rli[0], o[d0][1] * rli[1]); w0.y = cvtpk(o[d0][2] * rli[2], o[d0][3] * rli[3]); w0.z = cvtpk(o[d0][4] * rli[4], o[d0][5] * rli[5]); w0.w = cvtpk(o[d0][6] * rli[6], o[d0][7] * rli[7]);
                w1.x = cvtpk(o[d0][8] * rli[8], o[d0][9] * rli[9]); w1.y = cvtpk(o[d0][10] * rli[10], o[d0][11] * rli[11]); w1.z = cvtpk(o[d0][12] * rli[12], o[d0][13] * rli[13]); w1.w = cvtpk(o[d0][14] * rli[14], o[d0][15] * rli[15]);
                stash[(2 * d0) * 64 + ln] = w0; stash[(2 * d0 + 1) * 64 + ln] = w1;
            }
        } else {
            float rli[16], ssq[16];
#pragma unroll
            for (int r = 0; r < 16; ++r) { rli[r] = __builtin_amdgcn_rcpf(li_l[crow(r, hie)]); ssq[r] = 0.f; }
#pragma unroll
            for (int d0 = 0; d0 < 4; ++d0) {
                const u32x4 w0 = stash[(2 * d0) * 64 + ln], w1 = stash[(2 * d0 + 1) * 64 + ln];
                const unsigned ww[8] = {w0.x, w0.y, w0.z, w0.w, w1.x, w1.y, w1.z, w1.w};
#pragma unroll
                for (int r = 0; r < 16; ++r) { const float c = __uint_as_float((r & 1) ? (ww[r >> 1] & 0xffff0000u) : (ww[r >> 1] << 16));
                    const float x = fmaf(o[d0][r], rli[r], c); o[d0][r] = x; ssq[r] = fmaf(x, x, ssq[r]); }
            }
            asm volatile("s_waitcnt lgkmcnt(0)" ::: "memory");
#pragma unroll
            for (int r = 0; r < 16; ++r) { float s = ssq[r];
                s += __shfl_xor(s, 1); s += __shfl_xor(s, 2); s += __shfl_xor(s, 4); s += __shfl_xor(s, 8); s += __shfl_xor(s, 16);
                ssq[r] = __builtin_amdgcn_rsqf(s * (1.0f / 128.0f) + EPS); }
            LAS bf16_t* stg = (LAS bf16_t*)(lds + D_ST + wid * 8192);
#pragma unroll
            for (int r = 0; r < 16; ++r) { const int orow = crow(r, hie);
#pragma unroll
                for (int d0 = 0; d0 < 4; ++d0) stg[orow * 128 + d0 * 32 + r32e] = (bf16_t)(cvtpk(o[d0][r] * ssq[r], 0.f) & 0xffffu); }
            asm volatile("s_waitcnt lgkmcnt(0)" ::: "memory");
            bf16_t* Ow = O + (rowbase + qa + (ln >> 4)) * DM + h * 128 + (ln & 15) * 8;
            const LAS bf16_t* sl = stg + (ln >> 4) * 128 + (ln & 15) * 8;
#pragma unroll
            for (int i = 0; i < 8; ++i) { const u32x4 v = *(const LAS u32x4*)(sl + i * 512); *(u32x4*)(Ow + (long)i * 4 * DM) = v; }
        }
    }
    asm volatile("s_waitcnt lgkmcnt(0)" ::: "memory"); __syncthreads();
}

constexpr int W_K = 0, W_V = 49152, W_TB = 98304, W_WS = 106496, W_OST = 108544, W_END = W_OST + 32768;
__device__ __forceinline__ void win_unit(int b, int kvh, int qb, const bf16_t* P, bf16_t* O, LAS char* lds, const float* relb, const float* sink) {
    const int tid = threadIdx.x, wid = __builtin_amdgcn_readfirstlane(tid >> 6), lane = tid & 63, r32 = lane & 31, hi = lane >> 5;
    const long rowbase = (long)b * SEQ; const int q0 = qb * 128, kbase = q0 - 128;
    LAS float* tbw = (LAS float*)(lds + W_TB);
#pragma unroll
    for (int e = 0; e < 4; ++e) { const int idx = tid + e * 512, g = idx >> 9, rel = (idx & 511) - 256;
        tbw[idx] = (rel >= -128 && rel <= 128) ? (relb[rel_bucket(rel) * NBH + 4 + 4 * kvh + g] - sink[4 * kvh + g]) * LOG2E : -1e30f; }
    { int tl = tid; asm volatile("" : "+v"(tl));
      const int kr = tl >> 3, kc = (tl & 7) * 8, kst = KSW(kr, kc * 2), vst = v_st<2>(kr, kc);
      const bf16_t* Kh = P + rowbase * PITCH + C_WK + kvh * 64; const bf16_t* Vh = P + rowbase * PITCH + C_WV + kvh * 64;
      bf16x8 kreg[6], vreg[6];
#pragma unroll
      for (int t = 0; t < 6; ++t) { const int k0 = kbase + 64 * t; if (k0 >= 0 && k0 < SEQ) { kreg[t] = *(const bf16x8*)(&Kh[(long)(k0 + kr) * PITCH + kc]); vreg[t] = *(const bf16x8*)(&Vh[(long)(k0 + kr) * PITCH + kc]); } }
#pragma unroll
      for (int t = 0; t < 6; ++t) { const int k0 = kbase + 64 * t; if (k0 >= 0 && k0 < SEQ) { *(LAS bf16x8*)(lds + W_K + t * 8192 + kst) = kreg[t]; *(LAS bf16x8*)(lds + W_V + t * 8192 + vst) = vreg[t]; } }
    }
    __syncthreads();
    const int g = wid >> 1, hq = 4 * kvh + g;
    LAS float* li_l = (LAS float*)(lds + W_WS) + wid * 64;
    const LAS float* tbg = tbw + g * 512;
    const int vbw = (int)(uintptr_t)(lds + W_V) + v_rd_base(lane);
#pragma unroll 1
    for (int jb = 0; jb < 2; ++jb) {
        const int ql = 64 * (wid & 1) + 32 * jb;
        const bf16_t* Qw = P + (rowbase + q0 + ql + r32) * PITCH + C_WQ + hq * 64 + hi * 8;
        bf16x8 qr[4];
#pragma unroll
        for (int d0 = 0; d0 < 4; ++d0) qr[d0] = *(const bf16x8*)(Qw + d0 * 16);
        float l_reg = 0.f;
        f32x16 o[2]; o[0] = f32x16{}; o[1] = f32x16{};
        const int t_lo = ql >> 6;
#pragma unroll 1
        for (int t = t_lo; t < t_lo + 5; ++t) {
            const int k0 = kbase + 64 * t; if (k0 < 0 || k0 >= SEQ) continue;
            const int d_ = 64 * t - 128 - ql;
            const LAS float* t_ = tbg + (d_ + 256 + 4 * hi - r32);
            f32x16 p0, p1;
#pragma unroll
            for (int r = 0; r < 16; ++r) { p0[r] = t_[(r & 3) + 8 * (r >> 2)]; p1[r] = t_[32 + (r & 3) + 8 * (r >> 2)]; }
            qkt64(p0, p1, lds + W_K + t * 8192, qr, r32, hi);
#pragma unroll
            for (int r = 0; r < 16; ++r) { p0[r] = __builtin_amdgcn_exp2f(p0[r]); p1[r] = __builtin_amdgcn_exp2f(p1[r]); }
            bf16x8 pa0, pa1, pa2, pa3;
            {
                float ps = 0;
#pragma unroll
                for (int r = 0; r < 16; ++r) ps += p0[r];
#pragma unroll
                for (int r = 0; r < 16; ++r) ps += p1[r];
                l_reg += ps;
#define PK4(Pv, BASE, OUT) do { unsigned a0 = cvtpk(Pv[BASE + 0], Pv[BASE + 1]), a1 = cvtpk(Pv[BASE + 2], Pv[BASE + 3]);   \
    unsigned b0 = cvtpk(Pv[BASE + 4], Pv[BASE + 5]), b1 = cvtpk(Pv[BASE + 6], Pv[BASE + 7]);                              \
    auto r0 = __builtin_amdgcn_permlane32_swap(a0, b0, false, false); auto r1 = __builtin_amdgcn_permlane32_swap(a1, b1, false, false); \
    u32x4 w = {r0[0], r1[0], r0[1], r1[1]}; OUT = __builtin_bit_cast(bf16x8, w); } while (0)
                PK4(p0, 0, pa0); PK4(p0, 8, pa1); PK4(p1, 0, pa2); PK4(p1, 8, pa3);
#undef PK4
            }
            const int vb = vbw + t * 8192;
            pv_one<2, 0>(o[0], vb, pa0, pa1, pa2, pa3); pv_one<2, 1>(o[1], vb, pa0, pa1, pa2, pa3);
        }
        { auto rr = __builtin_amdgcn_permlane32_swap(__float_as_uint(l_reg), __float_as_uint(l_reg), false, false); l_reg = 1.0f + __uint_as_float(rr[0]) + __uint_as_float(rr[1]); }
        int ln = lane; asm volatile("" : "+v"(ln));
        const int r32e = ln & 31, hie = ln >> 5;
        if (hie == 0) li_l[r32e] = l_reg; asm volatile("s_waitcnt lgkmcnt(0)" ::: "memory");
        float rli[16];
#pragma unroll
        for (int r = 0; r < 16; ++r) rli[r] = __builtin_amdgcn_rcpf(li_l[crow(r, hie)]);
        LAS bf16_t* stg = (LAS bf16_t*)(lds + W_OST + wid * 4096);
#pragma unroll
        for (int r = 0; r < 16; ++r) { const int orow = crow(r, hie);
#pragma unroll
            for (int d0 = 0; d0 < 2; ++d0) stg[orow * 64 + d0 * 32 + r32e] = (bf16_t)(cvtpk(o[d0][r] * rli[r], 0.f) & 0xffffu); }
        asm volatile("s_waitcnt lgkmcnt(0)" ::: "memory");
        bf16_t* Ow = O + (rowbase + q0 + ql + (ln >> 3)) * DM + 512 + hq * 64 + (ln & 7) * 8;
        const LAS bf16_t* sl = stg + (ln >> 3) * 64 + (ln & 7) * 8;
#pragma unroll
        for (int i = 0; i < 4; ++i) { const u32x4 v = *(const LAS u32x4*)(sl + i * 512); *(u32x4*)(Ow + (long)i * 8 * DM) = v; }
        asm volatile("s_waitcnt lgkmcnt(0)" ::: "memory");
    }
    asm volatile("s_waitcnt lgkmcnt(0)" ::: "memory"); __syncthreads();
}
#undef SBAR
#undef KSW
}

constexpr size_t MiB = 1u << 20;
constexpr size_t WS_CTL = 0, CTL_ZERO_BYTES = 64 * 1024;
constexpr size_t WS_W1 = 1 * MiB;
constexpr size_t WS_W2 = WS_W1 + (size_t)DIN * DM * 2;
constexpr size_t WS_W3 = WS_W2 + (size_t)DM * DM * 2;
constexpr size_t WS_W4 = WS_W3 + (size_t)2 * DFF * DM * 2;
constexpr size_t WS_XS = 24 * MiB;
constexpr int CW_WMAX4 = 5120;
constexpr int CW_P3CNT = 4480;
constexpr size_t WS_FA = 26 * MiB;
constexpr size_t WS_FX = 26 * MiB + 512 * 1024;
constexpr int CW_WMAX1 = 13824, CW_W1CNT = 16200;
constexpr int CW_WMAX = 8192;
constexpr size_t WS_PROJ = 28 * MiB;
constexpr size_t WS_OB = 244 * MiB;
constexpr size_t WS_XQ = 340 * MiB;
constexpr size_t WS_X1Q = 340 * MiB;
constexpr size_t WS_X1B = 388 * MiB;
constexpr size_t WS_ACT = 28 * MiB;
constexpr size_t WS_END = WS_X1B + (size_t)NTOK * DM * 2;
static_assert(WS_W4 + (size_t)DM * DFF * 2 <= WS_XS && WS_XS + (size_t)NTOK * 32 <= WS_FA && WS_FA + (size_t)NTOK * 4 <= WS_FX && WS_FX + (size_t)NTOK * 4 <= WS_PROJ, "d_ws map");
static_assert(WS_PROJ + (size_t)NTOK * DIN * 2 <= WS_OB && WS_OB + (size_t)NTOK * DM * 2 <= WS_XQ && WS_XQ + (size_t)NTOK * DM <= WS_X1B && WS_ACT + (size_t)NTOK * DFF * 2 <= WS_X1Q - 4096, "d_ws map");
static_assert(CW_WMAX + 2 * DFF <= CW_WMAX1 && CW_WMAX1 + DIN <= CW_W1CNT && CW_W1CNT * 4 < CTL_ZERO_BYTES && 1024 + 3456 <= CW_P3CNT && CW_P3CNT + 192 <= CW_WMAX4 && CW_WMAX4 + DM <= CW_WMAX, "d_ws map");
constexpr int CW_BAR = 1024, XCD_BAR_WORDS_C = 3456;

constexpr int RING_BYTES = 131072, EPX_OFF = RING_BYTES, LDS_BYTES = 163840, MISC_OFF = LDS_BYTES - 512;
static_assert(att::D_END <= MISC_OFF && att::W_END <= MISC_OFF && EPX_OFF + 22528 <= MISC_OFF, "LDS map");

typedef GAS unsigned gu32;
#define RLX_AGENT __ATOMIC_RELAXED, __HIP_MEMORY_SCOPE_AGENT
#define LDS_WAIT() asm volatile("s_waitcnt lgkmcnt(0)" ::: "memory")

#define XB_TMO      128
#define XB_XCNT(j)  (256  + 64 * (j))
#define XB_XSUB(j)  (1280 + 64 * (j))
#define XB_XGEN(j)  (2304 + 64 * (j))
#define XB_TOP      3328
#define XB_TOPGEN   3392
#define XCD_BAR_WORDS 3456
#define XB_SPIN_CAP (1u << 22)
__device__ __forceinline__ unsigned xb_ld(unsigned* p)              { return __hip_atomic_load(p, __ATOMIC_RELAXED, __HIP_MEMORY_SCOPE_AGENT); }
__device__ __forceinline__ unsigned xb_add(unsigned* p, unsigned v) { return __hip_atomic_fetch_add(p, v, __ATOMIC_RELAXED, __HIP_MEMORY_SCOPE_AGENT); }
__device__ __forceinline__ unsigned xb_xcc_id() { return (unsigned)__builtin_amdgcn_s_getreg((3 << 11) | 20) & 0xFu; }
#define XB_SPIN(cond, bar) do { unsigned _sp = 0; while (cond) { __builtin_amdgcn_s_sleep(1); \
    if ((++_sp & 255u) == 0u) { if (xb_ld(&(bar)[XB_TMO])) break; if (_sp > XB_SPIN_CAP) { atomicAdd(&(bar)[XB_TMO], 1u); break; } } } } while (0)
struct XcdBarrier { unsigned* bar; unsigned x; volatile LAS unsigned* st; };
__device__ __forceinline__ XcdBarrier xcd_barrier_post(unsigned* bar, volatile LAS unsigned* st) {
    XcdBarrier b; b.bar = bar; b.x = xb_xcc_id(); b.st = st;
    if (threadIdx.x == 0) (void)xb_add(&bar[XB_XCNT(b.x)], 1u);
    return b;
}
__device__ __forceinline__ void xcd_barrier_complete(unsigned* bar, unsigned x, unsigned& nloc, unsigned& nx) {
    const unsigned G = gridDim.x * gridDim.y * gridDim.z;
    unsigned sum, cnt, mine, sp = 0u;
    for (;;) {
        sum = 0u; cnt = 0u; mine = 0u;
#pragma unroll
        for (unsigned j = 0; j < 16; ++j) { const unsigned c = xb_ld(&bar[XB_XCNT(j)]); sum += c; cnt += (c > 0u) ? 1u : 0u; mine = (j == x) ? c : mine; }
        if (sum == G) break;
        __builtin_amdgcn_s_sleep(1);
        if ((++sp & 255u) == 0u) { if (xb_ld(&bar[XB_TMO])) break; if (sp > XB_SPIN_CAP) { atomicAdd(&bar[XB_TMO], 1u); break; } }
    }
    nloc = mine > 0u ? mine : 1u; nx = cnt > 0u ? cnt : 1u;
}
__device__ __forceinline__ void xcd_barrier(const XcdBarrier& b) {
    asm volatile("s_waitcnt vmcnt(0)" ::: "memory");
    __syncthreads();
    if (threadIdx.x == 0) {
        unsigned* bar = b.bar;
        __builtin_amdgcn_s_waitcnt(0);
        unsigned nloc = b.st[0], nx = b.st[1];
        if (nloc == 0u) { xcd_barrier_complete(bar, b.x, nloc, nx); b.st[0] = nloc; b.st[1] = nx; }
        const unsigned old = xb_add(&bar[XB_XSUB(b.x)], 1u);
        const unsigned gen = old / nloc;
        if (old + 1u == (gen + 1u) * nloc) {
            __builtin_amdgcn_fence(__ATOMIC_RELEASE, "agent");
            asm volatile("s_waitcnt vmcnt(0)" ::: "memory");
            const unsigned og = xb_add(&bar[XB_TOP], 1u);
            const unsigned tg = og / nx;
            if (og + 1u == (tg + 1u) * nx) xb_add(&bar[XB_TOPGEN], 1u);
            else XB_SPIN(xb_ld(&bar[XB_TOPGEN]) == tg, bar);
            __builtin_amdgcn_fence(__ATOMIC_ACQUIRE, "agent");
            xb_add(&bar[XB_XGEN(b.x)], 1u);
            asm volatile("s_waitcnt vmcnt(0)" ::: "memory");
        } else {
            XB_SPIN(xb_ld(&bar[XB_XGEN(b.x)]) == gen, bar);
            __builtin_amdgcn_fence(__ATOMIC_ACQUIRE, "agent");
            asm volatile("s_waitcnt vmcnt(0)" ::: "memory");
        }
    }
    __syncthreads();
}

__device__ __forceinline__ float wave_sum(float v) {
#pragma unroll
    for (int o = 1; o < 64; o <<= 1) v += __shfl_xor(v, o);
    return v;
}
__device__ __forceinline__ unsigned f2bf(float f) { unsigned u = __builtin_bit_cast(unsigned, f); return (u + 0x7fffu + ((u >> 16) & 1u)) >> 16; }
__device__ __forceinline__ unsigned pk2(float lo, float hi) { return f2bf(lo) | (f2bf(hi) << 16); }
__device__ __forceinline__ void transpose_item(const float* W, int ld, int cbase, int K, int k0, bf16_t* WT, int nrow0, const float* fold, int foldmask, float fscale, int foldlim, LAS float* scr, int lane) {
    float wv[32];
#pragma unroll
    for (int i = 0; i < 32; ++i) wv[i] = W[(size_t)(k0 + 2 * i + (lane >> 5)) * ld + cbase + (lane & 31)];
#pragma unroll
    for (int i = 0; i < 32; ++i) { const int kk = 2 * i + (lane >> 5), k = k0 + kk;
        float f = 1.f; if (fold != nullptr && k < foldlim) f = fold[k & foldmask] * fscale;
        scr[kk * 33 + (lane & 31)] = wv[i] * f; }
    LDS_WAIT(); asm volatile("" ::: "memory");
    const int c = lane & 7;
#pragma unroll
    for (int j = 0; j < 4; ++j) { const int n = (lane >> 3) + 8 * j; const LAS float* s = scr + (8 * c) * 33 + n;
        u32x4 o; o.x = pk2(s[0 * 33], s[1 * 33]); o.y = pk2(s[2 * 33], s[3 * 33]); o.z = pk2(s[4 * 33], s[5 * 33]); o.w = pk2(s[6 * 33], s[7 * 33]);
        *(u32x4*)(WT + (size_t)(nrow0 + n) * K + k0 + 8 * c) = o; }
    LDS_WAIT(); asm volatile("" ::: "memory");
}

__device__ __forceinline__ void absmax_item(const float* W, int ld, int cbase, int k0, unsigned* wmax, const float* fold, int lane) {
    float wv[32];
#pragma unroll
    for (int i = 0; i < 32; ++i) wv[i] = W[(size_t)(k0 + 2 * i + (lane >> 5)) * ld + cbase + (lane & 31)];
    float m = 0.f;
#pragma unroll
    for (int i = 0; i < 32; ++i) m = __builtin_fmaxf(m, __builtin_fabsf(wv[i] * (fold ? fold[k0 + 2 * i + (lane >> 5)] : 1.f)));
    m = __builtin_fmaxf(m, __shfl_xor(m, 32));
    if (lane < 32) (void)__hip_atomic_fetch_max(wmax + lane, __float_as_uint(m), __ATOMIC_RELAXED, __HIP_MEMORY_SCOPE_AGENT);
}
__device__ __forceinline__ void quant_item(const float* W, int ld, int cbase, int K, int k0, signed char* WQ, int nrow0, const float* fold, const unsigned* wmax, LAS float* scr, int lane) {
    float wv[32];
#pragma unroll
    for (int i = 0; i < 32; ++i) wv[i] = W[(size_t)(k0 + 2 * i + (lane >> 5)) * ld + cbase + (lane & 31)];
    const float am = __uint_as_float(__hip_atomic_load(wmax + (lane & 31), __ATOMIC_RELAXED, __HIP_MEMORY_SCOPE_AGENT)); const float inv = am > 0.f ? 127.0f / am : 0.f;
#pragma unroll
    for (int i = 0; i < 32; ++i) { const int kk = 2 * i + (lane >> 5); scr[kk * 33 + (lane & 31)] = wv[i] * fold[k0 + kk] * inv; }
    LDS_WAIT(); asm volatile("" ::: "memory");
    const int n = lane >> 1, c = lane & 1; const LAS float* sp = scr + (32 * c) * 33 + n;
    u32x4 o0, o1;
    o0.x = q4(sp[0 * 33], sp[1 * 33], sp[2 * 33], sp[3 * 33]);     o0.y = q4(sp[4 * 33], sp[5 * 33], sp[6 * 33], sp[7 * 33]);
    o0.z = q4(sp[8 * 33], sp[9 * 33], sp[10 * 33], sp[11 * 33]);   o0.w = q4(sp[12 * 33], sp[13 * 33], sp[14 * 33], sp[15 * 33]);
    o1.x = q4(sp[16 * 33], sp[17 * 33], sp[18 * 33], sp[19 * 33]); o1.y = q4(sp[20 * 33], sp[21 * 33], sp[22 * 33], sp[23 * 33]);
    o1.z = q4(sp[24 * 33], sp[25 * 33], sp[26 * 33], sp[27 * 33]); o1.w = q4(sp[28 * 33], sp[29 * 33], sp[30 * 33], sp[31 * 33]);
    u32x4* dst = (u32x4*)(WQ + (size_t)(nrow0 + n) * K + k0 + 32 * c);
    dst[0] = o0; dst[1] = o1;
    LDS_WAIT(); asm volatile("" ::: "memory");
}

__device__ __forceinline__ void quantf8_item(const float* W, int ld, int cbase, int K, int k0, unsigned char* WQ, int nrow0, const unsigned* wmax, LAS float* scr, int lane) {
    float wv[32];
#pragma unroll
    for (int i = 0; i < 32; ++i) wv[i] = W[(size_t)(k0 + 2 * i + (lane >> 5)) * ld + cbase + (lane & 31)];
    const float am = __uint_as_float(__hip_atomic_load(wmax + (lane & 31), __ATOMIC_RELAXED, __HIP_MEMORY_SCOPE_AGENT)); const float inv = am > 0.f ? W8_TOP / am : 0.f;
#pragma unroll
    for (int i = 0; i < 32; ++i) { const int kk = 2 * i + (lane >> 5); scr[kk * 33 + (lane & 31)] = wv[i] * inv; }
    LDS_WAIT(); asm volatile("" ::: "memory");
    const int n = lane >> 1, c = lane & 1; const LAS float* sp = scr + (32 * c) * 33 + n;
    u32x4 o0, o1;
    o0.x = f8x4(sp[0 * 33], sp[1 * 33], sp[2 * 33], sp[3 * 33]);     o0.y = f8x4(sp[4 * 33], sp[5 * 33], sp[6 * 33], sp[7 * 33]);
    o0.z = f8x4(sp[8 * 33], sp[9 * 33], sp[10 * 33], sp[11 * 33]);   o0.w = f8x4(sp[12 * 33], sp[13 * 33], sp[14 * 33], sp[15 * 33]);
    o1.x = f8x4(sp[16 * 33], sp[17 * 33], sp[18 * 33], sp[19 * 33]); o1.y = f8x4(sp[20 * 33], sp[21 * 33], sp[22 * 33], sp[23 * 33]);
    o1.z = f8x4(sp[24 * 33], sp[25 * 33], sp[26 * 33], sp[27 * 33]); o1.w = f8x4(sp[28 * 33], sp[29 * 33], sp[30 * 33], sp[31 * 33]);
    u32x4* dst = (u32x4*)(WQ + (size_t)(nrow0 + n) * K + k0 + 32 * c);
    dst[0] = o0; dst[1] = o1;
    LDS_WAIT(); asm volatile("" ::: "memory");
}

struct Args { const float* in[22]; float* out; unsigned char* ws; int ph_lo, ph_hi, li, pad; };

__global__ void __launch_bounds__(NWAVES * 64, 2) hymba_fwd(Args args) {
    extern __shared__ __attribute__((aligned(16))) unsigned char lds_raw[];
    LAS unsigned char* lds = (LAS unsigned char*)lds_raw;
    volatile LAS unsigned* MISC = (volatile LAS unsigned*)(lds + MISC_OFF);
    const int tid = threadIdx.x, lane = tid & 63, wave = __builtin_amdgcn_readfirstlane(tid >> 6);
    const int G = gridDim.x; const int bx = blockIdx.x; const int vcu = (G % 8 == 0) ? (bx % 8) * (G / 8) + bx / 8 : bx;
    unsigned char* ws = args.ws;
    unsigned* ctl = (unsigned*)(ws + WS_CTL);
    const float* xp = args.in[0]; const float* xs = args.in[1];
    bf16_t* W1 = (bf16_t*)(ws + WS_W1); bf16_t* W2 = (bf16_t*)(ws + WS_W2); bf16_t* W3 = (bf16_t*)(ws + WS_W3); bf16_t* W4 = (bf16_t*)(ws + WS_W4);
    bf16_t* PROJ = (bf16_t*)(ws + WS_PROJ); bf16_t* X1B = (bf16_t*)(ws + WS_X1B); bf16_t* ACT = (bf16_t*)(ws + WS_ACT);
    bf16_t* OB = (bf16_t*)(ws + WS_OB);
    signed char* XQ = (signed char*)(ws + WS_XQ); float* FX = (float*)(ws + WS_FX); signed char* W1Q = (signed char*)(ws + WS_W1);
    for (int u = tid; u < 128; u += NWAVES * 64) ((LAS unsigned*)(lds + MISC_OFF))[u] = 0u;
    __syncthreads();
    XcdBarrier bar; bar.bar = ctl + CW_BAR + args.li * XCD_BAR_WORDS; bar.x = 0; bar.st = nullptr;
    if (MK_N_LAUNCHES != 6) bar = xcd_barrier_post(ctl + CW_BAR + args.li * XCD_BAR_WORDS, MISC + 8);
    const int lo = args.ph_lo, hi_ph = args.ph_hi;
#ifndef ONLY_PHASE
#define ONLY_PHASE -1
#endif
#define IN(k) ((ONLY_PHASE < 0 || ONLY_PHASE == (k)) && lo <= (k) && (k) < hi_ph)
#define BOTH(k) (IN(k) && IN((k) + 1))
#define GRID_BAR() do { if (MK_N_LAUNCHES != 6) xcd_barrier(bar); } while (0)

    if (IN(0)) {
        LAS float* scr = (LAS float*)(lds + wave * 16384);
        const int gw = vcu * NWAVES + wave, NGW = G * NWAVES;
        constexpr int I1 = (DM / 64) * (DIN / 32), I2 = (DM / 64) * (DM / 32), I3 = (DM / 64) * (2 * DFF / 32), I4 = (DFF / 64) * (DM / 32);
        for (int it = gw; it < I1 + I2 + I3 + I4; it += NGW) {
            int r = it;
            if (r < I1) { const int nblk = DIN / 32, kb = r / nblk, nb = r % nblk, n0 = 32 * nb, pn = n0 >> 8, p = n0 & 255, bj = p >> 7, wc = (p & 127) >> 5;
                absmax_item(args.in[3], DIN, 256 * pn + 64 * wc + 32 * bj, 64 * kb, ctl + CW_WMAX1 + n0, args.in[2], lane);
                asm volatile("s_waitcnt vmcnt(0)" ::: "memory"); if (lane == 0) (void)__hip_atomic_fetch_add(ctl + CW_W1CNT, 1u, __ATOMIC_RELAXED, __HIP_MEMORY_SCOPE_AGENT); continue; } r -= I1;
            if (r < I2) { const int nblk = DM / 32, kb = r / nblk, nb = r % nblk;
                const int n0 = 32 * nb, pn = n0 >> 8, p = n0 & 255, bj = p >> 7, wc = (p & 127) >> 5;
                transpose_item(args.in[15], DM, 256 * pn + 64 * wc + 32 * bj, DM, 64 * kb, W2, n0, args.in[10], 127, 1.0f - LAM_INIT, 512, scr, lane); continue; } r -= I2;
            if (r < I3) { const int nblk = 2 * DFF / 32, kb = r / nblk, nb = r % nblk, n0 = 32 * nb, pn = n0 >> 8, p = n0 & 255, bj = p >> 7, e0 = p & 127;
                absmax_item(bj ? args.in[18] : args.in[17], DFF, 128 * pn + e0, 64 * kb, ctl + CW_WMAX + n0, args.in[16], lane); continue; } r -= I3;
            { const int nblk = DM / 32, kb = r / nblk, nb = r % nblk;
                absmax_item(args.in[21], DM, 32 * nb, 64 * kb, ctl + CW_WMAX4 + 32 * nb, nullptr, lane); }
        }
        for (int m = gw; m < NTOK; m += 4 * NGW) {
            f32x4 v[4][4]; float ss[4]; int mr[4];
#pragma unroll
            for (int q = 0; q < 4; ++q) { int mm = m + q * NGW; mr[q] = mm; if (mm >= NTOK) mm = m;
                const float* xr = mm < TOK_P ? xp + (size_t)mm * DM : xs + (size_t)(mm - TOK_P) * DM;
#pragma unroll
                for (int j = 0; j < 4; ++j) v[q][j] = __builtin_nontemporal_load((const f32x4*)xr + 64 * j + lane); }
#pragma unroll
            for (int q = 0; q < 4; ++q) { ss[q] = 0.f;
#pragma unroll
                for (int j = 0; j < 4; ++j) ss[q] += dot4(v[q][j]); }
#pragma unroll
            for (int o = 1; o < 64; o <<= 1) {
#pragma unroll
                for (int q = 0; q < 4; ++q) ss[q] += __shfl_xor(ss[q], o); }
            float am[4];
#pragma unroll
            for (int q = 0; q < 4; ++q) { float a = 0.f;
#pragma unroll
                for (int j = 0; j < 4; ++j) a = __builtin_fmaxf(__builtin_fmaxf(a, __builtin_fmaxf(__builtin_fabsf(v[q][j][0]), __builtin_fabsf(v[q][j][1]))), __builtin_fmaxf(__builtin_fabsf(v[q][j][2]), __builtin_fabsf(v[q][j][3])));
                am[q] = a; }
#pragma unroll
            for (int o = 1; o < 64; o <<= 1) {
#pragma unroll
                for (int q = 0; q < 4; ++q) am[q] = __builtin_fmaxf(am[q], __shfl_xor(am[q], o)); }
#pragma unroll
            for (int q = 0; q < 4; ++q) if (mr[q] < NTOK) { const float ms = ss[q] * (1.f / DM) + EPS; const float r = __builtin_amdgcn_rsqf(ms);
                { const float inv = am[q] > 0.f ? 127.0f / am[q] : 0.f;
                  unsigned* oq = (unsigned*)(XQ + (size_t)mr[q] * DM) + lane;
#pragma unroll
                  for (int j = 0; j < 4; ++j) oq[64 * j] = q4(v[q][j][0] * inv, v[q][j][1] * inv, v[q][j][2] * inv, v[q][j][3] * inv);
                  if (lane == 0) FX[mr[q]] = am[q] * r * (1.0f / 127.0f); }
            }
        }
        { unsigned sp = 0; while (__builtin_amdgcn_readfirstlane(__hip_atomic_load(ctl + CW_W1CNT, __ATOMIC_RELAXED, __HIP_MEMORY_SCOPE_AGENT)) < (unsigned)I1) { __builtin_amdgcn_s_sleep(2); if (++sp > (1u << 22)) break; }
          __builtin_amdgcn_fence(__ATOMIC_ACQUIRE, "agent"); }
        for (int r = gw; r < I1; r += NGW) { const int nblk = DIN / 32, kb = r / nblk, nb = r % nblk, n0 = 32 * nb, pn = n0 >> 8, p = n0 & 255, bj = p >> 7, wc = (p & 127) >> 5;
            quant_item(args.in[3], DIN, 256 * pn + 64 * wc + 32 * bj, DM, 64 * kb, W1Q, n0, args.in[2], ctl + CW_WMAX1 + n0, scr, lane); }
        if (BOTH(0)) GRID_BAR();
    }

    if (IN(1)) {
        pg8::Gemm g{(const bf16_t*)XQ, (const bf16_t*)W1Q, DM / 2, 256}; pg8::StaticOrder S; S.init(NTOK / 256, DIN / 256, G, bx);
        { LAS float* gl = (LAS float*)(lds + EPX_OFF);
          if (tid < 256) { const int v = tid >> 6, d = tid & 63; gl[tid] = (v == 0 ? args.in[4] : v == 1 ? args.in[5] : v == 2 ? args.in[11] : args.in[12])[d]; }
          LDS_WAIT(); __syncthreads(); }
        pg8::EpiProj E{PROJ, (const LAS float*)(lds + EPX_OFF), FX, (const float*)(ctl + CW_WMAX1)};
        pg8::gemm_phase<pg8::EpiProj, pg8::StaticOrder, true, true, 1>(lds, g, S, E);
        if (BOTH(1)) GRID_BAR();
    }

    if (IN(2)) {
        if (wave == 0) {
            const float a = args.in[6][lane] * args.in[7][lane], b2 = args.in[8][lane] * args.in[9][lane];
            const float sa = wave_sum(a), sb = wave_sum(b2);
            if (lane == 0) ((LAS float*)(lds + MISC_OFF))[16] = __expf(sa) - __expf(sb) + LAM_INIT;
        }
        LDS_WAIT(); __syncthreads();
        const float lam = ((const LAS float*)(lds + MISC_OFF))[16];
        const int per = (768 + G - 1) / G;
#ifndef NO_DIFF
        for (int i = 0; i < per; ++i) { const int u = vcu * per + i; if (u < 768) { const int bh = u >> 3, qb = u & 7;
            att::diff_unit(bh >> 2, bh & 3, qb, PROJ, OB, (LAS char*)lds, lam, args.in[14]); } }
#endif
#ifndef NO_WIN
        for (int i = 0; i < per; ++i) { const int u = vcu * per + i; if (u < 768) { const int bk = u >> 4, qb = u & 15;
            att::win_unit(bk >> 1, bk & 1, qb, PROJ, OB, (LAS char*)lds, args.in[14], args.in[13]); } }
#endif
        if (BOTH(2)) GRID_BAR();
    }

    if (IN(3)) {
        pg8::Gemm g{OB, W2, DM, 256}; pg8::StaticOrder S; S.init(NTOK / 256, DM / 256, G, bx);
        {
            LAS float* scr = (LAS float*)(lds + wave * 16384);
            const int gw = vcu * NWAVES + wave, NGW = G * NWAVES;
            constexpr int I3 = (DM / 64) * (2 * DFF / 32);
            for (int r = gw; r < I3; r += NGW) { const int nblk = 2 * DFF / 32, kb = r / nblk, nb = r % nblk, n0 = 32 * nb, pn = n0 >> 8, p = n0 & 255, bj = p >> 7, e0 = p & 127;
                quant_item(bj ? args.in[18] : args.in[17], DFF, 128 * pn + e0, DM, 64 * kb, (signed char*)(ws + WS_W3), n0, args.in[16], ctl + CW_WMAX + n0, scr, lane); }
            constexpr int I4 = (DFF / 64) * (DM / 32);
            for (int r = gw; r < I4; r += NGW) { const int nblk = DM / 32, kb = r / nblk, nb = r % nblk;
                quantf8_item(args.in[21], DM, 32 * nb, DFF, 64 * kb, (unsigned char*)(ws + WS_W4), 32 * nb, ctl + CW_WMAX4 + 32 * nb, scr, lane); }
            __syncthreads();
        }
        pg8::EpiOut E{xp, xs, (float*)(ws + WS_FX), (LAS float*)(lds + EPX_OFF), (signed char*)(ws + WS_X1Q), (float*)(ws + WS_FA), (float*)(ws + WS_XS), ctl + CW_P3CNT};
        pg8::gemm_phase<pg8::EpiOut, pg8::StaticOrder>(lds, g, S, E);
        if (BOTH(3)) GRID_BAR();
    }

    if (IN(4)) {
        signed char* W3Q = (signed char*)(ws + WS_W3); signed char* X1Q = (signed char*)(ws + WS_X1Q); float* FA = (float*)(ws + WS_FA);
        pg8::Gemm g{(const bf16_t*)(X1Q - DM), (const bf16_t*)W3Q, DM / 2, 254}; pg8::StaticOrder S; S.init(194, 2 * DFF / 256, G, bx);
        pg8::EpiFfn E{(unsigned char*)ACT, FA, (const float*)(ctl + CW_WMAX), args.in[19], args.in[20], (LAS float*)(lds + EPX_OFF)};
        pg8::gemm_phase<pg8::EpiFfn, pg8::StaticOrder, true, true, 1>(lds, g, S, E);
        if (BOTH(4)) GRID_BAR();
    }

    if (IN(5)) {
        pg8::Gemm g{ACT, W4, DFF / 2, 256}; pg8::StaticOrder S; S.init(NTOK / 256, DM / 256, G, bx, 1);
        pg8::EpiDown E{(const signed char*)(ws + WS_X1Q), (const float*)(ws + WS_FX), args.out, (const float*)(ctl + CW_WMAX4)};
        pg8::gemm_phase<pg8::EpiDown, pg8::StaticOrder, true, true, 2>(lds, g, S, E);
    }
#undef IN
#undef BOTH
#undef GRID_BAR
}

extern "C" void kernel_launch(void* const* d_in, const int* in_sizes, int n_in, void* d_out, int out_size, void* d_ws, size_t ws_size, hipStream_t stream) {
    static int grid = 0;
    if (grid == 0) {
        if (n_in != 22 || in_sizes[0] != TOK_P * DM || in_sizes[1] != (NTOK - TOK_P) * DM || out_size != NTOK * DM || ws_size < WS_END) {
            fprintf(stderr, "kernel_launch: shape mismatch (n_in %d, in0 %d, in1 %d, out %d, ws %zu; need ws >= %zu)\n", n_in, n_in > 0 ? in_sizes[0] : -1, n_in > 1 ? in_sizes[1] : -1, out_size, ws_size, (size_t)WS_END); grid = -1; return; }
        int dev = 0, cus = 0;
        if (hipGetDevice(&dev) != hipSuccess || hipDeviceGetAttribute(&cus, hipDeviceAttributeMultiprocessorCount, dev) != hipSuccess) { fprintf(stderr, "kernel_launch: device query failed\n"); grid = -1; return; }
        if (hipFuncSetAttribute((const void*)hymba_fwd, hipFuncAttributeMaxDynamicSharedMemorySize, LDS_BYTES) != hipSuccess) { fprintf(stderr, "kernel_launch: hipFuncSetAttribute failed\n"); grid = -1; return; }
        int per_cu = 0;
        if (hipOccupancyMaxActiveBlocksPerMultiprocessor(&per_cu, (const void*)hymba_fwd, NWAVES * 64, LDS_BYTES) != hipSuccess || per_cu < 1)
            fprintf(stderr, "kernel_launch: note: occupancy query reports %d workgroups per CU\n", per_cu);
        (void)hipGetLastError();
        if (cus < 256) { fprintf(stderr, "kernel_launch: %d CUs; this kernel's unit schedule (co-running tile owners in the out-projection epilogue) is built for 256\n", cus); grid = -1; return; }
        grid = 256;
    }
    if (grid < 0) return;
    (void)hipMemsetAsync((char*)d_ws + WS_CTL, 0, CTL_ZERO_BYTES, stream);
    Args a{};
    for (int i = 0; i < 22; ++i) a.in[i] = (const float*)d_in[i];
    a.out = (float*)d_out; a.ws = (unsigned char*)d_ws;
#ifndef PROBE_DUP
#define PROBE_DUP -1
#endif
    constexpr int NL = (PROBE_DUP >= 0) ? 3 : MK_N_LAUNCHES;
    for (int li = 0; li < NL; ++li) {
        if (PROBE_DUP >= 0) {
            a.ph_lo = li == 0 ? 0 : (li == 1 ? PROBE_DUP : PROBE_DUP + 1); a.ph_hi = li == 2 ? 6 : PROBE_DUP + 1; a.li = li;
        } else { a.ph_lo = (NL == 6) ? li : 0; a.ph_hi = (NL == 6) ? li + 1 : 6; a.li = (NL == 6) ? 0 : li; }
        hipLaunchKernelGGL(hymba_fwd, dim3(grid), dim3(NWAVES * 64), LDS_BYTES, stream, a);
        const hipError_t le = hipPeekAtLastError();
        if (le != hipSuccess) { fprintf(stderr, "kernel_launch: launch %d failed: %s\n", li, hipGetErrorName(le)); break; }
    }
}
```

```cpp
#include <hip/hip_runtime.h>
#include <hip/hip_bf16.h>
#include <cstdio>
#include <cstdint>

#ifndef MK_N_LAUNCHES
#define MK_N_LAUNCHES 1
#endif

#define LAS __attribute__((address_space(3)))
#define GAS __attribute__((address_space(1)))
typedef unsigned short bf16_t;
typedef short bf16x8 __attribute__((ext_vector_type(8)));
typedef short s16x4 __attribute__((ext_vector_type(4)));
typedef float f32x2 __attribute__((ext_vector_type(2)));
typedef float f32x4 __attribute__((ext_vector_type(4)));
typedef float f32x16 __attribute__((ext_vector_type(16)));
typedef unsigned u32x2 __attribute__((ext_vector_type(2)));
typedef unsigned u32x4 __attribute__((ext_vector_type(4)));
typedef __bf16 bf16x2_t __attribute__((ext_vector_type(2)));

constexpr int DM = 1024, SEQ = 2048, NSEQ = 24, NTOK = NSEQ * SEQ, TOK_P = 8 * SEQ;
constexpr int DIN = 2304, DFF = 2816;
constexpr int C_DQ = 0, C_DK = 512, C_DV = 1024, C_WQ = 1536, C_WK = 2048, C_WV = 2176;
constexpr int NBH = 12;
constexpr float EPS = 1e-6f, LOG2E = 1.4426950408889634f, QSCALE = 0.125f * LOG2E;
constexpr float LAM_INIT = 0.2f;
constexpr int NWAVES = 8;

__device__ __forceinline__ unsigned cvtpk(float lo, float hi) { f32x2 v = {lo, hi}; bf16x2_t b = __builtin_convertvector(v, bf16x2_t); return __builtin_bit_cast(unsigned, b); }
__device__ __forceinline__ u32x4 pack8(f32x4 a, f32x4 b) { u32x4 w; w.x = cvtpk(a[0], a[1]); w.y = cvtpk(a[2], a[3]); w.z = cvtpk(b[0], b[1]); w.w = cvtpk(b[2], b[3]); return w; }
__device__ __forceinline__ float dot4(f32x4 a) { return (a[0] * a[0] + a[1] * a[1]) + (a[2] * a[2] + a[3] * a[3]); }

__device__ __forceinline__ unsigned q4(float a, float b, float c, float d) {
    const unsigned ua = __float_as_uint(a + 12582912.0f), ub = __float_as_uint(b + 12582912.0f), uc = __float_as_uint(c + 12582912.0f), ud = __float_as_uint(d + 12582912.0f);
    return (ua & 0xffu) | ((ub & 0xffu) << 8) | ((uc & 0xffu) << 16) | (ud << 24);
}
__device__ __forceinline__ unsigned f8x4(float a, float b, float c, float d) {
    int w = 0;
    w = __builtin_amdgcn_cvt_pk_fp8_f32(__builtin_amdgcn_fmed3f(a, -448.f, 448.f), __builtin_amdgcn_fmed3f(b, -448.f, 448.f), w, false);
    w = __builtin_amdgcn_cvt_pk_fp8_f32(__builtin_amdgcn_fmed3f(c, -448.f, 448.f), __builtin_amdgcn_fmed3f(d, -448.f, 448.f), w, true);
    return (unsigned)w;
}
constexpr float ACT8_SCALE = 8.0f, W8_TOP = 224.0f;
namespace pg8 {
constexpr int BM = 256, BK = 64, HALF = 128, HTB = HALF * BK * 2, STAGE_BYTES = 8 * HTB, NXCD = 8, WGM = 8;
__host__ __device__ __forceinline__ int lds_byte(int r, int c) { const int st = (r >> 4) * 2 + (c >> 5), rr = r & 15, cc = c & 31, ob = rr * 64 + cc * 2; return st * 1024 + (ob ^ (((ob >> 9) & 1) << 5)); }
__host__ __device__ __forceinline__ void stage_rc(int b, int& R, int& C) { const int st = b / 1024, sb = b % 1024, swz = sb ^ (((sb >> 9) & 1) << 5); R = (st >> 1) * 16 + swz / 64; C = (st & 1) * 32 + (swz % 64) / 2; }
__host__ __device__ __forceinline__ int perm32(int rho) { const int n = rho >> 4, i = rho & 15; return 8 * (i >> 2) + 4 * n + (i & 3); }

typedef int v4i32_t __attribute__((ext_vector_type(4)));
struct Unit { int pm, pn; };
struct Gemm { const bf16_t* A; const bf16_t* Bt; int K; int arows; };

struct StaticOrder {
    int nM, nN, nwg, G, c, rev;
    __device__ void init(int nM_, int nN_, int G_, int c_, int rev_ = 0) { nM = nM_; nN = nN_; nwg = nM * nN; G = G_; c = c_; rev = rev_; }
    __device__ bool next(int i, Unit& u) const {
        const int nr = (nwg - c + G - 1) / G; if (i >= nr) return false;
        const long L = (long)(rev ? nr - 1 - i : i) * G + c;
        int wgid = (int)L; { const int q = nwg / NXCD, r = nwg % NXCD, xcd = wgid % NXCD, off = wgid / NXCD; wgid = (xcd < r ? xcd * (q + 1) : r * (q + 1) + (xcd - r) * q) + off; }
        const int nig = WGM * nN, gid = wgid / nig, fm = gid * WGM, gsz = (nM - fm) < WGM ? (nM - fm) : WGM;
        u.pm = fm + ((wgid % nig) % gsz); u.pn = (wgid % nig) / gsz; return true;
    }
};


struct EpiProj {
    static constexpr bool PERM = true;
    bf16_t* P; const LAS float* gl; const float* fx; const float* swm;
    __device__ __forceinline__ void pre(const Unit& u, int wid, int lane_) const {
        int lane = lane_; asm volatile("" : "+v"(lane));
        if (wid >= 4) __builtin_amdgcn_global_load_lds((const unsigned*)(fx + u.pm * BM + 64 * (wid - 4) + lane), (LAS unsigned*)((LAS char*)gl + 1024 + (wid - 4) * 256), 4, 0, 0);
        if (wid == 2) __builtin_amdgcn_global_load_lds((const unsigned*)(swm + u.pn * 256 + lane * 4), (LAS unsigned*)((LAS char*)gl + 2048), 16, 0, 0);
    }
    __device__ __forceinline__ void operator()(const f32x4 (&acc)[2][2][4][2], const Unit& u, int wr, int wc, int fr, int fq, int lane) const {
        int fql = fq; asm volatile("" : "+v"(fql));
        f32x4 csw[2][2];
#pragma unroll
        for (int bj = 0; bj < 2; ++bj)
#pragma unroll
            for (int n = 0; n < 2; ++n) csw[bj][n] = *(const LAS f32x4*)(gl + 512 + 128 * bj + 32 * wc + 8 * fql + 4 * n) * (1.0f / 127.0f);
        const int gidx = u.pn * 4 + wc;
        int gsel = -1; float sc = 1.f;
        if (gidx < 8) { gsel = 0; sc = QSCALE; } else if (gidx < 16) { gsel = 1; } else if (gidx < 24) { } else if (gidx < 32) { gsel = 2; sc = QSCALE; } else if (gidx < 34) { gsel = 3; }
        const bool nrm = gsel >= 0; const LAS float* gain = gl + (nrm ? gsel : 0) * 64;
        f32x4 gv[2][2];
#pragma unroll
        for (int bj = 0; bj < 2; ++bj)
#pragma unroll
            for (int n = 0; n < 2; ++n) gv[bj][n] = nrm ? *(const LAS f32x4*)(gain + 32 * bj + 8 * fq + 4 * n) * sc : (f32x4){1.f, 1.f, 1.f, 1.f};
        bf16_t* base = P + (size_t)(u.pm * BM + wr * 64 + fr) * DIN + gidx * 64 + 8 * fq;
#pragma unroll
        for (int ai = 0; ai < 2; ++ai)
#pragma unroll
            for (int m = 0; m < 4; ++m) {
                const float fxr = gl[256 + ai * HALF + wr * 64 + m * 16 + fr];
                f32x4 v00 = __builtin_convertvector(__builtin_bit_cast(v4i32_t, acc[ai][0][m][0]), f32x4) * (csw[0][0] * fxr), v01 = __builtin_convertvector(__builtin_bit_cast(v4i32_t, acc[ai][0][m][1]), f32x4) * (csw[0][1] * fxr);
                f32x4 v10 = __builtin_convertvector(__builtin_bit_cast(v4i32_t, acc[ai][1][m][0]), f32x4) * (csw[1][0] * fxr), v11 = __builtin_convertvector(__builtin_bit_cast(v4i32_t, acc[ai][1][m][1]), f32x4) * (csw[1][1] * fxr);
                float rn = 1.f;
                if (nrm) { float ss = (dot4(v00) + dot4(v01)) + (dot4(v10) + dot4(v11)); ss += __shfl_xor(ss, 16); ss += __shfl_xor(ss, 32); rn = __builtin_amdgcn_rsqf(ss * (1.0f / 64.0f) + EPS); }
                v00 = v00 * rn * gv[0][0]; v01 = v01 * rn * gv[0][1]; v10 = v10 * rn * gv[1][0]; v11 = v11 * rn * gv[1][1];
                bf16_t* rowp = base + (size_t)(ai * HALF + m * 16) * DIN;
                const u32x4 pa = pack8(v00, v01), pb = pack8(v10, v11);
                u32x4 px; px.x = (unsigned)__builtin_amdgcn_mov_dpp((int)pb.x, 0x128, 0xf, 0xf, true); px.y = (unsigned)__builtin_amdgcn_mov_dpp((int)pb.y, 0x128, 0xf, 0xf, true);
                px.z = (unsigned)__builtin_amdgcn_mov_dpp((int)pb.z, 0x128, 0xf, 0xf, true); px.w = (unsigned)__builtin_amdgcn_mov_dpp((int)pb.w, 0x128, 0xf, 0xf, true);
                const bool hi8 = (fr & 8) != 0;
                bf16_t* r1p = base + (size_t)(ai * HALF + m * 16 - (hi8 ? 8 : 0)) * DIN + (hi8 ? 32 : 0);
                bf16_t* r2p = base + (size_t)(ai * HALF + m * 16 + (hi8 ? 0 : 8)) * DIN + (hi8 ? 0 : 32);
                *(u32x4*)(r1p) = hi8 ? px : pa; *(u32x4*)(r2p) = hi8 ? pa : px;
            }
    }
};

struct EpiOut {
    static constexpr bool PERM = true;
    const float* __restrict__ xp; const float* __restrict__ xsm; float* __restrict__ sx1; LAS float* xl;
    signed char* x1q; float* fa; float* xs; unsigned* cnt;
    __device__ __forceinline__ void pre(const Unit&, int, int) const {}
    __device__ __forceinline__ void operator()(f32x4 (&acc)[2][2][4][2], const Unit& u, int wr, int wc, int fr, int fq, int lane) const {
        asm volatile("" : "+v"(fr), "+v"(fq));
        const int rowbase = u.pm * BM;
        const int col0 = u.pn * BM + wc * 64 + 8 * fq;
        const float* xrow0 = rowbase < TOK_P ? xp + (size_t)rowbase * DM : xsm + (size_t)(rowbase - TOK_P) * DM;
#pragma unroll
        for (int ai = 0; ai < 2; ++ai) {
            f32x4 xv[4][2][2];
#pragma unroll
            for (int m = 0; m < 4; ++m) { const float* xr = xrow0 + (size_t)(ai * HALF + wr * 64 + m * 16 + fr) * DM + col0;
#pragma unroll
                for (int bj = 0; bj < 2; ++bj) { xv[m][bj][0] = *(const f32x4*)(xr + bj * 32); xv[m][bj][1] = *(const f32x4*)(xr + bj * 32 + 4); } }
#pragma unroll
            for (int m = 0; m < 4; ++m) {
                const int rl = ai * HALF + wr * 64 + m * 16 + fr; float s = 0.f, am = 0.f;
#pragma unroll
                for (int bj = 0; bj < 2; ++bj) {
                    const f32x4 o0 = xv[m][bj][0] + acc[ai][bj][m][0], o1 = xv[m][bj][1] + acc[ai][bj][m][1];
                    acc[ai][bj][m][0] = o0; acc[ai][bj][m][1] = o1;
#pragma unroll
                    for (int i = 0; i < 4; ++i) am = __builtin_fmaxf(am, __builtin_fmaxf(__builtin_fabsf(o0[i]), __builtin_fabsf(o1[i])));
                    s += dot4(o0) + dot4(o1); }
                s += __shfl_xor(s, 16); s += __shfl_xor(s, 32);
                am = __builtin_fmaxf(am, __shfl_xor(am, 16)); am = __builtin_fmaxf(am, __shfl_xor(am, 32));
                if (fq == 0) { xl[rl * 8 + wc] = s; xl[rl * 8 + 4 + wc] = am; }
            }
        }
        asm volatile("s_waitcnt lgkmcnt(0)" ::: "memory"); __builtin_amdgcn_s_barrier(); asm volatile("" ::: "memory");
        const int t = (wr * 4 + wc) * 64 + lane;
        if (t < 256) {
            const f32x4 q = *(const LAS f32x4*)(xl + t * 8), a4 = *(const LAS f32x4*)(xl + t * 8 + 4);
            float* sl = xs + ((size_t)(rowbase + t) * 4 + u.pn) * 2;
            __hip_atomic_store(sl, (q[0] + q[1]) + (q[2] + q[3]), __ATOMIC_RELAXED, __HIP_MEMORY_SCOPE_AGENT);
            __hip_atomic_store(sl + 1, __builtin_fmaxf(__builtin_fmaxf(a4[0], a4[1]), __builtin_fmaxf(a4[2], a4[3])), __ATOMIC_RELAXED, __HIP_MEMORY_SCOPE_AGENT);
            asm volatile("s_waitcnt vmcnt(0)" ::: "memory");
            if (lane == 0) (void)__hip_atomic_fetch_add(cnt + u.pm, 1u, __ATOMIC_RELAXED, __HIP_MEMORY_SCOPE_AGENT);
        }
        if (t < 64) {
            unsigned sp = 0; while (__builtin_amdgcn_readfirstlane(__hip_atomic_load(cnt + u.pm, __ATOMIC_RELAXED, __HIP_MEMORY_SCOPE_AGENT)) < 16u) { __builtin_amdgcn_s_sleep(1); if (++sp > (1u << 22)) break; }
        }
        asm volatile("s_waitcnt lgkmcnt(0)" ::: "memory"); __builtin_amdgcn_s_barrier(); asm volatile("" ::: "memory");
        if (t < 256) {
            const float* sl = xs + (size_t)(rowbase + t) * 8; float ss = 0.f, am = 0.f;
#pragma unroll
            for (int j = 0; j < 4; ++j) { ss += __hip_atomic_load(sl + 2 * j, __ATOMIC_RELAXED, __HIP_MEMORY_SCOPE_AGENT); am = __builtin_fmaxf(am, __hip_atomic_load(sl + 2 * j + 1, __ATOMIC_RELAXED, __HIP_MEMORY_SCOPE_AGENT)); }
            xl[2048 + t] = am > 0.f ? 127.0f / am : 0.f;
            if (u.pn == 0) { fa[rowbase + t] = __builtin_amdgcn_rsqf(ss * (1.0f / DM) + EPS) * am * (1.0f / 127.0f); sx1[rowbase + t] = am * (1.0f / 127.0f); }
        }
        asm volatile("s_waitcnt lgkmcnt(0)" ::: "memory"); __builtin_amdgcn_s_barrier(); asm volatile("" ::: "memory");
#pragma unroll
        for (int ai = 0; ai < 2; ++ai)
#pragma unroll
            for (int m = 0; m < 4; ++m) { const int rl = ai * HALF + wr * 64 + m * 16 + fr; const float inv = xl[2048 + rl];
                signed char* qp = x1q + (size_t)(rowbase + rl) * DM + col0;
#pragma unroll
                for (int bj = 0; bj < 2; ++bj) { const f32x4 b0 = acc[ai][bj][m][0] * inv, b1 = acc[ai][bj][m][1] * inv;
                    u32x2 o; o.x = q4(b0[0], b0[1], b0[2], b0[3]); o.y = q4(b1[0], b1[1], b1[2], b1[3]);
                    *(u32x2*)(qp + 32 * bj) = o; } }
    }
};

__device__ __forceinline__ float dpp8(float x) { return __builtin_bit_cast(float, __builtin_amdgcn_mov_dpp(__builtin_bit_cast(int, x), 0x128, 0xf, 0xf, true)); }
struct EpiDown {
    static constexpr bool PERM = true;
    const signed char* __restrict__ x1q; const float* __restrict__ sx1; float* __restrict__ out; const float* __restrict__ wmx;
    __device__ __forceinline__ void pre(const Unit&, int, int) const {}
    __device__ __forceinline__ void operator()(const f32x4 (&acc)[2][2][4][2], const Unit& u, int wr, int wc, int fr, int fq, int lane) const {
        asm volatile("" : "+v"(fr), "+v"(fq));
        const int col0 = u.pn * BM + wc * 32 + 8 * fq; const bool hi8 = (fr & 8) != 0;
        f32x4 cs[2][2];
#pragma unroll
        for (int bj = 0; bj < 2; ++bj)
#pragma unroll
            for (int n = 0; n < 2; ++n) cs[bj][n] = *(const f32x4*)(wmx + col0 + bj * HALF + 4 * n) * (1.0f / (W8_TOP * ACT8_SCALE));
#pragma unroll
        for (int ai = 0; ai < 2; ++ai) {
            u32x2 w[4][2]; float sx[4];
#pragma unroll
            for (int m = 0; m < 4; ++m) { const size_t row = (size_t)(u.pm * BM + ai * HALF + wr * 64 + m * 16 + fr); const size_t off = row * DM + col0;
                sx[m] = sx1[row];
#pragma unroll
                for (int bj = 0; bj < 2; ++bj) w[m][bj] = *(const u32x2*)(x1q + off + bj * HALF); }
#pragma unroll
            for (int m = 0; m < 4; ++m) { const size_t off = (size_t)(u.pm * BM + ai * HALF + wr * 64 + m * 16 + fr) * DM + col0;
#pragma unroll
                for (int bj = 0; bj < 2; ++bj) { const int wx = (int)w[m][bj].x, wy = (int)w[m][bj].y;
                    f32x4 r0, r1;
                    r0[0] = (float)((wx << 24) >> 24) * sx[m]; r0[1] = (float)((wx << 16) >> 24) * sx[m]; r0[2] = (float)((wx << 8) >> 24) * sx[m]; r0[3] = (float)(wx >> 24) * sx[m];
                    r1[0] = (float)((wy << 24) >> 24) * sx[m]; r1[1] = (float)((wy << 16) >> 24) * sx[m]; r1[2] = (float)((wy << 8) >> 24) * sx[m]; r1[3] = (float)(wy >> 24) * sx[m];
                    const f32x4 q0 = r0 + acc[ai][bj][m][0] * cs[bj][0], q1 = r1 + acc[ai][bj][m][1] * cs[bj][1];
                    f32x4 qx; qx[0] = dpp8(q1[0]); qx[1] = dpp8(q1[1]); qx[2] = dpp8(q1[2]); qx[3] = dpp8(q1[3]);
                    const long d1 = hi8 ? (long)(4 - 8 * DM) : 0, d2 = hi8 ? 0 : (long)(4 + 8 * DM);
                    *(f32x4*)(out + off + bj * HALF + d1) = hi8 ? qx : q0; *(f32x4*)(out + off + bj * HALF + d2) = hi8 ? q0 : qx; } } }
    }
};

template <int CTRL> __device__ __forceinline__ float dppz(float x) { return __builtin_bit_cast(float, __builtin_amdgcn_update_dpp(0, __builtin_bit_cast(int, x), CTRL, 0xf, 0xf, true)); }
struct EpiFfn {
    static constexpr bool PERM = true;
    unsigned char* act; const float* fa; const float* swm; const float* cw; const float* cb; LAS float* xl;
    __device__ __forceinline__ void pre(const Unit& u, int wid, int lane_) const {
        int lane = lane_; asm volatile("" : "+v"(lane));
        const int tok0 = 254 * u.pm - 1;
        if (wid >= 4) { int tok = tok0 + 64 * (wid - 4) + lane; tok = tok < 0 ? 0 : (tok > NTOK - 1 ? NTOK - 1 : tok);
            __builtin_amdgcn_global_load_lds((const unsigned*)(fa + tok), (LAS unsigned*)((LAS char*)xl + 4096 + (wid - 4) * 256), 4, 0, 0); }
        if (wid == 2) __builtin_amdgcn_global_load_lds((const unsigned*)(swm + u.pn * 256 + lane * 4), (LAS unsigned*)((LAS char*)xl + 5120), 16, 0, 0);
        if (wid < 2) { const float* src = (wid == 0 ? (lane < 32 ? cw : cw + DFF) : (lane < 32 ? cw + 2 * DFF : cb)) + u.pn * 128 + (lane & 31) * 4;
            __builtin_amdgcn_global_load_lds((const unsigned*)src, (LAS unsigned*)((LAS char*)xl + 20480 + wid * 1024), 16, 0, 0); }
    }
    template <int AI, int M, bool MASK>
    __device__ __forceinline__ void conv_rows(const f32x4 (&acc)[2][2][4][2], const f32x4 (&w0)[2], const f32x4 (&w1)[2], const f32x4 (&w2)[2], const f32x4 (&bb)[2],
                                              int tok, int rl, int G, int xc, int fr, int ch0) const {
        const bool pcut = MASK && (tok & (SEQ - 1)) == 0, ncut = MASK && (tok & (SEQ - 1)) == SEQ - 1;
        f32x4 r0, r1;
#pragma unroll
        for (int n = 0; n < 2; ++n) { f32x4 res;
            f32x4 ex = (f32x4){0.f, 0.f, 0.f, 0.f};
            if (M == 0) { if (G > 0) ex = *(const LAS f32x4*)(xl + (2 * (G - 1) + 1) * 128 + xc + 4 * n); ex = fr == 0 ? ex : (f32x4){0.f, 0.f, 0.f, 0.f}; }
            if (M == 3) { if (G < 3) ex = *(const LAS f32x4*)(xl + (2 * (G + 1)) * 128 + xc + 4 * n); ex = fr == 15 ? ex : (f32x4){0.f, 0.f, 0.f, 0.f}; }
#pragma unroll
            for (int i = 0; i < 4; ++i) {
                const float own = acc[AI][0][M][n][i];
                float pr = dppz<0x111>(own);
                pr += (M > 0) ? dppz<0x10F>(acc[AI][0][M > 0 ? M - 1 : 0][n][i]) : ex[i];
                float nx = dppz<0x101>(own);
                nx += (M < 3) ? dppz<0x11F>(acc[AI][0][M < 3 ? M + 1 : 3][n][i]) : ex[i];
                if (MASK) { pr = pcut ? 0.f : pr; nx = ncut ? 0.f : nx; }
                const float uc = fmaf(w0[n][i], pr, fmaf(w1[n][i], own, fmaf(w2[n][i], nx, bb[n][i])));
                const float sg = uc * __builtin_amdgcn_rcpf(1.0f + __builtin_amdgcn_exp2f(-LOG2E * uc));
                res[i] = sg * acc[AI][1][M][n][i] * ACT8_SCALE;
            }
            if (n == 0) r0 = res; else r1 = res; }
        if (rl != 0 && rl != 255 && tok < NTOK) { u32x2 o; o.x = f8x4(r0[0], r0[1], r0[2], r0[3]); o.y = f8x4(r1[0], r1[1], r1[2], r1[3]); *(u32x2*)(act + (size_t)tok * DFF + ch0) = o; }
    }
    __device__ __forceinline__ void operator()(f32x4 (&acc)[2][2][4][2], const Unit& u, int wr, int wc, int fr, int fq, int lane) const {
        const int ch0 = u.pn * 128 + wc * 32 + 8 * fq;
        const int tok0 = 254 * u.pm - 1;
        int fql = fq; asm volatile("" : "+v"(fql));
        const int xc = wc * 32 + 8 * fql;
        f32x4 su[2];
#pragma unroll
        for (int n = 0; n < 2; ++n) su[n] = *(const LAS f32x4*)(xl + 1280 + 128 + xc + 4 * n) * (1.0f / 127.0f);
#pragma unroll
        for (int ai = 0; ai < 2; ++ai)
#pragma unroll
            for (int m = 0; m < 4; ++m) { const float rs = xl[1024 + ai * HALF + wr * 64 + m * 16 + fr];
#pragma unroll
                for (int n = 0; n < 2; ++n) { const f32x4 rsu = su[n] * rs;
                    acc[ai][0][m][n] = __builtin_convertvector(__builtin_bit_cast(v4i32_t, acc[ai][0][m][n]), f32x4) * rs;
                    acc[ai][1][m][n] = __builtin_convertvector(__builtin_bit_cast(v4i32_t, acc[ai][1][m][n]), f32x4) * rsu; } }
#pragma unroll
        for (int ai = 0; ai < 2; ++ai) { const int G = 2 * ai + wr;
            if (fr == 0) { *(LAS f32x4*)(xl + (2 * G) * 128 + xc) = acc[ai][0][0][0]; *(LAS f32x4*)(xl + (2 * G) * 128 + xc + 4) = acc[ai][0][0][1]; }
            if (fr == 15) { *(LAS f32x4*)(xl + (2 * G + 1) * 128 + xc) = acc[ai][0][3][0]; *(LAS f32x4*)(xl + (2 * G + 1) * 128 + xc + 4) = acc[ai][0][3][1]; } }
        asm volatile("s_waitcnt lgkmcnt(0)" ::: "memory"); __builtin_amdgcn_s_barrier(); asm volatile("" ::: "memory"); __builtin_amdgcn_sched_barrier(0);
        f32x4 w0[2], w1[2], w2[2], bb[2];
#pragma unroll
        for (int n = 0; n < 2; ++n) { const LAS float* wl = xl + 5120 + xc + 4 * n; const f32x4 sgc = *(const LAS f32x4*)(xl + 1280 + xc + 4 * n) * (1.0f / 127.0f);
            w0[n] = *(const LAS f32x4*)(wl) * sgc; w1[n] = *(const LAS f32x4*)(wl + 128) * sgc; w2[n] = *(const LAS f32x4*)(wl + 256) * sgc; bb[n] = *(const LAS f32x4*)(wl + 384); }
#define FFN_ROWS(AI, M) do { const int tb_ = tok0 + AI * HALF + wr * 64 + M * 16; const int G_ = 2 * AI + wr; \
        conv_rows<AI, M, true>(acc, w0, w1, w2, bb, tb_ + fr, AI * HALF + wr * 64 + M * 16 + fr, G_, xc, fr, ch0); \
        if ((M) & 1) __builtin_amdgcn_sched_barrier(0); } while (0)
        FFN_ROWS(0, 0); FFN_ROWS(0, 1); FFN_ROWS(0, 2); FFN_ROWS(0, 3); FFN_ROWS(1, 0); FFN_ROWS(1, 1); FFN_ROWS(1, 2); FFN_ROWS(1, 3);
#undef FFN_ROWS
    }
};

typedef int v8i32_t __attribute__((ext_vector_type(8)));
template <class Epi, class Sched, bool ALIGN_EPI = true, bool SP2 = true, int QM = 0>
__device__ __forceinline__ void gemm_phase(LAS unsigned char* lds, const Gemm g, const Sched& S, const Epi& E) {
    const int tid = threadIdx.x, wid = __builtin_amdgcn_readfirstlane(tid >> 6), lane = tid & 63, wr = wid >> 2, wc = wid & 3, fr = lane & 15, fq = lane >> 4;
    const int K = g.K, nt = K / BK;
    unsigned voffA[2], voffB[2];
#pragma unroll
    for (int i = 0; i < 2; ++i) { int R, C; stage_rc(tid * 16 + i * 8192, R, C); const int Rb = Epi::PERM ? ((R & ~31) + perm32(R & 31)) : R;
        voffA[i] = (unsigned)(R * K + C) * 2u; voffB[i] = (unsigned)(Rb * K + C) * 2u; }
    const size_t kstep = (size_t)(BK * 2);
    const size_t hstep = (size_t)HALF * K * 2;
    const size_t tstepB = 2 * hstep;
    const size_t tstepA = (size_t)g.arows * K * 2;
    const unsigned ldsw = (unsigned)wid * 1024u;
    const int aoff = lds_byte(wr * 64 + fr, fq * 8), boff = lds_byte(wc * 32 + fr, fq * 8);
#define PG8_SA(b, h) (((b) * 2 + (h)) * HTB)
#define PG8_SB(b, h) ((4 + (b) * 2 + (h)) * HTB)
#define PG8_STAGE(bufoff, gbase, voff) do { _Pragma("unroll") for (int _i = 0; _i < 2; ++_i) \
        __builtin_amdgcn_global_load_lds((const unsigned*)((const char*)(gbase) + (voff)[_i]), (LAS unsigned*)(lds + (bufoff) + ldsw + _i * 8192), 16, 0, 0); } while (0)
#define PG8_LDA(dst, b, h) do { _Pragma("unroll") for (int m = 0; m < 4; ++m) _Pragma("unroll") for (int k = 0; k < 2; ++k) dst[m][k] = *(const LAS bf16x8*)(lds + PG8_SA(b, h) + aoff + m * 2048 + k * 1024); } while (0)
#define PG8_LDB(dst, b, h) do { _Pragma("unroll") for (int n = 0; n < 2; ++n) _Pragma("unroll") for (int k = 0; k < 2; ++k) dst[n][k] = *(const LAS bf16x8*)(lds + PG8_SB(b, h) + boff + n * 2048 + k * 1024); } while (0)
#define PG8_MMA(ai, bj, At, Bt) do { __builtin_amdgcn_s_setprio(1); \
    if constexpr (QM == 2) { _Pragma("unroll") for (int m = 0; m < 4; ++m) _Pragma("unroll") for (int n = 0; n < 2; ++n) { \
        const v8i32_t b8_ = __builtin_shufflevector(__builtin_bit_cast(v4i32_t, Bt[n][0]), __builtin_bit_cast(v4i32_t, Bt[n][1]), 0, 1, 2, 3, 4, 5, 6, 7), a8_ = __builtin_shufflevector(__builtin_bit_cast(v4i32_t, At[m][0]), __builtin_bit_cast(v4i32_t, At[m][1]), 0, 1, 2, 3, 4, 5, 6, 7); \
        asm volatile("v_mfma_scale_f32_16x16x128_f8f6f4 %0, %1, %2, %0, %3, %3 op_sel_hi:[0,0,0]" : "+v"(acc[ai][bj][m][n]) : "v"(b8_), "v"(a8_), "v"(one8)); } } \
    else _Pragma("unroll") for (int m = 0; m < 4; ++m) _Pragma("unroll") for (int n = 0; n < 2; ++n) _Pragma("unroll") for (int k = 0; k < 2; ++k) \
        { if constexpr (QM == 1) acc[ai][bj][m][n] = __builtin_bit_cast(f32x4, __builtin_amdgcn_mfma_i32_16x16x64_i8(__builtin_bit_cast(v4i32_t, Bt[n][k]), __builtin_bit_cast(v4i32_t, At[m][k]), __builtin_bit_cast(v4i32_t, acc[ai][bj][m][n]), 0, 0, 0)); \
          else acc[ai][bj][m][n] = __builtin_amdgcn_mfma_f32_16x16x32_bf16(Bt[n][k], At[m][k], acc[ai][bj][m][n], 0, 0, 0); } __builtin_amdgcn_s_setprio(0); } while (0)
#define PG8_WAIT_V(n) asm volatile("s_waitcnt vmcnt(" #n ")" ::: "memory")
#define PG8_WAIT_L(n) asm volatile("s_waitcnt lgkmcnt(" #n ")" ::: "memory")
#define PG8_BAR __builtin_amdgcn_s_barrier()
#define PG8_SCHED __builtin_amdgcn_sched_barrier(0)
    Unit cur, nxt; int ui = 0;
    if (!S.next(0, cur)) return;
    const int one8 = 0x7f7f7f7f;
    f32x4 acc[2][2][4][2];
#pragma unroll
    for (int a = 0; a < 2; ++a)
#pragma unroll
        for (int b = 0; b < 2; ++b)
#pragma unroll
            for (int m = 0; m < 4; ++m)
#pragma unroll
                for (int n = 0; n < 2; ++n) acc[a][b][m][n] = (f32x4){0.f, 0.f, 0.f, 0.f};
    bf16x8 At[4][2], B0[2][2], B1[2][2];
    const char* cA = (const char*)g.A + (size_t)cur.pm * tstepA; const char* cB = (const char*)g.Bt + (size_t)cur.pn * tstepB;
    if constexpr (SP2) {
        PG8_STAGE(PG8_SB(0, 0), cB, voffB); PG8_STAGE(PG8_SB(0, 1), cB + hstep, voffB); PG8_STAGE(PG8_SA(0, 0), cA, voffA); PG8_STAGE(PG8_SA(0, 1), cA + hstep, voffA);
        if (wr == 1) PG8_BAR;
        PG8_WAIT_V(2); PG8_BAR;
        PG8_STAGE(PG8_SB(1, 0), cB + kstep, voffB); PG8_STAGE(PG8_SA(1, 0), cA + kstep, voffA); PG8_STAGE(PG8_SB(1, 1), cB + hstep + kstep, voffB);
        PG8_WAIT_V(6); PG8_BAR;
    } else {
        PG8_STAGE(PG8_SB(0, 0), cB, voffB); PG8_STAGE(PG8_SA(0, 0), cA, voffA); PG8_STAGE(PG8_SB(0, 1), cB + hstep, voffB); PG8_STAGE(PG8_SA(0, 1), cA + hstep, voffA);
        if (wr == 1) PG8_BAR;
        PG8_WAIT_V(4); PG8_BAR;
        PG8_STAGE(PG8_SB(1, 0), cB + kstep, voffB); PG8_STAGE(PG8_SA(1, 0), cA + kstep, voffA); PG8_STAGE(PG8_SB(1, 1), cB + hstep + kstep, voffB);
        PG8_WAIT_V(6); PG8_BAR;
    }
    for (;;) {
        const bool has_next = S.next(ui + 1, nxt);
        const char* nA = has_next ? (const char*)g.A + (size_t)nxt.pm * tstepA : cA; const char* nB = has_next ? (const char*)g.Bt + (size_t)nxt.pn * tstepB : cB;
        for (int t = 0; t < nt; t += 2) {
            const bool last = (t == nt - 2);
            const char* a1 = cA + (size_t)(t + 1) * kstep;
            const char* a2 = last ? nA : cA + (size_t)(t + 2) * kstep; const char* b2 = last ? nB : cB + (size_t)(t + 2) * kstep;
            const char* a3 = a2 + kstep; const char* b3 = b2 + kstep;
            if (last) E.pre(cur, wid, lane);
            if constexpr (SP2) {
            PG8_LDB(B0, 0, 0); PG8_LDB(B1, 0, 1); PG8_SCHED; PG8_LDA(At, 0, 0); PG8_STAGE(PG8_SA(1, 1), a1 + hstep, voffA);
            PG8_WAIT_V(8); PG8_WAIT_L(0); PG8_BAR; PG8_MMA(0, 0, At, B0); PG8_MMA(0, 1, At, B1); PG8_BAR; PG8_SCHED;
            PG8_LDA(At, 0, 1); PG8_STAGE(PG8_SB(0, 0), b2, voffB); PG8_STAGE(PG8_SB(0, 1), b2 + hstep, voffB); PG8_STAGE(PG8_SA(0, 0), a2, voffA);
            PG8_WAIT_V(8); PG8_WAIT_L(0); PG8_BAR; PG8_MMA(1, 0, At, B0); PG8_MMA(1, 1, At, B1); PG8_BAR; PG8_SCHED;
            PG8_LDB(B0, 1, 0); PG8_LDB(B1, 1, 1); PG8_SCHED; PG8_LDA(At, 1, 0); PG8_STAGE(PG8_SA(0, 1), a2 + hstep, voffA);
            PG8_WAIT_V(8); PG8_WAIT_L(0); PG8_BAR; PG8_MMA(0, 0, At, B0); PG8_MMA(0, 1, At, B1); PG8_BAR; PG8_SCHED;
            PG8_LDA(At, 1, 1); PG8_STAGE(PG8_SB(1, 0), b3, voffB); PG8_STAGE(PG8_SB(1, 1), b3 + hstep, voffB); PG8_STAGE(PG8_SA(1, 0), a3, voffA);
            PG8_WAIT_V(8); PG8_WAIT_L(0); PG8_BAR; PG8_MMA(1, 0, At, B0); PG8_MMA(1, 1, At, B1); PG8_BAR; PG8_SCHED;
            } else {
            PG8_LDB(B0, 0, 0); PG8_SCHED; PG8_LDA(At, 0, 0); PG8_STAGE(PG8_SA(1, 1), a1 + hstep, voffA);
            PG8_WAIT_L(8); PG8_BAR; PG8_WAIT_L(0); PG8_MMA(0, 0, At, B0); PG8_BAR; PG8_SCHED;
            PG8_LDB(B1, 0, 1); PG8_STAGE(PG8_SB(0, 0), b2, voffB);
            PG8_BAR; PG8_WAIT_L(0); PG8_MMA(0, 1, At, B1); PG8_BAR;
            PG8_LDA(At, 0, 1); PG8_STAGE(PG8_SA(0, 0), a2, voffA);
            PG8_BAR; PG8_WAIT_L(0); PG8_MMA(1, 0, At, B0); PG8_BAR; PG8_SCHED;
            PG8_STAGE(PG8_SB(0, 1), b2 + hstep, voffB);
            PG8_WAIT_V(6); PG8_BAR; PG8_MMA(1, 1, At, B1); PG8_BAR;
            PG8_LDB(B0, 1, 0); PG8_SCHED; PG8_LDA(At, 1, 0); PG8_STAGE(PG8_SA(0, 1), a2 + hstep, voffA);
            PG8_WAIT_L(8); PG8_BAR; PG8_WAIT_L(0); PG8_MMA(0, 0, At, B0); PG8_BAR; PG8_SCHED;
            PG8_LDB(B1, 1, 1); PG8_STAGE(PG8_SB(1, 0), b3, voffB);
            PG8_BAR; PG8_WAIT_L(0); PG8_MMA(0, 1, At, B1); PG8_BAR;
            PG8_LDA(At, 1, 1); PG8_STAGE(PG8_SA(1, 0), a3, voffA);
            PG8_BAR; PG8_WAIT_L(0); PG8_MMA(1, 0, At, B0); PG8_BAR; PG8_SCHED;
            PG8_STAGE(PG8_SB(1, 1), b3 + hstep, voffB);
            PG8_WAIT_V(6); PG8_BAR; PG8_MMA(1, 1, At, B1); PG8_BAR;
            }
        }
        if constexpr (ALIGN_EPI) { if (wr == 0) PG8_BAR; }
        E(acc, cur, wr, wc, fr, fq, lane);
        if (!has_next) break;
#pragma unroll
        for (int a = 0; a < 2; ++a)
#pragma unroll
            for (int b = 0; b < 2; ++b)
#pragma unroll
                for (int m = 0; m < 4; ++m)
#pragma unroll
                    for (int n = 0; n < 2; ++n) acc[a][b][m][n] = (f32x4){0.f, 0.f, 0.f, 0.f};
        cur = nxt; cA = nA; cB = nB; ++ui;
        if constexpr (ALIGN_EPI) { if (wr == 1) PG8_BAR; }
    }
    PG8_WAIT_V(0);
    if constexpr (!ALIGN_EPI) { if (wr == 0) PG8_BAR; }
    PG8_BAR;
#undef PG8_SA
#undef PG8_SB
#undef PG8_STAGE
#undef PG8_LDA
#undef PG8_LDB
#undef PG8_MMA
#undef PG8_WAIT_V
#undef PG8_WAIT_L
#undef PG8_BAR
#undef PG8_SCHED
}
}

namespace att {
constexpr int PITCH = DIN;
#define SBAR() __builtin_amdgcn_sched_barrier(0)
#define KSW(row, colB) ((row) * 128 + ((colB) ^ ((((row) >> 1) & 7) << 4)))
__device__ __forceinline__ int crow(int r, int hi) { return (r & 3) + 8 * (r >> 2) + 4 * hi; }
__device__ __forceinline__ int rel_bucket(int rel) {
    const int n = rel < 0 ? -rel : rel; int v;
    if (n < 8) v = n; else { v = 2 + (31 - __clz(n * n)); v = v > 15 ? 15 : v; }
    return (rel > 0 ? 16 : 0) + v;
}
constexpr float THR = 5.0f;

__device__ __forceinline__ void partialSM(f32x16& p0, f32x16& p1, float off, float& m_reg, float& alpha) {
    float pmax = p0[0];
#pragma unroll
    for (int r = 1; r < 16; ++r) pmax = fmaxf(pmax, p0[r]);
#pragma unroll
    for (int r = 0; r < 16; ++r) pmax = fmaxf(pmax, p1[r]);
    { auto rr = __builtin_amdgcn_permlane32_swap(__float_as_uint(pmax), __float_as_uint(pmax), false, false);
      pmax = fmaxf(__uint_as_float(rr[0]), __uint_as_float(rr[1])); }
    pmax += off;
    if (__builtin_expect(__all(pmax - m_reg <= THR), 1)) { alpha = 1.f; }
    else { const float mn = fmaxf(m_reg, pmax); alpha = __builtin_amdgcn_exp2f(m_reg - mn); m_reg = mn; }
    const float sub = off - m_reg;
#pragma unroll
    for (int r = 0; r < 16; ++r) { p0[r] += sub; p1[r] += sub; }
#pragma unroll
    for (int r = 0; r < 16; ++r) p0[r] = __builtin_amdgcn_exp2f(p0[r]);
}
__device__ __forceinline__ void finishSM(f32x16& p0, f32x16& p1, float alpha, float& l_reg, bf16x8& pa0, bf16x8& pa1, bf16x8& pa2, bf16x8& pa3) {
#pragma unroll
    for (int r = 0; r < 16; ++r) p1[r] = __builtin_amdgcn_exp2f(p1[r]);
    float ps = 0;
#pragma unroll
    for (int r = 0; r < 16; ++r) ps += p0[r];
#pragma unroll
    for (int r = 0; r < 16; ++r) ps += p1[r];
    { auto rr = __builtin_amdgcn_permlane32_swap(__float_as_uint(ps), __float_as_uint(ps), false, false);
      ps = __uint_as_float(rr[0]) + __uint_as_float(rr[1]); }
    l_reg = l_reg * alpha + ps;
#define PK4(P, BASE, OUT) do { unsigned a0 = cvtpk(P[BASE + 0], P[BASE + 1]), a1 = cvtpk(P[BASE + 2], P[BASE + 3]);   \
    unsigned b0 = cvtpk(P[BASE + 4], P[BASE + 5]), b1 = cvtpk(P[BASE + 6], P[BASE + 7]);                              \
    auto r0 = __builtin_amdgcn_permlane32_swap(a0, b0, false, false); auto r1 = __builtin_amdgcn_permlane32_swap(a1, b1, false, false); \
    u32x4 w = {r0[0], r1[0], r0[1], r1[1]}; OUT = __builtin_bit_cast(bf16x8, w); } while (0)
    PK4(p0, 0, pa0); PK4(p0, 8, pa1); PK4(p1, 0, pa2); PK4(p1, 8, pa3);
#undef PK4
}
__device__ __forceinline__ void qkt64(f32x16& p0, f32x16& p1, const LAS char* Ks, const bf16x8* qr, int r32, int hi) {
#pragma unroll
    for (int d0 = 0; d0 < 4; ++d0) { const int cb = (d0 * 16 + hi * 8) * 2;
        const bf16x8 b0 = *(const LAS bf16x8*)(Ks + KSW(r32, cb));
        const bf16x8 b1 = *(const LAS bf16x8*)(Ks + KSW(r32, cb) + 4096);
        p0 = __builtin_amdgcn_mfma_f32_32x32x16_bf16(b0, qr[d0], p0, 0, 0, 0); p1 = __builtin_amdgcn_mfma_f32_32x32x16_bf16(b1, qr[d0], p1, 0, 0, 0); }
}
template <int NCB> __device__ __forceinline__ int v_st(int k, int c) { const int kk = (k & ~0xC) | ((k & 4) << 1) | ((k & 8) >> 1); return ((kk >> 3) * NCB + (c >> 5)) * 512 + ((kk & 7) * 32 + (c & 31)) * 2; }
__device__ __forceinline__ int v_rd_base(int lane) { return ((lane & 3) << 3) | (((lane >> 2) & 3) << 6) | (((lane >> 4) & 1) << 5) | (((lane >> 5) & 1) << 8); }
template <int NCB> constexpr int v_rd_off(int d0, int ks, int half) { return d0 * 512 + ks * (NCB * 1024) + half * (NCB * 512); }
template <int OFF> __device__ __forceinline__ s16x4 tr_read(int vb) { s16x4 r; asm volatile("ds_read_b64_tr_b16 %0, %1 offset:%2" : "=&v"(r) : "v"(vb), "i"(OFF) : "memory"); return r; }
template <int NCB, int D0> __device__ __forceinline__ void pv_one(f32x16& od, int vb, bf16x8 pa0, bf16x8 pa1, bf16x8 pa2, bf16x8 pa3) {
    const s16x4 l0 = tr_read<v_rd_off<NCB>(D0, 0, 0)>(vb), h0 = tr_read<v_rd_off<NCB>(D0, 0, 1)>(vb), l1 = tr_read<v_rd_off<NCB>(D0, 1, 0)>(vb), h1 = tr_read<v_rd_off<NCB>(D0, 1, 1)>(vb);
    const s16x4 l2 = tr_read<v_rd_off<NCB>(D0, 2, 0)>(vb), h2 = tr_read<v_rd_off<NCB>(D0, 2, 1)>(vb), l3 = tr_read<v_rd_off<NCB>(D0, 3, 0)>(vb), h3 = tr_read<v_rd_off<NCB>(D0, 3, 1)>(vb);
    asm volatile("s_waitcnt lgkmcnt(0)" ::: "memory"); SBAR();
#define PK(L, H) (bf16x8){L[0], L[1], L[2], L[3], H[0], H[1], H[2], H[3]}
    od = __builtin_amdgcn_mfma_f32_32x32x16_bf16(pa0, PK(l0, h0), od, 0, 0, 0);
    od = __builtin_amdgcn_mfma_f32_32x32x16_bf16(pa1, PK(l1, h1), od, 0, 0, 0);
    od = __builtin_amdgcn_mfma_f32_32x32x16_bf16(pa2, PK(l2, h2), od, 0, 0, 0);
    od = __builtin_amdgcn_mfma_f32_32x32x16_bf16(pa3, PK(l3, h3), od, 0, 0, 0);
#undef PK
}

constexpr int D_V = 0, D_K = 49152, D_WS = 81920, D_TB = 83968, D_ST = 86016, D_END = D_ST + 65536;
constexpr int NT = SEQ / 64;

typedef short v4i16_t __attribute__((ext_vector_type(4)));
__device__ __forceinline__ s16x4 vtr(const LAS char* p) { return __builtin_bit_cast(s16x4, __builtin_amdgcn_ds_read_tr16_b64_v4i16((LAS v4i16_t*)p)); }
#define PIN(x) asm volatile("" : "+v"(x))
#define MX3(a, b, c) __builtin_fmaxf(__builtin_fmaxf((a), (b)), (c))
#define EX(v) __builtin_amdgcn_exp2f(v)
#define MFMA32(a, b, c) __builtin_amdgcn_mfma_f32_32x32x16_bf16((a), (b), (c), 0, 0, 0)
constexpr float THRL = 6.0f;
__device__ __forceinline__ float rowmax32(const f32x16& C0, const f32x16& C1) {
    float a = MX3(C0[0], C0[1], C1[0]), b = MX3(C0[2], C0[3], C1[1]); a = MX3(a, C1[2], C1[3]);
#pragma unroll
    for (int r = 4; r < 16; r += 4) { a = MX3(a, C0[r], C0[r + 1]); b = MX3(b, C0[r + 2], C0[r + 3]); a = MX3(a, C1[r], C1[r + 1]); b = MX3(b, C1[r + 2], C1[r + 3]); }
    float rm = __builtin_fmaxf(a, b);
    auto rr = __builtin_amdgcn_permlane32_swap(__float_as_uint(rm), __float_as_uint(rm), false, false);
    return __builtin_fmaxf(__uint_as_float(rr[0]), __uint_as_float(rr[1]));
}
__device__ __forceinline__ void diff_pass(f32x16 (&o)[4], float& l_out, const bf16_t* Qw, const bf16_t* __restrict__ Kh, const bf16_t* __restrict__ Vh,
                                          LAS char* lds, int qa, float cL, float cR) {
    const int tid = threadIdx.x, wid = __builtin_amdgcn_readfirstlane(tid >> 6), lane = tid & 63, r32 = lane & 31, hi = lane >> 5;
    LAS char* V_lds = lds + D_V; LAS char* K_lds = lds + D_K;
    LAS float* wsf = (LAS float*)(lds + D_WS) + wid * 64 + 32;
    const LAS float* tb = (const LAS float*)(lds + D_TB);
#pragma unroll
    for (int d = 0; d < 4; ++d) o[d] = f32x16{};
    bf16x8 qr[4];
#pragma unroll
    for (int d0 = 0; d0 < 4; ++d0) qr[d0] = *(const bf16x8*)(Qw + d0 * 16);
#pragma unroll
    for (int d0 = 0; d0 < 4; ++d0) PIN(qr[d0]);
    const bf16_t* ksrc; const bf16_t* vsrc0;
    { const int row = wid * 8 + (lane >> 3), pos = lane & 7;
      ksrc = Kh + (long)row * PITCH + ((pos ^ ((row >> 1) & 7)) * 8);
      vsrc0 = Vh + (long)row * PITCH + ((pos ^ (((row >> 1) & 1) << 2)) * 8); }
    const LAS char* kq[4];
    { const int sw = (r32 >> 1) & 7;
#pragma unroll
      for (int d0 = 0; d0 < 4; ++d0) kq[d0] = K_lds + r32 * 128 + (((2 * d0 + hi) ^ sw) << 4); }
    const LAS char* vpe; const LAS char* vpo;
    { const int q = (lane & 15) >> 2, p = lane & 3, g = (lane >> 4) & 1, sw = (q >> 1) & 1;
      vpe = V_lds + (4 * hi + q) * 128 + sw * 64 + g * 32 + p * 8; vpo = V_lds + (4 * hi + q) * 128 + (sw ^ 1) * 64 + g * 32 + p * 8; }
#define DMA_K(j, ko) __builtin_amdgcn_global_load_lds((const unsigned*)(ksrc + (long)(j) * 64 * PITCH), (LAS unsigned*)(K_lds + (ko) + wid * 1024), 16, 0, 0)
#define DMA_V(j, vo) do { __builtin_amdgcn_global_load_lds((const unsigned*)(vsrc0 + (long)(j) * 64 * PITCH), (LAS unsigned*)(V_lds + (vo) + wid * 1024), 16, 0, 0); \
    __builtin_amdgcn_global_load_lds((const unsigned*)(vsrc0 + 64 + (long)(j) * 64 * PITCH), (LAS unsigned*)(V_lds + (vo) + 8192 + wid * 1024), 16, 0, 0); } while (0)
#define WAIT_BAR(N) do { asm volatile("s_waitcnt vmcnt(" #N ") lgkmcnt(0)" ::: "memory"); __builtin_amdgcn_s_barrier(); asm volatile("" ::: "memory"); } while (0)
    float mhat, l_reg = 0.f; bool resc = false;
    f32x16 pA0, pA1, pB0, pB1;
    bf16x8 kf[4]; s16x4 vlo[6], vhi[6]; u32x4 pw0, pw1, pw2, pw3;
#define KRD(i, KS) do { kf[(i) & 3] = *(const LAS bf16x8*)(kq[(i) >> 1] + (KS) + ((i) & 1) * 4096); } while (0)
    WAIT_BAR(0);
    DMA_K(0, 0); DMA_K(1, 8192); DMA_V(0, 0); DMA_K(2, 16384); DMA_K(3, 24576); DMA_V(1, 16384);
    WAIT_BAR(7);
    {
        float off0 = 0.f; const int d_ = -qa;
        if (d_ <= -154) { pA0 = f32x16{}; pA1 = f32x16{}; off0 = cL; }
        else { const LAS float* t_ = tb + (d_ + 256 + 4 * hi - r32);
#pragma unroll
            for (int r = 0; r < 16; ++r) { pA0[r] = t_[(r & 3) + 8 * (r >> 2)]; pA1[r] = t_[32 + (r & 3) + 8 * (r >> 2)]; } }
#pragma unroll
        for (int d0 = 0; d0 < 4; ++d0) { const bf16x8 k0_ = *(const LAS bf16x8*)(kq[d0]), k1_ = *(const LAS bf16x8*)(kq[d0] + 4096);
            pA0 = MFMA32(k0_, qr[d0], pA0); pA1 = MFMA32(k1_, qr[d0], pA1); }
        const float rm = rowmax32(pA0, pA1);
        mhat = rm + off0;
#pragma unroll
        for (int r = 0; r < 16; ++r) { pA0[r] = EX(pA0[r] - rm); pA1[r] = EX(pA1[r] - rm); }
    }
    WAIT_BAR(3);
    KRD(0, 8192); KRD(1, 8192); KRD(2, 8192); KRD(3, 8192);
#define PKW(P, B) cvtpk(P[B], P[(B) + 1])
#define PAF(k) __builtin_bit_cast(bf16x8, pw##k)
#define VFR(i) (bf16x8){vlo[(i) % 6][0], vlo[(i) % 6][1], vlo[(i) % 6][2], vlo[(i) % 6][3], vhi[(i) % 6][0], vhi[(i) % 6][1], vhi[(i) % 6][2], vhi[(i) % 6][3]}
#define VRD(i, VS) do { const LAS char* vq_ = ((((i) & 3) & 1) ? vpo : vpe) + (VS) + (((i) & 3) >> 1) * 8192 + ((i) >> 2) * 2048; vlo[(i) % 6] = vtr(vq_); vhi[(i) % 6] = vtr(vq_ + 1024); } while (0)
#define GAPA(g, CC, QI, KB, A0, A1, A2, A3, W0, W1, PW) do { CC = MFMA32(kf[(g) & 3], qr[QI], CC); if ((g) + 4 < 8) KRD((g) + 4, KB); sacc += A0; sacc += A1; sacc += A2; sacc += A3; PIN(sacc); W0; W1; PIN(PW); SBAR(); } while (0)
#define GAPB(i, X, B, VB, KN, PRE) do { o[(i) & 3] = MFMA32(PAF_SEL(i), VFR(i), o[(i) & 3]); X[B] = EX(X[B]); X[(B) + 1] = EX(X[(B) + 1]); PIN(X); if ((i) + 5 < 16) VRD((i) + 5, VB); \
    if ((PRE) && (i) >= 8 && (i) < 12) KRD((i) - 8, KN); SBAR(); } while (0)
#define PAF_SEL(i) (((i) >> 2) == 0 ? PAF(0) : ((i) >> 2) == 1 ? PAF(1) : ((i) >> 2) == 2 ? PAF(2) : PAF(3))
#define STEP(C0, C1, P0, P1, t, KB, VB, KN, PRE) do { SBAR(); \
    { const int d_ = (t) * 64 - qa; \
      if (d_ > -154 && d_ < 122) { const LAS float* t_ = tb + (d_ + 256 + 4 * hi - r32); \
        _Pragma("unroll") for (int r = 0; r < 16; ++r) { C0[r] = t_[(r & 3) + 8 * (r >> 2)] - mhat; C1[r] = t_[32 + (r & 3) + 8 * (r >> 2)] - mhat; } } \
      else { const float cs_ = (d_ < 0 ? cL : cR) - mhat; _Pragma("unroll") for (int r = 0; r < 16; ++r) { C0[r] = cs_; C1[r] = cs_; } } } \
    PIN(C0); PIN(C1); SBAR(); \
    float sacc = (P0[0] + P0[1]); \
    GAPA(0, C0, 0, KB, P0[2],  P0[3],  P0[4],  P0[5],  pw0[0] = PKW(P0, 0),  pw0[1] = PKW(P0, 2),  pw0); \
    GAPA(1, C1, 0, KB, P0[6],  P0[7],  P0[8],  P0[9],  pw0[2] = PKW(P0, 4),  pw0[3] = PKW(P0, 6),  pw0); \
    GAPA(2, C0, 1, KB, P0[10], P0[11], P0[12], P0[13], pw1[0] = PKW(P0, 8),  pw1[1] = PKW(P0, 10), pw1); \
    GAPA(3, C1, 1, KB, P0[14], P0[15], P1[0],  P1[1],  pw1[2] = PKW(P0, 12), pw1[3] = PKW(P0, 14), pw1); \
    GAPA(4, C0, 2, KB, P1[2],  P1[3],  P1[4],  P1[5],  pw2[0] = PKW(P1, 0),  pw2[1] = PKW(P1, 2),  pw2); \
    GAPA(5, C1, 2, KB, P1[6],  P1[7],  P1[8],  P1[9],  pw2[2] = PKW(P1, 4),  pw2[3] = PKW(P1, 6),  pw2); \
    GAPA(6, C0, 3, KB, P1[10], P1[11], P1[12], P1[13], pw3[0] = PKW(P1, 8),  pw3[1] = PKW(P1, 10), pw3); \
    GAPA(7, C1, 3, KB, P1[14], P1[15], 0.f,    0.f,    pw3[2] = PKW(P1, 12), pw3[3] = PKW(P1, 14), pw3); \
    l_reg += sacc; \
    VRD(0, VB); VRD(1, VB); VRD(2, VB); VRD(3, VB); VRD(4, VB); \
    { const float rm = rowmax32(C0, C1); resc = false; \
      if (__builtin_expect(__any(rm > THRL), 0)) { const float dl = __builtin_fmaxf(rm, 0.f); mhat += dl; \
        _Pragma("unroll") for (int r = 0; r < 16; ++r) { C0[r] -= dl; C1[r] -= dl; } \
        const float f = EX(-dl); l_reg *= f; if (hi == 0) wsf[r32] = f; resc = true; } } \
    SBAR(); \
    GAPB(0, C0, 0, VB, KN, PRE);  GAPB(1, C0, 2, VB, KN, PRE);  GAPB(2, C0, 4, VB, KN, PRE);   GAPB(3, C0, 6, VB, KN, PRE); \
    GAPB(4, C0, 8, VB, KN, PRE);  GAPB(5, C0, 10, VB, KN, PRE); GAPB(6, C0, 12, VB, KN, PRE);  GAPB(7, C0, 14, VB, KN, PRE); \
    GAPB(8, C1, 0, VB, KN, PRE);  GAPB(9, C1, 2, VB, KN, PRE);  GAPB(10, C1, 4, VB, KN, PRE);  GAPB(11, C1, 6, VB, KN, PRE); \
    GAPB(12, C1, 8, VB, KN, PRE); GAPB(13, C1, 10, VB, KN, PRE); GAPB(14, C1, 12, VB, KN, PRE); GAPB(15, C1, 14, VB, KN, PRE); \
    } while (0)
#define RESC() do { if (resc) { asm volatile("s_waitcnt lgkmcnt(0)" ::: "memory"); \
    _Pragma("unroll") for (int d = 0; d < 4; ++d) _Pragma("unroll") for (int r = 0; r < 16; ++r) o[d][r] *= wsf[crow(r, hi)]; } } while (0)
    int ks_cur = 8192, ks_n1 = 16384, ks_n3 = 0;
    int vs_prev = 0, vs_next = 32768;
#define ROT() do { ks_cur = (ks_cur + 8192) & 24576; ks_n1 = (ks_n1 + 8192) & 24576; ks_n3 = (ks_n3 + 8192) & 24576; vs_prev = vs_prev == 32768 ? 0 : vs_prev + 16384; vs_next = vs_next == 32768 ? 0 : vs_next + 16384; } while (0)
#define STEPX(C0, C1, P0, P1, t, PRE) STEP(C0, C1, P0, P1, t, ks_cur, vs_prev, ks_n1, PRE)
#pragma unroll 1
    for (int t = 1; t + 4 < NT; t += 2) {
        DMA_K(t + 3, ks_n3); DMA_V(t + 1, vs_next);
        STEPX(pB0, pB1, pA0, pA1, t, true);
        WAIT_BAR(3); RESC(); ROT();
        DMA_K(t + 4, ks_n3); DMA_V(t + 2, vs_next);
        STEPX(pA0, pA1, pB0, pB1, t + 1, true);
        WAIT_BAR(3); RESC(); ROT();
    }
    DMA_V(NT - 2, vs_next);
    STEPX(pB0, pB1, pA0, pA1, NT - 3, true);
    WAIT_BAR(2); RESC(); ROT();
    DMA_V(NT - 1, vs_next);
    STEPX(pA0, pA1, pB0, pB1, NT - 2, true);
    WAIT_BAR(2); RESC(); ROT();
    STEPX(pB0, pB1, pA0, pA1, NT - 1, false);
    WAIT_BAR(0); RESC(); ROT();
    { float sacc = 0.f;
#pragma unroll
      for (int r = 0; r < 16; ++r) sacc += pB0[r];
#pragma unroll
      for (int r = 0; r < 16; ++r) sacc += pB1[r];
      l_reg += sacc;
      pw0 = (u32x4){PKW(pB0, 0), PKW(pB0, 2), PKW(pB0, 4), PKW(pB0, 6)}; pw1 = (u32x4){PKW(pB0, 8), PKW(pB0, 10), PKW(pB0, 12), PKW(pB0, 14)};
      pw2 = (u32x4){PKW(pB1, 0), PKW(pB1, 2), PKW(pB1, 4), PKW(pB1, 6)}; pw3 = (u32x4){PKW(pB1, 8), PKW(pB1, 10), PKW(pB1, 12), PKW(pB1, 14)};
      SBAR();
#define DRAIN(i) do { VRD(i, vs_prev); o[(i) & 3] = MFMA32(PAF_SEL(i), VFR(i), o[(i) & 3]); } while (0)
      DRAIN(0); DRAIN(1); DRAIN(2); DRAIN(3); DRAIN(4); DRAIN(5); DRAIN(6); DRAIN(7); DRAIN(8); DRAIN(9); DRAIN(10); DRAIN(11); DRAIN(12); DRAIN(13); DRAIN(14); DRAIN(15);
#undef DRAIN
    }
    { auto rr = __builtin_amdgcn_permlane32_swap(__float_as_uint(l_reg), __float_as_uint(l_reg), false, false); l_out = __uint_as_float(rr[0]) + __uint_as_float(rr[1]); }
#undef DMA_K
#undef DMA_V
#undef WAIT_BAR
#undef ROT
#undef KRD
#undef PKW
#undef PAF
#undef VFR
#undef VRD
#undef GAPA
#undef GAPB
#undef PAF_SEL
#undef STEP
#undef STEPX
#undef RESC
}

__device__ __forceinline__ void diff_unit(int b, int h, int qb, const bf16_t* P, bf16_t* O, LAS char* lds, float lam, const float* relb) {
    const int tid = threadIdx.x, wid = __builtin_amdgcn_readfirstlane(tid >> 6), lane = tid & 63, r32 = lane & 31, hi = lane >> 5;
    const long rowbase = (long)b * SEQ; const int q0 = qb * 256, qa = q0 + wid * 32;
    LAS float* tb = (LAS float*)(lds + D_TB);
    LAS float* li_l = (LAS float*)(lds + D_WS) + wid * 64;
    tb[tid] = relb[rel_bucket(tid - 256) * NBH + h] * LOG2E;
    const float cL = relb[15 * NBH + h] * LOG2E, cR = relb[31 * NBH + h] * LOG2E;
    const bf16_t* Qrow = P + (rowbase + qa + r32) * PITCH + C_DQ + h * 128 + hi * 8;
    const bf16_t* Kh = P + rowbase * PITCH + C_DK + h * 128;
    const bf16_t* Vh = P + rowbase * PITCH + C_DV + h * 128;
    LAS u32x4* stash = (LAS u32x4*)(lds + D_ST + wid * 8192);
    f32x16 o[4]; float l_reg;
#pragma unroll 1
    for (int pass = 0; pass < 2; ++pass) {
        const int mo = pass == 0 ? 64 : 0;
        diff_pass(o, l_reg, Qrow + mo, Kh + mo, Vh, lds, qa, cL, cR);
        int ln = lane; asm volatile("" : "+v"(ln));
        const int r32e = ln & 31, hie = ln >> 5;
        if (hie == 0) li_l[r32e] = l_reg; asm volatile("s_waitcnt lgkmcnt(0)" ::: "memory");
        if (pass == 0) {
            float rli[16];
#pragma unroll
            for (int r = 0; r < 16; ++r) rli[r] = -lam * __builtin_amdgcn_rcpf(li_l[crow(r, hie)]);
#pragma unroll
            for (int d0 = 0; d0 < 4; ++d0) {
                u32x4 w0, w1;
                w0.x = cvtpk(o[d0][0] * rli[0], o[d0][1] * rli[1]); w0.y = cvtpk(o[d0][2] * rli[2], o[d0][3] * rli[3]); w0.z = cvtpk(o[d0][4] * rli[4], o[d0][5] * rli[5]); w0.w = cvtpk(o[d0][6] * rli[6], o[d0][7] * rli[7]);
                w1.x = cvtpk(o[d0][8] * rli[8], o[d0][9] * rli[9]); w1.y = cvtpk(o[d0][10] * rli[10], o[d0][11] * rli[11]); w1.z = cvtpk(o[d0][12] * rli[12], o[d0][13] * rli[13]); w1.w = cvtpk(o[d0][14] * rli[14], o[d0][15] * rli[15]);
                stash[(2 * d0) * 64 + ln] = w0; stash[(2 * d0 + 1) * 64 + ln] = w1;
            }
        } else {
            float rli[16], ssq[16];
#pragma unroll
            for (int r = 0; r < 16; ++r) { rli[r] = __builtin_amdgcn_rcpf(li_l[crow(r, hie)]); ssq[r] = 0.f; }
#pragma unroll
            for (int d0 = 0; d0 < 4; ++d0) {
                const u32x4 w0 = stash[(2 * d0) * 64 + ln], w1 = stash[(2 * d0 + 1) * 64 + ln];
                const unsigned ww[8] = {w0.x, w0.y, w0.z, w0.w, w1.x, w1.y, w1.z, w1.w};
#pragma unroll
                for (int r = 0; r < 16; ++r) { const float c = __uint_as_float((r & 1) ? (ww[r >> 1] & 0xffff0000u) : (ww[r >> 1] << 16));
                    const float x = fmaf(o[d0][r], rli[r], c); o[d0][r] = x; ssq[r] = fmaf(x, x, ssq[r]); }
            }
            asm volatile("s_waitcnt lgkmcnt(0)" ::: "memory");
#pragma unroll
            for (int r = 0; r < 16; ++r) { float s = ssq[r];
                s += __shfl_xor(s, 1); s += __shfl_xor(s, 2); s += __shfl_xor(s, 4); s += __shfl_xor(s, 8); s += __shfl_xor(s, 16);
                ssq[r] = __builtin_amdgcn_rsqf(s * (1.0f / 128.0f) + EPS); }
            LAS bf16_t* stg = (LAS bf16_t*)(lds + D_ST + wid * 8192);
#pragma unroll
            for (int r = 0; r < 16; ++r) { const int orow = crow(r, hie);
#pragma unroll
                for (int d0 = 0; d0 < 4; ++d0) stg[orow * 128 + d0 * 32 + r32e] = (bf16_t)(cvtpk(o[d0][r] * ssq[r], 0.f) & 0xffffu); }
            asm volatile("s_waitcnt lgkmcnt(0)" ::: "memory");
            bf16_t* Ow = O + (rowbase + qa + (ln >> 4)) * DM + h * 128 + (ln & 15) * 8;
            const LAS bf16_t* sl = stg + (ln >> 4) * 128 + (ln & 15) * 8;
#pragma unroll
            for (int i = 0; i < 8; ++i) { const u32x4 v = *(const LAS u32x4*)(sl + i * 512); *(u32x4*)(Ow + (long)i * 4 * DM) = v; }
        }
    }
    asm volatile("s_waitcnt lgkmcnt(0)" ::: "memory"); __syncthreads();
}

constexpr int W_K = 0, W_V = 49152, W_TB = 98304, W_WS = 106496, W_OST = 108544, W_END = W_OST + 32768;
__device__ __forceinline__ void win_unit(int b, int kvh, int qb, const bf16_t* P, bf16_t* O, LAS char* lds, const float* relb, const float* sink) {
    const int tid = threadIdx.x, wid = __builtin_amdgcn_readfirstlane(tid >> 6), lane = tid & 63, r32 = lane & 31, hi = lane >> 5;
    const long rowbase = (long)b * SEQ; const int q0 = qb * 128, kbase = q0 - 128;
    LAS float* tbw = (LAS float*)(lds + W_TB);
#pragma unroll
    for (int e = 0; e < 4; ++e) { const int idx = tid + e * 512, g = idx >> 9, rel = (idx & 511) - 256;
        tbw[idx] = (rel >= -128 && rel <= 128) ? (relb[rel_bucket(rel) * NBH + 4 + 4 * kvh + g] - sink[4 * kvh + g]) * LOG2E : -1e30f; }
    { int tl = tid; asm volatile("" : "+v"(tl));
      const int kr = tl >> 3, kc = (tl & 7) * 8, kst = KSW(kr, kc * 2), vst = v_st<2>(kr, kc);
      const bf16_t* Kh = P + rowbase * PITCH + C_WK + kvh * 64; const bf16_t* Vh = P + rowbase * PITCH + C_WV + kvh * 64;
      bf16x8 kreg[6], vreg[6];
#pragma unroll
      for (int t = 0; t < 6; ++t) { const int k0 = kbase + 64 * t; if (k0 >= 0 && k0 < SEQ) { kreg[t] = *(const bf16x8*)(&Kh[(long)(k0 + kr) * PITCH + kc]); vreg[t] = *(const bf16x8*)(&Vh[(long)(k0 + kr) * PITCH + kc]); } }
#pragma unroll
      for (int t = 0; t < 6; ++t) { const int k0 = kbase + 64 * t; if (k0 >= 0 && k0 < SEQ) { *(LAS bf16x8*)(lds + W_K + t * 8192 + kst) = kreg[t]; *(LAS bf16x8*)(lds + W_V + t * 8192 + vst) = vreg[t]; } }
    }
    __syncthreads();
    const int g = wid >> 1, hq = 4 * kvh + g;
    LAS float* li_l = (LAS float*)(lds + W_WS) + wid * 64;
    const LAS float* tbg = tbw + g * 512;
    const int vbw = (int)(uintptr_t)(lds + W_V) + v_rd_base(lane);
#pragma unroll 1
    for (int jb = 0; jb < 2; ++jb) {
        const int ql = 64 * (wid & 1) + 32 * jb;
        const bf16_t* Qw = P + (rowbase + q0 + ql + r32) * PITCH + C_WQ + hq * 64 + hi * 8;
        bf16x8 qr[4];
#pragma unroll
        for (int d0 = 0; d0 < 4; ++d0) qr[d0] = *(const bf16x8*)(Qw + d0 * 16);
        float l_reg = 0.f;
        f32x16 o[2]; o[0] = f32x16{}; o[1] = f32x16{};
        const int t_lo = ql >> 6;
#pragma unroll 1
        for (int t = t_lo; t < t_lo + 5; ++t) {
            const int k0 = kbase + 64 * t; if (k0 < 0 || k0 >= SEQ) continue;
            const int d_ = 64 * t - 128 - ql;
            const LAS float* t_ = tbg + (d_ + 256 + 4 * hi - r32);
            f32x16 p0, p1;
#pragma unroll
            for (int r = 0; r < 16; ++r) { p0[r] = t_[(r & 3) + 8 * (r >> 2)]; p1[r] = t_[32 + (r & 3) + 8 * (r >> 2)]; }
            qkt64(p0, p1, lds + W_K + t * 8192, qr, r32, hi);
#pragma unroll
            for (int r = 0; r < 16; ++r) { p0[r] = __builtin_amdgcn_exp2f(p0[r]); p1[r] = __builtin_amdgcn_exp2f(p1[r]); }
            bf16x8 pa0, pa1, pa2, pa3;
            {
                float ps = 0;
#pragma unroll
                for (int r = 0; r < 16; ++r) ps += p0[r];
#pragma unroll
                for (int r = 0; r < 16; ++r) ps += p1[r];
                l_reg += ps;
#define PK4(Pv, BASE, OUT) do { unsigned a0 = cvtpk(Pv[BASE + 0], Pv[BASE + 1]), a1 = cvtpk(Pv[BASE + 2], Pv[BASE + 3]);   \
    unsigned b0 = cvtpk(Pv[BASE + 4], Pv[BASE + 5]), b1 = cvtpk(Pv[BASE + 6], Pv[BASE + 7]);                              \
    auto r0 = __builtin_amdgcn_permlane32_swap(a0, b0, false, false); auto r1 = __builtin_amdgcn_permlane32_swap(a1, b1, false, false); \
    u32x4 w = {r0[0], r1[0], r0[1], r1[1]}; OUT = __builtin_bit_cast(bf16x8, w); } while (0)
                PK4(p0, 0, pa0); PK4(p0, 8, pa1); PK4(p1, 0, pa2); PK4(p1, 8, pa3);
#undef PK4
            }
            const int vb = vbw + t * 8192;
            pv_one<2, 0>(o[0], vb, pa0, pa1, pa2, pa3); pv_one<2, 1>(o[1], vb, pa0, pa1, pa2, pa3);
        }
        { auto rr = __builtin_amdgcn_permlane32_swap(__float_as_uint(l_reg), __float_as_uint(l_reg), false, false); l_reg = 1.0f + __uint_as_float(rr[0]) + __uint_as_float(rr[1]); }
        int ln = lane; asm volatile("" : "+v"(ln));
        const int r32e = ln & 31, hie = ln >> 5;
        if (hie == 0) li_l[r32e] = l_reg; asm volatile("s_waitcnt lgkmcnt(0)" ::: "memory");
        float rli[16];
#pragma unroll
        for (int r = 0; r < 16; ++r) rli[r] = __builtin_amdgcn_rcpf(li_l[crow(r, hie)]);
        LAS bf16_t* stg = (LAS bf16_t*)(lds + W_OST + wid * 4096);
#pragma unroll
        for (int r = 0; r < 16; ++r) { const int orow = crow(r, hie);
#pragma unroll
            for (int d0 = 0; d0 < 2; ++d0) stg[orow * 64 + d0 * 32 + r32e] = (bf16_t)(cvtpk(o[d0][r] * rli[r], 0.f) & 0xffffu); }
        asm volatile("s_waitcnt lgkmcnt(0)" ::: "memory");
        bf16_t* Ow = O + (rowbase + q0 + ql + (ln >> 3)) * DM + 512 + hq * 64 + (ln & 7) * 8;
        const LAS bf16_t* sl = stg + (ln >> 3) * 64 + (ln & 7) * 8;
#pragma unroll
        for (int i = 0; i < 4; ++i) { const u32x4 v = *(const LAS u32x4*)(sl + i * 512); *(u32x4*)(Ow + (long)i * 8 * DM) = v; }
        asm volatile("s_waitcnt lgkmcnt(0)" ::: "memory");
    }
    asm volatile("s_waitcnt lgkmcnt(0)" ::: "memory"); __syncthreads();
}
#undef SBAR
#undef KSW
}

constexpr size_t MiB = 1u << 20;
constexpr size_t WS_CTL = 0, CTL_ZERO_BYTES = 64 * 1024;
constexpr size_t WS_W1 = 1 * MiB;
constexpr size_t WS_W2 = WS_W1 + (size_t)DIN * DM * 2;
constexpr size_t WS_W3 = WS_W2 + (size_t)DM * DM * 2;
constexpr size_t WS_W4 = WS_W3 + (size_t)2 * DFF * DM * 2;
constexpr size_t WS_XS = 24 * MiB;
constexpr int CW_WMAX4 = 5120;
constexpr int CW_GBAR = 6400;
constexpr int CW_P3CNT = 4480;
constexpr size_t WS_FA = 26 * MiB;
constexpr size_t WS_FX = 26 * MiB + 512 * 1024;
constexpr int CW_WMAX1 = 13824, CW_W1CNT = 16200;
constexpr int CW_WMAX = 8192;
constexpr size_t WS_PROJ = 28 * MiB;
constexpr size_t WS_OB = 244 * MiB;
constexpr size_t WS_XQ = 340 * MiB;
constexpr size_t WS_X1Q = 340 * MiB;
constexpr size_t WS_X1B = 388 * MiB;
constexpr size_t WS_ACT = 28 * MiB;
constexpr size_t WS_END = WS_X1B + (size_t)NTOK * DM * 2;
static_assert(WS_W4 + (size_t)DM * DFF * 2 <= WS_XS && WS_XS + (size_t)NTOK * 32 <= WS_FA && WS_FA + (size_t)NTOK * 4 <= WS_FX && WS_FX + (size_t)NTOK * 4 <= WS_PROJ, "d_ws map");
static_assert(WS_PROJ + (size_t)NTOK * DIN * 2 <= WS_OB && WS_OB + (size_t)NTOK * DM * 2 <= WS_XQ && WS_XQ + (size_t)NTOK * DM <= WS_X1B && WS_ACT + (size_t)NTOK * DFF * 2 <= WS_X1Q - 4096, "d_ws map");
static_assert(CW_WMAX + 2 * DFF <= CW_WMAX1 && CW_WMAX1 + DIN <= CW_W1CNT && CW_W1CNT * 4 < CTL_ZERO_BYTES && 1024 + 3456 <= CW_P3CNT && CW_P3CNT + 192 <= CW_WMAX4 && CW_WMAX4 + DM <= CW_GBAR && CW_GBAR + 8 * 128 <= CW_WMAX, "d_ws map");
constexpr int CW_BAR = 1024, XCD_BAR_WORDS_C = 3456;

constexpr int RING_BYTES = 131072, EPX_OFF = RING_BYTES, LDS_BYTES = 163840, MISC_OFF = LDS_BYTES - 512;
static_assert(att::D_END <= MISC_OFF && att::W_END <= MISC_OFF && EPX_OFF + 22528 <= MISC_OFF, "LDS map");

typedef GAS unsigned gu32;
#define RLX_AGENT __ATOMIC_RELAXED, __HIP_MEMORY_SCOPE_AGENT
#define LDS_WAIT() asm volatile("s_waitcnt lgkmcnt(0)" ::: "memory")

#define XB_TMO      128
#define XB_XCNT(j)  (256  + 64 * (j))
#define XB_XSUB(j)  (1280 + 64 * (j))
#define XB_XGEN(j)  (2304 + 64 * (j))
#define XB_TOP      3328
#define XB_TOPGEN   3392
#define XCD_BAR_WORDS 3456
#define XB_SPIN_CAP (1u << 22)
__device__ __forceinline__ unsigned xb_ld(unsigned* p)              { return __hip_atomic_load(p, __ATOMIC_RELAXED, __HIP_MEMORY_SCOPE_AGENT); }
__device__ __forceinline__ unsigned xb_add(unsigned* p, unsigned v) { return __hip_atomic_fetch_add(p, v, __ATOMIC_RELAXED, __HIP_MEMORY_SCOPE_AGENT); }
__device__ __forceinline__ unsigned xb_xcc_id() { return (unsigned)__builtin_amdgcn_s_getreg((3 << 11) | 20) & 0xFu; }
#define XB_SPIN(cond, bar) do { unsigned _sp = 0; while (cond) { __builtin_amdgcn_s_sleep(1); \
    if ((++_sp & 255u) == 0u) { if (xb_ld(&(bar)[XB_TMO])) break; if (_sp > XB_SPIN_CAP) { atomicAdd(&(bar)[XB_TMO], 1u); break; } } } } while (0)
struct XcdBarrier { unsigned* bar; unsigned x; volatile LAS unsigned* st; };
__device__ __forceinline__ XcdBarrier xcd_barrier_post(unsigned* bar, volatile LAS unsigned* st) {
    XcdBarrier b; b.bar = bar; b.x = xb_xcc_id(); b.st = st;
    if (threadIdx.x == 0) (void)xb_add(&bar[XB_XCNT(b.x)], 1u);
    return b;
}
__device__ __forceinline__ void xcd_barrier_complete(unsigned* bar, unsigned x, unsigned& nloc, unsigned& nx) {
    const unsigned G = gridDim.x * gridDim.y * gridDim.z;
    unsigned sum, cnt, mine, sp = 0u;
    for (;;) {
        sum = 0u; cnt = 0u; mine = 0u;
#pragma unroll
        for (unsigned j = 0; j < 16; ++j) { const unsigned c = xb_ld(&bar[XB_XCNT(j)]); sum += c; cnt += (c > 0u) ? 1u : 0u; mine = (j == x) ? c : mine; }
        if (sum == G) break;
        __builtin_amdgcn_s_sleep(1);
        if ((++sp & 255u) == 0u) { if (xb_ld(&bar[XB_TMO])) break; if (sp > XB_SPIN_CAP) { atomicAdd(&bar[XB_TMO], 1u); break; } }
    }
    nloc = mine > 0u ? mine : 1u; nx = cnt > 0u ? cnt : 1u;
}
__device__ __forceinline__ void xcd_barrier(const XcdBarrier& b) {
    asm volatile("s_waitcnt vmcnt(0)" ::: "memory");
    __syncthreads();
    if (threadIdx.x == 0) {
        unsigned* bar = b.bar;
        __builtin_amdgcn_s_waitcnt(0);
        unsigned nloc = b.st[0], nx = b.st[1];
        if (nloc == 0u) { xcd_barrier_complete(bar, b.x, nloc, nx); b.st[0] = nloc; b.st[1] = nx; }
        const unsigned old = xb_add(&bar[XB_XSUB(b.x)], 1u);
        const unsigned gen = old / nloc;
        if (old + 1u == (gen + 1u) * nloc) {
            __builtin_amdgcn_fence(__ATOMIC_RELEASE, "agent");
            asm volatile("s_waitcnt vmcnt(0)" ::: "memory");
            const unsigned og = xb_add(&bar[XB_TOP], 1u);
            const unsigned tg = og / nx;
            if (og + 1u == (tg + 1u) * nx) xb_add(&bar[XB_TOPGEN], 1u);
            else XB_SPIN(xb_ld(&bar[XB_TOPGEN]) == tg, bar);
            __builtin_amdgcn_fence(__ATOMIC_ACQUIRE, "agent");
            xb_add(&bar[XB_XGEN(b.x)], 1u);
            asm volatile("s_waitcnt vmcnt(0)" ::: "memory");
        } else {
            XB_SPIN(xb_ld(&bar[XB_XGEN(b.x)]) == gen, bar);
            __builtin_amdgcn_fence(__ATOMIC_ACQUIRE, "agent");
            asm volatile("s_waitcnt vmcnt(0)" ::: "memory");
        }
    }
    __syncthreads();
}

__device__ __forceinline__ void group_barrier(unsigned* gb, unsigned nmem, volatile LAS unsigned* ep) {
    asm volatile("s_waitcnt vmcnt(0)" ::: "memory");
    __syncthreads();
    if (threadIdx.x == 0) {
        __builtin_amdgcn_fence(__ATOMIC_RELEASE, "agent");
        asm volatile("s_waitcnt vmcnt(0)" ::: "memory");
        const unsigned e = ep[0]; ep[0] = e + 1u;
        const unsigned old = xb_add(&gb[0], 1u);
        if (old + 1u == (e + 1u) * nmem) xb_add(&gb[64], 1u);
        else { unsigned sp = 0; while (xb_ld(&gb[64]) == e) { __builtin_amdgcn_s_sleep(1); if (++sp > XB_SPIN_CAP) break; } }
        __builtin_amdgcn_fence(__ATOMIC_ACQUIRE, "agent");
        asm volatile("s_waitcnt vmcnt(0)" ::: "memory");
    }
    __syncthreads();
}

__device__ __forceinline__ float wave_sum(float v) {
#pragma unroll
    for (int o = 1; o < 64; o <<= 1) v += __shfl_xor(v, o);
    return v;
}
__device__ __forceinline__ unsigned f2bf(float f) { unsigned u = __builtin_bit_cast(unsigned, f); return (u + 0x7fffu + ((u >> 16) & 1u)) >> 16; }
__device__ __forceinline__ unsigned pk2(float lo, float hi) { return f2bf(lo) | (f2bf(hi) << 16); }
__device__ __forceinline__ void transpose_item(const float* W, int ld, int cbase, int K, int k0, bf16_t* WT, int nrow0, const float* fold, int foldmask, float fscale, int foldlim, LAS float* scr, int lane) {
    float wv[32];
#pragma unroll
    for (int i = 0; i < 32; ++i) wv[i] = W[(size_t)(k0 + 2 * i + (lane >> 5)) * ld + cbase + (lane & 31)];
#pragma unroll
    for (int i = 0; i < 32; ++i) { const int kk = 2 * i + (lane >> 5), k = k0 + kk;
        float f = 1.f; if (fold != nullptr && k < foldlim) f = fold[k & foldmask] * fscale;
        scr[kk * 33 + (lane & 31)] = wv[i] * f; }
    LDS_WAIT(); asm volatile("" ::: "memory");
    const int c = lane & 7;
#pragma unroll
    for (int j = 0; j < 4; ++j) { const int n = (lane >> 3) + 8 * j; const LAS float* s = scr + (8 * c) * 33 + n;
        u32x4 o; o.x = pk2(s[0 * 33], s[1 * 33]); o.y = pk2(s[2 * 33], s[3 * 33]); o.z = pk2(s[4 * 33], s[5 * 33]); o.w = pk2(s[6 * 33], s[7 * 33]);
        *(u32x4*)(WT + (size_t)(nrow0 + n) * K + k0 + 8 * c) = o; }
    LDS_WAIT(); asm volatile("" ::: "memory");
}

__device__ __forceinline__ void absmax_item(const float* W, int ld, int cbase, int k0, unsigned* wmax, const float* fold, int lane) {
    float wv[32];
#pragma unroll
    for (int i = 0; i < 32; ++i) wv[i] = W[(size_t)(k0 + 2 * i + (lane >> 5)) * ld + cbase + (lane & 31)];
    float m = 0.f;
#pragma unroll
    for (int i = 0; i < 32; ++i) m = __builtin_fmaxf(m, __builtin_fabsf(wv[i] * (fold ? fold[k0 + 2 * i + (lane >> 5)] : 1.f)));
    m = __builtin_fmaxf(m, __shfl_xor(m, 32));
    if (lane < 32) (void)__hip_atomic_fetch_max(wmax + lane, __float_as_uint(m), __ATOMIC_RELAXED, __HIP_MEMORY_SCOPE_AGENT);
}
__device__ __forceinline__ void quant_item(const float* W, int ld, int cbase, int K, int k0, signed char* WQ, int nrow0, const float* fold, const unsigned* wmax, LAS float* scr, int lane) {
    float wv[32];
#pragma unroll
    for (int i = 0; i < 32; ++i) wv[i] = W[(size_t)(k0 + 2 * i + (lane >> 5)) * ld + cbase + (lane & 31)];
    const float am = __uint_as_float(__hip_atomic_load(wmax + (lane & 31), __ATOMIC_RELAXED, __HIP_MEMORY_SCOPE_AGENT)); const float inv = am > 0.f ? 127.0f / am : 0.f;
#pragma unroll
    for (int i = 0; i < 32; ++i) { const int kk = 2 * i + (lane >> 5); scr[kk * 33 + (lane & 31)] = wv[i] * fold[k0 + kk] * inv; }
    LDS_WAIT(); asm volatile("" ::: "memory");
    const int n = lane >> 1, c = lane & 1; const LAS float* sp = scr + (32 * c) * 33 + n;
    u32x4 o0, o1;
    o0.x = q4(sp[0 * 33], sp[1 * 33], sp[2 * 33], sp[3 * 33]);     o0.y = q4(sp[4 * 33], sp[5 * 33], sp[6 * 33], sp[7 * 33]);
    o0.z = q4(sp[8 * 33], sp[9 * 33], sp[10 * 33], sp[11 * 33]);   o0.w = q4(sp[12 * 33], sp[13 * 33], sp[14 * 33], sp[15 * 33]);
    o1.x = q4(sp[16 * 33], sp[17 * 33], sp[18 * 33], sp[19 * 33]); o1.y = q4(sp[20 * 33], sp[21 * 33], sp[22 * 33], sp[23 * 33]);
    o1.z = q4(sp[24 * 33], sp[25 * 33], sp[26 * 33], sp[27 * 33]); o1.w = q4(sp[28 * 33], sp[29 * 33], sp[30 * 33], sp[31 * 33]);
    u32x4* dst = (u32x4*)(WQ + (size_t)(nrow0 + n) * K + k0 + 32 * c);
    dst[0] = o0; dst[1] = o1;
    LDS_WAIT(); asm volatile("" ::: "memory");
}

__device__ __forceinline__ void quantf8_item(const float* W, int ld, int cbase, int K, int k0, unsigned char* WQ, int nrow0, const unsigned* wmax, LAS float* scr, int lane) {
    float wv[32];
#pragma unroll
    for (int i = 0; i < 32; ++i) wv[i] = W[(size_t)(k0 + 2 * i + (lane >> 5)) * ld + cbase + (lane & 31)];
    const float am = __uint_as_float(__hip_atomic_load(wmax + (lane & 31), __ATOMIC_RELAXED, __HIP_MEMORY_SCOPE_AGENT)); const float inv = am > 0.f ? W8_TOP / am : 0.f;
#pragma unroll
    for (int i = 0; i < 32; ++i) { const int kk = 2 * i + (lane >> 5); scr[kk * 33 + (lane & 31)] = wv[i] * inv; }
    LDS_WAIT(); asm volatile("" ::: "memory");
    const int n = lane >> 1, c = lane & 1; const LAS float* sp = scr + (32 * c) * 33 + n;
    u32x4 o0, o1;
    o0.x = f8x4(sp[0 * 33], sp[1 * 33], sp[2 * 33], sp[3 * 33]);     o0.y = f8x4(sp[4 * 33], sp[5 * 33], sp[6 * 33], sp[7 * 33]);
    o0.z = f8x4(sp[8 * 33], sp[9 * 33], sp[10 * 33], sp[11 * 33]);   o0.w = f8x4(sp[12 * 33], sp[13 * 33], sp[14 * 33], sp[15 * 33]);
    o1.x = f8x4(sp[16 * 33], sp[17 * 33], sp[18 * 33], sp[19 * 33]); o1.y = f8x4(sp[20 * 33], sp[21 * 33], sp[22 * 33], sp[23 * 33]);
    o1.z = f8x4(sp[24 * 33], sp[25 * 33], sp[26 * 33], sp[27 * 33]); o1.w = f8x4(sp[28 * 33], sp[29 * 33], sp[30 * 33], sp[31 * 33]);
    u32x4* dst = (u32x4*)(WQ + (size_t)(nrow0 + n) * K + k0 + 32 * c);
    dst[0] = o0; dst[1] = o1;
    LDS_WAIT(); asm volatile("" ::: "memory");
}

struct Args { const float* in[22]; float* out; unsigned char* ws; int ph_lo, ph_hi, li, pad; };

__global__ void __launch_bounds__(NWAVES * 64, 2) hymba_fwd(Args args) {
    extern __shared__ __attribute__((aligned(16))) unsigned char lds_raw[];
    LAS unsigned char* lds = (LAS unsigned char*)lds_raw;
    volatile LAS unsigned* MISC = (volatile LAS unsigned*)(lds + MISC_OFF);
    const int tid = threadIdx.x, lane = tid & 63, wave = __builtin_amdgcn_readfirstlane(tid >> 6);
    const int G = gridDim.x; const int bx = blockIdx.x; const int vcu = (G % 8 == 0) ? (bx % 8) * (G / 8) + bx / 8 : bx;
    unsigned char* ws = args.ws;
    unsigned* ctl = (unsigned*)(ws + WS_CTL);
    const float* xp = args.in[0]; const float* xs = args.in[1];
    bf16_t* W1 = (bf16_t*)(ws + WS_W1); bf16_t* W2 = (bf16_t*)(ws + WS_W2); bf16_t* W3 = (bf16_t*)(ws + WS_W3); bf16_t* W4 = (bf16_t*)(ws + WS_W4);
    bf16_t* PROJ = (bf16_t*)(ws + WS_PROJ); bf16_t* X1B = (bf16_t*)(ws + WS_X1B); bf16_t* ACT = (bf16_t*)(ws + WS_ACT);
    bf16_t* OB = (bf16_t*)(ws + WS_OB);
    signed char* XQ = (signed char*)(ws + WS_XQ); float* FX = (float*)(ws + WS_FX); signed char* W1Q = (signed char*)(ws + WS_W1);
    for (int u = tid; u < 128; u += NWAVES * 64) ((LAS unsigned*)(lds + MISC_OFF))[u] = 0u;
    __syncthreads();
    XcdBarrier bar; bar.bar = ctl + CW_BAR + args.li * XCD_BAR_WORDS; bar.x = 0; bar.st = nullptr;
    if (MK_N_LAUNCHES != 6) bar = xcd_barrier_post(ctl + CW_BAR + args.li * XCD_BAR_WORDS, MISC + 8);
    const int lo = args.ph_lo, hi_ph = args.ph_hi;
#ifndef ONLY_PHASE
#define ONLY_PHASE -1
#endif
#define IN(k) ((ONLY_PHASE < 0 || ONLY_PHASE == (k)) && lo <= (k) && (k) < hi_ph)
#define BOTH(k) (IN(k) && IN((k) + 1))
#define GRID_BAR() do { if (MK_N_LAUNCHES != 6) xcd_barrier(bar); } while (0)
#define GROUP_BAR() do { if (MK_N_LAUNCHES != 6) { if (G == 256) group_barrier(ctl + CW_GBAR + (bx & 7) * 128, 32u, MISC + 12); else xcd_barrier(bar); } } while (0)

    if (IN(0)) {
        LAS float* scr = (LAS float*)(lds + wave * 16384);
        const int gw = vcu * NWAVES + wave, NGW = G * NWAVES;
        constexpr int I1 = (DM / 64) * (DIN / 32), I2 = (DM / 64) * (DM / 32), I3 = (DM / 64) * (2 * DFF / 32), I4 = (DFF / 64) * (DM / 32);
        for (int it = gw; it < I1 + I2 + I3 + I4; it += NGW) {
            int r = it;
            if (r < I1) { const int nblk = DIN / 32, kb = r / nblk, nb = r % nblk, n0 = 32 * nb, pn = n0 >> 8, p = n0 & 255, bj = p >> 7, wc = (p & 127) >> 5;
                absmax_item(args.in[3], DIN, 256 * pn + 64 * wc + 32 * bj, 64 * kb, ctl + CW_WMAX1 + n0, args.in[2], lane);
                asm volatile("s_waitcnt vmcnt(0)" ::: "memory"); if (lane == 0) (void)__hip_atomic_fetch_add(ctl + CW_W1CNT, 1u, __ATOMIC_RELAXED, __HIP_MEMORY_SCOPE_AGENT); continue; } r -= I1;
            if (r < I2) { const int nblk = DM / 32, kb = r / nblk, nb = r % nblk;
                const int n0 = 32 * nb, pn = n0 >> 8, p = n0 & 255, bj = p >> 7, wc = (p & 127) >> 5;
                transpose_item(args.in[15], DM, 256 * pn + 64 * wc + 32 * bj, DM, 64 * kb, W2, n0, args.in[10], 127, 1.0f - LAM_INIT, 512, scr, lane); continue; } r -= I2;
            if (r < I3) { const int nblk = 2 * DFF / 32, kb = r / nblk, nb = r % nblk, n0 = 32 * nb, pn = n0 >> 8, p = n0 & 255, bj = p >> 7, e0 = p & 127;
                absmax_item(bj ? args.in[18] : args.in[17], DFF, 128 * pn + e0, 64 * kb, ctl + CW_WMAX + n0, args.in[16], lane); continue; } r -= I3;
            { const int nblk = DM / 32, kb = r / nblk, nb = r % nblk;
                absmax_item(args.in[21], DM, 32 * nb, 64 * kb, ctl + CW_WMAX4 + 32 * nb, nullptr, lane); }
        }
        for (int m = gw; m < NTOK; m += 4 * NGW) {
            f32x4 v[4][4]; float ss[4]; int mr[4];
#pragma unroll
            for (int q = 0; q < 4; ++q) { int mm = m + q * NGW; mr[q] = mm; if (mm >= NTOK) mm = m;
                const float* xr = mm < TOK_P ? xp + (size_t)mm * DM : xs + (size_t)(mm - TOK_P) * DM;
#pragma unroll
                for (int j = 0; j < 4; ++j) v[q][j] = __builtin_nontemporal_load((const f32x4*)xr + 64 * j + lane); }
#pragma unroll
            for (int q = 0; q < 4; ++q) { ss[q] = 0.f;
#pragma unroll
                for (int j = 0; j < 4; ++j) ss[q] += dot4(v[q][j]); }
#pragma unroll
            for (int o = 1; o < 64; o <<= 1) {
#pragma unroll
                for (int q = 0; q < 4; ++q) ss[q] += __shfl_xor(ss[q], o); }
            float am[4];
#pragma unroll
            for (int q = 0; q < 4; ++q) { float a = 0.f;
#pragma unroll
                for (int j = 0; j < 4; ++j) a = __builtin_fmaxf(__builtin_fmaxf(a, __builtin_fmaxf(__builtin_fabsf(v[q][j][0]), __builtin_fabsf(v[q][j][1]))), __builtin_fmaxf(__builtin_fabsf(v[q][j][2]), __builtin_fabsf(v[q][j][3])));
                am[q] = a; }
#pragma unroll
            for (int o = 1; o < 64; o <<= 1) {
#pragma unroll
                for (int q = 0; q < 4; ++q) am[q] = __builtin_fmaxf(am[q], __shfl_xor(am[q], o)); }
#pragma unroll
            for (int q = 0; q < 4; ++q) if (mr[q] < NTOK) { const float ms = ss[q] * (1.f / DM) + EPS; const float r = __builtin_amdgcn_rsqf(ms);
                { const float inv = am[q] > 0.f ? 127.0f / am[q] : 0.f;
                  unsigned* oq = (unsigned*)(XQ + (size_t)mr[q] * DM) + lane;
#pragma unroll
                  for (int j = 0; j < 4; ++j) oq[64 * j] = q4(v[q][j][0] * inv, v[q][j][1] * inv, v[q][j][2] * inv, v[q][j][3] * inv);
                  if (lane == 0) FX[mr[q]] = am[q] * r * (1.0f / 127.0f); }
            }
        }
        { unsigned sp = 0; while (__builtin_amdgcn_readfirstlane(__hip_atomic_load(ctl + CW_W1CNT, __ATOMIC_RELAXED, __HIP_MEMORY_SCOPE_AGENT)) < (unsigned)I1) { __builtin_amdgcn_s_sleep(2); if (++sp > (1u << 22)) break; }
          __builtin_amdgcn_fence(__ATOMIC_ACQUIRE, "agent"); }
        for (int r = gw; r < I1; r += NGW) { const int nblk = DIN / 32, kb = r / nblk, nb = r % nblk, n0 = 32 * nb, pn = n0 >> 8, p = n0 & 255, bj = p >> 7, wc = (p & 127) >> 5;
            quant_item(args.in[3], DIN, 256 * pn + 64 * wc + 32 * bj, DM, 64 * kb, W1Q, n0, args.in[2], ctl + CW_WMAX1 + n0, scr, lane); }
        if (BOTH(0)) GRID_BAR();
    }

    if (IN(1)) {
        pg8::Gemm g{(const bf16_t*)XQ, (const bf16_t*)W1Q, DM / 2, 256}; pg8::StaticOrder S; S.init(NTOK / 256, DIN / 256, G, bx);
        { LAS float* gl = (LAS float*)(lds + EPX_OFF);
          if (tid < 256) { const int v = tid >> 6, d = tid & 63; gl[tid] = (v == 0 ? args.in[4] : v == 1 ? args.in[5] : v == 2 ? args.in[11] : args.in[12])[d]; }
          LDS_WAIT(); __syncthreads(); }
        pg8::EpiProj E{PROJ, (const LAS float*)(lds + EPX_OFF), FX, (const float*)(ctl + CW_WMAX1)};
        pg8::gemm_phase<pg8::EpiProj, pg8::StaticOrder, true, true, 1>(lds, g, S, E);
        if (BOTH(1)) GROUP_BAR();
    }

    if (IN(2)) {
        if (wave == 0) {
            const float a = args.in[6][lane] * args.in[7][lane], b2 = args.in[8][lane] * args.in[9][lane];
            const float sa = wave_sum(a), sb = wave_sum(b2);
            if (lane == 0) ((LAS float*)(lds + MISC_OFF))[16] = __expf(sa) - __expf(sb) + LAM_INIT;
        }
        LDS_WAIT(); __syncthreads();
        const float lam = ((const LAS float*)(lds + MISC_OFF))[16];
        const int per = (768 + G - 1) / G;
#ifndef NO_DIFF
        for (int i = 0; i < per; ++i) { const int u = vcu * per + i; if (u < 768) { const int bh = u >> 3, qb = u & 7;
            att::diff_unit(bh >> 2, bh & 3, qb, PROJ, OB, (LAS char*)lds, lam, args.in[14]); } }
#endif
#ifndef NO_WIN
        for (int i = 0; i < per; ++i) { const int u = vcu * per + i; if (u < 768) { const int bk = u >> 4, qb = u & 15;
            att::win_unit(bk >> 1, bk & 1, qb, PROJ, OB, (LAS char*)lds, args.in[14], args.in[13]); } }
#endif
        if (BOTH(2)) GROUP_BAR();
    }

    if (IN(3)) {
        pg8::Gemm g{OB, W2, DM, 256}; pg8::StaticOrder S; S.init(NTOK / 256, DM / 256, G, bx);
        {
            LAS float* scr = (LAS float*)(lds + wave * 16384);
            const int gw = vcu * NWAVES + wave, NGW = G * NWAVES;
            constexpr int I3 = (DM / 64) * (2 * DFF / 32);
            for (int r = gw; r < I3; r += NGW) { const int nblk = 2 * DFF / 32, kb = r / nblk, nb = r % nblk, n0 = 32 * nb, pn = n0 >> 8, p = n0 & 255, bj = p >> 7, e0 = p & 127;
                quant_item(bj ? args.in[18] : args.in[17], DFF, 128 * pn + e0, DM, 64 * kb, (signed char*)(ws + WS_W3), n0, args.in[16], ctl + CW_WMAX + n0, scr, lane); }
            constexpr int I4 = (DFF / 64) * (DM / 32);
            for (int r = gw; r < I4; r += NGW) { const int nblk = DM / 32, kb = r / nblk, nb = r % nblk;
                quantf8_item(args.in[21], DM, 32 * nb, DFF, 64 * kb, (unsigned char*)(ws + WS_W4), 32 * nb, ctl + CW_WMAX4 + 32 * nb, scr, lane); }
            __syncthreads();
        }
        pg8::EpiOut E{xp, xs, (float*)(ws + WS_FX), (LAS float*)(lds + EPX_OFF), (signed char*)(ws + WS_X1Q), (float*)(ws + WS_FA), (float*)(ws + WS_XS), ctl + CW_P3CNT};
        pg8::gemm_phase<pg8::EpiOut, pg8::StaticOrder>(lds, g, S, E);
        if (BOTH(3)) GRID_BAR();
    }

    if (IN(4)) {
        signed char* W3Q = (signed char*)(ws + WS_W3); signed char* X1Q = (signed char*)(ws + WS_X1Q); float* FA = (float*)(ws + WS_FA);
        pg8::Gemm g{(const bf16_t*)(X1Q - DM), (const bf16_t*)W3Q, DM / 2, 254}; pg8::StaticOrder S; S.init(194, 2 * DFF / 256, G, bx);
        pg8::EpiFfn E{(unsigned char*)ACT, FA, (const float*)(ctl + CW_WMAX), args.in[19], args.in[20], (LAS float*)(lds + EPX_OFF)};
        pg8::gemm_phase<pg8::EpiFfn, pg8::StaticOrder, true, true, 1>(lds, g, S, E);
        if (BOTH(4)) GRID_BAR();
    }

    if (IN(5)) {
        pg8::Gemm g{ACT, W4, DFF / 2, 256}; pg8::StaticOrder S; S.init(NTOK / 256, DM / 256, G, bx, 1);
        pg8::EpiDown E{(const signed char*)(ws + WS_X1Q), (const float*)(ws + WS_FX), args.out, (const float*)(ctl + CW_WMAX4)};
        pg8::gemm_phase<pg8::EpiDown, pg8::StaticOrder, true, true, 2>(lds, g, S, E);
    }
#undef IN
#undef BOTH
#undef GRID_BAR
}

extern "C" void kernel_launch(void* const* d_in, const int* in_sizes, int n_in, void* d_out, int out_size, void* d_ws, size_t ws_size, hipStream_t stream) {
    static int grid = 0;
    if (grid == 0) {
        if (n_in != 22 || in_sizes[0] != TOK_P * DM || in_sizes[1] != (NTOK - TOK_P) * DM || out_size != NTOK * DM || ws_size < WS_END) {
            fprintf(stderr, "kernel_launch: shape mismatch (n_in %d, in0 %d, in1 %d, out %d, ws %zu; need ws >= %zu)\n", n_in, n_in > 0 ? in_sizes[0] : -1, n_in > 1 ? in_sizes[1] : -1, out_size, ws_size, (size_t)WS_END); grid = -1; return; }
        int dev = 0, cus = 0;
        if (hipGetDevice(&dev) != hipSuccess || hipDeviceGetAttribute(&cus, hipDeviceAttributeMultiprocessorCount, dev) != hipSuccess) { fprintf(stderr, "kernel_launch: device query failed\n"); grid = -1; return; }
        if (hipFuncSetAttribute((const void*)hymba_fwd, hipFuncAttributeMaxDynamicSharedMemorySize, LDS_BYTES) != hipSuccess) { fprintf(stderr, "kernel_launch: hipFuncSetAttribute failed\n"); grid = -1; return; }
        int per_cu = 0;
        if (hipOccupancyMaxActiveBlocksPerMultiprocessor(&per_cu, (const void*)hymba_fwd, NWAVES * 64, LDS_BYTES) != hipSuccess || per_cu < 1)
            fprintf(stderr, "kernel_launch: note: occupancy query reports %d workgroups per CU\n", per_cu);
        (void)hipGetLastError();
        if (cus < 256) { fprintf(stderr, "kernel_launch: %d CUs; this kernel's unit schedule (co-running tile owners in the out-projection epilogue) is built for 256\n", cus); grid = -1; return; }
        grid = 256;
    }
    if (grid < 0) return;
    (void)hipMemsetAsync((char*)d_ws + WS_CTL, 0, CTL_ZERO_BYTES, stream);
    Args a{};
    for (int i = 0; i < 22; ++i) a.in[i] = (const float*)d_in[i];
    a.out = (float*)d_out; a.ws = (unsigned char*)d_ws;
#ifndef PROBE_DUP
#define PROBE_DUP -1
#endif
    constexpr int NL = (PROBE_DUP >= 0) ? 3 : MK_N_LAUNCHES;
    for (int li = 0; li < NL; ++li) {
        if (PROBE_DUP >= 0) {
            a.ph_lo = li == 0 ? 0 : (li == 1 ? PROBE_DUP : PROBE_DUP + 1); a.ph_hi = li == 2 ? 6 : PROBE_DUP + 1; a.li = li;
        } else { a.ph_lo = (NL == 6) ? li : 0; a.ph_hi = (NL == 6) ? li + 1 : 6; a.li = (NL == 6) ? 0 : li; }
        hipLaunchKernelGGL(hymba_fwd, dim3(grid), dim3(NWAVES * 64), LDS_BYTES, stream, a);
        const hipError_t le = hipPeekAtLastError();
        if (le != hipSuccess) { fprintf(stderr, "kernel_launch: launch %d failed: %s\n", li, hipGetErrorName(le)); break; }
    }
}
```

```cpp
#include <hip/hip_runtime.h>
#include <hip/hip_bf16.h>
#include <cstdio>
#include <cstdint>

#ifndef MK_N_LAUNCHES
#define MK_N_LAUNCHES 1
#endif

#define LAS __attribute__((address_space(3)))
#define GAS __attribute__((address_space(1)))
typedef unsigned short bf16_t;
typedef short bf16x8 __attribute__((ext_vector_type(8)));
typedef short s16x4 __attribute__((ext_vector_type(4)));
typedef float f32x2 __attribute__((ext_vector_type(2)));
typedef float f32x4 __attribute__((ext_vector_type(4)));
typedef float f32x16 __attribute__((ext_vector_type(16)));
typedef unsigned u32x2 __attribute__((ext_vector_type(2)));
typedef unsigned u32x4 __attribute__((ext_vector_type(4)));
typedef __bf16 bf16x2_t __attribute__((ext_vector_type(2)));

constexpr int DM = 1024, SEQ = 2048, NSEQ = 24, NTOK = NSEQ * SEQ, TOK_P = 8 * SEQ;
constexpr int DIN = 2304, DFF = 2816;
constexpr int C_DQ = 0, C_DK = 512, C_DV = 1024, C_WQ = 1536, C_WK = 2048, C_WV = 2176;
constexpr int NBH = 12;
constexpr float EPS = 1e-6f, LOG2E = 1.4426950408889634f, QSCALE = 0.125f * LOG2E;
constexpr float LAM_INIT = 0.2f;
constexpr int NWAVES = 8;

__device__ __forceinline__ unsigned cvtpk(float lo, float hi) { f32x2 v = {lo, hi}; bf16x2_t b = __builtin_convertvector(v, bf16x2_t); return __builtin_bit_cast(unsigned, b); }
__device__ __forceinline__ u32x4 pack8(f32x4 a, f32x4 b) { u32x4 w; w.x = cvtpk(a[0], a[1]); w.y = cvtpk(a[2], a[3]); w.z = cvtpk(b[0], b[1]); w.w = cvtpk(b[2], b[3]); return w; }
__device__ __forceinline__ float dot4(f32x4 a) { return (a[0] * a[0] + a[1] * a[1]) + (a[2] * a[2] + a[3] * a[3]); }

__device__ __forceinline__ unsigned q4(float a, float b, float c, float d) {
    const unsigned ua = __float_as_uint(a + 12582912.0f), ub = __float_as_uint(b + 12582912.0f), uc = __float_as_uint(c + 12582912.0f), ud = __float_as_uint(d + 12582912.0f);
    return (ua & 0xffu) | ((ub & 0xffu) << 8) | ((uc & 0xffu) << 16) | (ud << 24);
}
__device__ __forceinline__ unsigned f8x4(float a, float b, float c, float d) {
    int w = 0;
    w = __builtin_amdgcn_cvt_pk_fp8_f32(__builtin_amdgcn_fmed3f(a, -448.f, 448.f), __builtin_amdgcn_fmed3f(b, -448.f, 448.f), w, false);
    w = __builtin_amdgcn_cvt_pk_fp8_f32(__builtin_amdgcn_fmed3f(c, -448.f, 448.f), __builtin_amdgcn_fmed3f(d, -448.f, 448.f), w, true);
    return (unsigned)w;
}
constexpr float ACT8_SCALE = 8.0f, W8_TOP = 224.0f;
namespace pg8 {
constexpr int BM = 256, BK = 64, HALF = 128, HTB = HALF * BK * 2, STAGE_BYTES = 8 * HTB, NXCD = 8, WGM = 8;
__host__ __device__ __forceinline__ int lds_byte(int r, int c) { const int st = (r >> 4) * 2 + (c >> 5), rr = r & 15, cc = c & 31, ob = rr * 64 + cc * 2; return st * 1024 + (ob ^ (((ob >> 9) & 1) << 5)); }
__host__ __device__ __forceinline__ void stage_rc(int b, int& R, int& C) { const int st = b / 1024, sb = b % 1024, swz = sb ^ (((sb >> 9) & 1) << 5); R = (st >> 1) * 16 + swz / 64; C = (st & 1) * 32 + (swz % 64) / 2; }
__host__ __device__ __forceinline__ int perm32(int rho) { const int n = rho >> 4, i = rho & 15; return 8 * (i >> 2) + 4 * n + (i & 3); }

typedef int v4i32_t __attribute__((ext_vector_type(4)));
struct Unit { int pm, pn; };
struct Gemm { const bf16_t* A; const bf16_t* Bt; int K; int arows; };

struct StaticOrder {
    int nM, nN, nwg, G, c, rev;
    __device__ void init(int nM_, int nN_, int G_, int c_, int rev_ = 0) { nM = nM_; nN = nN_; nwg = nM * nN; G = G_; c = c_; rev = rev_; }
    __device__ bool next(int i, Unit& u) const {
        const int nr = (nwg - c + G - 1) / G; if (i >= nr) return false;
        const long L = (long)(rev ? nr - 1 - i : i) * G + c;
        int wgid = (int)L; { const int q = nwg / NXCD, r = nwg % NXCD, xcd = wgid % NXCD, off = wgid / NXCD; wgid = (xcd < r ? xcd * (q + 1) : r * (q + 1) + (xcd - r) * q) + off; }
        const int nig = WGM * nN, gid = wgid / nig, fm = gid * WGM, gsz = (nM - fm) < WGM ? (nM - fm) : WGM;
        u.pm = fm + ((wgid % nig) % gsz); u.pn = (wgid % nig) / gsz; return true;
    }
};


struct EpiProj {
    static constexpr bool PERM = true;
    bf16_t* P; const LAS float* gl; const float* fx; const float* swm;
    __device__ __forceinline__ void pre(const Unit& u, int wid, int lane_) const {
        int lane = lane_; asm volatile("" : "+v"(lane));
        if (wid >= 4) __builtin_amdgcn_global_load_lds((const unsigned*)(fx + u.pm * BM + 64 * (wid - 4) + lane), (LAS unsigned*)((LAS char*)gl + 1024 + (wid - 4) * 256), 4, 0, 0);
        if (wid == 2) __builtin_amdgcn_global_load_lds((const unsigned*)(swm + u.pn * 256 + lane * 4), (LAS unsigned*)((LAS char*)gl + 2048), 16, 0, 0);
    }
    __device__ __forceinline__ void operator()(const f32x4 (&acc)[2][2][4][2], const Unit& u, int wr, int wc, int fr, int fq, int lane) const {
        int fql = fq; asm volatile("" : "+v"(fql));
        f32x4 csw[2][2];
#pragma unroll
        for (int bj = 0; bj < 2; ++bj)
#pragma unroll
            for (int n = 0; n < 2; ++n) csw[bj][n] = *(const LAS f32x4*)(gl + 512 + 128 * bj + 32 * wc + 8 * fql + 4 * n) * (1.0f / 127.0f);
        const int gidx = u.pn * 4 + wc;
        int gsel = -1; float sc = 1.f;
        if (gidx < 8) { gsel = 0; sc = QSCALE; } else if (gidx < 16) { gsel = 1; } else if (gidx < 24) { } else if (gidx < 32) { gsel = 2; sc = QSCALE; } else if (gidx < 34) { gsel = 3; }
        const bool nrm = gsel >= 0; const LAS float* gain = gl + (nrm ? gsel : 0) * 64;
        f32x4 gv[2][2];
#pragma unroll
        for (int bj = 0; bj < 2; ++bj)
#pragma unroll
            for (int n = 0; n < 2; ++n) gv[bj][n] = nrm ? *(const LAS f32x4*)(gain + 32 * bj + 8 * fq + 4 * n) * sc : (f32x4){1.f, 1.f, 1.f, 1.f};
        bf16_t* base = P + (size_t)(u.pm * BM + wr * 64 + fr) * DIN + gidx * 64 + 8 * fq;
#pragma unroll
        for (int ai = 0; ai < 2; ++ai)
#pragma unroll
            for (int m = 0; m < 4; ++m) {
                const float fxr = gl[256 + ai * HALF + wr * 64 + m * 16 + fr];
                f32x4 v00 = __builtin_convertvector(__builtin_bit_cast(v4i32_t, acc[ai][0][m][0]), f32x4) * (csw[0][0] * fxr), v01 = __builtin_convertvector(__builtin_bit_cast(v4i32_t, acc[ai][0][m][1]), f32x4) * (csw[0][1] * fxr);
                f32x4 v10 = __builtin_convertvector(__builtin_bit_cast(v4i32_t, acc[ai][1][m][0]), f32x4) * (csw[1][0] * fxr), v11 = __builtin_convertvector(__builtin_bit_cast(v4i32_t, acc[ai][1][m][1]), f32x4) * (csw[1][1] * fxr);
                float rn = 1.f;
                if (nrm) { float ss = (dot4(v00) + dot4(v01)) + (dot4(v10) + dot4(v11)); ss += __shfl_xor(ss, 16); ss += __shfl_xor(ss, 32); rn = __builtin_amdgcn_rsqf(ss * (1.0f / 64.0f) + EPS); }
                v00 = v00 * rn * gv[0][0]; v01 = v01 * rn * gv[0][1]; v10 = v10 * rn * gv[1][0]; v11 = v11 * rn * gv[1][1];
                bf16_t* rowp = base + (size_t)(ai * HALF + m * 16) * DIN;
                const u32x4 pa = pack8(v00, v01), pb = pack8(v10, v11);
                u32x4 px; px.x = (unsigned)__builtin_amdgcn_mov_dpp((int)pb.x, 0x128, 0xf, 0xf, true); px.y = (unsigned)__builtin_amdgcn_mov_dpp((int)pb.y, 0x128, 0xf, 0xf, true);
                px.z = (unsigned)__builtin_amdgcn_mov_dpp((int)pb.z, 0x128, 0xf, 0xf, true); px.w = (unsigned)__builtin_amdgcn_mov_dpp((int)pb.w, 0x128, 0xf, 0xf, true);
                const bool hi8 = (fr & 8) != 0;
                bf16_t* r1p = base + (size_t)(ai * HALF + m * 16 - (hi8 ? 8 : 0)) * DIN + (hi8 ? 32 : 0);
                bf16_t* r2p = base + (size_t)(ai * HALF + m * 16 + (hi8 ? 0 : 8)) * DIN + (hi8 ? 0 : 32);
                *(u32x4*)(r1p) = hi8 ? px : pa; *(u32x4*)(r2p) = hi8 ? pa : px;
            }
    }
};

struct EpiOut {
    static constexpr bool PERM = true;
    const signed char* xq0; const float* __restrict__ sx0; float* __restrict__ sx1; LAS float* xl;
    signed char* x1q; float* fa; float* xs; unsigned* cnt;
    __device__ __forceinline__ void pre(const Unit&, int, int) const {}
    __device__ __forceinline__ void operator()(f32x4 (&acc)[2][2][4][2], const Unit& u, int wr, int wc, int fr, int fq, int lane) const {
        asm volatile("" : "+v"(fr), "+v"(fq));
        const int rowbase = u.pm * BM;
        const int col0 = u.pn * BM + wc * 64 + 8 * fq;
#pragma unroll
        for (int ai = 0; ai < 2; ++ai) {
            u32x2 xv[4][2]; float s0[4];
#pragma unroll
            for (int m = 0; m < 4; ++m) { const size_t row = (size_t)(rowbase + ai * HALF + wr * 64 + m * 16 + fr); const signed char* xr = xq0 + row * DM + col0;
                s0[m] = sx0[row];
#pragma unroll
                for (int bj = 0; bj < 2; ++bj) xv[m][bj] = *(const u32x2*)(xr + bj * 32); }
#pragma unroll
            for (int m = 0; m < 4; ++m) {
                const int rl = ai * HALF + wr * 64 + m * 16 + fr; float s = 0.f, am = 0.f;
#pragma unroll
                for (int bj = 0; bj < 2; ++bj) {
                    const int wx = (int)xv[m][bj].x, wy = (int)xv[m][bj].y; f32x4 x0, x1;
                    x0[0] = (float)((wx << 24) >> 24); x0[1] = (float)((wx << 16) >> 24); x0[2] = (float)((wx << 8) >> 24); x0[3] = (float)(wx >> 24);
                    x1[0] = (float)((wy << 24) >> 24); x1[1] = (float)((wy << 16) >> 24); x1[2] = (float)((wy << 8) >> 24); x1[3] = (float)(wy >> 24);
                    const f32x4 o0 = x0 * s0[m] + acc[ai][bj][m][0], o1 = x1 * s0[m] + acc[ai][bj][m][1];
                    acc[ai][bj][m][0] = o0; acc[ai][bj][m][1] = o1;
#pragma unroll
                    for (int i = 0; i < 4; ++i) am = __builtin_fmaxf(am, __builtin_fmaxf(__builtin_fabsf(o0[i]), __builtin_fabsf(o1[i])));
                    s += dot4(o0) + dot4(o1); }
                s += __shfl_xor(s, 16); s += __shfl_xor(s, 32);
                am = __builtin_fmaxf(am, __shfl_xor(am, 16)); am = __builtin_fmaxf(am, __shfl_xor(am, 32));
                if (fq == 0) { xl[rl * 8 + wc] = s; xl[rl * 8 + 4 + wc] = am; }
            }
        }
        asm volatile("s_waitcnt lgkmcnt(0)" ::: "memory"); __builtin_amdgcn_s_barrier(); asm volatile("" ::: "memory");
        const int t = (wr * 4 + wc) * 64 + lane;
        if (t < 256) {
            const f32x4 q = *(const LAS f32x4*)(xl + t * 8), a4 = *(const LAS f32x4*)(xl + t * 8 + 4);
            float* sl = xs + ((size_t)(rowbase + t) * 4 + u.pn) * 2;
            __hip_atomic_store(sl, (q[0] + q[1]) + (q[2] + q[3]), __ATOMIC_RELAXED, __HIP_MEMORY_SCOPE_AGENT);
            __hip_atomic_store(sl + 1, __builtin_fmaxf(__builtin_fmaxf(a4[0], a4[1]), __builtin_fmaxf(a4[2], a4[3])), __ATOMIC_RELAXED, __HIP_MEMORY_SCOPE_AGENT);
            asm volatile("s_waitcnt vmcnt(0)" ::: "memory");
            if (lane == 0) (void)__hip_atomic_fetch_add(cnt + u.pm, 1u, __ATOMIC_RELAXED, __HIP_MEMORY_SCOPE_AGENT);
        }
        if (t < 64) {
            unsigned sp = 0; while (__builtin_amdgcn_readfirstlane(__hip_atomic_load(cnt + u.pm, __ATOMIC_RELAXED, __HIP_MEMORY_SCOPE_AGENT)) < 16u) { __builtin_amdgcn_s_sleep(1); if (++sp > (1u << 22)) break; }
        }
        asm volatile("s_waitcnt lgkmcnt(0)" ::: "memory"); __builtin_amdgcn_s_barrier(); asm volatile("" ::: "memory");
        if (t < 256) {
            const float* sl = xs + (size_t)(rowbase + t) * 8; float ss = 0.f, am = 0.f;
#pragma unroll
            for (int j = 0; j < 4; ++j) { ss += __hip_atomic_load(sl + 2 * j, __ATOMIC_RELAXED, __HIP_MEMORY_SCOPE_AGENT); am = __builtin_fmaxf(am, __hip_atomic_load(sl + 2 * j + 1, __ATOMIC_RELAXED, __HIP_MEMORY_SCOPE_AGENT)); }
            xl[2048 + t] = am > 0.f ? 127.0f / am : 0.f;
            if (u.pn == 0) { fa[rowbase + t] = __builtin_amdgcn_rsqf(ss * (1.0f / DM) + EPS) * am * (1.0f / 127.0f); sx1[rowbase + t] = am * (1.0f / 127.0f); }
        }
        asm volatile("s_waitcnt lgkmcnt(0)" ::: "memory"); __builtin_amdgcn_s_barrier(); asm volatile("" ::: "memory");
#pragma unroll
        for (int ai = 0; ai < 2; ++ai)
#pragma unroll
            for (int m = 0; m < 4; ++m) { const int rl = ai * HALF + wr * 64 + m * 16 + fr; const float inv = xl[2048 + rl];
                signed char* qp = x1q + (size_t)(rowbase + rl) * DM + col0;
#pragma unroll
                for (int bj = 0; bj < 2; ++bj) { const f32x4 b0 = acc[ai][bj][m][0] * inv, b1 = acc[ai][bj][m][1] * inv;
                    u32x2 o; o.x = q4(b0[0], b0[1], b0[2], b0[3]); o.y = q4(b1[0], b1[1], b1[2], b1[3]);
                    *(u32x2*)(qp + 32 * bj) = o; } }
    }
};

__device__ __forceinline__ float dpp8(float x) { return __builtin_bit_cast(float, __builtin_amdgcn_mov_dpp(__builtin_bit_cast(int, x), 0x128, 0xf, 0xf, true)); }
struct EpiDown {
    static constexpr bool PERM = true;
    const signed char* __restrict__ x1q; const float* __restrict__ sx1; float* __restrict__ out; const float* __restrict__ wmx;
    __device__ __forceinline__ void pre(const Unit&, int, int) const {}
    __device__ __forceinline__ void operator()(const f32x4 (&acc)[2][2][4][2], const Unit& u, int wr, int wc, int fr, int fq, int lane) const {
        asm volatile("" : "+v"(fr), "+v"(fq));
        const int col0 = u.pn * BM + wc * 32 + 8 * fq; const bool hi8 = (fr & 8) != 0;
        f32x4 cs[2][2];
#pragma unroll
        for (int bj = 0; bj < 2; ++bj)
#pragma unroll
            for (int n = 0; n < 2; ++n) cs[bj][n] = *(const f32x4*)(wmx + col0 + bj * HALF + 4 * n) * (1.0f / (W8_TOP * ACT8_SCALE));
#pragma unroll
        for (int ai = 0; ai < 2; ++ai) {
            u32x2 w[4][2]; float sx[4];
#pragma unroll
            for (int m = 0; m < 4; ++m) { const size_t row = (size_t)(u.pm * BM + ai * HALF + wr * 64 + m * 16 + fr); const size_t off = row * DM + col0;
                sx[m] = sx1[row];
#pragma unroll
                for (int bj = 0; bj < 2; ++bj) w[m][bj] = *(const u32x2*)(x1q + off + bj * HALF); }
#pragma unroll
            for (int m = 0; m < 4; ++m) { const size_t off = (size_t)(u.pm * BM + ai * HALF + wr * 64 + m * 16 + fr) * DM + col0;
#pragma unroll
                for (int bj = 0; bj < 2; ++bj) { const int wx = (int)w[m][bj].x, wy = (int)w[m][bj].y;
                    f32x4 r0, r1;
                    r0[0] = (float)((wx << 24) >> 24) * sx[m]; r0[1] = (float)((wx << 16) >> 24) * sx[m]; r0[2] = (float)((wx << 8) >> 24) * sx[m]; r0[3] = (float)(wx >> 24) * sx[m];
                    r1[0] = (float)((wy << 24) >> 24) * sx[m]; r1[1] = (float)((wy << 16) >> 24) * sx[m]; r1[2] = (float)((wy << 8) >> 24) * sx[m]; r1[3] = (float)(wy >> 24) * sx[m];
                    const f32x4 q0 = r0 + acc[ai][bj][m][0] * cs[bj][0], q1 = r1 + acc[ai][bj][m][1] * cs[bj][1];
                    f32x4 qx; qx[0] = dpp8(q1[0]); qx[1] = dpp8(q1[1]); qx[2] = dpp8(q1[2]); qx[3] = dpp8(q1[3]);
                    const long d1 = hi8 ? (long)(4 - 8 * DM) : 0, d2 = hi8 ? 0 : (long)(4 + 8 * DM);
                    *(f32x4*)(out + off + bj * HALF + d1) = hi8 ? qx : q0; *(f32x4*)(out + off + bj * HALF + d2) = hi8 ? q0 : qx; } } }
    }
};

template <int CTRL> __device__ __forceinline__ float dppz(float x) { return __builtin_bit_cast(float, __builtin_amdgcn_update_dpp(0, __builtin_bit_cast(int, x), CTRL, 0xf, 0xf, true)); }
struct EpiFfn {
    static constexpr bool PERM = true;
    unsigned char* act; const float* fa; const float* swm; const float* cw; const float* cb; LAS float* xl;
    __device__ __forceinline__ void pre(const Unit& u, int wid, int lane_) const {
        int lane = lane_; asm volatile("" : "+v"(lane));
        const int tok0 = 254 * u.pm - 1;
        if (wid >= 4) { int tok = tok0 + 64 * (wid - 4) + lane; tok = tok < 0 ? 0 : (tok > NTOK - 1 ? NTOK - 1 : tok);
            __builtin_amdgcn_global_load_lds((const unsigned*)(fa + tok), (LAS unsigned*)((LAS char*)xl + 4096 + (wid - 4) * 256), 4, 0, 0); }
        if (wid == 2) __builtin_amdgcn_global_load_lds((const unsigned*)(swm + u.pn * 256 + lane * 4), (LAS unsigned*)((LAS char*)xl + 5120), 16, 0, 0);
        if (wid < 2) { const float* src = (wid == 0 ? (lane < 32 ? cw : cw + DFF) : (lane < 32 ? cw + 2 * DFF : cb)) + u.pn * 128 + (lane & 31) * 4;
            __builtin_amdgcn_global_load_lds((const unsigned*)src, (LAS unsigned*)((LAS char*)xl + 20480 + wid * 1024), 16, 0, 0); }
    }
    template <int AI, int M, bool MASK>
    __device__ __forceinline__ void conv_rows(const f32x4 (&acc)[2][2][4][2], const f32x4 (&w0)[2], const f32x4 (&w1)[2], const f32x4 (&w2)[2], const f32x4 (&bb)[2],
                                              int tok, int rl, int G, int xc, int fr, int ch0) const {
        const bool pcut = MASK && (tok & (SEQ - 1)) == 0, ncut = MASK && (tok & (SEQ - 1)) == SEQ - 1;
        f32x4 r0, r1;
#pragma unroll
        for (int n = 0; n < 2; ++n) { f32x4 res;
            f32x4 ex = (f32x4){0.f, 0.f, 0.f, 0.f};
            if (M == 0) { if (G > 0) ex = *(const LAS f32x4*)(xl + (2 * (G - 1) + 1) * 128 + xc + 4 * n); ex = fr == 0 ? ex : (f32x4){0.f, 0.f, 0.f, 0.f}; }
            if (M == 3) { if (G < 3) ex = *(const LAS f32x4*)(xl + (2 * (G + 1)) * 128 + xc + 4 * n); ex = fr == 15 ? ex : (f32x4){0.f, 0.f, 0.f, 0.f}; }
#pragma unroll
            for (int i = 0; i < 4; ++i) {
                const float own = acc[AI][0][M][n][i];
                float pr = dppz<0x111>(own);
                pr += (M > 0) ? dppz<0x10F>(acc[AI][0][M > 0 ? M - 1 : 0][n][i]) : ex[i];
                float nx = dppz<0x101>(own);
                nx += (M < 3) ? dppz<0x11F>(acc[AI][0][M < 3 ? M + 1 : 3][n][i]) : ex[i];
                if (MASK) { pr = pcut ? 0.f : pr; nx = ncut ? 0.f : nx; }
                const float uc = fmaf(w0[n][i], pr, fmaf(w1[n][i], own, fmaf(w2[n][i], nx, bb[n][i])));
                const float sg = uc * __builtin_amdgcn_rcpf(1.0f + __builtin_amdgcn_exp2f(-LOG2E * uc));
                res[i] = sg * acc[AI][1][M][n][i] * ACT8_SCALE;
            }
            if (n == 0) r0 = res; else r1 = res; }
        if (rl != 0 && rl != 255 && tok < NTOK) { u32x2 o; o.x = f8x4(r0[0], r0[1], r0[2], r0[3]); o.y = f8x4(r1[0], r1[1], r1[2], r1[3]); *(u32x2*)(act + (size_t)tok * DFF + ch0) = o; }
    }
    __device__ __forceinline__ void operator()(f32x4 (&acc)[2][2][4][2], const Unit& u, int wr, int wc, int fr, int fq, int lane) const {
        const int ch0 = u.pn * 128 + wc * 32 + 8 * fq;
        const int tok0 = 254 * u.pm - 1;
        int fql = fq; asm volatile("" : "+v"(fql));
        const int xc = wc * 32 + 8 * fql;
        f32x4 su[2];
#pragma unroll
        for (int n = 0; n < 2; ++n) su[n] = *(const LAS f32x4*)(xl + 1280 + 128 + xc + 4 * n) * (1.0f / 127.0f);
#pragma unroll
        for (int ai = 0; ai < 2; ++ai)
#pragma unroll
            for (int m = 0; m < 4; ++m) { const float rs = xl[1024 + ai * HALF + wr * 64 + m * 16 + fr];
#pragma unroll
                for (int n = 0; n < 2; ++n) { const f32x4 rsu = su[n] * rs;
                    acc[ai][0][m][n] = __builtin_convertvector(__builtin_bit_cast(v4i32_t, acc[ai][0][m][n]), f32x4) * rs;
                    acc[ai][1][m][n] = __builtin_convertvector(__builtin_bit_cast(v4i32_t, acc[ai][1][m][n]), f32x4) * rsu; } }
#pragma unroll
        for (int ai = 0; ai < 2; ++ai) { const int G = 2 * ai + wr;
            if (fr == 0) { *(LAS f32x4*)(xl + (2 * G) * 128 + xc) = acc[ai][0][0][0]; *(LAS f32x4*)(xl + (2 * G) * 128 + xc + 4) = acc[ai][0][0][1]; }
            if (fr == 15) { *(LAS f32x4*)(xl + (2 * G + 1) * 128 + xc) = acc[ai][0][3][0]; *(LAS f32x4*)(xl + (2 * G + 1) * 128 + xc + 4) = acc[ai][0][3][1]; } }
        asm volatile("s_waitcnt lgkmcnt(0)" ::: "memory"); __builtin_amdgcn_s_barrier(); asm volatile("" ::: "memory"); __builtin_amdgcn_sched_barrier(0);
        f32x4 w0[2], w1[2], w2[2], bb[2];
#pragma unroll
        for (int n = 0; n < 2; ++n) { const LAS float* wl = xl + 5120 + xc + 4 * n; const f32x4 sgc = *(const LAS f32x4*)(xl + 1280 + xc + 4 * n) * (1.0f / 127.0f);
            w0[n] = *(const LAS f32x4*)(wl) * sgc; w1[n] = *(const LAS f32x4*)(wl + 128) * sgc; w2[n] = *(const LAS f32x4*)(wl + 256) * sgc; bb[n] = *(const LAS f32x4*)(wl + 384); }
#define FFN_ROWS(AI, M) do { const int tb_ = tok0 + AI * HALF + wr * 64 + M * 16; const int G_ = 2 * AI + wr; \
        conv_rows<AI, M, true>(acc, w0, w1, w2, bb, tb_ + fr, AI * HALF + wr * 64 + M * 16 + fr, G_, xc, fr, ch0); \
        if ((M) & 1) __builtin_amdgcn_sched_barrier(0); } while (0)
        FFN_ROWS(0, 0); FFN_ROWS(0, 1); FFN_ROWS(0, 2); FFN_ROWS(0, 3); FFN_ROWS(1, 0); FFN_ROWS(1, 1); FFN_ROWS(1, 2); FFN_ROWS(1, 3);
#undef FFN_ROWS
    }
};

typedef int v8i32_t __attribute__((ext_vector_type(8)));
template <class Epi, class Sched, bool ALIGN_EPI = true, bool SP2 = true, int QM = 0>
__device__ __forceinline__ void gemm_phase(LAS unsigned char* lds, const Gemm g, const Sched& S, const Epi& E) {
    const int tid = threadIdx.x, wid = __builtin_amdgcn_readfirstlane(tid >> 6), lane = tid & 63, wr = wid >> 2, wc = wid & 3, fr = lane & 15, fq = lane >> 4;
    const int K = g.K, nt = K / BK;
    unsigned voffA[2], voffB[2];
#pragma unroll
    for (int i = 0; i < 2; ++i) { int R, C; stage_rc(tid * 16 + i * 8192, R, C); const int Rb = Epi::PERM ? ((R & ~31) + perm32(R & 31)) : R;
        voffA[i] = (unsigned)(R * K + C) * 2u; voffB[i] = (unsigned)(Rb * K + C) * 2u; }
    const size_t kstep = (size_t)(BK * 2);
    const size_t hstep = (size_t)HALF * K * 2;
    const size_t tstepB = 2 * hstep;
    const size_t tstepA = (size_t)g.arows * K * 2;
    const unsigned ldsw = (unsigned)wid * 1024u;
    const int aoff = lds_byte(wr * 64 + fr, fq * 8), boff = lds_byte(wc * 32 + fr, fq * 8);
#define PG8_SA(b, h) (((b) * 2 + (h)) * HTB)
#define PG8_SB(b, h) ((4 + (b) * 2 + (h)) * HTB)
#define PG8_STAGE(bufoff, gbase, voff) do { _Pragma("unroll") for (int _i = 0; _i < 2; ++_i) \
        __builtin_amdgcn_global_load_lds((const unsigned*)((const char*)(gbase) + (voff)[_i]), (LAS unsigned*)(lds + (bufoff) + ldsw + _i * 8192), 16, 0, 0); } while (0)
#define PG8_LDA(dst, b, h) do { _Pragma("unroll") for (int m = 0; m < 4; ++m) _Pragma("unroll") for (int k = 0; k < 2; ++k) dst[m][k] = *(const LAS bf16x8*)(lds + PG8_SA(b, h) + aoff + m * 2048 + k * 1024); } while (0)
#define PG8_LDB(dst, b, h) do { _Pragma("unroll") for (int n = 0; n < 2; ++n) _Pragma("unroll") for (int k = 0; k < 2; ++k) dst[n][k] = *(const LAS bf16x8*)(lds + PG8_SB(b, h) + boff + n * 2048 + k * 1024); } while (0)
#define PG8_MMA(ai, bj, At, Bt) do { __builtin_amdgcn_s_setprio(1); \
    if constexpr (QM == 2) { _Pragma("unroll") for (int m = 0; m < 4; ++m) _Pragma("unroll") for (int n = 0; n < 2; ++n) { \
        const v8i32_t b8_ = __builtin_shufflevector(__builtin_bit_cast(v4i32_t, Bt[n][0]), __builtin_bit_cast(v4i32_t, Bt[n][1]), 0, 1, 2, 3, 4, 5, 6, 7), a8_ = __builtin_shufflevector(__builtin_bit_cast(v4i32_t, At[m][0]), __builtin_bit_cast(v4i32_t, At[m][1]), 0, 1, 2, 3, 4, 5, 6, 7); \
        asm volatile("v_mfma_scale_f32_16x16x128_f8f6f4 %0, %1, %2, %0, %3, %3 op_sel_hi:[0,0,0]" : "+v"(acc[ai][bj][m][n]) : "v"(b8_), "v"(a8_), "v"(one8)); } } \
    else _Pragma("unroll") for (int m = 0; m < 4; ++m) _Pragma("unroll") for (int n = 0; n < 2; ++n) _Pragma("unroll") for (int k = 0; k < 2; ++k) \
        { if constexpr (QM == 1) acc[ai][bj][m][n] = __builtin_bit_cast(f32x4, __builtin_amdgcn_mfma_i32_16x16x64_i8(__builtin_bit_cast(v4i32_t, Bt[n][k]), __builtin_bit_cast(v4i32_t, At[m][k]), __builtin_bit_cast(v4i32_t, acc[ai][bj][m][n]), 0, 0, 0)); \
          else acc[ai][bj][m][n] = __builtin_amdgcn_mfma_f32_16x16x32_bf16(Bt[n][k], At[m][k], acc[ai][bj][m][n], 0, 0, 0); } __builtin_amdgcn_s_setprio(0); } while (0)
#define PG8_WAIT_V(n) asm volatile("s_waitcnt vmcnt(" #n ")" ::: "memory")
#define PG8_WAIT_L(n) asm volatile("s_waitcnt lgkmcnt(" #n ")" ::: "memory")
#define PG8_BAR __builtin_amdgcn_s_barrier()
#define PG8_SCHED __builtin_amdgcn_sched_barrier(0)
    Unit cur, nxt; int ui = 0;
    if (!S.next(0, cur)) return;
    const int one8 = 0x7f7f7f7f;
    f32x4 acc[2][2][4][2];
#pragma unroll
    for (int a = 0; a < 2; ++a)
#pragma unroll
        for (int b = 0; b < 2; ++b)
#pragma unroll
            for (int m = 0; m < 4; ++m)
#pragma unroll
                for (int n = 0; n < 2; ++n) acc[a][b][m][n] = (f32x4){0.f, 0.f, 0.f, 0.f};
    bf16x8 At[4][2], B0[2][2], B1[2][2];
    const char* cA = (const char*)g.A + (size_t)cur.pm * tstepA; const char* cB = (const char*)g.Bt + (size_t)cur.pn * tstepB;
    if constexpr (SP2) {
        PG8_STAGE(PG8_SB(0, 0), cB, voffB); PG8_STAGE(PG8_SB(0, 1), cB + hstep, voffB); PG8_STAGE(PG8_SA(0, 0), cA, voffA); PG8_STAGE(PG8_SA(0, 1), cA + hstep, voffA);
        if (wr == 1) PG8_BAR;
        PG8_WAIT_V(2); PG8_BAR;
        PG8_STAGE(PG8_SB(1, 0), cB + kstep, voffB); PG8_STAGE(PG8_SA(1, 0), cA + kstep, voffA); PG8_STAGE(PG8_SB(1, 1), cB + hstep + kstep, voffB);
        PG8_WAIT_V(6); PG8_BAR;
    } else {
        PG8_STAGE(PG8_SB(0, 0), cB, voffB); PG8_STAGE(PG8_SA(0, 0), cA, voffA); PG8_STAGE(PG8_SB(0, 1), cB + hstep, voffB); PG8_STAGE(PG8_SA(0, 1), cA + hstep, voffA);
        if (wr == 1) PG8_BAR;
        PG8_WAIT_V(4); PG8_BAR;
        PG8_STAGE(PG8_SB(1, 0), cB + kstep, voffB); PG8_STAGE(PG8_SA(1, 0), cA + kstep, voffA); PG8_STAGE(PG8_SB(1, 1), cB + hstep + kstep, voffB);
        PG8_WAIT_V(6); PG8_BAR;
    }
    for (;;) {
        const bool has_next = S.next(ui + 1, nxt);
        const char* nA = has_next ? (const char*)g.A + (size_t)nxt.pm * tstepA : cA; const char* nB = has_next ? (const char*)g.Bt + (size_t)nxt.pn * tstepB : cB;
        for (int t = 0; t < nt; t += 2) {
            const bool last = (t == nt - 2);
            const char* a1 = cA + (size_t)(t + 1) * kstep;
            const char* a2 = last ? nA : cA + (size_t)(t + 2) * kstep; const char* b2 = last ? nB : cB + (size_t)(t + 2) * kstep;
            const char* a3 = a2 + kstep; const char* b3 = b2 + kstep;
            if (last) E.pre(cur, wid, lane);
            if constexpr (SP2) {
            PG8_LDB(B0, 0, 0); PG8_LDB(B1, 0, 1); PG8_SCHED; PG8_LDA(At, 0, 0); PG8_STAGE(PG8_SA(1, 1), a1 + hstep, voffA);
            PG8_WAIT_V(8); PG8_WAIT_L(0); PG8_BAR; PG8_MMA(0, 0, At, B0); PG8_MMA(0, 1, At, B1); PG8_BAR; PG8_SCHED;
            PG8_LDA(At, 0, 1); PG8_STAGE(PG8_SB(0, 0), b2, voffB); PG8_STAGE(PG8_SB(0, 1), b2 + hstep, voffB); PG8_STAGE(PG8_SA(0, 0), a2, voffA);
            PG8_WAIT_V(8); PG8_WAIT_L(0); PG8_BAR; PG8_MMA(1, 0, At, B0); PG8_MMA(1, 1, At, B1); PG8_BAR; PG8_SCHED;
            PG8_LDB(B0, 1, 0); PG8_LDB(B1, 1, 1); PG8_SCHED; PG8_LDA(At, 1, 0); PG8_STAGE(PG8_SA(0, 1), a2 + hstep, voffA);
            PG8_WAIT_V(8); PG8_WAIT_L(0); PG8_BAR; PG8_MMA(0, 0, At, B0); PG8_MMA(0, 1, At, B1); PG8_BAR; PG8_SCHED;
            PG8_LDA(At, 1, 1); PG8_STAGE(PG8_SB(1, 0), b3, voffB); PG8_STAGE(PG8_SB(1, 1), b3 + hstep, voffB); PG8_STAGE(PG8_SA(1, 0), a3, voffA);
            PG8_WAIT_V(8); PG8_WAIT_L(0); PG8_BAR; PG8_MMA(1, 0, At, B0); PG8_MMA(1, 1, At, B1); PG8_BAR; PG8_SCHED;
            } else {
            PG8_LDB(B0, 0, 0); PG8_SCHED; PG8_LDA(At, 0, 0); PG8_STAGE(PG8_SA(1, 1), a1 + hstep, voffA);
            PG8_WAIT_L(8); PG8_BAR; PG8_WAIT_L(0); PG8_MMA(0, 0, At, B0); PG8_BAR; PG8_SCHED;
            PG8_LDB(B1, 0, 1); PG8_STAGE(PG8_SB(0, 0), b2, voffB);
            PG8_BAR; PG8_WAIT_L(0); PG8_MMA(0, 1, At, B1); PG8_BAR;
            PG8_LDA(At, 0, 1); PG8_STAGE(PG8_SA(0, 0), a2, voffA);
            PG8_BAR; PG8_WAIT_L(0); PG8_MMA(1, 0, At, B0); PG8_BAR; PG8_SCHED;
            PG8_STAGE(PG8_SB(0, 1), b2 + hstep, voffB);
            PG8_WAIT_V(6); PG8_BAR; PG8_MMA(1, 1, At, B1); PG8_BAR;
            PG8_LDB(B0, 1, 0); PG8_SCHED; PG8_LDA(At, 1, 0); PG8_STAGE(PG8_SA(0, 1), a2 + hstep, voffA);
            PG8_WAIT_L(8); PG8_BAR; PG8_WAIT_L(0); PG8_MMA(0, 0, At, B0); PG8_BAR; PG8_SCHED;
            PG8_LDB(B1, 1, 1); PG8_STAGE(PG8_SB(1, 0), b3, voffB);
            PG8_BAR; PG8_WAIT_L(0); PG8_MMA(0, 1, At, B1); PG8_BAR;
            PG8_LDA(At, 1, 1); PG8_STAGE(PG8_SA(1, 0), a3, voffA);
            PG8_BAR; PG8_WAIT_L(0); PG8_MMA(1, 0, At, B0); PG8_BAR; PG8_SCHED;
            PG8_STAGE(PG8_SB(1, 1), b3 + hstep, voffB);
            PG8_WAIT_V(6); PG8_BAR; PG8_MMA(1, 1, At, B1); PG8_BAR;
            }
        }
        if constexpr (ALIGN_EPI) { if (wr == 0) PG8_BAR; }
        E(acc, cur, wr, wc, fr, fq, lane);
        if (!has_next) break;
#pragma unroll
        for (int a = 0; a < 2; ++a)
#pragma unroll
            for (int b = 0; b < 2; ++b)
#pragma unroll
                for (int m = 0; m < 4; ++m)
#pragma unroll
                    for (int n = 0; n < 2; ++n) acc[a][b][m][n] = (f32x4){0.f, 0.f, 0.f, 0.f};
        cur = nxt; cA = nA; cB = nB; ++ui;
        if constexpr (ALIGN_EPI) { if (wr == 1) PG8_BAR; }
    }
    PG8_WAIT_V(0);
    if constexpr (!ALIGN_EPI) { if (wr == 0) PG8_BAR; }
    PG8_BAR;
#undef PG8_SA
#undef PG8_SB
#undef PG8_STAGE
#undef PG8_LDA
#undef PG8_LDB
#undef PG8_MMA
#undef PG8_WAIT_V
#undef PG8_WAIT_L
#undef PG8_BAR
#undef PG8_SCHED
}
}

namespace att {
constexpr int PITCH = DIN;
#define SBAR() __builtin_amdgcn_sched_barrier(0)
#define KSW(row, colB) ((row) * 128 + ((colB) ^ ((((row) >> 1) & 7) << 4)))
__device__ __forceinline__ int crow(int r, int hi) { return (r & 3) + 8 * (r >> 2) + 4 * hi; }
__device__ __forceinline__ int rel_bucket(int rel) {
    const int n = rel < 0 ? -rel : rel; int v;
    if (n < 8) v = n; else { v = 2 + (31 - __clz(n * n)); v = v > 15 ? 15 : v; }
    return (rel > 0 ? 16 : 0) + v;
}
constexpr float THR = 5.0f;

__device__ __forceinline__ void partialSM(f32x16& p0, f32x16& p1, float off, float& m_reg, float& alpha) {
    float pmax = p0[0];
#pragma unroll
    for (int r = 1; r < 16; ++r) pmax = fmaxf(pmax, p0[r]);
#pragma unroll
    for (int r = 0; r < 16; ++r) pmax = fmaxf(pmax, p1[r]);
    { auto rr = __builtin_amdgcn_permlane32_swap(__float_as_uint(pmax), __float_as_uint(pmax), false, false);
      pmax = fmaxf(__uint_as_float(rr[0]), __uint_as_float(rr[1])); }
    pmax += off;
    if (__builtin_expect(__all(pmax - m_reg <= THR), 1)) { alpha = 1.f; }
    else { const float mn = fmaxf(m_reg, pmax); alpha = __builtin_amdgcn_exp2f(m_reg - mn); m_reg = mn; }
    const float sub = off - m_reg;
#pragma unroll
    for (int r = 0; r < 16; ++r) { p0[r] += sub; p1[r] += sub; }
#pragma unroll
    for (int r = 0; r < 16; ++r) p0[r] = __builtin_amdgcn_exp2f(p0[r]);
}
__device__ __forceinline__ void finishSM(f32x16& p0, f32x16& p1, float alpha, float& l_reg, bf16x8& pa0, bf16x8& pa1, bf16x8& pa2, bf16x8& pa3) {
#pragma unroll
    for (int r = 0; r < 16; ++r) p1[r] = __builtin_amdgcn_exp2f(p1[r]);
    float ps = 0;
#pragma unroll
    for (int r = 0; r < 16; ++r) ps += p0[r];
#pragma unroll
    for (int r = 0; r < 16; ++r) ps += p1[r];
    { auto rr = __builtin_amdgcn_permlane32_swap(__float_as_uint(ps), __float_as_uint(ps), false, false);
      ps = __uint_as_float(rr[0]) + __uint_as_float(rr[1]); }
    l_reg = l_reg * alpha + ps;
#define PK4(P, BASE, OUT) do { unsigned a0 = cvtpk(P[BASE + 0], P[BASE + 1]), a1 = cvtpk(P[BASE + 2], P[BASE + 3]);   \
    unsigned b0 = cvtpk(P[BASE + 4], P[BASE + 5]), b1 = cvtpk(P[BASE + 6], P[BASE + 7]);                              \
    auto r0 = __builtin_amdgcn_permlane32_swap(a0, b0, false, false); auto r1 = __builtin_amdgcn_permlane32_swap(a1, b1, false, false); \
    u32x4 w = {r0[0], r1[0], r0[1], r1[1]}; OUT = __builtin_bit_cast(bf16x8, w); } while (0)
    PK4(p0, 0, pa0); PK4(p0, 8, pa1); PK4(p1, 0, pa2); PK4(p1, 8, pa3);
#undef PK4
}
__device__ __forceinline__ void qkt64(f32x16& p0, f32x16& p1, const LAS char* Ks, const bf16x8* qr, int r32, int hi) {
#pragma unroll
    for (int d0 = 0; d0 < 4; ++d0) { const int cb = (d0 * 16 + hi * 8) * 2;
        const bf16x8 b0 = *(const LAS bf16x8*)(Ks + KSW(r32, cb));
        const bf16x8 b1 = *(const LAS bf16x8*)(Ks + KSW(r32, cb) + 4096);
        p0 = __builtin_amdgcn_mfma_f32_32x32x16_bf16(b0, qr[d0], p0, 0, 0, 0); p1 = __builtin_amdgcn_mfma_f32_32x32x16_bf16(b1, qr[d0], p1, 0, 0, 0); }
}
template <int NCB> __device__ __forceinline__ int v_st(int k, int c) { const int kk = (k & ~0xC) | ((k & 4) << 1) | ((k & 8) >> 1); return ((kk >> 3) * NCB + (c >> 5)) * 512 + ((kk & 7) * 32 + (c & 31)) * 2; }
__device__ __forceinline__ int v_rd_base(int lane) { return ((lane & 3) << 3) | (((lane >> 2) & 3) << 6) | (((lane >> 4) & 1) << 5) | (((lane >> 5) & 1) << 8); }
template <int NCB> constexpr int v_rd_off(int d0, int ks, int half) { return d0 * 512 + ks * (NCB * 1024) + half * (NCB * 512); }
template <int OFF> __device__ __forceinline__ s16x4 tr_read(int vb) { s16x4 r; asm volatile("ds_read_b64_tr_b16 %0, %1 offset:%2" : "=&v"(r) : "v"(vb), "i"(OFF) : "memory"); return r; }
template <int NCB, int D0> __device__ __forceinline__ void pv_one(f32x16& od, int vb, bf16x8 pa0, bf16x8 pa1, bf16x8 pa2, bf16x8 pa3) {
    const s16x4 l0 = tr_read<v_rd_off<NCB>(D0, 0, 0)>(vb), h0 = tr_read<v_rd_off<NCB>(D0, 0, 1)>(vb), l1 = tr_read<v_rd_off<NCB>(D0, 1, 0)>(vb), h1 = tr_read<v_rd_off<NCB>(D0, 1, 1)>(vb);
    const s16x4 l2 = tr_read<v_rd_off<NCB>(D0, 2, 0)>(vb), h2 = tr_read<v_rd_off<NCB>(D0, 2, 1)>(vb), l3 = tr_read<v_rd_off<NCB>(D0, 3, 0)>(vb), h3 = tr_read<v_rd_off<NCB>(D0, 3, 1)>(vb);
    asm volatile("s_waitcnt lgkmcnt(0)" ::: "memory"); SBAR();
#define PK(L, H) (bf16x8){L[0], L[1], L[2], L[3], H[0], H[1], H[2], H[3]}
    od = __builtin_amdgcn_mfma_f32_32x32x16_bf16(pa0, PK(l0, h0), od, 0, 0, 0);
    od = __builtin_amdgcn_mfma_f32_32x32x16_bf16(pa1, PK(l1, h1), od, 0, 0, 0);
    od = __builtin_amdgcn_mfma_f32_32x32x16_bf16(pa2, PK(l2, h2), od, 0, 0, 0);
    od = __builtin_amdgcn_mfma_f32_32x32x16_bf16(pa3, PK(l3, h3), od, 0, 0, 0);
#undef PK
}

constexpr int D_V = 0, D_K = 49152, D_WS = 81920, D_TB = 83968, D_ST = 86016, D_END = D_ST + 65536;
constexpr int NT = SEQ / 64;

typedef short v4i16_t __attribute__((ext_vector_type(4)));
__device__ __forceinline__ s16x4 vtr(const LAS char* p) { return __builtin_bit_cast(s16x4, __builtin_amdgcn_ds_read_tr16_b64_v4i16((LAS v4i16_t*)p)); }
#define PIN(x) asm volatile("" : "+v"(x))
#define MX3(a, b, c) __builtin_fmaxf(__builtin_fmaxf((a), (b)), (c))
#define EX(v) __builtin_amdgcn_exp2f(v)
#define MFMA32(a, b, c) __builtin_amdgcn_mfma_f32_32x32x16_bf16((a), (b), (c), 0, 0, 0)
constexpr float THRL = 6.0f;
__device__ __forceinline__ float rowmax32(const f32x16& C0, const f32x16& C1) {
    float a = MX3(C0[0], C0[1], C1[0]), b = MX3(C0[2], C0[3], C1[1]); a = MX3(a, C1[2], C1[3]);
#pragma unroll
    for (int r = 4; r < 16; r += 4) { a = MX3(a, C0[r], C0[r + 1]); b = MX3(b, C0[r + 2], C0[r + 3]); a = MX3(a, C1[r], C1[r + 1]); b = MX3(b, C1[r + 2], C1[r + 3]); }
    float rm = __builtin_fmaxf(a, b);
    auto rr = __builtin_amdgcn_permlane32_swap(__float_as_uint(rm), __float_as_uint(rm), false, false);
    return __builtin_fmaxf(__uint_as_float(rr[0]), __uint_as_float(rr[1]));
}
__device__ __forceinline__ void diff_pass(f32x16 (&o)[4], float& l_out, const bf16_t* Qw, const bf16_t* __restrict__ Kh, const bf16_t* __restrict__ Vh,
                                          LAS char* lds, int qa, float cL, float cR) {
    const int tid = threadIdx.x, wid = __builtin_amdgcn_readfirstlane(tid >> 6), lane = tid & 63, r32 = lane & 31, hi = lane >> 5;
    LAS char* V_lds = lds + D_V; LAS char* K_lds = lds + D_K;
    LAS float* wsf = (LAS float*)(lds + D_WS) + wid * 64 + 32;
    const LAS float* tb = (const LAS float*)(lds + D_TB);
#pragma unroll
    for (int d = 0; d < 4; ++d) o[d] = f32x16{};
    bf16x8 qr[4];
#pragma unroll
    for (int d0 = 0; d0 < 4; ++d0) qr[d0] = *(const bf16x8*)(Qw + d0 * 16);
#pragma unroll
    for (int d0 = 0; d0 < 4; ++d0) PIN(qr[d0]);
    const bf16_t* ksrc; const bf16_t* vsrc0;
    { const int row = wid * 8 + (lane >> 3), pos = lane & 7;
      ksrc = Kh + (long)row * PITCH + ((pos ^ ((row >> 1) & 7)) * 8);
      vsrc0 = Vh + (long)row * PITCH + ((pos ^ (((row >> 1) & 1) << 2)) * 8); }
    const LAS char* kq[4];
    { const int sw = (r32 >> 1) & 7;
#pragma unroll
      for (int d0 = 0; d0 < 4; ++d0) kq[d0] = K_lds + r32 * 128 + (((2 * d0 + hi) ^ sw) << 4); }
    const LAS char* vpe; const LAS char* vpo;
    { const int q = (lane & 15) >> 2, p = lane & 3, g = (lane >> 4) & 1, sw = (q >> 1) & 1;
      vpe = V_lds + (4 * hi + q) * 128 + sw * 64 + g * 32 + p * 8; vpo = V_lds + (4 * hi + q) * 128 + (sw ^ 1) * 64 + g * 32 + p * 8; }
#define DMA_K(j, ko) __builtin_amdgcn_global_load_lds((const unsigned*)(ksrc + (long)(j) * 64 * PITCH), (LAS unsigned*)(K_lds + (ko) + wid * 1024), 16, 0, 0)
#define DMA_V(j, vo) do { __builtin_amdgcn_global_load_lds((const unsigned*)(vsrc0 + (long)(j) * 64 * PITCH), (LAS unsigned*)(V_lds + (vo) + wid * 1024), 16, 0, 0); \
    __builtin_amdgcn_global_load_lds((const unsigned*)(vsrc0 + 64 + (long)(j) * 64 * PITCH), (LAS unsigned*)(V_lds + (vo) + 8192 + wid * 1024), 16, 0, 0); } while (0)
#define WAIT_BAR(N) do { asm volatile("s_waitcnt vmcnt(" #N ") lgkmcnt(0)" ::: "memory"); __builtin_amdgcn_s_barrier(); asm volatile("" ::: "memory"); } while (0)
    float mhat, l_reg = 0.f; bool resc = false;
    f32x16 pA0, pA1, pB0, pB1;
    bf16x8 kf[4]; s16x4 vlo[6], vhi[6]; u32x4 pw0, pw1, pw2, pw3;
#define KRD(i, KS) do { kf[(i) & 3] = *(const LAS bf16x8*)(kq[(i) >> 1] + (KS) + ((i) & 1) * 4096); } while (0)
    WAIT_BAR(0);
    DMA_K(0, 0); DMA_K(1, 8192); DMA_V(0, 0); DMA_K(2, 16384); DMA_K(3, 24576); DMA_V(1, 16384);
    WAIT_BAR(7);
    {
        float off0 = 0.f; const int d_ = -qa;
        if (d_ <= -154) { pA0 = f32x16{}; pA1 = f32x16{}; off0 = cL; }
        else { const LAS float* t_ = tb + (d_ + 256 + 4 * hi - r32);
#pragma unroll
            for (int r = 0; r < 16; ++r) { pA0[r] = t_[(r & 3) + 8 * (r >> 2)]; pA1[r] = t_[32 + (r & 3) + 8 * (r >> 2)]; } }
#pragma unroll
        for (int d0 = 0; d0 < 4; ++d0) { const bf16x8 k0_ = *(const LAS bf16x8*)(kq[d0]), k1_ = *(const LAS bf16x8*)(kq[d0] + 4096);
            pA0 = MFMA32(k0_, qr[d0], pA0); pA1 = MFMA32(k1_, qr[d0], pA1); }
        const float rm = rowmax32(pA0, pA1);
        mhat = rm + off0;
#pragma unroll
        for (int r = 0; r < 16; ++r) { pA0[r] = EX(pA0[r] - rm); pA1[r] = EX(pA1[r] - rm); }
    }
    WAIT_BAR(3);
    KRD(0, 8192); KRD(1, 8192); KRD(2, 8192); KRD(3, 8192);
#define PKW(P, B) cvtpk(P[B], P[(B) + 1])
#define PAF(k) __builtin_bit_cast(bf16x8, pw##k)
#define VFR(i) (bf16x8){vlo[(i) % 6][0], vlo[(i) % 6][1], vlo[(i) % 6][2], vlo[(i) % 6][3], vhi[(i) % 6][0], vhi[(i) % 6][1], vhi[(i) % 6][2], vhi[(i) % 6][3]}
#define VRD(i, VS) do { const LAS char* vq_ = ((((i) & 3) & 1) ? vpo : vpe) + (VS) + (((i) & 3) >> 1) * 8192 + ((i) >> 2) * 2048; vlo[(i) % 6] = vtr(vq_); vhi[(i) % 6] = vtr(vq_ + 1024); } while (0)
#define GAPA(g, CC, QI, KB, A0, A1, A2, A3, W0, W1, PW) do { CC = MFMA32(kf[(g) & 3], qr[QI], CC); if ((g) + 4 < 8) KRD((g) + 4, KB); sacc += A0; sacc += A1; sacc += A2; sacc += A3; PIN(sacc); W0; W1; PIN(PW); SBAR(); } while (0)
#define GAPB(i, X, B, VB, KN, PRE) do { o[(i) & 3] = MFMA32(PAF_SEL(i), VFR(i), o[(i) & 3]); X[B] = EX(X[B]); X[(B) + 1] = EX(X[(B) + 1]); PIN(X); if ((i) + 5 < 16) VRD((i) + 5, VB); \
    if ((PRE) && (i) >= 8 && (i) < 12) KRD((i) - 8, KN); SBAR(); } while (0)
#define PAF_SEL(i) (((i) >> 2) == 0 ? PAF(0) : ((i) >> 2) == 1 ? PAF(1) : ((i) >> 2) == 2 ? PAF(2) : PAF(3))
#define STEP(C0, C1, P0, P1, t, KB, VB, KN, PRE) do { SBAR(); \
    { const int d_ = (t) * 64 - qa; \
      if (d_ > -154 && d_ < 122) { const LAS float* t_ = tb + (d_ + 256 + 4 * hi - r32); \
        _Pragma("unroll") for (int r = 0; r < 16; ++r) { C0[r] = t_[(r & 3) + 8 * (r >> 2)] - mhat; C1[r] = t_[32 + (r & 3) + 8 * (r >> 2)] - mhat; } } \
      else { const float cs_ = (d_ < 0 ? cL : cR) - mhat; _Pragma("unroll") for (int r = 0; r < 16; ++r) { C0[r] = cs_; C1[r] = cs_; } } } \
    PIN(C0); PIN(C1); SBAR(); \
    float sacc = (P0[0] + P0[1]); \
    GAPA(0, C0, 0, KB, P0[2],  P0[3],  P0[4],  P0[5],  pw0[0] = PKW(P0, 0),  pw0[1] = PKW(P0, 2),  pw0); \
    GAPA(1, C1, 0, KB, P0[6],  P0[7],  P0[8],  P0[9],  pw0[2] = PKW(P0, 4),  pw0[3] = PKW(P0, 6),  pw0); \
    GAPA(2, C0, 1, KB, P0[10], P0[11], P0[12], P0[13], pw1[0] = PKW(P0, 8),  pw1[1] = PKW(P0, 10), pw1); \
    GAPA(3, C1, 1, KB, P0[14], P0[15], P1[0],  P1[1],  pw1[2] = PKW(P0, 12), pw1[3] = PKW(P0, 14), pw1); \
    GAPA(4, C0, 2, KB, P1[2],  P1[3],  P1[4],  P1[5],  pw2[0] = PKW(P1, 0),  pw2[1] = PKW(P1, 2),  pw2); \
    GAPA(5, C1, 2, KB, P1[6],  P1[7],  P1[8],  P1[9],  pw2[2] = PKW(P1, 4),  pw2[3] = PKW(P1, 6),  pw2); \
    GAPA(6, C0, 3, KB, P1[10], P1[11], P1[12], P1[13], pw3[0] = PKW(P1, 8),  pw3[1] = PKW(P1, 10), pw3); \
    GAPA(7, C1, 3, KB, P1[14], P1[15], 0.f,    0.f,    pw3[2] = PKW(P1, 12), pw3[3] = PKW(P1, 14), pw3); \
    l_reg += sacc; \
    VRD(0, VB); VRD(1, VB); VRD(2, VB); VRD(3, VB); VRD(4, VB); \
    { const float rm = rowmax32(C0, C1); resc = false; \
      if (__builtin_expect(__any(rm > THRL), 0)) { const float dl = __builtin_fmaxf(rm, 0.f); mhat += dl; \
        _Pragma("unroll") for (int r = 0; r < 16; ++r) { C0[r] -= dl; C1[r] -= dl; } \
        const float f = EX(-dl); l_reg *= f; if (hi == 0) wsf[r32] = f; resc = true; } } \
    SBAR(); \
    GAPB(0, C0, 0, VB, KN, PRE);  GAPB(1, C0, 2, VB, KN, PRE);  GAPB(2, C0, 4, VB, KN, PRE);   GAPB(3, C0, 6, VB, KN, PRE); \
    GAPB(4, C0, 8, VB, KN, PRE);  GAPB(5, C0, 10, VB, KN, PRE); GAPB(6, C0, 12, VB, KN, PRE);  GAPB(7, C0, 14, VB, KN, PRE); \
    GAPB(8, C1, 0, VB, KN, PRE);  GAPB(9, C1, 2, VB, KN, PRE);  GAPB(10, C1, 4, VB, KN, PRE);  GAPB(11, C1, 6, VB, KN, PRE); \
    GAPB(12, C1, 8, VB, KN, PRE); GAPB(13, C1, 10, VB, KN, PRE); GAPB(14, C1, 12, VB, KN, PRE); GAPB(15, C1, 14, VB, KN, PRE); \
    } while (0)
#define RESC() do { if (resc) { asm volatile("s_waitcnt lgkmcnt(0)" ::: "memory"); \
    _Pragma("unroll") for (int d = 0; d < 4; ++d) _Pragma("unroll") for (int r = 0; r < 16; ++r) o[d][r] *= wsf[crow(r, hi)]; } } while (0)
    int ks_cur = 8192, ks_n1 = 16384, ks_n3 = 0;
    int vs_prev = 0, vs_next = 32768;
#define ROT() do { ks_cur = (ks_cur + 8192) & 24576; ks_n1 = (ks_n1 + 8192) & 24576; ks_n3 = (ks_n3 + 8192) & 24576; vs_prev = vs_prev == 32768 ? 0 : vs_prev + 16384; vs_next = vs_next == 32768 ? 0 : vs_next + 16384; } while (0)
#define STEPX(C0, C1, P0, P1, t, PRE) STEP(C0, C1, P0, P1, t, ks_cur, vs_prev, ks_n1, PRE)
#pragma unroll 1
    for (int t = 1; t + 4 < NT; t += 2) {
        DMA_K(t + 3, ks_n3); DMA_V(t + 1, vs_next);
        STEPX(pB0, pB1, pA0, pA1, t, true);
        WAIT_BAR(3); RESC(); ROT();
        DMA_K(t + 4, ks_n3); DMA_V(t + 2, vs_next);
        STEPX(pA0, pA1, pB0, pB1, t + 1, true);
        WAIT_BAR(3); RESC(); ROT();
    }
    DMA_V(NT - 2, vs_next);
    STEPX(pB0, pB1, pA0, pA1, NT - 3, true);
    WAIT_BAR(2); RESC(); ROT();
    DMA_V(NT - 1, vs_next);
    STEPX(pA0, pA1, pB0, pB1, NT - 2, true);
    WAIT_BAR(2); RESC(); ROT();
    STEPX(pB0, pB1, pA0, pA1, NT - 1, false);
    WAIT_BAR(0); RESC(); ROT();
    { float sacc = 0.f;
#pragma unroll
      for (int r = 0; r < 16; ++r) sacc += pB0[r];
#pragma unroll
      for (int r = 0; r < 16; ++r) sacc += pB1[r];
      l_reg += sacc;
      pw0 = (u32x4){PKW(pB0, 0), PKW(pB0, 2), PKW(pB0, 4), PKW(pB0, 6)}; pw1 = (u32x4){PKW(pB0, 8), PKW(pB0, 10), PKW(pB0, 12), PKW(pB0, 14)};
      pw2 = (u32x4){PKW(pB1, 0), PKW(pB1, 2), PKW(pB1, 4), PKW(pB1, 6)}; pw3 = (u32x4){PKW(pB1, 8), PKW(pB1, 10), PKW(pB1, 12), PKW(pB1, 14)};
      SBAR();
#define DRAIN(i) do { VRD(i, vs_prev); o[(i) & 3] = MFMA32(PAF_SEL(i), VFR(i), o[(i) & 3]); } while (0)
      DRAIN(0); DRAIN(1); DRAIN(2); DRAIN(3); DRAIN(4); DRAIN(5); DRAIN(6); DRAIN(7); DRAIN(8); DRAIN(9); DRAIN(10); DRAIN(11); DRAIN(12); DRAIN(13); DRAIN(14); DRAIN(15);
#undef DRAIN
    }
    { auto rr = __builtin_amdgcn_permlane32_swap(__float_as_uint(l_reg), __float_as_uint(l_reg), false, false); l_out = __uint_as_float(rr[0]) + __uint_as_float(rr[1]); }
#undef DMA_K
#undef DMA_V
#undef WAIT_BAR
#undef ROT
#undef KRD
#undef PKW
#undef PAF
#undef VFR
#undef VRD
#undef GAPA
#undef GAPB
#undef PAF_SEL
#undef STEP
#undef STEPX
#undef RESC
}

__device__ __forceinline__ void diff_unit(int b, int h, int qb, const bf16_t* P, bf16_t* O, LAS char* lds, float lam, const float* relb) {
    const int tid = threadIdx.x, wid = __builtin_amdgcn_readfirstlane(tid >> 6), lane = tid & 63, r32 = lane & 31, hi = lane >> 5;
    const long rowbase = (long)b * SEQ; const int q0 = qb * 256, qa = q0 + wid * 32;
    LAS float* tb = (LAS float*)(lds + D_TB);
    LAS float* li_l = (LAS float*)(lds + D_WS) + wid * 64;
    tb[tid] = relb[rel_bucket(tid - 256) * NBH + h] * LOG2E;
    const float cL = relb[15 * NBH + h] * LOG2E, cR = relb[31 * NBH + h] * LOG2E;
    const bf16_t* Qrow = P + (rowbase + qa + r32) * PITCH + C_DQ + h * 128 + hi * 8;
    const bf16_t* Kh = P + rowbase * PITCH + C_DK + h * 128;
    const bf16_t* Vh = P + rowbase * PITCH + C_DV + h * 128;
    LAS u32x4* stash = (LAS u32x4*)(lds + D_ST + wid * 8192);
    f32x16 o[4]; float l_reg;
#pragma unroll 1
    for (int pass = 0; pass < 2; ++pass) {
        const int mo = pass == 0 ? 64 : 0;
        diff_pass(o, l_reg, Qrow + mo, Kh + mo, Vh, lds, qa, cL, cR);
        int ln = lane; asm volatile("" : "+v"(ln));
        const int r32e = ln & 31, hie = ln >> 5;
        if (hie == 0) li_l[r32e] = l_reg; asm volatile("s_waitcnt lgkmcnt(0)" ::: "memory");
        if (pass == 0) {
            float rli[16];
#pragma unroll
            for (int r = 0; r < 16; ++r) rli[r] = -lam * __builtin_amdgcn_rcpf(li_l[crow(r, hie)]);
#pragma unroll
            for (int d0 = 0; d0 < 4; ++d0) {
                u32x4 w0, w1;
                w0.x = cvtpk(o[d0][0] * rli[0], o[d0][1] * rli[1]); w0.y = cvtpk(o[d0][2] * rli[2], o[d0][3] * rli[3]); w0.z = cvtpk(o[d0][4] * rli[4], o[d0][5] * rli[5]); w0.w = cvtpk(o[d0][6] * rli[6], o[d0][7] * rli[7]);
                w1.x = cvtpk(o[d0][8] * rli[8], o[d0][9] * rli[9]); w1.y = cvtpk(o[d0][10] * rli[10], o[d0][11] * rli[11]); w1.z = cvtpk(o[d0][12] * rli[12], o[d0][13] * rli[13]); w1.w = cvtpk(o[d0][14] * rli[14], o[d0][15] * rli[15]);
                stash[(2 * d0) * 64 + ln] = w0; stash[(2 * d0 + 1) * 64 + ln] = w1;
            }
        } else {
            float rli[16], ssq[16];
#pragma unroll
            for (int r = 0; r < 16; ++r) { rli[r] = __builtin_amdgcn_rcpf(li_l[crow(r, hie)]); ssq[r] = 0.f; }
#pragma unroll
            for (int d0 = 0; d0 < 4; ++d0) {
                const u32x4 w0 = stash[(2 * d0) * 64 + ln], w1 = stash[(2 * d0 + 1) * 64 + ln];
                const unsigned ww[8] = {w0.x, w0.y, w0.z, w0.w, w1.x, w1.y, w1.z, w1.w};
#pragma unroll
                for (int r = 0; r < 16; ++r) { const float c = __uint_as_float((r & 1) ? (ww[r >> 1] & 0xffff0000u) : (ww[r >> 1] << 16));
                    const float x = fmaf(o[d0][r], rli[r], c); o[d0][r] = x; ssq[r] = fmaf(x, x, ssq[r]); }
            }
            asm volatile("s_waitcnt lgkmcnt(0)" ::: "memory");
#pragma unroll
            for (int r = 0; r < 16; ++r) { float s = ssq[r];
                s += __shfl_xor(s, 1); s += __shfl_xor(s, 2); s += __shfl_xor(s, 4); s += __shfl_xor(s, 8); s += __shfl_xor(s, 16);
                ssq[r] = __builtin_amdgcn_rsqf(s * (1.0f / 128.0f) + EPS); }
            LAS bf16_t* stg = (LAS bf16_t*)(lds + D_ST + wid * 8192);
#pragma unroll
            for (int r = 0; r < 16; ++r) { const int orow = crow(r, hie);
#pragma unroll
                for (int d0 = 0; d0 < 4; ++d0) stg[orow * 128 + d0 * 32 + r32e] = (bf16_t)(cvtpk(o[d0][r] * ssq[r], 0.f) & 0xffffu); }
            asm volatile("s_waitcnt lgkmcnt(0)" ::: "memory");
            bf16_t* Ow = O + (rowbase + qa + (ln >> 4)) * DM + h * 128 + (ln & 15) * 8;
            const LAS bf16_t* sl = stg + (ln >> 4) * 128 + (ln & 15) * 8;
#pragma unroll
            for (int i = 0; i < 8; ++i) { const u32x4 v = *(const LAS u32x4*)(sl + i * 512); *(u32x4*)(Ow + (long)i * 4 * DM) = v; }
        }
    }
    asm volatile("s_waitcnt lgkmcnt(0)" ::: "memory"); __syncthreads();
}

constexpr int W_K = 0, W_V = 49152, W_TB = 98304, W_WS = 106496, W_OST = 108544, W_END = W_OST + 32768;
__device__ __forceinline__ void win_unit(int b, int kvh, int qb, const bf16_t* P, bf16_t* O, LAS char* lds, const float* relb, const float* sink) {
    const int tid = threadIdx.x, wid = __builtin_amdgcn_readfirstlane(tid >> 6), lane = tid & 63, r32 = lane & 31, hi = lane >> 5;
    const long rowbase = (long)b * SEQ; const int q0 = qb * 128, kbase = q0 - 128;
    LAS float* tbw = (LAS float*)(lds + W_TB);
#pragma unroll
    for (int e = 0; e < 4; ++e) { const int idx = tid + e * 512, g = idx >> 9, rel = (idx & 511) - 256;
        tbw[idx] = (rel >= -128 && rel <= 128) ? (relb[rel_bucket(rel) * NBH + 4 + 4 * kvh + g] - sink[4 * kvh + g]) * LOG2E : -1e30f; }
    { int tl = tid; asm volatile("" : "+v"(tl));
      const int kr = tl >> 3, kc = (tl & 7) * 8, kst = KSW(kr, kc * 2), vst = v_st<2>(kr, kc);
      const bf16_t* Kh = P + rowbase * PITCH + C_WK + kvh * 64; const bf16_t* Vh = P + rowbase * PITCH + C_WV + kvh * 64;
      bf16x8 kreg[6], vreg[6];
#pragma unroll
      for (int t = 0; t < 6; ++t) { const int k0 = kbase + 64 * t; if (k0 >= 0 && k0 < SEQ) { kreg[t] = *(const bf16x8*)(&Kh[(long)(k0 + kr) * PITCH + kc]); vreg[t] = *(const bf16x8*)(&Vh[(long)(k0 + kr) * PITCH + kc]); } }
#pragma unroll
      for (int t = 0; t < 6; ++t) { const int k0 = kbase + 64 * t; if (k0 >= 0 && k0 < SEQ) { *(LAS bf16x8*)(lds + W_K + t * 8192 + kst) = kreg[t]; *(LAS bf16x8*)(lds + W_V + t * 8192 + vst) = vreg[t]; } }
    }
    __syncthreads();
    const int g = wid >> 1, hq = 4 * kvh + g;
    LAS float* li_l = (LAS float*)(lds + W_WS) + wid * 64;
    const LAS float* tbg = tbw + g * 512;
    const int vbw = (int)(uintptr_t)(lds + W_V) + v_rd_base(lane);
#pragma unroll 1
    for (int jb = 0; jb < 2; ++jb) {
        const int ql = 64 * (wid & 1) + 32 * jb;
        const bf16_t* Qw = P + (rowbase + q0 + ql + r32) * PITCH + C_WQ + hq * 64 + hi * 8;
        bf16x8 qr[4];
#pragma unroll
        for (int d0 = 0; d0 < 4; ++d0) qr[d0] = *(const bf16x8*)(Qw + d0 * 16);
        float l_reg = 0.f;
        f32x16 o[2]; o[0] = f32x16{}; o[1] = f32x16{};
        const int t_lo = ql >> 6;
#pragma unroll 1
        for (int t = t_lo; t < t_lo + 5; ++t) {
            const int k0 = kbase + 64 * t; if (k0 < 0 || k0 >= SEQ) continue;
            const int d_ = 64 * t - 128 - ql;
            const LAS float* t_ = tbg + (d_ + 256 + 4 * hi - r32);
            f32x16 p0, p1;
#pragma unroll
            for (int r = 0; r < 16; ++r) { p0[r] = t_[(r & 3) + 8 * (r >> 2)]; p1[r] = t_[32 + (r & 3) + 8 * (r >> 2)]; }
            qkt64(p0, p1, lds + W_K + t * 8192, qr, r32, hi);
#pragma unroll
            for (int r = 0; r < 16; ++r) { p0[r] = __builtin_amdgcn_exp2f(p0[r]); p1[r] = __builtin_amdgcn_exp2f(p1[r]); }
            bf16x8 pa0, pa1, pa2, pa3;
            {
                float ps = 0;
#pragma unroll
                for (int r = 0; r < 16; ++r) ps += p0[r];
#pragma unroll
                for (int r = 0; r < 16; ++r) ps += p1[r];
                l_reg += ps;
#define PK4(Pv, BASE, OUT) do { unsigned a0 = cvtpk(Pv[BASE + 0], Pv[BASE + 1]), a1 = cvtpk(Pv[BASE + 2], Pv[BASE + 3]);   \
    unsigned b0 = cvtpk(Pv[BASE + 4], Pv[BASE + 5]), b1 = cvtpk(Pv[BASE + 6], Pv[BASE + 7]);                              \
    auto r0 = __builtin_amdgcn_permlane32_swap(a0, b0, false, false); auto r1 = __builtin_amdgcn_permlane32_swap(a1, b1, false, false); \
    u32x4 w = {r0[0], r1[0], r0[1], r1[1]}; OUT = __builtin_bit_cast(bf16x8, w); } while (0)
                PK4(p0, 0, pa0); PK4(p0, 8, pa1); PK4(p1, 0, pa2); PK4(p1, 8, pa3);
#undef PK4
            }
            const int vb = vbw + t * 8192;
            pv_one<2, 0>(o[0], vb, pa0, pa1, pa2, pa3); pv_one<2, 1>(o[1], vb, pa0, pa1, pa2, pa3);
        }
        { auto rr = __builtin_amdgcn_permlane32_swap(__float_as_uint(l_reg), __float_as_uint(l_reg), false, false); l_reg = 1.0f + __uint_as_float(rr[0]) + __uint_as_float(rr[1]); }
        int ln = lane; asm volatile("" : "+v"(ln));
        const int r32e = ln & 31, hie = ln >> 5;
        if (hie == 0) li_l[r32e] = l_reg; asm volatile("s_waitcnt lgkmcnt(0)" ::: "memory");
        float rli[16];
#pragma unroll
        for (int r = 0; r < 16; ++r) rli[r] = __builtin_amdgcn_rcpf(li_l[crow(r, hie)]);
        LAS bf16_t* stg = (LAS bf16_t*)(lds + W_OST + wid * 4096);
#pragma unroll
        for (int r = 0; r < 16; ++r) { const int orow = crow(r, hie);
#pragma unroll
            for (int d0 = 0; d0 < 2; ++d0) stg[orow * 64 + d0 * 32 + r32e] = (bf16_t)(cvtpk(o[d0][r] * rli[r], 0.f) & 0xffffu); }
        asm volatile("s_waitcnt lgkmcnt(0)" ::: "memory");
        bf16_t* Ow = O + (rowbase + q0 + ql + (ln >> 3)) * DM + 512 + hq * 64 + (ln & 7) * 8;
        const LAS bf16_t* sl = stg + (ln >> 3) * 64 + (ln & 7) * 8;
#pragma unroll
        for (int i = 0; i < 4; ++i) { const u32x4 v = *(const LAS u32x4*)(sl + i * 512); *(u32x4*)(Ow + (long)i * 8 * DM) = v; }
        asm volatile("s_waitcnt lgkmcnt(0)" ::: "memory");
    }
    asm volatile("s_waitcnt lgkmcnt(0)" ::: "memory"); __syncthreads();
}
#undef SBAR
#undef KSW
}

constexpr size_t MiB = 1u << 20;
constexpr size_t WS_CTL = 0, CTL_ZERO_BYTES = 64 * 1024;
constexpr size_t WS_W1 = 1 * MiB;
constexpr size_t WS_W2 = WS_W1 + (size_t)DIN * DM * 2;
constexpr size_t WS_W3 = WS_W2 + (size_t)DM * DM * 2;
constexpr size_t WS_W4 = WS_W3 + (size_t)2 * DFF * DM * 2;
constexpr size_t WS_XS = 24 * MiB;
constexpr int CW_WMAX4 = 5120;
constexpr int CW_GBAR = 6400;
constexpr int CW_P3CNT = 4480;
constexpr size_t WS_FA = 26 * MiB;
constexpr size_t WS_FX = 26 * MiB + 512 * 1024;
constexpr int CW_WMAX1 = 13824, CW_W1CNT = 16200;
constexpr int CW_WMAX = 8192;
constexpr size_t WS_X0S = 27 * MiB;
constexpr size_t WS_PROJ = 28 * MiB;
constexpr size_t WS_OB = 244 * MiB;
constexpr size_t WS_XQ = 340 * MiB;
constexpr size_t WS_X1Q = 340 * MiB;
constexpr size_t WS_X1B = 388 * MiB;
constexpr size_t WS_ACT = 28 * MiB;
constexpr size_t WS_END = WS_X1B + (size_t)NTOK * DM * 2;
static_assert(WS_W4 + (size_t)DM * DFF * 2 <= WS_XS && WS_XS + (size_t)NTOK * 32 <= WS_FA && WS_FA + (size_t)NTOK * 4 <= WS_FX && WS_FX + (size_t)NTOK * 4 <= WS_X0S && WS_X0S + (size_t)NTOK * 4 <= WS_PROJ, "d_ws map");
static_assert(WS_PROJ + (size_t)NTOK * DIN * 2 <= WS_OB && WS_OB + (size_t)NTOK * DM * 2 <= WS_XQ && WS_XQ + (size_t)NTOK * DM <= WS_X1B && WS_ACT + (size_t)NTOK * DFF * 2 <= WS_X1Q - 4096, "d_ws map");
static_assert(CW_WMAX + 2 * DFF <= CW_WMAX1 && CW_WMAX1 + DIN <= CW_W1CNT && CW_W1CNT * 4 < CTL_ZERO_BYTES && 1024 + 3456 <= CW_P3CNT && CW_P3CNT + 192 <= CW_WMAX4 && CW_WMAX4 + DM <= CW_GBAR && CW_GBAR + 8 * 128 <= CW_WMAX, "d_ws map");
constexpr int CW_BAR = 1024, XCD_BAR_WORDS_C = 3456;

constexpr int RING_BYTES = 131072, EPX_OFF = RING_BYTES, LDS_BYTES = 163840, MISC_OFF = LDS_BYTES - 512;
static_assert(att::D_END <= MISC_OFF && att::W_END <= MISC_OFF && EPX_OFF + 22528 <= MISC_OFF, "LDS map");

typedef GAS unsigned gu32;
#define RLX_AGENT __ATOMIC_RELAXED, __HIP_MEMORY_SCOPE_AGENT
#define LDS_WAIT() asm volatile("s_waitcnt lgkmcnt(0)" ::: "memory")

#define XB_TMO      128
#define XB_XCNT(j)  (256  + 64 * (j))
#define XB_XSUB(j)  (1280 + 64 * (j))
#define XB_XGEN(j)  (2304 + 64 * (j))
#define XB_TOP      3328
#define XB_TOPGEN   3392
#define XCD_BAR_WORDS 3456
#define XB_SPIN_CAP (1u << 22)
__device__ __forceinline__ unsigned xb_ld(unsigned* p)              { return __hip_atomic_load(p, __ATOMIC_RELAXED, __HIP_MEMORY_SCOPE_AGENT); }
__device__ __forceinline__ unsigned xb_add(unsigned* p, unsigned v) { return __hip_atomic_fetch_add(p, v, __ATOMIC_RELAXED, __HIP_MEMORY_SCOPE_AGENT); }
__device__ __forceinline__ unsigned xb_xcc_id() { return (unsigned)__builtin_amdgcn_s_getreg((3 << 11) | 20) & 0xFu; }
#define XB_SPIN(cond, bar) do { unsigned _sp = 0; while (cond) { __builtin_amdgcn_s_sleep(1); \
    if ((++_sp & 255u) == 0u) { if (xb_ld(&(bar)[XB_TMO])) break; if (_sp > XB_SPIN_CAP) { atomicAdd(&(bar)[XB_TMO], 1u); break; } } } } while (0)
struct XcdBarrier { unsigned* bar; unsigned x; volatile LAS unsigned* st; };
__device__ __forceinline__ XcdBarrier xcd_barrier_post(unsigned* bar, volatile LAS unsigned* st) {
    XcdBarrier b; b.bar = bar; b.x = xb_xcc_id(); b.st = st;
    if (threadIdx.x == 0) (void)xb_add(&bar[XB_XCNT(b.x)], 1u);
    return b;
}
__device__ __forceinline__ void xcd_barrier_complete(unsigned* bar, unsigned x, unsigned& nloc, unsigned& nx) {
    const unsigned G = gridDim.x * gridDim.y * gridDim.z;
    unsigned sum, cnt, mine, sp = 0u;
    for (;;) {
        sum = 0u; cnt = 0u; mine = 0u;
#pragma unroll
        for (unsigned j = 0; j < 16; ++j) { const unsigned c = xb_ld(&bar[XB_XCNT(j)]); sum += c; cnt += (c > 0u) ? 1u : 0u; mine = (j == x) ? c : mine; }
        if (sum == G) break;
        __builtin_amdgcn_s_sleep(1);
        if ((++sp & 255u) == 0u) { if (xb_ld(&bar[XB_TMO])) break; if (sp > XB_SPIN_CAP) { atomicAdd(&bar[XB_TMO], 1u); break; } }
    }
    nloc = mine > 0u ? mine : 1u; nx = cnt > 0u ? cnt : 1u;
}
__device__ __forceinline__ void xcd_barrier(const XcdBarrier& b) {
    asm volatile("s_waitcnt vmcnt(0)" ::: "memory");
    __syncthreads();
    if (threadIdx.x == 0) {
        unsigned* bar = b.bar;
        __builtin_amdgcn_s_waitcnt(0);
        unsigned nloc = b.st[0], nx = b.st[1];
        if (nloc == 0u) { xcd_barrier_complete(bar, b.x, nloc, nx); b.st[0] = nloc; b.st[1] = nx; }
        const unsigned old = xb_add(&bar[XB_XSUB(b.x)], 1u);
        const unsigned gen = old / nloc;
        if (old + 1u == (gen + 1u) * nloc) {
            __builtin_amdgcn_fence(__ATOMIC_RELEASE, "agent");
            asm volatile("s_waitcnt vmcnt(0)" ::: "memory");
            const unsigned og = xb_add(&bar[XB_TOP], 1u);
            const unsigned tg = og / nx;
            if (og + 1u == (tg + 1u) * nx) xb_add(&bar[XB_TOPGEN], 1u);
            else XB_SPIN(xb_ld(&bar[XB_TOPGEN]) == tg, bar);
            __builtin_amdgcn_fence(__ATOMIC_ACQUIRE, "agent");
            xb_add(&bar[XB_XGEN(b.x)], 1u);
            asm volatile("s_waitcnt vmcnt(0)" ::: "memory");
        } else {
            XB_SPIN(xb_ld(&bar[XB_XGEN(b.x)]) == gen, bar);
            __builtin_amdgcn_fence(__ATOMIC_ACQUIRE, "agent");
            asm volatile("s_waitcnt vmcnt(0)" ::: "memory");
        }
    }
    __syncthreads();
}

__device__ __forceinline__ void group_barrier(unsigned* gb, unsigned nmem, volatile LAS unsigned* ep) {
    asm volatile("s_waitcnt vmcnt(0)" ::: "memory");
    __syncthreads();
    if (threadIdx.x == 0) {
        __builtin_amdgcn_fence(__ATOMIC_RELEASE, "agent");
        asm volatile("s_waitcnt vmcnt(0)" ::: "memory");
        const unsigned e = ep[0]; ep[0] = e + 1u;
        const unsigned old = xb_add(&gb[0], 1u);
        if (old + 1u == (e + 1u) * nmem) xb_add(&gb[64], 1u);
        else { unsigned sp = 0; while (xb_ld(&gb[64]) == e) { __builtin_amdgcn_s_sleep(1); if (++sp > XB_SPIN_CAP) break; } }
        __builtin_amdgcn_fence(__ATOMIC_ACQUIRE, "agent");
        asm volatile("s_waitcnt vmcnt(0)" ::: "memory");
    }
    __syncthreads();
}

__device__ __forceinline__ float wave_sum(float v) {
#pragma unroll
    for (int o = 1; o < 64; o <<= 1) v += __shfl_xor(v, o);
    return v;
}
__device__ __forceinline__ unsigned f2bf(float f) { unsigned u = __builtin_bit_cast(unsigned, f); return (u + 0x7fffu + ((u >> 16) & 1u)) >> 16; }
__device__ __forceinline__ unsigned pk2(float lo, float hi) { return f2bf(lo) | (f2bf(hi) << 16); }
__device__ __forceinline__ void transpose_item(const float* W, int ld, int cbase, int K, int k0, bf16_t* WT, int nrow0, const float* fold, int foldmask, float fscale, int foldlim, LAS float* scr, int lane) {
    float wv[32];
#pragma unroll
    for (int i = 0; i < 32; ++i) wv[i] = W[(size_t)(k0 + 2 * i + (lane >> 5)) * ld + cbase + (lane & 31)];
#pragma unroll
    for (int i = 0; i < 32; ++i) { const int kk = 2 * i + (lane >> 5), k = k0 + kk;
        float f = 1.f; if (fold != nullptr && k < foldlim) f = fold[k & foldmask] * fscale;
        scr[kk * 33 + (lane & 31)] = wv[i] * f; }
    LDS_WAIT(); asm volatile("" ::: "memory");
    const int c = lane & 7;
#pragma unroll
    for (int j = 0; j < 4; ++j) { const int n = (lane >> 3) + 8 * j; const LAS float* s = scr + (8 * c) * 33 + n;
        u32x4 o; o.x = pk2(s[0 * 33], s[1 * 33]); o.y = pk2(s[2 * 33], s[3 * 33]); o.z = pk2(s[4 * 33], s[5 * 33]); o.w = pk2(s[6 * 33], s[7 * 33]);
        *(u32x4*)(WT + (size_t)(nrow0 + n) * K + k0 + 8 * c) = o; }
    LDS_WAIT(); asm volatile("" ::: "memory");
}

__device__ __forceinline__ void absmax_item(const float* W, int ld, int cbase, int k0, unsigned* wmax, const float* fold, int lane) {
    float wv[32];
#pragma unroll
    for (int i = 0; i < 32; ++i) wv[i] = W[(size_t)(k0 + 2 * i + (lane >> 5)) * ld + cbase + (lane & 31)];
    float m = 0.f;
#pragma unroll
    for (int i = 0; i < 32; ++i) m = __builtin_fmaxf(m, __builtin_fabsf(wv[i] * (fold ? fold[k0 + 2 * i + (lane >> 5)] : 1.f)));
    m = __builtin_fmaxf(m, __shfl_xor(m, 32));
    if (lane < 32) (void)__hip_atomic_fetch_max(wmax + lane, __float_as_uint(m), __ATOMIC_RELAXED, __HIP_MEMORY_SCOPE_AGENT);
}
__device__ __forceinline__ void quant_item(const float* W, int ld, int cbase, int K, int k0, signed char* WQ, int nrow0, const float* fold, const unsigned* wmax, LAS float* scr, int lane) {
    float wv[32];
#pragma unroll
    for (int i = 0; i < 32; ++i) wv[i] = W[(size_t)(k0 + 2 * i + (lane >> 5)) * ld + cbase + (lane & 31)];
    const float am = __uint_as_float(__hip_atomic_load(wmax + (lane & 31), __ATOMIC_RELAXED, __HIP_MEMORY_SCOPE_AGENT)); const float inv = am > 0.f ? 127.0f / am : 0.f;
#pragma unroll
    for (int i = 0; i < 32; ++i) { const int kk = 2 * i + (lane >> 5); scr[kk * 33 + (lane & 31)] = wv[i] * fold[k0 + kk] * inv; }
    LDS_WAIT(); asm volatile("" ::: "memory");
    const int n = lane >> 1, c = lane & 1; const LAS float* sp = scr + (32 * c) * 33 + n;
    u32x4 o0, o1;
    o0.x = q4(sp[0 * 33], sp[1 * 33], sp[2 * 33], sp[3 * 33]);     o0.y = q4(sp[4 * 33], sp[5 * 33], sp[6 * 33], sp[7 * 33]);
    o0.z = q4(sp[8 * 33], sp[9 * 33], sp[10 * 33], sp[11 * 33]);   o0.w = q4(sp[12 * 33], sp[13 * 33], sp[14 * 33], sp[15 * 33]);
    o1.x = q4(sp[16 * 33], sp[17 * 33], sp[18 * 33], sp[19 * 33]); o1.y = q4(sp[20 * 33], sp[21 * 33], sp[22 * 33], sp[23 * 33]);
    o1.z = q4(sp[24 * 33], sp[25 * 33], sp[26 * 33], sp[27 * 33]); o1.w = q4(sp[28 * 33], sp[29 * 33], sp[30 * 33], sp[31 * 33]);
    u32x4* dst = (u32x4*)(WQ + (size_t)(nrow0 + n) * K + k0 + 32 * c);
    dst[0] = o0; dst[1] = o1;
    LDS_WAIT(); asm volatile("" ::: "memory");
}

__device__ __forceinline__ void quantf8_item(const float* W, int ld, int cbase, int K, int k0, unsigned char* WQ, int nrow0, const unsigned* wmax, LAS float* scr, int lane) {
    float wv[32];
#pragma unroll
    for (int i = 0; i < 32; ++i) wv[i] = W[(size_t)(k0 + 2 * i + (lane >> 5)) * ld + cbase + (lane & 31)];
    const float am = __uint_as_float(__hip_atomic_load(wmax + (lane & 31), __ATOMIC_RELAXED, __HIP_MEMORY_SCOPE_AGENT)); const float inv = am > 0.f ? W8_TOP / am : 0.f;
#pragma unroll
    for (int i = 0; i < 32; ++i) { const int kk = 2 * i + (lane >> 5); scr[kk * 33 + (lane & 31)] = wv[i] * inv; }
    LDS_WAIT(); asm volatile("" ::: "memory");
    const int n = lane >> 1, c = lane & 1; const LAS float* sp = scr + (32 * c) * 33 + n;
    u32x4 o0, o1;
    o0.x = f8x4(sp[0 * 33], sp[1 * 33], sp[2 * 33], sp[3 * 33]);     o0.y = f8x4(sp[4 * 33], sp[5 * 33], sp[6 * 33], sp[7 * 33]);
    o0.z = f8x4(sp[8 * 33], sp[9 * 33], sp[10 * 33], sp[11 * 33]);   o0.w = f8x4(sp[12 * 33], sp[13 * 33], sp[14 * 33], sp[15 * 33]);
    o1.x = f8x4(sp[16 * 33], sp[17 * 33], sp[18 * 33], sp[19 * 33]); o1.y = f8x4(sp[20 * 33], sp[21 * 33], sp[22 * 33], sp[23 * 33]);
    o1.z = f8x4(sp[24 * 33], sp[25 * 33], sp[26 * 33], sp[27 * 33]); o1.w = f8x4(sp[28 * 33], sp[29 * 33], sp[30 * 33], sp[31 * 33]);
    u32x4* dst = (u32x4*)(WQ + (size_t)(nrow0 + n) * K + k0 + 32 * c);
    dst[0] = o0; dst[1] = o1;
    LDS_WAIT(); asm volatile("" ::: "memory");
}

struct Args { const float* in[22]; float* out; unsigned char* ws; int ph_lo, ph_hi, li, pad; };

__global__ void __launch_bounds__(NWAVES * 64, 2) hymba_fwd(Args args) {
    extern __shared__ __attribute__((aligned(16))) unsigned char lds_raw[];
    LAS unsigned char* lds = (LAS unsigned char*)lds_raw;
    volatile LAS unsigned* MISC = (volatile LAS unsigned*)(lds + MISC_OFF);
    const int tid = threadIdx.x, lane = tid & 63, wave = __builtin_amdgcn_readfirstlane(tid >> 6);
    const int G = gridDim.x; const int bx = blockIdx.x; const int vcu = (G % 8 == 0) ? (bx % 8) * (G / 8) + bx / 8 : bx;
    unsigned char* ws = args.ws;
    unsigned* ctl = (unsigned*)(ws + WS_CTL);
    const float* xp = args.in[0]; const float* xs = args.in[1];
    bf16_t* W1 = (bf16_t*)(ws + WS_W1); bf16_t* W2 = (bf16_t*)(ws + WS_W2); bf16_t* W3 = (bf16_t*)(ws + WS_W3); bf16_t* W4 = (bf16_t*)(ws + WS_W4);
    bf16_t* PROJ = (bf16_t*)(ws + WS_PROJ); bf16_t* X1B = (bf16_t*)(ws + WS_X1B); bf16_t* ACT = (bf16_t*)(ws + WS_ACT);
    bf16_t* OB = (bf16_t*)(ws + WS_OB);
    signed char* XQ = (signed char*)(ws + WS_XQ); float* FX = (float*)(ws + WS_FX); signed char* W1Q = (signed char*)(ws + WS_W1);
    for (int u = tid; u < 128; u += NWAVES * 64) ((LAS unsigned*)(lds + MISC_OFF))[u] = 0u;
    __syncthreads();
    XcdBarrier bar; bar.bar = ctl + CW_BAR + args.li * XCD_BAR_WORDS; bar.x = 0; bar.st = nullptr;
    if (MK_N_LAUNCHES != 6) bar = xcd_barrier_post(ctl + CW_BAR + args.li * XCD_BAR_WORDS, MISC + 8);
    const int lo = args.ph_lo, hi_ph = args.ph_hi;
#ifndef ONLY_PHASE
#define ONLY_PHASE -1
#endif
#define IN(k) ((ONLY_PHASE < 0 || ONLY_PHASE == (k)) && lo <= (k) && (k) < hi_ph)
#define BOTH(k) (IN(k) && IN((k) + 1))
#define GRID_BAR() do { if (MK_N_LAUNCHES != 6) xcd_barrier(bar); } while (0)
#define GROUP_BAR() do { if (MK_N_LAUNCHES != 6) { if (G == 256) group_barrier(ctl + CW_GBAR + (bx & 7) * 128, 32u, MISC + 12); else xcd_barrier(bar); } } while (0)

    if (IN(0)) {
        LAS float* scr = (LAS float*)(lds + wave * 16384);
        const int gw = vcu * NWAVES + wave, NGW = G * NWAVES;
        constexpr int I1 = (DM / 64) * (DIN / 32), I2 = (DM / 64) * (DM / 32), I3 = (DM / 64) * (2 * DFF / 32), I4 = (DFF / 64) * (DM / 32);
        for (int it = gw; it < I1 + I2 + I3 + I4; it += NGW) {
            int r = it;
            if (r < I1) { const int nblk = DIN / 32, kb = r / nblk, nb = r % nblk, n0 = 32 * nb, pn = n0 >> 8, p = n0 & 255, bj = p >> 7, wc = (p & 127) >> 5;
                absmax_item(args.in[3], DIN, 256 * pn + 64 * wc + 32 * bj, 64 * kb, ctl + CW_WMAX1 + n0, args.in[2], lane);
                asm volatile("s_waitcnt vmcnt(0)" ::: "memory"); if (lane == 0) (void)__hip_atomic_fetch_add(ctl + CW_W1CNT, 1u, __ATOMIC_RELAXED, __HIP_MEMORY_SCOPE_AGENT); continue; } r -= I1;
            if (r < I2) { const int nblk = DM / 32, kb = r / nblk, nb = r % nblk;
                const int n0 = 32 * nb, pn = n0 >> 8, p = n0 & 255, bj = p >> 7, wc = (p & 127) >> 5;
                transpose_item(args.in[15], DM, 256 * pn + 64 * wc + 32 * bj, DM, 64 * kb, W2, n0, args.in[10], 127, 1.0f - LAM_INIT, 512, scr, lane); continue; } r -= I2;
            if (r < I3) { const int nblk = 2 * DFF / 32, kb = r / nblk, nb = r % nblk, n0 = 32 * nb, pn = n0 >> 8, p = n0 & 255, bj = p >> 7, e0 = p & 127;
                absmax_item(bj ? args.in[18] : args.in[17], DFF, 128 * pn + e0, 64 * kb, ctl + CW_WMAX + n0, args.in[16], lane); continue; } r -= I3;
            { const int nblk = DM / 32, kb = r / nblk, nb = r % nblk;
                absmax_item(args.in[21], DM, 32 * nb, 64 * kb, ctl + CW_WMAX4 + 32 * nb, nullptr, lane); }
        }
        for (int m = gw; m < NTOK; m += 4 * NGW) {
            f32x4 v[4][4]; float ss[4]; int mr[4];
#pragma unroll
            for (int q = 0; q < 4; ++q) { int mm = m + q * NGW; mr[q] = mm; if (mm >= NTOK) mm = m;
                const float* xr = mm < TOK_P ? xp + (size_t)mm * DM : xs + (size_t)(mm - TOK_P) * DM;
#pragma unroll
                for (int j = 0; j < 4; ++j) v[q][j] = __builtin_nontemporal_load((const f32x4*)xr + 64 * j + lane); }
#pragma unroll
            for (int q = 0; q < 4; ++q) { ss[q] = 0.f;
#pragma unroll
                for (int j = 0; j < 4; ++j) ss[q] += dot4(v[q][j]); }
#pragma unroll
            for (int o = 1; o < 64; o <<= 1) {
#pragma unroll
                for (int q = 0; q < 4; ++q) ss[q] += __shfl_xor(ss[q], o); }
            float am[4];
#pragma unroll
            for (int q = 0; q < 4; ++q) { float a = 0.f;
#pragma unroll
                for (int j = 0; j < 4; ++j) a = __builtin_fmaxf(__builtin_fmaxf(a, __builtin_fmaxf(__builtin_fabsf(v[q][j][0]), __builtin_fabsf(v[q][j][1]))), __builtin_fmaxf(__builtin_fabsf(v[q][j][2]), __builtin_fabsf(v[q][j][3])));
                am[q] = a; }
#pragma unroll
            for (int o = 1; o < 64; o <<= 1) {
#pragma unroll
                for (int q = 0; q < 4; ++q) am[q] = __builtin_fmaxf(am[q], __shfl_xor(am[q], o)); }
#pragma unroll
            for (int q = 0; q < 4; ++q) if (mr[q] < NTOK) { const float ms = ss[q] * (1.f / DM) + EPS; const float r = __builtin_amdgcn_rsqf(ms);
                { const float inv = am[q] > 0.f ? 127.0f / am[q] : 0.f;
                  unsigned* oq = (unsigned*)(XQ + (size_t)mr[q] * DM) + lane;
#pragma unroll
                  for (int j = 0; j < 4; ++j) oq[64 * j] = q4(v[q][j][0] * inv, v[q][j][1] * inv, v[q][j][2] * inv, v[q][j][3] * inv);
                  if (lane == 0) { FX[mr[q]] = am[q] * r * (1.0f / 127.0f); ((float*)(ws + WS_X0S))[mr[q]] = am[q] * (1.0f / 127.0f); } }
            }
        }
        { unsigned sp = 0; while (__builtin_amdgcn_readfirstlane(__hip_atomic_load(ctl + CW_W1CNT, __ATOMIC_RELAXED, __HIP_MEMORY_SCOPE_AGENT)) < (unsigned)I1) { __builtin_amdgcn_s_sleep(2); if (++sp > (1u << 22)) break; }
          __builtin_amdgcn_fence(__ATOMIC_ACQUIRE, "agent"); }
        for (int r = gw; r < I1; r += NGW) { const int nblk = DIN / 32, kb = r / nblk, nb = r % nblk, n0 = 32 * nb, pn = n0 >> 8, p = n0 & 255, bj = p >> 7, wc = (p & 127) >> 5;
            quant_item(args.in[3], DIN, 256 * pn + 64 * wc + 32 * bj, DM, 64 * kb, W1Q, n0, args.in[2], ctl + CW_WMAX1 + n0, scr, lane); }
        if (BOTH(0)) GRID_BAR();
    }

    if (IN(1)) {
        pg8::Gemm g{(const bf16_t*)XQ, (const bf16_t*)W1Q, DM / 2, 256}; pg8::StaticOrder S; S.init(NTOK / 256, DIN / 256, G, bx);
        { LAS float* gl = (LAS float*)(lds + EPX_OFF);
          if (tid < 256) { const int v = tid >> 6, d = tid & 63; gl[tid] = (v == 0 ? args.in[4] : v == 1 ? args.in[5] : v == 2 ? args.in[11] : args.in[12])[d]; }
          LDS_WAIT(); __syncthreads(); }
        pg8::EpiProj E{PROJ, (const LAS float*)(lds + EPX_OFF), FX, (const float*)(ctl + CW_WMAX1)};
        pg8::gemm_phase<pg8::EpiProj, pg8::StaticOrder, true, true, 1>(lds, g, S, E);
        if (BOTH(1)) GROUP_BAR();
    }

    if (IN(2)) {
        if (wave == 0) {
            const float a = args.in[6][lane] * args.in[7][lane], b2 = args.in[8][lane] * args.in[9][lane];
            const float sa = wave_sum(a), sb = wave_sum(b2);
            if (lane == 0) ((LAS float*)(lds + MISC_OFF))[16] = __expf(sa) - __expf(sb) + LAM_INIT;
        }
        LDS_WAIT(); __syncthreads();
        const float lam = ((const LAS float*)(lds + MISC_OFF))[16];
        const int per = (768 + G - 1) / G;
#ifndef NO_DIFF
        for (int i = 0; i < per; ++i) { const int u = vcu * per + i; if (u < 768) { const int bh = u >> 3, qb = u & 7;
            att::diff_unit(bh >> 2, bh & 3, qb, PROJ, OB, (LAS char*)lds, lam, args.in[14]); } }
#endif
#ifndef NO_WIN
        for (int i = 0; i < per; ++i) { const int u = vcu * per + i; if (u < 768) { const int bk = u >> 4, qb = u & 15;
            att::win_unit(bk >> 1, bk & 1, qb, PROJ, OB, (LAS char*)lds, args.in[14], args.in[13]); } }
#endif
        if (BOTH(2)) GROUP_BAR();
    }

    if (IN(3)) {
        pg8::Gemm g{OB, W2, DM, 256}; pg8::StaticOrder S; S.init(NTOK / 256, DM / 256, G, bx);
        {
            LAS float* scr = (LAS float*)(lds + wave * 16384);
            const int gw = vcu * NWAVES + wave, NGW = G * NWAVES;
            constexpr int I3 = (DM / 64) * (2 * DFF / 32);
            for (int r = gw; r < I3; r += NGW) { const int nblk = 2 * DFF / 32, kb = r / nblk, nb = r % nblk, n0 = 32 * nb, pn = n0 >> 8, p = n0 & 255, bj = p >> 7, e0 = p & 127;
                quant_item(bj ? args.in[18] : args.in[17], DFF, 128 * pn + e0, DM, 64 * kb, (signed char*)(ws + WS_W3), n0, args.in[16], ctl + CW_WMAX + n0, scr, lane); }
            constexpr int I4 = (DFF / 64) * (DM / 32);
            for (int r = gw; r < I4; r += NGW) { const int nblk = DM / 32, kb = r / nblk, nb = r % nblk;
                quantf8_item(args.in[21], DM, 32 * nb, DFF, 64 * kb, (unsigned char*)(ws + WS_W4), 32 * nb, ctl + CW_WMAX4 + 32 * nb, scr, lane); }
            __syncthreads();
        }
        pg8::EpiOut E{(const signed char*)(ws + WS_XQ), (const float*)(ws + WS_X0S), (float*)(ws + WS_FX), (LAS float*)(lds + EPX_OFF), (signed char*)(ws + WS_X1Q), (float*)(ws + WS_FA), (float*)(ws + WS_XS), ctl + CW_P3CNT};
        pg8::gemm_phase<pg8::EpiOut, pg8::StaticOrder>(lds, g, S, E);
        if (BOTH(3)) GRID_BAR();
    }

    if (IN(4)) {
        signed char* W3Q = (signed char*)(ws + WS_W3); signed char* X1Q = (signed char*)(ws + WS_X1Q); float* FA = (float*)(ws + WS_FA);
        pg8::Gemm g{(const bf16_t*)(X1Q - DM), (const bf16_t*)W3Q, DM / 2, 254}; pg8::StaticOrder S; S.init(194, 2 * DFF / 256, G, bx);
        pg8::EpiFfn E{(unsigned char*)ACT, FA, (const float*)(ctl + CW_WMAX), args.in[19], args.in[20], (LAS float*)(lds + EPX_OFF)};
        pg8::gemm_phase<pg8::EpiFfn, pg8::StaticOrder, true, true, 1>(lds, g, S, E);
        if (BOTH(4)) GRID_BAR();
    }

    if (IN(5)) {
        pg8::Gemm g{ACT, W4, DFF / 2, 256}; pg8::StaticOrder S; S.init(NTOK / 256, DM / 256, G, bx, 1);
        pg8::EpiDown E{(const signed char*)(ws + WS_X1Q), (const float*)(ws + WS_FX), args.out, (const float*)(ctl + CW_WMAX4)};
        pg8::gemm_phase<pg8::EpiDown, pg8::StaticOrder, true, true, 2>(lds, g, S, E);
    }
#undef IN
#undef BOTH
#undef GRID_BAR
}

extern "C" void kernel_launch(void* const* d_in, const int* in_sizes, int n_in, void* d_out, int out_size, void* d_ws, size_t ws_size, hipStream_t stream) {
    static int grid = 0;
    if (grid == 0) {
        if (n_in != 22 || in_sizes[0] != TOK_P * DM || in_sizes[1] != (NTOK - TOK_P) * DM || out_size != NTOK * DM || ws_size < WS_END) {
            fprintf(stderr, "kernel_launch: shape mismatch (n_in %d, in0 %d, in1 %d, out %d, ws %zu; need ws >= %zu)\n", n_in, n_in > 0 ? in_sizes[0] : -1, n_in > 1 ? in_sizes[1] : -1, out_size, ws_size, (size_t)WS_END); grid = -1; return; }
        int dev = 0, cus = 0;
        if (hipGetDevice(&dev) != hipSuccess || hipDeviceGetAttribute(&cus, hipDeviceAttributeMultiprocessorCount, dev) != hipSuccess) { fprintf(stderr, "kernel_launch: device query failed\n"); grid = -1; return; }
        if (hipFuncSetAttribute((const void*)hymba_fwd, hipFuncAttributeMaxDynamicSharedMemorySize, LDS_BYTES) != hipSuccess) { fprintf(stderr, "kernel_launch: hipFuncSetAttribute failed\n"); grid = -1; return; }
        int per_cu = 0;
        if (hipOccupancyMaxActiveBlocksPerMultiprocessor(&per_cu, (const void*)hymba_fwd, NWAVES * 64, LDS_BYTES) != hipSuccess || per_cu < 1)
            fprintf(stderr, "kernel_launch: note: occupancy query reports %d workgroups per CU\n", per_cu);
        (void)hipGetLastError();
        if (cus < 256) { fprintf(stderr, "kernel_launch: %d CUs; this kernel's unit schedule (co-running tile owners in the out-projection epilogue) is built for 256\n", cus); grid = -1; return; }
        grid = 256;
    }
    if (grid < 0) return;
    (void)hipMemsetAsync((char*)d_ws + WS_CTL, 0, CTL_ZERO_BYTES, stream);
    Args a{};
    for (int i = 0; i < 22; ++i) a.in[i] = (const float*)d_in[i];
    a.out = (float*)d_out; a.ws = (unsigned char*)d_ws;
#ifndef PROBE_DUP
#define PROBE_DUP -1
#endif
    constexpr int NL = (PROBE_DUP >= 0) ? 3 : MK_N_LAUNCHES;
    for (int li = 0; li < NL; ++li) {
        if (PROBE_DUP >= 0) {
            a.ph_lo = li == 0 ? 0 : (li == 1 ? PROBE_DUP : PROBE_DUP + 1); a.ph_hi = li == 2 ? 6 : PROBE_DUP + 1; a.li = li;
        } else { a.ph_lo = (NL == 6) ? li : 0; a.ph_hi = (NL == 6) ? li + 1 : 6; a.li = (NL == 6) ? 0 : li; }
        hipLaunchKernelGGL(hymba_fwd, dim3(grid), dim3(NWAVES * 64), LDS_BYTES, stream, a);
        const hipError_t le = hipPeekAtLastError();
        if (le != hipSuccess) { fprintf(stderr, "kernel_launch: launch %d failed: %s\n", li, hipGetErrorName(le)); break; }
    }
}
```

```cpp
#include <hip/hip_runtime.h>
#include <hip/hip_bf16.h>
#include <cstdio>
#include <cstdint>

#ifndef MK_N_LAUNCHES
#define MK_N_LAUNCHES 1
#endif

#define LAS __attribute__((address_space(3)))
#define GAS __attribute__((address_space(1)))
typedef unsigned short bf16_t;
typedef short bf16x8 __attribute__((ext_vector_type(8)));
typedef short s16x4 __attribute__((ext_vector_type(4)));
typedef float f32x2 __attribute__((ext_vector_type(2)));
typedef float f32x4 __attribute__((ext_vector_type(4)));
typedef float f32x16 __attribute__((ext_vector_type(16)));
typedef unsigned u32x2 __attribute__((ext_vector_type(2)));
typedef unsigned u32x4 __attribute__((ext_vector_type(4)));
typedef __bf16 bf16x2_t __attribute__((ext_vector_type(2)));

constexpr int DM = 1024, SEQ = 2048, NSEQ = 24, NTOK = NSEQ * SEQ, TOK_P = 8 * SEQ;
constexpr int DIN = 2304, DFF = 2816;
constexpr int C_DQ = 0, C_DK = 512, C_DV = 1024, C_WQ = 1536, C_WK = 2048, C_WV = 2176;
constexpr int NBH = 12;
constexpr float EPS = 1e-6f, LOG2E = 1.4426950408889634f, QSCALE = 0.125f * LOG2E;
constexpr float LAM_INIT = 0.2f;
constexpr int NWAVES = 8;

__device__ __forceinline__ unsigned cvtpk(float lo, float hi) { f32x2 v = {lo, hi}; bf16x2_t b = __builtin_convertvector(v, bf16x2_t); return __builtin_bit_cast(unsigned, b); }
__device__ __forceinline__ u32x4 pack8(f32x4 a, f32x4 b) { u32x4 w; w.x = cvtpk(a[0], a[1]); w.y = cvtpk(a[2], a[3]); w.z = cvtpk(b[0], b[1]); w.w = cvtpk(b[2], b[3]); return w; }
__device__ __forceinline__ float dot4(f32x4 a) { return (a[0] * a[0] + a[1] * a[1]) + (a[2] * a[2] + a[3] * a[3]); }

__device__ __forceinline__ unsigned q4(float a, float b, float c, float d) {
    const unsigned ua = __float_as_uint(a + 12582912.0f), ub = __float_as_uint(b + 12582912.0f), uc = __float_as_uint(c + 12582912.0f), ud = __float_as_uint(d + 12582912.0f);
    return (ua & 0xffu) | ((ub & 0xffu) << 8) | ((uc & 0xffu) << 16) | (ud << 24);
}
__device__ __forceinline__ unsigned f8x4(float a, float b, float c, float d) {
    int w = 0;
    w = __builtin_amdgcn_cvt_pk_fp8_f32(__builtin_amdgcn_fmed3f(a, -448.f, 448.f), __builtin_amdgcn_fmed3f(b, -448.f, 448.f), w, false);
    w = __builtin_amdgcn_cvt_pk_fp8_f32(__builtin_amdgcn_fmed3f(c, -448.f, 448.f), __builtin_amdgcn_fmed3f(d, -448.f, 448.f), w, true);
    return (unsigned)w;
}
constexpr float ACT8_SCALE = 8.0f, W8_TOP = 224.0f;
namespace pg8 {
constexpr int BM = 256, BK = 64, HALF = 128, HTB = HALF * BK * 2, STAGE_BYTES = 8 * HTB, NXCD = 8, WGM = 8;
__host__ __device__ __forceinline__ int lds_byte(int r, int c) { const int st = (r >> 4) * 2 + (c >> 5), rr = r & 15, cc = c & 31, ob = rr * 64 + cc * 2; return st * 1024 + (ob ^ (((ob >> 9) & 1) << 5)); }
__host__ __device__ __forceinline__ void stage_rc(int b, int& R, int& C) { const int st = b / 1024, sb = b % 1024, swz = sb ^ (((sb >> 9) & 1) << 5); R = (st >> 1) * 16 + swz / 64; C = (st & 1) * 32 + (swz % 64) / 2; }
__host__ __device__ __forceinline__ int perm32(int rho) { const int n = rho >> 4, i = rho & 15; return 8 * (i >> 2) + 4 * n + (i & 3); }

typedef int v4i32_t __attribute__((ext_vector_type(4)));
struct Unit { int pm, pn; };
struct Gemm { const bf16_t* A; const bf16_t* Bt; int K; int arows; };

struct StaticOrder {
    int nM, nN, nwg, G, c, rev;
    __device__ void init(int nM_, int nN_, int G_, int c_, int rev_ = 0) { nM = nM_; nN = nN_; nwg = nM * nN; G = G_; c = c_; rev = rev_; }
    __device__ bool next(int i, Unit& u) const {
        const int nr = (nwg - c + G - 1) / G; if (i >= nr) return false;
        const long L = (long)(rev ? nr - 1 - i : i) * G + c;
        int wgid = (int)L; { const int q = nwg / NXCD, r = nwg % NXCD, xcd = wgid % NXCD, off = wgid / NXCD; wgid = (xcd < r ? xcd * (q + 1) : r * (q + 1) + (xcd - r) * q) + off; }
        const int nig = WGM * nN, gid = wgid / nig, fm = gid * WGM, gsz = (nM - fm) < WGM ? (nM - fm) : WGM;
        u.pm = fm + ((wgid % nig) % gsz); u.pn = (wgid % nig) / gsz; return true;
    }
};


struct EpiProj {
    static constexpr bool PERM = true;
    bf16_t* P; const LAS float* gl; const float* fx; const float* swm;
    __device__ __forceinline__ void pre(const Unit& u, int wid, int lane_) const {
        int lane = lane_; asm volatile("" : "+v"(lane));
        if (wid >= 4) __builtin_amdgcn_global_load_lds((const unsigned*)(fx + u.pm * BM + 64 * (wid - 4) + lane), (LAS unsigned*)((LAS char*)gl + 1024 + (wid - 4) * 256), 4, 0, 0);
        if (wid == 2) __builtin_amdgcn_global_load_lds((const unsigned*)(swm + u.pn * 256 + lane * 4), (LAS unsigned*)((LAS char*)gl + 2048), 16, 0, 0);
    }
    __device__ __forceinline__ void operator()(const f32x4 (&acc)[2][2][4][2], const Unit& u, int wr, int wc, int fr, int fq, int lane) const {
        int fql = fq; asm volatile("" : "+v"(fql));
        f32x4 csw[2][2];
#pragma unroll
        for (int bj = 0; bj < 2; ++bj)
#pragma unroll
            for (int n = 0; n < 2; ++n) csw[bj][n] = *(const LAS f32x4*)(gl + 512 + 128 * bj + 32 * wc + 8 * fql + 4 * n) * (1.0f / 127.0f);
        const int gidx = u.pn * 4 + wc;
        int gsel = -1; float sc = 1.f;
        if (gidx < 8) { gsel = 0; sc = QSCALE; } else if (gidx < 16) { gsel = 1; } else if (gidx < 24) { } else if (gidx < 32) { gsel = 2; sc = QSCALE; } else if (gidx < 34) { gsel = 3; }
        const bool nrm = gsel >= 0; const LAS float* gain = gl + (nrm ? gsel : 0) * 64;
        f32x4 gv[2][2];
#pragma unroll
        for (int bj = 0; bj < 2; ++bj)
#pragma unroll
            for (int n = 0; n < 2; ++n) gv[bj][n] = nrm ? *(const LAS f32x4*)(gain + 32 * bj + 8 * fq + 4 * n) * sc : (f32x4){1.f, 1.f, 1.f, 1.f};
        bf16_t* base = P + (size_t)(u.pm * BM + wr * 64 + fr) * DIN + gidx * 64 + 8 * fq;
#pragma unroll
        for (int ai = 0; ai < 2; ++ai)
#pragma unroll
            for (int m = 0; m < 4; ++m) {
                const float fxr = gl[256 + ai * HALF + wr * 64 + m * 16 + fr];
                f32x4 v00 = __builtin_convertvector(__builtin_bit_cast(v4i32_t, acc[ai][0][m][0]), f32x4) * (csw[0][0] * fxr), v01 = __builtin_convertvector(__builtin_bit_cast(v4i32_t, acc[ai][0][m][1]), f32x4) * (csw[0][1] * fxr);
                f32x4 v10 = __builtin_convertvector(__builtin_bit_cast(v4i32_t, acc[ai][1][m][0]), f32x4) * (csw[1][0] * fxr), v11 = __builtin_convertvector(__builtin_bit_cast(v4i32_t, acc[ai][1][m][1]), f32x4) * (csw[1][1] * fxr);
                float rn = 1.f;
                if (nrm) { float ss = (dot4(v00) + dot4(v01)) + (dot4(v10) + dot4(v11)); ss += __shfl_xor(ss, 16); ss += __shfl_xor(ss, 32); rn = __builtin_amdgcn_rsqf(ss * (1.0f / 64.0f) + EPS); }
                v00 = v00 * rn * gv[0][0]; v01 = v01 * rn * gv[0][1]; v10 = v10 * rn * gv[1][0]; v11 = v11 * rn * gv[1][1];
                bf16_t* rowp = base + (size_t)(ai * HALF + m * 16) * DIN;
                const u32x4 pa = pack8(v00, v01), pb = pack8(v10, v11);
                u32x4 px; px.x = (unsigned)__builtin_amdgcn_mov_dpp((int)pb.x, 0x128, 0xf, 0xf, true); px.y = (unsigned)__builtin_amdgcn_mov_dpp((int)pb.y, 0x128, 0xf, 0xf, true);
                px.z = (unsigned)__builtin_amdgcn_mov_dpp((int)pb.z, 0x128, 0xf, 0xf, true); px.w = (unsigned)__builtin_amdgcn_mov_dpp((int)pb.w, 0x128, 0xf, 0xf, true);
                const bool hi8 = (fr & 8) != 0;
                bf16_t* r1p = base + (size_t)(ai * HALF + m * 16 - (hi8 ? 8 : 0)) * DIN + (hi8 ? 32 : 0);
                bf16_t* r2p = base + (size_t)(ai * HALF + m * 16 + (hi8 ? 0 : 8)) * DIN + (hi8 ? 0 : 32);
                *(u32x4*)(r1p) = hi8 ? px : pa; *(u32x4*)(r2p) = hi8 ? pa : px;
            }
    }
};

struct EpiOut {
    static constexpr bool PERM = true;
    const signed char* xq0; const float* __restrict__ sx0; float* __restrict__ sx1; LAS float* xl;
    signed char* x1q; float* fa; float* xs; unsigned* cnt;
    __device__ __forceinline__ void pre(const Unit&, int, int) const {}
    __device__ __forceinline__ void operator()(f32x4 (&acc)[2][2][4][2], const Unit& u, int wr, int wc, int fr, int fq, int lane) const {
        asm volatile("" : "+v"(fr), "+v"(fq));
        const int rowbase = u.pm * BM;
        const int col0 = u.pn * BM + wc * 64 + 8 * fq;
#pragma unroll
        for (int ai = 0; ai < 2; ++ai) {
            u32x2 xv[4][2]; float s0[4];
#pragma unroll
            for (int m = 0; m < 4; ++m) { const size_t row = (size_t)(rowbase + ai * HALF + wr * 64 + m * 16 + fr); const signed char* xr = xq0 + row * DM + col0;
                s0[m] = sx0[row];
#pragma unroll
                for (int bj = 0; bj < 2; ++bj) xv[m][bj] = *(const u32x2*)(xr + bj * 32); }
#pragma unroll
            for (int m = 0; m < 4; ++m) {
                const int rl = ai * HALF + wr * 64 + m * 16 + fr; float s = 0.f, am = 0.f;
#pragma unroll
                for (int bj = 0; bj < 2; ++bj) {
                    const int wx = (int)xv[m][bj].x, wy = (int)xv[m][bj].y; f32x4 x0, x1;
                    x0[0] = (float)((wx << 24) >> 24); x0[1] = (float)((wx << 16) >> 24); x0[2] = (float)((wx << 8) >> 24); x0[3] = (float)(wx >> 24);
                    x1[0] = (float)((wy << 24) >> 24); x1[1] = (float)((wy << 16) >> 24); x1[2] = (float)((wy << 8) >> 24); x1[3] = (float)(wy >> 24);
                    const f32x4 o0 = x0 * s0[m] + acc[ai][bj][m][0], o1 = x1 * s0[m] + acc[ai][bj][m][1];
                    acc[ai][bj][m][0] = o0; acc[ai][bj][m][1] = o1;
#pragma unroll
                    for (int i = 0; i < 4; ++i) am = __builtin_fmaxf(am, __builtin_fmaxf(__builtin_fabsf(o0[i]), __builtin_fabsf(o1[i])));
                    s += dot4(o0) + dot4(o1); }
                s += __shfl_xor(s, 16); s += __shfl_xor(s, 32);
                am = __builtin_fmaxf(am, __shfl_xor(am, 16)); am = __builtin_fmaxf(am, __shfl_xor(am, 32));
                if (fq == 0) { xl[rl * 8 + wc] = s; xl[rl * 8 + 4 + wc] = am; }
            }
        }
        asm volatile("s_waitcnt lgkmcnt(0)" ::: "memory"); __builtin_amdgcn_s_barrier(); asm volatile("" ::: "memory");
        const int t = (wr * 4 + wc) * 64 + lane;
        if (t < 256) {
            const f32x4 q = *(const LAS f32x4*)(xl + t * 8), a4 = *(const LAS f32x4*)(xl + t * 8 + 4);
            float* sl = xs + ((size_t)(rowbase + t) * 4 + u.pn) * 2;
            __hip_atomic_store(sl, (q[0] + q[1]) + (q[2] + q[3]), __ATOMIC_RELAXED, __HIP_MEMORY_SCOPE_AGENT);
            __hip_atomic_store(sl + 1, __builtin_fmaxf(__builtin_fmaxf(a4[0], a4[1]), __builtin_fmaxf(a4[2], a4[3])), __ATOMIC_RELAXED, __HIP_MEMORY_SCOPE_AGENT);
            asm volatile("s_waitcnt vmcnt(0)" ::: "memory");
            if (lane == 0) (void)__hip_atomic_fetch_add(cnt + u.pm, 1u, __ATOMIC_RELAXED, __HIP_MEMORY_SCOPE_AGENT);
        }
        if (t < 64) {
            unsigned sp = 0; while (__builtin_amdgcn_readfirstlane(__hip_atomic_load(cnt + u.pm, __ATOMIC_RELAXED, __HIP_MEMORY_SCOPE_AGENT)) < 16u) { __builtin_amdgcn_s_sleep(1); if (++sp > (1u << 22)) break; }
        }
        asm volatile("s_waitcnt lgkmcnt(0)" ::: "memory"); __builtin_amdgcn_s_barrier(); asm volatile("" ::: "memory");
        if (t < 256) {
            const float* sl = xs + (size_t)(rowbase + t) * 8; float ss = 0.f, am = 0.f;
#pragma unroll
            for (int j = 0; j < 4; ++j) { ss += __hip_atomic_load(sl + 2 * j, __ATOMIC_RELAXED, __HIP_MEMORY_SCOPE_AGENT); am = __builtin_fmaxf(am, __hip_atomic_load(sl + 2 * j + 1, __ATOMIC_RELAXED, __HIP_MEMORY_SCOPE_AGENT)); }
            xl[2048 + t] = am > 0.f ? 127.0f / am : 0.f;
            if (u.pn == 0) { fa[rowbase + t] = __builtin_amdgcn_rsqf(ss * (1.0f / DM) + EPS) * am * (1.0f / 127.0f); sx1[rowbase + t] = am * (1.0f / 127.0f); }
        }
        asm volatile("s_waitcnt lgkmcnt(0)" ::: "memory"); __builtin_amdgcn_s_barrier(); asm volatile("" ::: "memory");
#pragma unroll
        for (int ai = 0; ai < 2; ++ai)
#pragma unroll
            for (int m = 0; m < 4; ++m) { const int rl = ai * HALF + wr * 64 + m * 16 + fr; const float inv = xl[2048 + rl];
                signed char* qp = x1q + (size_t)(rowbase + rl) * DM + col0;
#pragma unroll
                for (int bj = 0; bj < 2; ++bj) { const f32x4 b0 = acc[ai][bj][m][0] * inv, b1 = acc[ai][bj][m][1] * inv;
                    u32x2 o; o.x = q4(b0[0], b0[1], b0[2], b0[3]); o.y = q4(b1[0], b1[1], b1[2], b1[3]);
                    *(u32x2*)(qp + 32 * bj) = o; } }
    }
};

__device__ __forceinline__ float dpp8(float x) { return __builtin_bit_cast(float, __builtin_amdgcn_mov_dpp(__builtin_bit_cast(int, x), 0x128, 0xf, 0xf, true)); }
struct EpiDown {
    static constexpr bool PERM = true;
    const signed char* __restrict__ x1q; const float* __restrict__ sx1; float* __restrict__ out; const float* __restrict__ wmx;
    __device__ __forceinline__ void pre(const Unit&, int, int) const {}
    __device__ __forceinline__ void operator()(const f32x4 (&acc)[2][2][4][2], const Unit& u, int wr, int wc, int fr, int fq, int lane) const {
        asm volatile("" : "+v"(fr), "+v"(fq));
        const int col0 = u.pn * BM + wc * 32 + 8 * fq; const bool hi8 = (fr & 8) != 0;
        f32x4 cs[2][2];
#pragma unroll
        for (int bj = 0; bj < 2; ++bj)
#pragma unroll
            for (int n = 0; n < 2; ++n) cs[bj][n] = *(const f32x4*)(wmx + col0 + bj * HALF + 4 * n) * (1.0f / (W8_TOP * ACT8_SCALE));
#pragma unroll
        for (int ai = 0; ai < 2; ++ai) {
            u32x2 w[4][2]; float sx[4];
#pragma unroll
            for (int m = 0; m < 4; ++m) { const size_t row = (size_t)(u.pm * BM + ai * HALF + wr * 64 + m * 16 + fr); const size_t off = row * DM + col0;
                sx[m] = sx1[row];
#pragma unroll
                for (int bj = 0; bj < 2; ++bj) w[m][bj] = *(const u32x2*)(x1q + off + bj * HALF); }
#pragma unroll
            for (int m = 0; m < 4; ++m) { const size_t off = (size_t)(u.pm * BM + ai * HALF + wr * 64 + m * 16 + fr) * DM + col0;
#pragma unroll
                for (int bj = 0; bj < 2; ++bj) { const int wx = (int)w[m][bj].x, wy = (int)w[m][bj].y;
                    f32x4 r0, r1;
                    r0[0] = (float)((wx << 24) >> 24) * sx[m]; r0[1] = (float)((wx << 16) >> 24) * sx[m]; r0[2] = (float)((wx << 8) >> 24) * sx[m]; r0[3] = (float)(wx >> 24) * sx[m];
                    r1[0] = (float)((wy << 24) >> 24) * sx[m]; r1[1] = (float)((wy << 16) >> 24) * sx[m]; r1[2] = (float)((wy << 8) >> 24) * sx[m]; r1[3] = (float)(wy >> 24) * sx[m];
                    const f32x4 q0 = r0 + acc[ai][bj][m][0] * cs[bj][0], q1 = r1 + acc[ai][bj][m][1] * cs[bj][1];
                    f32x4 qx; qx[0] = dpp8(q1[0]); qx[1] = dpp8(q1[1]); qx[2] = dpp8(q1[2]); qx[3] = dpp8(q1[3]);
                    const long d1 = hi8 ? (long)(4 - 8 * DM) : 0, d2 = hi8 ? 0 : (long)(4 + 8 * DM);
                    *(f32x4*)(out + off + bj * HALF + d1) = hi8 ? qx : q0; *(f32x4*)(out + off + bj * HALF + d2) = hi8 ? q0 : qx; } } }
    }
};

template <int CTRL> __device__ __forceinline__ float dppz(float x) { return __builtin_bit_cast(float, __builtin_amdgcn_update_dpp(0, __builtin_bit_cast(int, x), CTRL, 0xf, 0xf, true)); }
struct EpiFfn {
    static constexpr bool PERM = true;
    unsigned char* act; const float* fa; const float* swm; const float* cw; const float* cb; LAS float* xl;
    __device__ __forceinline__ void pre(const Unit& u, int wid, int lane_) const {
        int lane = lane_; asm volatile("" : "+v"(lane));
        const int tok0 = 254 * u.pm - 1;
        if (wid >= 4) { int tok = tok0 + 64 * (wid - 4) + lane; tok = tok < 0 ? 0 : (tok > NTOK - 1 ? NTOK - 1 : tok);
            __builtin_amdgcn_global_load_lds((const unsigned*)(fa + tok), (LAS unsigned*)((LAS char*)xl + 4096 + (wid - 4) * 256), 4, 0, 0); }
        if (wid == 2) __builtin_amdgcn_global_load_lds((const unsigned*)(swm + u.pn * 256 + lane * 4), (LAS unsigned*)((LAS char*)xl + 5120), 16, 0, 0);
        if (wid < 2) { const float* src = (wid == 0 ? (lane < 32 ? cw : cw + DFF) : (lane < 32 ? cw + 2 * DFF : cb)) + u.pn * 128 + (lane & 31) * 4;
            __builtin_amdgcn_global_load_lds((const unsigned*)src, (LAS unsigned*)((LAS char*)xl + 20480 + wid * 1024), 16, 0, 0); }
    }
    template <int AI, int M, bool MASK>
    __device__ __forceinline__ void conv_rows(const f32x4 (&acc)[2][2][4][2], const f32x4 (&w0)[2], const f32x4 (&w1)[2], const f32x4 (&w2)[2], const f32x4 (&bb)[2],
                                              int tok, int rl, int G, int xc, int fr, int ch0) const {
        const bool pcut = MASK && (tok & (SEQ - 1)) == 0, ncut = MASK && (tok & (SEQ - 1)) == SEQ - 1;
        f32x4 r0, r1;
#pragma unroll
        for (int n = 0; n < 2; ++n) { f32x4 res;
            f32x4 ex = (f32x4){0.f, 0.f, 0.f, 0.f};
            if (M == 0) { if (G > 0) ex = *(const LAS f32x4*)(xl + (2 * (G - 1) + 1) * 128 + xc + 4 * n); ex = fr == 0 ? ex : (f32x4){0.f, 0.f, 0.f, 0.f}; }
            if (M == 3) { if (G < 3) ex = *(const LAS f32x4*)(xl + (2 * (G + 1)) * 128 + xc + 4 * n); ex = fr == 15 ? ex : (f32x4){0.f, 0.f, 0.f, 0.f}; }
#pragma unroll
            for (int i = 0; i < 4; ++i) {
                const float own = acc[AI][0][M][n][i];
                float pr = dppz<0x111>(own);
                pr += (M > 0) ? dppz<0x10F>(acc[AI][0][M > 0 ? M - 1 : 0][n][i]) : ex[i];
                float nx = dppz<0x101>(own);
                nx += (M < 3) ? dppz<0x11F>(acc[AI][0][M < 3 ? M + 1 : 3][n][i]) : ex[i];
                if (MASK) { pr = pcut ? 0.f : pr; nx = ncut ? 0.f : nx; }
                const float uc = fmaf(w0[n][i], pr, fmaf(w1[n][i], own, fmaf(w2[n][i], nx, bb[n][i])));
                const float sg = uc * __builtin_amdgcn_rcpf(1.0f + __builtin_amdgcn_exp2f(-LOG2E * uc));
                res[i] = sg * acc[AI][1][M][n][i] * ACT8_SCALE;
            }
            if (n == 0) r0 = res; else r1 = res; }
        if (rl != 0 && rl != 255 && tok < NTOK) { u32x2 o; o.x = f8x4(r0[0], r0[1], r0[2], r0[3]); o.y = f8x4(r1[0], r1[1], r1[2], r1[3]); *(u32x2*)(act + (size_t)tok * DFF + ch0) = o; }
    }
    __device__ __forceinline__ void operator()(f32x4 (&acc)[2][2][4][2], const Unit& u, int wr, int wc, int fr, int fq, int lane) const {
        const int ch0 = u.pn * 128 + wc * 32 + 8 * fq;
        const int tok0 = 254 * u.pm - 1;
        int fql = fq; asm volatile("" : "+v"(fql));
        const int xc = wc * 32 + 8 * fql;
        f32x4 su[2];
#pragma unroll
        for (int n = 0; n < 2; ++n) su[n] = *(const LAS f32x4*)(xl + 1280 + 128 + xc + 4 * n) * (1.0f / 127.0f);
#pragma unroll
        for (int ai = 0; ai < 2; ++ai)
#pragma unroll
            for (int m = 0; m < 4; ++m) { const float rs = xl[1024 + ai * HALF + wr * 64 + m * 16 + fr];
#pragma unroll
                for (int n = 0; n < 2; ++n) { const f32x4 rsu = su[n] * rs;
                    acc[ai][0][m][n] = __builtin_convertvector(__builtin_bit_cast(v4i32_t, acc[ai][0][m][n]), f32x4) * rs;
                    acc[ai][1][m][n] = __builtin_convertvector(__builtin_bit_cast(v4i32_t, acc[ai][1][m][n]), f32x4) * rsu; } }
#pragma unroll
        for (int ai = 0; ai < 2; ++ai) { const int G = 2 * ai + wr;
            if (fr == 0) { *(LAS f32x4*)(xl + (2 * G) * 128 + xc) = acc[ai][0][0][0]; *(LAS f32x4*)(xl + (2 * G) * 128 + xc + 4) = acc[ai][0][0][1]; }
            if (fr == 15) { *(LAS f32x4*)(xl + (2 * G + 1) * 128 + xc) = acc[ai][0][3][0]; *(LAS f32x4*)(xl + (2 * G + 1) * 128 + xc + 4) = acc[ai][0][3][1]; } }
        asm volatile("s_waitcnt lgkmcnt(0)" ::: "memory"); __builtin_amdgcn_s_barrier(); asm volatile("" ::: "memory"); __builtin_amdgcn_sched_barrier(0);
        f32x4 w0[2], w1[2], w2[2], bb[2];
#pragma unroll
        for (int n = 0; n < 2; ++n) { const LAS float* wl = xl + 5120 + xc + 4 * n; const f32x4 sgc = *(const LAS f32x4*)(xl + 1280 + xc + 4 * n) * (1.0f / 127.0f);
            w0[n] = *(const LAS f32x4*)(wl) * sgc; w1[n] = *(const LAS f32x4*)(wl + 128) * sgc; w2[n] = *(const LAS f32x4*)(wl + 256) * sgc; bb[n] = *(const LAS f32x4*)(wl + 384); }
#define FFN_ROWS(AI, M) do { const int tb_ = tok0 + AI * HALF + wr * 64 + M * 16; const int G_ = 2 * AI + wr; \
        conv_rows<AI, M, true>(acc, w0, w1, w2, bb, tb_ + fr, AI * HALF + wr * 64 + M * 16 + fr, G_, xc, fr, ch0); \
        if ((M) & 1) __builtin_amdgcn_sched_barrier(0); } while (0)
        FFN_ROWS(0, 0); FFN_ROWS(0, 1); FFN_ROWS(0, 2); FFN_ROWS(0, 3); FFN_ROWS(1, 0); FFN_ROWS(1, 1); FFN_ROWS(1, 2); FFN_ROWS(1, 3);
#undef FFN_ROWS
    }
};

typedef int v8i32_t __attribute__((ext_vector_type(8)));
template <class Epi, class Sched, bool ALIGN_EPI = true, bool SP2 = true, int QM = 0>
__device__ __forceinline__ void gemm_phase(LAS unsigned char* lds, const Gemm g, const Sched& S, const Epi& E) {
    const int tid = threadIdx.x, wid = __builtin_amdgcn_readfirstlane(tid >> 6), lane = tid & 63, wr = wid >> 2, wc = wid & 3, fr = lane & 15, fq = lane >> 4;
    const int K = g.K, nt = K / BK;
    unsigned voffA[2], voffB[2];
#pragma unroll
    for (int i = 0; i < 2; ++i) { int R, C; stage_rc(tid * 16 + i * 8192, R, C); const int Rb = Epi::PERM ? ((R & ~31) + perm32(R & 31)) : R;
        voffA[i] = (unsigned)(R * K + C) * 2u; voffB[i] = (unsigned)(Rb * K + C) * 2u; }
    const size_t kstep = (size_t)(BK * 2);
    const size_t hstep = (size_t)HALF * K * 2;
    const size_t tstepB = 2 * hstep;
    const size_t tstepA = (size_t)g.arows * K * 2;
    const unsigned ldsw = (unsigned)wid * 1024u;
    const int aoff = lds_byte(wr * 64 + fr, fq * 8), boff = lds_byte(wc * 32 + fr, fq * 8);
#define PG8_SA(b, h) (((b) * 2 + (h)) * HTB)
#define PG8_SB(b, h) ((4 + (b) * 2 + (h)) * HTB)
#define PG8_STAGE(bufoff, gbase, voff) do { _Pragma("unroll") for (int _i = 0; _i < 2; ++_i) \
        __builtin_amdgcn_global_load_lds((const unsigned*)((const char*)(gbase) + (voff)[_i]), (LAS unsigned*)(lds + (bufoff) + ldsw + _i * 8192), 16, 0, 0); } while (0)
#define PG8_LDA(dst, b, h) do { _Pragma("unroll") for (int m = 0; m < 4; ++m) _Pragma("unroll") for (int k = 0; k < 2; ++k) dst[m][k] = *(const LAS bf16x8*)(lds + PG8_SA(b, h) + aoff + m * 2048 + k * 1024); } while (0)
#define PG8_LDB(dst, b, h) do { _Pragma("unroll") for (int n = 0; n < 2; ++n) _Pragma("unroll") for (int k = 0; k < 2; ++k) dst[n][k] = *(const LAS bf16x8*)(lds + PG8_SB(b, h) + boff + n * 2048 + k * 1024); } while (0)
#define PG8_MMA(ai, bj, At, Bt) do { __builtin_amdgcn_s_setprio(1); \
    if constexpr (QM == 2) { _Pragma("unroll") for (int m = 0; m < 4; ++m) _Pragma("unroll") for (int n = 0; n < 2; ++n) { \
        const v8i32_t b8_ = __builtin_shufflevector(__builtin_bit_cast(v4i32_t, Bt[n][0]), __builtin_bit_cast(v4i32_t, Bt[n][1]), 0, 1, 2, 3, 4, 5, 6, 7), a8_ = __builtin_shufflevector(__builtin_bit_cast(v4i32_t, At[m][0]), __builtin_bit_cast(v4i32_t, At[m][1]), 0, 1, 2, 3, 4, 5, 6, 7); \
        asm volatile("v_mfma_scale_f32_16x16x128_f8f6f4 %0, %1, %2, %0, %3, %3 op_sel_hi:[0,0,0]" : "+v"(acc[ai][bj][m][n]) : "v"(b8_), "v"(a8_), "v"(one8)); } } \
    else _Pragma("unroll") for (int m = 0; m < 4; ++m) _Pragma("unroll") for (int n = 0; n < 2; ++n) _Pragma("unroll") for (int k = 0; k < 2; ++k) \
        { if constexpr (QM == 1) acc[ai][bj][m][n] = __builtin_bit_cast(f32x4, __builtin_amdgcn_mfma_i32_16x16x64_i8(__builtin_bit_cast(v4i32_t, Bt[n][k]), __builtin_bit_cast(v4i32_t, At[m][k]), __builtin_bit_cast(v4i32_t, acc[ai][bj][m][n]), 0, 0, 0)); \
          else acc[ai][bj][m][n] = __builtin_amdgcn_mfma_f32_16x16x32_bf16(Bt[n][k], At[m][k], acc[ai][bj][m][n], 0, 0, 0); } __builtin_amdgcn_s_setprio(0); } while (0)
#define PG8_WAIT_V(n) asm volatile("s_waitcnt vmcnt(" #n ")" ::: "memory")
#define PG8_WAIT_L(n) asm volatile("s_waitcnt lgkmcnt(" #n ")" ::: "memory")
#define PG8_BAR __builtin_amdgcn_s_barrier()
#define PG8_SCHED __builtin_amdgcn_sched_barrier(0)
    Unit cur, nxt; int ui = 0;
    if (!S.next(0, cur)) return;
    const int one8 = 0x7f7f7f7f;
    f32x4 acc[2][2][4][2];
#pragma unroll
    for (int a = 0; a < 2; ++a)
#pragma unroll
        for (int b = 0; b < 2; ++b)
#pragma unroll
            for (int m = 0; m < 4; ++m)
#pragma unroll
                for (int n = 0; n < 2; ++n) acc[a][b][m][n] = (f32x4){0.f, 0.f, 0.f, 0.f};
    bf16x8 At[4][2], B0[2][2], B1[2][2];
    const char* cA = (const char*)g.A + (size_t)cur.pm * tstepA; const char* cB = (const char*)g.Bt + (size_t)cur.pn * tstepB;
    if constexpr (SP2) {
        PG8_STAGE(PG8_SB(0, 0), cB, voffB); PG8_STAGE(PG8_SB(0, 1), cB + hstep, voffB); PG8_STAGE(PG8_SA(0, 0), cA, voffA); PG8_STAGE(PG8_SA(0, 1), cA + hstep, voffA);
        if (wr == 1) PG8_BAR;
        PG8_WAIT_V(2); PG8_BAR;
        PG8_STAGE(PG8_SB(1, 0), cB + kstep, voffB); PG8_STAGE(PG8_SA(1, 0), cA + kstep, voffA); PG8_STAGE(PG8_SB(1, 1), cB + hstep + kstep, voffB);
        PG8_WAIT_V(6); PG8_BAR;
    } else {
        PG8_STAGE(PG8_SB(0, 0), cB, voffB); PG8_STAGE(PG8_SA(0, 0), cA, voffA); PG8_STAGE(PG8_SB(0, 1), cB + hstep, voffB); PG8_STAGE(PG8_SA(0, 1), cA + hstep, voffA);
        if (wr == 1) PG8_BAR;
        PG8_WAIT_V(4); PG8_BAR;
        PG8_STAGE(PG8_SB(1, 0), cB + kstep, voffB); PG8_STAGE(PG8_SA(1, 0), cA + kstep, voffA); PG8_STAGE(PG8_SB(1, 1), cB + hstep + kstep, voffB);
        PG8_WAIT_V(6); PG8_BAR;
    }
    for (;;) {
        const bool has_next = S.next(ui + 1, nxt);
        const char* nA = has_next ? (const char*)g.A + (size_t)nxt.pm * tstepA : cA; const char* nB = has_next ? (const char*)g.Bt + (size_t)nxt.pn * tstepB : cB;
        for (int t = 0; t < nt; t += 2) {
            const bool last = (t == nt - 2);
            const char* a1 = cA + (size_t)(t + 1) * kstep;
            const char* a2 = last ? nA : cA + (size_t)(t + 2) * kstep; const char* b2 = last ? nB : cB + (size_t)(t + 2) * kstep;
            const char* a3 = a2 + kstep; const char* b3 = b2 + kstep;
            if (last) E.pre(cur, wid, lane);
            if constexpr (SP2) {
            PG8_LDB(B0, 0, 0); PG8_LDB(B1, 0, 1); PG8_SCHED; PG8_LDA(At, 0, 0); PG8_STAGE(PG8_SA(1, 1), a1 + hstep, voffA);
            PG8_WAIT_V(8); PG8_WAIT_L(0); PG8_BAR; PG8_MMA(0, 0, At, B0); PG8_MMA(0, 1, At, B1); PG8_BAR; PG8_SCHED;
            PG8_LDA(At, 0, 1); PG8_STAGE(PG8_SB(0, 0), b2, voffB); PG8_STAGE(PG8_SB(0, 1), b2 + hstep, voffB); PG8_STAGE(PG8_SA(0, 0), a2, voffA);
            PG8_WAIT_V(8); PG8_WAIT_L(0); PG8_BAR; PG8_MMA(1, 0, At, B0); PG8_MMA(1, 1, At, B1); PG8_BAR; PG8_SCHED;
            PG8_LDB(B0, 1, 0); PG8_LDB(B1, 1, 1); PG8_SCHED; PG8_LDA(At, 1, 0); PG8_STAGE(PG8_SA(0, 1), a2 + hstep, voffA);
            PG8_WAIT_V(8); PG8_WAIT_L(0); PG8_BAR; PG8_MMA(0, 0, At, B0); PG8_MMA(0, 1, At, B1); PG8_BAR; PG8_SCHED;
            PG8_LDA(At, 1, 1); PG8_STAGE(PG8_SB(1, 0), b3, voffB); PG8_STAGE(PG8_SB(1, 1), b3 + hstep, voffB); PG8_STAGE(PG8_SA(1, 0), a3, voffA);
            PG8_WAIT_V(8); PG8_WAIT_L(0); PG8_BAR; PG8_MMA(1, 0, At, B0); PG8_MMA(1, 1, At, B1); PG8_BAR; PG8_SCHED;
            } else {
            PG8_LDB(B0, 0, 0); PG8_SCHED; PG8_LDA(At, 0, 0); PG8_STAGE(PG8_SA(1, 1), a1 + hstep, voffA);
            PG8_WAIT_L(8); PG8_BAR; PG8_WAIT_L(0); PG8_MMA(0, 0, At, B0); PG8_BAR; PG8_SCHED;
            PG8_LDB(B1, 0, 1); PG8_STAGE(PG8_SB(0, 0), b2, voffB);
            PG8_BAR; PG8_WAIT_L(0); PG8_MMA(0, 1, At, B1); PG8_BAR;
            PG8_LDA(At, 0, 1); PG8_STAGE(PG8_SA(0, 0), a2, voffA);
            PG8_BAR; PG8_WAIT_L(0); PG8_MMA(1, 0, At, B0); PG8_BAR; PG8_SCHED;
            PG8_STAGE(PG8_SB(0, 1), b2 + hstep, voffB);
            PG8_WAIT_V(6); PG8_BAR; PG8_MMA(1, 1, At, B1); PG8_BAR;
            PG8_LDB(B0, 1, 0); PG8_SCHED; PG8_LDA(At, 1, 0); PG8_STAGE(PG8_SA(0, 1), a2 + hstep, voffA);
            PG8_WAIT_L(8); PG8_BAR; PG8_WAIT_L(0); PG8_MMA(0, 0, At, B0); PG8_BAR; PG8_SCHED;
            PG8_LDB(B1, 1, 1); PG8_STAGE(PG8_SB(1, 0), b3, voffB);
            PG8_BAR; PG8_WAIT_L(0); PG8_MMA(0, 1, At, B1); PG8_BAR;
            PG8_LDA(At, 1, 1); PG8_STAGE(PG8_SA(1, 0), a3, voffA);
            PG8_BAR; PG8_WAIT_L(0); PG8_MMA(1, 0, At, B0); PG8_BAR; PG8_SCHED;
            PG8_STAGE(PG8_SB(1, 1), b3 + hstep, voffB);
            PG8_WAIT_V(6); PG8_BAR; PG8_MMA(1, 1, At, B1); PG8_BAR;
            }
        }
        if constexpr (ALIGN_EPI) { if (wr == 0) PG8_BAR; }
        E(acc, cur, wr, wc, fr, fq, lane);
        if (!has_next) break;
#pragma unroll
        for (int a = 0; a < 2; ++a)
#pragma unroll
            for (int b = 0; b < 2; ++b)
#pragma unroll
                for (int m = 0; m < 4; ++m)
#pragma unroll
                    for (int n = 0; n < 2; ++n) acc[a][b][m][n] = (f32x4){0.f, 0.f, 0.f, 0.f};
        cur = nxt; cA = nA; cB = nB; ++ui;
        if constexpr (ALIGN_EPI) { if (wr == 1) PG8_BAR; }
    }
    PG8_WAIT_V(0);
    if constexpr (!ALIGN_EPI) { if (wr == 0) PG8_BAR; }
    PG8_BAR;
#undef PG8_SA
#undef PG8_SB
#undef PG8_STAGE
#undef PG8_LDA
#undef PG8_LDB
#undef PG8_MMA
#undef PG8_WAIT_V
#undef PG8_WAIT_L
#undef PG8_BAR
#undef PG8_SCHED
}
}

namespace att {
constexpr int PITCH = DIN;
#define SBAR() __builtin_amdgcn_sched_barrier(0)
#define KSW(row, colB) ((row) * 128 + ((colB) ^ ((((row) >> 1) & 7) << 4)))
__device__ __forceinline__ int crow(int r, int hi) { return (r & 3) + 8 * (r >> 2) + 4 * hi; }
__device__ __forceinline__ int rel_bucket(int rel) {
    const int n = rel < 0 ? -rel : rel; int v;
    if (n < 8) v = n; else { v = 2 + (31 - __clz(n * n)); v = v > 15 ? 15 : v; }
    return (rel > 0 ? 16 : 0) + v;
}
constexpr float THR = 5.0f;

__device__ __forceinline__ void partialSM(f32x16& p0, f32x16& p1, float off, float& m_reg, float& alpha) {
    float pmax = p0[0];
#pragma unroll
    for (int r = 1; r < 16; ++r) pmax = fmaxf(pmax, p0[r]);
#pragma unroll
    for (int r = 0; r < 16; ++r) pmax = fmaxf(pmax, p1[r]);
    { auto rr = __builtin_amdgcn_permlane32_swap(__float_as_uint(pmax), __float_as_uint(pmax), false, false);
      pmax = fmaxf(__uint_as_float(rr[0]), __uint_as_float(rr[1])); }
    pmax += off;
    if (__builtin_expect(__all(pmax - m_reg <= THR), 1)) { alpha = 1.f; }
    else { const float mn = fmaxf(m_reg, pmax); alpha = __builtin_amdgcn_exp2f(m_reg - mn); m_reg = mn; }
    const float sub = off - m_reg;
#pragma unroll
    for (int r = 0; r < 16; ++r) { p0[r] += sub; p1[r] += sub; }
#pragma unroll
    for (int r = 0; r < 16; ++r) p0[r] = __builtin_amdgcn_exp2f(p0[r]);
}
__device__ __forceinline__ void finishSM(f32x16& p0, f32x16& p1, float alpha, float& l_reg, bf16x8& pa0, bf16x8& pa1, bf16x8& pa2, bf16x8& pa3) {
#pragma unroll
    for (int r = 0; r < 16; ++r) p1[r] = __builtin_amdgcn_exp2f(p1[r]);
    float ps = 0;
#pragma unroll
    for (int r = 0; r < 16; ++r) ps += p0[r];
#pragma unroll
    for (int r = 0; r < 16; ++r) ps += p1[r];
    { auto rr = __builtin_amdgcn_permlane32_swap(__float_as_uint(ps), __float_as_uint(ps), false, false);
      ps = __uint_as_float(rr[0]) + __uint_as_float(rr[1]); }
    l_reg = l_reg * alpha + ps;
#define PK4(P, BASE, OUT) do { unsigned a0 = cvtpk(P[BASE + 0], P[BASE + 1]), a1 = cvtpk(P[BASE + 2], P[BASE + 3]);   \
    unsigned b0 = cvtpk(P[BASE + 4], P[BASE + 5]), b1 = cvtpk(P[BASE + 6], P[BASE + 7]);                              \
    auto r0 = __builtin_amdgcn_permlane32_swap(a0, b0, false, false); auto r1 = __builtin_amdgcn_permlane32_swap(a1, b1, false, false); \
    u32x4 w = {r0[0], r1[0], r0[1], r1[1]}; OUT = __builtin_bit_cast(bf16x8, w); } while (0)
    PK4(p0, 0, pa0); PK4(p0, 8, pa1); PK4(p1, 0, pa2); PK4(p1, 8, pa3);
#undef PK4
}
__device__ __forceinline__ void qkt64(f32x16& p0, f32x16& p1, const LAS char* Ks, const bf16x8* qr, int r32, int hi) {
#pragma unroll
    for (int d0 = 0; d0 < 4; ++d0) { const int cb = (d0 * 16 + hi * 8) * 2;
        const bf16x8 b0 = *(const LAS bf16x8*)(Ks + KSW(r32, cb));
        const bf16x8 b1 = *(const LAS bf16x8*)(Ks + KSW(r32, cb) + 4096);
        p0 = __builtin_amdgcn_mfma_f32_32x32x16_bf16(b0, qr[d0], p0, 0, 0, 0); p1 = __builtin_amdgcn_mfma_f32_32x32x16_bf16(b1, qr[d0], p1, 0, 0, 0); }
}
template <int NCB> __device__ __forceinline__ int v_st(int k, int c) { const int kk = (k & ~0xC) | ((k & 4) << 1) | ((k & 8) >> 1); return ((kk >> 3) * NCB + (c >> 5)) * 512 + ((kk & 7) * 32 + (c & 31)) * 2; }
__device__ __forceinline__ int v_rd_base(int lane) { return ((lane & 3) << 3) | (((lane >> 2) & 3) << 6) | (((lane >> 4) & 1) << 5) | (((lane >> 5) & 1) << 8); }
template <int NCB> constexpr int v_rd_off(int d0, int ks, int half) { return d0 * 512 + ks * (NCB * 1024) + half * (NCB * 512); }
template <int OFF> __device__ __forceinline__ s16x4 tr_read(int vb) { s16x4 r; asm volatile("ds_read_b64_tr_b16 %0, %1 offset:%2" : "=&v"(r) : "v"(vb), "i"(OFF) : "memory"); return r; }
template <int NCB, int D0> __device__ __forceinline__ void pv_one(f32x16& od, int vb, bf16x8 pa0, bf16x8 pa1, bf16x8 pa2, bf16x8 pa3) {
    const s16x4 l0 = tr_read<v_rd_off<NCB>(D0, 0, 0)>(vb), h0 = tr_read<v_rd_off<NCB>(D0, 0, 1)>(vb), l1 = tr_read<v_rd_off<NCB>(D0, 1, 0)>(vb), h1 = tr_read<v_rd_off<NCB>(D0, 1, 1)>(vb);
    const s16x4 l2 = tr_read<v_rd_off<NCB>(D0, 2, 0)>(vb), h2 = tr_read<v_rd_off<NCB>(D0, 2, 1)>(vb), l3 = tr_read<v_rd_off<NCB>(D0, 3, 0)>(vb), h3 = tr_read<v_rd_off<NCB>(D0, 3, 1)>(vb);
    asm volatile("s_waitcnt lgkmcnt(0)" ::: "memory"); SBAR();
#define PK(L, H) (bf16x8){L[0], L[1], L[2], L[3], H[0], H[1], H[2], H[3]}
    od = __builtin_amdgcn_mfma_f32_32x32x16_bf16(pa0, PK(l0, h0), od, 0, 0, 0);
    od = __builtin_amdgcn_mfma_f32_32x32x16_bf16(pa1, PK(l1, h1), od, 0, 0, 0);
    od = __builtin_amdgcn_mfma_f32_32x32x16_bf16(pa2, PK(l2, h2), od, 0, 0, 0);
    od = __builtin_amdgcn_mfma_f32_32x32x16_bf16(pa3, PK(l3, h3), od, 0, 0, 0);
#undef PK
}

constexpr int D_V = 0, D_K = 49152, D_WS = 81920, D_TB = 83968, D_ST = 86016, D_END = D_ST + 65536;
constexpr int NT = SEQ / 64;

typedef short v4i16_t __attribute__((ext_vector_type(4)));
__device__ __forceinline__ s16x4 vtr(const LAS char* p) { return __builtin_bit_cast(s16x4, __builtin_amdgcn_ds_read_tr16_b64_v4i16((LAS v4i16_t*)p)); }
#define PIN(x) asm volatile("" : "+v"(x))
#define MX3(a, b, c) __builtin_fmaxf(__builtin_fmaxf((a), (b)), (c))
#define EX(v) __builtin_amdgcn_exp2f(v)
#define MFMA32(a, b, c) __builtin_amdgcn_mfma_f32_32x32x16_bf16((a), (b), (c), 0, 0, 0)
constexpr float THRL = 6.0f;
__device__ __forceinline__ float rowmax32(const f32x16& C0, const f32x16& C1) {
    float a = MX3(C0[0], C0[1], C1[0]), b = MX3(C0[2], C0[3], C1[1]); a = MX3(a, C1[2], C1[3]);
#pragma unroll
    for (int r = 4; r < 16; r += 4) { a = MX3(a, C0[r], C0[r + 1]); b = MX3(b, C0[r + 2], C0[r + 3]); a = MX3(a, C1[r], C1[r + 1]); b = MX3(b, C1[r + 2], C1[r + 3]); }
    float rm = __builtin_fmaxf(a, b);
    auto rr = __builtin_amdgcn_permlane32_swap(__float_as_uint(rm), __float_as_uint(rm), false, false);
    return __builtin_fmaxf(__uint_as_float(rr[0]), __uint_as_float(rr[1]));
}
__device__ __forceinline__ void diff_pass(f32x16 (&o)[4], float& l_out, const bf16_t* Qw, const bf16_t* __restrict__ Kh, const bf16_t* __restrict__ Vh,
                                          LAS char* lds, int qa, float cL, float cR) {
    const int tid = threadIdx.x, wid = __builtin_amdgcn_readfirstlane(tid >> 6), lane = tid & 63, r32 = lane & 31, hi = lane >> 5;
    LAS char* V_lds = lds + D_V; LAS char* K_lds = lds + D_K;
    LAS float* wsf = (LAS float*)(lds + D_WS) + wid * 64 + 32;
    const LAS float* tb = (const LAS float*)(lds + D_TB);
#pragma unroll
    for (int d = 0; d < 4; ++d) o[d] = f32x16{};
    bf16x8 qr[4];
#pragma unroll
    for (int d0 = 0; d0 < 4; ++d0) qr[d0] = *(const bf16x8*)(Qw + d0 * 16);
#pragma unroll
    for (int d0 = 0; d0 < 4; ++d0) PIN(qr[d0]);
    const bf16_t* ksrc; const bf16_t* vsrc0;
    { const int row = wid * 8 + (lane >> 3), pos = lane & 7;
      ksrc = Kh + (long)row * PITCH + ((pos ^ ((row >> 1) & 7)) * 8);
      vsrc0 = Vh + (long)row * PITCH + ((pos ^ (((row >> 1) & 1) << 2)) * 8); }
    const LAS char* kq[4];
    { const int sw = (r32 >> 1) & 7;
#pragma unroll
      for (int d0 = 0; d0 < 4; ++d0) kq[d0] = K_lds + r32 * 128 + (((2 * d0 + hi) ^ sw) << 4); }
    const LAS char* vpe; const LAS char* vpo;
    { const int q = (lane & 15) >> 2, p = lane & 3, g = (lane >> 4) & 1, sw = (q >> 1) & 1;
      vpe = V_lds + (4 * hi + q) * 128 + sw * 64 + g * 32 + p * 8; vpo = V_lds + (4 * hi + q) * 128 + (sw ^ 1) * 64 + g * 32 + p * 8; }
#define DMA_K(j, ko) __builtin_amdgcn_global_load_lds((const unsigned*)(ksrc + (long)(j) * 64 * PITCH), (LAS unsigned*)(K_lds + (ko) + wid * 1024), 16, 0, 0)
#define DMA_V(j, vo) do { __builtin_amdgcn_global_load_lds((const unsigned*)(vsrc0 + (long)(j) * 64 * PITCH), (LAS unsigned*)(V_lds + (vo) + wid * 1024), 16, 0, 0); \
    __builtin_amdgcn_global_load_lds((const unsigned*)(vsrc0 + 64 + (long)(j) * 64 * PITCH), (LAS unsigned*)(V_lds + (vo) + 8192 + wid * 1024), 16, 0, 0); } while (0)
#define WAIT_BAR(N) do { asm volatile("s_waitcnt vmcnt(" #N ") lgkmcnt(0)" ::: "memory"); __builtin_amdgcn_s_barrier(); asm volatile("" ::: "memory"); } while (0)
    float mhat, l_reg = 0.f; bool resc = false;
    f32x16 pA0, pA1, pB0, pB1;
    bf16x8 kf[4]; s16x4 vlo[6], vhi[6]; u32x4 pw0, pw1, pw2, pw3;
#define KRD(i, KS) do { kf[(i) & 3] = *(const LAS bf16x8*)(kq[(i) >> 1] + (KS) + ((i) & 1) * 4096); } while (0)
    WAIT_BAR(0);
    DMA_K(0, 0); DMA_K(1, 8192); DMA_V(0, 0); DMA_K(2, 16384); DMA_K(3, 24576); DMA_V(1, 16384);
    WAIT_BAR(7);
    {
        float off0 = 0.f; const int d_ = -qa;
        if (d_ <= -154) { pA0 = f32x16{}; pA1 = f32x16{}; off0 = cL; }
        else { const LAS float* t_ = tb + (d_ + 256 + 4 * hi - r32);
#pragma unroll
            for (int r = 0; r < 16; ++r) { pA0[r] = t_[(r & 3) + 8 * (r >> 2)]; pA1[r] = t_[32 + (r & 3) + 8 * (r >> 2)]; } }
#pragma unroll
        for (int d0 = 0; d0 < 4; ++d0) { const bf16x8 k0_ = *(const LAS bf16x8*)(kq[d0]), k1_ = *(const LAS bf16x8*)(kq[d0] + 4096);
            pA0 = MFMA32(k0_, qr[d0], pA0); pA1 = MFMA32(k1_, qr[d0], pA1); }
        const float rm = rowmax32(pA0, pA1);
        mhat = rm + off0;
#pragma unroll
        for (int r = 0; r < 16; ++r) { pA0[r] = EX(pA0[r] - rm); pA1[r] = EX(pA1[r] - rm); }
    }
    WAIT_BAR(3);
    KRD(0, 8192); KRD(1, 8192); KRD(2, 8192); KRD(3, 8192);
#define PKW(P, B) cvtpk(P[B], P[(B) + 1])
#define PAF(k) __builtin_bit_cast(bf16x8, pw##k)
#define VFR(i) (bf16x8){vlo[(i) % 6][0], vlo[(i) % 6][1], vlo[(i) % 6][2], vlo[(i) % 6][3], vhi[(i) % 6][0], vhi[(i) % 6][1], vhi[(i) % 6][2], vhi[(i) % 6][3]}
#define VRD(i, VS) do { const LAS char* vq_ = ((((i) & 3) & 1) ? vpo : vpe) + (VS) + (((i) & 3) >> 1) * 8192 + ((i) >> 2) * 2048; vlo[(i) % 6] = vtr(vq_); vhi[(i) % 6] = vtr(vq_ + 1024); } while (0)
#define GAPA(g, CC, QI, KB, A0, A1, A2, A3, W0, W1, PW) do { CC = MFMA32(kf[(g) & 3], qr[QI], CC); if ((g) + 4 < 8) KRD((g) + 4, KB); sacc += A0; sacc += A1; sacc += A2; sacc += A3; PIN(sacc); W0; W1; PIN(PW); SBAR(); } while (0)
#define GAPB(i, X, B, VB, KN, PRE) do { o[(i) & 3] = MFMA32(PAF_SEL(i), VFR(i), o[(i) & 3]); X[B] = EX(X[B]); X[(B) + 1] = EX(X[(B) + 1]); PIN(X); if ((i) + 5 < 16) VRD((i) + 5, VB); \
    if ((PRE) && (i) >= 8 && (i) < 12) KRD((i) - 8, KN); SBAR(); } while (0)
#define PAF_SEL(i) (((i) >> 2) == 0 ? PAF(0) : ((i) >> 2) == 1 ? PAF(1) : ((i) >> 2) == 2 ? PAF(2) : PAF(3))
#define STEP(C0, C1, P0, P1, t, KB, VB, KN, PRE) do { SBAR(); \
    { const int d_ = (t) * 64 - qa; \
      if (d_ > -154 && d_ < 122) { const LAS float* t_ = tb + (d_ + 256 + 4 * hi - r32); \
        _Pragma("unroll") for (int r = 0; r < 16; ++r) { C0[r] = t_[(r & 3) + 8 * (r >> 2)] - mhat; C1[r] = t_[32 + (r & 3) + 8 * (r >> 2)] - mhat; } } \
      else { const float cs_ = (d_ < 0 ? cL : cR) - mhat; _Pragma("unroll") for (int r = 0; r < 16; ++r) { C0[r] = cs_; C1[r] = cs_; } } } \
    PIN(C0); PIN(C1); SBAR(); \
    float sacc = (P0[0] + P0[1]); \
    GAPA(0, C0, 0, KB, P0[2],  P0[3],  P0[4],  P0[5],  pw0[0] = PKW(P0, 0),  pw0[1] = PKW(P0, 2),  pw0); \
    GAPA(1, C1, 0, KB, P0[6],  P0[7],  P0[8],  P0[9],  pw0[2] = PKW(P0, 4),  pw0[3] = PKW(P0, 6),  pw0); \
    GAPA(2, C0, 1, KB, P0[10], P0[11], P0[12], P0[13], pw1[0] = PKW(P0, 8),  pw1[1] = PKW(P0, 10), pw1); \
    GAPA(3, C1, 1, KB, P0[14], P0[15], P1[0],  P1[1],  pw1[2] = PKW(P0, 12), pw1[3] = PKW(P0, 14), pw1); \
    GAPA(4, C0, 2, KB, P1[2],  P1[3],  P1[4],  P1[5],  pw2[0] = PKW(P1, 0),  pw2[1] = PKW(P1, 2),  pw2); \
    GAPA(5, C1, 2, KB, P1[6],  P1[7],  P1[8],  P1[9],  pw2[2] = PKW(P1, 4),  pw2[3] = PKW(P1, 6),  pw2); \
    GAPA(6, C0, 3, KB, P1[10], P1[11], P1[12], P1[13], pw3[0] = PKW(P1, 8),  pw3[1] = PKW(P1, 10), pw3); \
    GAPA(7, C1, 3, KB, P1[14], P1[15], 0.f,    0.f,    pw3[2] = PKW(P1, 12), pw3[3] = PKW(P1, 14), pw3); \
    l_reg += sacc; \
    VRD(0, VB); VRD(1, VB); VRD(2, VB); VRD(3, VB); VRD(4, VB); \
    { const float rm = rowmax32(C0, C1); resc = false; \
      if (__builtin_expect(__any(rm > THRL), 0)) { const float dl = __builtin_fmaxf(rm, 0.f); mhat += dl; \
        _Pragma("unroll") for (int r = 0; r < 16; ++r) { C0[r] -= dl; C1[r] -= dl; } \
        const float f = EX(-dl); l_reg *= f; if (hi == 0) wsf[r32] = f; resc = true; } } \
    SBAR(); \
    GAPB(0, C0, 0, VB, KN, PRE);  GAPB(1, C0, 2, VB, KN, PRE);  GAPB(2, C0, 4, VB, KN, PRE);   GAPB(3, C0, 6, VB, KN, PRE); \
    GAPB(4, C0, 8, VB, KN, PRE);  GAPB(5, C0, 10, VB, KN, PRE); GAPB(6, C0, 12, VB, KN, PRE);  GAPB(7, C0, 14, VB, KN, PRE); \
    GAPB(8, C1, 0, VB, KN, PRE);  GAPB(9, C1, 2, VB, KN, PRE);  GAPB(10, C1, 4, VB, KN, PRE);  GAPB(11, C1, 6, VB, KN, PRE); \
    GAPB(12, C1, 8, VB, KN, PRE); GAPB(13, C1, 10, VB, KN, PRE); GAPB(14, C1, 12, VB, KN, PRE); GAPB(15, C1, 14, VB, KN, PRE); \
    } while (0)
#define RESC() do { if (resc) { asm volatile("s_waitcnt lgkmcnt(0)" ::: "memory"); \
    _Pragma("unroll") for (int d = 0; d < 4; ++d) _Pragma("unroll") for (int r = 0; r < 16; ++r) o[d][r] *= wsf[crow(r, hi)]; } } while (0)
    int ks_cur = 8192, ks_n1 = 16384, ks_n3 = 0;
    int vs_prev = 0, vs_next = 32768;
#define ROT() do { ks_cur = (ks_cur + 8192) & 24576; ks_n1 = (ks_n1 + 8192) & 24576; ks_n3 = (ks_n3 + 8192) & 24576; vs_prev = vs_prev == 32768 ? 0 : vs_prev + 16384; vs_next = vs_next == 32768 ? 0 : vs_next + 16384; } while (0)
#define STEPX(C0, C1, P0, P1, t, PRE) STEP(C0, C1, P0, P1, t, ks_cur, vs_prev, ks_n1, PRE)
#pragma unroll 1
    for (int t = 1; t + 4 < NT; t += 2) {
        DMA_K(t + 3, ks_n3); DMA_V(t + 1, vs_next);
        STEPX(pB0, pB1, pA0, pA1, t, true);
        WAIT_BAR(3); RESC(); ROT();
        DMA_K(t + 4, ks_n3); DMA_V(t + 2, vs_next);
        STEPX(pA0, pA1, pB0, pB1, t + 1, true);
        WAIT_BAR(3); RESC(); ROT();
    }
    DMA_V(NT - 2, vs_next);
    STEPX(pB0, pB1, pA0, pA1, NT - 3, true);
    WAIT_BAR(2); RESC(); ROT();
    DMA_V(NT - 1, vs_next);
    STEPX(pA0, pA1, pB0, pB1, NT - 2, true);
    WAIT_BAR(2); RESC(); ROT();
    STEPX(pB0, pB1, pA0, pA1, NT - 1, false);
    WAIT_BAR(0); RESC(); ROT();
    { float sacc = 0.f;
#pragma unroll
      for (int r = 0; r < 16; ++r) sacc += pB0[r];
#pragma unroll
      for (int r = 0; r < 16; ++r) sacc += pB1[r];
      l_reg += sacc;
      pw0 = (u32x4){PKW(pB0, 0), PKW(pB0, 2), PKW(pB0, 4), PKW(pB0, 6)}; pw1 = (u32x4){PKW(pB0, 8), PKW(pB0, 10), PKW(pB0, 12), PKW(pB0, 14)};
      pw2 = (u32x4){PKW(pB1, 0), PKW(pB1, 2), PKW(pB1, 4), PKW(pB1, 6)}; pw3 = (u32x4){PKW(pB1, 8), PKW(pB1, 10), PKW(pB1, 12), PKW(pB1, 14)};
      SBAR();
#define DRAIN(i) do { VRD(i, vs_prev); o[(i) & 3] = MFMA32(PAF_SEL(i), VFR(i), o[(i) & 3]); } while (0)
      DRAIN(0); DRAIN(1); DRAIN(2); DRAIN(3); DRAIN(4); DRAIN(5); DRAIN(6); DRAIN(7); DRAIN(8); DRAIN(9); DRAIN(10); DRAIN(11); DRAIN(12); DRAIN(13); DRAIN(14); DRAIN(15);
#undef DRAIN
    }
    { auto rr = __builtin_amdgcn_permlane32_swap(__float_as_uint(l_reg), __float_as_uint(l_reg), false, false); l_out = __uint_as_float(rr[0]) + __uint_as_float(rr[1]); }
#undef DMA_K
#undef DMA_V
#undef WAIT_BAR
#undef ROT
#undef KRD
#undef PKW
#undef PAF
#undef VFR
#undef VRD
#undef GAPA
#undef GAPB
#undef PAF_SEL
#undef STEP
#undef STEPX
#undef RESC
}

__device__ __forceinline__ void diff_unit(int b, int h, int qb, const bf16_t* P, bf16_t* O, LAS char* lds, float lam, const float* relb) {
    const int tid = threadIdx.x, wid = __builtin_amdgcn_readfirstlane(tid >> 6), lane = tid & 63, r32 = lane & 31, hi = lane >> 5;
    const long rowbase = (long)b * SEQ; const int q0 = qb * 256, qa = q0 + wid * 32;
    LAS float* tb = (LAS float*)(lds + D_TB);
    LAS float* li_l = (LAS float*)(lds + D_WS) + wid * 64;
    tb[tid] = relb[rel_bucket(tid - 256) * NBH + h] * LOG2E;
    const float cL = relb[15 * NBH + h] * LOG2E, cR = relb[31 * NBH + h] * LOG2E;
    const bf16_t* Qrow = P + (rowbase + qa + r32) * PITCH + C_DQ + h * 128 + hi * 8;
    const bf16_t* Kh = P + rowbase * PITCH + C_DK + h * 128;
    const bf16_t* Vh = P + rowbase * PITCH + C_DV + h * 128;
    LAS u32x4* stash = (LAS u32x4*)(lds + D_ST + wid * 8192);
    f32x16 o[4]; float l_reg;
#pragma unroll 1
    for (int pass = 0; pass < 2; ++pass) {
        const int mo = pass == 0 ? 64 : 0;
        diff_pass(o, l_reg, Qrow + mo, Kh + mo, Vh, lds, qa, cL, cR);
        int ln = lane; asm volatile("" : "+v"(ln));
        const int r32e = ln & 31, hie = ln >> 5;
        if (hie == 0) li_l[r32e] = l_reg; asm volatile("s_waitcnt lgkmcnt(0)" ::: "memory");
        if (pass == 0) {
            float rli[16];
#pragma unroll
            for (int r = 0; r < 16; ++r) rli[r] = -lam * __builtin_amdgcn_rcpf(li_l[crow(r, hie)]);
#pragma unroll
            for (int d0 = 0; d0 < 4; ++d0) {
                u32x4 w0, w1;
                w0.x = cvtpk(o[d0][0] * rli[0], o[d0][1] * rli[1]); w0.y = cvtpk(o[d0][2] * rli[2], o[d0][3] * rli[3]); w0.z = cvtpk(o[d0][4] * rli[4], o[d0][5] * rli[5]); w0.w = cvtpk(o[d0][6] * rli[6], o[d0][7] * rli[7]);
                w1.x = cvtpk(o[d0][8] * rli[8], o[d0][9] * rli[9]); w1.y = cvtpk(o[d0][10] * rli[10], o[d0][11] * rli[11]); w1.z = cvtpk(o[d0][12] * rli[12], o[d0][13] * rli[13]); w1.w = cvtpk(o[d0][14] * rli[14], o[d0][15] * rli[15]);
                stash[(2 * d0) * 64 + ln] = w0; stash[(2 * d0 + 1) * 64 + ln] = w1;
            }
        } else {
            float rli[16], ssq[16];
#pragma unroll
            for (int r = 0; r < 16; ++r) { rli[r] = __builtin_amdgcn_rcpf(li_l[crow(r, hie)]); ssq[r] = 0.f; }
#pragma unroll
            for (int d0 = 0; d0 < 4; ++d0) {
                const u32x4 w0 = stash[(2 * d0) * 64 + ln], w1 = stash[(2 * d0 + 1) * 64 + ln];
                const unsigned ww[8] = {w0.x, w0.y, w0.z, w0.w, w1.x, w1.y, w1.z, w1.w};
#pragma unroll
                for (int r = 0; r < 16; ++r) { const float c = __uint_as_float((r & 1) ? (ww[r >> 1] & 0xffff0000u) : (ww[r >> 1] << 16));
                    const float x = fmaf(o[d0][r], rli[r], c); o[d0][r] = x; ssq[r] = fmaf(x, x, ssq[r]); }
            }
            asm volatile("s_waitcnt lgkmcnt(0)" ::: "memory");
#pragma unroll
            for (int r = 0; r < 16; ++r) { float s = ssq[r];
                s += __shfl_xor(s, 1); s += __shfl_xor(s, 2); s += __shfl_xor(s, 4); s += __shfl_xor(s, 8); s += __shfl_xor(s, 16);
                ssq[r] = __builtin_amdgcn_rsqf(s * (1.0f / 128.0f) + EPS); }
            LAS bf16_t* stg = (LAS bf16_t*)(lds + D_ST + wid * 8192);
#pragma unroll
            for (int r = 0; r < 16; ++r) { const int orow = crow(r, hie);
#pragma unroll
                for (int d0 = 0; d0 < 4; ++d0) stg[orow * 128 + d0 * 32 + r32e] = (bf16_t)(cvtpk(o[d0][r] * ssq[r], 0.f) & 0xffffu); }
            asm volatile("s_waitcnt lgkmcnt(0)" ::: "memory");
            bf16_t* Ow = O + (rowbase + qa + (ln >> 4)) * DM + h * 128 + (ln & 15) * 8;
            const LAS bf16_t* sl = stg + (ln >> 4) * 128 + (ln & 15) * 8;
#pragma unroll
            for (int i = 0; i < 8; ++i) { const u32x4 v = *(const LAS u32x4*)(sl + i * 512); *(u32x4*)(Ow + (long)i * 4 * DM) = v; }
        }
    }
    asm volatile("s_waitcnt lgkmcnt(0)" ::: "memory"); __syncthreads();
}

constexpr int W_K = 0, W_V = 49152, W_TB = 98304, W_WS = 106496, W_OST = 108544, W_END = W_OST + 32768;
__device__ __forceinline__ void win_unit(int b, int kvh, int qb, const bf16_t* P, bf16_t* O, LAS char* lds, const float* relb, const float* sink) {
    const int tid = threadIdx.x, wid = __builtin_amdgcn_readfirstlane(tid >> 6), lane = tid & 63, r32 = lane & 31, hi = lane >> 5;
    const long rowbase = (long)b * SEQ; const int q0 = qb * 128, kbase = q0 - 128;
    LAS float* tbw = (LAS float*)(lds + W_TB);
#pragma unroll
    for (int e = 0; e < 4; ++e) { const int idx = tid + e * 512, g = idx >> 9, rel = (idx & 511) - 256;
        tbw[idx] = (rel >= -128 && rel <= 128) ? (relb[rel_bucket(rel) * NBH + 4 + 4 * kvh + g] - sink[4 * kvh + g]) * LOG2E : -1e30f; }
    { int tl = tid; asm volatile("" : "+v"(tl));
      const int kr = tl >> 3, kc = (tl & 7) * 8, kst = KSW(kr, kc * 2), vst = v_st<2>(kr, kc);
      const bf16_t* Kh = P + rowbase * PITCH + C_WK + kvh * 64; const bf16_t* Vh = P + rowbase * PITCH + C_WV + kvh * 64;
      bf16x8 kreg[6], vreg[6];
#pragma unroll
      for (int t = 0; t < 6; ++t) { const int k0 = kbase + 64 * t; if (k0 >= 0 && k0 < SEQ) { kreg[t] = *(const bf16x8*)(&Kh[(long)(k0 + kr) * PITCH + kc]); vreg[t] = *(const bf16x8*)(&Vh[(long)(k0 + kr) * PITCH + kc]); } }
#pragma unroll
      for (int t = 0; t < 6; ++t) { const int k0 = kbase + 64 * t; if (k0 >= 0 && k0 < SEQ) { *(LAS bf16x8*)(lds + W_K + t * 8192 + kst) = kreg[t]; *(LAS bf16x8*)(lds + W_V + t * 8192 + vst) = vreg[t]; } }
    }
    __syncthreads();
    const int g = wid >> 1, hq = 4 * kvh + g;
    LAS float* li_l = (LAS float*)(lds + W_WS) + wid * 64;
    const LAS float* tbg = tbw + g * 512;
    const int vbw = (int)(uintptr_t)(lds + W_V) + v_rd_base(lane);
#pragma unroll 1
    for (int jb = 0; jb < 2; ++jb) {
        const int ql = 64 * (wid & 1) + 32 * jb;
        const bf16_t* Qw = P + (rowbase + q0 + ql + r32) * PITCH + C_WQ + hq * 64 + hi * 8;
        bf16x8 qr[4];
#pragma unroll
        for (int d0 = 0; d0 < 4; ++d0) qr[d0] = *(const bf16x8*)(Qw + d0 * 16);
        float l_reg = 0.f;
        f32x16 o[2]; o[0] = f32x16{}; o[1] = f32x16{};
        const int t_lo = ql >> 6;
#pragma unroll 1
        for (int t = t_lo; t < t_lo + 5; ++t) {
            const int k0 = kbase + 64 * t; if (k0 < 0 || k0 >= SEQ) continue;
            const int d_ = 64 * t - 128 - ql;
            const LAS float* t_ = tbg + (d_ + 256 + 4 * hi - r32);
            f32x16 p0, p1;
#pragma unroll
            for (int r = 0; r < 16; ++r) { p0[r] = t_[(r & 3) + 8 * (r >> 2)]; p1[r] = t_[32 + (r & 3) + 8 * (r >> 2)]; }
            qkt64(p0, p1, lds + W_K + t * 8192, qr, r32, hi);
#pragma unroll
            for (int r = 0; r < 16; ++r) { p0[r] = __builtin_amdgcn_exp2f(p0[r]); p1[r] = __builtin_amdgcn_exp2f(p1[r]); }
            bf16x8 pa0, pa1, pa2, pa3;
            {
                float ps = 0;
#pragma unroll
                for (int r = 0; r < 16; ++r) ps += p0[r];
#pragma unroll
                for (int r = 0; r < 16; ++r) ps += p1[r];
                l_reg += ps;
#define PK4(Pv, BASE, OUT) do { unsigned a0 = cvtpk(Pv[BASE + 0], Pv[BASE + 1]), a1 = cvtpk(Pv[BASE + 2], Pv[BASE + 3]);   \
    unsigned b0 = cvtpk(Pv[BASE + 4], Pv[BASE + 5]), b1 = cvtpk(Pv[BASE + 6], Pv[BASE + 7]);                              \
    auto r0 = __builtin_amdgcn_permlane32_swap(a0, b0, false, false); auto r1 = __builtin_amdgcn_permlane32_swap(a1, b1, false, false); \
    u32x4 w = {r0[0], r1[0], r0[1], r1[1]}; OUT = __builtin_bit_cast(bf16x8, w); } while (0)
                PK4(p0, 0, pa0); PK4(p0, 8, pa1); PK4(p1, 0, pa2); PK4(p1, 8, pa3);
#undef PK4
            }
            const int vb = vbw + t * 8192;
            pv_one<2, 0>(o[0], vb, pa0, pa1, pa2, pa3); pv_one<2, 1>(o[1], vb, pa0, pa1, pa2, pa3);
        }
        { auto rr = __builtin_amdgcn_permlane32_swap(__float_as_uint(l_reg), __float_as_uint(l_reg), false, false); l_reg = 1.0f + __uint_as_float(rr[0]) + __uint_as_float(rr[1]); }
        int ln = lane; asm volatile("" : "+v"(ln));
        const int r32e = ln & 31, hie = ln >> 5;
        if (hie == 0) li_l[r32e] = l_reg; asm volatile("s_waitcnt lgkmcnt(0)" ::: "memory");
        float rli[16];
#pragma unroll
        for (int r = 0; r < 16; ++r) rli[r] = __builtin_amdgcn_rcpf(li_l[crow(r, hie)]);
        LAS bf16_t* stg = (LAS bf16_t*)(lds + W_OST + wid * 4096);
#pragma unroll
        for (int r = 0; r < 16; ++r) { const int orow = crow(r, hie);
#pragma unroll
            for (int d0 = 0; d0 < 2; ++d0) stg[orow * 64 + d0 * 32 + r32e] = (bf16_t)(cvtpk(o[d0][r] * rli[r], 0.f) & 0xffffu); }
        asm volatile("s_waitcnt lgkmcnt(0)" ::: "memory");
        bf16_t* Ow = O + (rowbase + q0 + ql + (ln >> 3)) * DM + 512 + hq * 64 + (ln & 7) * 8;
        const LAS bf16_t* sl = stg + (ln >> 3) * 64 + (ln & 7) * 8;
#pragma unroll
        for (int i = 0; i < 4; ++i) { const u32x4 v = *(const LAS u32x4*)(sl + i * 512); *(u32x4*)(Ow + (long)i * 8 * DM) = v; }
        asm volatile("s_waitcnt lgkmcnt(0)" ::: "memory");
    }
    asm volatile("s_waitcnt lgkmcnt(0)" ::: "memory"); __syncthreads();
}
#undef SBAR
#undef KSW
}

constexpr size_t MiB = 1u << 20;
constexpr size_t WS_CTL = 0, CTL_ZERO_BYTES = 64 * 1024;
constexpr size_t WS_W1 = 1 * MiB;
constexpr size_t WS_W2 = WS_W1 + (size_t)DIN * DM * 2;
constexpr size_t WS_W3 = WS_W2 + (size_t)DM * DM * 2;
constexpr size_t WS_W4 = WS_W3 + (size_t)2 * DFF * DM * 2;
constexpr size_t WS_XS = 24 * MiB;
constexpr int CW_WMAX4 = 5120;
constexpr int CW_GBAR = 6400;
constexpr int CW_P3CNT = 4480;
constexpr size_t WS_FA = 26 * MiB;
constexpr size_t WS_FX = 26 * MiB + 512 * 1024;
constexpr int CW_WMAX1 = 13824, CW_W1CNT = 16200;
constexpr int CW_WMAX = 8192;
constexpr size_t WS_X0S = 27 * MiB;
constexpr size_t WS_PROJ = 28 * MiB;
constexpr size_t WS_OB = 244 * MiB;
constexpr size_t WS_XQ = 340 * MiB;
constexpr size_t WS_X1Q = 340 * MiB;
constexpr size_t WS_X1B = 388 * MiB;
constexpr size_t WS_ACT = 28 * MiB;
constexpr size_t WS_END = WS_X1B + (size_t)NTOK * DM * 2;
static_assert(WS_W4 + (size_t)DM * DFF * 2 <= WS_XS && WS_XS + (size_t)NTOK * 32 <= WS_FA && WS_FA + (size_t)NTOK * 4 <= WS_FX && WS_FX + (size_t)NTOK * 4 <= WS_X0S && WS_X0S + (size_t)NTOK * 4 <= WS_PROJ, "d_ws map");
static_assert(WS_PROJ + (size_t)NTOK * DIN * 2 <= WS_OB && WS_OB + (size_t)NTOK * DM * 2 <= WS_XQ && WS_XQ + (size_t)NTOK * DM <= WS_X1B && WS_ACT + (size_t)NTOK * DFF * 2 <= WS_X1Q - 4096, "d_ws map");
static_assert(CW_WMAX + 2 * DFF <= CW_WMAX1 && CW_WMAX1 + DIN <= CW_W1CNT && CW_W1CNT * 4 < CTL_ZERO_BYTES && 1024 + 3456 <= CW_P3CNT && CW_P3CNT + 192 <= CW_WMAX4 && CW_WMAX4 + DM <= CW_GBAR && CW_GBAR + 8 * 128 <= CW_WMAX, "d_ws map");
constexpr int CW_BAR = 1024, XCD_BAR_WORDS_C = 3456;

constexpr int RING_BYTES = 131072, EPX_OFF = RING_BYTES, LDS_BYTES = 163840, MISC_OFF = LDS_BYTES - 512;
static_assert(att::D_END <= MISC_OFF && att::W_END <= MISC_OFF && EPX_OFF + 22528 <= MISC_OFF, "LDS map");

typedef GAS unsigned gu32;
#define RLX_AGENT __ATOMIC_RELAXED, __HIP_MEMORY_SCOPE_AGENT
#define LDS_WAIT() asm volatile("s_waitcnt lgkmcnt(0)" ::: "memory")

#define XB_TMO      128
#define XB_XCNT(j)  (256  + 64 * (j))
#define XB_XSUB(j)  (1280 + 64 * (j))
#define XB_XGEN(j)  (2304 + 64 * (j))
#define XB_TOP      3328
#define XB_TOPGEN   3392
#define XCD_BAR_WORDS 3456
#define XB_SPIN_CAP (1u << 22)
__device__ __forceinline__ unsigned xb_ld(unsigned* p)              { return __hip_atomic_load(p, __ATOMIC_RELAXED, __HIP_MEMORY_SCOPE_AGENT); }
__device__ __forceinline__ unsigned xb_add(unsigned* p, unsigned v) { return __hip_atomic_fetch_add(p, v, __ATOMIC_RELAXED, __HIP_MEMORY_SCOPE_AGENT); }
__device__ __forceinline__ unsigned xb_xcc_id() { return (unsigned)__builtin_amdgcn_s_getreg((3 << 11) | 20) & 0xFu; }
#define XB_SPIN(cond, bar) do { unsigned _sp = 0; while (cond) { __builtin_amdgcn_s_sleep(1); \
    if ((++_sp & 255u) == 0u) { if (xb_ld(&(bar)[XB_TMO])) break; if (_sp > XB_SPIN_CAP) { atomicAdd(&(bar)[XB_TMO], 1u); break; } } } } while (0)
struct XcdBarrier { unsigned* bar; unsigned x; volatile LAS unsigned* st; };
__device__ __forceinline__ XcdBarrier xcd_barrier_post(unsigned* bar, volatile LAS unsigned* st) {
    XcdBarrier b; b.bar = bar; b.x = xb_xcc_id(); b.st = st;
    if (threadIdx.x == 0) (void)xb_add(&bar[XB_XCNT(b.x)], 1u);
    return b;
}
__device__ __forceinline__ void xcd_barrier_complete(unsigned* bar, unsigned x, unsigned& nloc, unsigned& nx) {
    const unsigned G = gridDim.x * gridDim.y * gridDim.z;
    unsigned sum, cnt, mine, sp = 0u;
    for (;;) {
        sum = 0u; cnt = 0u; mine = 0u;
#pragma unroll
        for (unsigned j = 0; j < 16; ++j) { const unsigned c = xb_ld(&bar[XB_XCNT(j)]); sum += c; cnt += (c > 0u) ? 1u : 0u; mine = (j == x) ? c : mine; }
        if (sum == G) break;
        __builtin_amdgcn_s_sleep(1);
        if ((++sp & 255u) == 0u) { if (xb_ld(&bar[XB_TMO])) break; if (sp > XB_SPIN_CAP) { atomicAdd(&bar[XB_TMO], 1u); break; } }
    }
    nloc = mine > 0u ? mine : 1u; nx = cnt > 0u ? cnt : 1u;
}
__device__ __forceinline__ void xcd_barrier(const XcdBarrier& b) {
    asm volatile("s_waitcnt vmcnt(0)" ::: "memory");
    __syncthreads();
    if (threadIdx.x == 0) {
        unsigned* bar = b.bar;
        __builtin_amdgcn_s_waitcnt(0);
        unsigned nloc = b.st[0], nx = b.st[1];
        if (nloc == 0u) { xcd_barrier_complete(bar, b.x, nloc, nx); b.st[0] = nloc; b.st[1] = nx; }
        const unsigned old = xb_add(&bar[XB_XSUB(b.x)], 1u);
        const unsigned gen = old / nloc;
        if (old + 1u == (gen + 1u) * nloc) {
            __builtin_amdgcn_fence(__ATOMIC_RELEASE, "agent");
            asm volatile("s_waitcnt vmcnt(0)" ::: "memory");
            const unsigned og = xb_add(&bar[XB_TOP], 1u);
            const unsigned tg = og / nx;
            if (og + 1u == (tg + 1u) * nx) xb_add(&bar[XB_TOPGEN], 1u);
            else XB_SPIN(xb_ld(&bar[XB_TOPGEN]) == tg, bar);
            __builtin_amdgcn_fence(__ATOMIC_ACQUIRE, "agent");
            xb_add(&bar[XB_XGEN(b.x)], 1u);
            asm volatile("s_waitcnt vmcnt(0)" ::: "memory");
        } else {
            XB_SPIN(xb_ld(&bar[XB_XGEN(b.x)]) == gen, bar);
            __builtin_amdgcn_fence(__ATOMIC_ACQUIRE, "agent");
            asm volatile("s_waitcnt vmcnt(0)" ::: "memory");
        }
    }
    __syncthreads();
}

__device__ __forceinline__ void group_barrier(unsigned* gb, unsigned nmem, volatile LAS unsigned* ep) {
    asm volatile("s_waitcnt vmcnt(0)" ::: "memory");
    __syncthreads();
    if (threadIdx.x == 0) {
        __builtin_amdgcn_fence(__ATOMIC_RELEASE, "agent");
        asm volatile("s_waitcnt vmcnt(0)" ::: "memory");
        const unsigned e = ep[0]; ep[0] = e + 1u;
        const unsigned old = xb_add(&gb[0], 1u);
        if (old + 1u == (e + 1u) * nmem) xb_add(&gb[64], 1u);
        else { unsigned sp = 0; while (xb_ld(&gb[64]) == e) { __builtin_amdgcn_s_sleep(1); if (++sp > XB_SPIN_CAP) break; } }
        __builtin_amdgcn_fence(__ATOMIC_ACQUIRE, "agent");
        asm volatile("s_waitcnt vmcnt(0)" ::: "memory");
    }
    __syncthreads();
}

__device__ __forceinline__ float wave_sum(float v) {
#pragma unroll
    for (int o = 1; o < 64; o <<= 1) v += __shfl_xor(v, o);
    return v;
}
__device__ __forceinline__ unsigned f2bf(float f) { unsigned u = __builtin_bit_cast(unsigned, f); return (u + 0x7fffu + ((u >> 16) & 1u)) >> 16; }
__device__ __forceinline__ unsigned pk2(float lo, float hi) { return f2bf(lo) | (f2bf(hi) << 16); }
__device__ __forceinline__ void transpose_item(const float* W, int ld, int cbase, int K, int k0, bf16_t* WT, int nrow0, const float* fold, int foldmask, float fscale, int foldlim, LAS float* scr, int lane) {
    float wv[32];
#pragma unroll
    for (int i = 0; i < 32; ++i) wv[i] = W[(size_t)(k0 + 2 * i + (lane >> 5)) * ld + cbase + (lane & 31)];
#pragma unroll
    for (int i = 0; i < 32; ++i) { const int kk = 2 * i + (lane >> 5), k = k0 + kk;
        float f = 1.f; if (fold != nullptr && k < foldlim) f = fold[k & foldmask] * fscale;
        scr[kk * 33 + (lane & 31)] = wv[i] * f; }
    LDS_WAIT(); asm volatile("" ::: "memory");
    const int c = lane & 7;
#pragma unroll
    for (int j = 0; j < 4; ++j) { const int n = (lane >> 3) + 8 * j; const LAS float* s = scr + (8 * c) * 33 + n;
        u32x4 o; o.x = pk2(s[0 * 33], s[1 * 33]); o.y = pk2(s[2 * 33], s[3 * 33]); o.z = pk2(s[4 * 33], s[5 * 33]); o.w = pk2(s[6 * 33], s[7 * 33]);
        *(u32x4*)(WT + (size_t)(nrow0 + n) * K + k0 + 8 * c) = o; }
    LDS_WAIT(); asm volatile("" ::: "memory");
}

__device__ __forceinline__ void absmax_item(const float* W, int ld, int cbase, int k0, unsigned* wmax, const float* fold, int lane) {
    float wv[32];
#pragma unroll
    for (int i = 0; i < 32; ++i) wv[i] = W[(size_t)(k0 + 2 * i + (lane >> 5)) * ld + cbase + (lane & 31)];
    float m = 0.f;
#pragma unroll
    for (int i = 0; i < 32; ++i) m = __builtin_fmaxf(m, __builtin_fabsf(wv[i] * (fold ? fold[k0 + 2 * i + (lane >> 5)] : 1.f)));
    m = __builtin_fmaxf(m, __shfl_xor(m, 32));
    if (lane < 32) (void)__hip_atomic_fetch_max(wmax + lane, __float_as_uint(m), __ATOMIC_RELAXED, __HIP_MEMORY_SCOPE_AGENT);
}
__device__ __forceinline__ void quant_item(const float* W, int ld, int cbase, int K, int k0, signed char* WQ, int nrow0, const float* fold, const unsigned* wmax, LAS float* scr, int lane) {
    float wv[32];
#pragma unroll
    for (int i = 0; i < 32; ++i) wv[i] = W[(size_t)(k0 + 2 * i + (lane >> 5)) * ld + cbase + (lane & 31)];
    const float am = __uint_as_float(__hip_atomic_load(wmax + (lane & 31), __ATOMIC_RELAXED, __HIP_MEMORY_SCOPE_AGENT)); const float inv = am > 0.f ? 127.0f / am : 0.f;
#pragma unroll
    for (int i = 0; i < 32; ++i) { const int kk = 2 * i + (lane >> 5); scr[kk * 33 + (lane & 31)] = wv[i] * fold[k0 + kk] * inv; }
    LDS_WAIT(); asm volatile("" ::: "memory");
    const int n = lane >> 1, c = lane & 1; const LAS float* sp = scr + (32 * c) * 33 + n;
    u32x4 o0, o1;
    o0.x = q4(sp[0 * 33], sp[1 * 33], sp[2 * 33], sp[3 * 33]);     o0.y = q4(sp[4 * 33], sp[5 * 33], sp[6 * 33], sp[7 * 33]);
    o0.z = q4(sp[8 * 33], sp[9 * 33], sp[10 * 33], sp[11 * 33]);   o0.w = q4(sp[12 * 33], sp[13 * 33], sp[14 * 33], sp[15 * 33]);
    o1.x = q4(sp[16 * 33], sp[17 * 33], sp[18 * 33], sp[19 * 33]); o1.y = q4(sp[20 * 33], sp[21 * 33], sp[22 * 33], sp[23 * 33]);
    o1.z = q4(sp[24 * 33], sp[25 * 33], sp[26 * 33], sp[27 * 33]); o1.w = q4(sp[28 * 33], sp[29 * 33], sp[30 * 33], sp[31 * 33]);
    u32x4* dst = (u32x4*)(WQ + (size_t)(nrow0 + n) * K + k0 + 32 * c);
    dst[0] = o0; dst[1] = o1;
    LDS_WAIT(); asm volatile("" ::: "memory");
}

__device__ __forceinline__ void quantf8_item(const float* W, int ld, int cbase, int K, int k0, unsigned char* WQ, int nrow0, const unsigned* wmax, LAS float* scr, int lane) {
    float wv[32];
#pragma unroll
    for (int i = 0; i < 32; ++i) wv[i] = W[(size_t)(k0 + 2 * i + (lane >> 5)) * ld + cbase + (lane & 31)];
    const float am = __uint_as_float(__hip_atomic_load(wmax + (lane & 31), __ATOMIC_RELAXED, __HIP_MEMORY_SCOPE_AGENT)); const float inv = am > 0.f ? W8_TOP / am : 0.f;
#pragma unroll
    for (int i = 0; i < 32; ++i) { const int kk = 2 * i + (lane >> 5); scr[kk * 33 + (lane & 31)] = wv[i] * inv; }
    LDS_WAIT(); asm volatile("" ::: "memory");
    const int n = lane >> 1, c = lane & 1; const LAS float* sp = scr + (32 * c) * 33 + n;
    u32x4 o0, o1;
    o0.x = f8x4(sp[0 * 33], sp[1 * 33], sp[2 * 33], sp[3 * 33]);     o0.y = f8x4(sp[4 * 33], sp[5 * 33], sp[6 * 33], sp[7 * 33]);
    o0.z = f8x4(sp[8 * 33], sp[9 * 33], sp[10 * 33], sp[11 * 33]);   o0.w = f8x4(sp[12 * 33], sp[13 * 33], sp[14 * 33], sp[15 * 33]);
    o1.x = f8x4(sp[16 * 33], sp[17 * 33], sp[18 * 33], sp[19 * 33]); o1.y = f8x4(sp[20 * 33], sp[21 * 33], sp[22 * 33], sp[23 * 33]);
    o1.z = f8x4(sp[24 * 33], sp[25 * 33], sp[26 * 33], sp[27 * 33]); o1.w = f8x4(sp[28 * 33], sp[29 * 33], sp[30 * 33], sp[31 * 33]);
    u32x4* dst = (u32x4*)(WQ + (size_t)(nrow0 + n) * K + k0 + 32 * c);
    dst[0] = o0; dst[1] = o1;
    LDS_WAIT(); asm volatile("" ::: "memory");
}

struct Args { const float* in[22]; float* out; unsigned char* ws; int ph_lo, ph_hi, li, pad; };

__global__ void __launch_bounds__(NWAVES * 64, 2) hymba_fwd(Args args) {
    extern __shared__ __attribute__((aligned(16))) unsigned char lds_raw[];
    LAS unsigned char* lds = (LAS unsigned char*)lds_raw;
    volatile LAS unsigned* MISC = (volatile LAS unsigned*)(lds + MISC_OFF);
    const int tid = threadIdx.x, lane = tid & 63, wave = __builtin_amdgcn_readfirstlane(tid >> 6);
    const int G = gridDim.x; const int bx = blockIdx.x; const int vcu = (G % 8 == 0) ? (bx % 8) * (G / 8) + bx / 8 : bx;
    unsigned char* ws = args.ws;
    unsigned* ctl = (unsigned*)(ws + WS_CTL);
    const float* xp = args.in[0]; const float* xs = args.in[1];
    bf16_t* W1 = (bf16_t*)(ws + WS_W1); bf16_t* W2 = (bf16_t*)(ws + WS_W2); bf16_t* W3 = (bf16_t*)(ws + WS_W3); bf16_t* W4 = (bf16_t*)(ws + WS_W4);
    bf16_t* PROJ = (bf16_t*)(ws + WS_PROJ); bf16_t* X1B = (bf16_t*)(ws + WS_X1B); bf16_t* ACT = (bf16_t*)(ws + WS_ACT);
    bf16_t* OB = (bf16_t*)(ws + WS_OB);
    signed char* XQ = (signed char*)(ws + WS_XQ); float* FX = (float*)(ws + WS_FX); signed char* W1Q = (signed char*)(ws + WS_W1);
    for (int u = tid; u < 128; u += NWAVES * 64) ((LAS unsigned*)(lds + MISC_OFF))[u] = 0u;
    __syncthreads();
    XcdBarrier bar; bar.bar = ctl + CW_BAR + args.li * XCD_BAR_WORDS; bar.x = 0; bar.st = nullptr;
    if (MK_N_LAUNCHES != 6) bar = xcd_barrier_post(ctl + CW_BAR + args.li * XCD_BAR_WORDS, MISC + 8);
    const int lo = args.ph_lo, hi_ph = args.ph_hi;
#ifndef ONLY_PHASE
#define ONLY_PHASE -1
#endif
#define IN(k) ((ONLY_PHASE < 0 || ONLY_PHASE == (k)) && lo <= (k) && (k) < hi_ph)
#define BOTH(k) (IN(k) && IN((k) + 1))
#define GRID_BAR() do { if (MK_N_LAUNCHES != 6) xcd_barrier(bar); } while (0)
#define GROUP_BAR() do { if (MK_N_LAUNCHES != 6) { if (G == 256) group_barrier(ctl + CW_GBAR + (bx & 7) * 128, 32u, MISC + 12); else xcd_barrier(bar); } } while (0)

    if (IN(0)) {
        LAS float* scr = (LAS float*)(lds + wave * 16384);
        const int gw = vcu * NWAVES + wave, NGW = G * NWAVES;
        constexpr int I1 = (DM / 64) * (DIN / 32), I2 = (DM / 64) * (DM / 32), I3 = (DM / 64) * (2 * DFF / 32), I4 = (DFF / 64) * (DM / 32);
        for (int it = gw; it < I1 + I2 + I3 + I4; it += NGW) {
            int r = it;
            if (r < I1) { const int nblk = DIN / 32, kb = r / nblk, nb = r % nblk, n0 = 32 * nb, pn = n0 >> 8, p = n0 & 255, bj = p >> 7, wc = (p & 127) >> 5;
                absmax_item(args.in[3], DIN, 256 * pn + 64 * wc + 32 * bj, 64 * kb, ctl + CW_WMAX1 + n0, args.in[2], lane);
                asm volatile("s_waitcnt vmcnt(0)" ::: "memory"); if (lane == 0) (void)__hip_atomic_fetch_add(ctl + CW_W1CNT, 1u, __ATOMIC_RELAXED, __HIP_MEMORY_SCOPE_AGENT); continue; } r -= I1;
            if (r < I2) { const int nblk = DM / 32, kb = r / nblk, nb = r % nblk;
                const int n0 = 32 * nb, pn = n0 >> 8, p = n0 & 255, bj = p >> 7, wc = (p & 127) >> 5;
                transpose_item(args.in[15], DM, 256 * pn + 64 * wc + 32 * bj, DM, 64 * kb, W2, n0, args.in[10], 127, 1.0f - LAM_INIT, 512, scr, lane); continue; } r -= I2;
            if (r < I3) { const int nblk = 2 * DFF / 32, kb = r / nblk, nb = r % nblk, n0 = 32 * nb, pn = n0 >> 8, p = n0 & 255, bj = p >> 7, e0 = p & 127;
                absmax_item(bj ? args.in[18] : args.in[17], DFF, 128 * pn + e0, 64 * kb, ctl + CW_WMAX + n0, args.in[16], lane); continue; } r -= I3;
            { const int nblk = DM / 32, kb = r / nblk, nb = r % nblk;
                absmax_item(args.in[21], DM, 32 * nb, 64 * kb, ctl + CW_WMAX4 + 32 * nb, nullptr, lane); }
        }
        for (int m = gw; m < NTOK; m += 4 * NGW) {
            f32x4 v[4][4]; float ss[4]; int mr[4];
#pragma unroll
            for (int q = 0; q < 4; ++q) { int mm = m + q * NGW; mr[q] = mm; if (mm >= NTOK) mm = m;
                const float* xr = mm < TOK_P ? xp + (size_t)mm * DM : xs + (size_t)(mm - TOK_P) * DM;
#pragma unroll
                for (int j = 0; j < 4; ++j) v[q][j] = __builtin_nontemporal_load((const f32x4*)xr + 64 * j + lane); }
#pragma unroll
            for (int q = 0; q < 4; ++q) { ss[q] = 0.f;
#pragma unroll
                for (int j = 0; j < 4; ++j) ss[q] += dot4(v[q][j]); }
#pragma unroll
            for (int o = 1; o < 64; o <<= 1) {
#pragma unroll
                for (int q = 0; q < 4; ++q) ss[q] += __shfl_xor(ss[q], o); }
            float am[4];
#pragma unroll
            for (int q = 0; q < 4; ++q) { float a = 0.f;
#pragma unroll
                for (int j = 0; j < 4; ++j) a = __builtin_fmaxf(__builtin_fmaxf(a, __builtin_fmaxf(__builtin_fabsf(v[q][j][0]), __builtin_fabsf(v[q][j][1]))), __builtin_fmaxf(__builtin_fabsf(v[q][j][2]), __builtin_fabsf(v[q][j][3])));
                am[q] = a; }
#pragma unroll
            for (int o = 1; o < 64; o <<= 1) {
#pragma unroll
                for (int q = 0; q < 4; ++q) am[q] = __builtin_fmaxf(am[q], __shfl_xor(am[q], o)); }
#pragma unroll
            for (int q = 0; q < 4; ++q) if (mr[q] < NTOK) { const float ms = ss[q] * (1.f / DM) + EPS; const float r = __builtin_amdgcn_rsqf(ms);
                { const float inv = am[q] > 0.f ? 127.0f / am[q] : 0.f;
                  unsigned* oq = (unsigned*)(XQ + (size_t)mr[q] * DM) + lane;
#pragma unroll
                  for (int j = 0; j < 4; ++j) oq[64 * j] = q4(v[q][j][0] * inv, v[q][j][1] * inv, v[q][j][2] * inv, v[q][j][3] * inv);
                  if (lane == 0) { FX[mr[q]] = am[q] * r * (1.0f / 127.0f); ((float*)(ws + WS_X0S))[mr[q]] = am[q] * (1.0f / 127.0f); } }
            }
        }
        { unsigned sp = 0; while (__builtin_amdgcn_readfirstlane(__hip_atomic_load(ctl + CW_W1CNT, __ATOMIC_RELAXED, __HIP_MEMORY_SCOPE_AGENT)) < (unsigned)I1) { __builtin_amdgcn_s_sleep(2); if (++sp > (1u << 22)) break; }
          __builtin_amdgcn_fence(__ATOMIC_ACQUIRE, "agent"); }
        for (int r = gw; r < I1; r += NGW) { const int nblk = DIN / 32, kb = r / nblk, nb = r % nblk, n0 = 32 * nb, pn = n0 >> 8, p = n0 & 255, bj = p >> 7, wc = (p & 127) >> 5;
            quant_item(args.in[3], DIN, 256 * pn + 64 * wc + 32 * bj, DM, 64 * kb, W1Q, n0, args.in[2], ctl + CW_WMAX1 + n0, scr, lane); }
        if (BOTH(0)) GRID_BAR();
    }

    if (IN(1)) {
        { const int dl = (bx & 7) * 3; for (int k = 0; k < dl; ++k) __builtin_amdgcn_s_sleep(16); }
        pg8::Gemm g{(const bf16_t*)XQ, (const bf16_t*)W1Q, DM / 2, 256}; pg8::StaticOrder S; S.init(NTOK / 256, DIN / 256, G, bx);
        { LAS float* gl = (LAS float*)(lds + EPX_OFF);
          if (tid < 256) { const int v = tid >> 6, d = tid & 63; gl[tid] = (v == 0 ? args.in[4] : v == 1 ? args.in[5] : v == 2 ? args.in[11] : args.in[12])[d]; }
          LDS_WAIT(); __syncthreads(); }
        pg8::EpiProj E{PROJ, (const LAS float*)(lds + EPX_OFF), FX, (const float*)(ctl + CW_WMAX1)};
        pg8::gemm_phase<pg8::EpiProj, pg8::StaticOrder, true, true, 1>(lds, g, S, E);
        if (BOTH(1)) GROUP_BAR();
    }

    if (IN(2)) {
        if (wave == 0) {
            const float a = args.in[6][lane] * args.in[7][lane], b2 = args.in[8][lane] * args.in[9][lane];
            const float sa = wave_sum(a), sb = wave_sum(b2);
            if (lane == 0) ((LAS float*)(lds + MISC_OFF))[16] = __expf(sa) - __expf(sb) + LAM_INIT;
        }
        LDS_WAIT(); __syncthreads();
        const float lam = ((const LAS float*)(lds + MISC_OFF))[16];
        const int per = (768 + G - 1) / G;
#ifndef NO_DIFF
        for (int i = 0; i < per; ++i) { const int u = vcu * per + i; if (u < 768) { const int bh = u >> 3, qb = u & 7;
            att::diff_unit(bh >> 2, bh & 3, qb, PROJ, OB, (LAS char*)lds, lam, args.in[14]); } }
#endif
#ifndef NO_WIN
        for (int i = 0; i < per; ++i) { const int u = vcu * per + i; if (u < 768) { const int bk = u >> 4, qb = u & 15;
            att::win_unit(bk >> 1, bk & 1, qb, PROJ, OB, (LAS char*)lds, args.in[14], args.in[13]); } }
#endif
        if (BOTH(2)) GROUP_BAR();
    }

    if (IN(3)) {
        pg8::Gemm g{OB, W2, DM, 256}; pg8::StaticOrder S; S.init(NTOK / 256, DM / 256, G, bx);
        {
            LAS float* scr = (LAS float*)(lds + wave * 16384);
            const int gw = vcu * NWAVES + wave, NGW = G * NWAVES;
            constexpr int I3 = (DM / 64) * (2 * DFF / 32);
            for (int r = gw; r < I3; r += NGW) { const int nblk = 2 * DFF / 32, kb = r / nblk, nb = r % nblk, n0 = 32 * nb, pn = n0 >> 8, p = n0 & 255, bj = p >> 7, e0 = p & 127;
                quant_item(bj ? args.in[18] : args.in[17], DFF, 128 * pn + e0, DM, 64 * kb, (signed char*)(ws + WS_W3), n0, args.in[16], ctl + CW_WMAX + n0, scr, lane); }
            constexpr int I4 = (DFF / 64) * (DM / 32);
            for (int r = gw; r < I4; r += NGW) { const int nblk = DM / 32, kb = r / nblk, nb = r % nblk;
                quantf8_item(args.in[21], DM, 32 * nb, DFF, 64 * kb, (unsigned char*)(ws + WS_W4), 32 * nb, ctl + CW_WMAX4 + 32 * nb, scr, lane); }
            __syncthreads();
        }
        pg8::EpiOut E{(const signed char*)(ws + WS_XQ), (const float*)(ws + WS_X0S), (float*)(ws + WS_FX), (LAS float*)(lds + EPX_OFF), (signed char*)(ws + WS_X1Q), (float*)(ws + WS_FA), (float*)(ws + WS_XS), ctl + CW_P3CNT};
        pg8::gemm_phase<pg8::EpiOut, pg8::StaticOrder>(lds, g, S, E);
        if (BOTH(3)) GRID_BAR();
    }

    if (IN(4)) {
        signed char* W3Q = (signed char*)(ws + WS_W3); signed char* X1Q = (signed char*)(ws + WS_X1Q); float* FA = (float*)(ws + WS_FA);
        pg8::Gemm g{(const bf16_t*)(X1Q - DM), (const bf16_t*)W3Q, DM / 2, 254}; pg8::StaticOrder S; S.init(194, 2 * DFF / 256, G, bx);
        pg8::EpiFfn E{(unsigned char*)ACT, FA, (const float*)(ctl + CW_WMAX), args.in[19], args.in[20], (LAS float*)(lds + EPX_OFF)};
        pg8::gemm_phase<pg8::EpiFfn, pg8::StaticOrder, true, true, 1>(lds, g, S, E);
        if (BOTH(4)) GRID_BAR();
    }

    if (IN(5)) {
        pg8::Gemm g{ACT, W4, DFF / 2, 256}; pg8::StaticOrder S; S.init(NTOK / 256, DM / 256, G, bx, 1);
        pg8::EpiDown E{(const signed char*)(ws + WS_X1Q), (const float*)(ws + WS_FX), args.out, (const float*)(ctl + CW_WMAX4)};
        pg8::gemm_phase<pg8::EpiDown, pg8::StaticOrder, true, true, 2>(lds, g, S, E);
    }
#undef IN
#undef BOTH
#undef GRID_BAR
}

extern "C" void kernel_launch(void* const* d_in, const int* in_sizes, int n_in, void* d_out, int out_size, void* d_ws, size_t ws_size, hipStream_t stream) {
    static int grid = 0;
    if (grid == 0) {
        if (n_in != 22 || in_sizes[0] != TOK_P * DM || in_sizes[1] != (NTOK - TOK_P) * DM || out_size != NTOK * DM || ws_size < WS_END) {
            fprintf(stderr, "kernel_launch: shape mismatch (n_in %d, in0 %d, in1 %d, out %d, ws %zu; need ws >= %zu)\n", n_in, n_in > 0 ? in_sizes[0] : -1, n_in > 1 ? in_sizes[1] : -1, out_size, ws_size, (size_t)WS_END); grid = -1; return; }
        int dev = 0, cus = 0;
        if (hipGetDevice(&dev) != hipSuccess || hipDeviceGetAttribute(&cus, hipDeviceAttributeMultiprocessorCount, dev) != hipSuccess) { fprintf(stderr, "kernel_launch: device query failed\n"); grid = -1; return; }
        if (hipFuncSetAttribute((const void*)hymba_fwd, hipFuncAttributeMaxDynamicSharedMemorySize, LDS_BYTES) != hipSuccess) { fprintf(stderr, "kernel_launch: hipFuncSetAttribute failed\n"); grid = -1; return; }
        int per_cu = 0;
        if (hipOccupancyMaxActiveBlocksPerMultiprocessor(&per_cu, (const void*)hymba_fwd, NWAVES * 64, LDS_BYTES) != hipSuccess || per_cu < 1)
            fprintf(stderr, "kernel_launch: note: occupancy query reports %d workgroups per CU\n", per_cu);
        (void)hipGetLastError();
        if (cus < 256) { fprintf(stderr, "kernel_launch: %d CUs; this kernel's unit schedule (co-running tile owners in the out-projection epilogue) is built for 256\n", cus); grid = -1; return; }
        grid = 256;
    }
    if (grid < 0) return;
    (void)hipMemsetAsync((char*)d_ws + WS_CTL, 0, CTL_ZERO_BYTES, stream);
    Args a{};
    for (int i = 0; i < 22; ++i) a.in[i] = (const float*)d_in[i];
    a.out = (float*)d_out; a.ws = (unsigned char*)d_ws;
#ifndef PROBE_DUP
#define PROBE_DUP -1
#endif
    constexpr int NL = (PROBE_DUP >= 0) ? 3 : MK_N_LAUNCHES;
    for (int li = 0; li < NL; ++li) {
        if (PROBE_DUP >= 0) {
            a.ph_lo = li == 0 ? 0 : (li == 1 ? PROBE_DUP : PROBE_DUP + 1); a.ph_hi = li == 2 ? 6 : PROBE_DUP + 1; a.li = li;
        } else { a.ph_lo = (NL == 6) ? li : 0; a.ph_hi = (NL == 6) ? li + 1 : 6; a.li = (NL == 6) ? 0 : li; }
        hipLaunchKernelGGL(hymba_fwd, dim3(grid), dim3(NWAVES * 64), LDS_BYTES, stream, a);
        const hipError_t le = hipPeekAtLastError();
        if (le != hipSuccess) { fprintf(stderr, "kernel_launch: launch %d failed: %s\n", li, hipGetErrorName(le)); break; }
    }
}
```

```cpp
#include <hip/hip_runtime.h>
#include <hip/hip_bf16.h>
#include <cstdio>
#include <cstdint>

#ifndef MK_N_LAUNCHES
#define MK_N_LAUNCHES 1
#endif

#define LAS __attribute__((address_space(3)))
#define GAS __attribute__((address_space(1)))
typedef unsigned short bf16_t;
typedef short bf16x8 __attribute__((ext_vector_type(8)));
typedef short s16x4 __attribute__((ext_vector_type(4)));
typedef float f32x2 __attribute__((ext_vector_type(2)));
typedef float f32x4 __attribute__((ext_vector_type(4)));
typedef float f32x16 __attribute__((ext_vector_type(16)));
typedef unsigned u32x2 __attribute__((ext_vector_type(2)));
typedef unsigned u32x4 __attribute__((ext_vector_type(4)));
typedef __bf16 bf16x2_t __attribute__((ext_vector_type(2)));

constexpr int DM = 1024, SEQ = 2048, NSEQ = 24, NTOK = NSEQ * SEQ, TOK_P = 8 * SEQ;
constexpr int DIN = 2304, DFF = 2816;
constexpr int C_DQ = 0, C_DK = 512, C_DV = 1024, C_WQ = 1536, C_WK = 2048, C_WV = 2176;
constexpr int NBH = 12;
constexpr float EPS = 1e-6f, LOG2E = 1.4426950408889634f, QSCALE = 0.125f * LOG2E;
constexpr float LAM_INIT = 0.2f;
constexpr int NWAVES = 8;

__device__ __forceinline__ unsigned cvtpk(float lo, float hi) { f32x2 v = {lo, hi}; bf16x2_t b = __builtin_convertvector(v, bf16x2_t); return __builtin_bit_cast(unsigned, b); }
__device__ __forceinline__ u32x4 pack8(f32x4 a, f32x4 b) { u32x4 w; w.x = cvtpk(a[0], a[1]); w.y = cvtpk(a[2], a[3]); w.z = cvtpk(b[0], b[1]); w.w = cvtpk(b[2], b[3]); return w; }
__device__ __forceinline__ float dot4(f32x4 a) { return (a[0] * a[0] + a[1] * a[1]) + (a[2] * a[2] + a[3] * a[3]); }

__device__ __forceinline__ unsigned q4(float a, float b, float c, float d) {
    const unsigned ua = __float_as_uint(a + 12582912.0f), ub = __float_as_uint(b + 12582912.0f), uc = __float_as_uint(c + 12582912.0f), ud = __float_as_uint(d + 12582912.0f);
    return (ua & 0xffu) | ((ub & 0xffu) << 8) | ((uc & 0xffu) << 16) | (ud << 24);
}
__device__ __forceinline__ unsigned f8x4(float a, float b, float c, float d) {
    int w = 0;
    w = __builtin_amdgcn_cvt_pk_fp8_f32(__builtin_amdgcn_fmed3f(a, -448.f, 448.f), __builtin_amdgcn_fmed3f(b, -448.f, 448.f), w, false);
    w = __builtin_amdgcn_cvt_pk_fp8_f32(__builtin_amdgcn_fmed3f(c, -448.f, 448.f), __builtin_amdgcn_fmed3f(d, -448.f, 448.f), w, true);
    return (unsigned)w;
}
constexpr float ACT8_SCALE = 8.0f, W8_TOP = 224.0f;
namespace pg8 {
constexpr int BM = 256, BK = 64, HALF = 128, HTB = HALF * BK * 2, STAGE_BYTES = 8 * HTB, NXCD = 8, WGM = 8;
__host__ __device__ __forceinline__ int lds_byte(int r, int c) { const int st = (r >> 4) * 2 + (c >> 5), rr = r & 15, cc = c & 31, ob = rr * 64 + cc * 2; return st * 1024 + (ob ^ (((ob >> 9) & 1) << 5)); }
__host__ __device__ __forceinline__ void stage_rc(int b, int& R, int& C) { const int st = b / 1024, sb = b % 1024, swz = sb ^ (((sb >> 9) & 1) << 5); R = (st >> 1) * 16 + swz / 64; C = (st & 1) * 32 + (swz % 64) / 2; }
__host__ __device__ __forceinline__ int perm32(int rho) { const int n = rho >> 4, i = rho & 15; return 8 * (i >> 2) + 4 * n + (i & 3); }

typedef int v4i32_t __attribute__((ext_vector_type(4)));
struct Unit { int pm, pn; };
struct Gemm { const bf16_t* A; const bf16_t* Bt; int K; int arows; };

struct StaticOrder {
    int nM, nN, nwg, G, c, rev;
    __device__ void init(int nM_, int nN_, int G_, int c_, int rev_ = 0) { nM = nM_; nN = nN_; nwg = nM * nN; G = G_; c = c_; rev = rev_; }
    __device__ bool next(int i, Unit& u) const {
        const int nr = (nwg - c + G - 1) / G; if (i >= nr) return false;
        const long L = (long)(rev ? nr - 1 - i : i) * G + c;
        int wgid = (int)L; { const int q = nwg / NXCD, r = nwg % NXCD, xcd = wgid % NXCD, off = wgid / NXCD; wgid = (xcd < r ? xcd * (q + 1) : r * (q + 1) + (xcd - r) * q) + off; }
        const int nig = WGM * nN, gid = wgid / nig, fm = gid * WGM, gsz = (nM - fm) < WGM ? (nM - fm) : WGM;
        u.pm = fm + ((wgid % nig) % gsz); u.pn = (wgid % nig) / gsz; return true;
    }
};


struct EpiProj {
    static constexpr bool PERM = true;
    bf16_t* P; const LAS float* gl; const float* fx; const float* swm;
    __device__ __forceinline__ void pre(const Unit& u, int wid, int lane_) const {
        int lane = lane_; asm volatile("" : "+v"(lane));
        if (wid >= 4) __builtin_amdgcn_global_load_lds((const unsigned*)(fx + u.pm * BM + 64 * (wid - 4) + lane), (LAS unsigned*)((LAS char*)gl + 1024 + (wid - 4) * 256), 4, 0, 0);
        if (wid == 2) __builtin_amdgcn_global_load_lds((const unsigned*)(swm + u.pn * 256 + lane * 4), (LAS unsigned*)((LAS char*)gl + 2048), 16, 0, 0);
    }
    __device__ __forceinline__ void operator()(const f32x4 (&acc)[2][2][4][2], const Unit& u, int wr, int wc, int fr, int fq, int lane) const {
        int fql = fq; asm volatile("" : "+v"(fql));
        f32x4 csw[2][2];
#pragma unroll
        for (int bj = 0; bj < 2; ++bj)
#pragma unroll
            for (int n = 0; n < 2; ++n) csw[bj][n] = *(const LAS f32x4*)(gl + 512 + 128 * bj + 32 * wc + 8 * fql + 4 * n) * (1.0f / 127.0f);
        const int gidx = u.pn * 4 + wc;
        int gsel = -1; float sc = 1.f;
        if (gidx < 8) { gsel = 0; sc = QSCALE; } else if (gidx < 16) { gsel = 1; } else if (gidx < 24) { } else if (gidx < 32) { gsel = 2; sc = QSCALE; } else if (gidx < 34) { gsel = 3; }
        const bool nrm = gsel >= 0; const LAS float* gain = gl + (nrm ? gsel : 0) * 64;
        f32x4 gv[2][2];
#pragma unroll
        for (int bj = 0; bj < 2; ++bj)
#pragma unroll
            for (int n = 0; n < 2; ++n) gv[bj][n] = nrm ? *(const LAS f32x4*)(gain + 32 * bj + 8 * fq + 4 * n) * sc : (f32x4){1.f, 1.f, 1.f, 1.f};
        bf16_t* base = P + (size_t)(u.pm * BM + wr * 64 + fr) * DIN + gidx * 64 + 8 * fq;
#pragma unroll
        for (int ai = 0; ai < 2; ++ai)
#pragma unroll
            for (int m = 0; m < 4; ++m) {
                const float fxr = gl[256 + ai * HALF + wr * 64 + m * 16 + fr];
                f32x4 v00 = __builtin_convertvector(__builtin_bit_cast(v4i32_t, acc[ai][0][m][0]), f32x4) * (csw[0][0] * fxr), v01 = __builtin_convertvector(__builtin_bit_cast(v4i32_t, acc[ai][0][m][1]), f32x4) * (csw[0][1] * fxr);
                f32x4 v10 = __builtin_convertvector(__builtin_bit_cast(v4i32_t, acc[ai][1][m][0]), f32x4) * (csw[1][0] * fxr), v11 = __builtin_convertvector(__builtin_bit_cast(v4i32_t, acc[ai][1][m][1]), f32x4) * (csw[1][1] * fxr);
                float rn = 1.f;
                if (nrm) { float ss = (dot4(v00) + dot4(v01)) + (dot4(v10) + dot4(v11)); ss += __shfl_xor(ss, 16); ss += __shfl_xor(ss, 32); rn = __builtin_amdgcn_rsqf(ss * (1.0f / 64.0f) + EPS); }
                v00 = v00 * rn * gv[0][0]; v01 = v01 * rn * gv[0][1]; v10 = v10 * rn * gv[1][0]; v11 = v11 * rn * gv[1][1];
                bf16_t* rowp = base + (size_t)(ai * HALF + m * 16) * DIN;
                const u32x4 pa = pack8(v00, v01), pb = pack8(v10, v11);
                u32x4 px; px.x = (unsigned)__builtin_amdgcn_mov_dpp((int)pb.x, 0x128, 0xf, 0xf, true); px.y = (unsigned)__builtin_amdgcn_mov_dpp((int)pb.y, 0x128, 0xf, 0xf, true);
                px.z = (unsigned)__builtin_amdgcn_mov_dpp((int)pb.z, 0x128, 0xf, 0xf, true); px.w = (unsigned)__builtin_amdgcn_mov_dpp((int)pb.w, 0x128, 0xf, 0xf, true);
                const bool hi8 = (fr & 8) != 0;
                bf16_t* r1p = base + (size_t)(ai * HALF + m * 16 - (hi8 ? 8 : 0)) * DIN + (hi8 ? 32 : 0);
                bf16_t* r2p = base + (size_t)(ai * HALF + m * 16 + (hi8 ? 0 : 8)) * DIN + (hi8 ? 0 : 32);
                *(u32x4*)(r1p) = hi8 ? px : pa; *(u32x4*)(r2p) = hi8 ? pa : px;
            }
    }
};

struct EpiOut {
    static constexpr bool PERM = true;
    const signed char* xq0; const float* __restrict__ sx0; float* __restrict__ sx1; LAS float* xl;
    signed char* x1q; float* fa; float* xs; unsigned* cnt;
    __device__ __forceinline__ void pre(const Unit&, int, int) const {}
    __device__ __forceinline__ void operator()(f32x4 (&acc)[2][2][4][2], const Unit& u, int wr, int wc, int fr, int fq, int lane) const {
        asm volatile("" : "+v"(fr), "+v"(fq));
        const int rowbase = u.pm * BM;
        const int col0 = u.pn * BM + wc * 64 + 8 * fq;
#pragma unroll
        for (int ai = 0; ai < 2; ++ai) {
            u32x2 xv[4][2]; float s0[4];
#pragma unroll
            for (int m = 0; m < 4; ++m) { const size_t row = (size_t)(rowbase + ai * HALF + wr * 64 + m * 16 + fr); const signed char* xr = xq0 + row * DM + col0;
                s0[m] = sx0[row];
#pragma unroll
                for (int bj = 0; bj < 2; ++bj) xv[m][bj] = *(const u32x2*)(xr + bj * 32); }
#pragma unroll
            for (int m = 0; m < 4; ++m) {
                const int rl = ai * HALF + wr * 64 + m * 16 + fr; float s = 0.f, am = 0.f;
#pragma unroll
                for (int bj = 0; bj < 2; ++bj) {
                    const int wx = (int)xv[m][bj].x, wy = (int)xv[m][bj].y; f32x4 x0, x1;
                    x0[0] = (float)((wx << 24) >> 24); x0[1] = (float)((wx << 16) >> 24); x0[2] = (float)((wx << 8) >> 24); x0[3] = (float)(wx >> 24);
                    x1[0] = (float)((wy << 24) >> 24); x1[1] = (float)((wy << 16) >> 24); x1[2] = (float)((wy << 8) >> 24); x1[3] = (float)(wy >> 24);
                    const f32x4 o0 = x0 * s0[m] + acc[ai][bj][m][0], o1 = x1 * s0[m] + acc[ai][bj][m][1];
                    acc[ai][bj][m][0] = o0; acc[ai][bj][m][1] = o1;
#pragma unroll
                    for (int i = 0; i < 4; ++i) am = __builtin_fmaxf(am, __builtin_fmaxf(__builtin_fabsf(o0[i]), __builtin_fabsf(o1[i])));
                    s += dot4(o0) + dot4(o1); }
                s += __shfl_xor(s, 16); s += __shfl_xor(s, 32);
                am = __builtin_fmaxf(am, __shfl_xor(am, 16)); am = __builtin_fmaxf(am, __shfl_xor(am, 32));
                if (fq == 0) { xl[rl * 8 + wc] = s; xl[rl * 8 + 4 + wc] = am; }
            }
        }
        asm volatile("s_waitcnt lgkmcnt(0)" ::: "memory"); __builtin_amdgcn_s_barrier(); asm volatile("" ::: "memory");
        const int t = (wr * 4 + wc) * 64 + lane;
        if (t < 256) {
            const f32x4 q = *(const LAS f32x4*)(xl + t * 8), a4 = *(const LAS f32x4*)(xl + t * 8 + 4);
            float* sl = xs + ((size_t)(rowbase + t) * 4 + u.pn) * 2;
            __hip_atomic_store(sl, (q[0] + q[1]) + (q[2] + q[3]), __ATOMIC_RELAXED, __HIP_MEMORY_SCOPE_AGENT);
            __hip_atomic_store(sl + 1, __builtin_fmaxf(__builtin_fmaxf(a4[0], a4[1]), __builtin_fmaxf(a4[2], a4[3])), __ATOMIC_RELAXED, __HIP_MEMORY_SCOPE_AGENT);
            asm volatile("s_waitcnt vmcnt(0)" ::: "memory");
            if (lane == 0) (void)__hip_atomic_fetch_add(cnt + u.pm, 1u, __ATOMIC_RELAXED, __HIP_MEMORY_SCOPE_AGENT);
        }
        if (t < 64) {
            unsigned sp = 0; while (__builtin_amdgcn_readfirstlane(__hip_atomic_load(cnt + u.pm, __ATOMIC_RELAXED, __HIP_MEMORY_SCOPE_AGENT)) < 16u) { __builtin_amdgcn_s_sleep(1); if (++sp > (1u << 22)) break; }
        }
        asm volatile("s_waitcnt lgkmcnt(0)" ::: "memory"); __builtin_amdgcn_s_barrier(); asm volatile("" ::: "memory");
        if (t < 256) {
            const float* sl = xs + (size_t)(rowbase + t) * 8; float ss = 0.f, am = 0.f;
#pragma unroll
            for (int j = 0; j < 4; ++j) { ss += __hip_atomic_load(sl + 2 * j, __ATOMIC_RELAXED, __HIP_MEMORY_SCOPE_AGENT); am = __builtin_fmaxf(am, __hip_atomic_load(sl + 2 * j + 1, __ATOMIC_RELAXED, __HIP_MEMORY_SCOPE_AGENT)); }
            xl[2048 + t] = am > 0.f ? 127.0f / am : 0.f;
            if (u.pn == 0) { fa[rowbase + t] = __builtin_amdgcn_rsqf(ss * (1.0f / DM) + EPS) * am * (1.0f / 127.0f); sx1[rowbase + t] = am * (1.0f / 127.0f); }
        }
        asm volatile("s_waitcnt lgkmcnt(0)" ::: "memory"); __builtin_amdgcn_s_barrier(); asm volatile("" ::: "memory");
#pragma unroll
        for (int ai = 0; ai < 2; ++ai)
#pragma unroll
            for (int m = 0; m < 4; ++m) { const int rl = ai * HALF + wr * 64 + m * 16 + fr; const float inv = xl[2048 + rl];
                signed char* qp = x1q + (size_t)(rowbase + rl) * DM + col0;
#pragma unroll
                for (int bj = 0; bj < 2; ++bj) { const f32x4 b0 = acc[ai][bj][m][0] * inv, b1 = acc[ai][bj][m][1] * inv;
                    u32x2 o; o.x = q4(b0[0], b0[1], b0[2], b0[3]); o.y = q4(b1[0], b1[1], b1[2], b1[3]);
                    *(u32x2*)(qp + 32 * bj) = o; } }
    }
};

__device__ __forceinline__ float dpp8(float x) { return __builtin_bit_cast(float, __builtin_amdgcn_mov_dpp(__builtin_bit_cast(int, x), 0x128, 0xf, 0xf, true)); }
struct EpiDown {
    static constexpr bool PERM = true;
    const signed char* __restrict__ x1q; const float* __restrict__ sx1; float* __restrict__ out; const float* __restrict__ wmx;
    __device__ __forceinline__ void pre(const Unit&, int, int) const {}
    __device__ __forceinline__ void operator()(const f32x4 (&acc)[2][2][4][2], const Unit& u, int wr, int wc, int fr, int fq, int lane) const {
        asm volatile("" : "+v"(fr), "+v"(fq));
        const int col0 = u.pn * BM + wc * 32 + 8 * fq; const bool hi8 = (fr & 8) != 0;
        f32x4 cs[2][2];
#pragma unroll
        for (int bj = 0; bj < 2; ++bj)
#pragma unroll
            for (int n = 0; n < 2; ++n) cs[bj][n] = *(const f32x4*)(wmx + col0 + bj * HALF + 4 * n) * (1.0f / (W8_TOP * ACT8_SCALE));
#pragma unroll
        for (int ai = 0; ai < 2; ++ai) {
            u32x2 w[4][2]; float sx[4];
#pragma unroll
            for (int m = 0; m < 4; ++m) { const size_t row = (size_t)(u.pm * BM + ai * HALF + wr * 64 + m * 16 + fr); const size_t off = row * DM + col0;
                sx[m] = sx1[row];
#pragma unroll
                for (int bj = 0; bj < 2; ++bj) w[m][bj] = *(const u32x2*)(x1q + off + bj * HALF); }
#pragma unroll
            for (int m = 0; m < 4; ++m) { const size_t off = (size_t)(u.pm * BM + ai * HALF + wr * 64 + m * 16 + fr) * DM + col0;
#pragma unroll
                for (int bj = 0; bj < 2; ++bj) { const int wx = (int)w[m][bj].x, wy = (int)w[m][bj].y;
                    f32x4 r0, r1;
                    r0[0] = (float)((wx << 24) >> 24) * sx[m]; r0[1] = (float)((wx << 16) >> 24) * sx[m]; r0[2] = (float)((wx << 8) >> 24) * sx[m]; r0[3] = (float)(wx >> 24) * sx[m];
                    r1[0] = (float)((wy << 24) >> 24) * sx[m]; r1[1] = (float)((wy << 16) >> 24) * sx[m]; r1[2] = (float)((wy << 8) >> 24) * sx[m]; r1[3] = (float)(wy >> 24) * sx[m];
                    const f32x4 q0 = r0 + acc[ai][bj][m][0] * cs[bj][0], q1 = r1 + acc[ai][bj][m][1] * cs[bj][1];
                    f32x4 qx; qx[0] = dpp8(q1[0]); qx[1] = dpp8(q1[1]); qx[2] = dpp8(q1[2]); qx[3] = dpp8(q1[3]);
                    const long d1 = hi8 ? (long)(4 - 8 * DM) : 0, d2 = hi8 ? 0 : (long)(4 + 8 * DM);
                    *(f32x4*)(out + off + bj * HALF + d1) = hi8 ? qx : q0; *(f32x4*)(out + off + bj * HALF + d2) = hi8 ? q0 : qx; } } }
    }
};

template <int CTRL> __device__ __forceinline__ float dppz(float x) { return __builtin_bit_cast(float, __builtin_amdgcn_update_dpp(0, __builtin_bit_cast(int, x), CTRL, 0xf, 0xf, true)); }
struct EpiFfn {
    static constexpr bool PERM = true;
    unsigned char* act; const float* fa; const float* swm; const float* cw; const float* cb; LAS float* xl;
    __device__ __forceinline__ void pre(const Unit& u, int wid, int lane_) const {
        int lane = lane_; asm volatile("" : "+v"(lane));
        const int tok0 = 254 * u.pm - 1;
        if (wid >= 4) { int tok = tok0 + 64 * (wid - 4) + lane; tok = tok < 0 ? 0 : (tok > NTOK - 1 ? NTOK - 1 : tok);
            __builtin_amdgcn_global_load_lds((const unsigned*)(fa + tok), (LAS unsigned*)((LAS char*)xl + 4096 + (wid - 4) * 256), 4, 0, 0); }
        if (wid == 2) __builtin_amdgcn_global_load_lds((const unsigned*)(swm + u.pn * 256 + lane * 4), (LAS unsigned*)((LAS char*)xl + 5120), 16, 0, 0);
        if (wid < 2) { const float* src = (wid == 0 ? (lane < 32 ? cw : cw + DFF) : (lane < 32 ? cw + 2 * DFF : cb)) + u.pn * 128 + (lane & 31) * 4;
            __builtin_amdgcn_global_load_lds((const unsigned*)src, (LAS unsigned*)((LAS char*)xl + 20480 + wid * 1024), 16, 0, 0); }
    }
    template <int AI, int M, bool MASK>
    __device__ __forceinline__ void conv_rows(const f32x4 (&acc)[2][2][4][2], const f32x4 (&w0)[2], const f32x4 (&w1)[2], const f32x4 (&w2)[2], const f32x4 (&bb)[2],
                                              int tok, int rl, int G, int xc, int fr, int ch0) const {
        const bool pcut = MASK && (tok & (SEQ - 1)) == 0, ncut = MASK && (tok & (SEQ - 1)) == SEQ - 1;
        f32x4 r0, r1;
#pragma unroll
        for (int n = 0; n < 2; ++n) { f32x4 res;
            f32x4 ex = (f32x4){0.f, 0.f, 0.f, 0.f};
            if (M == 0) { if (G > 0) ex = *(const LAS f32x4*)(xl + (2 * (G - 1) + 1) * 128 + xc + 4 * n); ex = fr == 0 ? ex : (f32x4){0.f, 0.f, 0.f, 0.f}; }
            if (M == 3) { if (G < 3) ex = *(const LAS f32x4*)(xl + (2 * (G + 1)) * 128 + xc + 4 * n); ex = fr == 15 ? ex : (f32x4){0.f, 0.f, 0.f, 0.f}; }
#pragma unroll
            for (int i = 0; i < 4; ++i) {
                const float own = acc[AI][0][M][n][i];
                float pr = dppz<0x111>(own);
                pr += (M > 0) ? dppz<0x10F>(acc[AI][0][M > 0 ? M - 1 : 0][n][i]) : ex[i];
                float nx = dppz<0x101>(own);
                nx += (M < 3) ? dppz<0x11F>(acc[AI][0][M < 3 ? M + 1 : 3][n][i]) : ex[i];
                if (MASK) { pr = pcut ? 0.f : pr; nx = ncut ? 0.f : nx; }
                const float uc = fmaf(w0[n][i], pr, fmaf(w1[n][i], own, fmaf(w2[n][i], nx, bb[n][i])));
                const float sg = uc * __builtin_amdgcn_rcpf(1.0f + __builtin_amdgcn_exp2f(-LOG2E * uc));
                res[i] = sg * acc[AI][1][M][n][i] * ACT8_SCALE;
            }
            if (n == 0) r0 = res; else r1 = res; }
        if (rl != 0 && rl != 255 && tok < NTOK) { u32x2 o; o.x = f8x4(r0[0], r0[1], r0[2], r0[3]); o.y = f8x4(r1[0], r1[1], r1[2], r1[3]); *(u32x2*)(act + (size_t)tok * DFF + ch0) = o; }
    }
    __device__ __forceinline__ void operator()(f32x4 (&acc)[2][2][4][2], const Unit& u, int wr, int wc, int fr, int fq, int lane) const {
        const int ch0 = u.pn * 128 + wc * 32 + 8 * fq;
        const int tok0 = 254 * u.pm - 1;
        int fql = fq; asm volatile("" : "+v"(fql));
        const int xc = wc * 32 + 8 * fql;
        f32x4 su[2];
#pragma unroll
        for (int n = 0; n < 2; ++n) su[n] = *(const LAS f32x4*)(xl + 1280 + 128 + xc + 4 * n) * (1.0f / 127.0f);
#pragma unroll
        for (int ai = 0; ai < 2; ++ai)
#pragma unroll
            for (int m = 0; m < 4; ++m) { const float rs = xl[1024 + ai * HALF + wr * 64 + m * 16 + fr];
#pragma unroll
                for (int n = 0; n < 2; ++n) { const f32x4 rsu = su[n] * rs;
                    acc[ai][0][m][n] = __builtin_convertvector(__builtin_bit_cast(v4i32_t, acc[ai][0][m][n]), f32x4) * rs;
                    acc[ai][1][m][n] = __builtin_convertvector(__builtin_bit_cast(v4i32_t, acc[ai][1][m][n]), f32x4) * rsu; } }
#pragma unroll
        for (int ai = 0; ai < 2; ++ai) { const int G = 2 * ai + wr;
            if (fr == 0) { *(LAS f32x4*)(xl + (2 * G) * 128 + xc) = acc[ai][0][0][0]; *(LAS f32x4*)(xl + (2 * G) * 128 + xc + 4) = acc[ai][0][0][1]; }
            if (fr == 15) { *(LAS f32x4*)(xl + (2 * G + 1) * 128 + xc) = acc[ai][0][3][0]; *(LAS f32x4*)(xl + (2 * G + 1) * 128 + xc + 4) = acc[ai][0][3][1]; } }
        asm volatile("s_waitcnt lgkmcnt(0)" ::: "memory"); __builtin_amdgcn_s_barrier(); asm volatile("" ::: "memory"); __builtin_amdgcn_sched_barrier(0);
        f32x4 w0[2], w1[2], w2[2], bb[2];
#pragma unroll
        for (int n = 0; n < 2; ++n) { const LAS float* wl = xl + 5120 + xc + 4 * n; const f32x4 sgc = *(const LAS f32x4*)(xl + 1280 + xc + 4 * n) * (1.0f / 127.0f);
            w0[n] = *(const LAS f32x4*)(wl) * sgc; w1[n] = *(const LAS f32x4*)(wl + 128) * sgc; w2[n] = *(const LAS f32x4*)(wl + 256) * sgc; bb[n] = *(const LAS f32x4*)(wl + 384); }
#define FFN_ROWS(AI, M) do { const int tb_ = tok0 + AI * HALF + wr * 64 + M * 16; const int G_ = 2 * AI + wr; \
        conv_rows<AI, M, true>(acc, w0, w1, w2, bb, tb_ + fr, AI * HALF + wr * 64 + M * 16 + fr, G_, xc, fr, ch0); \
        if ((M) & 1) __builtin_amdgcn_sched_barrier(0); } while (0)
        FFN_ROWS(0, 0); FFN_ROWS(0, 1); FFN_ROWS(0, 2); FFN_ROWS(0, 3); FFN_ROWS(1, 0); FFN_ROWS(1, 1); FFN_ROWS(1, 2); FFN_ROWS(1, 3);
#undef FFN_ROWS
    }
};

typedef int v8i32_t __attribute__((ext_vector_type(8)));
template <class Epi, class Sched, bool ALIGN_EPI = true, bool SP2 = true, int QM = 0>
__device__ __forceinline__ void gemm_phase(LAS unsigned char* lds, const Gemm g, const Sched& S, const Epi& E) {
    const int tid = threadIdx.x, wid = __builtin_amdgcn_readfirstlane(tid >> 6), lane = tid & 63, wr = wid >> 2, wc = wid & 3, fr = lane & 15, fq = lane >> 4;
    const int K = g.K, nt = K / BK;
    unsigned voffA[2], voffB[2];
#pragma unroll
    for (int i = 0; i < 2; ++i) { int R, C; stage_rc(tid * 16 + i * 8192, R, C); const int Rb = Epi::PERM ? ((R & ~31) + perm32(R & 31)) : R;
        voffA[i] = (unsigned)(R * K + C) * 2u; voffB[i] = (unsigned)(Rb * K + C) * 2u; }
    const size_t kstep = (size_t)(BK * 2);
    const size_t hstep = (size_t)HALF * K * 2;
    const size_t tstepB = 2 * hstep;
    const size_t tstepA = (size_t)g.arows * K * 2;
    const unsigned ldsw = (unsigned)wid * 1024u;
    const int aoff = lds_byte(wr * 64 + fr, fq * 8), boff = lds_byte(wc * 32 + fr, fq * 8);
#define PG8_SA(b, h) (((b) * 2 + (h)) * HTB)
#define PG8_SB(b, h) ((4 + (b) * 2 + (h)) * HTB)
#define PG8_STAGE(bufoff, gbase, voff) do { _Pragma("unroll") for (int _i = 0; _i < 2; ++_i) \
        __builtin_amdgcn_global_load_lds((const unsigned*)((const char*)(gbase) + (voff)[_i]), (LAS unsigned*)(lds + (bufoff) + ldsw + _i * 8192), 16, 0, 0); } while (0)
#define PG8_LDA(dst, b, h) do { _Pragma("unroll") for (int m = 0; m < 4; ++m) _Pragma("unroll") for (int k = 0; k < 2; ++k) dst[m][k] = *(const LAS bf16x8*)(lds + PG8_SA(b, h) + aoff + m * 2048 + k * 1024); } while (0)
#define PG8_LDB(dst, b, h) do { _Pragma("unroll") for (int n = 0; n < 2; ++n) _Pragma("unroll") for (int k = 0; k < 2; ++k) dst[n][k] = *(const LAS bf16x8*)(lds + PG8_SB(b, h) + boff + n * 2048 + k * 1024); } while (0)
#define PG8_MMA(ai, bj, At, Bt) do { __builtin_amdgcn_s_setprio(1); \
    if constexpr (QM == 2) { _Pragma("unroll") for (int m = 0; m < 4; ++m) _Pragma("unroll") for (int n = 0; n < 2; ++n) { \
        const v8i32_t b8_ = __builtin_shufflevector(__builtin_bit_cast(v4i32_t, Bt[n][0]), __builtin_bit_cast(v4i32_t, Bt[n][1]), 0, 1, 2, 3, 4, 5, 6, 7), a8_ = __builtin_shufflevector(__builtin_bit_cast(v4i32_t, At[m][0]), __builtin_bit_cast(v4i32_t, At[m][1]), 0, 1, 2, 3, 4, 5, 6, 7); \
        asm volatile("v_mfma_scale_f32_16x16x128_f8f6f4 %0, %1, %2, %0, %3, %3 op_sel_hi:[0,0,0]" : "+v"(acc[ai][bj][m][n]) : "v"(b8_), "v"(a8_), "v"(one8)); } } \
    else _Pragma("unroll") for (int m = 0; m < 4; ++m) _Pragma("unroll") for (int n = 0; n < 2; ++n) _Pragma("unroll") for (int k = 0; k < 2; ++k) \
        { if constexpr (QM == 1) acc[ai][bj][m][n] = __builtin_bit_cast(f32x4, __builtin_amdgcn_mfma_i32_16x16x64_i8(__builtin_bit_cast(v4i32_t, Bt[n][k]), __builtin_bit_cast(v4i32_t, At[m][k]), __builtin_bit_cast(v4i32_t, acc[ai][bj][m][n]), 0, 0, 0)); \
          else acc[ai][bj][m][n] = __builtin_amdgcn_mfma_f32_16x16x32_bf16(Bt[n][k], At[m][k], acc[ai][bj][m][n], 0, 0, 0); } __builtin_amdgcn_s_setprio(0); } while (0)
#define PG8_WAIT_V(n) asm volatile("s_waitcnt vmcnt(" #n ")" ::: "memory")
#define PG8_WAIT_L(n) asm volatile("s_waitcnt lgkmcnt(" #n ")" ::: "memory")
#define PG8_BAR __builtin_amdgcn_s_barrier()
#define PG8_SCHED __builtin_amdgcn_sched_barrier(0)
    Unit cur, nxt; int ui = 0;
    if (!S.next(0, cur)) return;
    const int one8 = 0x7f7f7f7f;
    f32x4 acc[2][2][4][2];
#pragma unroll
    for (int a = 0; a < 2; ++a)
#pragma unroll
        for (int b = 0; b < 2; ++b)
#pragma unroll
            for (int m = 0; m < 4; ++m)
#pragma unroll
                for (int n = 0; n < 2; ++n) acc[a][b][m][n] = (f32x4){0.f, 0.f, 0.f, 0.f};
    bf16x8 At[4][2], B0[2][2], B1[2][2];
    const char* cA = (const char*)g.A + (size_t)cur.pm * tstepA; const char* cB = (const char*)g.Bt + (size_t)cur.pn * tstepB;
    if constexpr (SP2) {
        PG8_STAGE(PG8_SB(0, 0), cB, voffB); PG8_STAGE(PG8_SB(0, 1), cB + hstep, voffB); PG8_STAGE(PG8_SA(0, 0), cA, voffA); PG8_STAGE(PG8_SA(0, 1), cA + hstep, voffA);
        if (wr == 1) PG8_BAR;
        PG8_WAIT_V(2); PG8_BAR;
        PG8_STAGE(PG8_SB(1, 0), cB + kstep, voffB); PG8_STAGE(PG8_SA(1, 0), cA + kstep, voffA); PG8_STAGE(PG8_SB(1, 1), cB + hstep + kstep, voffB);
        PG8_WAIT_V(6); PG8_BAR;
    } else {
        PG8_STAGE(PG8_SB(0, 0), cB, voffB); PG8_STAGE(PG8_SA(0, 0), cA, voffA); PG8_STAGE(PG8_SB(0, 1), cB + hstep, voffB); PG8_STAGE(PG8_SA(0, 1), cA + hstep, voffA);
        if (wr == 1) PG8_BAR;
        PG8_WAIT_V(4); PG8_BAR;
        PG8_STAGE(PG8_SB(1, 0), cB + kstep, voffB); PG8_STAGE(PG8_SA(1, 0), cA + kstep, voffA); PG8_STAGE(PG8_SB(1, 1), cB + hstep + kstep, voffB);
        PG8_WAIT_V(6); PG8_BAR;
    }
    for (;;) {
        const bool has_next = S.next(ui + 1, nxt);
        const char* nA = has_next ? (const char*)g.A + (size_t)nxt.pm * tstepA : cA; const char* nB = has_next ? (const char*)g.Bt + (size_t)nxt.pn * tstepB : cB;
        for (int t = 0; t < nt; t += 2) {
            const bool last = (t == nt - 2);
            const char* a1 = cA + (size_t)(t + 1) * kstep;
            const char* a2 = last ? nA : cA + (size_t)(t + 2) * kstep; const char* b2 = last ? nB : cB + (size_t)(t + 2) * kstep;
            const char* a3 = a2 + kstep; const char* b3 = b2 + kstep;
            if (last) E.pre(cur, wid, lane);
            if constexpr (SP2) {
            PG8_LDB(B0, 0, 0); PG8_LDB(B1, 0, 1); PG8_SCHED; PG8_LDA(At, 0, 0); PG8_STAGE(PG8_SA(1, 1), a1 + hstep, voffA);
            PG8_WAIT_V(8); PG8_WAIT_L(0); PG8_BAR; PG8_MMA(0, 0, At, B0); PG8_MMA(0, 1, At, B1); PG8_BAR; PG8_SCHED;
            PG8_LDA(At, 0, 1); PG8_STAGE(PG8_SB(0, 0), b2, voffB); PG8_STAGE(PG8_SB(0, 1), b2 + hstep, voffB); PG8_STAGE(PG8_SA(0, 0), a2, voffA);
            PG8_WAIT_V(8); PG8_WAIT_L(0); PG8_BAR; PG8_MMA(1, 0, At, B0); PG8_MMA(1, 1, At, B1); PG8_BAR; PG8_SCHED;
            PG8_LDB(B0, 1, 0); PG8_LDB(B1, 1, 1); PG8_SCHED; PG8_LDA(At, 1, 0); PG8_STAGE(PG8_SA(0, 1), a2 + hstep, voffA);
            PG8_WAIT_V(8); PG8_WAIT_L(0); PG8_BAR; PG8_MMA(0, 0, At, B0); PG8_MMA(0, 1, At, B1); PG8_BAR; PG8_SCHED;
            PG8_LDA(At, 1, 1); PG8_STAGE(PG8_SB(1, 0), b3, voffB); PG8_STAGE(PG8_SB(1, 1), b3 + hstep, voffB); PG8_STAGE(PG8_SA(1, 0), a3, voffA);
            PG8_WAIT_V(8); PG8_WAIT_L(0); PG8_BAR; PG8_MMA(1, 0, At, B0); PG8_MMA(1, 1, At, B1); PG8_BAR; PG8_SCHED;
            } else {
            PG8_LDB(B0, 0, 0); PG8_SCHED; PG8_LDA(At, 0, 0); PG8_STAGE(PG8_SA(1, 1), a1 + hstep, voffA);
            PG8_WAIT_L(8); PG8_BAR; PG8_WAIT_L(0); PG8_MMA(0, 0, At, B0); PG8_BAR; PG8_SCHED;
            PG8_LDB(B1, 0, 1); PG8_STAGE(PG8_SB(0, 0), b2, voffB);
            PG8_BAR; PG8_WAIT_L(0); PG8_MMA(0, 1, At, B1); PG8_BAR;
            PG8_LDA(At, 0, 1); PG8_STAGE(PG8_SA(0, 0), a2, voffA);
            PG8_BAR; PG8_WAIT_L(0); PG8_MMA(1, 0, At, B0); PG8_BAR; PG8_SCHED;
            PG8_STAGE(PG8_SB(0, 1), b2 + hstep, voffB);
            PG8_WAIT_V(6); PG8_BAR; PG8_MMA(1, 1, At, B1); PG8_BAR;
            PG8_LDB(B0, 1, 0); PG8_SCHED; PG8_LDA(At, 1, 0); PG8_STAGE(PG8_SA(0, 1), a2 + hstep, voffA);
            PG8_WAIT_L(8); PG8_BAR; PG8_WAIT_L(0); PG8_MMA(0, 0, At, B0); PG8_BAR; PG8_SCHED;
            PG8_LDB(B1, 1, 1); PG8_STAGE(PG8_SB(1, 0), b3, voffB);
            PG8_BAR; PG8_WAIT_L(0); PG8_MMA(0, 1, At, B1); PG8_BAR;
            PG8_LDA(At, 1, 1); PG8_STAGE(PG8_SA(1, 0), a3, voffA);
            PG8_BAR; PG8_WAIT_L(0); PG8_MMA(1, 0, At, B0); PG8_BAR; PG8_SCHED;
            PG8_STAGE(PG8_SB(1, 1), b3 + hstep, voffB);
            PG8_WAIT_V(6); PG8_BAR; PG8_MMA(1, 1, At, B1); PG8_BAR;
            }
        }
        if constexpr (ALIGN_EPI) { if (wr == 0) PG8_BAR; }
        E(acc, cur, wr, wc, fr, fq, lane);
        if (!has_next) break;
#pragma unroll
        for (int a = 0; a < 2; ++a)
#pragma unroll
            for (int b = 0; b < 2; ++b)
#pragma unroll
                for (int m = 0; m < 4; ++m)
#pragma unroll
                    for (int n = 0; n < 2; ++n) acc[a][b][m][n] = (f32x4){0.f, 0.f, 0.f, 0.f};
        cur = nxt; cA = nA; cB = nB; ++ui;
        if constexpr (ALIGN_EPI) { if (wr == 1) PG8_BAR; }
    }
    PG8_WAIT_V(0);
    if constexpr (!ALIGN_EPI) { if (wr == 0) PG8_BAR; }
    PG8_BAR;
#undef PG8_SA
#undef PG8_SB
#undef PG8_STAGE
#undef PG8_LDA
#undef PG8_LDB
#undef PG8_MMA
#undef PG8_WAIT_V
#undef PG8_WAIT_L
#undef PG8_BAR
#undef PG8_SCHED
}
}

namespace att {
constexpr int PITCH = DIN;
#define SBAR() __builtin_amdgcn_sched_barrier(0)
#define KSW(row, colB) ((row) * 128 + ((colB) ^ ((((row) >> 1) & 7) << 4)))
__device__ __forceinline__ int crow(int r, int hi) { return (r & 3) + 8 * (r >> 2) + 4 * hi; }
__device__ __forceinline__ int rel_bucket(int rel) {
    const int n = rel < 0 ? -rel : rel; int v;
    if (n < 8) v = n; else { v = 2 + (31 - __clz(n * n)); v = v > 15 ? 15 : v; }
    return (rel > 0 ? 16 : 0) + v;
}
constexpr float THR = 5.0f;

__device__ __forceinline__ void partialSM(f32x16& p0, f32x16& p1, float off, float& m_reg, float& alpha) {
    float pmax = p0[0];
#pragma unroll
    for (int r = 1; r < 16; ++r) pmax = fmaxf(pmax, p0[r]);
#pragma unroll
    for (int r = 0; r < 16; ++r) pmax = fmaxf(pmax, p1[r]);
    { auto rr = __builtin_amdgcn_permlane32_swap(__float_as_uint(pmax), __float_as_uint(pmax), false, false);
      pmax = fmaxf(__uint_as_float(rr[0]), __uint_as_float(rr[1])); }
    pmax += off;
    if (__builtin_expect(__all(pmax - m_reg <= THR), 1)) { alpha = 1.f; }
    else { const float mn = fmaxf(m_reg, pmax); alpha = __builtin_amdgcn_exp2f(m_reg - mn); m_reg = mn; }
    const float sub = off - m_reg;
#pragma unroll
    for (int r = 0; r < 16; ++r) { p0[r] += sub; p1[r] += sub; }
#pragma unroll
    for (int r = 0; r < 16; ++r) p0[r] = __builtin_amdgcn_exp2f(p0[r]);
}
__device__ __forceinline__ void finishSM(f32x16& p0, f32x16& p1, float alpha, float& l_reg, bf16x8& pa0, bf16x8& pa1, bf16x8& pa2, bf16x8& pa3) {
#pragma unroll
    for (int r = 0; r < 16; ++r) p1[r] = __builtin_amdgcn_exp2f(p1[r]);
    float ps = 0;
#pragma unroll
    for (int r = 0; r < 16; ++r) ps += p0[r];
#pragma unroll
    for (int r = 0; r < 16; ++r) ps += p1[r];
    { auto rr = __builtin_amdgcn_permlane32_swap(__float_as_uint(ps), __float_as_uint(ps), false, false);
      ps = __uint_as_float(rr[0]) + __uint_as_float(rr[1]); }
    l_reg = l_reg * alpha + ps;
#define PK4(P, BASE, OUT) do { unsigned a0 = cvtpk(P[BASE + 0], P[BASE + 1]), a1 = cvtpk(P[BASE + 2], P[BASE + 3]);   \
    unsigned b0 = cvtpk(P[BASE + 4], P[BASE + 5]), b1 = cvtpk(P[BASE + 6], P[BASE + 7]);                              \
    auto r0 = __builtin_amdgcn_permlane32_swap(a0, b0, false, false); auto r1 = __builtin_amdgcn_permlane32_swap(a1, b1, false, false); \
    u32x4 w = {r0[0], r1[0], r0[1], r1[1]}; OUT = __builtin_bit_cast(bf16x8, w); } while (0)
    PK4(p0, 0, pa0); PK4(p0, 8, pa1); PK4(p1, 0, pa2); PK4(p1, 8, pa3);
#undef PK4
}
__device__ __forceinline__ void qkt64(f32x16& p0, f32x16& p1, const LAS char* Ks, const bf16x8* qr, int r32, int hi) {
#pragma unroll
    for (int d0 = 0; d0 < 4; ++d0) { const int cb = (d0 * 16 + hi * 8) * 2;
        const bf16x8 b0 = *(const LAS bf16x8*)(Ks + KSW(r32, cb));
        const bf16x8 b1 = *(const LAS bf16x8*)(Ks + KSW(r32, cb) + 4096);
        p0 = __builtin_amdgcn_mfma_f32_32x32x16_bf16(b0, qr[d0], p0, 0, 0, 0); p1 = __builtin_amdgcn_mfma_f32_32x32x16_bf16(b1, qr[d0], p1, 0, 0, 0); }
}
template <int NCB> __device__ __forceinline__ int v_st(int k, int c) { const int kk = (k & ~0xC) | ((k & 4) << 1) | ((k & 8) >> 1); return ((kk >> 3) * NCB + (c >> 5)) * 512 + ((kk & 7) * 32 + (c & 31)) * 2; }
__device__ __forceinline__ int v_rd_base(int lane) { return ((lane & 3) << 3) | (((lane >> 2) & 3) << 6) | (((lane >> 4) & 1) << 5) | (((lane >> 5) & 1) << 8); }
template <int NCB> constexpr int v_rd_off(int d0, int ks, int half) { return d0 * 512 + ks * (NCB * 1024) + half * (NCB * 512); }
template <int OFF> __device__ __forceinline__ s16x4 tr_read(int vb) { s16x4 r; asm volatile("ds_read_b64_tr_b16 %0, %1 offset:%2" : "=&v"(r) : "v"(vb), "i"(OFF) : "memory"); return r; }
template <int NCB, int D0> __device__ __forceinline__ void pv_one(f32x16& od, int vb, bf16x8 pa0, bf16x8 pa1, bf16x8 pa2, bf16x8 pa3) {
    const s16x4 l0 = tr_read<v_rd_off<NCB>(D0, 0, 0)>(vb), h0 = tr_read<v_rd_off<NCB>(D0, 0, 1)>(vb), l1 = tr_read<v_rd_off<NCB>(D0, 1, 0)>(vb), h1 = tr_read<v_rd_off<NCB>(D0, 1, 1)>(vb);
    const s16x4 l2 = tr_read<v_rd_off<NCB>(D0, 2, 0)>(vb), h2 = tr_read<v_rd_off<NCB>(D0, 2, 1)>(vb), l3 = tr_read<v_rd_off<NCB>(D0, 3, 0)>(vb), h3 = tr_read<v_rd_off<NCB>(D0, 3, 1)>(vb);
    asm volatile("s_waitcnt lgkmcnt(0)" ::: "memory"); SBAR();
#define PK(L, H) (bf16x8){L[0], L[1], L[2], L[3], H[0], H[1], H[2], H[3]}
    od = __builtin_amdgcn_mfma_f32_32x32x16_bf16(pa0, PK(l0, h0), od, 0, 0, 0);
    od = __builtin_amdgcn_mfma_f32_32x32x16_bf16(pa1, PK(l1, h1), od, 0, 0, 0);
    od = __builtin_amdgcn_mfma_f32_32x32x16_bf16(pa2, PK(l2, h2), od, 0, 0, 0);
    od = __builtin_amdgcn_mfma_f32_32x32x16_bf16(pa3, PK(l3, h3), od, 0, 0, 0);
#undef PK
}

constexpr int D_V = 0, D_K = 49152, D_WS = 81920, D_TB = 83968, D_ST = 86016, D_END = D_ST + 65536;
constexpr int NT = SEQ / 64;

typedef short v4i16_t __attribute__((ext_vector_type(4)));
__device__ __forceinline__ s16x4 vtr(const LAS char* p) { return __builtin_bit_cast(s16x4, __builtin_amdgcn_ds_read_tr16_b64_v4i16((LAS v4i16_t*)p)); }
#define PIN(x) asm volatile("" : "+v"(x))
#define MX3(a, b, c) __builtin_fmaxf(__builtin_fmaxf((a), (b)), (c))
#define EX(v) __builtin_amdgcn_exp2f(v)
#define MFMA32(a, b, c) __builtin_amdgcn_mfma_f32_32x32x16_bf16((a), (b), (c), 0, 0, 0)
constexpr float THRL = 6.0f;
__device__ __forceinline__ float rowmax32(const f32x16& C0, const f32x16& C1) {
    float a = MX3(C0[0], C0[1], C1[0]), b = MX3(C0[2], C0[3], C1[1]); a = MX3(a, C1[2], C1[3]);
#pragma unroll
    for (int r = 4; r < 16; r += 4) { a = MX3(a, C0[r], C0[r + 1]); b = MX3(b, C0[r + 2], C0[r + 3]); a = MX3(a, C1[r], C1[r + 1]); b = MX3(b, C1[r + 2], C1[r + 3]); }
    float rm = __builtin_fmaxf(a, b);
    auto rr = __builtin_amdgcn_permlane32_swap(__float_as_uint(rm), __float_as_uint(rm), false, false);
    return __builtin_fmaxf(__uint_as_float(rr[0]), __uint_as_float(rr[1]));
}
__device__ __forceinline__ void diff_pass(f32x16 (&o)[4], float& l_out, const bf16_t* Qw, const bf16_t* __restrict__ Kh, const bf16_t* __restrict__ Vh,
                                          LAS char* lds, int qa, float cL, float cR) {
    const int tid = threadIdx.x, wid = __builtin_amdgcn_readfirstlane(tid >> 6), lane = tid & 63, r32 = lane & 31, hi = lane >> 5;
    LAS char* V_lds = lds + D_V; LAS char* K_lds = lds + D_K;
    LAS float* wsf = (LAS float*)(lds + D_WS) + wid * 64 + 32;
    const LAS float* tb = (const LAS float*)(lds + D_TB);
#pragma unroll
    for (int d = 0; d < 4; ++d) o[d] = f32x16{};
    bf16x8 qr[4];
#pragma unroll
    for (int d0 = 0; d0 < 4; ++d0) qr[d0] = *(const bf16x8*)(Qw + d0 * 16);
#pragma unroll
    for (int d0 = 0; d0 < 4; ++d0) PIN(qr[d0]);
    const bf16_t* ksrc; const bf16_t* vsrc0;
    { const int row = wid * 8 + (lane >> 3), pos = lane & 7;
      ksrc = Kh + (long)row * PITCH + ((pos ^ ((row >> 1) & 7)) * 8);
      vsrc0 = Vh + (long)row * PITCH + ((pos ^ (((row >> 1) & 1) << 2)) * 8); }
    const LAS char* kq[4];
    { const int sw = (r32 >> 1) & 7;
#pragma unroll
      for (int d0 = 0; d0 < 4; ++d0) kq[d0] = K_lds + r32 * 128 + (((2 * d0 + hi) ^ sw) << 4); }
    const LAS char* vpe; const LAS char* vpo;
    { const int q = (lane & 15) >> 2, p = lane & 3, g = (lane >> 4) & 1, sw = (q >> 1) & 1;
      vpe = V_lds + (4 * hi + q) * 128 + sw * 64 + g * 32 + p * 8; vpo = V_lds + (4 * hi + q) * 128 + (sw ^ 1) * 64 + g * 32 + p * 8; }
#define DMA_K(j, ko) __builtin_amdgcn_global_load_lds((const unsigned*)(ksrc + (long)(j) * 64 * PITCH), (LAS unsigned*)(K_lds + (ko) + wid * 1024), 16, 0, 0)
#define DMA_V(j, vo) do { __builtin_amdgcn_global_load_lds((const unsigned*)(vsrc0 + (long)(j) * 64 * PITCH), (LAS unsigned*)(V_lds + (vo) + wid * 1024), 16, 0, 0); \
    __builtin_amdgcn_global_load_lds((const unsigned*)(vsrc0 + 64 + (long)(j) * 64 * PITCH), (LAS unsigned*)(V_lds + (vo) + 8192 + wid * 1024), 16, 0, 0); } while (0)
#define WAIT_BAR(N) do { asm volatile("s_waitcnt vmcnt(" #N ") lgkmcnt(0)" ::: "memory"); __builtin_amdgcn_s_barrier(); asm volatile("" ::: "memory"); } while (0)
    float mhat, l_reg = 0.f; bool resc = false;
    f32x16 pA0, pA1, pB0, pB1;
    bf16x8 kf[4]; s16x4 vlo[6], vhi[6]; u32x4 pw0, pw1, pw2, pw3;
#define KRD(i, KS) do { kf[(i) & 3] = *(const LAS bf16x8*)(kq[(i) >> 1] + (KS) + ((i) & 1) * 4096); } while (0)
    WAIT_BAR(0);
    DMA_K(0, 0); DMA_K(1, 8192); DMA_V(0, 0); DMA_K(2, 16384); DMA_K(3, 24576); DMA_V(1, 16384);
    WAIT_BAR(7);
    {
        float off0 = 0.f; const int d_ = -qa;
        if (d_ <= -154) { pA0 = f32x16{}; pA1 = f32x16{}; off0 = cL; }
        else { const LAS float* t_ = tb + (d_ + 256 + 4 * hi - r32);
#pragma unroll
            for (int r = 0; r < 16; ++r) { pA0[r] = t_[(r & 3) + 8 * (r >> 2)]; pA1[r] = t_[32 + (r & 3) + 8 * (r >> 2)]; } }
#pragma unroll
        for (int d0 = 0; d0 < 4; ++d0) { const bf16x8 k0_ = *(const LAS bf16x8*)(kq[d0]), k1_ = *(const LAS bf16x8*)(kq[d0] + 4096);
            pA0 = MFMA32(k0_, qr[d0], pA0); pA1 = MFMA32(k1_, qr[d0], pA1); }
        const float rm = rowmax32(pA0, pA1);
        mhat = rm + off0;
#pragma unroll
        for (int r = 0; r < 16; ++r) { pA0[r] = EX(pA0[r] - rm); pA1[r] = EX(pA1[r] - rm); }
    }
    WAIT_BAR(3);
    KRD(0, 8192); KRD(1, 8192); KRD(2, 8192); KRD(3, 8192);
#define PKW(P, B) cvtpk(P[B], P[(B) + 1])
#define PAF(k) __builtin_bit_cast(bf16x8, pw##k)
#define VFR(i) (bf16x8){vlo[(i) % 6][0], vlo[(i) % 6][1], vlo[(i) % 6][2], vlo[(i) % 6][3], vhi[(i) % 6][0], vhi[(i) % 6][1], vhi[(i) % 6][2], vhi[(i) % 6][3]}
#define VRD(i, VS) do { const LAS char* vq_ = ((((i) & 3) & 1) ? vpo : vpe) + (VS) + (((i) & 3) >> 1) * 8192 + ((i) >> 2) * 2048; vlo[(i) % 6] = vtr(vq_); vhi[(i) % 6] = vtr(vq_ + 1024); } while (0)
#define GAPA(g, CC, QI, KB, A0, A1, A2, A3, W0, W1, PW) do { CC = MFMA32(kf[(g) & 3], qr[QI], CC); if ((g) + 4 < 8) KRD((g) + 4, KB); sacc += A0; sacc += A1; sacc += A2; sacc += A3; PIN(sacc); W0; W1; PIN(PW); SBAR(); } while (0)
#define GAPB(i, X, B, VB, KN, PRE) do { o[(i) & 3] = MFMA32(PAF_SEL(i), VFR(i), o[(i) & 3]); X[B] = EX(X[B]); X[(B) + 1] = EX(X[(B) + 1]); PIN(X); if ((i) + 5 < 16) VRD((i) + 5, VB); \
    if ((PRE) && (i) >= 8 && (i) < 12) KRD((i) - 8, KN); SBAR(); } while (0)
#define PAF_SEL(i) (((i) >> 2) == 0 ? PAF(0) : ((i) >> 2) == 1 ? PAF(1) : ((i) >> 2) == 2 ? PAF(2) : PAF(3))
#define STEP(C0, C1, P0, P1, t, KB, VB, KN, PRE) do { SBAR(); \
    { const int d_ = (t) * 64 - qa; \
      if (d_ > -154 && d_ < 122) { const LAS float* t_ = tb + (d_ + 256 + 4 * hi - r32); \
        _Pragma("unroll") for (int r = 0; r < 16; ++r) { C0[r] = t_[(r & 3) + 8 * (r >> 2)] - mhat; C1[r] = t_[32 + (r & 3) + 8 * (r >> 2)] - mhat; } } \
      else { const float cs_ = (d_ < 0 ? cL : cR) - mhat; _Pragma("unroll") for (int r = 0; r < 16; ++r) { C0[r] = cs_; C1[r] = cs_; } } } \
    PIN(C0); PIN(C1); SBAR(); \
    float sacc = (P0[0] + P0[1]); \
    GAPA(0, C0, 0, KB, P0[2],  P0[3],  P0[4],  P0[5],  pw0[0] = PKW(P0, 0),  pw0[1] = PKW(P0, 2),  pw0); \
    GAPA(1, C1, 0, KB, P0[6],  P0[7],  P0[8],  P0[9],  pw0[2] = PKW(P0, 4),  pw0[3] = PKW(P0, 6),  pw0); \
    GAPA(2, C0, 1, KB, P0[10], P0[11], P0[12], P0[13], pw1[0] = PKW(P0, 8),  pw1[1] = PKW(P0, 10), pw1); \
    GAPA(3, C1, 1, KB, P0[14], P0[15], P1[0],  P1[1],  pw1[2] = PKW(P0, 12), pw1[3] = PKW(P0, 14), pw1); \
    GAPA(4, C0, 2, KB, P1[2],  P1[3],  P1[4],  P1[5],  pw2[0] = PKW(P1, 0),  pw2[1] = PKW(P1, 2),  pw2); \
    GAPA(5, C1, 2, KB, P1[6],  P1[7],  P1[8],  P1[9],  pw2[2] = PKW(P1, 4),  pw2[3] = PKW(P1, 6),  pw2); \
    GAPA(6, C0, 3, KB, P1[10], P1[11], P1[12], P1[13], pw3[0] = PKW(P1, 8),  pw3[1] = PKW(P1, 10), pw3); \
    GAPA(7, C1, 3, KB, P1[14], P1[15], 0.f,    0.f,    pw3[2] = PKW(P1, 12), pw3[3] = PKW(P1, 14), pw3); \
    l_reg += sacc; \
    VRD(0, VB); VRD(1, VB); VRD(2, VB); VRD(3, VB); VRD(4, VB); \
    { const float rm = rowmax32(C0, C1); resc = false; \
      if (__builtin_expect(__any(rm > THRL), 0)) { const float dl = __builtin_fmaxf(rm, 0.f); mhat += dl; \
        _Pragma("unroll") for (int r = 0; r < 16; ++r) { C0[r] -= dl; C1[r] -= dl; } \
        const float f = EX(-dl); l_reg *= f; if (hi == 0) wsf[r32] = f; resc = true; } } \
    SBAR(); \
    GAPB(0, C0, 0, VB, KN, PRE);  GAPB(1, C0, 2, VB, KN, PRE);  GAPB(2, C0, 4, VB, KN, PRE);   GAPB(3, C0, 6, VB, KN, PRE); \
    GAPB(4, C0, 8, VB, KN, PRE);  GAPB(5, C0, 10, VB, KN, PRE); GAPB(6, C0, 12, VB, KN, PRE);  GAPB(7, C0, 14, VB, KN, PRE); \
    GAPB(8, C1, 0, VB, KN, PRE);  GAPB(9, C1, 2, VB, KN, PRE);  GAPB(10, C1, 4, VB, KN, PRE);  GAPB(11, C1, 6, VB, KN, PRE); \
    GAPB(12, C1, 8, VB, KN, PRE); GAPB(13, C1, 10, VB, KN, PRE); GAPB(14, C1, 12, VB, KN, PRE); GAPB(15, C1, 14, VB, KN, PRE); \
    } while (0)
#define RESC() do { if (resc) { asm volatile("s_waitcnt lgkmcnt(0)" ::: "memory"); \
    _Pragma("unroll") for (int d = 0; d < 4; ++d) _Pragma("unroll") for (int r = 0; r < 16; ++r) o[d][r] *= wsf[crow(r, hi)]; } } while (0)
    int ks_cur = 8192, ks_n1 = 16384, ks_n3 = 0;
    int vs_prev = 0, vs_next = 32768;
#define ROT() do { ks_cur = (ks_cur + 8192) & 24576; ks_n1 = (ks_n1 + 8192) & 24576; ks_n3 = (ks_n3 + 8192) & 24576; vs_prev = vs_prev == 32768 ? 0 : vs_prev + 16384; vs_next = vs_next == 32768 ? 0 : vs_next + 16384; } while (0)
#define STEPX(C0, C1, P0, P1, t, PRE) STEP(C0, C1, P0, P1, t, ks_cur, vs_prev, ks_n1, PRE)
#pragma unroll 1
    for (int t = 1; t + 4 < NT; t += 2) {
        DMA_K(t + 3, ks_n3); DMA_V(t + 1, vs_next);
        STEPX(pB0, pB1, pA0, pA1, t, true);
        WAIT_BAR(3); RESC(); ROT();
        DMA_K(t + 4, ks_n3); DMA_V(t + 2, vs_next);
        STEPX(pA0, pA1, pB0, pB1, t + 1, true);
        WAIT_BAR(3); RESC(); ROT();
    }
    DMA_V(NT - 2, vs_next);
    STEPX(pB0, pB1, pA0, pA1, NT - 3, true);
    WAIT_BAR(2); RESC(); ROT();
    DMA_V(NT - 1, vs_next);
    STEPX(pA0, pA1, pB0, pB1, NT - 2, true);
    WAIT_BAR(2); RESC(); ROT();
    STEPX(pB0, pB1, pA0, pA1, NT - 1, false);
    WAIT_BAR(0); RESC(); ROT();
    { float sacc = 0.f;
#pragma unroll
      for (int r = 0; r < 16; ++r) sacc += pB0[r];
#pragma unroll
      for (int r = 0; r < 16; ++r) sacc += pB1[r];
      l_reg += sacc;
      pw0 = (u32x4){PKW(pB0, 0), PKW(pB0, 2), PKW(pB0, 4), PKW(pB0, 6)}; pw1 = (u32x4){PKW(pB0, 8), PKW(pB0, 10), PKW(pB0, 12), PKW(pB0, 14)};
      pw2 = (u32x4){PKW(pB1, 0), PKW(pB1, 2), PKW(pB1, 4), PKW(pB1, 6)}; pw3 = (u32x4){PKW(pB1, 8), PKW(pB1, 10), PKW(pB1, 12), PKW(pB1, 14)};
      SBAR();
#define DRAIN(i) do { VRD(i, vs_prev); o[(i) & 3] = MFMA32(PAF_SEL(i), VFR(i), o[(i) & 3]); } while (0)
      DRAIN(0); DRAIN(1); DRAIN(2); DRAIN(3); DRAIN(4); DRAIN(5); DRAIN(6); DRAIN(7); DRAIN(8); DRAIN(9); DRAIN(10); DRAIN(11); DRAIN(12); DRAIN(13); DRAIN(14); DRAIN(15);
#undef DRAIN
    }
    { auto rr = __builtin_amdgcn_permlane32_swap(__float_as_uint(l_reg), __float_as_uint(l_reg), false, false); l_out = __uint_as_float(rr[0]) + __uint_as_float(rr[1]); }
#undef DMA_K
#undef DMA_V
#undef WAIT_BAR
#undef ROT
#undef KRD
#undef PKW
#undef PAF
#undef VFR
#undef VRD
#undef GAPA
#undef GAPB
#undef PAF_SEL
#undef STEP
#undef STEPX
#undef RESC
}

__device__ __forceinline__ void diff_unit(int b, int h, int qb, const bf16_t* P, bf16_t* O, LAS char* lds, float lam, const float* relb) {
    const int tid = threadIdx.x, wid = __builtin_amdgcn_readfirstlane(tid >> 6), lane = tid & 63, r32 = lane & 31, hi = lane >> 5;
    const long rowbase = (long)b * SEQ; const int q0 = qb * 256, qa = q0 + wid * 32;
    LAS float* tb = (LAS float*)(lds + D_TB);
    LAS float* li_l = (LAS float*)(lds + D_WS) + wid * 64;
    tb[tid] = relb[rel_bucket(tid - 256) * NBH + h] * LOG2E;
    const float cL = relb[15 * NBH + h] * LOG2E, cR = relb[31 * NBH + h] * LOG2E;
    const bf16_t* Qrow = P + (rowbase + qa + r32) * PITCH + C_DQ + h * 128 + hi * 8;
    const bf16_t* Kh = P + rowbase * PITCH + C_DK + h * 128;
    const bf16_t* Vh = P + rowbase * PITCH + C_DV + h * 128;
    LAS u32x4* stash = (LAS u32x4*)(lds + D_ST + wid * 8192);
    f32x16 o[4]; float l_reg;
#pragma unroll 1
    for (int pass = 0; pass < 2; ++pass) {
        const int mo = pass == 0 ? 64 : 0;
        diff_pass(o, l_reg, Qrow + mo, Kh + mo, Vh, lds, qa, cL, cR);
        int ln = lane; asm volatile("" : "+v"(ln));
        const int r32e = ln & 31, hie = ln >> 5;
        if (hie == 0) li_l[r32e] = l_reg; asm volatile("s_waitcnt lgkmcnt(0)" ::: "memory");
        if (pass == 0) {
            float rli[16];
#pragma unroll
            for (int r = 0; r < 16; ++r) rli[r] = -lam * __builtin_amdgcn_rcpf(li_l[crow(r, hie)]);
#pragma unroll
            for (int d0 = 0; d0 < 4; ++d0) {
                u32x4 w0, w1;
                w0.x = cvtpk(o[d0][0] * rli[0], o[d0][1] * rli[1]); w0.y = cvtpk(o[d0][2] * rli[2], o[d0][3] * rli[3]); w0.z = cvtpk(o[d0][4] * rli[4], o[d0][5] * rli[5]); w0.w = cvtpk(o[d0][6] * rli[6], o[d0][7] * rli[7]);
                w1.x = cvtpk(o[d0][8] * rli[8], o[d0][9] * rli[9]); w1.y = cvtpk(o[d0][10] * rli[10], o[d0][11] * rli[11]); w1.z = cvtpk(o[d0][12] * rli[12], o[d0][13] * rli[13]); w1.w = cvtpk(o[d0][14] * rli[14], o[d0][15] * rli[15]);
                stash[(2 * d0) * 64 + ln] = w0; stash[(2 * d0 + 1) * 64 + ln] = w1;
            }
        } else {
            float rli[16], ssq[16];
#pragma unroll
            for (int r = 0; r < 16; ++r) { rli[r] = __builtin_amdgcn_rcpf(li_l[crow(r, hie)]); ssq[r] = 0.f; }
#pragma unroll
            for (int d0 = 0; d0 < 4; ++d0) {
                const u32x4 w0 = stash[(2 * d0) * 64 + ln], w1 = stash[(2 * d0 + 1) * 64 + ln];
                const unsigned ww[8] = {w0.x, w0.y, w0.z, w0.w, w1.x, w1.y, w1.z, w1.w};
#pragma unroll
                for (int r = 0; r < 16; ++r) { const float c = __uint_as_float((r & 1) ? (ww[r >> 1] & 0xffff0000u) : (ww[r >> 1] << 16));
                    const float x = fmaf(o[d0][r], rli[r], c); o[d0][r] = x; ssq[r] = fmaf(x, x, ssq[r]); }
            }
            asm volatile("s_waitcnt lgkmcnt(0)" ::: "memory");
#pragma unroll
            for (int r = 0; r < 16; ++r) { float s = ssq[r];
                s += __shfl_xor(s, 1); s += __shfl_xor(s, 2); s += __shfl_xor(s, 4); s += __shfl_xor(s, 8); s += __shfl_xor(s, 16);
                ssq[r] = __builtin_amdgcn_rsqf(s * (1.0f / 128.0f) + EPS); }
            LAS bf16_t* stg = (LAS bf16_t*)(lds + D_ST + wid * 8192);
#pragma unroll
            for (int r = 0; r < 16; ++r) { const int orow = crow(r, hie);
#pragma unroll
                for (int d0 = 0; d0 < 4; ++d0) stg[orow * 128 + d0 * 32 + r32e] = (bf16_t)(cvtpk(o[d0][r] * ssq[r], 0.f) & 0xffffu); }
            asm volatile("s_waitcnt lgkmcnt(0)" ::: "memory");
            bf16_t* Ow = O + (rowbase + qa + (ln >> 4)) * DM + h * 128 + (ln & 15) * 8;
            const LAS bf16_t* sl = stg + (ln >> 4) * 128 + (ln & 15) * 8;
#pragma unroll
            for (int i = 0; i < 8; ++i) { const u32x4 v = *(const LAS u32x4*)(sl + i * 512); *(u32x4*)(Ow + (long)i * 4 * DM) = v; }
        }
    }
    asm volatile("s_waitcnt lgkmcnt(0)" ::: "memory"); __syncthreads();
}

constexpr int W_K = 0, W_V = 49152, W_TB = 98304, W_WS = 106496, W_OST = 108544, W_END = W_OST + 32768;
__device__ __forceinline__ void win_unit(int b, int kvh, int qb, const bf16_t* P, bf16_t* O, LAS char* lds, const float* relb, const float* sink) {
    const int tid = threadIdx.x, wid = __builtin_amdgcn_readfirstlane(tid >> 6), lane = tid & 63, r32 = lane & 31, hi = lane >> 5;
    const long rowbase = (long)b * SEQ; const int q0 = qb * 128, kbase = q0 - 128;
    LAS float* tbw = (LAS float*)(lds + W_TB);
#pragma unroll
    for (int e = 0; e < 4; ++e) { const int idx = tid + e * 512, g = idx >> 9, rel = (idx & 511) - 256;
        tbw[idx] = (rel >= -128 && rel <= 128) ? (relb[rel_bucket(rel) * NBH + 4 + 4 * kvh + g] - sink[4 * kvh + g]) * LOG2E : -1e30f; }
    { int tl = tid; asm volatile("" : "+v"(tl));
      const int kr = tl >> 3, kc = (tl & 7) * 8, kst = KSW(kr, kc * 2), vst = v_st<2>(kr, kc);
      const bf16_t* Kh = P + rowbase * PITCH + C_WK + kvh * 64; const bf16_t* Vh = P + rowbase * PITCH + C_WV + kvh * 64;
      bf16x8 kreg[6], vreg[6];
#pragma unroll
      for (int t = 0; t < 6; ++t) { const int k0 = kbase + 64 * t; if (k0 >= 0 && k0 < SEQ) { kreg[t] = *(const bf16x8*)(&Kh[(long)(k0 + kr) * PITCH + kc]); vreg[t] = *(const bf16x8*)(&Vh[(long)(k0 + kr) * PITCH + kc]); } }
#pragma unroll
      for (int t = 0; t < 6; ++t) { const int k0 = kbase + 64 * t; if (k0 >= 0 && k0 < SEQ) { *(LAS bf16x8*)(lds + W_K + t * 8192 + kst) = kreg[t]; *(LAS bf16x8*)(lds + W_V + t * 8192 + vst) = vreg[t]; } }
    }
    __syncthreads();
    const int g = wid >> 1, hq = 4 * kvh + g;
    LAS float* li_l = (LAS float*)(lds + W_WS) + wid * 64;
    const LAS float* tbg = tbw + g * 512;
    const int vbw = (int)(uintptr_t)(lds + W_V) + v_rd_base(lane);
#pragma unroll 1
    for (int jb = 0; jb < 2; ++jb) {
        const int ql = 64 * (wid & 1) + 32 * jb;
        const bf16_t* Qw = P + (rowbase + q0 + ql + r32) * PITCH + C_WQ + hq * 64 + hi * 8;
        bf16x8 qr[4];
#pragma unroll
        for (int d0 = 0; d0 < 4; ++d0) qr[d0] = *(const bf16x8*)(Qw + d0 * 16);
        float l_reg = 0.f;
        f32x16 o[2]; o[0] = f32x16{}; o[1] = f32x16{};
        const int t_lo = ql >> 6;
#pragma unroll 1
        for (int t = t_lo; t < t_lo + 5; ++t) {
            const int k0 = kbase + 64 * t; if (k0 < 0 || k0 >= SEQ) continue;
            const int d_ = 64 * t - 128 - ql;
            const LAS float* t_ = tbg + (d_ + 256 + 4 * hi - r32);
            f32x16 p0, p1;
#pragma unroll
            for (int r = 0; r < 16; ++r) { p0[r] = t_[(r & 3) + 8 * (r >> 2)]; p1[r] = t_[32 + (r & 3) + 8 * (r >> 2)]; }
            qkt64(p0, p1, lds + W_K + t * 8192, qr, r32, hi);
#pragma unroll
            for (int r = 0; r < 16; ++r) { p0[r] = __builtin_amdgcn_exp2f(p0[r]); p1[r] = __builtin_amdgcn_exp2f(p1[r]); }
            bf16x8 pa0, pa1, pa2, pa3;
            {
                float ps = 0;
#pragma unroll
                for (int r = 0; r < 16; ++r) ps += p0[r];
#pragma unroll
                for (int r = 0; r < 16; ++r) ps += p1[r];
                l_reg += ps;
#define PK4(Pv, BASE, OUT) do { unsigned a0 = cvtpk(Pv[BASE + 0], Pv[BASE + 1]), a1 = cvtpk(Pv[BASE + 2], Pv[BASE + 3]);   \
    unsigned b0 = cvtpk(Pv[BASE + 4], Pv[BASE + 5]), b1 = cvtpk(Pv[BASE + 6], Pv[BASE + 7]);                              \
    auto r0 = __builtin_amdgcn_permlane32_swap(a0, b0, false, false); auto r1 = __builtin_amdgcn_permlane32_swap(a1, b1, false, false); \
    u32x4 w = {r0[0], r1[0], r0[1], r1[1]}; OUT = __builtin_bit_cast(bf16x8, w); } while (0)
                PK4(p0, 0, pa0); PK4(p0, 8, pa1); PK4(p1, 0, pa2); PK4(p1, 8, pa3);
#undef PK4
            }
            const int vb = vbw + t * 8192;
            pv_one<2, 0>(o[0], vb, pa0, pa1, pa2, pa3); pv_one<2, 1>(o[1], vb, pa0, pa1, pa2, pa3);
        }
        { auto rr = __builtin_amdgcn_permlane32_swap(__float_as_uint(l_reg), __float_as_uint(l_reg), false, false); l_reg = 1.0f + __uint_as_float(rr[0]) + __uint_as_float(rr[1]); }
        int ln = lane; asm volatile("" : "+v"(ln));
        const int r32e = ln & 31, hie = ln >> 5;
        if (hie == 0) li_l[r32e] = l_reg; asm volatile("s_waitcnt lgkmcnt(0)" ::: "memory");
        float rli[16];
#pragma unroll
        for (int r = 0; r < 16; ++r) rli[r] = __builtin_amdgcn_rcpf(li_l[crow(r, hie)]);
        LAS bf16_t* stg = (LAS bf16_t*)(lds + W_OST + wid * 4096);
#pragma unroll
        for (int r = 0; r < 16; ++r) { const int orow = crow(r, hie);
#pragma unroll
            for (int d0 = 0; d0 < 2; ++d0) stg[orow * 64 + d0 * 32 + r32e] = (bf16_t)(cvtpk(o[d0][r] * rli[r], 0.f) & 0xffffu); }
        asm volatile("s_waitcnt lgkmcnt(0)" ::: "memory");
        bf16_t* Ow = O + (rowbase + q0 + ql + (ln >> 3)) * DM + 512 + hq * 64 + (ln & 7) * 8;
        const LAS bf16_t* sl = stg + (ln >> 3) * 64 + (ln & 7) * 8;
#pragma unroll
        for (int i = 0; i < 4; ++i) { const u32x4 v = *(const LAS u32x4*)(sl + i * 512); *(u32x4*)(Ow + (long)i * 8 * DM) = v; }
        asm volatile("s_waitcnt lgkmcnt(0)" ::: "memory");
    }
    asm volatile("s_waitcnt lgkmcnt(0)" ::: "memory"); __syncthreads();
}
#undef SBAR
#undef KSW
}

constexpr size_t MiB = 1u << 20;
constexpr size_t WS_CTL = 0, CTL_ZERO_BYTES = 64 * 1024;
constexpr size_t WS_W1 = 1 * MiB;
constexpr size_t WS_W2 = WS_W1 + (size_t)DIN * DM * 2;
constexpr size_t WS_W3 = WS_W2 + (size_t)DM * DM * 2;
constexpr size_t WS_W4 = WS_W3 + (size_t)2 * DFF * DM * 2;
constexpr size_t WS_XS = 24 * MiB;
constexpr int CW_WMAX4 = 5120;
constexpr int CW_GBAR = 6400;
constexpr int CW_P3CNT = 4480;
constexpr size_t WS_FA = 26 * MiB;
constexpr size_t WS_FX = 26 * MiB + 512 * 1024;
constexpr int CW_WMAX1 = 13824, CW_W1CNT = 16200;
constexpr int CW_WMAX = 8192;
constexpr size_t WS_X0S = 27 * MiB;
constexpr size_t WS_PROJ = 28 * MiB;
constexpr size_t WS_OB = 244 * MiB;
constexpr size_t WS_XQ = 340 * MiB;
constexpr size_t WS_X1Q = 340 * MiB;
constexpr size_t WS_X1B = 388 * MiB;
constexpr size_t WS_ACT = 28 * MiB;
constexpr size_t WS_END = WS_X1B + (size_t)NTOK * DM * 2;
static_assert(WS_W4 + (size_t)DM * DFF * 2 <= WS_XS && WS_XS + (size_t)NTOK * 32 <= WS_FA && WS_FA + (size_t)NTOK * 4 <= WS_FX && WS_FX + (size_t)NTOK * 4 <= WS_X0S && WS_X0S + (size_t)NTOK * 4 <= WS_PROJ, "d_ws map");
static_assert(WS_PROJ + (size_t)NTOK * DIN * 2 <= WS_OB && WS_OB + (size_t)NTOK * DM * 2 <= WS_XQ && WS_XQ + (size_t)NTOK * DM <= WS_X1B && WS_ACT + (size_t)NTOK * DFF * 2 <= WS_X1Q - 4096, "d_ws map");
static_assert(CW_WMAX + 2 * DFF <= CW_WMAX1 && CW_WMAX1 + DIN <= CW_W1CNT && CW_W1CNT * 4 < CTL_ZERO_BYTES && 1024 + 3456 <= CW_P3CNT && CW_P3CNT + 192 <= CW_WMAX4 && CW_WMAX4 + DM <= CW_GBAR && CW_GBAR + 8 * 128 <= CW_WMAX, "d_ws map");
constexpr int CW_BAR = 1024, XCD_BAR_WORDS_C = 3456;

constexpr int RING_BYTES = 131072, EPX_OFF = RING_BYTES, LDS_BYTES = 163840, MISC_OFF = LDS_BYTES - 512;
static_assert(att::D_END <= MISC_OFF && att::W_END <= MISC_OFF && EPX_OFF + 22528 <= MISC_OFF, "LDS map");

typedef GAS unsigned gu32;
#define RLX_AGENT __ATOMIC_RELAXED, __HIP_MEMORY_SCOPE_AGENT
#define LDS_WAIT() asm volatile("s_waitcnt lgkmcnt(0)" ::: "memory")

#define XB_TMO      128
#define XB_XCNT(j)  (256  + 64 * (j))
#define XB_XSUB(j)  (1280 + 64 * (j))
#define XB_XGEN(j)  (2304 + 64 * (j))
#define XB_TOP      3328
#define XB_TOPGEN   3392
#define XCD_BAR_WORDS 3456
#define XB_SPIN_CAP (1u << 22)
__device__ __forceinline__ unsigned xb_ld(unsigned* p)              { return __hip_atomic_load(p, __ATOMIC_RELAXED, __HIP_MEMORY_SCOPE_AGENT); }
__device__ __forceinline__ unsigned xb_add(unsigned* p, unsigned v) { return __hip_atomic_fetch_add(p, v, __ATOMIC_RELAXED, __HIP_MEMORY_SCOPE_AGENT); }
__device__ __forceinline__ unsigned xb_xcc_id() { return (unsigned)__builtin_amdgcn_s_getreg((3 << 11) | 20) & 0xFu; }
#define XB_SPIN(cond, bar) do { unsigned _sp = 0; while (cond) { __builtin_amdgcn_s_sleep(1); \
    if ((++_sp & 255u) == 0u) { if (xb_ld(&(bar)[XB_TMO])) break; if (_sp > XB_SPIN_CAP) { atomicAdd(&(bar)[XB_TMO], 1u); break; } } } } while (0)
struct XcdBarrier { unsigned* bar; unsigned x; volatile LAS unsigned* st; };
__device__ __forceinline__ XcdBarrier xcd_barrier_post(unsigned* bar, volatile LAS unsigned* st) {
    XcdBarrier b; b.bar = bar; b.x = xb_xcc_id(); b.st = st;
    if (threadIdx.x == 0) (void)xb_add(&bar[XB_XCNT(b.x)], 1u);
    return b;
}
__device__ __forceinline__ void xcd_barrier_complete(unsigned* bar, unsigned x, unsigned& nloc, unsigned& nx) {
    const unsigned G = gridDim.x * gridDim.y * gridDim.z;
    unsigned sum, cnt, mine, sp = 0u;
    for (;;) {
        sum = 0u; cnt = 0u; mine = 0u;
#pragma unroll
        for (unsigned j = 0; j < 16; ++j) { const unsigned c = xb_ld(&bar[XB_XCNT(j)]); sum += c; cnt += (c > 0u) ? 1u : 0u; mine = (j == x) ? c : mine; }
        if (sum == G) break;
        __builtin_amdgcn_s_sleep(1);
        if ((++sp & 255u) == 0u) { if (xb_ld(&bar[XB_TMO])) break; if (sp > XB_SPIN_CAP) { atomicAdd(&bar[XB_TMO], 1u); break; } }
    }
    nloc = mine > 0u ? mine : 1u; nx = cnt > 0u ? cnt : 1u;
}
__device__ __forceinline__ void xcd_barrier(const XcdBarrier& b) {
    asm volatile("s_waitcnt vmcnt(0)" ::: "memory");
    __syncthreads();
    if (threadIdx.x == 0) {
        unsigned* bar = b.bar;
        __builtin_amdgcn_s_waitcnt(0);
        unsigned nloc = b.st[0], nx = b.st[1];
        if (nloc == 0u) { xcd_barrier_complete(bar, b.x, nloc, nx); b.st[0] = nloc; b.st[1] = nx; }
        const unsigned old = xb_add(&bar[XB_XSUB(b.x)], 1u);
        const unsigned gen = old / nloc;
        if (old + 1u == (gen + 1u) * nloc) {
            __builtin_amdgcn_fence(__ATOMIC_RELEASE, "agent");
            asm volatile("s_waitcnt vmcnt(0)" ::: "memory");
            const unsigned og = xb_add(&bar[XB_TOP], 1u);
            const unsigned tg = og / nx;
            if (og + 1u == (tg + 1u) * nx) xb_add(&bar[XB_TOPGEN], 1u);
            else XB_SPIN(xb_ld(&bar[XB_TOPGEN]) == tg, bar);
            __builtin_amdgcn_fence(__ATOMIC_ACQUIRE, "agent");
            xb_add(&bar[XB_XGEN(b.x)], 1u);
            asm volatile("s_waitcnt vmcnt(0)" ::: "memory");
        } else {
            XB_SPIN(xb_ld(&bar[XB_XGEN(b.x)]) == gen, bar);
            __builtin_amdgcn_fence(__ATOMIC_ACQUIRE, "agent");
            asm volatile("s_waitcnt vmcnt(0)" ::: "memory");
        }
    }
    __syncthreads();
}

__device__ __forceinline__ void group_barrier(unsigned* gb, unsigned nmem, volatile LAS unsigned* ep) {
    asm volatile("s_waitcnt vmcnt(0)" ::: "memory");
    __syncthreads();
    if (threadIdx.x == 0) {
        __builtin_amdgcn_fence(__ATOMIC_RELEASE, "agent");
        asm volatile("s_waitcnt vmcnt(0)" ::: "memory");
        const unsigned e = ep[0]; ep[0] = e + 1u;
        const unsigned old = xb_add(&gb[0], 1u);
        if (old + 1u == (e + 1u) * nmem) xb_add(&gb[64], 1u);
        else { unsigned sp = 0; while (xb_ld(&gb[64]) == e) { __builtin_amdgcn_s_sleep(1); if (++sp > XB_SPIN_CAP) break; } }
        __builtin_amdgcn_fence(__ATOMIC_ACQUIRE, "agent");
        asm volatile("s_waitcnt vmcnt(0)" ::: "memory");
    }
    __syncthreads();
}

__device__ __forceinline__ float wave_sum(float v) {
#pragma unroll
    for (int o = 1; o < 64; o <<= 1) v += __shfl_xor(v, o);
    return v;
}
__device__ __forceinline__ unsigned f2bf(float f) { unsigned u = __builtin_bit_cast(unsigned, f); return (u + 0x7fffu + ((u >> 16) & 1u)) >> 16; }
__device__ __forceinline__ unsigned pk2(float lo, float hi) { return f2bf(lo) | (f2bf(hi) << 16); }
__device__ __forceinline__ void transpose_item(const float* W, int ld, int cbase, int K, int k0, bf16_t* WT, int nrow0, const float* fold, int foldmask, float fscale, int foldlim, LAS float* scr, int lane) {
    float wv[32];
#pragma unroll
    for (int i = 0; i < 32; ++i) wv[i] = W[(size_t)(k0 + 2 * i + (lane >> 5)) * ld + cbase + (lane & 31)];
#pragma unroll
    for (int i = 0; i < 32; ++i) { const int kk = 2 * i + (lane >> 5), k = k0 + kk;
        float f = 1.f; if (fold != nullptr && k < foldlim) f = fold[k & foldmask] * fscale;
        scr[kk * 33 + (lane & 31)] = wv[i] * f; }
    LDS_WAIT(); asm volatile("" ::: "memory");
    const int c = lane & 7;
#pragma unroll
    for (int j = 0; j < 4; ++j) { const int n = (lane >> 3) + 8 * j; const LAS float* s = scr + (8 * c) * 33 + n;
        u32x4 o; o.x = pk2(s[0 * 33], s[1 * 33]); o.y = pk2(s[2 * 33], s[3 * 33]); o.z = pk2(s[4 * 33], s[5 * 33]); o.w = pk2(s[6 * 33], s[7 * 33]);
        *(u32x4*)(WT + (size_t)(nrow0 + n) * K + k0 + 8 * c) = o; }
    LDS_WAIT(); asm volatile("" ::: "memory");
}

__device__ __forceinline__ void absmax_item(const float* W, int ld, int cbase, int k0, unsigned* wmax, const float* fold, int lane) {
    float wv[32];
#pragma unroll
    for (int i = 0; i < 32; ++i) wv[i] = W[(size_t)(k0 + 2 * i + (lane >> 5)) * ld + cbase + (lane & 31)];
    float m = 0.f;
#pragma unroll
    for (int i = 0; i < 32; ++i) m = __builtin_fmaxf(m, __builtin_fabsf(wv[i] * (fold ? fold[k0 + 2 * i + (lane >> 5)] : 1.f)));
    m = __builtin_fmaxf(m, __shfl_xor(m, 32));
    if (lane < 32) (void)__hip_atomic_fetch_max(wmax + lane, __float_as_uint(m), __ATOMIC_RELAXED, __HIP_MEMORY_SCOPE_AGENT);
}
__device__ __forceinline__ void quant_item(const float* W, int ld, int cbase, int K, int k0, signed char* WQ, int nrow0, const float* fold, const unsigned* wmax, LAS float* scr, int lane) {
    float wv[32];
#pragma unroll
    for (int i = 0; i < 32; ++i) wv[i] = W[(size_t)(k0 + 2 * i + (lane >> 5)) * ld + cbase + (lane & 31)];
    const float am = __uint_as_float(__hip_atomic_load(wmax + (lane & 31), __ATOMIC_RELAXED, __HIP_MEMORY_SCOPE_AGENT)); const float inv = am > 0.f ? 127.0f / am : 0.f;
#pragma unroll
    for (int i = 0; i < 32; ++i) { const int kk = 2 * i + (lane >> 5); scr[kk * 33 + (lane & 31)] = wv[i] * fold[k0 + kk] * inv; }
    LDS_WAIT(); asm volatile("" ::: "memory");
    const int n = lane >> 1, c = lane & 1; const LAS float* sp = scr + (32 * c) * 33 + n;
    u32x4 o0, o1;
    o0.x = q4(sp[0 * 33], sp[1 * 33], sp[2 * 33], sp[3 * 33]);     o0.y = q4(sp[4 * 33], sp[5 * 33], sp[6 * 33], sp[7 * 33]);
    o0.z = q4(sp[8 * 33], sp[9 * 33], sp[10 * 33], sp[11 * 33]);   o0.w = q4(sp[12 * 33], sp[13 * 33], sp[14 * 33], sp[15 * 33]);
    o1.x = q4(sp[16 * 33], sp[17 * 33], sp[18 * 33], sp[19 * 33]); o1.y = q4(sp[20 * 33], sp[21 * 33], sp[22 * 33], sp[23 * 33]);
    o1.z = q4(sp[24 * 33], sp[25 * 33], sp[26 * 33], sp[27 * 33]); o1.w = q4(sp[28 * 33], sp[29 * 33], sp[30 * 33], sp[31 * 33]);
    u32x4* dst = (u32x4*)(WQ + (size_t)(nrow0 + n) * K + k0 + 32 * c);
    dst[0] = o0; dst[1] = o1;
    LDS_WAIT(); asm volatile("" ::: "memory");
}

__device__ __forceinline__ void quantf8_item(const float* W, int ld, int cbase, int K, int k0, unsigned char* WQ, int nrow0, const unsigned* wmax, LAS float* scr, int lane) {
    float wv[32];
#pragma unroll
    for (int i = 0; i < 32; ++i) wv[i] = W[(size_t)(k0 + 2 * i + (lane >> 5)) * ld + cbase + (lane & 31)];
    const float am = __uint_as_float(__hip_atomic_load(wmax + (lane & 31), __ATOMIC_RELAXED, __HIP_MEMORY_SCOPE_AGENT)); const float inv = am > 0.f ? W8_TOP / am : 0.f;
#pragma unroll
    for (int i = 0; i < 32; ++i) { const int kk = 2 * i + (lane >> 5); scr[kk * 33 + (lane & 31)] = wv[i] * inv; }
    LDS_WAIT(); asm volatile("" ::: "memory");
    const int n = lane >> 1, c = lane & 1; const LAS float* sp = scr + (32 * c) * 33 + n;
    u32x4 o0, o1;
    o0.x = f8x4(sp[0 * 33], sp[1 * 33], sp[2 * 33], sp[3 * 33]);     o0.y = f8x4(sp[4 * 33], sp[5 * 33], sp[6 * 33], sp[7 * 33]);
    o0.z = f8x4(sp[8 * 33], sp[9 * 33], sp[10 * 33], sp[11 * 33]);   o0.w = f8x4(sp[12 * 33], sp[13 * 33], sp[14 * 33], sp[15 * 33]);
    o1.x = f8x4(sp[16 * 33], sp[17 * 33], sp[18 * 33], sp[19 * 33]); o1.y = f8x4(sp[20 * 33], sp[21 * 33], sp[22 * 33], sp[23 * 33]);
    o1.z = f8x4(sp[24 * 33], sp[25 * 33], sp[26 * 33], sp[27 * 33]); o1.w = f8x4(sp[28 * 33], sp[29 * 33], sp[30 * 33], sp[31 * 33]);
    u32x4* dst = (u32x4*)(WQ + (size_t)(nrow0 + n) * K + k0 + 32 * c);
    dst[0] = o0; dst[1] = o1;
    LDS_WAIT(); asm volatile("" ::: "memory");
}

struct Args { const float* in[22]; float* out; unsigned char* ws; int ph_lo, ph_hi, li, pad; };

__global__ void __launch_bounds__(NWAVES * 64, 2) hymba_fwd(Args args) {
    extern __shared__ __attribute__((aligned(16))) unsigned char lds_raw[];
    LAS unsigned char* lds = (LAS unsigned char*)lds_raw;
    volatile LAS unsigned* MISC = (volatile LAS unsigned*)(lds + MISC_OFF);
    const int tid = threadIdx.x, lane = tid & 63, wave = __builtin_amdgcn_readfirstlane(tid >> 6);
    const int G = gridDim.x; const int bx = blockIdx.x; const int vcu = (G % 8 == 0) ? (bx % 8) * (G / 8) + bx / 8 : bx;
    unsigned char* ws = args.ws;
    unsigned* ctl = (unsigned*)(ws + WS_CTL);
    const float* xp = args.in[0]; const float* xs = args.in[1];
    bf16_t* W1 = (bf16_t*)(ws + WS_W1); bf16_t* W2 = (bf16_t*)(ws + WS_W2); bf16_t* W3 = (bf16_t*)(ws + WS_W3); bf16_t* W4 = (bf16_t*)(ws + WS_W4);
    bf16_t* PROJ = (bf16_t*)(ws + WS_PROJ); bf16_t* X1B = (bf16_t*)(ws + WS_X1B); bf16_t* ACT = (bf16_t*)(ws + WS_ACT);
    bf16_t* OB = (bf16_t*)(ws + WS_OB);
    signed char* XQ = (signed char*)(ws + WS_XQ); float* FX = (float*)(ws + WS_FX); signed char* W1Q = (signed char*)(ws + WS_W1);
    for (int u = tid; u < 128; u += NWAVES * 64) ((LAS unsigned*)(lds + MISC_OFF))[u] = 0u;
    __syncthreads();
    XcdBarrier bar; bar.bar = ctl + CW_BAR + args.li * XCD_BAR_WORDS; bar.x = 0; bar.st = nullptr;
    if (MK_N_LAUNCHES != 6) bar = xcd_barrier_post(ctl + CW_BAR + args.li * XCD_BAR_WORDS, MISC + 8);
    const int lo = args.ph_lo, hi_ph = args.ph_hi;
#ifndef ONLY_PHASE
#define ONLY_PHASE -1
#endif
#define IN(k) ((ONLY_PHASE < 0 || ONLY_PHASE == (k)) && lo <= (k) && (k) < hi_ph)
#define BOTH(k) (IN(k) && IN((k) + 1))
#define GRID_BAR() do { if (MK_N_LAUNCHES != 6) xcd_barrier(bar); } while (0)
#define GROUP_BAR() do { if (MK_N_LAUNCHES != 6) { if (G == 256) group_barrier(ctl + CW_GBAR + (bx & 7) * 128, 32u, MISC + 12); else xcd_barrier(bar); } } while (0)

    if (IN(0)) {
        LAS float* scr = (LAS float*)(lds + wave * 16384);
        const int gw = vcu * NWAVES + wave, NGW = G * NWAVES;
        constexpr int I1 = (DM / 64) * (DIN / 32), I2 = (DM / 64) * (DM / 32), I3 = (DM / 64) * (2 * DFF / 32), I4 = (DFF / 64) * (DM / 32);
        for (int it = gw; it < I1 + I2 + I3 + I4; it += NGW) {
            int r = it;
            if (r < I1) { const int nblk = DIN / 32, kb = r / nblk, nb = r % nblk, n0 = 32 * nb, pn = n0 >> 8, p = n0 & 255, bj = p >> 7, wc = (p & 127) >> 5;
                absmax_item(args.in[3], DIN, 256 * pn + 64 * wc + 32 * bj, 64 * kb, ctl + CW_WMAX1 + n0, args.in[2], lane);
                asm volatile("s_waitcnt vmcnt(0)" ::: "memory"); if (lane == 0) (void)__hip_atomic_fetch_add(ctl + CW_W1CNT, 1u, __ATOMIC_RELAXED, __HIP_MEMORY_SCOPE_AGENT); continue; } r -= I1;
            if (r < I2) { const int nblk = DM / 32, kb = r / nblk, nb = r % nblk;
                const int n0 = 32 * nb, pn = n0 >> 8, p = n0 & 255, bj = p >> 7, wc = (p & 127) >> 5;
                transpose_item(args.in[15], DM, 256 * pn + 64 * wc + 32 * bj, DM, 64 * kb, W2, n0, args.in[10], 127, 1.0f - LAM_INIT, 512, scr, lane); continue; } r -= I2;
            if (r < I3) { const int nblk = 2 * DFF / 32, kb = r / nblk, nb = r % nblk, n0 = 32 * nb, pn = n0 >> 8, p = n0 & 255, bj = p >> 7, e0 = p & 127;
                absmax_item(bj ? args.in[18] : args.in[17], DFF, 128 * pn + e0, 64 * kb, ctl + CW_WMAX + n0, args.in[16], lane); continue; } r -= I3;
            { const int nblk = DM / 32, kb = r / nblk, nb = r % nblk;
                absmax_item(args.in[21], DM, 32 * nb, 64 * kb, ctl + CW_WMAX4 + 32 * nb, nullptr, lane); }
        }
        for (int m = gw; m < NTOK; m += 4 * NGW) {
            f32x4 v[4][4]; float ss[4]; int mr[4];
#pragma unroll
            for (int q = 0; q < 4; ++q) { int mm = m + q * NGW; mr[q] = mm; if (mm >= NTOK) mm = m;
                const float* xr = mm < TOK_P ? xp + (size_t)mm * DM : xs + (size_t)(mm - TOK_P) * DM;
#pragma unroll
                for (int j = 0; j < 4; ++j) v[q][j] = __builtin_nontemporal_load((const f32x4*)xr + 64 * j + lane); }
#pragma unroll
            for (int q = 0; q < 4; ++q) { ss[q] = 0.f;
#pragma unroll
                for (int j = 0; j < 4; ++j) ss[q] += dot4(v[q][j]); }
#pragma unroll
            for (int o = 1; o < 64; o <<= 1) {
#pragma unroll
                for (int q = 0; q < 4; ++q) ss[q] += __shfl_xor(ss[q], o); }
            float am[4];
#pragma unroll
            for (int q = 0; q < 4; ++q) { float a = 0.f;
#pragma unroll
                for (int j = 0; j < 4; ++j) a = __builtin_fmaxf(__builtin_fmaxf(a, __builtin_fmaxf(__builtin_fabsf(v[q][j][0]), __builtin_fabsf(v[q][j][1]))), __builtin_fmaxf(__builtin_fabsf(v[q][j][2]), __builtin_fabsf(v[q][j][3])));
                am[q] = a; }
#pragma unroll
            for (int o = 1; o < 64; o <<= 1) {
#pragma unroll
                for (int q = 0; q < 4; ++q) am[q] = __builtin_fmaxf(am[q], __shfl_xor(am[q], o)); }
#pragma unroll
            for (int q = 0; q < 4; ++q) if (mr[q] < NTOK) { const float ms = ss[q] * (1.f / DM) + EPS; const float r = __builtin_amdgcn_rsqf(ms);
                { const float inv = am[q] > 0.f ? 127.0f / am[q] : 0.f;
                  unsigned* oq = (unsigned*)(XQ + (size_t)mr[q] * DM) + lane;
#pragma unroll
                  for (int j = 0; j < 4; ++j) oq[64 * j] = q4(v[q][j][0] * inv, v[q][j][1] * inv, v[q][j][2] * inv, v[q][j][3] * inv);
                  if (lane == 0) { FX[mr[q]] = am[q] * r * (1.0f / 127.0f); ((float*)(ws + WS_X0S))[mr[q]] = am[q] * (1.0f / 127.0f); } }
            }
        }
        { unsigned sp = 0; while (__builtin_amdgcn_readfirstlane(__hip_atomic_load(ctl + CW_W1CNT, __ATOMIC_RELAXED, __HIP_MEMORY_SCOPE_AGENT)) < (unsigned)I1) { __builtin_amdgcn_s_sleep(2); if (++sp > (1u << 22)) break; }
          __builtin_amdgcn_fence(__ATOMIC_ACQUIRE, "agent"); }
        for (int r = gw; r < I1; r += NGW) { const int nblk = DIN / 32, kb = r / nblk, nb = r % nblk, n0 = 32 * nb, pn = n0 >> 8, p = n0 & 255, bj = p >> 7, wc = (p & 127) >> 5;
            quant_item(args.in[3], DIN, 256 * pn + 64 * wc + 32 * bj, DM, 64 * kb, W1Q, n0, args.in[2], ctl + CW_WMAX1 + n0, scr, lane); }
        if (BOTH(0)) GRID_BAR();
    }

    if (IN(1)) {
        {
            LAS float* scr = (LAS float*)(lds + wave * 16384);
            constexpr int I3 = (DM / 64) * (2 * DFF / 32), I4 = (DFF / 64) * (DM / 32), IT = I3 + I4;
            const int gx = bx & 7, lo_ = (int)((long)IT * (gx * (gx - 1) / 2) / 28), hi_ = (int)((long)IT * (gx * (gx + 1) / 2) / 28);
            for (int r = lo_ + (bx >> 3) * NWAVES + wave; r < hi_; r += (G / 8) * NWAVES) {
                if (r < I3) { const int nblk = 2 * DFF / 32, kb = r / nblk, nb = r % nblk, n0 = 32 * nb, pn = n0 >> 8, p = n0 & 255, bj = p >> 7, e0 = p & 127;
                    quant_item(bj ? args.in[18] : args.in[17], DFF, 128 * pn + e0, DM, 64 * kb, (signed char*)(ws + WS_W3), n0, args.in[16], ctl + CW_WMAX + n0, scr, lane); }
                else { const int r4 = r - I3, nblk = DM / 32, kb = r4 / nblk, nb = r4 % nblk;
                    quantf8_item(args.in[21], DM, 32 * nb, DFF, 64 * kb, (unsigned char*)(ws + WS_W4), 32 * nb, ctl + CW_WMAX4 + 32 * nb, scr, lane); } }
            __syncthreads(); }
        pg8::Gemm g{(const bf16_t*)XQ, (const bf16_t*)W1Q, DM / 2, 256}; pg8::StaticOrder S; S.init(NTOK / 256, DIN / 256, G, bx);
        { LAS float* gl = (LAS float*)(lds + EPX_OFF);
          if (tid < 256) { const int v = tid >> 6, d = tid & 63; gl[tid] = (v == 0 ? args.in[4] : v == 1 ? args.in[5] : v == 2 ? args.in[11] : args.in[12])[d]; }
          LDS_WAIT(); __syncthreads(); }
        pg8::EpiProj E{PROJ, (const LAS float*)(lds + EPX_OFF), FX, (const float*)(ctl + CW_WMAX1)};
        pg8::gemm_phase<pg8::EpiProj, pg8::StaticOrder, true, true, 1>(lds, g, S, E);
        if (BOTH(1)) GROUP_BAR();
    }

    if (IN(2)) {
        if (wave == 0) {
            const float a = args.in[6][lane] * args.in[7][lane], b2 = args.in[8][lane] * args.in[9][lane];
            const float sa = wave_sum(a), sb = wave_sum(b2);
            if (lane == 0) ((LAS float*)(lds + MISC_OFF))[16] = __expf(sa) - __expf(sb) + LAM_INIT;
        }
        LDS_WAIT(); __syncthreads();
        const float lam = ((const LAS float*)(lds + MISC_OFF))[16];
        const int per = (768 + G - 1) / G;
#ifndef NO_DIFF
        for (int i = 0; i < per; ++i) { const int u = vcu * per + i; if (u < 768) { const int bh = u >> 3, qb = u & 7;
            att::diff_unit(bh >> 2, bh & 3, qb, PROJ, OB, (LAS char*)lds, lam, args.in[14]); } }
#endif
#ifndef NO_WIN
        for (int i = 0; i < per; ++i) { const int u = vcu * per + i; if (u < 768) { const int bk = u >> 4, qb = u & 15;
            att::win_unit(bk >> 1, bk & 1, qb, PROJ, OB, (LAS char*)lds, args.in[14], args.in[13]); } }
#endif
        if (BOTH(2)) GROUP_BAR();
    }

    if (IN(3)) {
        pg8::Gemm g{OB, W2, DM, 256}; pg8::StaticOrder S; S.init(NTOK / 256, DM / 256, G, bx);
        pg8::EpiOut E{(const signed char*)(ws + WS_XQ), (const float*)(ws + WS_X0S), (float*)(ws + WS_FX), (LAS float*)(lds + EPX_OFF), (signed char*)(ws + WS_X1Q), (float*)(ws + WS_FA), (float*)(ws + WS_XS), ctl + CW_P3CNT};
        pg8::gemm_phase<pg8::EpiOut, pg8::StaticOrder>(lds, g, S, E);
        if (BOTH(3)) GRID_BAR();
    }

    if (IN(4)) {
        signed char* W3Q = (signed char*)(ws + WS_W3); signed char* X1Q = (signed char*)(ws + WS_X1Q); float* FA = (float*)(ws + WS_FA);
        pg8::Gemm g{(const bf16_t*)(X1Q - DM), (const bf16_t*)W3Q, DM / 2, 254}; pg8::StaticOrder S; S.init(194, 2 * DFF / 256, G, bx);
        pg8::EpiFfn E{(unsigned char*)ACT, FA, (const float*)(ctl + CW_WMAX), args.in[19], args.in[20], (LAS float*)(lds + EPX_OFF)};
        pg8::gemm_phase<pg8::EpiFfn, pg8::StaticOrder, true, true, 1>(lds, g, S, E);
        if (BOTH(4)) GRID_BAR();
    }

    if (IN(5)) {
        pg8::Gemm g{ACT, W4, DFF / 2, 256}; pg8::StaticOrder S; S.init(NTOK / 256, DM / 256, G, bx, 1);
        pg8::EpiDown E{(const signed char*)(ws + WS_X1Q), (const float*)(ws + WS_FX), args.out, (const float*)(ctl + CW_WMAX4)};
        pg8::gemm_phase<pg8::EpiDown, pg8::StaticOrder, true, true, 2>(lds, g, S, E);
    }
#undef IN
#undef BOTH
#undef GRID_BAR
}

extern "C" void kernel_launch(void* const* d_in, const int* in_sizes, int n_in, void* d_out, int out_size, void* d_ws, size_t ws_size, hipStream_t stream) {
    static int grid = 0;
    if (grid == 0) {
        if (n_in != 22 || in_sizes[0] != TOK_P * DM || in_sizes[1] != (NTOK - TOK_P) * DM || out_size != NTOK * DM || ws_size < WS_END) {
            fprintf(stderr, "kernel_launch: shape mismatch (n_in %d, in0 %d, in1 %d, out %d, ws %zu; need ws >= %zu)\n", n_in, n_in > 0 ? in_sizes[0] : -1, n_in > 1 ? in_sizes[1] : -1, out_size, ws_size, (size_t)WS_END); grid = -1; return; }
        int dev = 0, cus = 0;
        if (hipGetDevice(&dev) != hipSuccess || hipDeviceGetAttribute(&cus, hipDeviceAttributeMultiprocessorCount, dev) != hipSuccess) { fprintf(stderr, "kernel_launch: device query failed\n"); grid = -1; return; }
        if (hipFuncSetAttribute((const void*)hymba_fwd, hipFuncAttributeMaxDynamicSharedMemorySize, LDS_BYTES) != hipSuccess) { fprintf(stderr, "kernel_launch: hipFuncSetAttribute failed\n"); grid = -1; return; }
        int per_cu = 0;
        if (hipOccupancyMaxActiveBlocksPerMultiprocessor(&per_cu, (const void*)hymba_fwd, NWAVES * 64, LDS_BYTES) != hipSuccess || per_cu < 1)
            fprintf(stderr, "kernel_launch: note: occupancy query reports %d workgroups per CU\n", per_cu);
        (void)hipGetLastError();
        if (cus < 256) { fprintf(stderr, "kernel_launch: %d CUs; this kernel's unit schedule (co-running tile owners in the out-projection epilogue) is built for 256\n", cus); grid = -1; return; }
        grid = 256;
    }
    if (grid < 0) return;
    (void)hipMemsetAsync((char*)d_ws + WS_CTL, 0, CTL_ZERO_BYTES, stream);
    Args a{};
    for (int i = 0; i < 22; ++i) a.in[i] = (const float*)d_in[i];
    a.out = (float*)d_out; a.ws = (unsigned char*)d_ws;
#ifndef PROBE_DUP
#define PROBE_DUP -1
#endif
    constexpr int NL = (PROBE_DUP >= 0) ? 3 : MK_N_LAUNCHES;
    for (int li = 0; li < NL; ++li) {
        if (PROBE_DUP >= 0) {
            a.ph_lo = li == 0 ? 0 : (li == 1 ? PROBE_DUP : PROBE_DUP + 1); a.ph_hi = li == 2 ? 6 : PROBE_DUP + 1; a.li = li;
        } else { a.ph_lo = (NL == 6) ? li : 0; a.ph_hi = (NL == 6) ? li + 1 : 6; a.li = (NL == 6) ? 0 : li; }
        hipLaunchKernelGGL(hymba_fwd, dim3(grid), dim3(NWAVES * 64), LDS_BYTES, stream, a);
        const hipError_t le = hipPeekAtLastError();
        if (le != hipSuccess) { fprintf(stderr, "kernel_launch: launch %d failed: %s\n", li, hipGetErrorName(le)); break; }
    }
}
```

```cpp
#include <hip/hip_runtime.h>
#include <hip/hip_bf16.h>
#include <cstdio>
#include <cstdint>

#ifndef MK_N_LAUNCHES
#define MK_N_LAUNCHES 1
#endif

#define LAS __attribute__((address_space(3)))
#define GAS __attribute__((address_space(1)))
typedef unsigned short bf16_t;
typedef short bf16x8 __attribute__((ext_vector_type(8)));
typedef short s16x4 __attribute__((ext_vector_type(4)));
typedef float f32x2 __attribute__((ext_vector_type(2)));
typedef float f32x4 __attribute__((ext_vector_type(4)));
typedef float f32x16 __attribute__((ext_vector_type(16)));
typedef unsigned u32x2 __attribute__((ext_vector_type(2)));
typedef unsigned u32x4 __attribute__((ext_vector_type(4)));
typedef __bf16 bf16x2_t __attribute__((ext_vector_type(2)));

constexpr int DM = 1024, SEQ = 2048, NSEQ = 24, NTOK = NSEQ * SEQ, TOK_P = 8 * SEQ;
constexpr int DIN = 2304, DFF = 2816;
constexpr int C_DQ = 0, C_DK = 512, C_DV = 1024, C_WQ = 1536, C_WK = 2048, C_WV = 2176;
constexpr int NBH = 12;
constexpr float EPS = 1e-6f, LOG2E = 1.4426950408889634f, QSCALE = 0.125f * LOG2E;
constexpr float LAM_INIT = 0.2f;
constexpr int NWAVES = 8;

__device__ __forceinline__ unsigned cvtpk(float lo, float hi) { f32x2 v = {lo, hi}; bf16x2_t b = __builtin_convertvector(v, bf16x2_t); return __builtin_bit_cast(unsigned, b); }
__device__ __forceinline__ u32x4 pack8(f32x4 a, f32x4 b) { u32x4 w; w.x = cvtpk(a[0], a[1]); w.y = cvtpk(a[2], a[3]); w.z = cvtpk(b[0], b[1]); w.w = cvtpk(b[2], b[3]); return w; }
__device__ __forceinline__ float dot4(f32x4 a) { return (a[0] * a[0] + a[1] * a[1]) + (a[2] * a[2] + a[3] * a[3]); }

__device__ __forceinline__ unsigned q4(float a, float b, float c, float d) {
    const unsigned ua = __float_as_uint(a + 12582912.0f), ub = __float_as_uint(b + 12582912.0f), uc = __float_as_uint(c + 12582912.0f), ud = __float_as_uint(d + 12582912.0f);
    return (ua & 0xffu) | ((ub & 0xffu) << 8) | ((uc & 0xffu) << 16) | (ud << 24);
}
__device__ __forceinline__ unsigned f8x4(float a, float b, float c, float d) {
    int w = 0;
    w = __builtin_amdgcn_cvt_pk_fp8_f32(__builtin_amdgcn_fmed3f(a, -448.f, 448.f), __builtin_amdgcn_fmed3f(b, -448.f, 448.f), w, false);
    w = __builtin_amdgcn_cvt_pk_fp8_f32(__builtin_amdgcn_fmed3f(c, -448.f, 448.f), __builtin_amdgcn_fmed3f(d, -448.f, 448.f), w, true);
    return (unsigned)w;
}
constexpr float ACT8_SCALE = 8.0f, W8_TOP = 224.0f;
namespace pg8 {
constexpr int BM = 256, BK = 64, HALF = 128, HTB = HALF * BK * 2, STAGE_BYTES = 8 * HTB, NXCD = 8, WGM = 8;
__host__ __device__ __forceinline__ int lds_byte(int r, int c) { const int st = (r >> 4) * 2 + (c >> 5), rr = r & 15, cc = c & 31, ob = rr * 64 + cc * 2; return st * 1024 + (ob ^ (((ob >> 9) & 1) << 5)); }
__host__ __device__ __forceinline__ void stage_rc(int b, int& R, int& C) { const int st = b / 1024, sb = b % 1024, swz = sb ^ (((sb >> 9) & 1) << 5); R = (st >> 1) * 16 + swz / 64; C = (st & 1) * 32 + (swz % 64) / 2; }
__host__ __device__ __forceinline__ int perm32(int rho) { const int n = rho >> 4, i = rho & 15; return 8 * (i >> 2) + 4 * n + (i & 3); }

typedef int v4i32_t __attribute__((ext_vector_type(4)));
struct Unit { int pm, pn; };
struct Gemm { const bf16_t* A; const bf16_t* Bt; int K; int arows; };

struct StaticOrder {
    int nM, nN, nwg, G, c, rev;
    __device__ void init(int nM_, int nN_, int G_, int c_, int rev_ = 0) { nM = nM_; nN = nN_; nwg = nM * nN; G = G_; c = c_; rev = rev_; }
    __device__ bool next(int i, Unit& u) const {
        const int nr = (nwg - c + G - 1) / G; if (i >= nr) return false;
        const long L = (long)(rev ? nr - 1 - i : i) * G + c;
        int wgid = (int)L; { const int q = nwg / NXCD, r = nwg % NXCD, xcd = wgid % NXCD, off = wgid / NXCD; wgid = (xcd < r ? xcd * (q + 1) : r * (q + 1) + (xcd - r) * q) + off; }
        const int nig = WGM * nN, gid = wgid / nig, fm = gid * WGM, gsz = (nM - fm) < WGM ? (nM - fm) : WGM;
        u.pm = fm + ((wgid % nig) % gsz); u.pn = (wgid % nig) / gsz; return true;
    }
};


struct EpiProj {
    static constexpr bool PERM = true;
    bf16_t* P; const LAS float* gl; const float* fx; const float* swm;
    __device__ __forceinline__ void pre(const Unit& u, int wid, int lane_) const {
        int lane = lane_; asm volatile("" : "+v"(lane));
        if (wid >= 4) __builtin_amdgcn_global_load_lds((const unsigned*)(fx + u.pm * BM + 64 * (wid - 4) + lane), (LAS unsigned*)((LAS char*)gl + 1024 + (wid - 4) * 256), 4, 0, 0);
        if (wid == 2) __builtin_amdgcn_global_load_lds((const unsigned*)(swm + u.pn * 256 + lane * 4), (LAS unsigned*)((LAS char*)gl + 2048), 16, 0, 0);
    }
    __device__ __forceinline__ void operator()(const f32x4 (&acc)[2][2][4][2], const Unit& u, int wr, int wc, int fr, int fq, int lane) const {
        int fql = fq; asm volatile("" : "+v"(fql));
        f32x4 csw[2][2];
#pragma unroll
        for (int bj = 0; bj < 2; ++bj)
#pragma unroll
            for (int n = 0; n < 2; ++n) csw[bj][n] = *(const LAS f32x4*)(gl + 512 + 128 * bj + 32 * wc + 8 * fql + 4 * n) * (1.0f / 127.0f);
        const int gidx = u.pn * 4 + wc;
        int gsel = -1; float sc = 1.f;
        if (gidx < 8) { gsel = 0; sc = QSCALE; } else if (gidx < 16) { gsel = 1; } else if (gidx < 24) { } else if (gidx < 32) { gsel = 2; sc = QSCALE; } else if (gidx < 34) { gsel = 3; }
        const bool nrm = gsel >= 0; const LAS float* gain = gl + (nrm ? gsel : 0) * 64;
        f32x4 gv[2][2];
#pragma unroll
        for (int bj = 0; bj < 2; ++bj)
#pragma unroll
            for (int n = 0; n < 2; ++n) gv[bj][n] = nrm ? *(const LAS f32x4*)(gain + 32 * bj + 8 * fq + 4 * n) * sc : (f32x4){1.f, 1.f, 1.f, 1.f};
        bf16_t* base = P + (size_t)(u.pm * BM + wr * 64 + fr) * DIN + gidx * 64 + 8 * fq;
#pragma unroll
        for (int ai = 0; ai < 2; ++ai)
#pragma unroll
            for (int m = 0; m < 4; ++m) {
                const float fxr = gl[256 + ai * HALF + wr * 64 + m * 16 + fr];
                f32x4 v00 = __builtin_convertvector(__builtin_bit_cast(v4i32_t, acc[ai][0][m][0]), f32x4) * (csw[0][0] * fxr), v01 = __builtin_convertvector(__builtin_bit_cast(v4i32_t, acc[ai][0][m][1]), f32x4) * (csw[0][1] * fxr);
                f32x4 v10 = __builtin_convertvector(__builtin_bit_cast(v4i32_t, acc[ai][1][m][0]), f32x4) * (csw[1][0] * fxr), v11 = __builtin_convertvector(__builtin_bit_cast(v4i32_t, acc[ai][1][m][1]), f32x4) * (csw[1][1] * fxr);
                float rn = 1.f;
                if (nrm) { float ss = (dot4(v00) + dot4(v01)) + (dot4(v10) + dot4(v11)); ss += __shfl_xor(ss, 16); ss += __shfl_xor(ss, 32); rn = __builtin_amdgcn_rsqf(ss * (1.0f / 64.0f) + EPS); }
                v00 = v00 * rn * gv[0][0]; v01 = v01 * rn * gv[0][1]; v10 = v10 * rn * gv[1][0]; v11 = v11 * rn * gv[1][1];
                bf16_t* rowp = base + (size_t)(ai * HALF + m * 16) * DIN;
                const u32x4 pa = pack8(v00, v01), pb = pack8(v10, v11);
                u32x4 px; px.x = (unsigned)__builtin_amdgcn_mov_dpp((int)pb.x, 0x128, 0xf, 0xf, true); px.y = (unsigned)__builtin_amdgcn_mov_dpp((int)pb.y, 0x128, 0xf, 0xf, true);
                px.z = (unsigned)__builtin_amdgcn_mov_dpp((int)pb.z, 0x128, 0xf, 0xf, true); px.w = (unsigned)__builtin_amdgcn_mov_dpp((int)pb.w, 0x128, 0xf, 0xf, true);
                const bool hi8 = (fr & 8) != 0;
                bf16_t* r1p = base + (size_t)(ai * HALF + m * 16 - (hi8 ? 8 : 0)) * DIN + (hi8 ? 32 : 0);
                bf16_t* r2p = base + (size_t)(ai * HALF + m * 16 + (hi8 ? 0 : 8)) * DIN + (hi8 ? 0 : 32);
                *(u32x4*)(r1p) = hi8 ? px : pa; *(u32x4*)(r2p) = hi8 ? pa : px;
            }
    }
};

struct EpiOut {
    static constexpr bool PERM = true;
    const signed char* xq0; const float* __restrict__ sx0; float* __restrict__ sx1; LAS float* xl;
    signed char* x1q; float* fa; float* xs; unsigned* cnt;
    __device__ __forceinline__ void pre(const Unit&, int, int) const {}
    __device__ __forceinline__ void operator()(f32x4 (&acc)[2][2][4][2], const Unit& u, int wr, int wc, int fr, int fq, int lane) const {
        asm volatile("" : "+v"(fr), "+v"(fq));
        const int rowbase = u.pm * BM;
        const int col0 = u.pn * BM + wc * 64 + 8 * fq;
#pragma unroll
        for (int ai = 0; ai < 2; ++ai) {
            u32x2 xv[4][2]; float s0[4];
#pragma unroll
            for (int m = 0; m < 4; ++m) { const size_t row = (size_t)(rowbase + ai * HALF + wr * 64 + m * 16 + fr); const signed char* xr = xq0 + row * DM + col0;
                s0[m] = sx0[row];
#pragma unroll
                for (int bj = 0; bj < 2; ++bj) xv[m][bj] = *(const u32x2*)(xr + bj * 32); }
#pragma unroll
            for (int m = 0; m < 4; ++m) {
                const int rl = ai * HALF + wr * 64 + m * 16 + fr; float s = 0.f, am = 0.f;
#pragma unroll
                for (int bj = 0; bj < 2; ++bj) {
                    const int wx = (int)xv[m][bj].x, wy = (int)xv[m][bj].y; f32x4 x0, x1;
                    x0[0] = (float)((wx << 24) >> 24); x0[1] = (float)((wx << 16) >> 24); x0[2] = (float)((wx << 8) >> 24); x0[3] = (float)(wx >> 24);
                    x1[0] = (float)((wy << 24) >> 24); x1[1] = (float)((wy << 16) >> 24); x1[2] = (float)((wy << 8) >> 24); x1[3] = (float)(wy >> 24);
                    const f32x4 o0 = x0 * s0[m] + acc[ai][bj][m][0], o1 = x1 * s0[m] + acc[ai][bj][m][1];
                    acc[ai][bj][m][0] = o0; acc[ai][bj][m][1] = o1;
#pragma unroll
                    for (int i = 0; i < 4; ++i) am = __builtin_fmaxf(am, __builtin_fmaxf(__builtin_fabsf(o0[i]), __builtin_fabsf(o1[i])));
                    s += dot4(o0) + dot4(o1); }
                s += __shfl_xor(s, 16); s += __shfl_xor(s, 32);
                am = __builtin_fmaxf(am, __shfl_xor(am, 16)); am = __builtin_fmaxf(am, __shfl_xor(am, 32));
                if (fq == 0) { xl[rl * 8 + wc] = s; xl[rl * 8 + 4 + wc] = am; }
            }
        }
        asm volatile("s_waitcnt lgkmcnt(0)" ::: "memory"); __builtin_amdgcn_s_barrier(); asm volatile("" ::: "memory");
        const int t = (wr * 4 + wc) * 64 + lane;
        if (t < 256) {
            const f32x4 q = *(const LAS f32x4*)(xl + t * 8), a4 = *(const LAS f32x4*)(xl + t * 8 + 4);
            float* sl = xs + ((size_t)(rowbase + t) * 4 + u.pn) * 2;
            __hip_atomic_store(sl, (q[0] + q[1]) + (q[2] + q[3]), __ATOMIC_RELAXED, __HIP_MEMORY_SCOPE_AGENT);
            __hip_atomic_store(sl + 1, __builtin_fmaxf(__builtin_fmaxf(a4[0], a4[1]), __builtin_fmaxf(a4[2], a4[3])), __ATOMIC_RELAXED, __HIP_MEMORY_SCOPE_AGENT);
            asm volatile("s_waitcnt vmcnt(0)" ::: "memory");
            if (lane == 0) (void)__hip_atomic_fetch_add(cnt + u.pm, 1u, __ATOMIC_RELAXED, __HIP_MEMORY_SCOPE_AGENT);
        }
        if (t < 64) {
            unsigned sp = 0; while (__builtin_amdgcn_readfirstlane(__hip_atomic_load(cnt + u.pm, __ATOMIC_RELAXED, __HIP_MEMORY_SCOPE_AGENT)) < 16u) { __builtin_amdgcn_s_sleep(1); if (++sp > (1u << 22)) break; }
        }
        asm volatile("s_waitcnt lgkmcnt(0)" ::: "memory"); __builtin_amdgcn_s_barrier(); asm volatile("" ::: "memory");
        if (t < 256) {
            const float* sl = xs + (size_t)(rowbase + t) * 8; float ss = 0.f, am = 0.f;
#pragma unroll
            for (int j = 0; j < 4; ++j) { ss += __hip_atomic_load(sl + 2 * j, __ATOMIC_RELAXED, __HIP_MEMORY_SCOPE_AGENT); am = __builtin_fmaxf(am, __hip_atomic_load(sl + 2 * j + 1, __ATOMIC_RELAXED, __HIP_MEMORY_SCOPE_AGENT)); }
            xl[2048 + t] = am > 0.f ? 127.0f / am : 0.f;
            if (u.pn == 0) { fa[rowbase + t] = __builtin_amdgcn_rsqf(ss * (1.0f / DM) + EPS) * am * (1.0f / 127.0f); sx1[rowbase + t] = am * (1.0f / 127.0f); }
        }
        asm volatile("s_waitcnt lgkmcnt(0)" ::: "memory"); __builtin_amdgcn_s_barrier(); asm volatile("" ::: "memory");
#pragma unroll
        for (int ai = 0; ai < 2; ++ai)
#pragma unroll
            for (int m = 0; m < 4; ++m) { const int rl = ai * HALF + wr * 64 + m * 16 + fr; const float inv = xl[2048 + rl];
                signed char* qp = x1q + (size_t)(rowbase + rl) * DM + col0;
#pragma unroll
                for (int bj = 0; bj < 2; ++bj) { const f32x4 b0 = acc[ai][bj][m][0] * inv, b1 = acc[ai][bj][m][1] * inv;
                    u32x2 o; o.x = q4(b0[0], b0[1], b0[2], b0[3]); o.y = q4(b1[0], b1[1], b1[2], b1[3]);
                    *(u32x2*)(qp + 32 * bj) = o; } }
    }
};

__device__ __forceinline__ float dpp8(float x) { return __builtin_bit_cast(float, __builtin_amdgcn_mov_dpp(__builtin_bit_cast(int, x), 0x128, 0xf, 0xf, true)); }
struct EpiDown {
    static constexpr bool PERM = true;
    const signed char* __restrict__ x1q; const float* __restrict__ sx1; float* __restrict__ out; const float* __restrict__ wmx;
    __device__ __forceinline__ void pre(const Unit&, int, int) const {}
    __device__ __forceinline__ void operator()(const f32x4 (&acc)[2][2][4][2], const Unit& u, int wr, int wc, int fr, int fq, int lane) const {
        asm volatile("" : "+v"(fr), "+v"(fq));
        const int col0 = u.pn * BM + wc * 32 + 8 * fq; const bool hi8 = (fr & 8) != 0;
        f32x4 cs[2][2];
#pragma unroll
        for (int bj = 0; bj < 2; ++bj)
#pragma unroll
            for (int n = 0; n < 2; ++n) cs[bj][n] = *(const f32x4*)(wmx + col0 + bj * HALF + 4 * n) * (1.0f / (W8_TOP * ACT8_SCALE));
#pragma unroll
        for (int ai = 0; ai < 2; ++ai) {
            u32x2 w[4][2]; float sx[4];
#pragma unroll
            for (int m = 0; m < 4; ++m) { const size_t row = (size_t)(u.pm * BM + ai * HALF + wr * 64 + m * 16 + fr); const size_t off = row * DM + col0;
                sx[m] = sx1[row];
#pragma unroll
                for (int bj = 0; bj < 2; ++bj) w[m][bj] = *(const u32x2*)(x1q + off + bj * HALF); }
#pragma unroll
            for (int m = 0; m < 4; ++m) { const size_t off = (size_t)(u.pm * BM + ai * HALF + wr * 64 + m * 16 + fr) * DM + col0;
#pragma unroll
                for (int bj = 0; bj < 2; ++bj) { const int wx = (int)w[m][bj].x, wy = (int)w[m][bj].y;
                    f32x4 r0, r1;
                    r0[0] = (float)((wx << 24) >> 24) * sx[m]; r0[1] = (float)((wx << 16) >> 24) * sx[m]; r0[2] = (float)((wx << 8) >> 24) * sx[m]; r0[3] = (float)(wx >> 24) * sx[m];
                    r1[0] = (float)((wy << 24) >> 24) * sx[m]; r1[1] = (float)((wy << 16) >> 24) * sx[m]; r1[2] = (float)((wy << 8) >> 24) * sx[m]; r1[3] = (float)(wy >> 24) * sx[m];
                    const f32x4 q0 = r0 + acc[ai][bj][m][0] * cs[bj][0], q1 = r1 + acc[ai][bj][m][1] * cs[bj][1];
                    f32x4 qx; qx[0] = dpp8(q1[0]); qx[1] = dpp8(q1[1]); qx[2] = dpp8(q1[2]); qx[3] = dpp8(q1[3]);
                    const long d1 = hi8 ? (long)(4 - 8 * DM) : 0, d2 = hi8 ? 0 : (long)(4 + 8 * DM);
                    __builtin_nontemporal_store(hi8 ? qx : q0, (f32x4*)(out + off + bj * HALF + d1)); __builtin_nontemporal_store(hi8 ? q0 : qx, (f32x4*)(out + off + bj * HALF + d2)); } } }
    }
};

template <int CTRL> __device__ __forceinline__ float dppz(float x) { return __builtin_bit_cast(float, __builtin_amdgcn_update_dpp(0, __builtin_bit_cast(int, x), CTRL, 0xf, 0xf, true)); }
struct EpiFfn {
    static constexpr bool PERM = true;
    unsigned char* act; const float* fa; const float* swm; const float* cw; const float* cb; LAS float* xl;
    __device__ __forceinline__ void pre(const Unit& u, int wid, int lane_) const {
        int lane = lane_; asm volatile("" : "+v"(lane));
        const int tok0 = 254 * u.pm - 1;
        if (wid >= 4) { int tok = tok0 + 64 * (wid - 4) + lane; tok = tok < 0 ? 0 : (tok > NTOK - 1 ? NTOK - 1 : tok);
            __builtin_amdgcn_global_load_lds((const unsigned*)(fa + tok), (LAS unsigned*)((LAS char*)xl + 4096 + (wid - 4) * 256), 4, 0, 0); }
        if (wid == 2) __builtin_amdgcn_global_load_lds((const unsigned*)(swm + u.pn * 256 + lane * 4), (LAS unsigned*)((LAS char*)xl + 5120), 16, 0, 0);
        if (wid < 2) { const float* src = (wid == 0 ? (lane < 32 ? cw : cw + DFF) : (lane < 32 ? cw + 2 * DFF : cb)) + u.pn * 128 + (lane & 31) * 4;
            __builtin_amdgcn_global_load_lds((const unsigned*)src, (LAS unsigned*)((LAS char*)xl + 20480 + wid * 1024), 16, 0, 0); }
    }
    template <int AI, int M, bool MASK>
    __device__ __forceinline__ void conv_rows(const f32x4 (&acc)[2][2][4][2], const f32x4 (&w0)[2], const f32x4 (&w1)[2], const f32x4 (&w2)[2], const f32x4 (&bb)[2],
                                              int tok, int rl, int G, int xc, int fr, int ch0) const {
        const bool pcut = MASK && (tok & (SEQ - 1)) == 0, ncut = MASK && (tok & (SEQ - 1)) == SEQ - 1;
        f32x4 r0, r1;
#pragma unroll
        for (int n = 0; n < 2; ++n) { f32x4 res;
            f32x4 ex = (f32x4){0.f, 0.f, 0.f, 0.f};
            if (M == 0) { if (G > 0) ex = *(const LAS f32x4*)(xl + (2 * (G - 1) + 1) * 128 + xc + 4 * n); ex = fr == 0 ? ex : (f32x4){0.f, 0.f, 0.f, 0.f}; }
            if (M == 3) { if (G < 3) ex = *(const LAS f32x4*)(xl + (2 * (G + 1)) * 128 + xc + 4 * n); ex = fr == 15 ? ex : (f32x4){0.f, 0.f, 0.f, 0.f}; }
#pragma unroll
            for (int i = 0; i < 4; ++i) {
                const float own = acc[AI][0][M][n][i];
                float pr = dppz<0x111>(own);
                pr += (M > 0) ? dppz<0x10F>(acc[AI][0][M > 0 ? M - 1 : 0][n][i]) : ex[i];
                float nx = dppz<0x101>(own);
                nx += (M < 3) ? dppz<0x11F>(acc[AI][0][M < 3 ? M + 1 : 3][n][i]) : ex[i];
                if (MASK) { pr = pcut ? 0.f : pr; nx = ncut ? 0.f : nx; }
                const float uc = fmaf(w0[n][i], pr, fmaf(w1[n][i], own, fmaf(w2[n][i], nx, bb[n][i])));
                const float sg = uc * __builtin_amdgcn_rcpf(1.0f + __builtin_amdgcn_exp2f(-LOG2E * uc));
                res[i] = sg * acc[AI][1][M][n][i] * ACT8_SCALE;
            }
            if (n == 0) r0 = res; else r1 = res; }
        if (rl != 0 && rl != 255 && tok < NTOK) { u32x2 o; o.x = f8x4(r0[0], r0[1], r0[2], r0[3]); o.y = f8x4(r1[0], r1[1], r1[2], r1[3]); *(u32x2*)(act + (size_t)tok * DFF + ch0) = o; }
    }
    __device__ __forceinline__ void operator()(f32x4 (&acc)[2][2][4][2], const Unit& u, int wr, int wc, int fr, int fq, int lane) const {
        const int ch0 = u.pn * 128 + wc * 32 + 8 * fq;
        const int tok0 = 254 * u.pm - 1;
        int fql = fq; asm volatile("" : "+v"(fql));
        const int xc = wc * 32 + 8 * fql;
        f32x4 su[2];
#pragma unroll
        for (int n = 0; n < 2; ++n) su[n] = *(const LAS f32x4*)(xl + 1280 + 128 + xc + 4 * n) * (1.0f / 127.0f);
#pragma unroll
        for (int ai = 0; ai < 2; ++ai)
#pragma unroll
            for (int m = 0; m < 4; ++m) { const float rs = xl[1024 + ai * HALF + wr * 64 + m * 16 + fr];
#pragma unroll
                for (int n = 0; n < 2; ++n) { const f32x4 rsu = su[n] * rs;
                    acc[ai][0][m][n] = __builtin_convertvector(__builtin_bit_cast(v4i32_t, acc[ai][0][m][n]), f32x4) * rs;
                    acc[ai][1][m][n] = __builtin_convertvector(__builtin_bit_cast(v4i32_t, acc[ai][1][m][n]), f32x4) * rsu; } }
#pragma unroll
        for (int ai = 0; ai < 2; ++ai) { const int G = 2 * ai + wr;
            if (fr == 0) { *(LAS f32x4*)(xl + (2 * G) * 128 + xc) = acc[ai][0][0][0]; *(LAS f32x4*)(xl + (2 * G) * 128 + xc + 4) = acc[ai][0][0][1]; }
            if (fr == 15) { *(LAS f32x4*)(xl + (2 * G + 1) * 128 + xc) = acc[ai][0][3][0]; *(LAS f32x4*)(xl + (2 * G + 1) * 128 + xc + 4) = acc[ai][0][3][1]; } }
        asm volatile("s_waitcnt lgkmcnt(0)" ::: "memory"); __builtin_amdgcn_s_barrier(); asm volatile("" ::: "memory"); __builtin_amdgcn_sched_barrier(0);
        f32x4 w0[2], w1[2], w2[2], bb[2];
#pragma unroll
        for (int n = 0; n < 2; ++n) { const LAS float* wl = xl + 5120 + xc + 4 * n; const f32x4 sgc = *(const LAS f32x4*)(xl + 1280 + xc + 4 * n) * (1.0f / 127.0f);
            w0[n] = *(const LAS f32x4*)(wl) * sgc; w1[n] = *(const LAS f32x4*)(wl + 128) * sgc; w2[n] = *(const LAS f32x4*)(wl + 256) * sgc; bb[n] = *(const LAS f32x4*)(wl + 384); }
#define FFN_ROWS(AI, M) do { const int tb_ = tok0 + AI * HALF + wr * 64 + M * 16; const int G_ = 2 * AI + wr; \
        conv_rows<AI, M, true>(acc, w0, w1, w2, bb, tb_ + fr, AI * HALF + wr * 64 + M * 16 + fr, G_, xc, fr, ch0); \
        if ((M) & 1) __builtin_amdgcn_sched_barrier(0); } while (0)
        FFN_ROWS(0, 0); FFN_ROWS(0, 1); FFN_ROWS(0, 2); FFN_ROWS(0, 3); FFN_ROWS(1, 0); FFN_ROWS(1, 1); FFN_ROWS(1, 2); FFN_ROWS(1, 3);
#undef FFN_ROWS
    }
};

typedef int v8i32_t __attribute__((ext_vector_type(8)));
template <class Epi, class Sched, bool ALIGN_EPI = true, bool SP2 = true, int QM = 0>
__device__ __forceinline__ void gemm_phase(LAS unsigned char* lds, const Gemm g, const Sched& S, const Epi& E) {
    const int tid = threadIdx.x, wid = __builtin_amdgcn_readfirstlane(tid >> 6), lane = tid & 63, wr = wid >> 2, wc = wid & 3, fr = lane & 15, fq = lane >> 4;
    const int K = g.K, nt = K / BK;
    unsigned voffA[2], voffB[2];
#pragma unroll
    for (int i = 0; i < 2; ++i) { int R, C; stage_rc(tid * 16 + i * 8192, R, C); const int Rb = Epi::PERM ? ((R & ~31) + perm32(R & 31)) : R;
        voffA[i] = (unsigned)(R * K + C) * 2u; voffB[i] = (unsigned)(Rb * K + C) * 2u; }
    const size_t kstep = (size_t)(BK * 2);
    const size_t hstep = (size_t)HALF * K * 2;
    const size_t tstepB = 2 * hstep;
    const size_t tstepA = (size_t)g.arows * K * 2;
    const unsigned ldsw = (unsigned)wid * 1024u;
    const int aoff = lds_byte(wr * 64 + fr, fq * 8), boff = lds_byte(wc * 32 + fr, fq * 8);
#define PG8_SA(b, h) (((b) * 2 + (h)) * HTB)
#define PG8_SB(b, h) ((4 + (b) * 2 + (h)) * HTB)
#define PG8_STAGE(bufoff, gbase, voff) do { _Pragma("unroll") for (int _i = 0; _i < 2; ++_i) \
        __builtin_amdgcn_global_load_lds((const unsigned*)((const char*)(gbase) + (voff)[_i]), (LAS unsigned*)(lds + (bufoff) + ldsw + _i * 8192), 16, 0, 0); } while (0)
#define PG8_LDA(dst, b, h) do { _Pragma("unroll") for (int m = 0; m < 4; ++m) _Pragma("unroll") for (int k = 0; k < 2; ++k) dst[m][k] = *(const LAS bf16x8*)(lds + PG8_SA(b, h) + aoff + m * 2048 + k * 1024); } while (0)
#define PG8_LDB(dst, b, h) do { _Pragma("unroll") for (int n = 0; n < 2; ++n) _Pragma("unroll") for (int k = 0; k < 2; ++k) dst[n][k] = *(const LAS bf16x8*)(lds + PG8_SB(b, h) + boff + n * 2048 + k * 1024); } while (0)
#define PG8_MMA(ai, bj, At, Bt) do { __builtin_amdgcn_s_setprio(1); \
    if constexpr (QM == 2) { _Pragma("unroll") for (int m = 0; m < 4; ++m) _Pragma("unroll") for (int n = 0; n < 2; ++n) { \
        const v8i32_t b8_ = __builtin_shufflevector(__builtin_bit_cast(v4i32_t, Bt[n][0]), __builtin_bit_cast(v4i32_t, Bt[n][1]), 0, 1, 2, 3, 4, 5, 6, 7), a8_ = __builtin_shufflevector(__builtin_bit_cast(v4i32_t, At[m][0]), __builtin_bit_cast(v4i32_t, At[m][1]), 0, 1, 2, 3, 4, 5, 6, 7); \
        asm volatile("v_mfma_scale_f32_16x16x128_f8f6f4 %0, %1, %2, %0, %3, %3 op_sel_hi:[0,0,0]" : "+v"(acc[ai][bj][m][n]) : "v"(b8_), "v"(a8_), "v"(one8)); } } \
    else _Pragma("unroll") for (int m = 0; m < 4; ++m) _Pragma("unroll") for (int n = 0; n < 2; ++n) _Pragma("unroll") for (int k = 0; k < 2; ++k) \
        { if constexpr (QM == 1) acc[ai][bj][m][n] = __builtin_bit_cast(f32x4, __builtin_amdgcn_mfma_i32_16x16x64_i8(__builtin_bit_cast(v4i32_t, Bt[n][k]), __builtin_bit_cast(v4i32_t, At[m][k]), __builtin_bit_cast(v4i32_t, acc[ai][bj][m][n]), 0, 0, 0)); \
          else acc[ai][bj][m][n] = __builtin_amdgcn_mfma_f32_16x16x32_bf16(Bt[n][k], At[m][k], acc[ai][bj][m][n], 0, 0, 0); } __builtin_amdgcn_s_setprio(0); } while (0)
#define PG8_WAIT_V(n) asm volatile("s_waitcnt vmcnt(" #n ")" ::: "memory")
#define PG8_WAIT_L(n) asm volatile("s_waitcnt lgkmcnt(" #n ")" ::: "memory")
#define PG8_BAR __builtin_amdgcn_s_barrier()
#define PG8_SCHED __builtin_amdgcn_sched_barrier(0)
    Unit cur, nxt; int ui = 0;
    if (!S.next(0, cur)) return;
    const int one8 = 0x7f7f7f7f;
    f32x4 acc[2][2][4][2];
#pragma unroll
    for (int a = 0; a < 2; ++a)
#pragma unroll
        for (int b = 0; b < 2; ++b)
#pragma unroll
            for (int m = 0; m < 4; ++m)
#pragma unroll
                for (int n = 0; n < 2; ++n) acc[a][b][m][n] = (f32x4){0.f, 0.f, 0.f, 0.f};
    bf16x8 At[4][2], B0[2][2], B1[2][2];
    const char* cA = (const char*)g.A + (size_t)cur.pm * tstepA; const char* cB = (const char*)g.Bt + (size_t)cur.pn * tstepB;
    if constexpr (SP2) {
        PG8_STAGE(PG8_SB(0, 0), cB, voffB); PG8_STAGE(PG8_SB(0, 1), cB + hstep, voffB); PG8_STAGE(PG8_SA(0, 0), cA, voffA); PG8_STAGE(PG8_SA(0, 1), cA + hstep, voffA);
        if (wr == 1) PG8_BAR;
        PG8_WAIT_V(2); PG8_BAR;
        PG8_STAGE(PG8_SB(1, 0), cB + kstep, voffB); PG8_STAGE(PG8_SA(1, 0), cA + kstep, voffA); PG8_STAGE(PG8_SB(1, 1), cB + hstep + kstep, voffB);
        PG8_WAIT_V(6); PG8_BAR;
    } else {
        PG8_STAGE(PG8_SB(0, 0), cB, voffB); PG8_STAGE(PG8_SA(0, 0), cA, voffA); PG8_STAGE(PG8_SB(0, 1), cB + hstep, voffB); PG8_STAGE(PG8_SA(0, 1), cA + hstep, voffA);
        if (wr == 1) PG8_BAR;
        PG8_WAIT_V(4); PG8_BAR;
        PG8_STAGE(PG8_SB(1, 0), cB + kstep, voffB); PG8_STAGE(PG8_SA(1, 0), cA + kstep, voffA); PG8_STAGE(PG8_SB(1, 1), cB + hstep + kstep, voffB);
        PG8_WAIT_V(6); PG8_BAR;
    }
    for (;;) {
        const bool has_next = S.next(ui + 1, nxt);
        const char* nA = has_next ? (const char*)g.A + (size_t)nxt.pm * tstepA : cA; const char* nB = has_next ? (const char*)g.Bt + (size_t)nxt.pn * tstepB : cB;
        for (int t = 0; t < nt; t += 2) {
            const bool last = (t == nt - 2);
            const char* a1 = cA + (size_t)(t + 1) * kstep;
            const char* a2 = last ? nA : cA + (size_t)(t + 2) * kstep; const char* b2 = last ? nB : cB + (size_t)(t + 2) * kstep;
            const char* a3 = a2 + kstep; const char* b3 = b2 + kstep;
            if (last) E.pre(cur, wid, lane);
            if constexpr (SP2) {
            PG8_LDB(B0, 0, 0); PG8_LDB(B1, 0, 1); PG8_SCHED; PG8_LDA(At, 0, 0); PG8_STAGE(PG8_SA(1, 1), a1 + hstep, voffA);
            PG8_WAIT_V(8); PG8_WAIT_L(0); PG8_BAR; PG8_MMA(0, 0, At, B0); PG8_MMA(0, 1, At, B1); PG8_BAR; PG8_SCHED;
            PG8_LDA(At, 0, 1); PG8_STAGE(PG8_SB(0, 0), b2, voffB); PG8_STAGE(PG8_SB(0, 1), b2 + hstep, voffB); PG8_STAGE(PG8_SA(0, 0), a2, voffA);
            PG8_WAIT_V(8); PG8_WAIT_L(0); PG8_BAR; PG8_MMA(1, 0, At, B0); PG8_MMA(1, 1, At, B1); PG8_BAR; PG8_SCHED;
            PG8_LDB(B0, 1, 0); PG8_LDB(B1, 1, 1); PG8_SCHED; PG8_LDA(At, 1, 0); PG8_STAGE(PG8_SA(0, 1), a2 + hstep, voffA);
            PG8_WAIT_V(8); PG8_WAIT_L(0); PG8_BAR; PG8_MMA(0, 0, At, B0); PG8_MMA(0, 1, At, B1); PG8_BAR; PG8_SCHED;
            PG8_LDA(At, 1, 1); PG8_STAGE(PG8_SB(1, 0), b3, voffB); PG8_STAGE(PG8_SB(1, 1), b3 + hstep, voffB); PG8_STAGE(PG8_SA(1, 0), a3, voffA);
            PG8_WAIT_V(8); PG8_WAIT_L(0); PG8_BAR; PG8_MMA(1, 0, At, B0); PG8_MMA(1, 1, At, B1); PG8_BAR; PG8_SCHED;
            } else {
            PG8_LDB(B0, 0, 0); PG8_SCHED; PG8_LDA(At, 0, 0); PG8_STAGE(PG8_SA(1, 1), a1 + hstep, voffA);
            PG8_WAIT_L(8); PG8_BAR; PG8_WAIT_L(0); PG8_MMA(0, 0, At, B0); PG8_BAR; PG8_SCHED;
            PG8_LDB(B1, 0, 1); PG8_STAGE(PG8_SB(0, 0), b2, voffB);
            PG8_BAR; PG8_WAIT_L(0); PG8_MMA(0, 1, At, B1); PG8_BAR;
            PG8_LDA(At, 0, 1); PG8_STAGE(PG8_SA(0, 0), a2, voffA);
            PG8_BAR; PG8_WAIT_L(0); PG8_MMA(1, 0, At, B0); PG8_BAR; PG8_SCHED;
            PG8_STAGE(PG8_SB(0, 1), b2 + hstep, voffB);
            PG8_WAIT_V(6); PG8_BAR; PG8_MMA(1, 1, At, B1); PG8_BAR;
            PG8_LDB(B0, 1, 0); PG8_SCHED; PG8_LDA(At, 1, 0); PG8_STAGE(PG8_SA(0, 1), a2 + hstep, voffA);
            PG8_WAIT_L(8); PG8_BAR; PG8_WAIT_L(0); PG8_MMA(0, 0, At, B0); PG8_BAR; PG8_SCHED;
            PG8_LDB(B1, 1, 1); PG8_STAGE(PG8_SB(1, 0), b3, voffB);
            PG8_BAR; PG8_WAIT_L(0); PG8_MMA(0, 1, At, B1); PG8_BAR;
            PG8_LDA(At, 1, 1); PG8_STAGE(PG8_SA(1, 0), a3, voffA);
            PG8_BAR; PG8_WAIT_L(0); PG8_MMA(1, 0, At, B0); PG8_BAR; PG8_SCHED;
            PG8_STAGE(PG8_SB(1, 1), b3 + hstep, voffB);
            PG8_WAIT_V(6); PG8_BAR; PG8_MMA(1, 1, At, B1); PG8_BAR;
            }
        }
        if constexpr (ALIGN_EPI) { if (wr == 0) PG8_BAR; }
        E(acc, cur, wr, wc, fr, fq, lane);
        if (!has_next) break;
#pragma unroll
        for (int a = 0; a < 2; ++a)
#pragma unroll
            for (int b = 0; b < 2; ++b)
#pragma unroll
                for (int m = 0; m < 4; ++m)
#pragma unroll
                    for (int n = 0; n < 2; ++n) acc[a][b][m][n] = (f32x4){0.f, 0.f, 0.f, 0.f};
        cur = nxt; cA = nA; cB = nB; ++ui;
        if constexpr (ALIGN_EPI) { if (wr == 1) PG8_BAR; }
    }
    PG8_WAIT_V(0);
    if constexpr (!ALIGN_EPI) { if (wr == 0) PG8_BAR; }
    PG8_BAR;
#undef PG8_SA
#undef PG8_SB
#undef PG8_STAGE
#undef PG8_LDA
#undef PG8_LDB
#undef PG8_MMA
#undef PG8_WAIT_V
#undef PG8_WAIT_L
#undef PG8_BAR
#undef PG8_SCHED
}
}

namespace att {
constexpr int PITCH = DIN;
#define SBAR() __builtin_amdgcn_sched_barrier(0)
#define KSW(row, colB) ((row) * 128 + ((colB) ^ ((((row) >> 1) & 7) << 4)))
__device__ __forceinline__ int crow(int r, int hi) { return (r & 3) + 8 * (r >> 2) + 4 * hi; }
__device__ __forceinline__ int rel_bucket(int rel) {
    const int n = rel < 0 ? -rel : rel; int v;
    if (n < 8) v = n; else { v = 2 + (31 - __clz(n * n)); v = v > 15 ? 15 : v; }
    return (rel > 0 ? 16 : 0) + v;
}
constexpr float THR = 5.0f;

__device__ __forceinline__ void partialSM(f32x16& p0, f32x16& p1, float off, float& m_reg, float& alpha) {
    float pmax = p0[0];
#pragma unroll
    for (int r = 1; r < 16; ++r) pmax = fmaxf(pmax, p0[r]);
#pragma unroll
    for (int r = 0; r < 16; ++r) pmax = fmaxf(pmax, p1[r]);
    { auto rr = __builtin_amdgcn_permlane32_swap(__float_as_uint(pmax), __float_as_uint(pmax), false, false);
      pmax = fmaxf(__uint_as_float(rr[0]), __uint_as_float(rr[1])); }
    pmax += off;
    if (__builtin_expect(__all(pmax - m_reg <= THR), 1)) { alpha = 1.f; }
    else { const float mn = fmaxf(m_reg, pmax); alpha = __builtin_amdgcn_exp2f(m_reg - mn); m_reg = mn; }
    const float sub = off - m_reg;
#pragma unroll
    for (int r = 0; r < 16; ++r) { p0[r] += sub; p1[r] += sub; }
#pragma unroll
    for (int r = 0; r < 16; ++r) p0[r] = __builtin_amdgcn_exp2f(p0[r]);
}
__device__ __forceinline__ void finishSM(f32x16& p0, f32x16& p1, float alpha, float& l_reg, bf16x8& pa0, bf16x8& pa1, bf16x8& pa2, bf16x8& pa3) {
#pragma unroll
    for (int r = 0; r < 16; ++r) p1[r] = __builtin_amdgcn_exp2f(p1[r]);
    float ps = 0;
#pragma unroll
    for (int r = 0; r < 16; ++r) ps += p0[r];
#pragma unroll
    for (int r = 0; r < 16; ++r) ps += p1[r];
    { auto rr = __builtin_amdgcn_permlane32_swap(__float_as_uint(ps), __float_as_uint(ps), false, false);
      ps = __uint_as_float(rr[0]) + __uint_as_float(rr[1]); }
    l_reg = l_reg * alpha + ps;
#define PK4(P, BASE, OUT) do { unsigned a0 = cvtpk(P[BASE + 0], P[BASE + 1]), a1 = cvtpk(P[BASE + 2], P[BASE + 3]);   \
    unsigned b0 = cvtpk(P[BASE + 4], P[BASE + 5]), b1 = cvtpk(P[BASE + 6], P[BASE + 7]);                              \
    auto r0 = __builtin_amdgcn_permlane32_swap(a0, b0, false, false); auto r1 = __builtin_amdgcn_permlane32_swap(a1, b1, false, false); \
    u32x4 w = {r0[0], r1[0], r0[1], r1[1]}; OUT = __builtin_bit_cast(bf16x8, w); } while (0)
    PK4(p0, 0, pa0); PK4(p0, 8, pa1); PK4(p1, 0, pa2); PK4(p1, 8, pa3);
#undef PK4
}
__device__ __forceinline__ void qkt64(f32x16& p0, f32x16& p1, const LAS char* Ks, const bf16x8* qr, int r32, int hi) {
#pragma unroll
    for (int d0 = 0; d0 < 4; ++d0) { const int cb = (d0 * 16 + hi * 8) * 2;
        const bf16x8 b0 = *(const LAS bf16x8*)(Ks + KSW(r32, cb));
        const bf16x8 b1 = *(const LAS bf16x8*)(Ks + KSW(r32, cb) + 4096);
        p0 = __builtin_amdgcn_mfma_f32_32x32x16_bf16(b0, qr[d0], p0, 0, 0, 0); p1 = __builtin_amdgcn_mfma_f32_32x32x16_bf16(b1, qr[d0], p1, 0, 0, 0); }
}
template <int NCB> __device__ __forceinline__ int v_st(int k, int c) { const int kk = (k & ~0xC) | ((k & 4) << 1) | ((k & 8) >> 1); return ((kk >> 3) * NCB + (c >> 5)) * 512 + ((kk & 7) * 32 + (c & 31)) * 2; }
__device__ __forceinline__ int v_rd_base(int lane) { return ((lane & 3) << 3) | (((lane >> 2) & 3) << 6) | (((lane >> 4) & 1) << 5) | (((lane >> 5) & 1) << 8); }
template <int NCB> constexpr int v_rd_off(int d0, int ks, int half) { return d0 * 512 + ks * (NCB * 1024) + half * (NCB * 512); }
template <int OFF> __device__ __forceinline__ s16x4 tr_read(int vb) { s16x4 r; asm volatile("ds_read_b64_tr_b16 %0, %1 offset:%2" : "=&v"(r) : "v"(vb), "i"(OFF) : "memory"); return r; }
template <int NCB, int D0> __device__ __forceinline__ void pv_one(f32x16& od, int vb, bf16x8 pa0, bf16x8 pa1, bf16x8 pa2, bf16x8 pa3) {
    const s16x4 l0 = tr_read<v_rd_off<NCB>(D0, 0, 0)>(vb), h0 = tr_read<v_rd_off<NCB>(D0, 0, 1)>(vb), l1 = tr_read<v_rd_off<NCB>(D0, 1, 0)>(vb), h1 = tr_read<v_rd_off<NCB>(D0, 1, 1)>(vb);
    const s16x4 l2 = tr_read<v_rd_off<NCB>(D0, 2, 0)>(vb), h2 = tr_read<v_rd_off<NCB>(D0, 2, 1)>(vb), l3 = tr_read<v_rd_off<NCB>(D0, 3, 0)>(vb), h3 = tr_read<v_rd_off<NCB>(D0, 3, 1)>(vb);
    asm volatile("s_waitcnt lgkmcnt(0)" ::: "memory"); SBAR();
#define PK(L, H) (bf16x8){L[0], L[1], L[2], L[3], H[0], H[1], H[2], H[3]}
    od = __builtin_amdgcn_mfma_f32_32x32x16_bf16(pa0, PK(l0, h0), od, 0, 0, 0);
    od = __builtin_amdgcn_mfma_f32_32x32x16_bf16(pa1, PK(l1, h1), od, 0, 0, 0);
    od = __builtin_amdgcn_mfma_f32_32x32x16_bf16(pa2, PK(l2, h2), od, 0, 0, 0);
    od = __builtin_amdgcn_mfma_f32_32x32x16_bf16(pa3, PK(l3, h3), od, 0, 0, 0);
#undef PK
}

constexpr int D_V = 0, D_K = 49152, D_WS = 81920, D_TB = 83968, D_ST = 86016, D_END = D_ST + 65536;
constexpr int NT = SEQ / 64;

typedef short v4i16_t __attribute__((ext_vector_type(4)));
__device__ __forceinline__ s16x4 vtr(const LAS char* p) { return __builtin_bit_cast(s16x4, __builtin_amdgcn_ds_read_tr16_b64_v4i16((LAS v4i16_t*)p)); }
#define PIN(x) asm volatile("" : "+v"(x))
#define MX3(a, b, c) __builtin_fmaxf(__builtin_fmaxf((a), (b)), (c))
#define EX(v) __builtin_amdgcn_exp2f(v)
#define MFMA32(a, b, c) __builtin_amdgcn_mfma_f32_32x32x16_bf16((a), (b), (c), 0, 0, 0)
constexpr float THRL = 6.0f;
__device__ __forceinline__ float rowmax32(const f32x16& C0, const f32x16& C1) {
    float a = MX3(C0[0], C0[1], C1[0]), b = MX3(C0[2], C0[3], C1[1]); a = MX3(a, C1[2], C1[3]);
#pragma unroll
    for (int r = 4; r < 16; r += 4) { a = MX3(a, C0[r], C0[r + 1]); b = MX3(b, C0[r + 2], C0[r + 3]); a = MX3(a, C1[r], C1[r + 1]); b = MX3(b, C1[r + 2], C1[r + 3]); }
    float rm = __builtin_fmaxf(a, b);
    auto rr = __builtin_amdgcn_permlane32_swap(__float_as_uint(rm), __float_as_uint(rm), false, false);
    return __builtin_fmaxf(__uint_as_float(rr[0]), __uint_as_float(rr[1]));
}
__device__ __forceinline__ void diff_pass(f32x16 (&o)[4], float& l_out, const bf16_t* Qw, const bf16_t* __restrict__ Kh, const bf16_t* __restrict__ Vh,
                                          LAS char* lds, int qa, float cL, float cR) {
    const int tid = threadIdx.x, wid = __builtin_amdgcn_readfirstlane(tid >> 6), lane = tid & 63, r32 = lane & 31, hi = lane >> 5;
    LAS char* V_lds = lds + D_V; LAS char* K_lds = lds + D_K;
    LAS float* wsf = (LAS float*)(lds + D_WS) + wid * 64 + 32;
    const LAS float* tb = (const LAS float*)(lds + D_TB);
#pragma unroll
    for (int d = 0; d < 4; ++d) o[d] = f32x16{};
    bf16x8 qr[4];
#pragma unroll
    for (int d0 = 0; d0 < 4; ++d0) qr[d0] = *(const bf16x8*)(Qw + d0 * 16);
#pragma unroll
    for (int d0 = 0; d0 < 4; ++d0) PIN(qr[d0]);
    const bf16_t* ksrc; const bf16_t* vsrc0;
    { const int row = wid * 8 + (lane >> 3), pos = lane & 7;
      ksrc = Kh + (long)row * PITCH + ((pos ^ ((row >> 1) & 7)) * 8);
      vsrc0 = Vh + (long)row * PITCH + ((pos ^ (((row >> 1) & 1) << 2)) * 8); }
    const LAS char* kq[4];
    { const int sw = (r32 >> 1) & 7;
#pragma unroll
      for (int d0 = 0; d0 < 4; ++d0) kq[d0] = K_lds + r32 * 128 + (((2 * d0 + hi) ^ sw) << 4); }
    const LAS char* vpe; const LAS char* vpo;
    { const int q = (lane & 15) >> 2, p = lane & 3, g = (lane >> 4) & 1, sw = (q >> 1) & 1;
      vpe = V_lds + (4 * hi + q) * 128 + sw * 64 + g * 32 + p * 8; vpo = V_lds + (4 * hi + q) * 128 + (sw ^ 1) * 64 + g * 32 + p * 8; }
#define DMA_K(j, ko) __builtin_amdgcn_global_load_lds((const unsigned*)(ksrc + (long)(j) * 64 * PITCH), (LAS unsigned*)(K_lds + (ko) + wid * 1024), 16, 0, 0)
#define DMA_V(j, vo) do { __builtin_amdgcn_global_load_lds((const unsigned*)(vsrc0 + (long)(j) * 64 * PITCH), (LAS unsigned*)(V_lds + (vo) + wid * 1024), 16, 0, 0); \
    __builtin_amdgcn_global_load_lds((const unsigned*)(vsrc0 + 64 + (long)(j) * 64 * PITCH), (LAS unsigned*)(V_lds + (vo) + 8192 + wid * 1024), 16, 0, 0); } while (0)
#define WAIT_BAR(N) do { asm volatile("s_waitcnt vmcnt(" #N ") lgkmcnt(0)" ::: "memory"); __builtin_amdgcn_s_barrier(); asm volatile("" ::: "memory"); } while (0)
    float mhat, l_reg = 0.f; bool resc = false;
    f32x16 pA0, pA1, pB0, pB1;
    bf16x8 kf[4]; s16x4 vlo[6], vhi[6]; u32x4 pw0, pw1, pw2, pw3;
#define KRD(i, KS) do { kf[(i) & 3] = *(const LAS bf16x8*)(kq[(i) >> 1] + (KS) + ((i) & 1) * 4096); } while (0)
    WAIT_BAR(0);
    DMA_K(0, 0); DMA_K(1, 8192); DMA_V(0, 0); DMA_K(2, 16384); DMA_K(3, 24576); DMA_V(1, 16384);
    WAIT_BAR(7);
    {
        float off0 = 0.f; const int d_ = -qa;
        if (d_ <= -154) { pA0 = f32x16{}; pA1 = f32x16{}; off0 = cL; }
        else { const LAS float* t_ = tb + (d_ + 256 + 4 * hi - r32);
#pragma unroll
            for (int r = 0; r < 16; ++r) { pA0[r] = t_[(r & 3) + 8 * (r >> 2)]; pA1[r] = t_[32 + (r & 3) + 8 * (r >> 2)]; } }
#pragma unroll
        for (int d0 = 0; d0 < 4; ++d0) { const bf16x8 k0_ = *(const LAS bf16x8*)(kq[d0]), k1_ = *(const LAS bf16x8*)(kq[d0] + 4096);
            pA0 = MFMA32(k0_, qr[d0], pA0); pA1 = MFMA32(k1_, qr[d0], pA1); }
        const float rm = rowmax32(pA0, pA1);
        mhat = rm + off0;
#pragma unroll
        for (int r = 0; r < 16; ++r) { pA0[r] = EX(pA0[r] - rm); pA1[r] = EX(pA1[r] - rm); }
    }
    WAIT_BAR(3);
    KRD(0, 8192); KRD(1, 8192); KRD(2, 8192); KRD(3, 8192);
#define PKW(P, B) cvtpk(P[B], P[(B) + 1])
#define PAF(k) __builtin_bit_cast(bf16x8, pw##k)
#define VFR(i) (bf16x8){vlo[(i) % 6][0], vlo[(i) % 6][1], vlo[(i) % 6][2], vlo[(i) % 6][3], vhi[(i) % 6][0], vhi[(i) % 6][1], vhi[(i) % 6][2], vhi[(i) % 6][3]}
#define VRD(i, VS) do { const LAS char* vq_ = ((((i) & 3) & 1) ? vpo : vpe) + (VS) + (((i) & 3) >> 1) * 8192 + ((i) >> 2) * 2048; vlo[(i) % 6] = vtr(vq_); vhi[(i) % 6] = vtr(vq_ + 1024); } while (0)
#define GAPA(g, CC, QI, KB, A0, A1, A2, A3, W0, W1, PW) do { CC = MFMA32(kf[(g) & 3], qr[QI], CC); if ((g) + 4 < 8) KRD((g) + 4, KB); sacc += A0; sacc += A1; sacc += A2; sacc += A3; PIN(sacc); W0; W1; PIN(PW); SBAR(); } while (0)
#define GAPB(i, X, B, VB, KN, PRE) do { o[(i) & 3] = MFMA32(PAF_SEL(i), VFR(i), o[(i) & 3]); X[B] = EX(X[B]); X[(B) + 1] = EX(X[(B) + 1]); PIN(X); if ((i) + 5 < 16) VRD((i) + 5, VB); \
    if ((PRE) && (i) >= 8 && (i) < 12) KRD((i) - 8, KN); SBAR(); } while (0)
#define PAF_SEL(i) (((i) >> 2) == 0 ? PAF(0) : ((i) >> 2) == 1 ? PAF(1) : ((i) >> 2) == 2 ? PAF(2) : PAF(3))
#define STEP(C0, C1, P0, P1, t, KB, VB, KN, PRE) do { SBAR(); \
    { const int d_ = (t) * 64 - qa; \
      if (d_ > -154 && d_ < 122) { const LAS float* t_ = tb + (d_ + 256 + 4 * hi - r32); \
        _Pragma("unroll") for (int r = 0; r < 16; ++r) { C0[r] = t_[(r & 3) + 8 * (r >> 2)] - mhat; C1[r] = t_[32 + (r & 3) + 8 * (r >> 2)] - mhat; } } \
      else { const float cs_ = (d_ < 0 ? cL : cR) - mhat; _Pragma("unroll") for (int r = 0; r < 16; ++r) { C0[r] = cs_; C1[r] = cs_; } } } \
    PIN(C0); PIN(C1); SBAR(); \
    float sacc = (P0[0] + P0[1]); \
    GAPA(0, C0, 0, KB, P0[2],  P0[3],  P0[4],  P0[5],  pw0[0] = PKW(P0, 0),  pw0[1] = PKW(P0, 2),  pw0); \
    GAPA(1, C1, 0, KB, P0[6],  P0[7],  P0[8],  P0[9],  pw0[2] = PKW(P0, 4),  pw0[3] = PKW(P0, 6),  pw0); \
    GAPA(2, C0, 1, KB, P0[10], P0[11], P0[12], P0[13], pw1[0] = PKW(P0, 8),  pw1[1] = PKW(P0, 10), pw1); \
    GAPA(3, C1, 1, KB, P0[14], P0[15], P1[0],  P1[1],  pw1[2] = PKW(P0, 12), pw1[3] = PKW(P0, 14), pw1); \
    GAPA(4, C0, 2, KB, P1[2],  P1[3],  P1[4],  P1[5],  pw2[0] = PKW(P1, 0),  pw2[1] = PKW(P1, 2),  pw2); \
    GAPA(5, C1, 2, KB, P1[6],  P1[7],  P1[8],  P1[9],  pw2[2] = PKW(P1, 4),  pw2[3] = PKW(P1, 6),  pw2); \
    GAPA(6, C0, 3, KB, P1[10], P1[11], P1[12], P1[13], pw3[0] = PKW(P1, 8),  pw3[1] = PKW(P1, 10), pw3); \
    GAPA(7, C1, 3, KB, P1[14], P1[15], 0.f,    0.f,    pw3[2] = PKW(P1, 12), pw3[3] = PKW(P1, 14), pw3); \
    l_reg += sacc; \
    VRD(0, VB); VRD(1, VB); VRD(2, VB); VRD(3, VB); VRD(4, VB); \
    { const float rm = rowmax32(C0, C1); resc = false; \
      if (__builtin_expect(__any(rm > THRL), 0)) { const float dl = __builtin_fmaxf(rm, 0.f); mhat += dl; \
        _Pragma("unroll") for (int r = 0; r < 16; ++r) { C0[r] -= dl; C1[r] -= dl; } \
        const float f = EX(-dl); l_reg *= f; if (hi == 0) wsf[r32] = f; resc = true; } } \
    SBAR(); \
    GAPB(0, C0, 0, VB, KN, PRE);  GAPB(1, C0, 2, VB, KN, PRE);  GAPB(2, C0, 4, VB, KN, PRE);   GAPB(3, C0, 6, VB, KN, PRE); \
    GAPB(4, C0, 8, VB, KN, PRE);  GAPB(5, C0, 10, VB, KN, PRE); GAPB(6, C0, 12, VB, KN, PRE);  GAPB(7, C0, 14, VB, KN, PRE); \
    GAPB(8, C1, 0, VB, KN, PRE);  GAPB(9, C1, 2, VB, KN, PRE);  GAPB(10, C1, 4, VB, KN, PRE);  GAPB(11, C1, 6, VB, KN, PRE); \
    GAPB(12, C1, 8, VB, KN, PRE); GAPB(13, C1, 10, VB, KN, PRE); GAPB(14, C1, 12, VB, KN, PRE); GAPB(15, C1, 14, VB, KN, PRE); \
    } while (0)
#define RESC() do { if (resc) { asm volatile("s_waitcnt lgkmcnt(0)" ::: "memory"); \
    _Pragma("unroll") for (int d = 0; d < 4; ++d) _Pragma("unroll") for (int r = 0; r < 16; ++r) o[d][r] *= wsf[crow(r, hi)]; } } while (0)
    int ks_cur = 8192, ks_n1 = 16384, ks_n3 = 0;
    int vs_prev = 0, vs_next = 32768;
#define ROT() do { ks_cur = (ks_cur + 8192) & 24576; ks_n1 = (ks_n1 + 8192) & 24576; ks_n3 = (ks_n3 + 8192) & 24576; vs_prev = vs_prev == 32768 ? 0 : vs_prev + 16384; vs_next = vs_next == 32768 ? 0 : vs_next + 16384; } while (0)
#define STEPX(C0, C1, P0, P1, t, PRE) STEP(C0, C1, P0, P1, t, ks_cur, vs_prev, ks_n1, PRE)
#pragma unroll 1
    for (int t = 1; t + 4 < NT; t += 2) {
        DMA_K(t + 3, ks_n3); DMA_V(t + 1, vs_next);
        STEPX(pB0, pB1, pA0, pA1, t, true);
        WAIT_BAR(3); RESC(); ROT();
        DMA_K(t + 4, ks_n3); DMA_V(t + 2, vs_next);
        STEPX(pA0, pA1, pB0, pB1, t + 1, true);
        WAIT_BAR(3); RESC(); ROT();
    }
    DMA_V(NT - 2, vs_next);
    STEPX(pB0, pB1, pA0, pA1, NT - 3, true);
    WAIT_BAR(2); RESC(); ROT();
    DMA_V(NT - 1, vs_next);
    STEPX(pA0, pA1, pB0, pB1, NT - 2, true);
    WAIT_BAR(2); RESC(); ROT();
    STEPX(pB0, pB1, pA0, pA1, NT - 1, false);
    WAIT_BAR(0); RESC(); ROT();
    { float sacc = 0.f;
#pragma unroll
      for (int r = 0; r < 16; ++r) sacc += pB0[r];
#pragma unroll
      for (int r = 0; r < 16; ++r) sacc += pB1[r];
      l_reg += sacc;
      pw0 = (u32x4){PKW(pB0, 0), PKW(pB0, 2), PKW(pB0, 4), PKW(pB0, 6)}; pw1 = (u32x4){PKW(pB0, 8), PKW(pB0, 10), PKW(pB0, 12), PKW(pB0, 14)};
      pw2 = (u32x4){PKW(pB1, 0), PKW(pB1, 2), PKW(pB1, 4), PKW(pB1, 6)}; pw3 = (u32x4){PKW(pB1, 8), PKW(pB1, 10), PKW(pB1, 12), PKW(pB1, 14)};
      SBAR();
#define DRAIN(i) do { VRD(i, vs_prev); o[(i) & 3] = MFMA32(PAF_SEL(i), VFR(i), o[(i) & 3]); } while (0)
      DRAIN(0); DRAIN(1); DRAIN(2); DRAIN(3); DRAIN(4); DRAIN(5); DRAIN(6); DRAIN(7); DRAIN(8); DRAIN(9); DRAIN(10); DRAIN(11); DRAIN(12); DRAIN(13); DRAIN(14); DRAIN(15);
#undef DRAIN
    }
    { auto rr = __builtin_amdgcn_permlane32_swap(__float_as_uint(l_reg), __float_as_uint(l_reg), false, false); l_out = __uint_as_float(rr[0]) + __uint_as_float(rr[1]); }
#undef DMA_K
#undef DMA_V
#undef WAIT_BAR
#undef ROT
#undef KRD
#undef PKW
#undef PAF
#undef VFR
#undef VRD
#undef GAPA
#undef GAPB
#undef PAF_SEL
#undef STEP
#undef STEPX
#undef RESC
}

__device__ __forceinline__ void diff_unit(int b, int h, int qb, const bf16_t* P, bf16_t* O, LAS char* lds, float lam, const float* relb) {
    const int tid = threadIdx.x, wid = __builtin_amdgcn_readfirstlane(tid >> 6), lane = tid & 63, r32 = lane & 31, hi = lane >> 5;
    const long rowbase = (long)b * SEQ; const int q0 = qb * 256, qa = q0 + wid * 32;
    LAS float* tb = (LAS float*)(lds + D_TB);
    LAS float* li_l = (LAS float*)(lds + D_WS) + wid * 64;
    tb[tid] = relb[rel_bucket(tid - 256) * NBH + h] * LOG2E;
    const float cL = relb[15 * NBH + h] * LOG2E, cR = relb[31 * NBH + h] * LOG2E;
    const bf16_t* Qrow = P + (rowbase + qa + r32) * PITCH + C_DQ + h * 128 + hi * 8;
    const bf16_t* Kh = P + rowbase * PITCH + C_DK + h * 128;
    const bf16_t* Vh = P + rowbase * PITCH + C_DV + h * 128;
    LAS u32x4* stash = (LAS u32x4*)(lds + D_ST + wid * 8192);
    f32x16 o[4]; float l_reg;
#pragma unroll 1
    for (int pass = 0; pass < 2; ++pass) {
        const int mo = pass == 0 ? 64 : 0;
        diff_pass(o, l_reg, Qrow + mo, Kh + mo, Vh, lds, qa, cL, cR);
        int ln = lane; asm volatile("" : "+v"(ln));
        const int r32e = ln & 31, hie = ln >> 5;
        if (hie == 0) li_l[r32e] = l_reg; asm volatile("s_waitcnt lgkmcnt(0)" ::: "memory");
        if (pass == 0) {
            float rli[16];
#pragma unroll
            for (int r = 0; r < 16; ++r) rli[r] = -lam * __builtin_amdgcn_rcpf(li_l[crow(r, hie)]);
#pragma unroll
            for (int d0 = 0; d0 < 4; ++d0) {
                u32x4 w0, w1;
                w0.x = cvtpk(o[d0][0] * rli[0], o[d0][1] * rli[1]); w0.y = cvtpk(o[d0][2] * rli[2], o[d0][3] * rli[3]); w0.z = cvtpk(o[d0][4] * rli[4], o[d0][5] * rli[5]); w0.w = cvtpk(o[d0][6] * rli[6], o[d0][7] * rli[7]);
                w1.x = cvtpk(o[d0][8] * rli[8], o[d0][9] * rli[9]); w1.y = cvtpk(o[d0][10] * rli[10], o[d0][11] * rli[11]); w1.z = cvtpk(o[d0][12] * rli[12], o[d0][13] * rli[13]); w1.w = cvtpk(o[d0][14] * rli[14], o[d0][15] * rli[15]);
                stash[(2 * d0) * 64 + ln] = w0; stash[(2 * d0 + 1) * 64 + ln] = w1;
            }
        } else {
            float rli[16], ssq[16];
#pragma unroll
            for (int r = 0; r < 16; ++r) { rli[r] = __builtin_amdgcn_rcpf(li_l[crow(r, hie)]); ssq[r] = 0.f; }
#pragma unroll
            for (int d0 = 0; d0 < 4; ++d0) {
                const u32x4 w0 = stash[(2 * d0) * 64 + ln], w1 = stash[(2 * d0 + 1) * 64 + ln];
                const unsigned ww[8] = {w0.x, w0.y, w0.z, w0.w, w1.x, w1.y, w1.z, w1.w};
#pragma unroll
                for (int r = 0; r < 16; ++r) { const float c = __uint_as_float((r & 1) ? (ww[r >> 1] & 0xffff0000u) : (ww[r >> 1] << 16));
                    const float x = fmaf(o[d0][r], rli[r], c); o[d0][r] = x; ssq[r] = fmaf(x, x, ssq[r]); }
            }
            asm volatile("s_waitcnt lgkmcnt(0)" ::: "memory");
#pragma unroll
            for (int r = 0; r < 16; ++r) { float s = ssq[r];
                s += __shfl_xor(s, 1); s += __shfl_xor(s, 2); s += __shfl_xor(s, 4); s += __shfl_xor(s, 8); s += __shfl_xor(s, 16);
                ssq[r] = __builtin_amdgcn_rsqf(s * (1.0f / 128.0f) + EPS); }
            LAS bf16_t* stg = (LAS bf16_t*)(lds + D_ST + wid * 8192);
#pragma unroll
            for (int r = 0; r < 16; ++r) { const int orow = crow(r, hie);
#pragma unroll
                for (int d0 = 0; d0 < 4; ++d0) stg[orow * 128 + d0 * 32 + r32e] = (bf16_t)(cvtpk(o[d0][r] * ssq[r], 0.f) & 0xffffu); }
            asm volatile("s_waitcnt lgkmcnt(0)" ::: "memory");
            bf16_t* Ow = O + (rowbase + qa + (ln >> 4)) * DM + h * 128 + (ln & 15) * 8;
            const LAS bf16_t* sl = stg + (ln >> 4) * 128 + (ln & 15) * 8;
#pragma unroll
            for (int i = 0; i < 8; ++i) { const u32x4 v = *(const LAS u32x4*)(sl + i * 512); *(u32x4*)(Ow + (long)i * 4 * DM) = v; }
        }
    }
    asm volatile("s_waitcnt lgkmcnt(0)" ::: "memory"); __syncthreads();
}

constexpr int W_K = 0, W_V = 49152, W_TB = 98304, W_WS = 106496, W_OST = 108544, W_END = W_OST + 32768;
__device__ __forceinline__ void win_unit(int b, int kvh, int qb, const bf16_t* P, bf16_t* O, LAS char* lds, const float* relb, const float* sink) {
    const int tid = threadIdx.x, wid = __builtin_amdgcn_readfirstlane(tid >> 6), lane = tid & 63, r32 = lane & 31, hi = lane >> 5;
    const long rowbase = (long)b * SEQ; const int q0 = qb * 128, kbase = q0 - 128;
    LAS float* tbw = (LAS float*)(lds + W_TB);
#pragma unroll
    for (int e = 0; e < 4; ++e) { const int idx = tid + e * 512, g = idx >> 9, rel = (idx & 511) - 256;
        tbw[idx] = (rel >= -128 && rel <= 128) ? (relb[rel_bucket(rel) * NBH + 4 + 4 * kvh + g] - sink[4 * kvh + g]) * LOG2E : -1e30f; }
    { int tl = tid; asm volatile("" : "+v"(tl));
      const int kr = tl >> 3, kc = (tl & 7) * 8, kst = KSW(kr, kc * 2), vst = v_st<2>(kr, kc);
      const bf16_t* Kh = P + rowbase * PITCH + C_WK + kvh * 64; const bf16_t* Vh = P + rowbase * PITCH + C_WV + kvh * 64;
      bf16x8 kreg[6], vreg[6];
#pragma unroll
      for (int t = 0; t < 6; ++t) { const int k0 = kbase + 64 * t; if (k0 >= 0 && k0 < SEQ) { kreg[t] = *(const bf16x8*)(&Kh[(long)(k0 + kr) * PITCH + kc]); vreg[t] = *(const bf16x8*)(&Vh[(long)(k0 + kr) * PITCH + kc]); } }
#pragma unroll
      for (int t = 0; t < 6; ++t) { const int k0 = kbase + 64 * t; if (k0 >= 0 && k0 < SEQ) { *(LAS bf16x8*)(lds + W_K + t * 8192 + kst) = kreg[t]; *(LAS bf16x8*)(lds + W_V + t * 8192 + vst) = vreg[t]; } }
    }
    __syncthreads();
    const int g = wid >> 1, hq = 4 * kvh + g;
    LAS float* li_l = (LAS float*)(lds + W_WS) + wid * 64;
    const LAS float* tbg = tbw + g * 512;
    const int vbw = (int)(uintptr_t)(lds + W_V) + v_rd_base(lane);
#pragma unroll 1
    for (int jb = 0; jb < 2; ++jb) {
        const int ql = 64 * (wid & 1) + 32 * jb;
        const bf16_t* Qw = P + (rowbase + q0 + ql + r32) * PITCH + C_WQ + hq * 64 + hi * 8;
        bf16x8 qr[4];
#pragma unroll
        for (int d0 = 0; d0 < 4; ++d0) qr[d0] = *(const bf16x8*)(Qw + d0 * 16);
        float l_reg = 0.f;
        f32x16 o[2]; o[0] = f32x16{}; o[1] = f32x16{};
        const int t_lo = ql >> 6;
#pragma unroll 1
        for (int t = t_lo; t < t_lo + 5; ++t) {
            const int k0 = kbase + 64 * t; if (k0 < 0 || k0 >= SEQ) continue;
            const int d_ = 64 * t - 128 - ql;
            const LAS float* t_ = tbg + (d_ + 256 + 4 * hi - r32);
            f32x16 p0, p1;
#pragma unroll
            for (int r = 0; r < 16; ++r) { p0[r] = t_[(r & 3) + 8 * (r >> 2)]; p1[r] = t_[32 + (r & 3) + 8 * (r >> 2)]; }
            qkt64(p0, p1, lds + W_K + t * 8192, qr, r32, hi);
#pragma unroll
            for (int r = 0; r < 16; ++r) { p0[r] = __builtin_amdgcn_exp2f(p0[r]); p1[r] = __builtin_amdgcn_exp2f(p1[r]); }
            bf16x8 pa0, pa1, pa2, pa3;
            {
                float ps = 0;
#pragma unroll
                for (int r = 0; r < 16; ++r) ps += p0[r];
#pragma unroll
                for (int r = 0; r < 16; ++r) ps += p1[r];
                l_reg += ps;
#define PK4(Pv, BASE, OUT) do { unsigned a0 = cvtpk(Pv[BASE + 0], Pv[BASE + 1]), a1 = cvtpk(Pv[BASE + 2], Pv[BASE + 3]);   \
    unsigned b0 = cvtpk(Pv[BASE + 4], Pv[BASE + 5]), b1 = cvtpk(Pv[BASE + 6], Pv[BASE + 7]);                              \
    auto r0 = __builtin_amdgcn_permlane32_swap(a0, b0, false, false); auto r1 = __builtin_amdgcn_permlane32_swap(a1, b1, false, false); \
    u32x4 w = {r0[0], r1[0], r0[1], r1[1]}; OUT = __builtin_bit_cast(bf16x8, w); } while (0)
                PK4(p0, 0, pa0); PK4(p0, 8, pa1); PK4(p1, 0, pa2); PK4(p1, 8, pa3);
#undef PK4
            }
            const int vb = vbw + t * 8192;
            pv_one<2, 0>(o[0], vb, pa0, pa1, pa2, pa3); pv_one<2, 1>(o[1], vb, pa0, pa1, pa2, pa3);
        }
        { auto rr = __builtin_amdgcn_permlane32_swap(__float_as_uint(l_reg), __float_as_uint(l_reg), false, false); l_reg = 1.0f + __uint_as_float(rr[0]) + __uint_as_float(rr[1]); }
        int ln = lane; asm volatile("" : "+v"(ln));
        const int r32e = ln & 31, hie = ln >> 5;
        if (hie == 0) li_l[r32e] = l_reg; asm volatile("s_waitcnt lgkmcnt(0)" ::: "memory");
        float rli[16];
#pragma unroll
        for (int r = 0; r < 16; ++r) rli[r] = __builtin_amdgcn_rcpf(li_l[crow(r, hie)]);
        LAS bf16_t* stg = (LAS bf16_t*)(lds + W_OST + wid * 4096);
#pragma unroll
        for (int r = 0; r < 16; ++r) { const int orow = crow(r, hie);
#pragma unroll
            for (int d0 = 0; d0 < 2; ++d0) stg[orow * 64 + d0 * 32 + r32e] = (bf16_t)(cvtpk(o[d0][r] * rli[r], 0.f) & 0xffffu); }
        asm volatile("s_waitcnt lgkmcnt(0)" ::: "memory");
        bf16_t* Ow = O + (rowbase + q0 + ql + (ln >> 3)) * DM + 512 + hq * 64 + (ln & 7) * 8;
        const LAS bf16_t* sl = stg + (ln >> 3) * 64 + (ln & 7) * 8;
#pragma unroll
        for (int i = 0; i < 4; ++i) { const u32x4 v = *(const LAS u32x4*)(sl + i * 512); *(u32x4*)(Ow + (long)i * 8 * DM) = v; }
        asm volatile("s_waitcnt lgkmcnt(0)" ::: "memory");
    }
    asm volatile("s_waitcnt lgkmcnt(0)" ::: "memory"); __syncthreads();
}
#undef SBAR
#undef KSW
}

constexpr size_t MiB = 1u << 20;
constexpr size_t WS_CTL = 0, CTL_ZERO_BYTES = 64 * 1024;
constexpr size_t WS_W1 = 1 * MiB;
constexpr size_t WS_W2 = WS_W1 + (size_t)DIN * DM * 2;
constexpr size_t WS_W3 = WS_W2 + (size_t)DM * DM * 2;
constexpr size_t WS_W4 = WS_W3 + (size_t)2 * DFF * DM * 2;
constexpr size_t WS_XS = 24 * MiB;
constexpr int CW_WMAX4 = 5120;
constexpr int CW_GBAR = 6400;
constexpr int CW_P3CNT = 4480;
constexpr size_t WS_FA = 26 * MiB;
constexpr size_t WS_FX = 26 * MiB + 512 * 1024;
constexpr int CW_WMAX1 = 13824, CW_W1CNT = 16200;
constexpr int CW_WMAX = 8192;
constexpr size_t WS_X0S = 27 * MiB;
constexpr size_t WS_PROJ = 28 * MiB;
constexpr size_t WS_OB = 244 * MiB;
constexpr size_t WS_XQ = 340 * MiB;
constexpr size_t WS_X1Q = 340 * MiB;
constexpr size_t WS_X1B = 388 * MiB;
constexpr size_t WS_ACT = 28 * MiB;
constexpr size_t WS_END = WS_X1B + (size_t)NTOK * DM * 2;
static_assert(WS_W4 + (size_t)DM * DFF * 2 <= WS_XS && WS_XS + (size_t)NTOK * 32 <= WS_FA && WS_FA + (size_t)NTOK * 4 <= WS_FX && WS_FX + (size_t)NTOK * 4 <= WS_X0S && WS_X0S + (size_t)NTOK * 4 <= WS_PROJ, "d_ws map");
static_assert(WS_PROJ + (size_t)NTOK * DIN * 2 <= WS_OB && WS_OB + (size_t)NTOK * DM * 2 <= WS_XQ && WS_XQ + (size_t)NTOK * DM <= WS_X1B && WS_ACT + (size_t)NTOK * DFF * 2 <= WS_X1Q - 4096, "d_ws map");
static_assert(CW_WMAX + 2 * DFF <= CW_WMAX1 && CW_WMAX1 + DIN <= CW_W1CNT && CW_W1CNT * 4 < CTL_ZERO_BYTES && 1024 + 3456 <= CW_P3CNT && CW_P3CNT + 192 <= CW_WMAX4 && CW_WMAX4 + DM <= CW_GBAR && CW_GBAR + 8 * 128 <= CW_WMAX, "d_ws map");
constexpr int CW_BAR = 1024, XCD_BAR_WORDS_C = 3456;

constexpr int RING_BYTES = 131072, EPX_OFF = RING_BYTES, LDS_BYTES = 163840, MISC_OFF = LDS_BYTES - 512;
static_assert(att::D_END <= MISC_OFF && att::W_END <= MISC_OFF && EPX_OFF + 22528 <= MISC_OFF, "LDS map");

typedef GAS unsigned gu32;
#define RLX_AGENT __ATOMIC_RELAXED, __HIP_MEMORY_SCOPE_AGENT
#define LDS_WAIT() asm volatile("s_waitcnt lgkmcnt(0)" ::: "memory")

#define XB_TMO      128
#define XB_XCNT(j)  (256  + 64 * (j))
#define XB_XSUB(j)  (1280 + 64 * (j))
#define XB_XGEN(j)  (2304 + 64 * (j))
#define XB_TOP      3328
#define XB_TOPGEN   3392
#define XCD_BAR_WORDS 3456
#define XB_SPIN_CAP (1u << 22)
__device__ __forceinline__ unsigned xb_ld(unsigned* p)              { return __hip_atomic_load(p, __ATOMIC_RELAXED, __HIP_MEMORY_SCOPE_AGENT); }
__device__ __forceinline__ unsigned xb_add(unsigned* p, unsigned v) { return __hip_atomic_fetch_add(p, v, __ATOMIC_RELAXED, __HIP_MEMORY_SCOPE_AGENT); }
__device__ __forceinline__ unsigned xb_xcc_id() { return (unsigned)__builtin_amdgcn_s_getreg((3 << 11) | 20) & 0xFu; }
#define XB_SPIN(cond, bar) do { unsigned _sp = 0; while (cond) { __builtin_amdgcn_s_sleep(1); \
    if ((++_sp & 255u) == 0u) { if (xb_ld(&(bar)[XB_TMO])) break; if (_sp > XB_SPIN_CAP) { atomicAdd(&(bar)[XB_TMO], 1u); break; } } } } while (0)
struct XcdBarrier { unsigned* bar; unsigned x; volatile LAS unsigned* st; };
__device__ __forceinline__ XcdBarrier xcd_barrier_post(unsigned* bar, volatile LAS unsigned* st) {
    XcdBarrier b; b.bar = bar; b.x = xb_xcc_id(); b.st = st;
    if (threadIdx.x == 0) (void)xb_add(&bar[XB_XCNT(b.x)], 1u);
    return b;
}
__device__ __forceinline__ void xcd_barrier_complete(unsigned* bar, unsigned x, unsigned& nloc, unsigned& nx) {
    const unsigned G = gridDim.x * gridDim.y * gridDim.z;
    unsigned sum, cnt, mine, sp = 0u;
    for (;;) {
        sum = 0u; cnt = 0u; mine = 0u;
#pragma unroll
        for (unsigned j = 0; j < 16; ++j) { const unsigned c = xb_ld(&bar[XB_XCNT(j)]); sum += c; cnt += (c > 0u) ? 1u : 0u; mine = (j == x) ? c : mine; }
        if (sum == G) break;
        __builtin_amdgcn_s_sleep(1);
        if ((++sp & 255u) == 0u) { if (xb_ld(&bar[XB_TMO])) break; if (sp > XB_SPIN_CAP) { atomicAdd(&bar[XB_TMO], 1u); break; } }
    }
    nloc = mine > 0u ? mine : 1u; nx = cnt > 0u ? cnt : 1u;
}
__device__ __forceinline__ void xcd_barrier(const XcdBarrier& b) {
    asm volatile("s_waitcnt vmcnt(0)" ::: "memory");
    __syncthreads();
    if (threadIdx.x == 0) {
        unsigned* bar = b.bar;
        __builtin_amdgcn_s_waitcnt(0);
        unsigned nloc = b.st[0], nx = b.st[1];
        if (nloc == 0u) { xcd_barrier_complete(bar, b.x, nloc, nx); b.st[0] = nloc; b.st[1] = nx; }
        const unsigned old = xb_add(&bar[XB_XSUB(b.x)], 1u);
        const unsigned gen = old / nloc;
        if (old + 1u == (gen + 1u) * nloc) {
            __builtin_amdgcn_fence(__ATOMIC_RELEASE, "agent");
            asm volatile("s_waitcnt vmcnt(0)" ::: "memory");
            const unsigned og = xb_add(&bar[XB_TOP], 1u);
            const unsigned tg = og / nx;
            if (og + 1u == (tg + 1u) * nx) xb_add(&bar[XB_TOPGEN], 1u);
            else XB_SPIN(xb_ld(&bar[XB_TOPGEN]) == tg, bar);
            __builtin_amdgcn_fence(__ATOMIC_ACQUIRE, "agent");
            xb_add(&bar[XB_XGEN(b.x)], 1u);
            asm volatile("s_waitcnt vmcnt(0)" ::: "memory");
        } else {
            XB_SPIN(xb_ld(&bar[XB_XGEN(b.x)]) == gen, bar);
            __builtin_amdgcn_fence(__ATOMIC_ACQUIRE, "agent");
            asm volatile("s_waitcnt vmcnt(0)" ::: "memory");
        }
    }
    __syncthreads();
}

__device__ __forceinline__ void group_barrier(unsigned* gb, unsigned nmem, volatile LAS unsigned* ep) {
    asm volatile("s_waitcnt vmcnt(0)" ::: "memory");
    __syncthreads();
    if (threadIdx.x == 0) {
        __builtin_amdgcn_fence(__ATOMIC_RELEASE, "agent");
        asm volatile("s_waitcnt vmcnt(0)" ::: "memory");
        const unsigned e = ep[0]; ep[0] = e + 1u;
        const unsigned old = xb_add(&gb[0], 1u);
        if (old + 1u == (e + 1u) * nmem) xb_add(&gb[64], 1u);
        else { unsigned sp = 0; while (xb_ld(&gb[64]) == e) { __builtin_amdgcn_s_sleep(1); if (++sp > XB_SPIN_CAP) break; } }
        __builtin_amdgcn_fence(__ATOMIC_ACQUIRE, "agent");
        asm volatile("s_waitcnt vmcnt(0)" ::: "memory");
    }
    __syncthreads();
}

__device__ __forceinline__ float wave_sum(float v) {
#pragma unroll
    for (int o = 1; o < 64; o <<= 1) v += __shfl_xor(v, o);
    return v;
}
__device__ __forceinline__ unsigned f2bf(float f) { unsigned u = __builtin_bit_cast(unsigned, f); return (u + 0x7fffu + ((u >> 16) & 1u)) >> 16; }
__device__ __forceinline__ unsigned pk2(float lo, float hi) { return f2bf(lo) | (f2bf(hi) << 16); }
__device__ __forceinline__ void transpose_item(const float* W, int ld, int cbase, int K, int k0, bf16_t* WT, int nrow0, const float* fold, int foldmask, float fscale, int foldlim, LAS float* scr, int lane) {
    float wv[32];
#pragma unroll
    for (int i = 0; i < 32; ++i) wv[i] = W[(size_t)(k0 + 2 * i + (lane >> 5)) * ld + cbase + (lane & 31)];
#pragma unroll
    for (int i = 0; i < 32; ++i) { const int kk = 2 * i + (lane >> 5), k = k0 + kk;
        float f = 1.f; if (fold != nullptr && k < foldlim) f = fold[k & foldmask] * fscale;
        scr[kk * 33 + (lane & 31)] = wv[i] * f; }
    LDS_WAIT(); asm volatile("" ::: "memory");
    const int c = lane & 7;
#pragma unroll
    for (int j = 0; j < 4; ++j) { const int n = (lane >> 3) + 8 * j; const LAS float* s = scr + (8 * c) * 33 + n;
        u32x4 o; o.x = pk2(s[0 * 33], s[1 * 33]); o.y = pk2(s[2 * 33], s[3 * 33]); o.z = pk2(s[4 * 33], s[5 * 33]); o.w = pk2(s[6 * 33], s[7 * 33]);
        *(u32x4*)(WT + (size_t)(nrow0 + n) * K + k0 + 8 * c) = o; }
    LDS_WAIT(); asm volatile("" ::: "memory");
}

__device__ __forceinline__ void absmax_item(const float* W, int ld, int cbase, int k0, unsigned* wmax, const float* fold, int lane) {
    float wv[32];
#pragma unroll
    for (int i = 0; i < 32; ++i) wv[i] = W[(size_t)(k0 + 2 * i + (lane >> 5)) * ld + cbase + (lane & 31)];
    float m = 0.f;
#pragma unroll
    for (int i = 0; i < 32; ++i) m = __builtin_fmaxf(m, __builtin_fabsf(wv[i] * (fold ? fold[k0 + 2 * i + (lane >> 5)] : 1.f)));
    m = __builtin_fmaxf(m, __shfl_xor(m, 32));
    if (lane < 32) (void)__hip_atomic_fetch_max(wmax + lane, __float_as_uint(m), __ATOMIC_RELAXED, __HIP_MEMORY_SCOPE_AGENT);
}
__device__ __forceinline__ void quant_item(const float* W, int ld, int cbase, int K, int k0, signed char* WQ, int nrow0, const float* fold, const unsigned* wmax, LAS float* scr, int lane) {
    float wv[32];
#pragma unroll
    for (int i = 0; i < 32; ++i) wv[i] = W[(size_t)(k0 + 2 * i + (lane >> 5)) * ld + cbase + (lane & 31)];
    const float am = __uint_as_float(__hip_atomic_load(wmax + (lane & 31), __ATOMIC_RELAXED, __HIP_MEMORY_SCOPE_AGENT)); const float inv = am > 0.f ? 127.0f / am : 0.f;
#pragma unroll
    for (int i = 0; i < 32; ++i) { const int kk = 2 * i + (lane >> 5); scr[kk * 33 + (lane & 31)] = wv[i] * fold[k0 + kk] * inv; }
    LDS_WAIT(); asm volatile("" ::: "memory");
    const int n = lane >> 1, c = lane & 1; const LAS float* sp = scr + (32 * c) * 33 + n;
    u32x4 o0, o1;
    o0.x = q4(sp[0 * 33], sp[1 * 33], sp[2 * 33], sp[3 * 33]);     o0.y = q4(sp[4 * 33], sp[5 * 33], sp[6 * 33], sp[7 * 33]);
    o0.z = q4(sp[8 * 33], sp[9 * 33], sp[10 * 33], sp[11 * 33]);   o0.w = q4(sp[12 * 33], sp[13 * 33], sp[14 * 33], sp[15 * 33]);
    o1.x = q4(sp[16 * 33], sp[17 * 33], sp[18 * 33], sp[19 * 33]); o1.y = q4(sp[20 * 33], sp[21 * 33], sp[22 * 33], sp[23 * 33]);
    o1.z = q4(sp[24 * 33], sp[25 * 33], sp[26 * 33], sp[27 * 33]); o1.w = q4(sp[28 * 33], sp[29 * 33], sp[30 * 33], sp[31 * 33]);
    u32x4* dst = (u32x4*)(WQ + (size_t)(nrow0 + n) * K + k0 + 32 * c);
    dst[0] = o0; dst[1] = o1;
    LDS_WAIT(); asm volatile("" ::: "memory");
}

__device__ __forceinline__ void quantf8_item(const float* W, int ld, int cbase, int K, int k0, unsigned char* WQ, int nrow0, const unsigned* wmax, LAS float* scr, int lane) {
    float wv[32];
#pragma unroll
    for (int i = 0; i < 32; ++i) wv[i] = W[(size_t)(k0 + 2 * i + (lane >> 5)) * ld + cbase + (lane & 31)];
    const float am = __uint_as_float(__hip_atomic_load(wmax + (lane & 31), __ATOMIC_RELAXED, __HIP_MEMORY_SCOPE_AGENT)); const float inv = am > 0.f ? W8_TOP / am : 0.f;
#pragma unroll
    for (int i = 0; i < 32; ++i) { const int kk = 2 * i + (lane >> 5); scr[kk * 33 + (lane & 31)] = wv[i] * inv; }
    LDS_WAIT(); asm volatile("" ::: "memory");
    const int n = lane >> 1, c = lane & 1; const LAS float* sp = scr + (32 * c) * 33 + n;
    u32x4 o0, o1;
    o0.x = f8x4(sp[0 * 33], sp[1 * 33], sp[2 * 33], sp[3 * 33]);     o0.y = f8x4(sp[4 * 33], sp[5 * 33], sp[6 * 33], sp[7 * 33]);
    o0.z = f8x4(sp[8 * 33], sp[9 * 33], sp[10 * 33], sp[11 * 33]);   o0.w = f8x4(sp[12 * 33], sp[13 * 33], sp[14 * 33], sp[15 * 33]);
    o1.x = f8x4(sp[16 * 33], sp[17 * 33], sp[18 * 33], sp[19 * 33]); o1.y = f8x4(sp[20 * 33], sp[21 * 33], sp[22 * 33], sp[23 * 33]);
    o1.z = f8x4(sp[24 * 33], sp[25 * 33], sp[26 * 33], sp[27 * 33]); o1.w = f8x4(sp[28 * 33], sp[29 * 33], sp[30 * 33], sp[31 * 33]);
    u32x4* dst = (u32x4*)(WQ + (size_t)(nrow0 + n) * K + k0 + 32 * c);
    dst[0] = o0; dst[1] = o1;
    LDS_WAIT(); asm volatile("" ::: "memory");
}

struct Args { const float* in[22]; float* out; unsigned char* ws; int ph_lo, ph_hi, li, pad; };

__global__ void __launch_bounds__(NWAVES * 64, 2) hymba_fwd(Args args) {
    extern __shared__ __attribute__((aligned(16))) unsigned char lds_raw[];
    LAS unsigned char* lds = (LAS unsigned char*)lds_raw;
    volatile LAS unsigned* MISC = (volatile LAS unsigned*)(lds + MISC_OFF);
    const int tid = threadIdx.x, lane = tid & 63, wave = __builtin_amdgcn_readfirstlane(tid >> 6);
    const int G = gridDim.x; const int bx = blockIdx.x; const int vcu = (G % 8 == 0) ? (bx % 8) * (G / 8) + bx / 8 : bx;
    unsigned char* ws = args.ws;
    unsigned* ctl = (unsigned*)(ws + WS_CTL);
    const float* xp = args.in[0]; const float* xs = args.in[1];
    bf16_t* W1 = (bf16_t*)(ws + WS_W1); bf16_t* W2 = (bf16_t*)(ws + WS_W2); bf16_t* W3 = (bf16_t*)(ws + WS_W3); bf16_t* W4 = (bf16_t*)(ws + WS_W4);
    bf16_t* PROJ = (bf16_t*)(ws + WS_PROJ); bf16_t* X1B = (bf16_t*)(ws + WS_X1B); bf16_t* ACT = (bf16_t*)(ws + WS_ACT);
    bf16_t* OB = (bf16_t*)(ws + WS_OB);
    signed char* XQ = (signed char*)(ws + WS_XQ); float* FX = (float*)(ws + WS_FX); signed char* W1Q = (signed char*)(ws + WS_W1);
    for (int u = tid; u < 128; u += NWAVES * 64) ((LAS unsigned*)(lds + MISC_OFF))[u] = 0u;
    __syncthreads();
    XcdBarrier bar; bar.bar = ctl + CW_BAR + args.li * XCD_BAR_WORDS; bar.x = 0; bar.st = nullptr;
    if (MK_N_LAUNCHES != 6) bar = xcd_barrier_post(ctl + CW_BAR + args.li * XCD_BAR_WORDS, MISC + 8);
    const int lo = args.ph_lo, hi_ph = args.ph_hi;
#ifndef ONLY_PHASE
#define ONLY_PHASE -1
#endif
#define IN(k) ((ONLY_PHASE < 0 || ONLY_PHASE == (k)) && lo <= (k) && (k) < hi_ph)
#define BOTH(k) (IN(k) && IN((k) + 1))
#define GRID_BAR() do { if (MK_N_LAUNCHES != 6) xcd_barrier(bar); } while (0)
#define GROUP_BAR() do { if (MK_N_LAUNCHES != 6) { if (G == 256) group_barrier(ctl + CW_GBAR + (bx & 7) * 128, 32u, MISC + 12); else xcd_barrier(bar); } } while (0)

    if (IN(0)) {
        LAS float* scr = (LAS float*)(lds + wave * 16384);
        const int gw = vcu * NWAVES + wave, NGW = G * NWAVES;
        constexpr int I1 = (DM / 64) * (DIN / 32), I2 = (DM / 64) * (DM / 32), I3 = (DM / 64) * (2 * DFF / 32), I4 = (DFF / 64) * (DM / 32);
        for (int it = gw; it < I1 + I2 + I3 + I4; it += NGW) {
            int r = it;
            if (r < I1) { const int nblk = DIN / 32, kb = r / nblk, nb = r % nblk, n0 = 32 * nb, pn = n0 >> 8, p = n0 & 255, bj = p >> 7, wc = (p & 127) >> 5;
                absmax_item(args.in[3], DIN, 256 * pn + 64 * wc + 32 * bj, 64 * kb, ctl + CW_WMAX1 + n0, args.in[2], lane);
                asm volatile("s_waitcnt vmcnt(0)" ::: "memory"); if (lane == 0) (void)__hip_atomic_fetch_add(ctl + CW_W1CNT, 1u, __ATOMIC_RELAXED, __HIP_MEMORY_SCOPE_AGENT); continue; } r -= I1;
            if (r < I2) { const int nblk = DM / 32, kb = r / nblk, nb = r % nblk;
                const int n0 = 32 * nb, pn = n0 >> 8, p = n0 & 255, bj = p >> 7, wc = (p & 127) >> 5;
                transpose_item(args.in[15], DM, 256 * pn + 64 * wc + 32 * bj, DM, 64 * kb, W2, n0, args.in[10], 127, 1.0f - LAM_INIT, 512, scr, lane); continue; } r -= I2;
            if (r < I3) { const int nblk = 2 * DFF / 32, kb = r / nblk, nb = r % nblk, n0 = 32 * nb, pn = n0 >> 8, p = n0 & 255, bj = p >> 7, e0 = p & 127;
                absmax_item(bj ? args.in[18] : args.in[17], DFF, 128 * pn + e0, 64 * kb, ctl + CW_WMAX + n0, args.in[16], lane); continue; } r -= I3;
            { const int nblk = DM / 32, kb = r / nblk, nb = r % nblk;
                absmax_item(args.in[21], DM, 32 * nb, 64 * kb, ctl + CW_WMAX4 + 32 * nb, nullptr, lane); }
        }
        for (int m = gw; m < NTOK; m += 4 * NGW) {
            f32x4 v[4][4]; float ss[4]; int mr[4];
#pragma unroll
            for (int q = 0; q < 4; ++q) { int mm = m + q * NGW; mr[q] = mm; if (mm >= NTOK) mm = m;
                const float* xr = mm < TOK_P ? xp + (size_t)mm * DM : xs + (size_t)(mm - TOK_P) * DM;
#pragma unroll
                for (int j = 0; j < 4; ++j) v[q][j] = __builtin_nontemporal_load((const f32x4*)xr + 64 * j + lane); }
#pragma unroll
            for (int q = 0; q < 4; ++q) { ss[q] = 0.f;
#pragma unroll
                for (int j = 0; j < 4; ++j) ss[q] += dot4(v[q][j]); }
#pragma unroll
            for (int o = 1; o < 64; o <<= 1) {
#pragma unroll
                for (int q = 0; q < 4; ++q) ss[q] += __shfl_xor(ss[q], o); }
            float am[4];
#pragma unroll
            for (int q = 0; q < 4; ++q) { float a = 0.f;
#pragma unroll
                for (int j = 0; j < 4; ++j) a = __builtin_fmaxf(__builtin_fmaxf(a, __builtin_fmaxf(__builtin_fabsf(v[q][j][0]), __builtin_fabsf(v[q][j][1]))), __builtin_fmaxf(__builtin_fabsf(v[q][j][2]), __builtin_fabsf(v[q][j][3])));
                am[q] = a; }
#pragma unroll
            for (int o = 1; o < 64; o <<= 1) {
#pragma unroll
                for (int q = 0; q < 4; ++q) am[q] = __builtin_fmaxf(am[q], __shfl_xor(am[q], o)); }
#pragma unroll
            for (int q = 0; q < 4; ++q) if (mr[q] < NTOK) { const float ms = ss[q] * (1.f / DM) + EPS; const float r = __builtin_amdgcn_rsqf(ms);
                { const float inv = am[q] > 0.f ? 127.0f / am[q] : 0.f;
                  unsigned* oq = (unsigned*)(XQ + (size_t)mr[q] * DM) + lane;
#pragma unroll
                  for (int j = 0; j < 4; ++j) oq[64 * j] = q4(v[q][j][0] * inv, v[q][j][1] * inv, v[q][j][2] * inv, v[q][j][3] * inv);
                  if (lane == 0) { FX[mr[q]] = am[q] * r * (1.0f / 127.0f); ((float*)(ws + WS_X0S))[mr[q]] = am[q] * (1.0f / 127.0f); } }
            }
        }
        { unsigned sp = 0; while (__builtin_amdgcn_readfirstlane(__hip_atomic_load(ctl + CW_W1CNT, __ATOMIC_RELAXED, __HIP_MEMORY_SCOPE_AGENT)) < (unsigned)I1) { __builtin_amdgcn_s_sleep(2); if (++sp > (1u << 22)) break; }
          __builtin_amdgcn_fence(__ATOMIC_ACQUIRE, "agent"); }
        for (int r = gw; r < I1; r += NGW) { const int nblk = DIN / 32, kb = r / nblk, nb = r % nblk, n0 = 32 * nb, pn = n0 >> 8, p = n0 & 255, bj = p >> 7, wc = (p & 127) >> 5;
            quant_item(args.in[3], DIN, 256 * pn + 64 * wc + 32 * bj, DM, 64 * kb, W1Q, n0, args.in[2], ctl + CW_WMAX1 + n0, scr, lane); }
        if (BOTH(0)) GRID_BAR();
    }

    if (IN(1)) {
        {
            LAS float* scr = (LAS float*)(lds + wave * 16384);
            constexpr int I3 = (DM / 64) * (2 * DFF / 32), I4 = (DFF / 64) * (DM / 32), IT = I3 + I4;
            const int gx = bx & 7, lo_ = (int)((long)IT * (gx * (gx - 1) / 2) / 28), hi_ = (int)((long)IT * (gx * (gx + 1) / 2) / 28);
            for (int r = lo_ + (bx >> 3) * NWAVES + wave; r < hi_; r += (G / 8) * NWAVES) {
                if (r < I3) { const int nblk = 2 * DFF / 32, kb = r / nblk, nb = r % nblk, n0 = 32 * nb, pn = n0 >> 8, p = n0 & 255, bj = p >> 7, e0 = p & 127;
                    quant_item(bj ? args.in[18] : args.in[17], DFF, 128 * pn + e0, DM, 64 * kb, (signed char*)(ws + WS_W3), n0, args.in[16], ctl + CW_WMAX + n0, scr, lane); }
                else { const int r4 = r - I3, nblk = DM / 32, kb = r4 / nblk, nb = r4 % nblk;
                    quantf8_item(args.in[21], DM, 32 * nb, DFF, 64 * kb, (unsigned char*)(ws + WS_W4), 32 * nb, ctl + CW_WMAX4 + 32 * nb, scr, lane); } }
            __syncthreads(); }
        pg8::Gemm g{(const bf16_t*)XQ, (const bf16_t*)W1Q, DM / 2, 256}; pg8::StaticOrder S; S.init(NTOK / 256, DIN / 256, G, bx);
        { LAS float* gl = (LAS float*)(lds + EPX_OFF);
          if (tid < 256) { const int v = tid >> 6, d = tid & 63; gl[tid] = (v == 0 ? args.in[4] : v == 1 ? args.in[5] : v == 2 ? args.in[11] : args.in[12])[d]; }
          LDS_WAIT(); __syncthreads(); }
        pg8::EpiProj E{PROJ, (const LAS float*)(lds + EPX_OFF), FX, (const float*)(ctl + CW_WMAX1)};
        pg8::gemm_phase<pg8::EpiProj, pg8::StaticOrder, true, true, 1>(lds, g, S, E);
        if (BOTH(1)) GROUP_BAR();
    }

    if (IN(2)) {
        if (wave == 0) {
            const float a = args.in[6][lane] * args.in[7][lane], b2 = args.in[8][lane] * args.in[9][lane];
            const float sa = wave_sum(a), sb = wave_sum(b2);
            if (lane == 0) ((LAS float*)(lds + MISC_OFF))[16] = __expf(sa) - __expf(sb) + LAM_INIT;
        }
        LDS_WAIT(); __syncthreads();
        const float lam = ((const LAS float*)(lds + MISC_OFF))[16];
        const int per = (768 + G - 1) / G;
#ifndef NO_DIFF
        for (int i = 0; i < per; ++i) { const int u = vcu * per + i; if (u < 768) { const int bh = u >> 3, qb = u & 7;
            att::diff_unit(bh >> 2, bh & 3, qb, PROJ, OB, (LAS char*)lds, lam, args.in[14]); } }
#endif
#ifndef NO_WIN
        for (int i = 0; i < per; ++i) { const int u = vcu * per + i; if (u < 768) { const int bk = u >> 4, qb = u & 15;
            att::win_unit(bk >> 1, bk & 1, qb, PROJ, OB, (LAS char*)lds, args.in[14], args.in[13]); } }
#endif
        if (BOTH(2)) GROUP_BAR();
    }

    if (IN(3)) {
        pg8::Gemm g{OB, W2, DM, 256}; pg8::StaticOrder S; S.init(NTOK / 256, DM / 256, G, bx);
        pg8::EpiOut E{(const signed char*)(ws + WS_XQ), (const float*)(ws + WS_X0S), (float*)(ws + WS_FX), (LAS float*)(lds + EPX_OFF), (signed char*)(ws + WS_X1Q), (float*)(ws + WS_FA), (float*)(ws + WS_XS), ctl + CW_P3CNT};
        pg8::gemm_phase<pg8::EpiOut, pg8::StaticOrder>(lds, g, S, E);
        if (BOTH(3)) GRID_BAR();
    }

    if (IN(4)) {
        signed char* W3Q = (signed char*)(ws + WS_W3); signed char* X1Q = (signed char*)(ws + WS_X1Q); float* FA = (float*)(ws + WS_FA);
        pg8::Gemm g{(const bf16_t*)(X1Q - DM), (const bf16_t*)W3Q, DM / 2, 254}; pg8::StaticOrder S; S.init(194, 2 * DFF / 256, G, bx);
        pg8::EpiFfn E{(unsigned char*)ACT, FA, (const float*)(ctl + CW_WMAX), args.in[19], args.in[20], (LAS float*)(lds + EPX_OFF)};
        pg8::gemm_phase<pg8::EpiFfn, pg8::StaticOrder, true, true, 1>(lds, g, S, E);
        if (BOTH(4)) GRID_BAR();
    }

    if (IN(5)) {
        pg8::Gemm g{ACT, W4, DFF / 2, 256}; pg8::StaticOrder S; S.init(NTOK / 256, DM / 256, G, bx, 1);
        pg8::EpiDown E{(const signed char*)(ws + WS_X1Q), (const float*)(ws + WS_FX), args.out, (const float*)(ctl + CW_WMAX4)};
        pg8::gemm_phase<pg8::EpiDown, pg8::StaticOrder, true, true, 2>(lds, g, S, E);
    }
#undef IN
#undef BOTH
#undef GRID_BAR
}

extern "C" void kernel_launch(void* const* d_in, const int* in_sizes, int n_in, void* d_out, int out_size, void* d_ws, size_t ws_size, hipStream_t stream) {
    static int grid = 0;
    if (grid == 0) {
        if (n_in != 22 || in_sizes[0] != TOK_P * DM || in_sizes[1] != (NTOK - TOK_P) * DM || out_size != NTOK * DM || ws_size < WS_END) {
            fprintf(stderr, "kernel_launch: shape mismatch (n_in %d, in0 %d, in1 %d, out %d, ws %zu; need ws >= %zu)\n", n_in, n_in > 0 ? in_sizes[0] : -1, n_in > 1 ? in_sizes[1] : -1, out_size, ws_size, (size_t)WS_END); grid = -1; return; }
        int dev = 0, cus = 0;
        if (hipGetDevice(&dev) != hipSuccess || hipDeviceGetAttribute(&cus, hipDeviceAttributeMultiprocessorCount, dev) != hipSuccess) { fprintf(stderr, "kernel_launch: device query failed\n"); grid = -1; return; }
        if (hipFuncSetAttribute((const void*)hymba_fwd, hipFuncAttributeMaxDynamicSharedMemorySize, LDS_BYTES) != hipSuccess) { fprintf(stderr, "kernel_launch: hipFuncSetAttribute failed\n"); grid = -1; return; }
        int per_cu = 0;
        if (hipOccupancyMaxActiveBlocksPerMultiprocessor(&per_cu, (const void*)hymba_fwd, NWAVES * 64, LDS_BYTES) != hipSuccess || per_cu < 1)
            fprintf(stderr, "kernel_launch: note: occupancy query reports %d workgroups per CU\n", per_cu);
        (void)hipGetLastError();
        if (cus < 256) { fprintf(stderr, "kernel_launch: %d CUs; this kernel's unit schedule (co-running tile owners in the out-projection epilogue) is built for 256\n", cus); grid = -1; return; }
        grid = 256;
    }
    if (grid < 0) return;
    (void)hipMemsetAsync((char*)d_ws + WS_CTL, 0, CTL_ZERO_BYTES, stream);
    Args a{};
    for (int i = 0; i < 22; ++i) a.in[i] = (const float*)d_in[i];
    a.out = (float*)d_out; a.ws = (unsigned char*)d_ws;
#ifndef PROBE_DUP
#define PROBE_DUP -1
#endif
    constexpr int NL = (PROBE_DUP >= 0) ? 3 : MK_N_LAUNCHES;
    for (int li = 0; li < NL; ++li) {
        if (PROBE_DUP >= 0) {
            a.ph_lo = li == 0 ? 0 : (li == 1 ? PROBE_DUP : PROBE_DUP + 1); a.ph_hi = li == 2 ? 6 : PROBE_DUP + 1; a.li = li;
        } else { a.ph_lo = (NL == 6) ? li : 0; a.ph_hi = (NL == 6) ? li + 1 : 6; a.li = (NL == 6) ? 0 : li; }
        hipLaunchKernelGGL(hymba_fwd, dim3(grid), dim3(NWAVES * 64), LDS_BYTES, stream, a);
        const hipError_t le = hipPeekAtLastError();
        if (le != hipSuccess) { fprintf(stderr, "kernel_launch: launch %d failed: %s\n", li, hipGetErrorName(le)); break; }
    }
}
```

```cpp
#include <hip/hip_runtime.h>
#include <hip/hip_bf16.h>
#include <cstdio>
#include <cstdint>

#ifndef MK_N_LAUNCHES
#define MK_N_LAUNCHES 1
#endif

#define LAS __attribute__((address_space(3)))
#define GAS __attribute__((address_space(1)))
typedef unsigned short bf16_t;
typedef short bf16x8 __attribute__((ext_vector_type(8)));
typedef short s16x4 __attribute__((ext_vector_type(4)));
typedef float f32x2 __attribute__((ext_vector_type(2)));
typedef float f32x4 __attribute__((ext_vector_type(4)));
typedef float f32x16 __attribute__((ext_vector_type(16)));
typedef unsigned u32x2 __attribute__((ext_vector_type(2)));
typedef unsigned u32x4 __attribute__((ext_vector_type(4)));
typedef __bf16 bf16x2_t __attribute__((ext_vector_type(2)));

constexpr int DM = 1024, SEQ = 2048, NSEQ = 24, NTOK = NSEQ * SEQ, TOK_P = 8 * SEQ;
constexpr int DIN = 2304, DFF = 2816;
constexpr int C_DQ = 0, C_DK = 512, C_DV = 1024, C_WQ = 1536, C_WK = 2048, C_WV = 2176;
constexpr int NBH = 12;
constexpr float EPS = 1e-6f, LOG2E = 1.4426950408889634f, QSCALE = 0.125f * LOG2E;
constexpr float LAM_INIT = 0.2f;
constexpr int NWAVES = 8;

__device__ __forceinline__ unsigned cvtpk(float lo, float hi) { f32x2 v = {lo, hi}; bf16x2_t b = __builtin_convertvector(v, bf16x2_t); return __builtin_bit_cast(unsigned, b); }
__device__ __forceinline__ u32x4 pack8(f32x4 a, f32x4 b) { u32x4 w; w.x = cvtpk(a[0], a[1]); w.y = cvtpk(a[2], a[3]); w.z = cvtpk(b[0], b[1]); w.w = cvtpk(b[2], b[3]); return w; }
__device__ __forceinline__ float dot4(f32x4 a) { return (a[0] * a[0] + a[1] * a[1]) + (a[2] * a[2] + a[3] * a[3]); }

__device__ __forceinline__ unsigned q4(float a, float b, float c, float d) {
    const unsigned ua = __float_as_uint(a + 12582912.0f), ub = __float_as_uint(b + 12582912.0f), uc = __float_as_uint(c + 12582912.0f), ud = __float_as_uint(d + 12582912.0f);
    return __builtin_amdgcn_perm(__builtin_amdgcn_perm(ud, uc, 0x0c0c0400u), __builtin_amdgcn_perm(ub, ua, 0x0c0c0400u), 0x05040100u);
}
__device__ __forceinline__ unsigned q4s(f32x4 v, f32x2 i2, f32x2 m) {
    const f32x2 lo = __builtin_elementwise_fma((f32x2){v[0], v[1]}, i2, m), hi = __builtin_elementwise_fma((f32x2){v[2], v[3]}, i2, m);
    return __builtin_amdgcn_perm(__builtin_amdgcn_perm(__float_as_uint(hi.y), __float_as_uint(hi.x), 0x0c0c0400u), __builtin_amdgcn_perm(__float_as_uint(lo.y), __float_as_uint(lo.x), 0x0c0c0400u), 0x05040100u);
}
__device__ __forceinline__ unsigned f8x4(float a, float b, float c, float d) {
    int w = 0;
    w = __builtin_amdgcn_cvt_pk_fp8_f32(__builtin_amdgcn_fmed3f(a, -448.f, 448.f), __builtin_amdgcn_fmed3f(b, -448.f, 448.f), w, false);
    w = __builtin_amdgcn_cvt_pk_fp8_f32(__builtin_amdgcn_fmed3f(c, -448.f, 448.f), __builtin_amdgcn_fmed3f(d, -448.f, 448.f), w, true);
    return (unsigned)w;
}
constexpr float ACT8_SCALE = 8.0f, W8_TOP = 224.0f;
namespace pg8 {
constexpr int BM = 256, BK = 64, HALF = 128, HTB = HALF * BK * 2, STAGE_BYTES = 8 * HTB, NXCD = 8, WGM = 8;
__host__ __device__ __forceinline__ int lds_byte(int r, int c) { const int st = (r >> 4) * 2 + (c >> 5), rr = r & 15, cc = c & 31, ob = rr * 64 + cc * 2; return st * 1024 + (ob ^ (((ob >> 9) & 1) << 5)); }
__host__ __device__ __forceinline__ void stage_rc(int b, int& R, int& C) { const int st = b / 1024, sb = b % 1024, swz = sb ^ (((sb >> 9) & 1) << 5); R = (st >> 1) * 16 + swz / 64; C = (st & 1) * 32 + (swz % 64) / 2; }
__host__ __device__ __forceinline__ int perm32(int rho) { const int n = rho >> 4, i = rho & 15; return 8 * (i >> 2) + 4 * n + (i & 3); }

typedef int v4i32_t __attribute__((ext_vector_type(4)));
struct Unit { int pm, pn; };
struct Gemm { const bf16_t* A; const bf16_t* Bt; int K; int arows; };

struct StaticOrder {
    int nM, nN, nwg, G, c, rev;
    __device__ void init(int nM_, int nN_, int G_, int c_, int rev_ = 0) { nM = nM_; nN = nN_; nwg = nM * nN; G = G_; c = c_; rev = rev_; }
    __device__ bool next(int i, Unit& u) const {
        const int nr = (nwg - c + G - 1) / G; if (i >= nr) return false;
        const long L = (long)(rev ? nr - 1 - i : i) * G + c;
        int wgid = (int)L; { const int q = nwg / NXCD, r = nwg % NXCD, xcd = wgid % NXCD, off = wgid / NXCD; wgid = (xcd < r ? xcd * (q + 1) : r * (q + 1) + (xcd - r) * q) + off; }
        const int nig = WGM * nN, gid = wgid / nig, fm = gid * WGM, gsz = (nM - fm) < WGM ? (nM - fm) : WGM;
        u.pm = fm + ((wgid % nig) % gsz); u.pn = (wgid % nig) / gsz; return true;
    }
};


struct EpiProj {
    static constexpr bool PERM = true;
    bf16_t* P; const LAS float* gl; const float* fx; const float* swm;
    __device__ __forceinline__ void pre(const Unit& u, int wid, int lane_) const {
        int lane = lane_; asm volatile("" : "+v"(lane));
        if (wid >= 4) __builtin_amdgcn_global_load_lds((const unsigned*)(fx + u.pm * BM + 64 * (wid - 4) + lane), (LAS unsigned*)((LAS char*)gl + 1024 + (wid - 4) * 256), 4, 0, 0);
        if (wid == 2) __builtin_amdgcn_global_load_lds((const unsigned*)(swm + u.pn * 256 + lane * 4), (LAS unsigned*)((LAS char*)gl + 2048), 16, 0, 0);
    }
    __device__ __forceinline__ void operator()(const f32x4 (&acc)[2][2][4][2], const Unit& u, int wr, int wc, int fr, int fq, int lane) const {
        int fql = fq; asm volatile("" : "+v"(fql));
        f32x4 csw[2][2];
#pragma unroll
        for (int bj = 0; bj < 2; ++bj)
#pragma unroll
            for (int n = 0; n < 2; ++n) csw[bj][n] = *(const LAS f32x4*)(gl + 512 + 128 * bj + 32 * wc + 8 * fql + 4 * n) * (1.0f / 127.0f);
        const int gidx = u.pn * 4 + wc;
        int gsel = -1; float sc = 1.f;
        if (gidx < 8) { gsel = 0; sc = QSCALE; } else if (gidx < 16) { gsel = 1; } else if (gidx < 24) { } else if (gidx < 32) { gsel = 2; sc = QSCALE; } else if (gidx < 34) { gsel = 3; }
        const bool nrm = gsel >= 0; const LAS float* gain = gl + (nrm ? gsel : 0) * 64;
        f32x4 gv[2][2];
#pragma unroll
        for (int bj = 0; bj < 2; ++bj)
#pragma unroll
            for (int n = 0; n < 2; ++n) gv[bj][n] = nrm ? *(const LAS f32x4*)(gain + 32 * bj + 8 * fq + 4 * n) * sc : (f32x4){1.f, 1.f, 1.f, 1.f};
        bf16_t* base = P + (size_t)(u.pm * BM + wr * 64 + fr) * DIN + gidx * 64 + 8 * fq;
#pragma unroll
        for (int ai = 0; ai < 2; ++ai)
#pragma unroll
            for (int m = 0; m < 4; ++m) {
                const float fxr = gl[256 + ai * HALF + wr * 64 + m * 16 + fr];
                f32x4 v00 = __builtin_convertvector(__builtin_bit_cast(v4i32_t, acc[ai][0][m][0]), f32x4) * (csw[0][0] * fxr), v01 = __builtin_convertvector(__builtin_bit_cast(v4i32_t, acc[ai][0][m][1]), f32x4) * (csw[0][1] * fxr);
                f32x4 v10 = __builtin_convertvector(__builtin_bit_cast(v4i32_t, acc[ai][1][m][0]), f32x4) * (csw[1][0] * fxr), v11 = __builtin_convertvector(__builtin_bit_cast(v4i32_t, acc[ai][1][m][1]), f32x4) * (csw[1][1] * fxr);
                float rn = 1.f;
                if (nrm) {
                    f32x2 qa = (f32x2){v00[0], v00[1]} * (f32x2){v00[0], v00[1]}, qb = (f32x2){v00[2], v00[3]} * (f32x2){v00[2], v00[3]};
                    qa = __builtin_elementwise_fma((f32x2){v01[0], v01[1]}, (f32x2){v01[0], v01[1]}, qa); qb = __builtin_elementwise_fma((f32x2){v01[2], v01[3]}, (f32x2){v01[2], v01[3]}, qb);
                    qa = __builtin_elementwise_fma((f32x2){v10[0], v10[1]}, (f32x2){v10[0], v10[1]}, qa); qb = __builtin_elementwise_fma((f32x2){v10[2], v10[3]}, (f32x2){v10[2], v10[3]}, qb);
                    qa = __builtin_elementwise_fma((f32x2){v11[0], v11[1]}, (f32x2){v11[0], v11[1]}, qa); qb = __builtin_elementwise_fma((f32x2){v11[2], v11[3]}, (f32x2){v11[2], v11[3]}, qb);
                    qa += qb; float ss = qa.x + qa.y; ss += __shfl_xor(ss, 16); ss += __shfl_xor(ss, 32); rn = __builtin_amdgcn_rsqf(ss * (1.0f / 64.0f) + EPS); }
                v00 = v00 * rn * gv[0][0]; v01 = v01 * rn * gv[0][1]; v10 = v10 * rn * gv[1][0]; v11 = v11 * rn * gv[1][1];
                bf16_t* rowp = base + (size_t)(ai * HALF + m * 16) * DIN;
                const u32x4 pa = pack8(v00, v01), pb = pack8(v10, v11);
                u32x4 px; px.x = (unsigned)__builtin_amdgcn_mov_dpp((int)pb.x, 0x128, 0xf, 0xf, true); px.y = (unsigned)__builtin_amdgcn_mov_dpp((int)pb.y, 0x128, 0xf, 0xf, true);
                px.z = (unsigned)__builtin_amdgcn_mov_dpp((int)pb.z, 0x128, 0xf, 0xf, true); px.w = (unsigned)__builtin_amdgcn_mov_dpp((int)pb.w, 0x128, 0xf, 0xf, true);
                const bool hi8 = (fr & 8) != 0;
                bf16_t* r1p = base + (size_t)(ai * HALF + m * 16 - (hi8 ? 8 : 0)) * DIN + (hi8 ? 32 : 0);
                bf16_t* r2p = base + (size_t)(ai * HALF + m * 16 + (hi8 ? 0 : 8)) * DIN + (hi8 ? 0 : 32);
                *(u32x4*)(r1p) = hi8 ? px : pa; *(u32x4*)(r2p) = hi8 ? pa : px;
            }
    }
};

struct EpiOut {
    static constexpr bool PERM = true;
    const signed char* xq0; const float* __restrict__ sx0; float* __restrict__ sx1; LAS float* xl;
    signed char* x1q; float* fa; float* xs; unsigned* cnt;
    __device__ __forceinline__ void pre(const Unit&, int, int) const {}
    __device__ __forceinline__ void operator()(f32x4 (&acc)[2][2][4][2], const Unit& u, int wr, int wc, int fr, int fq, int lane) const {
        asm volatile("" : "+v"(fr), "+v"(fq));
        const int rowbase = u.pm * BM;
        const int col0 = u.pn * BM + wc * 64 + 16 * fq;
        u32x4 xva[2][4]; float s0a[2][4];
#pragma unroll
        for (int ai = 0; ai < 2; ++ai)
#pragma unroll
            for (int m = 0; m < 4; ++m) { const size_t row = (size_t)(rowbase + ai * HALF + wr * 64 + m * 16 + fr); const signed char* xr = xq0 + row * DM + col0;
                s0a[ai][m] = sx0[row];
                xva[ai][m] = *(const u32x4*)xr; }
#pragma unroll
        for (int ai = 0; ai < 2; ++ai) {
            const u32x4 (&xv)[4] = xva[ai]; const float (&s0)[4] = s0a[ai];
#pragma unroll
            for (int m = 0; m < 4; ++m) {
                const int rl = ai * HALF + wr * 64 + m * 16 + fr; float s = 0.f, am = 0.f; f32x2 s2 = {0.f, 0.f}, t2 = {0.f, 0.f};
#pragma unroll
                for (int bj = 0; bj < 2; ++bj) {
                    const int wx = (int)(bj ? xv[m].z : xv[m].x), wy = (int)(bj ? xv[m].w : xv[m].y); f32x4 x0, x1;
                    x0[0] = (float)((wx << 24) >> 24); x0[1] = (float)((wx << 16) >> 24); x0[2] = (float)((wx << 8) >> 24); x0[3] = (float)(wx >> 24);
                    x1[0] = (float)((wy << 24) >> 24); x1[1] = (float)((wy << 16) >> 24); x1[2] = (float)((wy << 8) >> 24); x1[3] = (float)(wy >> 24);
                    const f32x4 o0 = x0 * s0[m] + acc[ai][bj][m][0], o1 = x1 * s0[m] + acc[ai][bj][m][1];
                    acc[ai][bj][m][0] = o0; acc[ai][bj][m][1] = o1;
#pragma unroll
                    for (int i = 0; i < 4; ++i) am = __builtin_fmaxf(__builtin_fmaxf(am, __builtin_fabsf(o0[i])), __builtin_fabsf(o1[i]));
                    s2 = __builtin_elementwise_fma((f32x2){o0[0], o0[1]}, (f32x2){o0[0], o0[1]}, s2); t2 = __builtin_elementwise_fma((f32x2){o0[2], o0[3]}, (f32x2){o0[2], o0[3]}, t2);
                    s2 = __builtin_elementwise_fma((f32x2){o1[0], o1[1]}, (f32x2){o1[0], o1[1]}, s2); t2 = __builtin_elementwise_fma((f32x2){o1[2], o1[3]}, (f32x2){o1[2], o1[3]}, t2); }
                s2 += t2; s = s2.x + s2.y;
                s += __shfl_xor(s, 16); s += __shfl_xor(s, 32);
                am = __builtin_fmaxf(am, __shfl_xor(am, 16)); am = __builtin_fmaxf(am, __shfl_xor(am, 32));
                if (fq == 0) { xl[rl * 8 + wc] = s; xl[rl * 8 + 4 + wc] = am; }
            }
        }
        asm volatile("s_waitcnt lgkmcnt(0)" ::: "memory"); __builtin_amdgcn_s_barrier(); asm volatile("" ::: "memory");
        const int t = (wr * 4 + wc) * 64 + lane;
        if (t < 256) {
            const f32x4 q = *(const LAS f32x4*)(xl + t * 8), a4 = *(const LAS f32x4*)(xl + t * 8 + 4);
            float* sl = xs + ((size_t)(rowbase + t) * 4 + u.pn) * 2;
            __hip_atomic_store(sl, (q[0] + q[1]) + (q[2] + q[3]) + 1e-30f, __ATOMIC_RELAXED, __HIP_MEMORY_SCOPE_AGENT);
            __hip_atomic_store(sl + 1, __builtin_fmaxf(__builtin_fmaxf(a4[0], a4[1]), __builtin_fmaxf(a4[2], a4[3])) + 1e-30f, __ATOMIC_RELAXED, __HIP_MEMORY_SCOPE_AGENT);
            const float* sr = xs + (size_t)(rowbase + t) * 8; float ss = 0.f, am = 0.f; unsigned sp = 0;
            while (true) { float v0 = __hip_atomic_load(sr + 0, __ATOMIC_RELAXED, __HIP_MEMORY_SCOPE_AGENT), v1 = __hip_atomic_load(sr + 1, __ATOMIC_RELAXED, __HIP_MEMORY_SCOPE_AGENT),
                                 v2 = __hip_atomic_load(sr + 2, __ATOMIC_RELAXED, __HIP_MEMORY_SCOPE_AGENT), v3 = __hip_atomic_load(sr + 3, __ATOMIC_RELAXED, __HIP_MEMORY_SCOPE_AGENT),
                                 v4 = __hip_atomic_load(sr + 4, __ATOMIC_RELAXED, __HIP_MEMORY_SCOPE_AGENT), v5 = __hip_atomic_load(sr + 5, __ATOMIC_RELAXED, __HIP_MEMORY_SCOPE_AGENT),
                                 v6 = __hip_atomic_load(sr + 6, __ATOMIC_RELAXED, __HIP_MEMORY_SCOPE_AGENT), v7 = __hip_atomic_load(sr + 7, __ATOMIC_RELAXED, __HIP_MEMORY_SCOPE_AGENT);
                const bool ok = (v0 != 0.f) & (v1 != 0.f) & (v2 != 0.f) & (v3 != 0.f) & (v4 != 0.f) & (v5 != 0.f) & (v6 != 0.f) & (v7 != 0.f);
                ss = (v0 + v2) + (v4 + v6); am = __builtin_fmaxf(__builtin_fmaxf(v1, v3), __builtin_fmaxf(v5, v7));
                if (__all(ok) || ++sp > (1u << 20)) break;
                __builtin_amdgcn_s_sleep(1); }
            xl[2048 + t] = am > 0.f ? 127.0f / am : 0.f;
            if (u.pn == 0) { fa[rowbase + t] = __builtin_amdgcn_rsqf(ss * (1.0f / DM) + EPS) * am * (1.0f / 127.0f); sx1[rowbase + t] = am * (1.0f / 127.0f); }
        }
        asm volatile("s_waitcnt lgkmcnt(0)" ::: "memory"); __builtin_amdgcn_s_barrier(); asm volatile("" ::: "memory");
        f32x2 mg2 = {12582912.0f, 12582912.0f}; asm volatile("" : "+v"(mg2));
#pragma unroll
        for (int ai = 0; ai < 2; ++ai)
#pragma unroll
            for (int m = 0; m < 4; ++m) { const int rl = ai * HALF + wr * 64 + m * 16 + fr; const float inv = xl[2048 + rl];
                signed char* qp = x1q + (size_t)(rowbase + rl) * DM + col0;
                u32x4 o;
                f32x2 i2 = {inv, inv}; asm volatile("" : "+v"(i2));
                o.x = q4s(acc[ai][0][m][0], i2, mg2); o.y = q4s(acc[ai][0][m][1], i2, mg2); o.z = q4s(acc[ai][1][m][0], i2, mg2); o.w = q4s(acc[ai][1][m][1], i2, mg2);
                *(u32x4*)qp = o; }
    }
};

__device__ __forceinline__ float dpp8(float x) { return __builtin_bit_cast(float, __builtin_amdgcn_mov_dpp(__builtin_bit_cast(int, x), 0x128, 0xf, 0xf, true)); }
struct EpiDown {
    static constexpr bool PERM = true;
    const signed char* __restrict__ x1q; const float* __restrict__ sx1; float* __restrict__ out; const float* __restrict__ wmx;
    __device__ __forceinline__ void pre(const Unit&, int, int) const {}
    __device__ __forceinline__ void operator()(const f32x4 (&acc)[2][2][4][2], const Unit& u, int wr, int wc, int fr, int fq, int lane) const {
        asm volatile("" : "+v"(fr), "+v"(fq));
        const int col0 = u.pn * BM + wc * 32 + 8 * fq; const bool hi8 = (fr & 8) != 0;
        f32x4 cs[2][2];
#pragma unroll
        for (int bj = 0; bj < 2; ++bj)
#pragma unroll
            for (int n = 0; n < 2; ++n) cs[bj][n] = *(const f32x4*)(wmx + col0 + bj * HALF + 4 * n) * (1.0f / (W8_TOP * ACT8_SCALE));
#pragma unroll
        for (int ai = 0; ai < 2; ++ai) {
            u32x2 w[4][2]; float sx[4];
#pragma unroll
            for (int m = 0; m < 4; ++m) { const size_t row = (size_t)(u.pm * BM + ai * HALF + wr * 64 + m * 16 + fr); const size_t off = row * DM + col0;
                sx[m] = sx1[row];
#pragma unroll
                for (int bj = 0; bj < 2; ++bj) w[m][bj] = *(const u32x2*)(x1q + off + bj * HALF); }
#pragma unroll
            for (int m = 0; m < 4; ++m) { const size_t off = (size_t)(u.pm * BM + ai * HALF + wr * 64 + m * 16 + fr) * DM + col0;
#pragma unroll
                for (int bj = 0; bj < 2; ++bj) { const int wx = (int)w[m][bj].x, wy = (int)w[m][bj].y;
                    f32x4 r0, r1;
                    r0[0] = (float)((wx << 24) >> 24) * sx[m]; r0[1] = (float)((wx << 16) >> 24) * sx[m]; r0[2] = (float)((wx << 8) >> 24) * sx[m]; r0[3] = (float)(wx >> 24) * sx[m];
                    r1[0] = (float)((wy << 24) >> 24) * sx[m]; r1[1] = (float)((wy << 16) >> 24) * sx[m]; r1[2] = (float)((wy << 8) >> 24) * sx[m]; r1[3] = (float)(wy >> 24) * sx[m];
                    const f32x4 q0 = r0 + acc[ai][bj][m][0] * cs[bj][0], q1 = r1 + acc[ai][bj][m][1] * cs[bj][1];
                    f32x4 qx; qx[0] = dpp8(q1[0]); qx[1] = dpp8(q1[1]); qx[2] = dpp8(q1[2]); qx[3] = dpp8(q1[3]);
                    const long d1 = hi8 ? (long)(4 - 8 * DM) : 0, d2 = hi8 ? 0 : (long)(4 + 8 * DM);
                    __builtin_nontemporal_store(hi8 ? qx : q0, (f32x4*)(out + off + bj * HALF + d1)); __builtin_nontemporal_store(hi8 ? q0 : qx, (f32x4*)(out + off + bj * HALF + d2)); } } }
    }
};

template <int CTRL> __device__ __forceinline__ float dppz(float x) { return __builtin_bit_cast(float, __builtin_amdgcn_update_dpp(0, __builtin_bit_cast(int, x), CTRL, 0xf, 0xf, true)); }
template <int CTRL> __device__ __forceinline__ float dppo(float old, float x) { return __builtin_bit_cast(float, __builtin_amdgcn_update_dpp(__builtin_bit_cast(int, old), __builtin_bit_cast(int, x), CTRL, 0xf, 0xf, false)); }
struct EpiFfn {
    static constexpr bool PERM = true;
    unsigned char* act; const float* fa; const float* swm; const float* cw; const float* cb; LAS float* xl;
    __device__ __forceinline__ void pre(const Unit& u, int wid, int lane_) const {
        int lane = lane_; asm volatile("" : "+v"(lane));
        const int tok0 = 254 * u.pm - 1;
        if (wid >= 4) { int tok = tok0 + 64 * (wid - 4) + lane; tok = tok < 0 ? 0 : (tok > NTOK - 1 ? NTOK - 1 : tok);
            __builtin_amdgcn_global_load_lds((const unsigned*)(fa + tok), (LAS unsigned*)((LAS char*)xl + 4096 + (wid - 4) * 256), 4, 0, 0); }
        if (wid == 2) __builtin_amdgcn_global_load_lds((const unsigned*)(swm + u.pn * 256 + lane * 4), (LAS unsigned*)((LAS char*)xl + 5120), 16, 0, 0);
        if (wid < 2) { const float* src = (wid == 0 ? (lane < 32 ? cw : cw + DFF) : (lane < 32 ? cw + 2 * DFF : cb)) + u.pn * 128 + (lane & 31) * 4;
            __builtin_amdgcn_global_load_lds((const unsigned*)src, (LAS unsigned*)((LAS char*)xl + 20480 + wid * 1024), 16, 0, 0); }
    }
    template <int AI, int M, bool MASK>
    __device__ __forceinline__ void conv_rows(const f32x4 (&acc)[2][2][4][2], const f32x4 (&w0)[2], const f32x4 (&w1)[2], const f32x4 (&w2)[2], const f32x4 (&bb)[2],
                                              int tok, int rl, int G, int xc, int fr, int ch0) const {
        const bool pcut = MASK && (tok & (SEQ - 1)) == 0, ncut = MASK && (tok & (SEQ - 1)) == SEQ - 1;
        f32x2 rr[4];
#pragma unroll
        for (int n = 0; n < 2; ++n) {
            f32x4 ex = (f32x4){0.f, 0.f, 0.f, 0.f};
            if (M == 0) ex = *(const LAS f32x4*)(xl + ((2 * (G - 1) + 1) & 7) * 128 + xc + 4 * n);
            if (M == 3) ex = *(const LAS f32x4*)(xl + ((2 * (G + 1)) & 7) * 128 + xc + 4 * n);
#pragma unroll
            for (int h = 0; h < 2; ++h) { const int i = 2 * h;
                const f32x4 gv = acc[AI][0][M][n], gp = acc[AI][0][M > 0 ? M - 1 : 0][n], gn = acc[AI][0][M < 3 ? M + 1 : 3][n], uv = acc[AI][1][M][n];
                const f32x2 own = {gv[i], gv[i + 1]};
                const f32x2 p0 = (M > 0) ? (f32x2){dppz<0x10F>(gp[i]), dppz<0x10F>(gp[i + 1])} : (f32x2){ex[i], ex[i + 1]};
                f32x2 pr = {dppo<0x111>(p0.x, gv[i]), dppo<0x111>(p0.y, gv[i + 1])};
                const f32x2 n0 = (M < 3) ? (f32x2){dppz<0x11F>(gn[i]), dppz<0x11F>(gn[i + 1])} : (f32x2){ex[i], ex[i + 1]};
                f32x2 nx = {dppo<0x101>(n0.x, gv[i]), dppo<0x101>(n0.y, gv[i + 1])};
                if (MASK) { pr = pcut ? (f32x2){0.f, 0.f} : pr; nx = ncut ? (f32x2){0.f, 0.f} : nx; }
                const f32x2 a0 = {w0[n][i], w0[n][i + 1]}, a1 = {w1[n][i], w1[n][i + 1]}, a2 = {w2[n][i], w2[n][i + 1]}, ab = {bb[n][i], bb[n][i + 1]};
                const f32x2 uc = __builtin_elementwise_fma(a0, pr, __builtin_elementwise_fma(a1, own, __builtin_elementwise_fma(a2, nx, ab)));
                const f32x2 dn = (f32x2){__builtin_amdgcn_exp2f(uc.x), __builtin_amdgcn_exp2f(uc.y)} + 1.0f;
                const f32x2 rc = {__builtin_amdgcn_rcpf(dn.x), __builtin_amdgcn_rcpf(dn.y)};
                rr[2 * n + h] = uc * rc * (f32x2){uv[i], uv[i + 1]}; } }
        if (rl != 0 && rl != 255 && tok < NTOK) { u32x2 o; o.x = f8x4(rr[0].x, rr[0].y, rr[1].x, rr[1].y); o.y = f8x4(rr[2].x, rr[2].y, rr[3].x, rr[3].y); *(u32x2*)(act + (size_t)tok * DFF + ch0) = o; }
    }
    __device__ __forceinline__ void operator()(f32x4 (&acc)[2][2][4][2], const Unit& u, int wr, int wc, int fr, int fq, int lane) const {
        const int ch0 = u.pn * 128 + wc * 32 + 8 * fq;
        const int tok0 = 254 * u.pm - 1;
        int fql = fq; asm volatile("" : "+v"(fql));
        const int xc = wc * 32 + 8 * fql;
        f32x4 su[2];
#pragma unroll
        for (int n = 0; n < 2; ++n) su[n] = *(const LAS f32x4*)(xl + 1280 + 128 + xc + 4 * n) * (-ACT8_SCALE / (127.0f * LOG2E));
#pragma unroll
        for (int ai = 0; ai < 2; ++ai)
#pragma unroll
            for (int m = 0; m < 4; ++m) { const float rs = xl[1024 + ai * HALF + wr * 64 + m * 16 + fr];
#pragma unroll
                for (int n = 0; n < 2; ++n) { const f32x4 rsu = su[n] * rs;
                    acc[ai][0][m][n] = __builtin_convertvector(__builtin_bit_cast(v4i32_t, acc[ai][0][m][n]), f32x4) * rs;
                    acc[ai][1][m][n] = __builtin_convertvector(__builtin_bit_cast(v4i32_t, acc[ai][1][m][n]), f32x4) * rsu; } }
#pragma unroll
        for (int ai = 0; ai < 2; ++ai) { const int G = 2 * ai + wr;
            if (fr == 0) { *(LAS f32x4*)(xl + (2 * G) * 128 + xc) = acc[ai][0][0][0]; *(LAS f32x4*)(xl + (2 * G) * 128 + xc + 4) = acc[ai][0][0][1]; }
            if (fr == 15) { *(LAS f32x4*)(xl + (2 * G + 1) * 128 + xc) = acc[ai][0][3][0]; *(LAS f32x4*)(xl + (2 * G + 1) * 128 + xc + 4) = acc[ai][0][3][1]; } }
        asm volatile("s_waitcnt lgkmcnt(0)" ::: "memory"); __builtin_amdgcn_s_barrier(); asm volatile("" ::: "memory"); __builtin_amdgcn_sched_barrier(0);
        const int wru = __builtin_amdgcn_readfirstlane(wr);
        f32x4 w0[2], w1[2], w2[2], bb[2];
#pragma unroll
        for (int n = 0; n < 2; ++n) { const LAS float* wl = xl + 5120 + xc + 4 * n; const f32x4 sgc = *(const LAS f32x4*)(xl + 1280 + xc + 4 * n) * (-LOG2E / 127.0f);
            w0[n] = *(const LAS f32x4*)(wl) * sgc; w1[n] = *(const LAS f32x4*)(wl + 128) * sgc; w2[n] = *(const LAS f32x4*)(wl + 256) * sgc; bb[n] = *(const LAS f32x4*)(wl + 384) * -LOG2E; }
#define FFN_ROWS(AI, M) do { const int tb_ = tok0 + AI * HALF + wru * 64 + M * 16; const int G_ = 2 * AI + wr;     \
        if (((tb_ + 16) & (SEQ - 1)) <= 16) conv_rows<AI, M, true>(acc, w0, w1, w2, bb, tb_ + fr, AI * HALF + wr * 64 + M * 16 + fr, G_, xc, fr, ch0); \
        else conv_rows<AI, M, false>(acc, w0, w1, w2, bb, tb_ + fr, AI * HALF + wr * 64 + M * 16 + fr, G_, xc, fr, ch0); \
        if ((M) & 1) __builtin_amdgcn_sched_barrier(0); } while (0)
        FFN_ROWS(0, 0); FFN_ROWS(0, 1); FFN_ROWS(0, 2); FFN_ROWS(0, 3); FFN_ROWS(1, 0); FFN_ROWS(1, 1); FFN_ROWS(1, 2); FFN_ROWS(1, 3);
#undef FFN_ROWS
    }
};

typedef int v8i32_t __attribute__((ext_vector_type(8)));
template <class Epi, class Sched, bool ALIGN_EPI = true, bool SP2 = true, int QM = 0>
__device__ __forceinline__ void gemm_phase(LAS unsigned char* lds, const Gemm g, const Sched& S, const Epi& E) {
    const int tid = threadIdx.x, wid = __builtin_amdgcn_readfirstlane(tid >> 6), lane = tid & 63, wr = wid >> 2, wc = wid & 3, fr = lane & 15, fq = lane >> 4;
    const int K = g.K, nt = K / BK;
    unsigned voffA[2], voffB[2];
#pragma unroll
    for (int i = 0; i < 2; ++i) { int R, C; stage_rc(tid * 16 + i * 8192, R, C); const int Rb = Epi::PERM ? ((R & ~31) + perm32(R & 31)) : R;
        voffA[i] = (unsigned)(R * K + C) * 2u; voffB[i] = (unsigned)(Rb * K + C) * 2u; }
    const size_t kstep = (size_t)(BK * 2);
    const size_t hstep = (size_t)HALF * K * 2;
    const size_t tstepB = 2 * hstep;
    const size_t tstepA = (size_t)g.arows * K * 2;
    const unsigned ldsw = (unsigned)wid * 1024u;
    const int aoff = lds_byte(wr * 64 + fr, fq * 8), boff = lds_byte(wc * 32 + fr, fq * 8);
#define PG8_SA(b, h) (((b) * 2 + (h)) * HTB)
#define PG8_SB(b, h) ((4 + (b) * 2 + (h)) * HTB)
#define PG8_STAGE(bufoff, gbase, voff) do { _Pragma("unroll") for (int _i = 0; _i < 2; ++_i) \
        __builtin_amdgcn_global_load_lds((const unsigned*)((const char*)(gbase) + (voff)[_i]), (LAS unsigned*)(lds + (bufoff) + ldsw + _i * 8192), 16, 0, 0); } while (0)
#define PG8_LDA(dst, b, h) do { _Pragma("unroll") for (int m = 0; m < 4; ++m) _Pragma("unroll") for (int k = 0; k < 2; ++k) dst[m][k] = *(const LAS bf16x8*)(lds + PG8_SA(b, h) + aoff + m * 2048 + k * 1024); } while (0)
#define PG8_LDB(dst, b, h) do { _Pragma("unroll") for (int n = 0; n < 2; ++n) _Pragma("unroll") for (int k = 0; k < 2; ++k) dst[n][k] = *(const LAS bf16x8*)(lds + PG8_SB(b, h) + boff + n * 2048 + k * 1024); } while (0)
#define PG8_MMA(ai, bj, At, Bt) do { __builtin_amdgcn_s_setprio(1); \
    if constexpr (QM == 2) { _Pragma("unroll") for (int m = 0; m < 4; ++m) _Pragma("unroll") for (int n = 0; n < 2; ++n) { \
        const v8i32_t b8_ = __builtin_shufflevector(__builtin_bit_cast(v4i32_t, Bt[n][0]), __builtin_bit_cast(v4i32_t, Bt[n][1]), 0, 1, 2, 3, 4, 5, 6, 7), a8_ = __builtin_shufflevector(__builtin_bit_cast(v4i32_t, At[m][0]), __builtin_bit_cast(v4i32_t, At[m][1]), 0, 1, 2, 3, 4, 5, 6, 7); \
        asm volatile("v_mfma_scale_f32_16x16x128_f8f6f4 %0, %1, %2, %0, %3, %3 op_sel_hi:[0,0,0]" : "+v"(acc[ai][bj][m][n]) : "v"(b8_), "v"(a8_), "v"(one8)); } } \
    else _Pragma("unroll") for (int m = 0; m < 4; ++m) _Pragma("unroll") for (int n = 0; n < 2; ++n) _Pragma("unroll") for (int k = 0; k < 2; ++k) \
        { if constexpr (QM == 1) acc[ai][bj][m][n] = __builtin_bit_cast(f32x4, __builtin_amdgcn_mfma_i32_16x16x64_i8(__builtin_bit_cast(v4i32_t, Bt[n][k]), __builtin_bit_cast(v4i32_t, At[m][k]), __builtin_bit_cast(v4i32_t, acc[ai][bj][m][n]), 0, 0, 0)); \
          else acc[ai][bj][m][n] = __builtin_amdgcn_mfma_f32_16x16x32_bf16(Bt[n][k], At[m][k], acc[ai][bj][m][n], 0, 0, 0); } __builtin_amdgcn_s_setprio(0); } while (0)
#define PG8_WAIT_V(n) asm volatile("s_waitcnt vmcnt(" #n ")" ::: "memory")
#define PG8_WAIT_L(n) asm volatile("s_waitcnt lgkmcnt(" #n ")" ::: "memory")
#define PG8_BAR __builtin_amdgcn_s_barrier()
#define PG8_SCHED __builtin_amdgcn_sched_barrier(0)
    Unit cur, nxt; int ui = 0;
    if (!S.next(0, cur)) return;
    const int one8 = 0x7f7f7f7f;
    f32x4 acc[2][2][4][2];
#pragma unroll
    for (int a = 0; a < 2; ++a)
#pragma unroll
        for (int b = 0; b < 2; ++b)
#pragma unroll
            for (int m = 0; m < 4; ++m)
#pragma unroll
                for (int n = 0; n < 2; ++n) acc[a][b][m][n] = (f32x4){0.f, 0.f, 0.f, 0.f};
    bf16x8 At[4][2], B0[2][2], B1[2][2];
    const char* cA = (const char*)g.A + (size_t)cur.pm * tstepA; const char* cB = (const char*)g.Bt + (size_t)cur.pn * tstepB;
    if constexpr (SP2) {
        PG8_STAGE(PG8_SB(0, 0), cB, voffB); PG8_STAGE(PG8_SB(0, 1), cB + hstep, voffB); PG8_STAGE(PG8_SA(0, 0), cA, voffA); PG8_STAGE(PG8_SA(0, 1), cA + hstep, voffA);
        if (wr == 1) PG8_BAR;
        PG8_WAIT_V(2); PG8_BAR;
        PG8_STAGE(PG8_SB(1, 0), cB + kstep, voffB); PG8_STAGE(PG8_SA(1, 0), cA + kstep, voffA); PG8_STAGE(PG8_SB(1, 1), cB + hstep + kstep, voffB);
        PG8_WAIT_V(6); PG8_BAR;
    } else {
        PG8_STAGE(PG8_SB(0, 0), cB, voffB); PG8_STAGE(PG8_SA(0, 0), cA, voffA); PG8_STAGE(PG8_SB(0, 1), cB + hstep, voffB); PG8_STAGE(PG8_SA(0, 1), cA + hstep, voffA);
        if (wr == 1) PG8_BAR;
        PG8_WAIT_V(4); PG8_BAR;
        PG8_STAGE(PG8_SB(1, 0), cB + kstep, voffB); PG8_STAGE(PG8_SA(1, 0), cA + kstep, voffA); PG8_STAGE(PG8_SB(1, 1), cB + hstep + kstep, voffB);
        PG8_WAIT_V(6); PG8_BAR;
    }
    for (;;) {
        const bool has_next = S.next(ui + 1, nxt);
        const char* nA = has_next ? (const char*)g.A + (size_t)nxt.pm * tstepA : cA; const char* nB = has_next ? (const char*)g.Bt + (size_t)nxt.pn * tstepB : cB;
        for (int t = 0; t < nt; t += 2) {
            const bool last = (t == nt - 2);
            const char* a1 = cA + (size_t)(t + 1) * kstep;
            const char* a2 = last ? nA : cA + (size_t)(t + 2) * kstep; const char* b2 = last ? nB : cB + (size_t)(t + 2) * kstep;
            const char* a3 = a2 + kstep; const char* b3 = b2 + kstep;
            if (last) E.pre(cur, wid, lane);
            if constexpr (SP2) {
            PG8_LDB(B0, 0, 0); PG8_LDB(B1, 0, 1); PG8_SCHED; PG8_LDA(At, 0, 0); PG8_STAGE(PG8_SA(1, 1), a1 + hstep, voffA);
            PG8_WAIT_V(8); PG8_WAIT_L(0); PG8_BAR; PG8_MMA(0, 0, At, B0); PG8_MMA(0, 1, At, B1); PG8_BAR; PG8_SCHED;
            PG8_LDA(At, 0, 1); PG8_STAGE(PG8_SB(0, 0), b2, voffB); PG8_STAGE(PG8_SB(0, 1), b2 + hstep, voffB); PG8_STAGE(PG8_SA(0, 0), a2, voffA);
            PG8_WAIT_V(8); PG8_WAIT_L(0); PG8_BAR; PG8_MMA(1, 0, At, B0); PG8_MMA(1, 1, At, B1); PG8_BAR; PG8_SCHED;
            PG8_LDB(B0, 1, 0); PG8_LDB(B1, 1, 1); PG8_SCHED; PG8_LDA(At, 1, 0); PG8_STAGE(PG8_SA(0, 1), a2 + hstep, voffA);
            PG8_WAIT_V(8); PG8_WAIT_L(0); PG8_BAR; PG8_MMA(0, 0, At, B0); PG8_MMA(0, 1, At, B1); PG8_BAR; PG8_SCHED;
            PG8_LDA(At, 1, 1); PG8_STAGE(PG8_SB(1, 0), b3, voffB); PG8_STAGE(PG8_SB(1, 1), b3 + hstep, voffB); PG8_STAGE(PG8_SA(1, 0), a3, voffA);
            PG8_WAIT_V(8); PG8_WAIT_L(0); PG8_BAR; PG8_MMA(1, 0, At, B0); PG8_MMA(1, 1, At, B1); PG8_BAR; PG8_SCHED;
            } else {
            PG8_LDB(B0, 0, 0); PG8_SCHED; PG8_LDA(At, 0, 0); PG8_STAGE(PG8_SA(1, 1), a1 + hstep, voffA);
            PG8_WAIT_L(8); PG8_BAR; PG8_WAIT_L(0); PG8_MMA(0, 0, At, B0); PG8_BAR; PG8_SCHED;
            PG8_LDB(B1, 0, 1); PG8_STAGE(PG8_SB(0, 0), b2, voffB);
            PG8_BAR; PG8_WAIT_L(0); PG8_MMA(0, 1, At, B1); PG8_BAR;
            PG8_LDA(At, 0, 1); PG8_STAGE(PG8_SA(0, 0), a2, voffA);
            PG8_BAR; PG8_WAIT_L(0); PG8_MMA(1, 0, At, B0); PG8_BAR; PG8_SCHED;
            PG8_STAGE(PG8_SB(0, 1), b2 + hstep, voffB);
            PG8_WAIT_V(6); PG8_BAR; PG8_MMA(1, 1, At, B1); PG8_BAR;
            PG8_LDB(B0, 1, 0); PG8_SCHED; PG8_LDA(At, 1, 0); PG8_STAGE(PG8_SA(0, 1), a2 + hstep, voffA);
            PG8_WAIT_L(8); PG8_BAR; PG8_WAIT_L(0); PG8_MMA(0, 0, At, B0); PG8_BAR; PG8_SCHED;
            PG8_LDB(B1, 1, 1); PG8_STAGE(PG8_SB(1, 0), b3, voffB);
            PG8_BAR; PG8_WAIT_L(0); PG8_MMA(0, 1, At, B1); PG8_BAR;
            PG8_LDA(At, 1, 1); PG8_STAGE(PG8_SA(1, 0), a3, voffA);
            PG8_BAR; PG8_WAIT_L(0); PG8_MMA(1, 0, At, B0); PG8_BAR; PG8_SCHED;
            PG8_STAGE(PG8_SB(1, 1), b3 + hstep, voffB);
            PG8_WAIT_V(6); PG8_BAR; PG8_MMA(1, 1, At, B1); PG8_BAR;
            }
        }
        if constexpr (ALIGN_EPI) { if (wr == 0) PG8_BAR; }
        E(acc, cur, wr, wc, fr, fq, lane);
        if (!has_next) break;
#pragma unroll
        for (int a = 0; a < 2; ++a)
#pragma unroll
            for (int b = 0; b < 2; ++b)
#pragma unroll
                for (int m = 0; m < 4; ++m)
#pragma unroll
                    for (int n = 0; n < 2; ++n) acc[a][b][m][n] = (f32x4){0.f, 0.f, 0.f, 0.f};
        cur = nxt; cA = nA; cB = nB; ++ui;
        if constexpr (ALIGN_EPI) { if (wr == 1) PG8_BAR; }
    }
    PG8_WAIT_V(0);
    if constexpr (!ALIGN_EPI) { if (wr == 0) PG8_BAR; }
    PG8_BAR;
#undef PG8_SA
#undef PG8_SB
#undef PG8_STAGE
#undef PG8_LDA
#undef PG8_LDB
#undef PG8_MMA
#undef PG8_WAIT_V
#undef PG8_WAIT_L
#undef PG8_BAR
#undef PG8_SCHED
}
}

namespace att {
constexpr int PITCH = DIN;
#define SBAR() __builtin_amdgcn_sched_barrier(0)
#define KSW(row, colB) ((row) * 128 + ((colB) ^ ((((row) >> 1) & 7) << 4)))
__device__ __forceinline__ int crow(int r, int hi) { return (r & 3) + 8 * (r >> 2) + 4 * hi; }
__device__ __forceinline__ int rel_bucket(int rel) {
    const int n = rel < 0 ? -rel : rel; int v;
    if (n < 8) v = n; else { v = 2 + (31 - __clz(n * n)); v = v > 15 ? 15 : v; }
    return (rel > 0 ? 16 : 0) + v;
}
constexpr float THR = 5.0f;

__device__ __forceinline__ void partialSM(f32x16& p0, f32x16& p1, float off, float& m_reg, float& alpha) {
    float pmax = p0[0];
#pragma unroll
    for (int r = 1; r < 16; ++r) pmax = fmaxf(pmax, p0[r]);
#pragma unroll
    for (int r = 0; r < 16; ++r) pmax = fmaxf(pmax, p1[r]);
    { auto rr = __builtin_amdgcn_permlane32_swap(__float_as_uint(pmax), __float_as_uint(pmax), false, false);
      pmax = fmaxf(__uint_as_float(rr[0]), __uint_as_float(rr[1])); }
    pmax += off;
    if (__builtin_expect(__all(pmax - m_reg <= THR), 1)) { alpha = 1.f; }
    else { const float mn = fmaxf(m_reg, pmax); alpha = __builtin_amdgcn_exp2f(m_reg - mn); m_reg = mn; }
    const float sub = off - m_reg;
#pragma unroll
    for (int r = 0; r < 16; ++r) { p0[r] += sub; p1[r] += sub; }
#pragma unroll
    for (int r = 0; r < 16; ++r) p0[r] = __builtin_amdgcn_exp2f(p0[r]);
}
__device__ __forceinline__ void finishSM(f32x16& p0, f32x16& p1, float alpha, float& l_reg, bf16x8& pa0, bf16x8& pa1, bf16x8& pa2, bf16x8& pa3) {
#pragma unroll
    for (int r = 0; r < 16; ++r) p1[r] = __builtin_amdgcn_exp2f(p1[r]);
    float ps = 0;
#pragma unroll
    for (int r = 0; r < 16; ++r) ps += p0[r];
#pragma unroll
    for (int r = 0; r < 16; ++r) ps += p1[r];
    { auto rr = __builtin_amdgcn_permlane32_swap(__float_as_uint(ps), __float_as_uint(ps), false, false);
      ps = __uint_as_float(rr[0]) + __uint_as_float(rr[1]); }
    l_reg = l_reg * alpha + ps;
#define PK4(P, BASE, OUT) do { unsigned a0 = cvtpk(P[BASE + 0], P[BASE + 1]), a1 = cvtpk(P[BASE + 2], P[BASE + 3]);   \
    unsigned b0 = cvtpk(P[BASE + 4], P[BASE + 5]), b1 = cvtpk(P[BASE + 6], P[BASE + 7]);                              \
    auto r0 = __builtin_amdgcn_permlane32_swap(a0, b0, false, false); auto r1 = __builtin_amdgcn_permlane32_swap(a1, b1, false, false); \
    u32x4 w = {r0[0], r1[0], r0[1], r1[1]}; OUT = __builtin_bit_cast(bf16x8, w); } while (0)
    PK4(p0, 0, pa0); PK4(p0, 8, pa1); PK4(p1, 0, pa2); PK4(p1, 8, pa3);
#undef PK4
}
__device__ __forceinline__ void qkt64(f32x16& p0, f32x16& p1, const LAS char* Ks, const bf16x8* qr, int r32, int hi) {
#pragma unroll
    for (int d0 = 0; d0 < 4; ++d0) { const int cb = (d0 * 16 + hi * 8) * 2;
        const bf16x8 b0 = *(const LAS bf16x8*)(Ks + KSW(r32, cb));
        const bf16x8 b1 = *(const LAS bf16x8*)(Ks + KSW(r32, cb) + 4096);
        p0 = __builtin_amdgcn_mfma_f32_32x32x16_bf16(b0, qr[d0], p0, 0, 0, 0); p1 = __builtin_amdgcn_mfma_f32_32x32x16_bf16(b1, qr[d0], p1, 0, 0, 0); }
}
template <int NCB> __device__ __forceinline__ int v_st(int k, int c) { const int kk = (k & ~0xC) | ((k & 4) << 1) | ((k & 8) >> 1); return ((kk >> 3) * NCB + (c >> 5)) * 512 + ((kk & 7) * 32 + (c & 31)) * 2; }
__device__ __forceinline__ int v_rd_base(int lane) { return ((lane & 3) << 3) | (((lane >> 2) & 3) << 6) | (((lane >> 4) & 1) << 5) | (((lane >> 5) & 1) << 8); }
template <int NCB> constexpr int v_rd_off(int d0, int ks, int half) { return d0 * 512 + ks * (NCB * 1024) + half * (NCB * 512); }
template <int OFF> __device__ __forceinline__ s16x4 tr_read(int vb) { s16x4 r; asm volatile("ds_read_b64_tr_b16 %0, %1 offset:%2" : "=&v"(r) : "v"(vb), "i"(OFF) : "memory"); return r; }
template <int NCB, int D0> __device__ __forceinline__ void pv_one(f32x16& od, int vb, bf16x8 pa0, bf16x8 pa1, bf16x8 pa2, bf16x8 pa3) {
    const s16x4 l0 = tr_read<v_rd_off<NCB>(D0, 0, 0)>(vb), h0 = tr_read<v_rd_off<NCB>(D0, 0, 1)>(vb), l1 = tr_read<v_rd_off<NCB>(D0, 1, 0)>(vb), h1 = tr_read<v_rd_off<NCB>(D0, 1, 1)>(vb);
    const s16x4 l2 = tr_read<v_rd_off<NCB>(D0, 2, 0)>(vb), h2 = tr_read<v_rd_off<NCB>(D0, 2, 1)>(vb), l3 = tr_read<v_rd_off<NCB>(D0, 3, 0)>(vb), h3 = tr_read<v_rd_off<NCB>(D0, 3, 1)>(vb);
    asm volatile("s_waitcnt lgkmcnt(0)" ::: "memory"); SBAR();
#define PK(L, H) (bf16x8){L[0], L[1], L[2], L[3], H[0], H[1], H[2], H[3]}
    od = __builtin_amdgcn_mfma_f32_32x32x16_bf16(pa0, PK(l0, h0), od, 0, 0, 0);
    od = __builtin_amdgcn_mfma_f32_32x32x16_bf16(pa1, PK(l1, h1), od, 0, 0, 0);
    od = __builtin_amdgcn_mfma_f32_32x32x16_bf16(pa2, PK(l2, h2), od, 0, 0, 0);
    od = __builtin_amdgcn_mfma_f32_32x32x16_bf16(pa3, PK(l3, h3), od, 0, 0, 0);
#undef PK
}

constexpr int D_V = 0, D_K = 49152, D_WS = 81920, D_TB = 83968, D_ST = 86016, D_END = D_ST + 65536;
constexpr int NT = SEQ / 64;

typedef short v4i16_t __attribute__((ext_vector_type(4)));
__device__ __forceinline__ s16x4 vtr(const LAS char* p) { return __builtin_bit_cast(s16x4, __builtin_amdgcn_ds_read_tr16_b64_v4i16((LAS v4i16_t*)p)); }
#define PIN(x) asm volatile("" : "+v"(x))
#define MX3(a, b, c) __builtin_fmaxf(__builtin_fmaxf((a), (b)), (c))
#define EX(v) __builtin_amdgcn_exp2f(v)
#define MFMA32(a, b, c) __builtin_amdgcn_mfma_f32_32x32x16_bf16((a), (b), (c), 0, 0, 0)
constexpr float THRL = 6.0f, SUMTHR = 1024.0f;
__device__ __forceinline__ float rowmax32(const f32x16& C0, const f32x16& C1) {
    float a = MX3(C0[0], C0[1], C1[0]), b = MX3(C0[2], C0[3], C1[1]); a = MX3(a, C1[2], C1[3]);
#pragma unroll
    for (int r = 4; r < 16; r += 4) { a = MX3(a, C0[r], C0[r + 1]); b = MX3(b, C0[r + 2], C0[r + 3]); a = MX3(a, C1[r], C1[r + 1]); b = MX3(b, C1[r + 2], C1[r + 3]); }
    float rm = __builtin_fmaxf(a, b);
    auto rr = __builtin_amdgcn_permlane32_swap(__float_as_uint(rm), __float_as_uint(rm), false, false);
    return __builtin_fmaxf(__uint_as_float(rr[0]), __uint_as_float(rr[1]));
}
__device__ __forceinline__ void diff_pass(f32x16 (&o)[4], float& l_out, const bf16_t* Qw, const bf16_t* __restrict__ Kh, const bf16_t* __restrict__ Vh,
                                          LAS char* lds, int qa, float cL, float cR) {
    const int tid = threadIdx.x, wid = __builtin_amdgcn_readfirstlane(tid >> 6), lane = tid & 63, r32 = lane & 31, hi = lane >> 5;
    LAS char* V_lds = lds + D_V; LAS char* K_lds = lds + D_K;
    LAS float* wsf = (LAS float*)(lds + D_WS) + wid * 64 + 32;
    const LAS float* tb = (const LAS float*)(lds + D_TB);
#pragma unroll
    for (int d = 0; d < 4; ++d) o[d] = f32x16{};
    bf16x8 qr[4];
#pragma unroll
    for (int d0 = 0; d0 < 4; ++d0) qr[d0] = *(const bf16x8*)(Qw + d0 * 16);
#pragma unroll
    for (int d0 = 0; d0 < 4; ++d0) PIN(qr[d0]);
    const bf16_t* ksrc; const bf16_t* vsrc0;
    { const int row = wid * 8 + (lane >> 3), pos = lane & 7;
      ksrc = Kh + (long)row * PITCH + ((pos ^ ((row >> 1) & 7)) * 8);
      vsrc0 = Vh + (long)row * PITCH + ((pos ^ (((row >> 1) & 1) << 2)) * 8); }
    const LAS char* kq[4];
    { const int sw = (r32 >> 1) & 7;
#pragma unroll
      for (int d0 = 0; d0 < 4; ++d0) kq[d0] = K_lds + r32 * 128 + (((2 * d0 + hi) ^ sw) << 4); }
    const LAS char* vpe; const LAS char* vpo;
    { const int q = (lane & 15) >> 2, p = lane & 3, g = (lane >> 4) & 1, sw = (q >> 1) & 1;
      vpe = V_lds + (4 * hi + q) * 128 + sw * 64 + g * 32 + p * 8; vpo = V_lds + (4 * hi + q) * 128 + (sw ^ 1) * 64 + g * 32 + p * 8; }
#define DMA_K(j, ko) __builtin_amdgcn_global_load_lds((const unsigned*)(ksrc + (long)(j) * 64 * PITCH), (LAS unsigned*)(K_lds + (ko) + wid * 1024), 16, 0, 0)
#define DMA_V(j, vo) do { __builtin_amdgcn_global_load_lds((const unsigned*)(vsrc0 + (long)(j) * 64 * PITCH), (LAS unsigned*)(V_lds + (vo) + wid * 1024), 16, 0, 0); \
    __builtin_amdgcn_global_load_lds((const unsigned*)(vsrc0 + 64 + (long)(j) * 64 * PITCH), (LAS unsigned*)(V_lds + (vo) + 8192 + wid * 1024), 16, 0, 0); } while (0)
#define WAIT_BAR(N) do { asm volatile("s_waitcnt vmcnt(" #N ") lgkmcnt(0)" ::: "memory"); __builtin_amdgcn_s_barrier(); asm volatile("" ::: "memory"); } while (0)
    float mhat, l_reg = 0.f; bool resc = false;
    f32x16 pA0, pA1, pB0, pB1;
    bf16x8 kf[4]; s16x4 vlo[6], vhi[6]; u32x4 pw0, pw1, pw2, pw3;
#define KRD(i, KS) do { kf[(i) & 3] = *(const LAS bf16x8*)(kq[(i) >> 1] + (KS) + ((i) & 1) * 4096); } while (0)
    WAIT_BAR(0);
    DMA_K(0, 0); DMA_K(1, 8192); DMA_V(0, 0); DMA_K(2, 16384); DMA_K(3, 24576); DMA_V(1, 16384);
    WAIT_BAR(7);
    {
        float off0 = 0.f; const int d_ = -qa;
        if (d_ <= -154) { pA0 = f32x16{}; pA1 = f32x16{}; off0 = cL; }
        else { const LAS float* t_ = tb + (d_ + 256 + 4 * hi - r32);
#pragma unroll
            for (int r = 0; r < 16; ++r) { pA0[r] = t_[(r & 3) + 8 * (r >> 2)]; pA1[r] = t_[32 + (r & 3) + 8 * (r >> 2)]; } }
#pragma unroll
        for (int d0 = 0; d0 < 4; ++d0) { const bf16x8 k0_ = *(const LAS bf16x8*)(kq[d0]), k1_ = *(const LAS bf16x8*)(kq[d0] + 4096);
            pA0 = MFMA32(k0_, qr[d0], pA0); pA1 = MFMA32(k1_, qr[d0], pA1); }
        const float rm = rowmax32(pA0, pA1);
        mhat = rm + off0;
#pragma unroll
        for (int r = 0; r < 16; ++r) { pA0[r] = EX(pA0[r] - rm); pA1[r] = EX(pA1[r] - rm); }
    }
    WAIT_BAR(3);
    KRD(0, 8192); KRD(1, 8192); KRD(2, 8192); KRD(3, 8192);
#define PKW(P, B) cvtpk(P[B], P[(B) + 1])
#define PAF(k) __builtin_bit_cast(bf16x8, pw##k)
#define VFR(i) (bf16x8){vlo[(i) % 6][0], vlo[(i) % 6][1], vlo[(i) % 6][2], vlo[(i) % 6][3], vhi[(i) % 6][0], vhi[(i) % 6][1], vhi[(i) % 6][2], vhi[(i) % 6][3]}
#define VRD(i, VS) do { const LAS char* vq_ = ((((i) & 3) & 1) ? vpo : vpe) + (VS) + (((i) & 3) >> 1) * 8192 + ((i) >> 2) * 2048; vlo[(i) % 6] = vtr(vq_); vhi[(i) % 6] = vtr(vq_ + 1024); } while (0)
#define GAPA(g, CC, QI, KB, A0, A1, A2, A3, W0, W1, PW) do { CC = MFMA32(kf[(g) & 3], qr[QI], CC); if ((g) + 4 < 8) KRD((g) + 4, KB); sacc += (f32x2){A0, A1}; sacc += (f32x2){A2, A3}; PIN(sacc); W0; W1; PIN(PW); SBAR(); } while (0)
#define GAPB(i, X, B, VB, KN, PRE) do { o[(i) & 3] = MFMA32(PAF_SEL(i), VFR(i), o[(i) & 3]); X[B] = EX(X[B]); X[(B) + 1] = EX(X[(B) + 1]); PIN(X); if ((i) + 5 < 16) VRD((i) + 5, VB); \
    if ((PRE) && (i) >= 8 && (i) < 12) KRD((i) - 8, KN); SBAR(); } while (0)
#define PAF_SEL(i) (((i) >> 2) == 0 ? PAF(0) : ((i) >> 2) == 1 ? PAF(1) : ((i) >> 2) == 2 ? PAF(2) : PAF(3))
#define STEP(C0, C1, P0, P1, t, KB, VB, KN, PRE) do { SBAR(); \
    { const int d_ = (t) * 64 - qa; \
      if (d_ > -154 && d_ < 122) { const LAS float* t_ = tb + (d_ + 256 + 4 * hi - r32); \
        _Pragma("unroll") for (int r = 0; r < 16; ++r) { C0[r] = t_[(r & 3) + 8 * (r >> 2)] - mhat; C1[r] = t_[32 + (r & 3) + 8 * (r >> 2)] - mhat; } } \
      else { const float cs_ = (d_ < 0 ? cL : cR) - mhat; \
          \
        const unsigned hb_ = cvtpk(cs_, 0.f) & 0xffffu; const float lo_ = cs_ - __uint_as_float(hb_ << 16); \
        u32x4 cbw_ = {hi == 0 ? (hb_ | (cvtpk(lo_, 0.f) << 16)) : 0u, 0u, 0u, 0u}, onw_ = {hi == 0 ? 0x3f803f80u : 0u, 0u, 0u, 0u}; \
        C0 = MFMA32(__builtin_bit_cast(bf16x8, onw_), __builtin_bit_cast(bf16x8, cbw_), f32x16{}); asm volatile("" : "+v"(cbw_));     \
        C1 = MFMA32(__builtin_bit_cast(bf16x8, onw_), __builtin_bit_cast(bf16x8, cbw_), f32x16{}); } } \
    PIN(C0); PIN(C1); SBAR(); \
    f32x2 sacc = {P0[0], P0[1]};     \
    GAPA(0, C0, 0, KB, P0[2],  P0[3],  P0[4],  P0[5],  pw0[0] = PKW(P0, 0),  pw0[1] = PKW(P0, 2),  pw0); \
    GAPA(1, C1, 0, KB, P0[6],  P0[7],  P0[8],  P0[9],  pw0[2] = PKW(P0, 4),  pw0[3] = PKW(P0, 6),  pw0); \
    GAPA(2, C0, 1, KB, P0[10], P0[11], P0[12], P0[13], pw1[0] = PKW(P0, 8),  pw1[1] = PKW(P0, 10), pw1); \
    GAPA(3, C1, 1, KB, P0[14], P0[15], P1[0],  P1[1],  pw1[2] = PKW(P0, 12), pw1[3] = PKW(P0, 14), pw1); \
    GAPA(4, C0, 2, KB, P1[2],  P1[3],  P1[4],  P1[5],  pw2[0] = PKW(P1, 0),  pw2[1] = PKW(P1, 2),  pw2); \
    GAPA(5, C1, 2, KB, P1[6],  P1[7],  P1[8],  P1[9],  pw2[2] = PKW(P1, 4),  pw2[3] = PKW(P1, 6),  pw2); \
    GAPA(6, C0, 3, KB, P1[10], P1[11], P1[12], P1[13], pw3[0] = PKW(P1, 8),  pw3[1] = PKW(P1, 10), pw3); \
    GAPA(7, C1, 3, KB, P1[14], P1[15], 0.f,    0.f,    pw3[2] = PKW(P1, 12), pw3[3] = PKW(P1, 14), pw3); \
    const float ts_ = sacc.x + sacc.y; l_reg += ts_; \
    VRD(0, VB); VRD(1, VB); VRD(2, VB); VRD(3, VB); VRD(4, VB); \
    { resc = false;     \
      if (__builtin_expect(__any(ts_ > SUMTHR), 0)) { auto sw_ = __builtin_amdgcn_permlane32_swap(__float_as_uint(ts_), __float_as_uint(ts_), false, false); \
        const float rs_ = __uint_as_float(sw_[0]) + __uint_as_float(sw_[1]); const float dl = rs_ > 1.f ? __builtin_amdgcn_logf(rs_) : 0.f; mhat += dl; \
        _Pragma("unroll") for (int r = 0; r < 16; ++r) { C0[r] -= dl; C1[r] -= dl; } \
        const float f = EX(-dl); l_reg *= f; if (hi == 0) wsf[r32] = f; resc = true; } } \
    SBAR(); \
    GAPB(0, C0, 0, VB, KN, PRE);  GAPB(1, C0, 2, VB, KN, PRE);  GAPB(2, C0, 4, VB, KN, PRE);   GAPB(3, C0, 6, VB, KN, PRE); \
    GAPB(4, C0, 8, VB, KN, PRE);  GAPB(5, C0, 10, VB, KN, PRE); GAPB(6, C0, 12, VB, KN, PRE);  GAPB(7, C0, 14, VB, KN, PRE); \
    GAPB(8, C1, 0, VB, KN, PRE);  GAPB(9, C1, 2, VB, KN, PRE);  GAPB(10, C1, 4, VB, KN, PRE);  GAPB(11, C1, 6, VB, KN, PRE); \
    GAPB(12, C1, 8, VB, KN, PRE); GAPB(13, C1, 10, VB, KN, PRE); GAPB(14, C1, 12, VB, KN, PRE); GAPB(15, C1, 14, VB, KN, PRE); \
    } while (0)
#define RESC() do { if (resc) { asm volatile("s_waitcnt lgkmcnt(0)" ::: "memory"); \
    _Pragma("unroll") for (int d = 0; d < 4; ++d) _Pragma("unroll") for (int r = 0; r < 16; ++r) o[d][r] *= wsf[crow(r, hi)]; } } while (0)
    int ks_cur = 8192, ks_n1 = 16384, ks_n3 = 0;
    int vs_prev = 0, vs_next = 32768;
#define ROT() do { ks_cur = (ks_cur + 8192) & 24576; ks_n1 = (ks_n1 + 8192) & 24576; ks_n3 = (ks_n3 + 8192) & 24576; vs_prev = vs_prev == 32768 ? 0 : vs_prev + 16384; vs_next = vs_next == 32768 ? 0 : vs_next + 16384; } while (0)
#define STEPX(C0, C1, P0, P1, t, PRE) STEP(C0, C1, P0, P1, t, ks_cur, vs_prev, ks_n1, PRE)
#pragma unroll 1
    for (int t = 1; t + 4 < NT; t += 2) {
        DMA_K(t + 3, ks_n3); DMA_V(t + 1, vs_next);
        STEPX(pB0, pB1, pA0, pA1, t, true);
        WAIT_BAR(3); RESC(); ROT();
        DMA_K(t + 4, ks_n3); DMA_V(t + 2, vs_next);
        STEPX(pA0, pA1, pB0, pB1, t + 1, true);
        WAIT_BAR(3); RESC(); ROT();
    }
    DMA_V(NT - 2, vs_next);
    STEPX(pB0, pB1, pA0, pA1, NT - 3, true);
    WAIT_BAR(2); RESC(); ROT();
    DMA_V(NT - 1, vs_next);
    STEPX(pA0, pA1, pB0, pB1, NT - 2, true);
    WAIT_BAR(2); RESC(); ROT();
    STEPX(pB0, pB1, pA0, pA1, NT - 1, false);
    WAIT_BAR(0); RESC(); ROT();
    { float sacc = 0.f;
#pragma unroll
      for (int r = 0; r < 16; ++r) sacc += pB0[r];
#pragma unroll
      for (int r = 0; r < 16; ++r) sacc += pB1[r];
      l_reg += sacc;
      pw0 = (u32x4){PKW(pB0, 0), PKW(pB0, 2), PKW(pB0, 4), PKW(pB0, 6)}; pw1 = (u32x4){PKW(pB0, 8), PKW(pB0, 10), PKW(pB0, 12), PKW(pB0, 14)};
      pw2 = (u32x4){PKW(pB1, 0), PKW(pB1, 2), PKW(pB1, 4), PKW(pB1, 6)}; pw3 = (u32x4){PKW(pB1, 8), PKW(pB1, 10), PKW(pB1, 12), PKW(pB1, 14)};
      SBAR();
#define DRAIN(i) do { VRD(i, vs_prev); o[(i) & 3] = MFMA32(PAF_SEL(i), VFR(i), o[(i) & 3]); } while (0)
      DRAIN(0); DRAIN(1); DRAIN(2); DRAIN(3); DRAIN(4); DRAIN(5); DRAIN(6); DRAIN(7); DRAIN(8); DRAIN(9); DRAIN(10); DRAIN(11); DRAIN(12); DRAIN(13); DRAIN(14); DRAIN(15);
#undef DRAIN
    }
    { auto rr = __builtin_amdgcn_permlane32_swap(__float_as_uint(l_reg), __float_as_uint(l_reg), false, false); l_out = __uint_as_float(rr[0]) + __uint_as_float(rr[1]); }
#undef DMA_K
#undef DMA_V
#undef WAIT_BAR
#undef ROT
#undef KRD
#undef PKW
#undef PAF
#undef VFR
#undef VRD
#undef GAPA
#undef GAPB
#undef PAF_SEL
#undef STEP
#undef STEPX
#undef RESC
}

__device__ __forceinline__ void diff_unit(int b, int h, int qb, const bf16_t* P, bf16_t* O, LAS char* lds, float lam, const float* relb) {
    const int tid = threadIdx.x, wid = __builtin_amdgcn_readfirstlane(tid >> 6), lane = tid & 63, r32 = lane & 31, hi = lane >> 5;
    const long rowbase = (long)b * SEQ; const int q0 = qb * 256, qa = q0 + wid * 32;
    LAS float* tb = (LAS float*)(lds + D_TB);
    LAS float* li_l = (LAS float*)(lds + D_WS) + wid * 64;
    tb[tid] = relb[rel_bucket(tid - 256) * NBH + h] * LOG2E;
    const float cL = relb[15 * NBH + h] * LOG2E, cR = relb[31 * NBH + h] * LOG2E;
    const bf16_t* Qrow = P + (rowbase + qa + r32) * PITCH + C_DQ + h * 128 + hi * 8;
    const bf16_t* Kh = P + rowbase * PITCH + C_DK + h * 128;
    const bf16_t* Vh = P + rowbase * PITCH + C_DV + h * 128;
    LAS u32x4* stash = (LAS u32x4*)(lds + D_ST + wid * 8192);
    f32x16 o[4]; float l_reg;
#pragma unroll 1
    for (int pass = 0; pass < 2; ++pass) {
        const int mo = pass == 0 ? 64 : 0;
        diff_pass(o, l_reg, Qrow + mo, Kh + mo, Vh, lds, qa, cL, cR);
        int ln = lane; asm volatile("" : "+v"(ln));
        const int r32e = ln & 31, hie = ln >> 5;
        if (hie == 0) li_l[r32e] = l_reg; asm volatile("s_waitcnt lgkmcnt(0)" ::: "memory");
        if (pass == 0) {
            float rli[16];
#pragma unroll
            for (int r = 0; r < 16; ++r) rli[r] = -lam * __builtin_amdgcn_rcpf(li_l[crow(r, hie)]);
#pragma unroll
            for (int d0 = 0; d0 < 4; ++d0) {
                u32x4 w0, w1;
                w0.x = cvtpk(o[d0][0] * rli[0], o[d0][1] * rli[1]); w0.y = cvtpk(o[d0][2] * rli[2], o[d0][3] * rli[3]); w0.z = cvtpk(o[d0][4] * rli[4], o[d0][5] * rli[5]); w0.w = cvtpk(o[d0][6] * rli[6], o[d0][7] * rli[7]);
                w1.x = cvtpk(o[d0][8] * rli[8], o[d0][9] * rli[9]); w1.y = cvtpk(o[d0][10] * rli[10], o[d0][11] * rli[11]); w1.z = cvtpk(o[d0][12] * rli[12], o[d0][13] * rli[13]); w1.w = cvtpk(o[d0][14] * rli[14], o[d0][15] * rli[15]);
                stash[(2 * d0) * 64 + ln] = w0; stash[(2 * d0 + 1) * 64 + ln] = w1;
            }
        } else {
            float rli[16], ssq[16];
#pragma unroll
            for (int r = 0; r < 16; ++r) { rli[r] = __builtin_amdgcn_rcpf(li_l[crow(r, hie)]); ssq[r] = 0.f; }
#pragma unroll
            for (int d0 = 0; d0 < 4; ++d0) {
                const u32x4 w0 = stash[(2 * d0) * 64 + ln], w1 = stash[(2 * d0 + 1) * 64 + ln];
                const unsigned ww[8] = {w0.x, w0.y, w0.z, w0.w, w1.x, w1.y, w1.z, w1.w};
#pragma unroll
                for (int r = 0; r < 16; ++r) { const float c = __uint_as_float((r & 1) ? (ww[r >> 1] & 0xffff0000u) : (ww[r >> 1] << 16));
                    const float x = fmaf(o[d0][r], rli[r], c); o[d0][r] = x; ssq[r] = fmaf(x, x, ssq[r]); }
            }
            asm volatile("s_waitcnt lgkmcnt(0)" ::: "memory");
#pragma unroll
            for (int r = 0; r < 16; ++r) { float s = ssq[r];
                s += __shfl_xor(s, 1); s += __shfl_xor(s, 2); s += __shfl_xor(s, 4); s += __shfl_xor(s, 8); s += __shfl_xor(s, 16);
                ssq[r] = __builtin_amdgcn_rsqf(s * (1.0f / 128.0f) + EPS); }
            LAS bf16_t* stg = (LAS bf16_t*)(lds + D_ST + wid * 8192);
#pragma unroll
            for (int r = 0; r < 16; ++r) { const int orow = crow(r, hie);
#pragma unroll
                for (int d0 = 0; d0 < 4; ++d0) stg[orow * 128 + d0 * 32 + r32e] = (bf16_t)(cvtpk(o[d0][r] * ssq[r], 0.f) & 0xffffu); }
            asm volatile("s_waitcnt lgkmcnt(0)" ::: "memory");
            bf16_t* Ow = O + (rowbase + qa + (ln >> 4)) * DM + h * 128 + (ln & 15) * 8;
            const LAS bf16_t* sl = stg + (ln >> 4) * 128 + (ln & 15) * 8;
#pragma unroll
            for (int i = 0; i < 8; ++i) { const u32x4 v = *(const LAS u32x4*)(sl + i * 512); *(u32x4*)(Ow + (long)i * 4 * DM) = v; }
        }
    }
    asm volatile("s_waitcnt lgkmcnt(0)" ::: "memory"); __syncthreads();
}

constexpr int W_K = 0, W_V = 49152, W_TB = 98304, W_WS = 106496, W_OST = 108544, W_END = W_OST + 32768;
__device__ __forceinline__ void win_unit(int b, int kvh, int qb, const bf16_t* P, bf16_t* O, LAS char* lds, const float* relb, const float* sink) {
    const int tid = threadIdx.x, wid = __builtin_amdgcn_readfirstlane(tid >> 6), lane = tid & 63, r32 = lane & 31, hi = lane >> 5;
    const long rowbase = (long)b * SEQ; const int q0 = qb * 128, kbase = q0 - 128;
    LAS float* tbw = (LAS float*)(lds + W_TB);
#pragma unroll
    for (int e = 0; e < 4; ++e) { const int idx = tid + e * 512, g = idx >> 9, rel = (idx & 511) - 256;
        tbw[idx] = (rel >= -128 && rel <= 128) ? (relb[rel_bucket(rel) * NBH + 4 + 4 * kvh + g] - sink[4 * kvh + g]) * LOG2E : -1e30f; }
    { int tl = tid; asm volatile("" : "+v"(tl));
      const int kr = tl >> 3, kc = (tl & 7) * 8, kst = KSW(kr, kc * 2), vst = v_st<2>(kr, kc);
      const bf16_t* Kh = P + rowbase * PITCH + C_WK + kvh * 64; const bf16_t* Vh = P + rowbase * PITCH + C_WV + kvh * 64;
      bf16x8 kreg[6], vreg[6];
#pragma unroll
      for (int t = 0; t < 6; ++t) { const int k0 = kbase + 64 * t; if (k0 >= 0 && k0 < SEQ) { kreg[t] = *(const bf16x8*)(&Kh[(long)(k0 + kr) * PITCH + kc]); vreg[t] = *(const bf16x8*)(&Vh[(long)(k0 + kr) * PITCH + kc]); } }
#pragma unroll
      for (int t = 0; t < 6; ++t) { const int k0 = kbase + 64 * t; if (k0 >= 0 && k0 < SEQ) { *(LAS bf16x8*)(lds + W_K + t * 8192 + kst) = kreg[t]; *(LAS bf16x8*)(lds + W_V + t * 8192 + vst) = vreg[t]; } }
    }
    __syncthreads();
    const int g = wid >> 1, hq = 4 * kvh + g;
    LAS float* li_l = (LAS float*)(lds + W_WS) + wid * 64;
    const LAS float* tbg = tbw + g * 512;
    const int vbw = (int)(uintptr_t)(lds + W_V) + v_rd_base(lane);
#pragma unroll 1
    for (int jb = 0; jb < 2; ++jb) {
        const int ql = 64 * (wid & 1) + 32 * jb;
        const bf16_t* Qw = P + (rowbase + q0 + ql + r32) * PITCH + C_WQ + hq * 64 + hi * 8;
        bf16x8 qr[4];
#pragma unroll
        for (int d0 = 0; d0 < 4; ++d0) qr[d0] = *(const bf16x8*)(Qw + d0 * 16);
        float l_reg = 0.f;
        f32x16 o[2]; o[0] = f32x16{}; o[1] = f32x16{};
        const int t_lo = ql >> 6;
#pragma unroll 1
        for (int t = t_lo; t < t_lo + 5; ++t) {
            const int k0 = kbase + 64 * t; if (k0 < 0 || k0 >= SEQ) continue;
            const int d_ = 64 * t - 128 - ql;
            const LAS float* t_ = tbg + (d_ + 256 + 4 * hi - r32);
            f32x16 p0, p1;
#pragma unroll
            for (int r = 0; r < 16; ++r) { p0[r] = t_[(r & 3) + 8 * (r >> 2)]; p1[r] = t_[32 + (r & 3) + 8 * (r >> 2)]; }
            qkt64(p0, p1, lds + W_K + t * 8192, qr, r32, hi);
#pragma unroll
            for (int r = 0; r < 16; ++r) { p0[r] = __builtin_amdgcn_exp2f(p0[r]); p1[r] = __builtin_amdgcn_exp2f(p1[r]); }
            bf16x8 pa0, pa1, pa2, pa3;
            {
                float ps = 0;
#pragma unroll
                for (int r = 0; r < 16; ++r) ps += p0[r];
#pragma unroll
                for (int r = 0; r < 16; ++r) ps += p1[r];
                l_reg += ps;
#define PK4(Pv, BASE, OUT) do { unsigned a0 = cvtpk(Pv[BASE + 0], Pv[BASE + 1]), a1 = cvtpk(Pv[BASE + 2], Pv[BASE + 3]);   \
    unsigned b0 = cvtpk(Pv[BASE + 4], Pv[BASE + 5]), b1 = cvtpk(Pv[BASE + 6], Pv[BASE + 7]);                              \
    auto r0 = __builtin_amdgcn_permlane32_swap(a0, b0, false, false); auto r1 = __builtin_amdgcn_permlane32_swap(a1, b1, false, false); \
    u32x4 w = {r0[0], r1[0], r0[1], r1[1]}; OUT = __builtin_bit_cast(bf16x8, w); } while (0)
                PK4(p0, 0, pa0); PK4(p0, 8, pa1); PK4(p1, 0, pa2); PK4(p1, 8, pa3);
#undef PK4
            }
            const int vb = vbw + t * 8192;
            pv_one<2, 0>(o[0], vb, pa0, pa1, pa2, pa3); pv_one<2, 1>(o[1], vb, pa0, pa1, pa2, pa3);
        }
        { auto rr = __builtin_amdgcn_permlane32_swap(__float_as_uint(l_reg), __float_as_uint(l_reg), false, false); l_reg = 1.0f + __uint_as_float(rr[0]) + __uint_as_float(rr[1]); }
        int ln = lane; asm volatile("" : "+v"(ln));
        const int r32e = ln & 31, hie = ln >> 5;
        if (hie == 0) li_l[r32e] = l_reg; asm volatile("s_waitcnt lgkmcnt(0)" ::: "memory");
        float rli[16];
#pragma unroll
        for (int r = 0; r < 16; ++r) rli[r] = __builtin_amdgcn_rcpf(li_l[crow(r, hie)]);
        LAS bf16_t* stg = (LAS bf16_t*)(lds + W_OST + wid * 4096);
#pragma unroll
        for (int r = 0; r < 16; ++r) { const int orow = crow(r, hie);
#pragma unroll
            for (int d0 = 0; d0 < 2; ++d0) stg[orow * 64 + d0 * 32 + r32e] = (bf16_t)(cvtpk(o[d0][r] * rli[r], 0.f) & 0xffffu); }
        asm volatile("s_waitcnt lgkmcnt(0)" ::: "memory");
        bf16_t* Ow = O + (rowbase + q0 + ql + (ln >> 3)) * DM + 512 + hq * 64 + (ln & 7) * 8;
        const LAS bf16_t* sl = stg + (ln >> 3) * 64 + (ln & 7) * 8;
#pragma unroll
        for (int i = 0; i < 4; ++i) { const u32x4 v = *(const LAS u32x4*)(sl + i * 512); *(u32x4*)(Ow + (long)i * 8 * DM) = v; }
        asm volatile("s_waitcnt lgkmcnt(0)" ::: "memory");
    }
    asm volatile("s_waitcnt lgkmcnt(0)" ::: "memory"); __syncthreads();
}
#undef SBAR
#undef KSW
}

constexpr size_t MiB = 1u << 20;
constexpr size_t WS_CTL = 24 * MiB + 1536 * 1024, CTL_ZERO_BYTES = 64 * 1024;
constexpr size_t WS_W1 = 1 * MiB;
constexpr size_t WS_W2 = WS_W1 + (size_t)DIN * DM * 2;
constexpr size_t WS_W3 = WS_W2 + (size_t)DM * DM * 2;
constexpr size_t WS_W4 = WS_W3 + (size_t)2 * DFF * DM * 2;
constexpr size_t WS_XS = 24 * MiB;
constexpr int CW_WMAX4 = 5120;
constexpr int CW_GBAR = 6400;
constexpr int CW_P3CNT = 4480;
constexpr size_t WS_FA = 26 * MiB;
constexpr size_t WS_FX = 26 * MiB + 512 * 1024;
constexpr int CW_WMAX1 = 13824, CW_W1CNT = 16200;
constexpr int CW_WMAX = 8192;
constexpr size_t WS_X0S = 27 * MiB;
constexpr size_t WS_PROJ = 28 * MiB;
constexpr size_t WS_OB = 244 * MiB;
constexpr size_t WS_XQ = 340 * MiB;
constexpr size_t WS_X1Q = 340 * MiB;
constexpr size_t WS_X1B = 388 * MiB;
constexpr size_t WS_ACT = 28 * MiB;
constexpr size_t WS_END = WS_X1B + (size_t)NTOK * DM * 2;
static_assert(WS_W4 + (size_t)DM * DFF * 2 <= WS_XS && WS_XS + (size_t)NTOK * 32 <= WS_FA && WS_FA + (size_t)NTOK * 4 <= WS_FX && WS_FX + (size_t)NTOK * 4 <= WS_X0S && WS_X0S + (size_t)NTOK * 4 <= WS_PROJ, "d_ws map");
static_assert(WS_PROJ + (size_t)NTOK * DIN * 2 <= WS_OB && WS_OB + (size_t)NTOK * DM * 2 <= WS_XQ && WS_XQ + (size_t)NTOK * DM <= WS_X1B && WS_ACT + (size_t)NTOK * DFF * 2 <= WS_X1Q - 4096, "d_ws map");
static_assert(CW_WMAX + 2 * DFF <= CW_WMAX1 && CW_WMAX1 + DIN <= CW_W1CNT && CW_W1CNT * 4 < CTL_ZERO_BYTES && 1024 + 3456 <= CW_P3CNT && CW_P3CNT + 192 <= CW_WMAX4 && CW_WMAX4 + DM <= CW_GBAR && CW_GBAR + 8 * 128 <= CW_WMAX, "d_ws map");
constexpr int CW_BAR = 1024, XCD_BAR_WORDS_C = 3456;

constexpr int RING_BYTES = 131072, EPX_OFF = RING_BYTES, LDS_BYTES = 163840, MISC_OFF = LDS_BYTES - 512;
static_assert(att::D_END <= MISC_OFF && att::W_END <= MISC_OFF && EPX_OFF + 22528 <= MISC_OFF, "LDS map");

typedef GAS unsigned gu32;
#define RLX_AGENT __ATOMIC_RELAXED, __HIP_MEMORY_SCOPE_AGENT
#define LDS_WAIT() asm volatile("s_waitcnt lgkmcnt(0)" ::: "memory")

#define XB_TMO      128
#define XB_XCNT(j)  (256  + 64 * (j))
#define XB_XSUB(j)  (1280 + 64 * (j))
#define XB_XGEN(j)  (2304 + 64 * (j))
#define XB_TOP      3328
#define XB_TOPGEN   3392
#define XCD_BAR_WORDS 3456
#define XB_SPIN_CAP (1u << 22)
__device__ __forceinline__ unsigned xb_ld(unsigned* p)              { return __hip_atomic_load(p, __ATOMIC_RELAXED, __HIP_MEMORY_SCOPE_AGENT); }
__device__ __forceinline__ unsigned xb_add(unsigned* p, unsigned v) { return __hip_atomic_fetch_add(p, v, __ATOMIC_RELAXED, __HIP_MEMORY_SCOPE_AGENT); }
__device__ __forceinline__ unsigned xb_xcc_id() { return (unsigned)__builtin_amdgcn_s_getreg((3 << 11) | 20) & 0xFu; }
#define XB_SPIN(cond, bar) do { unsigned _sp = 0; while (cond) { __builtin_amdgcn_s_sleep(1); \
    if ((++_sp & 255u) == 0u) { if (xb_ld(&(bar)[XB_TMO])) break; if (_sp > XB_SPIN_CAP) { atomicAdd(&(bar)[XB_TMO], 1u); break; } } } } while (0)
struct XcdBarrier { unsigned* bar; unsigned x; volatile LAS unsigned* st; };
__device__ __forceinline__ XcdBarrier xcd_barrier_post(unsigned* bar, volatile LAS unsigned* st) {
    XcdBarrier b; b.bar = bar; b.x = xb_xcc_id(); b.st = st;
    if (threadIdx.x == 0) (void)xb_add(&bar[XB_XCNT(b.x)], 1u);
    return b;
}
__device__ __forceinline__ void xcd_barrier_complete(unsigned* bar, unsigned x, unsigned& nloc, unsigned& nx) {
    const unsigned G = gridDim.x * gridDim.y * gridDim.z;
    unsigned sum, cnt, mine, sp = 0u;
    for (;;) {
        sum = 0u; cnt = 0u; mine = 0u;
#pragma unroll
        for (unsigned j = 0; j < 16; ++j) { const unsigned c = xb_ld(&bar[XB_XCNT(j)]); sum += c; cnt += (c > 0u) ? 1u : 0u; mine = (j == x) ? c : mine; }
        if (sum == G) break;
        __builtin_amdgcn_s_sleep(1);
        if ((++sp & 255u) == 0u) { if (xb_ld(&bar[XB_TMO])) break; if (sp > XB_SPIN_CAP) { atomicAdd(&bar[XB_TMO], 1u); break; } }
    }
    nloc = mine > 0u ? mine : 1u; nx = cnt > 0u ? cnt : 1u;
}
__device__ __forceinline__ void xcd_barrier(const XcdBarrier& b) {
    asm volatile("s_waitcnt vmcnt(0)" ::: "memory");
    __syncthreads();
    if (threadIdx.x == 0) {
        unsigned* bar = b.bar;
        __builtin_amdgcn_s_waitcnt(0);
        unsigned nloc = b.st[0], nx = b.st[1];
        if (nloc == 0u) { xcd_barrier_complete(bar, b.x, nloc, nx); b.st[0] = nloc; b.st[1] = nx; }
        const unsigned old = xb_add(&bar[XB_XSUB(b.x)], 1u);
        const unsigned gen = old / nloc;
        if (old + 1u == (gen + 1u) * nloc) {
            __builtin_amdgcn_fence(__ATOMIC_RELEASE, "agent");
            asm volatile("s_waitcnt vmcnt(0)" ::: "memory");
            const unsigned og = xb_add(&bar[XB_TOP], 1u);
            const unsigned tg = og / nx;
            if (og + 1u == (tg + 1u) * nx) xb_add(&bar[XB_TOPGEN], 1u);
            else XB_SPIN(xb_ld(&bar[XB_TOPGEN]) == tg, bar);
            __builtin_amdgcn_fence(__ATOMIC_ACQUIRE, "agent");
            xb_add(&bar[XB_XGEN(b.x)], 1u);
            asm volatile("s_waitcnt vmcnt(0)" ::: "memory");
        } else {
            XB_SPIN(xb_ld(&bar[XB_XGEN(b.x)]) == gen, bar);
            __builtin_amdgcn_fence(__ATOMIC_ACQUIRE, "agent");
            asm volatile("s_waitcnt vmcnt(0)" ::: "memory");
        }
    }
    __syncthreads();
}

__device__ __forceinline__ void group_barrier(unsigned* gb, unsigned nmem, volatile LAS unsigned* ep) {
    asm volatile("s_waitcnt vmcnt(0)" ::: "memory");
    __syncthreads();
    if (threadIdx.x == 0) {
        __builtin_amdgcn_fence(__ATOMIC_RELEASE, "agent");
        asm volatile("s_waitcnt vmcnt(0)" ::: "memory");
        const unsigned e = ep[0]; ep[0] = e + 1u;
        const unsigned old = xb_add(&gb[0], 1u);
        if (old + 1u == (e + 1u) * nmem) xb_add(&gb[64], 1u);
        else { unsigned sp = 0; while (xb_ld(&gb[64]) == e) { __builtin_amdgcn_s_sleep(1); if (++sp > XB_SPIN_CAP) break; } }
        __builtin_amdgcn_fence(__ATOMIC_ACQUIRE, "agent");
        asm volatile("s_waitcnt vmcnt(0)" ::: "memory");
    }
    __syncthreads();
}

__device__ __forceinline__ float wave_sum(float v) {
#pragma unroll
    for (int o = 1; o < 64; o <<= 1) v += __shfl_xor(v, o);
    return v;
}
__device__ __forceinline__ unsigned f2bf(float f) { unsigned u = __builtin_bit_cast(unsigned, f); return (u + 0x7fffu + ((u >> 16) & 1u)) >> 16; }
__device__ __forceinline__ unsigned pk2(float lo, float hi) { return f2bf(lo) | (f2bf(hi) << 16); }
template <bool S16 = false>
__device__ __forceinline__ void transpose_item(const float* W, int ld, int cbase, int K, int k0, bf16_t* WT, int nrow0, const float* fold, int foldmask, float fscale, int foldlim, LAS float* scr, int lane) {
    float wv[32];
    const int cl = S16 ? 16 * ((lane & 31) >> 3) + (lane & 7) : (lane & 31);
#pragma unroll
    for (int i = 0; i < 32; ++i) wv[i] = W[(size_t)(k0 + 2 * i + (lane >> 5)) * ld + cbase + cl];
#pragma unroll
    for (int i = 0; i < 32; ++i) { const int kk = 2 * i + (lane >> 5), k = k0 + kk;
        float f = 1.f; if (fold != nullptr && k < foldlim) f = fold[k & foldmask] * fscale;
        scr[kk * 33 + (lane & 31)] = wv[i] * f; }
    LDS_WAIT(); asm volatile("" ::: "memory");
    const int c = lane & 7;
#pragma unroll
    for (int j = 0; j < 4; ++j) { const int n = (lane >> 3) + 8 * j; const LAS float* s = scr + (8 * c) * 33 + n;
        u32x4 o; o.x = pk2(s[0 * 33], s[1 * 33]); o.y = pk2(s[2 * 33], s[3 * 33]); o.z = pk2(s[4 * 33], s[5 * 33]); o.w = pk2(s[6 * 33], s[7 * 33]);
        *(u32x4*)(WT + (size_t)(nrow0 + n) * K + k0 + 8 * c) = o; }
    LDS_WAIT(); asm volatile("" ::: "memory");
}

__device__ __forceinline__ void absmax_item(const float* W, int ld, int cbase, int k0, unsigned* wmax, const float* fold, int lane) {
    float wv[32];
#pragma unroll
    for (int i = 0; i < 32; ++i) wv[i] = W[(size_t)(k0 + 2 * i + (lane >> 5)) * ld + cbase + (lane & 31)];
    float m = 0.f;
#pragma unroll
    for (int i = 0; i < 32; ++i) m = __builtin_fmaxf(m, __builtin_fabsf(wv[i] * (fold ? fold[k0 + 2 * i + (lane >> 5)] : 1.f)));
    m = __builtin_fmaxf(m, __shfl_xor(m, 32));
    if (lane < 32) (void)__hip_atomic_fetch_max(wmax + lane, __float_as_uint(m), __ATOMIC_RELAXED, __HIP_MEMORY_SCOPE_AGENT);
}
__device__ __forceinline__ void quant_item(const float* W, int ld, int cbase, int K, int k0, signed char* WQ, int nrow0, const float* fold, const unsigned* wmax, LAS float* scr, int lane) {
    float wv[32];
#pragma unroll
    for (int i = 0; i < 32; ++i) wv[i] = W[(size_t)(k0 + 2 * i + (lane >> 5)) * ld + cbase + (lane & 31)];
    const float am = __uint_as_float(__hip_atomic_load(wmax + (lane & 31), __ATOMIC_RELAXED, __HIP_MEMORY_SCOPE_AGENT)); const float inv = am > 0.f ? 127.0f / am : 0.f;
#pragma unroll
    for (int i = 0; i < 32; ++i) { const int kk = 2 * i + (lane >> 5); scr[kk * 33 + (lane & 31)] = wv[i] * fold[k0 + kk] * inv; }
    LDS_WAIT(); asm volatile("" ::: "memory");
    const int n = lane >> 1, c = lane & 1; const LAS float* sp = scr + (32 * c) * 33 + n;
    u32x4 o0, o1;
    o0.x = q4(sp[0 * 33], sp[1 * 33], sp[2 * 33], sp[3 * 33]);     o0.y = q4(sp[4 * 33], sp[5 * 33], sp[6 * 33], sp[7 * 33]);
    o0.z = q4(sp[8 * 33], sp[9 * 33], sp[10 * 33], sp[11 * 33]);   o0.w = q4(sp[12 * 33], sp[13 * 33], sp[14 * 33], sp[15 * 33]);
    o1.x = q4(sp[16 * 33], sp[17 * 33], sp[18 * 33], sp[19 * 33]); o1.y = q4(sp[20 * 33], sp[21 * 33], sp[22 * 33], sp[23 * 33]);
    o1.z = q4(sp[24 * 33], sp[25 * 33], sp[26 * 33], sp[27 * 33]); o1.w = q4(sp[28 * 33], sp[29 * 33], sp[30 * 33], sp[31 * 33]);
    u32x4* dst = (u32x4*)(WQ + (size_t)(nrow0 + n) * K + k0 + 32 * c);
    dst[0] = o0; dst[1] = o1;
    LDS_WAIT(); asm volatile("" ::: "memory");
}

__device__ __forceinline__ void quantf8_item(const float* W, int ld, int cbase, int K, int k0, unsigned char* WQ, int nrow0, const unsigned* wmax, LAS float* scr, int lane) {
    float wv[32];
#pragma unroll
    for (int i = 0; i < 32; ++i) wv[i] = W[(size_t)(k0 + 2 * i + (lane >> 5)) * ld + cbase + (lane & 31)];
    const float am = __uint_as_float(__hip_atomic_load(wmax + (lane & 31), __ATOMIC_RELAXED, __HIP_MEMORY_SCOPE_AGENT)); const float inv = am > 0.f ? W8_TOP / am : 0.f;
#pragma unroll
    for (int i = 0; i < 32; ++i) { const int kk = 2 * i + (lane >> 5); scr[kk * 33 + (lane & 31)] = wv[i] * inv; }
    LDS_WAIT(); asm volatile("" ::: "memory");
    const int n = lane >> 1, c = lane & 1; const LAS float* sp = scr + (32 * c) * 33 + n;
    u32x4 o0, o1;
    o0.x = f8x4(sp[0 * 33], sp[1 * 33], sp[2 * 33], sp[3 * 33]);     o0.y = f8x4(sp[4 * 33], sp[5 * 33], sp[6 * 33], sp[7 * 33]);
    o0.z = f8x4(sp[8 * 33], sp[9 * 33], sp[10 * 33], sp[11 * 33]);   o0.w = f8x4(sp[12 * 33], sp[13 * 33], sp[14 * 33], sp[15 * 33]);
    o1.x = f8x4(sp[16 * 33], sp[17 * 33], sp[18 * 33], sp[19 * 33]); o1.y = f8x4(sp[20 * 33], sp[21 * 33], sp[22 * 33], sp[23 * 33]);
    o1.z = f8x4(sp[24 * 33], sp[25 * 33], sp[26 * 33], sp[27 * 33]); o1.w = f8x4(sp[28 * 33], sp[29 * 33], sp[30 * 33], sp[31 * 33]);
    u32x4* dst = (u32x4*)(WQ + (size_t)(nrow0 + n) * K + k0 + 32 * c);
    dst[0] = o0; dst[1] = o1;
    LDS_WAIT(); asm volatile("" ::: "memory");
}

struct Args { const float* in[22]; float* out; unsigned char* ws; int ph_lo, ph_hi, li, pad; };

__global__ void __launch_bounds__(NWAVES * 64, 2) hymba_fwd(Args args) {
    extern __shared__ __attribute__((aligned(16))) unsigned char lds_raw[];
    LAS unsigned char* lds = (LAS unsigned char*)lds_raw;
    volatile LAS unsigned* MISC = (volatile LAS unsigned*)(lds + MISC_OFF);
    const int tid = threadIdx.x, lane = tid & 63, wave = __builtin_amdgcn_readfirstlane(tid >> 6);
    const int G = gridDim.x; const int bx = blockIdx.x; const int vcu = (G % 8 == 0) ? (bx % 8) * (G / 8) + bx / 8 : bx;
    unsigned char* ws = args.ws;
    unsigned* ctl = (unsigned*)(ws + WS_CTL);
    const float* xp = args.in[0]; const float* xs = args.in[1];
    bf16_t* W1 = (bf16_t*)(ws + WS_W1); bf16_t* W2 = (bf16_t*)(ws + WS_W2); bf16_t* W3 = (bf16_t*)(ws + WS_W3); bf16_t* W4 = (bf16_t*)(ws + WS_W4);
    bf16_t* PROJ = (bf16_t*)(ws + WS_PROJ); bf16_t* X1B = (bf16_t*)(ws + WS_X1B); bf16_t* ACT = (bf16_t*)(ws + WS_ACT);
    bf16_t* OB = (bf16_t*)(ws + WS_OB);
    signed char* XQ = (signed char*)(ws + WS_XQ); float* FX = (float*)(ws + WS_FX); signed char* W1Q = (signed char*)(ws + WS_W1);
    for (int u = tid; u < 128; u += NWAVES * 64) ((LAS unsigned*)(lds + MISC_OFF))[u] = 0u;
    __syncthreads();
    XcdBarrier bar; bar.bar = ctl + CW_BAR + args.li * XCD_BAR_WORDS; bar.x = 0; bar.st = nullptr;
    if (MK_N_LAUNCHES != 6) bar = xcd_barrier_post(ctl + CW_BAR + args.li * XCD_BAR_WORDS, MISC + 8);
    const int lo = args.ph_lo, hi_ph = args.ph_hi;
#ifndef ONLY_PHASE
#define ONLY_PHASE -1
#endif
#define IN(k) ((ONLY_PHASE < 0 || ONLY_PHASE == (k)) && lo <= (k) && (k) < hi_ph)
#define BOTH(k) (IN(k) && IN((k) + 1))
#define GRID_BAR() do { if (MK_N_LAUNCHES != 6) xcd_barrier(bar); } while (0)
#define GROUP_BAR() do { if (MK_N_LAUNCHES != 6) { if (G == 256) group_barrier(ctl + CW_GBAR + (bx & 7) * 128, 32u, MISC + 12); else xcd_barrier(bar); } } while (0)

    if (IN(0)) {
        LAS float* scr = (LAS float*)(lds + wave * 16384);
        const int gw = vcu * NWAVES + wave, NGW = G * NWAVES;
        constexpr int I1 = (DM / 64) * (DIN / 32), I2 = (DM / 64) * (DM / 32), I3 = (DM / 64) * (2 * DFF / 32), I4 = (DFF / 64) * (DM / 32);
        for (int it = gw; it < I1 + I2 + I3 + I4; it += NGW) {
            int r = it;
            if (r < I1) { const int nblk = DIN / 32, kb = r / nblk, nb = r % nblk, n0 = 32 * nb, pn = n0 >> 8, p = n0 & 255, bj = p >> 7, wc = (p & 127) >> 5;
                absmax_item(args.in[3], DIN, 256 * pn + 64 * wc + 32 * bj, 64 * kb, ctl + CW_WMAX1 + n0, args.in[2], lane);
                asm volatile("s_waitcnt vmcnt(0)" ::: "memory"); if (lane == 0) (void)__hip_atomic_fetch_add(ctl + CW_W1CNT, 1u, __ATOMIC_RELAXED, __HIP_MEMORY_SCOPE_AGENT); continue; } r -= I1;
            if (r < I2) { const int nblk = DM / 32, kb = r / nblk, nb = r % nblk;
                const int n0 = 32 * nb, pn = n0 >> 8, p = n0 & 255, bj = p >> 7, wc = (p & 127) >> 5;
                transpose_item<true>(args.in[15], DM, 256 * pn + 64 * wc + 8 * bj, DM, 64 * kb, W2, n0, args.in[10], 127, 1.0f - LAM_INIT, 512, scr, lane); continue; } r -= I2;
            if (r < I3) { const int nblk = 2 * DFF / 32, kb = r / nblk, nb = r % nblk, n0 = 32 * nb, pn = n0 >> 8, p = n0 & 255, bj = p >> 7, e0 = p & 127;
                absmax_item(bj ? args.in[18] : args.in[17], DFF, 128 * pn + e0, 64 * kb, ctl + CW_WMAX + n0, args.in[16], lane); continue; } r -= I3;
            { const int nblk = DM / 32, kb = r / nblk, nb = r % nblk;
                absmax_item(args.in[21], DM, 32 * nb, 64 * kb, ctl + CW_WMAX4 + 32 * nb, nullptr, lane); }
        }
        for (int m = gw; m < NTOK; m += 4 * NGW) {
            f32x4 v[4][4]; float ss[4]; int mr[4];
#pragma unroll
            for (int q = 0; q < 4; ++q) { int mm = m + q * NGW; mr[q] = mm; if (mm >= NTOK) mm = m;
                const float* xr = mm < TOK_P ? xp + (size_t)mm * DM : xs + (size_t)(mm - TOK_P) * DM;
#pragma unroll
                for (int j = 0; j < 4; ++j) v[q][j] = __builtin_nontemporal_load((const f32x4*)xr + 64 * j + lane); }
#pragma unroll
            for (int q = 0; q < 4; ++q) { ss[q] = 0.f;
#pragma unroll
                for (int j = 0; j < 4; ++j) ss[q] += dot4(v[q][j]); }
#pragma unroll
            for (int o = 1; o < 64; o <<= 1) {
#pragma unroll
                for (int q = 0; q < 4; ++q) ss[q] += __shfl_xor(ss[q], o); }
            float am[4];
#pragma unroll
            for (int q = 0; q < 4; ++q) { float a = 0.f;
#pragma unroll
                for (int j = 0; j < 4; ++j) a = __builtin_fmaxf(__builtin_fmaxf(a, __builtin_fmaxf(__builtin_fabsf(v[q][j][0]), __builtin_fabsf(v[q][j][1]))), __builtin_fmaxf(__builtin_fabsf(v[q][j][2]), __builtin_fabsf(v[q][j][3])));
                am[q] = a; }
#pragma unroll
            for (int o = 1; o < 64; o <<= 1) {
#pragma unroll
                for (int q = 0; q < 4; ++q) am[q] = __builtin_fmaxf(am[q], __shfl_xor(am[q], o)); }
#pragma unroll
            for (int q = 0; q < 4; ++q) if (mr[q] < NTOK) { const float ms = ss[q] * (1.f / DM) + EPS; const float r = __builtin_amdgcn_rsqf(ms);
                { const float inv = am[q] > 0.f ? 127.0f / am[q] : 0.f;
                  unsigned* oq = (unsigned*)(XQ + (size_t)mr[q] * DM) + lane;
#pragma unroll
                  for (int j = 0; j < 4; ++j) oq[64 * j] = q4(v[q][j][0] * inv, v[q][j][1] * inv, v[q][j][2] * inv, v[q][j][3] * inv);
                  if (lane == 0) { FX[mr[q]] = am[q] * r * (1.0f / 127.0f); ((float*)(ws + WS_X0S))[mr[q]] = am[q] * (1.0f / 127.0f); } }
            }
        }
        { unsigned sp = 0; while (__builtin_amdgcn_readfirstlane(__hip_atomic_load(ctl + CW_W1CNT, __ATOMIC_RELAXED, __HIP_MEMORY_SCOPE_AGENT)) < (unsigned)I1) { __builtin_amdgcn_s_sleep(2); if (++sp > (1u << 22)) break; }
          __builtin_amdgcn_fence(__ATOMIC_ACQUIRE, "agent"); }
        for (int r = gw; r < I1; r += NGW) { const int nblk = DIN / 32, kb = r / nblk, nb = r % nblk, n0 = 32 * nb, pn = n0 >> 8, p = n0 & 255, bj = p >> 7, wc = (p & 127) >> 5;
            quant_item(args.in[3], DIN, 256 * pn + 64 * wc + 32 * bj, DM, 64 * kb, W1Q, n0, args.in[2], ctl + CW_WMAX1 + n0, scr, lane); }
        if (BOTH(0)) GRID_BAR();
    }

    if (IN(1)) {
        {
            LAS float* scr = (LAS float*)(lds + wave * 16384);
            constexpr int I3 = (DM / 64) * (2 * DFF / 32), I4 = (DFF / 64) * (DM / 32), IT = I3 + I4;
            const int gx = bx & 7, lo_ = (int)((long)IT * (gx * (gx - 1) / 2) / 28), hi_ = (int)((long)IT * (gx * (gx + 1) / 2) / 28);
            for (int r = lo_ + (bx >> 3) * NWAVES + wave; r < hi_; r += (G / 8) * NWAVES) {
                if (r < I3) { const int nblk = 2 * DFF / 32, kb = r / nblk, nb = r % nblk, n0 = 32 * nb, pn = n0 >> 8, p = n0 & 255, bj = p >> 7, e0 = p & 127;
                    quant_item(bj ? args.in[18] : args.in[17], DFF, 128 * pn + e0, DM, 64 * kb, (signed char*)(ws + WS_W3), n0, args.in[16], ctl + CW_WMAX + n0, scr, lane); }
                else { const int r4 = r - I3, nblk = DM / 32, kb = r4 / nblk, nb = r4 % nblk;
                    quantf8_item(args.in[21], DM, 32 * nb, DFF, 64 * kb, (unsigned char*)(ws + WS_W4), 32 * nb, ctl + CW_WMAX4 + 32 * nb, scr, lane); } }
            __syncthreads(); }
        pg8::Gemm g{(const bf16_t*)XQ, (const bf16_t*)W1Q, DM / 2, 256}; pg8::StaticOrder S; S.init(NTOK / 256, DIN / 256, G, bx);
        { LAS float* gl = (LAS float*)(lds + EPX_OFF);
          if (tid < 256) { const int v = tid >> 6, d = tid & 63; gl[tid] = (v == 0 ? args.in[4] : v == 1 ? args.in[5] : v == 2 ? args.in[11] : args.in[12])[d]; }
          LDS_WAIT(); __syncthreads(); }
        pg8::EpiProj E{PROJ, (const LAS float*)(lds + EPX_OFF), FX, (const float*)(ctl + CW_WMAX1)};
        pg8::gemm_phase<pg8::EpiProj, pg8::StaticOrder, true, true, 1>(lds, g, S, E);
        if (BOTH(1)) GROUP_BAR();
    }

    if (IN(2)) {
        if (wave == 0) {
            const float a = args.in[6][lane] * args.in[7][lane], b2 = args.in[8][lane] * args.in[9][lane];
            const float sa = wave_sum(a), sb = wave_sum(b2);
            if (lane == 0) ((LAS float*)(lds + MISC_OFF))[16] = __expf(sa) - __expf(sb) + LAM_INIT;
        }
        LDS_WAIT(); __syncthreads();
        const float lam = ((const LAS float*)(lds + MISC_OFF))[16];
        const int per = (768 + G - 1) / G;
#ifndef NO_DIFF
        for (int i = 0; i < per; ++i) { const int u = vcu * per + i; if (u < 768) { const int bh = u >> 3, qb = u & 7;
            att::diff_unit(bh >> 2, bh & 3, qb, PROJ, OB, (LAS char*)lds, lam, args.in[14]); } }
#endif
#ifndef NO_WIN
        for (int i = 0; i < per; ++i) { const int u = vcu * per + i; if (u < 768) { const int bk = u >> 4, qb = u & 15;
            att::win_unit(bk >> 1, bk & 1, qb, PROJ, OB, (LAS char*)lds, args.in[14], args.in[13]); } }
#endif
        if (BOTH(2)) GROUP_BAR();
    }

    if (IN(3)) {
        pg8::Gemm g{OB, W2, DM, 256}; pg8::StaticOrder S; S.init(NTOK / 256, DM / 256, G, bx);
        pg8::EpiOut E{(const signed char*)(ws + WS_XQ), (const float*)(ws + WS_X0S), (float*)(ws + WS_FX), (LAS float*)(lds + EPX_OFF), (signed char*)(ws + WS_X1Q), (float*)(ws + WS_FA), (float*)(ws + WS_XS), ctl + CW_P3CNT};
        pg8::gemm_phase<pg8::EpiOut, pg8::StaticOrder>(lds, g, S, E);
        if (BOTH(3)) GRID_BAR();
    }

    if (IN(4)) {
        signed char* W3Q = (signed char*)(ws + WS_W3); signed char* X1Q = (signed char*)(ws + WS_X1Q); float* FA = (float*)(ws + WS_FA);
        pg8::Gemm g{(const bf16_t*)(X1Q - DM), (const bf16_t*)W3Q, DM / 2, 254}; pg8::StaticOrder S; S.init(194, 2 * DFF / 256, G, bx);
        pg8::EpiFfn E{(unsigned char*)ACT, FA, (const float*)(ctl + CW_WMAX), args.in[19], args.in[20], (LAS float*)(lds + EPX_OFF)};
        pg8::gemm_phase<pg8::EpiFfn, pg8::StaticOrder, true, true, 1>(lds, g, S, E);
        if (BOTH(4)) GRID_BAR();
    }

    if (IN(5)) {
        pg8::Gemm g{ACT, W4, DFF / 2, 256}; pg8::StaticOrder S; S.init(NTOK / 256, DM / 256, G, bx, 0);
        pg8::EpiDown E{(const signed char*)(ws + WS_X1Q), (const float*)(ws + WS_FX), args.out, (const float*)(ctl + CW_WMAX4)};
        pg8::gemm_phase<pg8::EpiDown, pg8::StaticOrder, true, true, 2>(lds, g, S, E);
    }
#undef IN
#undef BOTH
#undef GRID_BAR
}

extern "C" void kernel_launch(void* const* d_in, const int* in_sizes, int n_in, void* d_out, int out_size, void* d_ws, size_t ws_size, hipStream_t stream) {
    static int grid = 0;
    if (grid == 0) {
        if (n_in != 22 || in_sizes[0] != TOK_P * DM || in_sizes[1] != (NTOK - TOK_P) * DM || out_size != NTOK * DM || ws_size < WS_END) {
            fprintf(stderr, "kernel_launch: shape mismatch (n_in %d, in0 %d, in1 %d, out %d, ws %zu; need ws >= %zu)\n", n_in, n_in > 0 ? in_sizes[0] : -1, n_in > 1 ? in_sizes[1] : -1, out_size, ws_size, (size_t)WS_END); grid = -1; return; }
        int dev = 0, cus = 0;
        if (hipGetDevice(&dev) != hipSuccess || hipDeviceGetAttribute(&cus, hipDeviceAttributeMultiprocessorCount, dev) != hipSuccess) { fprintf(stderr, "kernel_launch: device query failed\n"); grid = -1; return; }
        if (hipFuncSetAttribute((const void*)hymba_fwd, hipFuncAttributeMaxDynamicSharedMemorySize, LDS_BYTES) != hipSuccess) { fprintf(stderr, "kernel_launch: hipFuncSetAttribute failed\n"); grid = -1; return; }
        int per_cu = 0;
        if (hipOccupancyMaxActiveBlocksPerMultiprocessor(&per_cu, (const void*)hymba_fwd, NWAVES * 64, LDS_BYTES) != hipSuccess || per_cu < 1)
            fprintf(stderr, "kernel_launch: note: occupancy query reports %d workgroups per CU\n", per_cu);
        (void)hipGetLastError();
        if (cus < 256) { fprintf(stderr, "kernel_launch: %d CUs; this kernel's unit schedule (co-running tile owners in the out-projection epilogue) is built for 256\n", cus); grid = -1; return; }
        grid = 256;
    }
    if (grid < 0) return;
    (void)hipMemsetAsync((char*)d_ws + WS_XS, 0, (WS_CTL - WS_XS) + CTL_ZERO_BYTES, stream);
    Args a{};
    for (int i = 0; i < 22; ++i) a.in[i] = (const float*)d_in[i];
    a.out = (float*)d_out; a.ws = (unsigned char*)d_ws;
#ifndef PROBE_DUP
#define PROBE_DUP -1
#endif
    constexpr int NL = (PROBE_DUP >= 0) ? 3 : MK_N_LAUNCHES;
    for (int li = 0; li < NL; ++li) {
        if (PROBE_DUP >= 0) {
            a.ph_lo = li == 0 ? 0 : (li == 1 ? PROBE_DUP : PROBE_DUP + 1); a.ph_hi = li == 2 ? 6 : PROBE_DUP + 1; a.li = li;
        } else { a.ph_lo = (NL == 6) ? li : 0; a.ph_hi = (NL == 6) ? li + 1 : 6; a.li = (NL == 6) ? 0 : li; }
        hipLaunchKernelGGL(hymba_fwd, dim3(grid), dim3(NWAVES * 64), LDS_BYTES, stream, a);
        const hipError_t le = hipPeekAtLastError();
        if (le != hipSuccess) { fprintf(stderr, "kernel_launch: launch %d failed: %s\n", li, hipGetErrorName(le)); break; }
    }
}
```
